# Optimizing an MI355X kernel written in HIP

```python
import numpy as np
import jax
import jax.numpy as jnp
from jax import lax

D_MODEL = 2048
BATCH = 16
SEQ = 256
DEPTH = 4
DEC_BATCH = 4
DEC_SEQ = 2048
PAST_LEN = 256

GRID_W = 64
N_AB = (DEPTH + 1) // 2
N_C = DEPTH // 2
A_HEADS = 8
A_NOPE = 128
A_ROPE = 64
A_VDIM = 128
A_QK = A_NOPE + A_ROPE
Q_LORA = 512
KV_LORA = 256
A_WIDTH = A_HEADS * A_VDIM
B_HEADS = 8
B_DK = 128
B_DV = 128
B_KDIM = B_HEADS * B_DK
B_WIDTH = B_HEADS * B_DV
B_CHUNK = 32
C_HEADS = 16
C_KV_HEADS = 4
C_GROUP = C_HEADS // C_KV_HEADS
C_HEAD_DIM = 128
C_WIDTH = C_HEADS * C_HEAD_DIM
C_KV_WIDTH = C_KV_HEADS * C_HEAD_DIM
WINDOW = 128
C_BLOCK = 128
Q_BLOCK = 128
ROPE_BASE = 10000.0
EPS = 1e-6
NEG_BIG = -1e30
AB_SIZES = (Q_LORA, KV_LORA, A_ROPE, A_WIDTH, B_KDIM, B_KDIM, B_KDIM, B_WIDTH, B_WIDTH)
AB_IN = sum(AB_SIZES)
AB_MIX = A_WIDTH + B_WIDTH
C_SIZES = (C_WIDTH, C_KV_WIDTH, C_KV_WIDTH, C_WIDTH)
C_IN = sum(C_SIZES)

kernel_name = 'hybrid_mla_hgrn2_swa_prefix_dit_step'


def rmsnorm(x, g):
    xf = x.astype(jnp.float32)
    y = xf * lax.rsqrt(jnp.mean(xf * xf, axis=-1, keepdims=True) + EPS)
    return (y * g.astype(jnp.float32)).astype(x.dtype)


def split_cols(a, sizes):
    return jnp.split(a, np.cumsum(sizes)[:-1].tolist(), axis=-1)


def modulate_and_norm(x, cond, w_mod, b_mod, g):
    m = (jax.nn.silu(cond) @ w_mod + b_mod)[:, None, :]
    shift, scale, gate = jnp.split(m, 3, axis=-1)
    return rmsnorm(x, g) * (1 + scale) + shift, gate


def axial_rope_tables(n_tokens, rot_dim):
    rows = n_tokens // GRID_W
    row = jnp.repeat(jnp.arange(rows, dtype=jnp.float32), GRID_W)
    col = jnp.tile(jnp.arange(GRID_W, dtype=jnp.float32), rows)
    n_freq = rot_dim // 4
    inv = ROPE_BASE ** (-jnp.arange(n_freq, dtype=jnp.float32) / n_freq)
    ang = jnp.concatenate([row[:, None] * inv, col[:, None] * inv], axis=-1)
    return jnp.cos(ang), jnp.sin(ang)


def apply_rope(x, cos, sin):
    x1, x2 = jnp.split(x.astype(jnp.float32), 2, axis=-1)
    c, s = cos[:, None, :], sin[:, None, :]
    return jnp.concatenate([x1 * c - x2 * s, x1 * s + x2 * c], axis=-1).astype(x.dtype)


def rope_tail(x, cos, sin):
    return jnp.concatenate([x[..., :A_NOPE], apply_rope(x[..., A_NOPE:], cos, sin)], axis=-1)


def blocked_attention(q, k, v, scale):
    Bn, T, H, dq = q.shape
    nb = T // Q_BLOCK
    qb = jnp.moveaxis(q.reshape(Bn, nb, Q_BLOCK, H, dq), 1, 0)

    def one(qi):
        s = jnp.einsum('bqhd,bkhd->bhqk', qi, k).astype(jnp.float32) * scale
        p = jax.nn.softmax(s, axis=-1).astype(v.dtype)
        return jnp.einsum('bhqk,bkhd->bqhd', p, v)

    o = lax.map(one, qb)
    return jnp.moveaxis(o, 0, 1).reshape(Bn, T, H, v.shape[-1])


def mla_keys(c_kv, k_pe, w_kv_up, k_norm_g):
    Bn, L, _ = c_kv.shape
    kv = (c_kv @ w_kv_up).reshape(Bn, L, A_HEADS, A_NOPE + A_VDIM)
    k_pe_h = jnp.broadcast_to(k_pe[:, :, None, :], (Bn, L, A_HEADS, A_ROPE))
    k = jnp.concatenate([kv[..., :A_NOPE], k_pe_h], axis=-1)
    return rmsnorm(k, k_norm_g), kv[..., A_NOPE:]


def hgrn_lower_bounds(lb_logits):
    p = jax.nn.softmax(lb_logits.astype(jnp.float32), axis=0)
    return jnp.cumsum(p, axis=0) - p[0:1]


def hgrn_gates(f_raw, lb):
    x = f_raw.astype(jnp.float32)
    one_minus_f = (1.0 - lb) * jax.nn.sigmoid(-x)
    return jnp.log1p(-one_minus_f), one_minus_f


def hgrn_chunk_scan(q, log_f, k, v, s0):
    Bn, T, H, _ = q.shape
    DV = v.shape[-1]
    n = T // B_CHUNK

    def chunks(a):
        a = a.astype(jnp.float32).reshape(Bn, n, B_CHUNK, H, a.shape[-1])
        return jnp.moveaxis(a, 1, 0).swapaxes(2, 3)

    incl = jnp.tril(jnp.ones((B_CHUNK, B_CHUNK), dtype=bool))[:, :, None]

    def step(S, xs):
        qc, lfc, kc, vc = xs
        b = jnp.cumsum(lfc, axis=2)
        rel = jnp.where(incl, b[:, :, :, None, :] - b[:, :, None, :, :], NEG_BIG)
        scores = jnp.einsum('bhtk,bhtsk,bhsk->bhts', qc, jnp.exp(rel), kc)
        o = scores @ vc + jnp.einsum('bhtk,bhkv->bhtv', qc * jnp.exp(b), S)
        b_end = b[:, :, -1:, :]
        S = jnp.exp(b_end[:, :, 0, :, None]) * S + jnp.einsum('bhsk,bhsv->bhkv', kc * jnp.exp(b_end - b), vc)
        return S, o

    S, o = lax.scan(step, s0.astype(jnp.float32), (chunks(q), chunks(log_f), chunks(k), chunks(v)))
    o = jnp.moveaxis(o.swapaxes(2, 3), 0, 1).reshape(Bn, T, H, DV)
    return o.astype(v.dtype), S.astype(v.dtype)


def hgrn_bidir(q, v, f_fwd, f_bwd, lb, s0_fwd, s0_bwd):
    Bn, T = q.shape[:2]

    def heads(a):
        return a.reshape(Bn, T, B_HEADS, B_DK)

    def flip(a):
        return jnp.flip(a, axis=1)

    lf_f, k_f = hgrn_gates(f_fwd, lb[0])
    lf_b, k_b = hgrn_gates(f_bwd, lb[1])
    o_f, s_f = hgrn_chunk_scan(q, heads(lf_f), heads(k_f), v, s0_fwd)
    o_b, s_b = hgrn_chunk_scan(flip(q), flip(heads(lf_b)), flip(heads(k_b)), flip(v), s0_bwd)
    return o_f + flip(o_b), s_f, s_b


def ab_mixer(h, w_in, q_lora_g, kv_lora_g, w_q_up, w_kv_up, q_norm_g, k_norm_g, lb, hgrn_g, w_out,
             rope=None, ctx=None):
    Bn, T, _ = h.shape
    q_lat, kv_lat, k_pe, a_gate, b_q, b_ff, b_fb, b_i, b_gate = split_cols(h @ w_in, AB_SIZES)
    q = (rmsnorm(q_lat, q_lora_g) @ w_q_up).reshape(Bn, T, A_HEADS, A_QK)
    q = rmsnorm(q, q_norm_g)
    c_kv = rmsnorm(kv_lat, kv_lora_g)
    k, v = mla_keys(c_kv, k_pe, w_kv_up, k_norm_g)
    if ctx is None:
        keys, vals = k, v
        zero = jnp.zeros((Bn, B_HEADS, B_DK, B_DV), jnp.float32)
        s0f, s0b = zero, zero
    else:
        q, k = rope_tail(q, *rope), rope_tail(k, *rope)
        k_ctx, v_ctx = mla_keys(ctx[0], ctx[1], w_kv_up, k_norm_g)
        keys = jnp.concatenate([k_ctx, k], axis=1)
        vals = jnp.concatenate([v_ctx, v], axis=1)
        s0f, s0b = ctx[2], ctx[3]
    o_a = blocked_attention(q, keys, vals, A_QK ** -0.5).reshape(Bn, T, A_WIDTH) * jax.nn.silu(a_gate)
    qb = jax.nn.silu(b_q).reshape(Bn, T, B_HEADS, B_DK)
    vb = b_i.reshape(Bn, T, B_HEADS, B_DV)
    o_b, s_f, s_b = hgrn_bidir(qb, vb, b_ff, b_fb, lb, s0f, s0b)
    o_b = rmsnorm(o_b, hgrn_g).reshape(Bn, T, B_WIDTH) * jax.nn.silu(b_gate)
    out = jnp.concatenate([o_a, o_b], axis=-1) @ w_out
    return out, (c_kv, k_pe, s_f, s_b)


def gqa_ctx_attention(q, k, v, sink):
    Bn, T, _, d = q.shape
    nb = T // Q_BLOCK
    qb = jnp.moveaxis(q.reshape(Bn, nb, Q_BLOCK, C_KV_HEADS, C_GROUP, d), 1, 0)
    sink_l = sink.astype(jnp.float32).reshape(C_KV_HEADS, C_GROUP, 1, 1)

    def one(qi):
        s = jnp.einsum('bqkgd,bskd->bkgqs', qi, k).astype(jnp.float32) * (d ** -0.5)
        s = jnp.concatenate([jnp.broadcast_to(sink_l, s.shape[:-1] + (1,)), s], axis=-1)
        p = jax.nn.softmax(s, axis=-1)[..., 1:].astype(v.dtype)
        return jnp.einsum('bkgqs,bskd->bqkgd', p, v)

    o = lax.map(one, qb)
    return jnp.moveaxis(o, 0, 1).reshape(Bn, T, C_HEADS, d)


def gqa_band_attention(q, k, v, k_ctx, v_ctx, sink):
    Bn, T, _, d = q.shape
    L = k_ctx.shape[1]
    nb = T // C_BLOCK

    def band(a):
        ab = jnp.pad(a, ((0, 0), (C_BLOCK, C_BLOCK), (0, 0), (0, 0))).reshape(Bn, nb + 2, C_BLOCK, C_KV_HEADS, d)
        return jnp.moveaxis(jnp.concatenate([ab[:, :-2], ab[:, 1:-1], ab[:, 2:]], axis=2), 1, 0)

    qb = jnp.moveaxis(q.reshape(Bn, nb, C_BLOCK, C_KV_HEADS, C_GROUP, d), 1, 0)
    blk = jnp.arange(nb)[:, None, None]
    qpos = blk * C_BLOCK + jnp.arange(C_BLOCK)[None, :, None]
    kpos = (blk - 1) * C_BLOCK + jnp.arange(3 * C_BLOCK)[None, None, :]
    mask = (jnp.abs(kpos - qpos) <= WINDOW) & (kpos >= 0) & (kpos < T)
    sink_l = sink.astype(jnp.float32).reshape(C_KV_HEADS, C_GROUP, 1, 1)
    scale = d ** -0.5

    def one(args):
        qi, ki, vi, mi = args
        s_c = jnp.einsum('bqkgd,bskd->bkgqs', qi, k_ctx).astype(jnp.float32) * scale
        s_l = jnp.einsum('bqkgd,bskd->bkgqs', qi, ki).astype(jnp.float32) * scale
        s_l = jnp.where(mi, s_l, NEG_BIG)
        s = jnp.concatenate([jnp.broadcast_to(sink_l, s_c.shape[:-1] + (1,)), s_c, s_l], axis=-1)
        p = jax.nn.softmax(s, axis=-1).astype(vi.dtype)
        return (jnp.einsum('bkgqs,bskd->bqkgd', p[..., 1:1 + L], v_ctx)
                + jnp.einsum('bkgqs,bskd->bqkgd', p[..., 1 + L:], vi))

    o = lax.map(one, (qb, band(k), band(v), mask))
    return jnp.moveaxis(o, 0, 1).reshape(Bn, T, C_HEADS, d)


def c_mixer(h, w_in, q_norm_g, k_norm_g, sink, w_out, rope=None, ctx=None):
    Bn, T, _ = h.shape
    q, k, v, gate = split_cols(h @ w_in, C_SIZES)
    q = rmsnorm(q.reshape(Bn, T, C_HEADS, C_HEAD_DIM), q_norm_g)
    k = rmsnorm(k.reshape(Bn, T, C_KV_HEADS, C_HEAD_DIM), k_norm_g)
    v = v.reshape(Bn, T, C_KV_HEADS, C_HEAD_DIM)
    if ctx is None:
        o = gqa_ctx_attention(q, k, v, sink)
    else:
        o = gqa_band_attention(apply_rope(q, *rope), apply_rope(k, *rope), v, ctx[0], ctx[1], sink)
    out = (o.reshape(Bn, T, C_WIDTH) * jax.nn.silu(gate)) @ w_out
    return out, (k, v)


def setup_inputs(seed: int = 0) -> dict:
    key = jax.random.key(seed)
    keys = iter(jax.random.split(key, 64))

    def nrm(shape, scale):
        return jax.random.normal(next(keys), shape, jnp.float32) * scale

    def gain(shape):
        return 1.0 + 0.01 * jax.random.normal(next(keys), shape, jnp.float32)

    D = D_MODEL
    return {
        'x_prompt': nrm((BATCH, SEQ, D), 1.0),
        'x_sample': nrm((DEC_BATCH, DEC_SEQ, D), 1.0),
        'cache_ckv': nrm((DEC_BATCH, N_AB, PAST_LEN, KV_LORA), 1.0),
        'cache_kpe': nrm((DEC_BATCH, N_AB, PAST_LEN, A_ROPE), 1.0),
        'state_hgrn_fwd': nrm((DEC_BATCH, N_AB, B_HEADS, B_DK, B_DV), 0.5),
        'state_hgrn_bwd': nrm((DEC_BATCH, N_AB, B_HEADS, B_DK, B_DV), 0.5),
        'cache_k_c': nrm((DEC_BATCH, N_C, PAST_LEN, C_KV_HEADS, C_HEAD_DIM), 1.0),
        'cache_v_c': nrm((DEC_BATCH, N_C, PAST_LEN, C_KV_HEADS, C_HEAD_DIM), 1.0),
        'c': nrm((DEC_BATCH, D), 1.0),
        'c_ctx': nrm((D,), 1.0),
        'mod_w_ab': nrm((N_AB, D, 3 * D), 0.5 * D ** -0.5),
        'mod_b_ab': nrm((N_AB, 3 * D), 0.01),
        'norm_ab': gain((N_AB, D)),
        'w_in_ab': nrm((N_AB, D, AB_IN), D ** -0.5),
        'q_lora_norm': gain((N_AB, Q_LORA)),
        'kv_lora_norm': gain((N_AB, KV_LORA)),
        'w_q_up': nrm((N_AB, Q_LORA, A_HEADS * A_QK), Q_LORA ** -0.5),
        'w_kv_up': nrm((N_AB, KV_LORA, A_HEADS * (A_NOPE + A_VDIM)), KV_LORA ** -0.5),
        'q_norm_ab': gain((N_AB, A_QK)),
        'k_norm_ab': gain((N_AB, A_QK)),
        'hgrn_lb_logits': nrm((N_AB, 2, B_KDIM), 0.5),
        'hgrn_out_norm': gain((N_AB, B_DV)),
        'w_out_ab': nrm((N_AB, AB_MIX, D), AB_MIX ** -0.5),
        'mod_w_c': nrm((N_C, D, 3 * D), 0.5 * D ** -0.5),
        'mod_b_c': nrm((N_C, 3 * D), 0.01),
        'norm_c': gain((N_C, D)),
        'w_in_c': nrm((N_C, D, C_IN), D ** -0.5),
        'q_norm_c': gain((N_C, C_HEAD_DIM)),
        'k_norm_c': gain((N_C, C_HEAD_DIM)),
        'sink_c': nrm((N_C, C_HEADS), 0.5),
        'w_out_c': nrm((N_C, C_WIDTH, D), C_WIDTH ** -0.5),
    }


def reference(x_prompt, x_sample, cache_ckv, cache_kpe, state_hgrn_fwd, state_hgrn_bwd, cache_k_c, cache_v_c,
              c, c_ctx, mod_w_ab, mod_b_ab, norm_ab, w_in_ab, q_lora_norm, kv_lora_norm, w_q_up, w_kv_up,
              q_norm_ab, k_norm_ab, hgrn_lb_logits, hgrn_out_norm, w_out_ab, mod_w_c, mod_b_c, norm_c, w_in_c,
              q_norm_c, k_norm_c, sink_c, w_out_c):
    lat_len = x_sample.shape[1]
    rope_a = axial_rope_tables(lat_len, A_ROPE)
    rope_c = axial_rope_tables(lat_len, C_HEAD_DIM)
    lower = hgrn_lower_bounds(hgrn_lb_logits)
    cond_ctx = c_ctx[None, :]
    xp, xs = x_prompt, x_sample
    new_ckv, new_kpe, new_sf, new_sb, new_kc, new_vc = [], [], [], [], [], []
    for layer in range(DEPTH):
        j = layer // 2
        if layer % 2 == 0:
            w = (w_in_ab[j], q_lora_norm[j], kv_lora_norm[j], w_q_up[j], w_kv_up[j], q_norm_ab[j], k_norm_ab[j],
                 lower[j], hgrn_out_norm[j], w_out_ab[j])
            h, g = modulate_and_norm(xp, cond_ctx, mod_w_ab[j], mod_b_ab[j], norm_ab[j])
            out, (ckv, kpe, sf, sb) = ab_mixer(h, *w)
            xp = xp + g * out
            new_ckv.append(ckv)
            new_kpe.append(kpe)
            new_sf.append(sf)
            new_sb.append(sb)
            h, g = modulate_and_norm(xs, c, mod_w_ab[j], mod_b_ab[j], norm_ab[j])
            ctx = (cache_ckv[:, j], cache_kpe[:, j], state_hgrn_fwd[:, j], state_hgrn_bwd[:, j])
            out, _ = ab_mixer(h, *w, rope=rope_a, ctx=ctx)
            xs = xs + g * out
        else:
            w = (w_in_c[j], q_norm_c[j], k_norm_c[j], sink_c[j], w_out_c[j])
            h, g = modulate_and_norm(xp, cond_ctx, mod_w_c[j], mod_b_c[j], norm_c[j])
            out, (kc, vc) = c_mixer(h, *w)
            xp = xp + g * out
            new_kc.append(kc)
            new_vc.append(vc)
            h, g = modulate_and_norm(xs, c, mod_w_c[j], mod_b_c[j], norm_c[j])
            out, _ = c_mixer(h, *w, rope=rope_c, ctx=(cache_k_c[:, j], cache_v_c[:, j]))
            xs = xs + g * out
    return (xp, xs, jnp.stack(new_ckv, axis=1), jnp.stack(new_kpe, axis=1), jnp.stack(new_sf, axis=1),
            jnp.stack(new_sb, axis=1), jnp.stack(new_kc, axis=1), jnp.stack(new_vc, axis=1))
```

```cpp
#include <hip/hip_runtime.h>
#include <hip/hip_cooperative_groups.h>
#include <cstdio>
#include <cstdint>
namespace cg = cooperative_groups;

namespace pg8 {
#define PG8_LAS __attribute__((address_space(3)))
typedef unsigned short bf16_t;
typedef short bf16x8 __attribute__((ext_vector_type(8)));
typedef float f32x4 __attribute__((ext_vector_type(4)));
typedef unsigned u32x4 __attribute__((ext_vector_type(4)));
constexpr int BM = 256, BK = 64, HALF = 128, HTB = HALF * BK * 2  , STAGE_BYTES = 8 * HTB, NXCD = 8, WGM = 8;
__device__ __forceinline__ int pg8_otid() { int t = threadIdx.x; asm volatile("" : "+v"(t)); return t; }

__host__ __device__ __forceinline__ int lds_byte(int r, int c) { const int st = (r >> 4) * 2 + (c >> 5), rr = r & 15, cc = c & 31, ob = rr * 64 + cc * 2; return st * 1024 + (ob ^ (((ob >> 9) & 1) << 5)); }
__host__ __device__ __forceinline__ void stage_rc(int b, int& R, int& C) { const int st = b / 1024, sb = b % 1024, swz = sb ^ (((sb >> 9) & 1) << 5); R = (st >> 1) * 16 + swz / 64; C = (st & 1) * 32 + (swz % 64) / 2; }
__host__ __device__ __forceinline__ int perm32(int rho) { const int n = rho >> 4, i = rho & 15; return 8 * (i >> 2) + 4 * n + (i & 3); }

struct Unit { int pm, pn; };
struct Gemm { const bf16_t* A; const bf16_t* Bt; int M, N, K; };

struct StaticOrder {
    int nM, nN, nwg, G, c;
    __host__ __device__ void init(int M, int N, int G_, int c_) { nM = M / BM; nN = N / BM; nwg = nM * nN; G = G_; c = c_; }
    __host__ __device__ bool next(int i, Unit& u) const {
        const long L = (long)i * G + c; if (L >= nwg) return false;
        int wgid = (int)L; { const int q = nwg / NXCD, r = nwg % NXCD, xcd = wgid % NXCD, off = wgid / NXCD; wgid = (xcd < r ? xcd * (q + 1) : r * (q + 1) + (xcd - r) * q) + off; }
        const int nig = WGM * nN, gid = wgid / nig, fm = gid * WGM, gsz = (nM - fm) < WGM ? (nM - fm) : WGM;
        u.pm = fm + ((wgid % nig) % gsz); u.pn = (wgid % nig) / gsz; return true;
    }
    __device__ __forceinline__ void a_ready(const Unit&) const {}
    __device__ __forceinline__ void done(const Unit&) const {}
};

__device__ __forceinline__ unsigned cvt_pk_bf16(float lo, float hi) { unsigned r; asm volatile("v_cvt_pk_bf16_f32 %0, %1, %2" : "=v"(r) : "v"(lo), "v"(hi)); return r; }

struct EpiStore {
    static constexpr bool PERM = true, AFTER_DRAIN = false;
    bf16_t* O; int ldc;
    __device__ __forceinline__ void operator()(const f32x4 (&acc)[2][2][4][2], const Unit& u, int wr, int wc, int fr, int fq) const {
        const int row0 = u.pm * BM + wr * 64 + fr; const int col0 = u.pn * BM + wc * 32 + 8 * fq;
#pragma unroll
        for (int ai = 0; ai < 2; ++ai)
#pragma unroll
            for (int m = 0; m < 4; ++m) { bf16_t* rowp = O + (size_t)(row0 + ai * HALF + m * 16) * ldc + col0;
#pragma unroll
                for (int bj = 0; bj < 2; ++bj) { const f32x4 v0 = acc[ai][bj][m][0], v1 = acc[ai][bj][m][1];
                    u32x4 w; w.x = cvt_pk_bf16(v0[0], v0[1]); w.y = cvt_pk_bf16(v0[2], v0[3]); w.z = cvt_pk_bf16(v1[0], v1[1]); w.w = cvt_pk_bf16(v1[2], v1[3]);
                    *(u32x4*)(rowp + bj * HALF) = w; } }
    }
};
struct EpiResid {
    static constexpr bool PERM = true, AFTER_DRAIN = false;
    const float* xin_ctx; const float* xin_lat; float* out; const float* gate_base;
    __device__ __forceinline__ void operator()(const f32x4 (&acc)[2][2][4][2], const Unit& u, int wr, int wc, int fr, int fq) const {
        const int pm = u.pm;
        const float* xin = pm < 16 ? xin_ctx + (size_t)pm * 256 * 2048 : xin_lat + (size_t)(pm - 16) * 256 * 2048;
        float* xo = out + (size_t)pm * 256 * 2048;
        const int ci = pm < 16 ? 4 : ((pm - 16) >> 3);
        const float* gt = gate_base + ci * 6144;
        const int rl0 = wr * 64 + fr, col0 = u.pn * BM + wc * 32 + 8 * fq;
        f32x4 g0[2], g1[2];
#pragma unroll
        for (int bj = 0; bj < 2; ++bj) { g0[bj] = *(const f32x4*)(gt + col0 + bj * HALF); g1[bj] = *(const f32x4*)(gt + col0 + bj * HALF + 4); }
#pragma unroll
        for (int ai = 0; ai < 2; ++ai)
#pragma unroll
            for (int m = 0; m < 4; ++m) { const size_t off = (size_t)(rl0 + ai * HALF + m * 16) * 2048 + col0;
#pragma unroll
                for (int bj = 0; bj < 2; ++bj) {
                    const f32x4 x0 = *(const f32x4*)(xin + off + bj * HALF), x1 = *(const f32x4*)(xin + off + bj * HALF + 4);
                    *(f32x4*)(xo + off + bj * HALF) = x0 + g0[bj] * acc[ai][bj][m][0];
                    *(f32x4*)(xo + off + bj * HALF + 4) = x1 + g1[bj] * acc[ai][bj][m][1]; }
                asm volatile("" ::: "memory"); }
    }
};

template <class Epi, class Sched, bool ALIGN_EPI = false, bool SP2 = false>
__device__ __forceinline__ void gemm_phase(PG8_LAS unsigned char* lds, const Gemm g, const Sched& S, const Epi& E) {
    const int tid = pg8_otid(), wid = __builtin_amdgcn_readfirstlane(tid >> 6), lane = tid & 63, wr = wid >> 2, wc = wid & 3, fr = lane & 15, fq = lane >> 4;
    const int K = g.K, nt = K / BK;
    unsigned voffA[2], voffB[2];
#pragma unroll
    for (int i = 0; i < 2; ++i) { int R, C; stage_rc(tid * 16 + i * 8192, R, C); const int Rb = Epi::PERM ? ((R & ~31) + perm32(R & 31)) : R;
        voffA[i] = (unsigned)(R * K + C) * 2u; voffB[i] = (unsigned)(Rb * K + C) * 2u; }
    const size_t kstep = (size_t)(BK * 2);
    const size_t hstep = (size_t)HALF * K * 2;
    const size_t tstep = 2 * hstep;
    const unsigned ldsw = (unsigned)wid * 1024u;
    const int aoff = lds_byte(wr * 64 + fr, fq * 8), boff = lds_byte(wc * 32 + fr, fq * 8);
#define PG8_SA(b, h) (((b) * 2 + (h)) * HTB)
#define PG8_SB(b, h) ((4 + (b) * 2 + (h)) * HTB)
#define PG8_STAGE(bufoff, gbase, voff) do { _Pragma("unroll") for (int _i = 0; _i < 2; ++_i) \
        __builtin_amdgcn_global_load_lds((const unsigned*)((const char*)(gbase) + (voff)[_i]), (PG8_LAS unsigned*)(lds + (bufoff) + ldsw + _i * 8192), 16, 0, 0); } while (0)
#define PG8_LDA(dst, b, h) do { _Pragma("unroll") for (int m = 0; m < 4; ++m) _Pragma("unroll") for (int k = 0; k < 2; ++k) dst[m][k] = *(const PG8_LAS bf16x8*)(lds + PG8_SA(b, h) + aoff + m * 2048 + k * 1024); } while (0)
#define PG8_LDB(dst, b, h) do { _Pragma("unroll") for (int n = 0; n < 2; ++n) _Pragma("unroll") for (int k = 0; k < 2; ++k) dst[n][k] = *(const PG8_LAS bf16x8*)(lds + PG8_SB(b, h) + boff + n * 2048 + k * 1024); } while (0)
#define PG8_MMA(ai, bj, At, Bt) do { __builtin_amdgcn_s_setprio(1); _Pragma("unroll") for (int m = 0; m < 4; ++m) _Pragma("unroll") for (int n = 0; n < 2; ++n) _Pragma("unroll") for (int k = 0; k < 2; ++k) \
        acc[ai][bj][m][n] = __builtin_amdgcn_mfma_f32_16x16x32_bf16(Bt[n][k], At[m][k], acc[ai][bj][m][n], 0, 0, 0); __builtin_amdgcn_s_setprio(0); } while (0)
#define PG8_WAIT_V(n) asm volatile("s_waitcnt vmcnt(" #n ")" ::: "memory")
#define PG8_WAIT_L(n) asm volatile("s_waitcnt lgkmcnt(" #n ")" ::: "memory")
#define PG8_BAR __builtin_amdgcn_s_barrier()
#define PG8_SCHED __builtin_amdgcn_sched_barrier(0)
    Unit cur, nxt; int ui = 0;
    if (!S.next(0, cur)) return;
    f32x4 acc[2][2][4][2];
#pragma unroll
    for (int a = 0; a < 2; ++a)
#pragma unroll
        for (int b = 0; b < 2; ++b)
#pragma unroll
            for (int m = 0; m < 4; ++m)
#pragma unroll
                for (int n = 0; n < 2; ++n) acc[a][b][m][n] = (f32x4){0.f, 0.f, 0.f, 0.f};
    bf16x8 At[4][2], B0[2][2], B1[2][2];
    const char* cA = (const char*)g.A + (size_t)cur.pm * tstep; const char* cB = (const char*)g.Bt + (size_t)cur.pn * tstep;
    S.a_ready(cur);
    if constexpr (SP2) {
        PG8_STAGE(PG8_SB(0, 0), cB, voffB); PG8_STAGE(PG8_SB(0, 1), cB + hstep, voffB); PG8_STAGE(PG8_SA(0, 0), cA, voffA); PG8_STAGE(PG8_SA(0, 1), cA + hstep, voffA);
        if (wr == 1) PG8_BAR;
        PG8_WAIT_V(2); PG8_BAR;
        PG8_STAGE(PG8_SB(1, 0), cB + kstep, voffB); PG8_STAGE(PG8_SA(1, 0), cA + kstep, voffA); PG8_STAGE(PG8_SB(1, 1), cB + hstep + kstep, voffB);
        PG8_WAIT_V(6); PG8_BAR;
    } else {
        PG8_STAGE(PG8_SB(0, 0), cB, voffB); PG8_STAGE(PG8_SA(0, 0), cA, voffA); PG8_STAGE(PG8_SB(0, 1), cB + hstep, voffB); PG8_STAGE(PG8_SA(0, 1), cA + hstep, voffA);
        if (wr == 1) PG8_BAR;
        PG8_WAIT_V(4); PG8_BAR;
        PG8_STAGE(PG8_SB(1, 0), cB + kstep, voffB); PG8_STAGE(PG8_SA(1, 0), cA + kstep, voffA); PG8_STAGE(PG8_SB(1, 1), cB + hstep + kstep, voffB);
        PG8_WAIT_V(6); PG8_BAR;
    }
    for (;;) {
        const bool has_next = S.next(ui + 1, nxt);
        const char* nA = has_next ? (const char*)g.A + (size_t)nxt.pm * tstep : cA; const char* nB = has_next ? (const char*)g.Bt + (size_t)nxt.pn * tstep : cB;
        for (int t = 0; t < nt; t += 2) {
            const bool last = (t == nt - 2);
            const char* a1 = cA + (size_t)(t + 1) * kstep;
            const char* a2 = last ? nA : cA + (size_t)(t + 2) * kstep; const char* b2 = last ? nB : cB + (size_t)(t + 2) * kstep;
            const char* a3 = a2 + kstep; const char* b3 = b2 + kstep;
            if (last && has_next) S.a_ready(nxt);
            if constexpr (SP2) {
            PG8_LDB(B0, 0, 0); PG8_LDB(B1, 0, 1); PG8_SCHED; PG8_LDA(At, 0, 0); PG8_STAGE(PG8_SA(1, 1), a1 + hstep, voffA);
            PG8_WAIT_V(8); PG8_WAIT_L(0); PG8_BAR; PG8_MMA(0, 0, At, B0); PG8_MMA(0, 1, At, B1); PG8_BAR; PG8_SCHED;
            PG8_LDA(At, 0, 1); PG8_STAGE(PG8_SB(0, 0), b2, voffB); PG8_STAGE(PG8_SB(0, 1), b2 + hstep, voffB); PG8_STAGE(PG8_SA(0, 0), a2, voffA);
            PG8_WAIT_V(8); PG8_WAIT_L(0); PG8_BAR; PG8_MMA(1, 0, At, B0); PG8_MMA(1, 1, At, B1); PG8_BAR; PG8_SCHED;
            PG8_LDB(B0, 1, 0); PG8_LDB(B1, 1, 1); PG8_SCHED; PG8_LDA(At, 1, 0); PG8_STAGE(PG8_SA(0, 1), a2 + hstep, voffA);
            PG8_WAIT_V(8); PG8_WAIT_L(0); PG8_BAR; PG8_MMA(0, 0, At, B0); PG8_MMA(0, 1, At, B1); PG8_BAR; PG8_SCHED;
            PG8_LDA(At, 1, 1); PG8_STAGE(PG8_SB(1, 0), b3, voffB); PG8_STAGE(PG8_SB(1, 1), b3 + hstep, voffB); PG8_STAGE(PG8_SA(1, 0), a3, voffA);
            PG8_WAIT_V(8); PG8_WAIT_L(0); PG8_BAR; PG8_MMA(1, 0, At, B0); PG8_MMA(1, 1, At, B1); PG8_BAR; PG8_SCHED;
            } else {
            PG8_LDB(B0, 0, 0); PG8_SCHED; PG8_LDA(At, 0, 0); PG8_STAGE(PG8_SA(1, 1), a1 + hstep, voffA);
            PG8_WAIT_L(8); PG8_BAR; PG8_WAIT_L(0); PG8_MMA(0, 0, At, B0); PG8_BAR; PG8_SCHED;
            PG8_LDB(B1, 0, 1); PG8_STAGE(PG8_SB(0, 0), b2, voffB);
            PG8_BAR; PG8_WAIT_L(0); PG8_MMA(0, 1, At, B1); PG8_BAR;
            PG8_LDA(At, 0, 1); PG8_STAGE(PG8_SA(0, 0), a2, voffA);
            PG8_BAR; PG8_WAIT_L(0); PG8_MMA(1, 0, At, B0); PG8_BAR; PG8_SCHED;
            PG8_STAGE(PG8_SB(0, 1), b2 + hstep, voffB);
            PG8_WAIT_V(6); PG8_BAR; PG8_MMA(1, 1, At, B1); PG8_BAR;
            PG8_LDB(B0, 1, 0); PG8_SCHED; PG8_LDA(At, 1, 0); PG8_STAGE(PG8_SA(0, 1), a2 + hstep, voffA);
            PG8_WAIT_L(8); PG8_BAR; PG8_WAIT_L(0); PG8_MMA(0, 0, At, B0); PG8_BAR; PG8_SCHED;
            PG8_LDB(B1, 1, 1); PG8_STAGE(PG8_SB(1, 0), b3, voffB);
            PG8_BAR; PG8_WAIT_L(0); PG8_MMA(0, 1, At, B1); PG8_BAR;
            PG8_LDA(At, 1, 1); PG8_STAGE(PG8_SA(1, 0), a3, voffA);
            PG8_BAR; PG8_WAIT_L(0); PG8_MMA(1, 0, At, B0); PG8_BAR; PG8_SCHED;
            PG8_STAGE(PG8_SB(1, 1), b3 + hstep, voffB);
            PG8_WAIT_V(6); PG8_BAR; PG8_MMA(1, 1, At, B1); PG8_BAR;
            }
        }
        if constexpr (ALIGN_EPI) { if (wr == 0) PG8_BAR; }
        if constexpr (!Epi::AFTER_DRAIN) { E(acc, cur, wr, wc, fr, fq); S.done(cur); }
        if (!has_next) break;
#pragma unroll
        for (int a = 0; a < 2; ++a)
#pragma unroll
            for (int b = 0; b < 2; ++b)
#pragma unroll
                for (int m = 0; m < 4; ++m)
#pragma unroll
                    for (int n = 0; n < 2; ++n) acc[a][b][m][n] = (f32x4){0.f, 0.f, 0.f, 0.f};
        cur = nxt; cA = nA; cB = nB; ++ui;
        if constexpr (ALIGN_EPI) { if (wr == 1) PG8_BAR; }
    }
    PG8_WAIT_V(0);
    if constexpr (!ALIGN_EPI) { if (wr == 0) PG8_BAR; }
    PG8_BAR;
    if constexpr (Epi::AFTER_DRAIN) { E.fused(acc, cur, wr, wc, fr, fq, lds, wid, lane); S.done(cur); }
#undef PG8_SA
#undef PG8_SB
#undef PG8_STAGE
#undef PG8_LDA
#undef PG8_LDB
#undef PG8_MMA
#undef PG8_WAIT_V
#undef PG8_WAIT_L
#undef PG8_BAR
#undef PG8_SCHED
}
}

#define LAS __attribute__((address_space(3)))
typedef unsigned short bf16_t;
typedef short bf16x8 __attribute__((ext_vector_type(8)));
typedef short s16x4 __attribute__((ext_vector_type(4)));
typedef float f32x4 __attribute__((ext_vector_type(4)));
typedef float f32x16 __attribute__((ext_vector_type(16)));
typedef unsigned u32x4 __attribute__((ext_vector_type(4)));
typedef unsigned u32x2 __attribute__((ext_vector_type(2)));


__device__ __forceinline__ int otid() { int t = threadIdx.x; asm volatile("" : "+v"(t)); return t; }
__device__ __forceinline__ int obid() { int b = blockIdx.x; asm volatile("" : "+s"(b)); return b; }
constexpr int NWAVES = 8, NTHR = 512;
constexpr int DM = 2048, MC = 4096, ML = 8192, MROWS = 12288, MKROWS = 13312;
constexpr int LDP_AB = 7168, LDP_C = 5120;
constexpr int COL_QL = 0, COL_KVL = 512, COL_AG = 768, COL_BQ = 1792, COL_FF = 2816, COL_FB = 3840, COL_BI = 4864, COL_BG = 5888, COL_KPE = 6912;
constexpr float EPSN = 1e-6f;
constexpr float LOG2E = 1.4426950408889634f;
constexpr float QSC_A = 0.07216878364870322f * LOG2E;
constexpr float QSC_C = 0.08838834764831845f * LOG2E;

constexpr size_t O_YP = 0, O_YS = 8388608, O_CKV = 25165824, O_KPE = 27262976, O_SF = 27787264, O_SB = 31981568, O_KC = 36175872, O_VC = 40370176;

constexpr size_t MiB = 1u << 20;
constexpr size_t WS_CTL = 0, CTL_BYTES = 65536;
constexpr size_t WS_MOD = 1 * MiB, WS_LB = WS_MOD + 512 * 1024, WS_ROPEA = WS_LB + 64 * 1024, WS_ROPEC = WS_ROPEA + 512 * 1024;
constexpr size_t WS_KCC = 532 * MiB;
constexpr size_t WS_WINAB = 8 * MiB, WS_WQUP = 64 * MiB, WS_WKVUP = 67 * MiB, WS_WOUTAB = 69 * MiB, WS_WINC = 85 * MiB, WS_WOUTC = 125 * MiB;
constexpr size_t WS_H = 141 * MiB, WS_PROJ = 189 * MiB, WS_QRAW = 357 * MiB, WS_KVRAW = 393 * MiB, WS_KF = 445 * MiB, WS_OF = 484 * MiB, WS_OB = 508 * MiB;
constexpr size_t WS_QN = WS_OF, WS_CKV = WS_OF + 12 * MiB, WS_END = 552 * MiB;

constexpr int LDS_PHASE = 131072, LDS_BYTES = LDS_PHASE + 1024;

__device__ __forceinline__ float bf2f(unsigned short b) { return __uint_as_float((unsigned)b << 16); }
__device__ __forceinline__ unsigned f2bf(float f) { unsigned u = __float_as_uint(f); return (u + 0x7fffu + ((u >> 16) & 1u)) >> 16; }
__device__ __forceinline__ unsigned pk2(float lo, float hi) { return f2bf(lo) | (f2bf(hi) << 16); }
__device__ __forceinline__ float silu_f(float x) { return x / (1.f + __expf(-x)); }
__device__ __forceinline__ float wave_sum(float v) {
#pragma unroll
    for (int o = 1; o < 64; o <<= 1) v += __shfl_xor(v, o);
    return v;
}
__device__ __forceinline__ float sum16(float v) {
    v += __shfl_xor(v, 1); v += __shfl_xor(v, 2); v += __shfl_xor(v, 4); v += __shfl_xor(v, 8); return v;
}
__device__ __forceinline__ bf16x8 pack8(const float* v) {
    u32x4 w; w.x = pk2(v[0], v[1]); w.y = pk2(v[2], v[3]); w.z = pk2(v[4], v[5]); w.w = pk2(v[6], v[7]); return __builtin_bit_cast(bf16x8, w);
}

struct Args { const float* in[31]; float* out; unsigned char* ws; };

__device__ __forceinline__ void p0_transpose_item(const float* W, int K, int N, bf16_t* WT, int k0, int n0, int drow0, LAS float* scr, int lane) {
#pragma unroll 8
    for (int i = 0; i < 32; ++i) { const int kk = 2 * i + (lane >> 5); scr[kk * 33 + (lane & 31)] = W[(size_t)(k0 + kk) * N + n0 + (lane & 31)]; }
    asm volatile("s_waitcnt lgkmcnt(0)" ::: "memory");
    const int c = lane & 7;
#pragma unroll
    for (int j = 0; j < 4; ++j) { const int n = (lane >> 3) + 8 * j; const LAS float* s = scr + (8 * c) * 33 + n;
        u32x4 o; o.x = pk2(s[0 * 33], s[1 * 33]); o.y = pk2(s[2 * 33], s[3 * 33]); o.z = pk2(s[4 * 33], s[5 * 33]); o.w = pk2(s[6 * 33], s[7 * 33]);
        *(u32x4*)(WT + (size_t)(drow0 + n) * K + k0 + 8 * c) = o; }
    asm volatile("s_waitcnt lgkmcnt(0)" ::: "memory");
}

__device__ __forceinline__ void phase_p0(const Args& a, LAS unsigned char* lds) {
    const int tid = otid(), lane = tid & 63, wave = tid >> 6;
    const int G = gridDim.x, bid = obid();
    const int gw = bid * NWAVES + wave, NGW = G * NWAVES;
    unsigned char* ws = a.ws;
    {
        LAS float* scr = (LAS float*)(lds + wave * 8448);
        constexpr int I_INAB = 32 * 218, I_QUP = 8 * 48, I_KVUP = 4 * 64, I_OUT = 32 * 64, I_INC = 32 * 160;
        constexpr int PER_J = I_INAB + I_QUP + I_KVUP + I_OUT + I_INC + I_OUT;
        for (int it = gw; it < 2 * PER_J; it += NGW) {
            const int j = it / PER_J; int r = it % PER_J;
            if (r < I_INAB) { const int kb = r / 218, nb = r % 218, n0 = nb * 32; const int d0 = n0 < 768 ? n0 : (n0 < 832 ? n0 + 6144 : n0 - 64);
                p0_transpose_item(a.in[13] + (size_t)j * 2048 * 6976, 2048, 6976, (bf16_t*)(ws + WS_WINAB) + (size_t)j * 7168 * 2048, kb * 64, n0, d0, scr, lane); continue; }
            r -= I_INAB;
            if (r < I_QUP) { const int kb = r / 48, nb = r % 48;
                p0_transpose_item(a.in[16] + (size_t)j * 512 * 1536, 512, 1536, (bf16_t*)(ws + WS_WQUP) + (size_t)j * 1536 * 512, kb * 64, nb * 32, nb * 32, scr, lane); continue; }
            r -= I_QUP;
            if (r < I_KVUP) { const int kb = r / 64, nb = r % 64;
                p0_transpose_item(a.in[17] + (size_t)j * 256 * 2048, 256, 2048, (bf16_t*)(ws + WS_WKVUP) + (size_t)j * 2048 * 256, kb * 64, nb * 32, nb * 32, scr, lane); continue; }
            r -= I_KVUP;
            if (r < I_OUT) { const int kb = r / 64, nb = r % 64;
                p0_transpose_item(a.in[22] + (size_t)j * 2048 * 2048, 2048, 2048, (bf16_t*)(ws + WS_WOUTAB) + (size_t)j * 2048 * 2048, kb * 64, nb * 32, nb * 32, scr, lane); continue; }
            r -= I_OUT;
            if (r < I_INC) { const int kb = r / 160, nb = r % 160;
                p0_transpose_item(a.in[26] + (size_t)j * 2048 * 5120, 2048, 5120, (bf16_t*)(ws + WS_WINC) + (size_t)j * 5120 * 2048, kb * 64, nb * 32, nb * 32, scr, lane); continue; }
            r -= I_INC;
            { const int kb = r / 64, nb = r % 64;
                p0_transpose_item(a.in[30] + (size_t)j * 2048 * 2048, 2048, 2048, (bf16_t*)(ws + WS_WOUTC) + (size_t)j * 2048 * 2048, kb * 64, nb * 32, nb * 32, scr, lane); }
        }
    }
    const int gt = bid * NTHR + tid, NGT = G * NTHR;
    for (int i = gt; i < 2 * 192 * 256; i += NGT) { const int j = i / (192 * 256), r = i % (192 * 256);
        *(u32x4*)((bf16_t*)(ws + WS_WINAB) + (size_t)j * 7168 * 2048 + (size_t)6976 * 2048 + (size_t)r * 8) = (u32x4){0u, 0u, 0u, 0u}; }
    for (int i = gt; i < 2 * 131072; i += NGT) { const int which = i / 131072, e = (i % 131072) * 8;
        const float* src = a.in[6 + which] + e; const f32x4 x0 = *(const f32x4*)src, x1 = *(const f32x4*)(src + 4);
        u32x4 w; w.x = pk2(x0[0], x0[1]); w.y = pk2(x0[2], x0[3]); w.z = pk2(x1[0], x1[1]); w.w = pk2(x1[2], x1[3]);
        *(u32x4*)((bf16_t*)(ws + WS_KCC) + (size_t)(e >> 9) * LDP_C + (which ? 512 : 0) + (e & 511)) = w; }
    for (int i = gt; i < 2 * 2048; i += NGT) { const int j = i / 2048, r = i % 2048; const float l0 = a.in[20][r], l1 = a.in[20][2048 + r];
        ((float*)(ws + WS_LB))[i] = j == 0 ? 0.f : 1.f / (1.f + __expf(l0 - l1)); }
    for (int i = gt; i < 2048 * 32; i += NGT) { const int t = i >> 5, f = i & 31; const float pos = f < 16 ? (float)(t >> 6) : (float)(t & 63);
        const float inv = exp2f(-(float)(f & 15) * (13.287712379549449f / 16.f)); const float ang = pos * inv;
        ((float*)(ws + WS_ROPEA))[2 * i] = __cosf(ang); ((float*)(ws + WS_ROPEA))[2 * i + 1] = __sinf(ang); }
    for (int i = gt; i < 2048 * 64; i += NGT) { const int t = i >> 6, f = i & 63; const float pos = f < 32 ? (float)(t >> 6) : (float)(t & 63);
        const float inv = exp2f(-(float)(f & 31) * (13.287712379549449f / 32.f)); const float ang = pos * inv;
        ((float*)(ws + WS_ROPEC))[2 * i] = __cosf(ang); ((float*)(ws + WS_ROPEC))[2 * i + 1] = __sinf(ang); }
    __syncthreads();
    {
        LAS float* SC = (LAS float*)lds;
        LAS float* RED = (LAS float*)(lds + 40960);
        for (int i = tid; i < 5 * 2048; i += NTHR) { const int b = i >> 11, k = i & 2047; const float x = b < 4 ? a.in[8][b * 2048 + k] : a.in[9][k]; SC[i] = silu_f(x); }
        __syncthreads();
        const int cq = tid & 7, ks = tid >> 3;
        for (int u = bid; u < 768; u += G) {
            const int L = u / 192, col0 = (u % 192) * 32;
            const float* W = ((L & 1) ? a.in[23] : a.in[10]) + (size_t)(L >> 1) * 2048 * 6144;
            const float* bias = ((L & 1) ? a.in[24] : a.in[11]) + (size_t)(L >> 1) * 6144;
            f32x4 acc[5];
#pragma unroll
            for (int b = 0; b < 5; ++b) acc[b] = (f32x4){0.f, 0.f, 0.f, 0.f};
#pragma unroll 8
            for (int kk = 0; kk < 32; ++kk) { const int k = 32 * ks + kk; const f32x4 w = *(const f32x4*)(W + (size_t)k * 6144 + col0 + 4 * cq);
#pragma unroll
                for (int b = 0; b < 5; ++b) acc[b] += SC[b * 2048 + k] * w; }
#pragma unroll
            for (int b = 0; b < 5; ++b) *(LAS f32x4*)(RED + (ks * 5 + b) * 32 + 4 * cq) = acc[b];
            __syncthreads();
            if (tid < 160) { const int b = tid >> 5, c = tid & 31; float s = 0.f;
                for (int q = 0; q < 64; ++q) s += RED[(q * 5 + b) * 32 + c];
                ((float*)(ws + WS_MOD))[(L * 5 + b) * 6144 + col0 + c] = s + bias[col0 + c]; }
            __syncthreads();
        }
    }
}

__device__ __forceinline__ void phase_modnorm(const Args& a, int L) {
    const int tid = otid(), lane = tid & 63, wave = tid >> 6;
    const int gw = obid() * NWAVES + wave, NGW = gridDim.x * NWAVES;
    const float* g = ((L & 1) ? a.in[25] : a.in[12]) + (L >> 1) * 2048;
    bf16_t* H = (bf16_t*)(a.ws + WS_H);
    for (int r = gw; r < MROWS; r += NGW) {
        const float* x = L == 0 ? (r < MC ? a.in[0] + (size_t)r * DM : a.in[1] + (size_t)(r - MC) * DM) : a.out + (size_t)r * DM;
        const int ci = r < MC ? 4 : ((r - MC) >> 11);
        const float* md = (const float*)(a.ws + WS_MOD) + (L * 5 + ci) * 6144;
        f32x4 v[8]; float ss = 0.f;
#pragma unroll
        for (int j = 0; j < 8; ++j) { v[j] = *(const f32x4*)(x + 256 * j + 4 * lane); ss += (v[j][0] * v[j][0] + v[j][1] * v[j][1]) + (v[j][2] * v[j][2] + v[j][3] * v[j][3]); }
        const float rstd = rsqrtf(wave_sum(ss) * (1.f / 2048.f) + EPSN);
#pragma unroll
        for (int j = 0; j < 8; ++j) { const int c = 256 * j + 4 * lane;
            const f32x4 gg = *(const f32x4*)(g + c), sh = *(const f32x4*)(md + c), sc = *(const f32x4*)(md + 2048 + c);
            const f32x4 y = (v[j] * rstd * gg) * (sc + 1.f) + sh;
            u32x2 w; w.x = pk2(y[0], y[1]); w.y = pk2(y[2], y[3]);
            *(u32x2*)(H + (size_t)r * DM + c) = w; }
    }
}

__device__ __forceinline__ void phase_prep_ab(const Args& a, int j) {
    const int tid = otid(), lane = tid & 63, wave = tid >> 6;
    const int gw = obid() * NWAVES + wave, NGW = gridDim.x * NWAVES;
    const bf16_t* P = (const bf16_t*)(a.ws + WS_PROJ);
    bf16_t* QN = (bf16_t*)(a.ws + WS_QN); bf16_t* CKV = (bf16_t*)(a.ws + WS_CKV);
    const float* gq = a.in[14] + j * 512; const float* gkv = a.in[15] + j * 256;
    for (int r = gw; r < MKROWS; r += NGW) {
        if (r < MROWS) {
            const bf16_t* p = P + (size_t)r * LDP_AB;
            const bf16x8 q = *(const bf16x8*)(p + COL_QL + 8 * lane);
            float qv[8]; float ss = 0.f;
#pragma unroll
            for (int e = 0; e < 8; ++e) { qv[e] = bf2f((unsigned short)q[e]); ss += qv[e] * qv[e]; }
            const float rq = rsqrtf(wave_sum(ss) * (1.f / 512.f) + EPSN);
#pragma unroll
            for (int e = 0; e < 8; ++e) qv[e] = qv[e] * rq * gq[8 * lane + e];
            *(bf16x8*)(QN + (size_t)r * 512 + 8 * lane) = pack8(qv);
            const s16x4 kv = *(const s16x4*)(p + COL_KVL + 4 * lane);
            float kf[4]; float s2 = 0.f;
#pragma unroll
            for (int e = 0; e < 4; ++e) { kf[e] = bf2f((unsigned short)kv[e]); s2 += kf[e] * kf[e]; }
            const float rk = rsqrtf(wave_sum(s2) * (1.f / 256.f) + EPSN);
#pragma unroll
            for (int e = 0; e < 4; ++e) kf[e] = kf[e] * rk * gkv[4 * lane + e];
            u32x2 w; w.x = pk2(kf[0], kf[1]); w.y = pk2(kf[2], kf[3]);
            *(u32x2*)(CKV + (size_t)r * 256 + 4 * lane) = w;
            if (r < MC) { const int b = r >> 8, t = r & 255; const size_t rowo = (size_t)((b * 2 + j) * 256 + t);
                *(f32x4*)(a.out + O_CKV + rowo * 256 + 4 * lane) = (f32x4){kf[0], kf[1], kf[2], kf[3]};
                a.out[O_KPE + rowo * 64 + lane] = bf2f(p[COL_KPE + lane]); }
        } else {
            const int rr = r - MROWS, b = rr >> 8, t = rr & 255;
            const f32x4 x = *(const f32x4*)(a.in[2] + (size_t)((b * 2 + j) * 256 + t) * 256 + 4 * lane);
            u32x2 w; w.x = pk2(x[0], x[1]); w.y = pk2(x[2], x[3]);
            *(u32x2*)(CKV + (size_t)r * 256 + 4 * lane) = w;
        }
    }
}

__device__ __forceinline__ void phase_hn_ab(const Args& a, int j) {
    const int tid = otid(), lane = tid & 63, wave = tid >> 6, sub = lane & 15, hq = lane >> 4;
    const int gw = obid() * NWAVES + wave, NGW = gridDim.x * NWAVES;
    bf16_t* Q = (bf16_t*)(a.ws + WS_QRAW); const bf16_t* KV = (const bf16_t*)(a.ws + WS_KVRAW); bf16_t* KF = (bf16_t*)(a.ws + WS_KF);
    const bf16_t* P = (const bf16_t*)(a.ws + WS_PROJ);
    const float* RA = (const float*)(a.ws + WS_ROPEA);
    const float* gq = a.in[18] + j * 192; const float* gk = a.in[19] + j * 192;
    const int NQ = MROWS * 2, NK = MKROWS * 2;
    for (int it = gw; it < NQ + NK; it += NGW) {
        const bool isq = it < NQ; const int w = isq ? it : it - NQ; const int r = w >> 1, h = (w & 1) * 4 + hq;
        float xn[8], x1[2], x2[2];
        if (isq) {
            const bf16_t* p = Q + (size_t)r * 1536 + h * 192;
            const bf16x8 v = *(const bf16x8*)(p + 8 * sub); const unsigned a1 = *(const unsigned*)(p + 128 + 2 * sub), a2 = *(const unsigned*)(p + 160 + 2 * sub);
#pragma unroll
            for (int e = 0; e < 8; ++e) xn[e] = bf2f((unsigned short)v[e]);
            x1[0] = bf2f(a1 & 0xffff); x1[1] = bf2f(a1 >> 16); x2[0] = bf2f(a2 & 0xffff); x2[1] = bf2f(a2 >> 16);
        } else {
            const bf16_t* p = KV + (size_t)r * 2048 + h * 256;
            const bf16x8 v = *(const bf16x8*)(p + 8 * sub);
#pragma unroll
            for (int e = 0; e < 8; ++e) xn[e] = bf2f((unsigned short)v[e]);
            if (r < MROWS) { const bf16_t* pe = P + (size_t)r * LDP_AB + COL_KPE; const unsigned a1 = *(const unsigned*)(pe + 2 * sub), a2 = *(const unsigned*)(pe + 32 + 2 * sub);
                x1[0] = bf2f(a1 & 0xffff); x1[1] = bf2f(a1 >> 16); x2[0] = bf2f(a2 & 0xffff); x2[1] = bf2f(a2 >> 16); }
            else { const int rr = r - MROWS, b = rr >> 8, t = rr & 255; const float* pe = a.in[3] + (size_t)((b * 2 + j) * 256 + t) * 64;
                x1[0] = pe[2 * sub]; x1[1] = pe[2 * sub + 1]; x2[0] = pe[32 + 2 * sub]; x2[1] = pe[32 + 2 * sub + 1]; }
        }
        float ss = x1[0] * x1[0] + x1[1] * x1[1] + x2[0] * x2[0] + x2[1] * x2[1];
#pragma unroll
        for (int e = 0; e < 8; ++e) ss += xn[e] * xn[e];
        const float rstd = rsqrtf(sum16(ss) * (1.f / 192.f) + EPSN);
        const float* g = isq ? gq : gk;
#pragma unroll
        for (int e = 0; e < 8; ++e) xn[e] = xn[e] * rstd * g[8 * sub + e];
        x1[0] *= rstd * g[128 + 2 * sub]; x1[1] *= rstd * g[128 + 2 * sub + 1]; x2[0] *= rstd * g[160 + 2 * sub]; x2[1] *= rstd * g[160 + 2 * sub + 1];
        if (r >= MC && r < MROWS) { const int t = (r - MC) & 2047;
#pragma unroll
            for (int u = 0; u < 2; ++u) { const float c = RA[(t * 32 + 2 * sub + u) * 2], s = RA[(t * 32 + 2 * sub + u) * 2 + 1];
                const float y1 = x1[u] * c - x2[u] * s, y2 = x1[u] * s + x2[u] * c; x1[u] = y1; x2[u] = y2; } }
        if (isq) {
#pragma unroll
            for (int e = 0; e < 8; ++e) xn[e] *= QSC_A;
            x1[0] *= QSC_A; x1[1] *= QSC_A; x2[0] *= QSC_A; x2[1] *= QSC_A;
            bf16_t* p = Q + (size_t)r * 1536 + h * 192;
            *(bf16x8*)(p + 8 * sub) = pack8(xn); *(unsigned*)(p + 128 + 2 * sub) = pk2(x1[0], x1[1]); *(unsigned*)(p + 160 + 2 * sub) = pk2(x2[0], x2[1]);
        } else {
            bf16_t* p = KF + (size_t)r * 1536 + h * 192;
            *(bf16x8*)(p + 8 * sub) = pack8(xn); *(unsigned*)(p + 128 + 2 * sub) = pk2(x1[0], x1[1]); *(unsigned*)(p + 160 + 2 * sub) = pk2(x2[0], x2[1]);
        }
    }
}

__device__ __forceinline__ void phase_fin_ab(const Args& a, int j) {
    const int tid = otid(), lane = tid & 63, wave = tid >> 6, sub = lane & 15, hq = lane >> 4;
    const int gw = obid() * NWAVES + wave, NGW = gridDim.x * NWAVES;
    const bf16_t* OF = (const bf16_t*)(a.ws + WS_OF); const bf16_t* OB = (const bf16_t*)(a.ws + WS_OB);
    const bf16_t* P = (const bf16_t*)(a.ws + WS_PROJ); bf16_t* MIX = (bf16_t*)(a.ws + WS_H);
    const float* g = a.in[21] + j * 128;
    for (int it = gw; it < MROWS * 2; it += NGW) {
        const int r = it >> 1, h = (it & 1) * 4 + hq; const size_t o = (size_t)r * 1024 + h * 128 + 8 * sub;
        const bf16x8 va = *(const bf16x8*)(OF + o), vb = *(const bf16x8*)(OB + o), vg = *(const bf16x8*)(P + (size_t)r * LDP_AB + COL_BG + h * 128 + 8 * sub);
        float s[8]; float ss = 0.f;
#pragma unroll
        for (int e = 0; e < 8; ++e) { s[e] = bf2f((unsigned short)va[e]) + bf2f((unsigned short)vb[e]); ss += s[e] * s[e]; }
        const float rstd = rsqrtf(sum16(ss) * (1.f / 128.f) + EPSN);
#pragma unroll
        for (int e = 0; e < 8; ++e) s[e] = s[e] * rstd * g[8 * sub + e] * silu_f(bf2f((unsigned short)vg[e]));
        *(bf16x8*)(MIX + (size_t)r * DM + 1024 + h * 128 + 8 * sub) = pack8(s);
    }
}

__device__ __forceinline__ void phase_hn_c(const Args& a, int j) {
    const int tid = otid(), lane = tid & 63, wave = tid >> 6, sub = lane & 15, hq = lane >> 4;
    const int gw = obid() * NWAVES + wave, NGW = gridDim.x * NWAVES;
    bf16_t* P = (bf16_t*)(a.ws + WS_PROJ);
    const float* RC = (const float*)(a.ws + WS_ROPEC);
    const float* gq = a.in[27] + j * 128; const float* gk = a.in[28] + j * 128;
    for (int it = gw; it < MROWS * 6; it += NGW) {
        const int r = it / 6, st = it % 6;
        if (st == 5) {
            if (r < MC) { const int b = r >> 8, t = r & 255; const bf16x8 v = *(const bf16x8*)(P + (size_t)r * LDP_C + 2560 + 8 * lane);
                float* o = a.out + O_VC + (size_t)((b * 2 + j) * 256 + t) * 512 + 8 * lane;
                *(f32x4*)o = (f32x4){bf2f((unsigned short)v[0]), bf2f((unsigned short)v[1]), bf2f((unsigned short)v[2]), bf2f((unsigned short)v[3])};
                *(f32x4*)(o + 4) = (f32x4){bf2f((unsigned short)v[4]), bf2f((unsigned short)v[5]), bf2f((unsigned short)v[6]), bf2f((unsigned short)v[7])}; }
            continue;
        }
        const int h = st * 4 + hq;
        const bool isq = h < 16;
        bf16_t* p = P + (size_t)r * LDP_C + (isq ? h * 128 : 2048 + (h - 16) * 128);
        const s16x4 v1 = *(const s16x4*)(p + 4 * sub), v2 = *(const s16x4*)(p + 64 + 4 * sub);
        float x1[4], x2[4]; float ss = 0.f;
#pragma unroll
        for (int e = 0; e < 4; ++e) { x1[e] = bf2f((unsigned short)v1[e]); x2[e] = bf2f((unsigned short)v2[e]); ss += x1[e] * x1[e] + x2[e] * x2[e]; }
        const float rstd = rsqrtf(sum16(ss) * (1.f / 128.f) + EPSN);
        const float* g = isq ? gq : gk;
#pragma unroll
        for (int e = 0; e < 4; ++e) { x1[e] *= rstd * g[4 * sub + e]; x2[e] *= rstd * g[64 + 4 * sub + e]; }
        if (r >= MC) { const int t = (r - MC) & 2047;
#pragma unroll
            for (int e = 0; e < 4; ++e) { const float c = RC[(t * 64 + 4 * sub + e) * 2], s = RC[(t * 64 + 4 * sub + e) * 2 + 1];
                const float y1 = x1[e] * c - x2[e] * s, y2 = x1[e] * s + x2[e] * c; x1[e] = y1; x2[e] = y2; } }
        else if (!isq) { const int b = r >> 8, t = r & 255; float* o = a.out + O_KC + (size_t)((b * 2 + j) * 256 + t) * 512 + (h - 16) * 128;
            *(f32x4*)(o + 4 * sub) = (f32x4){x1[0], x1[1], x1[2], x1[3]}; *(f32x4*)(o + 64 + 4 * sub) = (f32x4){x2[0], x2[1], x2[2], x2[3]}; }
        if (isq) {
#pragma unroll
            for (int e = 0; e < 4; ++e) { x1[e] *= QSC_C; x2[e] *= QSC_C; } }
        u32x2 w1, w2; w1.x = pk2(x1[0], x1[1]); w1.y = pk2(x1[2], x1[3]); w2.x = pk2(x2[0], x2[1]); w2.y = pk2(x2[2], x2[3]);
        *(u32x2*)(p + 4 * sub) = w1; *(u32x2*)(p + 64 + 4 * sub) = w2;
    }
}

namespace att {
__device__ __forceinline__ int crow(int r, int hi) { return (r & 3) + 8 * (r >> 2) + 4 * hi; }
__device__ __forceinline__ unsigned cvtpk(float lo, float hi) { unsigned r; asm volatile("v_cvt_pk_bf16_f32 %0, %1, %2" : "=v"(r) : "v"(lo), "v"(hi)); return r; }
__device__ __forceinline__ int v_st(int k, int c) { const int kk = (k & ~0xC) | ((k & 4) << 1) | ((k & 8) >> 1); return ((kk >> 3) * 4 + (c >> 5)) * 512 + ((kk & 7) * 32 + (c & 31)) * 2; }
__device__ __forceinline__ int v_rd_base(int lane) { return ((lane & 3) << 3) | (((lane >> 2) & 3) << 6) | (((lane >> 4) & 1) << 5) | (((lane >> 5) & 1) << 8); }
constexpr int v_rd_off(int d0, int ks, int half) { return d0 * 512 + ks * 4096 + half * 2048; }
template <int OFF> __device__ __forceinline__ s16x4 tr_read(int vb) {
    s16x4 r; asm volatile("ds_read_b64_tr_b16 %0, %1 offset:%2" : "=&v"(r) : "v"(vb), "i"(OFF) : "memory"); return r;
}
template <int D0> __device__ __forceinline__ void pv_one(f32x16& od, int vb, bf16x8 pa0, bf16x8 pa1, bf16x8 pa2, bf16x8 pa3) {
    const s16x4 l0 = tr_read<v_rd_off(D0, 0, 0)>(vb), h0 = tr_read<v_rd_off(D0, 0, 1)>(vb), l1 = tr_read<v_rd_off(D0, 1, 0)>(vb), h1 = tr_read<v_rd_off(D0, 1, 1)>(vb);
    const s16x4 l2 = tr_read<v_rd_off(D0, 2, 0)>(vb), h2 = tr_read<v_rd_off(D0, 2, 1)>(vb), l3 = tr_read<v_rd_off(D0, 3, 0)>(vb), h3 = tr_read<v_rd_off(D0, 3, 1)>(vb);
    asm volatile("s_waitcnt lgkmcnt(0)" ::: "memory"); __builtin_amdgcn_sched_barrier(0);
#define ATT_PK(L, H) (bf16x8){L[0], L[1], L[2], L[3], H[0], H[1], H[2], H[3]}
    od = __builtin_amdgcn_mfma_f32_32x32x16_bf16(pa0, ATT_PK(l0, h0), od, 0, 0, 0);
    od = __builtin_amdgcn_mfma_f32_32x32x16_bf16(pa1, ATT_PK(l1, h1), od, 0, 0, 0);
    od = __builtin_amdgcn_mfma_f32_32x32x16_bf16(pa2, ATT_PK(l2, h2), od, 0, 0, 0);
    od = __builtin_amdgcn_mfma_f32_32x32x16_bf16(pa3, ATT_PK(l3, h3), od, 0, 0, 0);
#undef ATT_PK
}
struct Item {
    const bf16_t* Q; int ldq;
    const bf16_t* K0; const bf16_t* V0; int n0;
    const bf16_t* K1; const bf16_t* V1; int ldk, ldv, t_lo, t_hi;
    int q0, band; float m0, l0;
    const bf16_t* G; int ldg; bf16_t* O; int ldo;
};
template <int DQK>
__device__ __forceinline__ void attn_item(LAS unsigned char* lds, const Item& it) {
    constexpr int KROW = DQK * 2, SHM_K = 64 * KROW, SHM_V = 64 * 128 * 2, ND = DQK / 16;
    const int tid = otid(), wid = tid >> 6, lane = tid & 63, r32 = lane & 31, hi = lane >> 5;
    LAS unsigned char* V_lds = lds; LAS unsigned char* K_lds = lds + 2 * SHM_V;
    LAS float* wsx = (LAS float*)(lds + 2 * SHM_V + 2 * SHM_K) + wid * 64; LAS float* li_l = wsx; LAS float* al_l = wsx + 32;
    float m_reg = it.m0, l_reg = it.l0;
    f32x16 o[4];
#pragma unroll
    for (int d = 0; d < 4; ++d)
#pragma unroll
        for (int r = 0; r < 16; ++r) o[d][r] = 0.f;
    bf16x8 qr[ND];
    { const bf16_t* Qw = it.Q + (size_t)(wid * 32 + r32) * it.ldq + hi * 8;
#pragma unroll
      for (int d0 = 0; d0 < ND; ++d0) qr[d0] = *(const bf16x8*)(Qw + d0 * 16); }
    const int NT = it.n0 + (it.t_hi - it.t_lo);
    const int wvu = __builtin_amdgcn_readfirstlane(wid);
    const int vb0 = (int)(uintptr_t)V_lds + v_rd_base(lane);
    constexpr int NKI = SHM_K / 8192;
    unsigned kog[NKI], vog[2];
#pragma unroll
    for (int i = 0; i < NKI; ++i) { const int off = i * 8192 + wid * 1024 + lane * 16, row = off / KROW, pos = off % KROW; kog[i] = (unsigned)(row * it.ldk + ((pos ^ ((row & 7) << 4)) >> 1)); }
#pragma unroll
    for (int i = 0; i < 2; ++i) { const int q = (i * 8192 + wid * 1024 + lane * 16) >> 4, sub = q >> 5, rem = q & 31, rowin = rem >> 2, cch = rem & 3;
        const int kk = (sub >> 2) * 8 + rowin; vog[i] = (unsigned)(((kk & ~0xC) | ((kk & 4) << 1) | ((kk & 8) >> 1)) * it.ldv + (sub & 3) * 32 + cch * 8); }
    int koff[4];
#pragma unroll
    for (int dl = 0; dl < 4; ++dl) koff[dl] = r32 * KROW + ((dl * 32 + hi * 16) ^ ((r32 & 7) << 4));
#define ATT_STAGE(jj, b) do { const int _j = (jj); const bool _s0 = _j < it.n0; const int _t = _s0 ? _j : it.t_lo + (_j - it.n0); \
        const bf16_t* _Kp = (_s0 ? it.K0 : it.K1) + (size_t)(64 * _t) * it.ldk; const bf16_t* _Vp = (_s0 ? it.V0 : it.V1) + (size_t)(64 * _t) * it.ldv; \
        _Pragma("unroll") for (int _i = 0; _i < NKI; ++_i) __builtin_amdgcn_global_load_lds((const unsigned*)(_Kp + kog[_i]), (LAS unsigned*)(K_lds + (b) * SHM_K + _i * 8192 + wvu * 1024), 16, 0, 0); \
        _Pragma("unroll") for (int _i = 0; _i < 2; ++_i) __builtin_amdgcn_global_load_lds((const unsigned*)(_Vp + vog[_i]), (LAS unsigned*)(V_lds + (b) * SHM_V + _i * 8192 + wvu * 1024), 16, 0, 0); } while (0)
    ATT_STAGE(0, 0); asm volatile("s_waitcnt vmcnt(0)" ::: "memory"); __syncthreads();
    for (int j = 0; j < NT; ++j) {
        const int cur = j & 1;
        if (j + 1 < NT) ATT_STAGE(j + 1, cur ^ 1);
        bool act = true; const bool domask = it.band && j >= it.n0; int kpos0 = 0;
        if (domask) { kpos0 = 64 * (it.t_lo + j - it.n0); const int qlo = it.q0 + wid * 32; act = (kpos0 + 63 >= qlo - 128) && (kpos0 <= qlo + 31 + 128); }
        if (act) {
            f32x16 p0, p1;
#pragma unroll
            for (int r = 0; r < 16; ++r) { p0[r] = 0.f; p1[r] = 0.f; }
            const LAS unsigned char* Ks = K_lds + cur * SHM_K;
#pragma unroll
            for (int d0 = 0; d0 < ND; ++d0) {
                const bf16x8 b0 = *(const LAS bf16x8*)(Ks + koff[d0 & 3] + (d0 >> 2) * 128);
                const bf16x8 b1 = *(const LAS bf16x8*)(Ks + koff[d0 & 3] + (d0 >> 2) * 128 + 32 * KROW);
                p0 = __builtin_amdgcn_mfma_f32_32x32x16_bf16(b0, qr[d0], p0, 0, 0, 0);
                p1 = __builtin_amdgcn_mfma_f32_32x32x16_bf16(b1, qr[d0], p1, 0, 0, 0);
                if ((d0 & 3) == 3) __builtin_amdgcn_sched_barrier(0); }
            if (domask) { const int qp = it.q0 + wid * 32 + r32;
#pragma unroll
                for (int r = 0; r < 16; ++r) { const int d = kpos0 + crow(r, hi) - qp;
                    if (d > 128 || d < -128) p0[r] = -1e30f;
                    if (d + 32 > 128 || d + 32 < -128) p1[r] = -1e30f; } }
            float pmax = p0[0];
#pragma unroll
            for (int r = 1; r < 16; ++r) pmax = fmaxf(pmax, p0[r]);
#pragma unroll
            for (int r = 0; r < 16; ++r) pmax = fmaxf(pmax, p1[r]);
            { auto rr = __builtin_amdgcn_permlane32_swap(__float_as_uint(pmax), __float_as_uint(pmax), false, false);
              pmax = fmaxf(__uint_as_float(rr[0]), __uint_as_float(rr[1])); }
            const float mn = fmaxf(m_reg, pmax); const float alpha = __builtin_amdgcn_exp2f(m_reg - mn); m_reg = mn;
            float ps = 0.f;
#pragma unroll
            for (int r = 0; r < 16; ++r) { p0[r] = __builtin_amdgcn_exp2f(p0[r] - mn); p1[r] = __builtin_amdgcn_exp2f(p1[r] - mn); ps += p0[r] + p1[r]; }
            { auto rr = __builtin_amdgcn_permlane32_swap(__float_as_uint(ps), __float_as_uint(ps), false, false);
              ps = __uint_as_float(rr[0]) + __uint_as_float(rr[1]); }
            l_reg = l_reg * alpha + ps;
            bf16x8 pa0, pa1, pa2, pa3;
#define ATT_PK4(P, BASE, OUT) do { unsigned a0 = cvtpk(P[BASE + 0], P[BASE + 1]), a1 = cvtpk(P[BASE + 2], P[BASE + 3]);   \
    unsigned b0 = cvtpk(P[BASE + 4], P[BASE + 5]), b1 = cvtpk(P[BASE + 6], P[BASE + 7]);                              \
    auto r0 = __builtin_amdgcn_permlane32_swap(a0, b0, false, false); auto r1 = __builtin_amdgcn_permlane32_swap(a1, b1, false, false); \
    u32x4 w = {r0[0], r1[0], r0[1], r1[1]}; OUT = __builtin_bit_cast(bf16x8, w); } while (0)
            ATT_PK4(p0, 0, pa0); ATT_PK4(p0, 8, pa1); ATT_PK4(p1, 0, pa2); ATT_PK4(p1, 8, pa3);
#undef ATT_PK4
            if (__any(alpha < 1.f)) { if (hi == 0) al_l[r32] = alpha; asm volatile("s_waitcnt lgkmcnt(0)" ::: "memory");
#pragma unroll
                for (int r = 0; r < 16; ++r) { const float al = al_l[crow(r, hi)];
#pragma unroll
                    for (int d = 0; d < 4; ++d) o[d][r] *= al; } }
            const int vb = vb0 + cur * SHM_V;
            pv_one<0>(o[0], vb, pa0, pa1, pa2, pa3); pv_one<1>(o[1], vb, pa0, pa1, pa2, pa3); pv_one<2>(o[2], vb, pa0, pa1, pa2, pa3); pv_one<3>(o[3], vb, pa0, pa1, pa2, pa3);
        }
        asm volatile("s_waitcnt vmcnt(0)" ::: "memory"); __syncthreads();
    }
#undef ATT_STAGE
    if (hi == 0) li_l[r32] = l_reg; asm volatile("s_waitcnt lgkmcnt(0)" ::: "memory");
#pragma unroll
    for (int r = 0; r < 16; ++r) { const int orow = wid * 32 + crow(r, hi); const float rli = 1.f / li_l[crow(r, hi)];
#pragma unroll
        for (int d0 = 0; d0 < 4; ++d0) { const int col = d0 * 32 + r32; const float g = bf2f(it.G[(size_t)orow * it.ldg + col]);
            it.O[(size_t)orow * it.ldo + col] = (bf16_t)f2bf(o[d0][r] * rli * silu_f(g)); }
        asm volatile("" ::: "memory"); }
    __syncthreads();
}
}

__device__ __forceinline__ void hgrn_item(LAS unsigned char* lds, const bf16_t* PROJ, int rowbase, int T, int h, int dir,
                                          const float* lb, const float* s0, float* sout, bf16_t* OUT) {
    LAS float* LF = (LAS float*)lds;
    LAS float* GS = (LAS float*)(lds + 16384);
    LAS float* DEC = (LAS float*)(lds + 16384 + 2048);
    LAS bf16_t* QT = (LAS bf16_t*)(lds + 18944);
    LAS bf16_t* KT = QT + 32 * 136;
    LAS bf16_t* KTt = KT + 32 * 136;
    LAS bf16_t* Vt = KTt + 128 * 40;
    const int tid = otid(), wid = tid >> 6, lane = tid & 63, fr = lane & 15, fq = lane >> 4;
    const int t1 = tid >> 4, c8 = (tid & 15) * 8, c2 = tid & 127, part = tid >> 7, n0 = wid * 16;
    f32x4 S[8];
#pragma unroll
    for (int kt = 0; kt < 8; ++kt) {
        if (s0) {
#pragma unroll
            for (int r = 0; r < 4; ++r) S[kt][r] = s0[(size_t)(16 * kt + 4 * fq + r) * 128 + n0 + fr]; }
        else S[kt] = (f32x4){0.f, 0.f, 0.f, 0.f}; }
    float oml[8];
#pragma unroll
    for (int e = 0; e < 8; ++e) oml[e] = 1.f - lb[c8 + e];
    const int nch = T / 32;
    const int colq = COL_BQ + h * 128 + c8, colf = (dir ? COL_FB : COL_FF) + h * 128 + c8, colv = COL_BI + h * 128 + c8;
    bf16x8 rq, rf, rv;
#define HG_LOAD(cc) do { const int _tok = dir ? T - 1 - (32 * (cc) + t1) : 32 * (cc) + t1; const bf16_t* _p = PROJ + (size_t)(rowbase + _tok) * LDP_AB; \
        rq = *(const bf16x8*)(_p + colq); rf = *(const bf16x8*)(_p + colf); rv = *(const bf16x8*)(_p + colv); } while (0)
    HG_LOAD(0);
    for (int c = 0; c < nch; ++c) {
        float sq[8], kk[8], lf[8]; const bf16x8 vv = rv;
#pragma unroll
        for (int e = 0; e < 8; ++e) { const float x = bf2f((unsigned short)rf[e]); const float omf = oml[e] / (1.f + __expf(x));
            lf[e] = fmaxf(log1pf(-omf), -30.f); kk[e] = omf; sq[e] = silu_f(bf2f((unsigned short)rq[e])); }
        *(LAS f32x4*)(LF + t1 * 128 + c8) = (f32x4){lf[0], lf[1], lf[2], lf[3]}; *(LAS f32x4*)(LF + t1 * 128 + c8 + 4) = (f32x4){lf[4], lf[5], lf[6], lf[7]};
        if (c + 1 < nch) HG_LOAD(c + 1);
        __syncthreads();
        float bl[8]; { float run = 0.f;
#pragma unroll
            for (int i = 0; i < 8; ++i) { run += LF[(8 * part + i) * 128 + c2]; bl[i] = run; }
            GS[part * 128 + c2] = run; }
        __syncthreads();
        { float off = 0.f;
#pragma unroll
            for (int p = 0; p < 3; ++p) if (p < part) off += GS[p * 128 + c2];
#pragma unroll
            for (int i = 0; i < 8; ++i) LF[(8 * part + i) * 128 + c2] = bl[i] + off;
            if (part == 3) DEC[c2] = __expf(bl[7] + off); }
        __syncthreads();
        { const f32x4 b0 = *(const LAS f32x4*)(LF + t1 * 128 + c8), b1 = *(const LAS f32x4*)(LF + t1 * 128 + c8 + 4);
            float qt[8], kt_[8];
#pragma unroll
            for (int e = 0; e < 8; ++e) { const float b = e < 4 ? b0[e & 3] : b1[e & 3]; qt[e] = sq[e] * __expf(b); kt_[e] = kk[e] * __expf(fminf(-b, 80.f)); }
            *(LAS bf16x8*)(QT + t1 * 136 + c8) = pack8(qt); *(LAS bf16x8*)(KT + t1 * 136 + c8) = pack8(kt_);
#pragma unroll
            for (int e = 0; e < 8; ++e) { KTt[(c8 + e) * 40 + t1] = (bf16_t)f2bf(kt_[e]); Vt[(c8 + e) * 40 + t1] = (bf16_t)vv[e]; } }
        __syncthreads();
        f32x4 pt00 = {0.f, 0.f, 0.f, 0.f}, pt01 = pt00, pt11 = pt00;
#pragma unroll
        for (int ks = 0; ks < 4; ++ks) {
            const bf16x8 a0 = *(const LAS bf16x8*)(KT + fr * 136 + 32 * ks + 8 * fq), a1 = *(const LAS bf16x8*)(KT + (16 + fr) * 136 + 32 * ks + 8 * fq);
            const bf16x8 b0 = *(const LAS bf16x8*)(QT + fr * 136 + 32 * ks + 8 * fq), b1 = *(const LAS bf16x8*)(QT + (16 + fr) * 136 + 32 * ks + 8 * fq);
            pt00 = __builtin_amdgcn_mfma_f32_16x16x32_bf16(a0, b0, pt00, 0, 0, 0);
            pt01 = __builtin_amdgcn_mfma_f32_16x16x32_bf16(a0, b1, pt01, 0, 0, 0);
            pt11 = __builtin_amdgcn_mfma_f32_16x16x32_bf16(a1, b1, pt11, 0, 0, 0); }
#pragma unroll
        for (int r = 0; r < 4; ++r) { if (4 * fq + r > fr) { pt00[r] = 0.f; pt11[r] = 0.f; } }
        u32x4 wA0, wA1;
        wA0.x = pk2(pt00[0], pt00[1]); wA0.y = pk2(pt00[2], pt00[3]); wA0.z = 0u; wA0.w = 0u;
        wA1.x = pk2(pt01[0], pt01[1]); wA1.y = pk2(pt01[2], pt01[3]); wA1.z = pk2(pt11[0], pt11[1]); wA1.w = pk2(pt11[2], pt11[3]);
        const u32x2 vlo = *(const LAS u32x2*)(Vt + (n0 + fr) * 40 + 4 * fq), vhi = *(const LAS u32x2*)(Vt + (n0 + fr) * 40 + 16 + 4 * fq);
        const u32x4 wV = {vlo.x, vlo.y, vhi.x, vhi.y};
        f32x4 o0 = {0.f, 0.f, 0.f, 0.f}, o1 = o0;
        o0 = __builtin_amdgcn_mfma_f32_16x16x32_bf16(__builtin_bit_cast(bf16x8, wA0), __builtin_bit_cast(bf16x8, wV), o0, 0, 0, 0);
        o1 = __builtin_amdgcn_mfma_f32_16x16x32_bf16(__builtin_bit_cast(bf16x8, wA1), __builtin_bit_cast(bf16x8, wV), o1, 0, 0, 0);
#pragma unroll
        for (int aa = 0; aa < 4; ++aa) {
            u32x4 wS; wS.x = pk2(S[2 * aa][0], S[2 * aa][1]); wS.y = pk2(S[2 * aa][2], S[2 * aa][3]); wS.z = pk2(S[2 * aa + 1][0], S[2 * aa + 1][1]); wS.w = pk2(S[2 * aa + 1][2], S[2 * aa + 1][3]);
            const u32x2 q0l = *(const LAS u32x2*)(QT + fr * 136 + 32 * aa + 4 * fq), q0h = *(const LAS u32x2*)(QT + fr * 136 + 32 * aa + 16 + 4 * fq);
            const u32x2 q1l = *(const LAS u32x2*)(QT + (16 + fr) * 136 + 32 * aa + 4 * fq), q1h = *(const LAS u32x2*)(QT + (16 + fr) * 136 + 32 * aa + 16 + 4 * fq);
            const u32x4 wQ0 = {q0l.x, q0l.y, q0h.x, q0h.y}, wQ1 = {q1l.x, q1l.y, q1h.x, q1h.y};
            o0 = __builtin_amdgcn_mfma_f32_16x16x32_bf16(__builtin_bit_cast(bf16x8, wQ0), __builtin_bit_cast(bf16x8, wS), o0, 0, 0, 0);
            o1 = __builtin_amdgcn_mfma_f32_16x16x32_bf16(__builtin_bit_cast(bf16x8, wQ1), __builtin_bit_cast(bf16x8, wS), o1, 0, 0, 0); }
        { const bf16x8 vn = *(const LAS bf16x8*)(Vt + (n0 + fr) * 40 + 8 * fq);
#pragma unroll
            for (int kt = 0; kt < 8; ++kt) { const bf16x8 ka = *(const LAS bf16x8*)(KTt + (16 * kt + fr) * 40 + 8 * fq);
                S[kt] = __builtin_amdgcn_mfma_f32_16x16x32_bf16(ka, vn, S[kt], 0, 0, 0);
                const f32x4 d = *(const LAS f32x4*)(DEC + 16 * kt + 4 * fq); S[kt] = S[kt] * d; } }
#pragma unroll
        for (int r = 0; r < 4; ++r) {
            const int i0 = 4 * fq + r, i1 = 16 + 4 * fq + r;
            const int tok0 = dir ? T - 1 - (32 * c + i0) : 32 * c + i0, tok1 = dir ? T - 1 - (32 * c + i1) : 32 * c + i1;
            OUT[(size_t)(rowbase + tok0) * 1024 + h * 128 + n0 + fr] = (bf16_t)f2bf(o0[r]);
            OUT[(size_t)(rowbase + tok1) * 1024 + h * 128 + n0 + fr] = (bf16_t)f2bf(o1[r]); }
    }
#undef HG_LOAD
    if (sout) {
#pragma unroll
        for (int kt = 0; kt < 8; ++kt)
#pragma unroll
            for (int r = 0; r < 4; ++r) sout[(size_t)(16 * kt + 4 * fq + r) * 128 + n0 + fr] = S[kt][r]; }
    __syncthreads();
}

__device__ __forceinline__ int fetch_item(unsigned* ctr, LAS int* slot) {
    __syncthreads();
    if (otid() == 0) *slot = (int)atomicAdd(ctr, 1u);
    __syncthreads();
    return *slot;
}

enum { K_P0 = 0, K_MODNORM, K_GEMM_IN, K_PREP_AB, K_GEMM_QUP, K_GEMM_KVUP, K_HN_AB, K_MIX_AB, K_FIN_AB, K_GEMM_OUT, K_HN_C, K_ATTN_C };

__global__ void __launch_bounds__(NTHR, 2) mk_fwd(Args a) {
    extern __shared__ __attribute__((aligned(16))) unsigned char lds_raw[];
    LAS unsigned char* lds = (LAS unsigned char*)lds_raw;
    LAS int* slot = (LAS int*)(lds + LDS_PHASE);
    cg::grid_group grid = cg::this_grid();
    unsigned char* ws = a.ws;
    unsigned* ctl = (unsigned*)(ws + WS_CTL);
    const int G = gridDim.x;

    for (int step = 0; step < 29; ++step) {
        asm volatile("" : "+s"(step));
        int kind, L = 0; bool sync_after = true;
        if (step == 0) kind = K_P0;
        else { const int s = step - 1, pair = s / 14, r = s % 14;
            if (r < 9) { L = 2 * pair; kind = r == 0 ? K_MODNORM : r == 1 ? K_GEMM_IN : r == 2 ? K_PREP_AB : r == 3 ? K_GEMM_QUP : r == 4 ? K_GEMM_KVUP : r == 5 ? K_HN_AB : r == 6 ? K_MIX_AB : r == 7 ? K_FIN_AB : K_GEMM_OUT; }
            else { L = 2 * pair + 1; const int q = r - 9; kind = q == 0 ? K_MODNORM : q == 1 ? K_GEMM_IN : q == 2 ? K_HN_C : q == 3 ? K_ATTN_C : K_GEMM_OUT; } }
        const int j = L >> 1; const bool isC = (L & 1) != 0;
        if (kind == K_GEMM_QUP) sync_after = false;
        if (step == 28) sync_after = false;

        if (kind == K_P0) phase_p0(a, lds);
        else if (kind == K_MODNORM) phase_modnorm(a, L);
        else if (kind == K_GEMM_IN || kind == K_GEMM_QUP || kind == K_GEMM_KVUP) {
            pg8::Gemm g; pg8::EpiStore E;
            if (kind == K_GEMM_IN) {
                if (!isC) { g = pg8::Gemm{(const bf16_t*)(ws + WS_H), (const bf16_t*)(ws + WS_WINAB) + (size_t)j * 7168 * 2048, MROWS, 7168, 2048}; E = pg8::EpiStore{(bf16_t*)(ws + WS_PROJ), LDP_AB}; }
                else { g = pg8::Gemm{(const bf16_t*)(ws + WS_H), (const bf16_t*)(ws + WS_WINC) + (size_t)j * 5120 * 2048, MROWS, 5120, 2048}; E = pg8::EpiStore{(bf16_t*)(ws + WS_PROJ), LDP_C}; }
            } else if (kind == K_GEMM_QUP) { g = pg8::Gemm{(const bf16_t*)(ws + WS_QN), (const bf16_t*)(ws + WS_WQUP) + (size_t)j * 1536 * 512, MROWS, 1536, 512}; E = pg8::EpiStore{(bf16_t*)(ws + WS_QRAW), 1536}; }
            else { g = pg8::Gemm{(const bf16_t*)(ws + WS_CKV), (const bf16_t*)(ws + WS_WKVUP) + (size_t)j * 2048 * 256, MKROWS, 2048, 256}; E = pg8::EpiStore{(bf16_t*)(ws + WS_KVRAW), 2048}; }
            pg8::StaticOrder S; S.init(g.M, g.N, G, obid());
            pg8::gemm_phase<pg8::EpiStore, pg8::StaticOrder, true, true>(lds, g, S, E);
        }
        else if (kind == K_GEMM_OUT) {
            pg8::Gemm g{(const bf16_t*)(ws + WS_H), (const bf16_t*)(ws + (isC ? WS_WOUTC : WS_WOUTAB)) + (size_t)j * 2048 * 2048, MROWS, 2048, 2048};
            pg8::EpiResid E{L == 0 ? a.in[0] : a.out, L == 0 ? a.in[1] : a.out + (size_t)MC * DM, a.out, (const float*)(ws + WS_MOD) + (size_t)L * 5 * 6144 + 4096};
            pg8::StaticOrder S; S.init(g.M, g.N, G, obid());
            pg8::gemm_phase<pg8::EpiResid, pg8::StaticOrder, true, true>(lds, g, S, E);
        }
        else if (kind == K_PREP_AB) phase_prep_ab(a, j);
        else if (kind == K_HN_AB) phase_hn_ab(a, j);
        else if (kind == K_FIN_AB) phase_fin_ab(a, j);
        else if (kind == K_HN_C) phase_hn_c(a, j);
        else if (kind == K_MIX_AB) {
            unsigned* ctr = ctl + 64 * step;
            const bf16_t* P = (const bf16_t*)(ws + WS_PROJ); bf16_t* MIX = (bf16_t*)(ws + WS_H);
            const bf16_t* QF = (const bf16_t*)(ws + WS_QRAW); const bf16_t* KF = (const bf16_t*)(ws + WS_KF); const bf16_t* KV = (const bf16_t*)(ws + WS_KVRAW);
            for (;;) {
                const int idx = fetch_item(ctr, slot);
                if (idx >= 704) break;
                if (idx < 64 || (idx >= 320 && idx < 576)) {
                    const bool lat = idx < 64; const int i = lat ? idx : idx - 320; const int b = i >> 4, h = (i >> 1) & 7, dir = i & 1;
                    const float* lb = (const float*)(ws + WS_LB) + (j * 2 + dir) * 1024 + h * 128;
                    const float* s0 = lat ? a.in[4 + dir] + (size_t)((b * 2 + j) * 8 + h) * 16384 : nullptr;
                    float* so = lat ? nullptr : a.out + (dir ? O_SB : O_SF) + (size_t)((b * 2 + j) * 8 + h) * 16384;
                    hgrn_item(lds, P, lat ? MC + b * 2048 : b * 256, lat ? 2048 : 256, h, dir, lb, s0, so, (bf16_t*)(ws + (dir ? WS_OB : WS_OF)));
                } else {
                    att::Item it;
                    const bool lat = idx < 320; int b, h, r0;
                    if (lat) { const int i = idx - 64; b = i >> 6; h = (i >> 3) & 7; const int qb = i & 7; r0 = MC + b * 2048 + qb * 256;
                        it.K0 = KF + (size_t)(MROWS + b * 256) * 1536 + h * 192; it.V0 = KV + (size_t)(MROWS + b * 256) * 2048 + h * 256 + 128; it.n0 = 4;
                        it.K1 = KF + (size_t)(MC + b * 2048) * 1536 + h * 192; it.V1 = KV + (size_t)(MC + b * 2048) * 2048 + h * 256 + 128; it.t_lo = 0; it.t_hi = 32; }
                    else { const int i = idx - 576; b = i >> 3; h = i & 7; r0 = b * 256;
                        it.K0 = KF; it.V0 = KV; it.n0 = 0;
                        it.K1 = KF + (size_t)r0 * 1536 + h * 192; it.V1 = KV + (size_t)r0 * 2048 + h * 256 + 128; it.t_lo = 0; it.t_hi = 4; }
                    it.ldk = 1536; it.ldv = 2048;
                    it.Q = QF + (size_t)r0 * 1536 + h * 192; it.ldq = 1536; it.q0 = 0; it.band = 0; it.m0 = -1e30f; it.l0 = 0.f;
                    it.G = P + (size_t)r0 * LDP_AB + COL_AG + h * 128; it.ldg = LDP_AB; it.O = MIX + (size_t)r0 * DM + h * 128; it.ldo = DM;
                    att::attn_item<192>(lds, it);
                }
            }
        }
        else if (kind == K_ATTN_C) {
            unsigned* ctr = ctl + 64 * step;
            const bf16_t* P = (const bf16_t*)(ws + WS_PROJ); bf16_t* MIX = (bf16_t*)(ws + WS_H);
            const bf16_t* KCC = (const bf16_t*)(ws + WS_KCC);
            for (;;) {
                const int idx = fetch_item(ctr, slot);
                if (idx >= 768) break;
                att::Item it; int b, h, r0;
                if (idx < 512) { b = idx >> 7; h = (idx >> 3) & 15; const int qb = idx & 7; r0 = MC + b * 2048 + qb * 256; const int kvh = h >> 2;
                    it.K0 = KCC + (size_t)((b * 2 + j) * 256) * LDP_C + kvh * 128; it.V0 = KCC + (size_t)((b * 2 + j) * 256) * LDP_C + 512 + kvh * 128; it.n0 = 4;
                    it.K1 = P + (size_t)(MC + b * 2048) * LDP_C + 2048 + kvh * 128; it.V1 = P + (size_t)(MC + b * 2048) * LDP_C + 2560 + kvh * 128;
                    it.t_lo = 4 * qb - 2 < 0 ? 0 : 4 * qb - 2; it.t_hi = 4 * qb + 6 > 32 ? 32 : 4 * qb + 6; it.q0 = qb * 256; it.band = 1; }
                else { const int i = idx - 512; b = i >> 4; h = i & 15; r0 = b * 256; const int kvh = h >> 2;
                    it.K0 = KCC; it.V0 = KCC; it.n0 = 0;
                    it.K1 = P + (size_t)r0 * LDP_C + 2048 + kvh * 128; it.V1 = P + (size_t)r0 * LDP_C + 2560 + kvh * 128; it.t_lo = 0; it.t_hi = 4; it.q0 = 0; it.band = 0; }
                it.ldk = LDP_C; it.ldv = LDP_C;
                it.Q = P + (size_t)r0 * LDP_C + h * 128; it.ldq = LDP_C; it.m0 = a.in[29][j * 16 + h] * LOG2E; it.l0 = 1.f;
                it.G = P + (size_t)r0 * LDP_C + 3072 + h * 128; it.ldg = LDP_C; it.O = MIX + (size_t)r0 * DM + h * 128; it.ldo = DM;
                att::attn_item<128>(lds, it);
            }
        }
        if (sync_after) grid.sync();
    }
}

extern "C" void kernel_launch(void* const* d_in, const int* in_sizes, int n_in, void* d_out, int out_size, void* d_ws, size_t ws_size, hipStream_t stream) {
    static int grid = 0;
    if (grid == 0) {
        if (n_in != 31 || ws_size < WS_END) { fprintf(stderr, "kernel_launch: unexpected n_in %d or ws_size %zu (< %zu)\n", n_in, ws_size, (size_t)WS_END); grid = -1; return; }
        int dev = 0, cus = 0, per_cu = 0;
        hipGetDevice(&dev); hipDeviceGetAttribute(&cus, hipDeviceAttributeMultiprocessorCount, dev);
        if (hipFuncSetAttribute((const void*)mk_fwd, hipFuncAttributeMaxDynamicSharedMemorySize, LDS_BYTES) != hipSuccess) { fprintf(stderr, "kernel_launch: hipFuncSetAttribute failed\n"); grid = -1; return; }
        if (hipOccupancyMaxActiveBlocksPerMultiprocessor(&per_cu, (const void*)mk_fwd, NTHR, LDS_BYTES) != hipSuccess || per_cu < 1) per_cu = 1;
        (void)hipGetLastError();
        grid = cus > 0 ? cus : 256;
    }
    if (grid < 0) return;
    hipMemsetAsync((char*)d_ws + WS_CTL, 0, CTL_BYTES, stream);
    Args a{};
    for (int i = 0; i < 31; ++i) a.in[i] = (const float*)d_in[i];
    a.out = (float*)d_out; a.ws = (unsigned char*)d_ws;
    void* args[] = {&a};
    hipError_t e = hipLaunchCooperativeKernel((const void*)mk_fwd, dim3(grid), dim3(NTHR), args, LDS_BYTES, stream);
    if (e != hipSuccess) fprintf(stderr, "cooperative launch failed: %s (grid %d)\n", hipGetErrorString(e), grid);
}
```

```cpp
#include <hip/hip_runtime.h>
#include <hip/hip_cooperative_groups.h>
#include <cstdio>
#include <cstdint>
namespace cg = cooperative_groups;

namespace pg8 {
#define PG8_LAS __attribute__((address_space(3)))
typedef unsigned short bf16_t;
typedef short bf16x8 __attribute__((ext_vector_type(8)));
typedef float f32x4 __attribute__((ext_vector_type(4)));
typedef unsigned u32x4 __attribute__((ext_vector_type(4)));
constexpr int BM = 256, BK = 64, HALF = 128, HTB = HALF * BK * 2  , STAGE_BYTES = 8 * HTB, NXCD = 8, WGM = 8;
__device__ __forceinline__ int pg8_otid() { int t = threadIdx.x; asm volatile("" : "+v"(t)); return t; }

__host__ __device__ __forceinline__ int lds_byte(int r, int c) { const int st = (r >> 4) * 2 + (c >> 5), rr = r & 15, cc = c & 31, ob = rr * 64 + cc * 2; return st * 1024 + (ob ^ (((ob >> 9) & 1) << 5)); }
__host__ __device__ __forceinline__ void stage_rc(int b, int& R, int& C) { const int st = b / 1024, sb = b % 1024, swz = sb ^ (((sb >> 9) & 1) << 5); R = (st >> 1) * 16 + swz / 64; C = (st & 1) * 32 + (swz % 64) / 2; }
__host__ __device__ __forceinline__ int perm32(int rho) { const int n = rho >> 4, i = rho & 15; return 8 * (i >> 2) + 4 * n + (i & 3); }

struct Unit { int pm, pn; };
struct Gemm { const bf16_t* A; const bf16_t* Bt; int M, N, K; };

struct StaticOrder {
    int nM, nN, nwg, G, c;
    __host__ __device__ void init(int M, int N, int G_, int c_) { nM = M / BM; nN = N / BM; nwg = nM * nN; G = G_; c = c_; }
    __host__ __device__ bool next(int i, Unit& u) const {
        const long L = (long)i * G + c; if (L >= nwg) return false;
        int wgid = (int)L; { const int q = nwg / NXCD, r = nwg % NXCD, xcd = wgid % NXCD, off = wgid / NXCD; wgid = (xcd < r ? xcd * (q + 1) : r * (q + 1) + (xcd - r) * q) + off; }
        const int nig = WGM * nN, gid = wgid / nig, fm = gid * WGM, gsz = (nM - fm) < WGM ? (nM - fm) : WGM;
        u.pm = fm + ((wgid % nig) % gsz); u.pn = (wgid % nig) / gsz; return true;
    }
    __device__ __forceinline__ void a_ready(const Unit&) const {}
    __device__ __forceinline__ void done(const Unit&) const {}
};

__device__ __forceinline__ unsigned cvt_pk_bf16(float lo, float hi) { unsigned r; asm volatile("v_cvt_pk_bf16_f32 %0, %1, %2" : "=v"(r) : "v"(lo), "v"(hi)); return r; }

struct EpiStore {
    static constexpr bool PERM = true, AFTER_DRAIN = false;
    bf16_t* O; int ldc;
    __device__ __forceinline__ void operator()(const f32x4 (&acc)[2][2][4][2], const Unit& u, int wr, int wc, int fr, int fq) const {
        const int row0 = u.pm * BM + wr * 64 + fr; const int col0 = u.pn * BM + wc * 32 + 8 * fq;
#pragma unroll
        for (int ai = 0; ai < 2; ++ai)
#pragma unroll
            for (int m = 0; m < 4; ++m) { bf16_t* rowp = O + (size_t)(row0 + ai * HALF + m * 16) * ldc + col0;
#pragma unroll
                for (int bj = 0; bj < 2; ++bj) { const f32x4 v0 = acc[ai][bj][m][0], v1 = acc[ai][bj][m][1];
                    u32x4 w; w.x = cvt_pk_bf16(v0[0], v0[1]); w.y = cvt_pk_bf16(v0[2], v0[3]); w.z = cvt_pk_bf16(v1[0], v1[1]); w.w = cvt_pk_bf16(v1[2], v1[3]);
                    *(u32x4*)(rowp + bj * HALF) = w; } }
    }
};
struct EpiResid {
    static constexpr bool PERM = true, AFTER_DRAIN = false;
    const float* xin_ctx; const float* xin_lat; float* out; const float* gate_base;
    __device__ __forceinline__ void operator()(const f32x4 (&acc)[2][2][4][2], const Unit& u, int wr, int wc, int fr, int fq) const {
        const int pm = u.pm;
        const float* xin = pm < 16 ? xin_ctx + (size_t)pm * 256 * 2048 : xin_lat + (size_t)(pm - 16) * 256 * 2048;
        float* xo = out + (size_t)pm * 256 * 2048;
        const int ci = pm < 16 ? 4 : ((pm - 16) >> 3);
        const float* gt = gate_base + ci * 6144;
        const int rl0 = wr * 64 + fr, col0 = u.pn * BM + wc * 32 + 8 * fq;
        f32x4 g0[2], g1[2];
#pragma unroll
        for (int bj = 0; bj < 2; ++bj) { g0[bj] = *(const f32x4*)(gt + col0 + bj * HALF); g1[bj] = *(const f32x4*)(gt + col0 + bj * HALF + 4); }
#pragma unroll
        for (int ai = 0; ai < 2; ++ai)
#pragma unroll
            for (int m = 0; m < 4; ++m) { const size_t off = (size_t)(rl0 + ai * HALF + m * 16) * 2048 + col0;
#pragma unroll
                for (int bj = 0; bj < 2; ++bj) {
                    const f32x4 x0 = *(const f32x4*)(xin + off + bj * HALF), x1 = *(const f32x4*)(xin + off + bj * HALF + 4);
                    *(f32x4*)(xo + off + bj * HALF) = x0 + g0[bj] * acc[ai][bj][m][0];
                    *(f32x4*)(xo + off + bj * HALF + 4) = x1 + g1[bj] * acc[ai][bj][m][1]; }
                asm volatile("" ::: "memory"); }
    }
};

template <class Epi, class Sched, bool ALIGN_EPI = false, bool SP2 = false>
__device__ __forceinline__ void gemm_phase(PG8_LAS unsigned char* lds, const Gemm g, const Sched& S, const Epi& E) {
    const int tid = pg8_otid(), wid = __builtin_amdgcn_readfirstlane(tid >> 6), lane = tid & 63, wr = wid >> 2, wc = wid & 3, fr = lane & 15, fq = lane >> 4;
    const int K = g.K, nt = K / BK;
    unsigned voffA[2], voffB[2];
#pragma unroll
    for (int i = 0; i < 2; ++i) { int R, C; stage_rc(tid * 16 + i * 8192, R, C); const int Rb = Epi::PERM ? ((R & ~31) + perm32(R & 31)) : R;
        voffA[i] = (unsigned)(R * K + C) * 2u; voffB[i] = (unsigned)(Rb * K + C) * 2u; }
    const size_t kstep = (size_t)(BK * 2);
    const size_t hstep = (size_t)HALF * K * 2;
    const size_t tstep = 2 * hstep;
    const unsigned ldsw = (unsigned)wid * 1024u;
    const int aoff = lds_byte(wr * 64 + fr, fq * 8), boff = lds_byte(wc * 32 + fr, fq * 8);
#define PG8_SA(b, h) (((b) * 2 + (h)) * HTB)
#define PG8_SB(b, h) ((4 + (b) * 2 + (h)) * HTB)
#define PG8_STAGE(bufoff, gbase, voff) do { _Pragma("unroll") for (int _i = 0; _i < 2; ++_i) \
        __builtin_amdgcn_global_load_lds((const unsigned*)((const char*)(gbase) + (voff)[_i]), (PG8_LAS unsigned*)(lds + (bufoff) + ldsw + _i * 8192), 16, 0, 0); } while (0)
#define PG8_LDA(dst, b, h) do { _Pragma("unroll") for (int m = 0; m < 4; ++m) _Pragma("unroll") for (int k = 0; k < 2; ++k) dst[m][k] = *(const PG8_LAS bf16x8*)(lds + PG8_SA(b, h) + aoff + m * 2048 + k * 1024); } while (0)
#define PG8_LDB(dst, b, h) do { _Pragma("unroll") for (int n = 0; n < 2; ++n) _Pragma("unroll") for (int k = 0; k < 2; ++k) dst[n][k] = *(const PG8_LAS bf16x8*)(lds + PG8_SB(b, h) + boff + n * 2048 + k * 1024); } while (0)
#define PG8_MMA(ai, bj, At, Bt) do { __builtin_amdgcn_s_setprio(1); _Pragma("unroll") for (int m = 0; m < 4; ++m) _Pragma("unroll") for (int n = 0; n < 2; ++n) _Pragma("unroll") for (int k = 0; k < 2; ++k) \
        acc[ai][bj][m][n] = __builtin_amdgcn_mfma_f32_16x16x32_bf16(Bt[n][k], At[m][k], acc[ai][bj][m][n], 0, 0, 0); __builtin_amdgcn_s_setprio(0); } while (0)
#define PG8_WAIT_V(n) asm volatile("s_waitcnt vmcnt(" #n ")" ::: "memory")
#define PG8_WAIT_L(n) asm volatile("s_waitcnt lgkmcnt(" #n ")" ::: "memory")
#define PG8_BAR __builtin_amdgcn_s_barrier()
#define PG8_SCHED __builtin_amdgcn_sched_barrier(0)
    Unit cur, nxt; int ui = 0;
    if (!S.next(0, cur)) return;
    f32x4 acc[2][2][4][2];
#pragma unroll
    for (int a = 0; a < 2; ++a)
#pragma unroll
        for (int b = 0; b < 2; ++b)
#pragma unroll
            for (int m = 0; m < 4; ++m)
#pragma unroll
                for (int n = 0; n < 2; ++n) acc[a][b][m][n] = (f32x4){0.f, 0.f, 0.f, 0.f};
    bf16x8 At[4][2], B0[2][2], B1[2][2];
    const char* cA = (const char*)g.A + (size_t)cur.pm * tstep; const char* cB = (const char*)g.Bt + (size_t)cur.pn * tstep;
    S.a_ready(cur);
    if constexpr (SP2) {
        PG8_STAGE(PG8_SB(0, 0), cB, voffB); PG8_STAGE(PG8_SB(0, 1), cB + hstep, voffB); PG8_STAGE(PG8_SA(0, 0), cA, voffA); PG8_STAGE(PG8_SA(0, 1), cA + hstep, voffA);
        if (wr == 1) PG8_BAR;
        PG8_WAIT_V(2); PG8_BAR;
        PG8_STAGE(PG8_SB(1, 0), cB + kstep, voffB); PG8_STAGE(PG8_SA(1, 0), cA + kstep, voffA); PG8_STAGE(PG8_SB(1, 1), cB + hstep + kstep, voffB);
        PG8_WAIT_V(6); PG8_BAR;
    } else {
        PG8_STAGE(PG8_SB(0, 0), cB, voffB); PG8_STAGE(PG8_SA(0, 0), cA, voffA); PG8_STAGE(PG8_SB(0, 1), cB + hstep, voffB); PG8_STAGE(PG8_SA(0, 1), cA + hstep, voffA);
        if (wr == 1) PG8_BAR;
        PG8_WAIT_V(4); PG8_BAR;
        PG8_STAGE(PG8_SB(1, 0), cB + kstep, voffB); PG8_STAGE(PG8_SA(1, 0), cA + kstep, voffA); PG8_STAGE(PG8_SB(1, 1), cB + hstep + kstep, voffB);
        PG8_WAIT_V(6); PG8_BAR;
    }
    for (;;) {
        const bool has_next = S.next(ui + 1, nxt);
        const char* nA = has_next ? (const char*)g.A + (size_t)nxt.pm * tstep : cA; const char* nB = has_next ? (const char*)g.Bt + (size_t)nxt.pn * tstep : cB;
        for (int t = 0; t < nt; t += 2) {
            const bool last = (t == nt - 2);
            const char* a1 = cA + (size_t)(t + 1) * kstep;
            const char* a2 = last ? nA : cA + (size_t)(t + 2) * kstep; const char* b2 = last ? nB : cB + (size_t)(t + 2) * kstep;
            const char* a3 = a2 + kstep; const char* b3 = b2 + kstep;
            if (last && has_next) S.a_ready(nxt);
            if constexpr (SP2) {
            PG8_LDB(B0, 0, 0); PG8_LDB(B1, 0, 1); PG8_SCHED; PG8_LDA(At, 0, 0); PG8_STAGE(PG8_SA(1, 1), a1 + hstep, voffA);
            PG8_WAIT_V(8); PG8_WAIT_L(0); PG8_BAR; PG8_MMA(0, 0, At, B0); PG8_MMA(0, 1, At, B1); PG8_BAR; PG8_SCHED;
            PG8_LDA(At, 0, 1); PG8_STAGE(PG8_SB(0, 0), b2, voffB); PG8_STAGE(PG8_SB(0, 1), b2 + hstep, voffB); PG8_STAGE(PG8_SA(0, 0), a2, voffA);
            PG8_WAIT_V(8); PG8_WAIT_L(0); PG8_BAR; PG8_MMA(1, 0, At, B0); PG8_MMA(1, 1, At, B1); PG8_BAR; PG8_SCHED;
            PG8_LDB(B0, 1, 0); PG8_LDB(B1, 1, 1); PG8_SCHED; PG8_LDA(At, 1, 0); PG8_STAGE(PG8_SA(0, 1), a2 + hstep, voffA);
            PG8_WAIT_V(8); PG8_WAIT_L(0); PG8_BAR; PG8_MMA(0, 0, At, B0); PG8_MMA(0, 1, At, B1); PG8_BAR; PG8_SCHED;
            PG8_LDA(At, 1, 1); PG8_STAGE(PG8_SB(1, 0), b3, voffB); PG8_STAGE(PG8_SB(1, 1), b3 + hstep, voffB); PG8_STAGE(PG8_SA(1, 0), a3, voffA);
            PG8_WAIT_V(8); PG8_WAIT_L(0); PG8_BAR; PG8_MMA(1, 0, At, B0); PG8_MMA(1, 1, At, B1); PG8_BAR; PG8_SCHED;
            } else {
            PG8_LDB(B0, 0, 0); PG8_SCHED; PG8_LDA(At, 0, 0); PG8_STAGE(PG8_SA(1, 1), a1 + hstep, voffA);
            PG8_WAIT_L(8); PG8_BAR; PG8_WAIT_L(0); PG8_MMA(0, 0, At, B0); PG8_BAR; PG8_SCHED;
            PG8_LDB(B1, 0, 1); PG8_STAGE(PG8_SB(0, 0), b2, voffB);
            PG8_BAR; PG8_WAIT_L(0); PG8_MMA(0, 1, At, B1); PG8_BAR;
            PG8_LDA(At, 0, 1); PG8_STAGE(PG8_SA(0, 0), a2, voffA);
            PG8_BAR; PG8_WAIT_L(0); PG8_MMA(1, 0, At, B0); PG8_BAR; PG8_SCHED;
            PG8_STAGE(PG8_SB(0, 1), b2 + hstep, voffB);
            PG8_WAIT_V(6); PG8_BAR; PG8_MMA(1, 1, At, B1); PG8_BAR;
            PG8_LDB(B0, 1, 0); PG8_SCHED; PG8_LDA(At, 1, 0); PG8_STAGE(PG8_SA(0, 1), a2 + hstep, voffA);
            PG8_WAIT_L(8); PG8_BAR; PG8_WAIT_L(0); PG8_MMA(0, 0, At, B0); PG8_BAR; PG8_SCHED;
            PG8_LDB(B1, 1, 1); PG8_STAGE(PG8_SB(1, 0), b3, voffB);
            PG8_BAR; PG8_WAIT_L(0); PG8_MMA(0, 1, At, B1); PG8_BAR;
            PG8_LDA(At, 1, 1); PG8_STAGE(PG8_SA(1, 0), a3, voffA);
            PG8_BAR; PG8_WAIT_L(0); PG8_MMA(1, 0, At, B0); PG8_BAR; PG8_SCHED;
            PG8_STAGE(PG8_SB(1, 1), b3 + hstep, voffB);
            PG8_WAIT_V(6); PG8_BAR; PG8_MMA(1, 1, At, B1); PG8_BAR;
            }
        }
        if constexpr (ALIGN_EPI) { if (wr == 0) PG8_BAR; }
        if constexpr (!Epi::AFTER_DRAIN) { E(acc, cur, wr, wc, fr, fq); S.done(cur); }
        if (!has_next) break;
#pragma unroll
        for (int a = 0; a < 2; ++a)
#pragma unroll
            for (int b = 0; b < 2; ++b)
#pragma unroll
                for (int m = 0; m < 4; ++m)
#pragma unroll
                    for (int n = 0; n < 2; ++n) acc[a][b][m][n] = (f32x4){0.f, 0.f, 0.f, 0.f};
        cur = nxt; cA = nA; cB = nB; ++ui;
        if constexpr (ALIGN_EPI) { if (wr == 1) PG8_BAR; }
    }
    PG8_WAIT_V(0);
    if constexpr (!ALIGN_EPI) { if (wr == 0) PG8_BAR; }
    PG8_BAR;
    if constexpr (Epi::AFTER_DRAIN) { E.fused(acc, cur, wr, wc, fr, fq, lds, wid, lane); S.done(cur); }
#undef PG8_SA
#undef PG8_SB
#undef PG8_STAGE
#undef PG8_LDA
#undef PG8_LDB
#undef PG8_MMA
#undef PG8_WAIT_V
#undef PG8_WAIT_L
#undef PG8_BAR
#undef PG8_SCHED
}
}

#define LAS __attribute__((address_space(3)))
typedef unsigned short bf16_t;
typedef short bf16x8 __attribute__((ext_vector_type(8)));
typedef short s16x4 __attribute__((ext_vector_type(4)));
typedef float f32x4 __attribute__((ext_vector_type(4)));
typedef float f32x16 __attribute__((ext_vector_type(16)));
typedef unsigned u32x4 __attribute__((ext_vector_type(4)));
typedef unsigned u32x2 __attribute__((ext_vector_type(2)));


__device__ __forceinline__ int otid() { int t = threadIdx.x; asm volatile("" : "+v"(t)); return t; }
__device__ __forceinline__ int obid() { int b = blockIdx.x; asm volatile("" : "+s"(b)); return b; }
constexpr int NWAVES = 8, NTHR = 512;
constexpr int DM = 2048, MC = 4096, ML = 8192, MROWS = 12288, MKROWS = 13312;
constexpr int LDP_AB = 7168, LDP_C = 5120;
constexpr int COL_QL = 0, COL_KVL = 512, COL_AG = 768, COL_BQ = 1792, COL_FF = 2816, COL_FB = 3840, COL_BI = 4864, COL_BG = 5888, COL_KPE = 6912;
constexpr float EPSN = 1e-6f;
constexpr float LOG2E = 1.4426950408889634f;
constexpr float QSC_A = 0.07216878364870322f * LOG2E;
constexpr float QSC_C = 0.08838834764831845f * LOG2E;

constexpr size_t O_YP = 0, O_YS = 8388608, O_CKV = 25165824, O_KPE = 27262976, O_SF = 27787264, O_SB = 31981568, O_KC = 36175872, O_VC = 40370176;

constexpr size_t MiB = 1u << 20;
constexpr size_t WS_CTL = 0, CTL_BYTES = 65536;
constexpr size_t WS_MOD = 1 * MiB, WS_LB = WS_MOD + 512 * 1024, WS_ROPEA = WS_LB + 64 * 1024, WS_ROPEC = WS_ROPEA + 512 * 1024;
constexpr size_t WS_KCC = 532 * MiB;
constexpr size_t WS_WINAB = 8 * MiB, WS_WQUP = 64 * MiB, WS_WKVUP = 67 * MiB, WS_WOUTAB = 69 * MiB, WS_WINC = 85 * MiB, WS_WOUTC = 125 * MiB;
constexpr size_t WS_H = 141 * MiB, WS_PROJ = 189 * MiB, WS_QRAW = 357 * MiB, WS_KVRAW = 393 * MiB, WS_KF = 445 * MiB, WS_OF = 484 * MiB, WS_OB = 508 * MiB;
constexpr size_t WS_QN = WS_OF, WS_CKV = WS_OF + 12 * MiB, WS_END = 552 * MiB;

constexpr int LDS_PHASE = 131072, LDS_BYTES = LDS_PHASE + 1024;

__device__ __forceinline__ float bf2f(unsigned short b) { return __uint_as_float((unsigned)b << 16); }
__device__ __forceinline__ unsigned f2bf(float f) { unsigned u = __float_as_uint(f); return (u + 0x7fffu + ((u >> 16) & 1u)) >> 16; }
__device__ __forceinline__ unsigned pk2(float lo, float hi) { return f2bf(lo) | (f2bf(hi) << 16); }
__device__ __forceinline__ float silu_f(float x) { return x * __builtin_amdgcn_rcpf(1.f + __expf(-x)); }
__device__ __forceinline__ float wave_sum(float v) {
#pragma unroll
    for (int o = 1; o < 64; o <<= 1) v += __shfl_xor(v, o);
    return v;
}
__device__ __forceinline__ float sum16(float v) {
    v += __shfl_xor(v, 1); v += __shfl_xor(v, 2); v += __shfl_xor(v, 4); v += __shfl_xor(v, 8); return v;
}
__device__ __forceinline__ bf16x8 pack8(const float* v) {
    u32x4 w; w.x = pk2(v[0], v[1]); w.y = pk2(v[2], v[3]); w.z = pk2(v[4], v[5]); w.w = pk2(v[6], v[7]); return __builtin_bit_cast(bf16x8, w);
}

struct Args { const float* in[31]; float* out; unsigned char* ws; };
typedef const Args __attribute__((address_space(4)))* KArgs;

__device__ __forceinline__ void p0_transpose_item(const float* W, int K, int N, bf16_t* WT, int k0, int n0, int drow0, LAS float* scr, int lane) {
#pragma unroll 8
    for (int i = 0; i < 32; ++i) { const int kk = 2 * i + (lane >> 5); scr[kk * 33 + (lane & 31)] = W[(size_t)(k0 + kk) * N + n0 + (lane & 31)]; }
    asm volatile("s_waitcnt lgkmcnt(0)" ::: "memory");
    const int c = lane & 7;
#pragma unroll
    for (int j = 0; j < 4; ++j) { const int n = (lane >> 3) + 8 * j; const LAS float* s = scr + (8 * c) * 33 + n;
        u32x4 o; o.x = pk2(s[0 * 33], s[1 * 33]); o.y = pk2(s[2 * 33], s[3 * 33]); o.z = pk2(s[4 * 33], s[5 * 33]); o.w = pk2(s[6 * 33], s[7 * 33]);
        *(u32x4*)(WT + (size_t)(drow0 + n) * K + k0 + 8 * c) = o; }
    asm volatile("s_waitcnt lgkmcnt(0)" ::: "memory");
}

__device__ __forceinline__ void phase_p0(KArgs a, LAS unsigned char* lds) {
    const int tid = otid(), lane = tid & 63, wave = tid >> 6;
    const int G = gridDim.x, bid = obid();
    const int gw = bid * NWAVES + wave, NGW = G * NWAVES;
    unsigned char* ws = a->ws;
    {
        LAS float* scr = (LAS float*)(lds + wave * 8448);
        constexpr int I_INAB = 32 * 218, I_QUP = 8 * 48, I_KVUP = 4 * 64, I_OUT = 32 * 64, I_INC = 32 * 160;
        constexpr int PER_J = I_INAB + I_QUP + I_KVUP + I_OUT + I_INC + I_OUT;
        for (int it = gw; it < 2 * PER_J; it += NGW) {
            const int j = it / PER_J; int r = it % PER_J;
            if (r < I_INAB) { const int kb = r / 218, nb = r % 218, n0 = nb * 32; const int d0 = n0 < 768 ? n0 : (n0 < 832 ? n0 + 6144 : n0 - 64);
                p0_transpose_item(a->in[13] + (size_t)j * 2048 * 6976, 2048, 6976, (bf16_t*)(ws + WS_WINAB) + (size_t)j * 7168 * 2048, kb * 64, n0, d0, scr, lane); continue; }
            r -= I_INAB;
            if (r < I_QUP) { const int kb = r / 48, nb = r % 48;
                p0_transpose_item(a->in[16] + (size_t)j * 512 * 1536, 512, 1536, (bf16_t*)(ws + WS_WQUP) + (size_t)j * 1536 * 512, kb * 64, nb * 32, nb * 32, scr, lane); continue; }
            r -= I_QUP;
            if (r < I_KVUP) { const int kb = r / 64, nb = r % 64;
                p0_transpose_item(a->in[17] + (size_t)j * 256 * 2048, 256, 2048, (bf16_t*)(ws + WS_WKVUP) + (size_t)j * 2048 * 256, kb * 64, nb * 32, nb * 32, scr, lane); continue; }
            r -= I_KVUP;
            if (r < I_OUT) { const int kb = r / 64, nb = r % 64;
                p0_transpose_item(a->in[22] + (size_t)j * 2048 * 2048, 2048, 2048, (bf16_t*)(ws + WS_WOUTAB) + (size_t)j * 2048 * 2048, kb * 64, nb * 32, nb * 32, scr, lane); continue; }
            r -= I_OUT;
            if (r < I_INC) { const int kb = r / 160, nb = r % 160;
                p0_transpose_item(a->in[26] + (size_t)j * 2048 * 5120, 2048, 5120, (bf16_t*)(ws + WS_WINC) + (size_t)j * 5120 * 2048, kb * 64, nb * 32, nb * 32, scr, lane); continue; }
            r -= I_INC;
            { const int kb = r / 64, nb = r % 64;
                p0_transpose_item(a->in[30] + (size_t)j * 2048 * 2048, 2048, 2048, (bf16_t*)(ws + WS_WOUTC) + (size_t)j * 2048 * 2048, kb * 64, nb * 32, nb * 32, scr, lane); }
        }
    }
    const int gt = bid * NTHR + tid, NGT = G * NTHR;
    for (int i = gt; i < 2 * 192 * 256; i += NGT) { const int j = i / (192 * 256), r = i % (192 * 256);
        *(u32x4*)((bf16_t*)(ws + WS_WINAB) + (size_t)j * 7168 * 2048 + (size_t)6976 * 2048 + (size_t)r * 8) = (u32x4){0u, 0u, 0u, 0u}; }
    for (int i = gt; i < 2 * 131072; i += NGT) { const int which = i / 131072, e = (i % 131072) * 8;
        const float* src = a->in[6 + which] + e; const f32x4 x0 = *(const f32x4*)src, x1 = *(const f32x4*)(src + 4);
        u32x4 w; w.x = pk2(x0[0], x0[1]); w.y = pk2(x0[2], x0[3]); w.z = pk2(x1[0], x1[1]); w.w = pk2(x1[2], x1[3]);
        *(u32x4*)((bf16_t*)(ws + WS_KCC) + (size_t)(e >> 9) * LDP_C + (which ? 512 : 0) + (e & 511)) = w; }
    for (int i = gt; i < 2 * 2048; i += NGT) { const int j = i / 2048, r = i % 2048; const float l0 = a->in[20][r], l1 = a->in[20][2048 + r];
        ((float*)(ws + WS_LB))[i] = j == 0 ? 0.f : 1.f / (1.f + __expf(l0 - l1)); }
    for (int i = gt; i < 2048 * 32; i += NGT) { const int t = i >> 5, f = i & 31; const float pos = f < 16 ? (float)(t >> 6) : (float)(t & 63);
        const float inv = exp2f(-(float)(f & 15) * (13.287712379549449f / 16.f)); const float ang = pos * inv;
        ((float*)(ws + WS_ROPEA))[2 * i] = __cosf(ang); ((float*)(ws + WS_ROPEA))[2 * i + 1] = __sinf(ang); }
    for (int i = gt; i < 2048 * 64; i += NGT) { const int t = i >> 6, f = i & 63; const float pos = f < 32 ? (float)(t >> 6) : (float)(t & 63);
        const float inv = exp2f(-(float)(f & 31) * (13.287712379549449f / 32.f)); const float ang = pos * inv;
        ((float*)(ws + WS_ROPEC))[2 * i] = __cosf(ang); ((float*)(ws + WS_ROPEC))[2 * i + 1] = __sinf(ang); }
    __syncthreads();
    {
        LAS float* SC = (LAS float*)lds;
        LAS float* RED = (LAS float*)(lds + 40960);
        for (int i = tid; i < 5 * 2048; i += NTHR) { const int b = i >> 11, k = i & 2047; const float x = b < 4 ? a->in[8][b * 2048 + k] : a->in[9][k]; SC[i] = silu_f(x); }
        __syncthreads();
        const int cq = tid & 7, ks = tid >> 3;
        for (int u = bid; u < 768; u += G) {
            const int L = u / 192, col0 = (u % 192) * 32;
            const float* W = ((L & 1) ? a->in[23] : a->in[10]) + (size_t)(L >> 1) * 2048 * 6144;
            const float* bias = ((L & 1) ? a->in[24] : a->in[11]) + (size_t)(L >> 1) * 6144;
            f32x4 acc[5];
#pragma unroll
            for (int b = 0; b < 5; ++b) acc[b] = (f32x4){0.f, 0.f, 0.f, 0.f};
#pragma unroll 8
            for (int kk = 0; kk < 32; ++kk) { const int k = 32 * ks + kk; const f32x4 w = *(const f32x4*)(W + (size_t)k * 6144 + col0 + 4 * cq);
#pragma unroll
                for (int b = 0; b < 5; ++b) acc[b] += SC[b * 2048 + k] * w; }
#pragma unroll
            for (int b = 0; b < 5; ++b) *(LAS f32x4*)(RED + (ks * 5 + b) * 32 + 4 * cq) = acc[b];
            __syncthreads();
            if (tid < 160) { const int b = tid >> 5, c = tid & 31; float s = 0.f;
                for (int q = 0; q < 64; ++q) s += RED[(q * 5 + b) * 32 + c];
                ((float*)(ws + WS_MOD))[(L * 5 + b) * 6144 + col0 + c] = s + bias[col0 + c]; }
            __syncthreads();
        }
    }
}

__device__ __forceinline__ void phase_modnorm(KArgs a, int L) {
    const int tid = otid(), lane = tid & 63, wave = tid >> 6;
    const int gw = obid() * NWAVES + wave, NGW = gridDim.x * NWAVES;
    const float* g = ((L & 1) ? a->in[25] : a->in[12]) + (L >> 1) * 2048;
    bf16_t* H = (bf16_t*)(a->ws + WS_H);
    for (int r = gw; r < MROWS; r += NGW) {
        const float* x = L == 0 ? (r < MC ? a->in[0] + (size_t)r * DM : a->in[1] + (size_t)(r - MC) * DM) : a->out + (size_t)r * DM;
        const int ci = r < MC ? 4 : ((r - MC) >> 11);
        const float* md = (const float*)(a->ws + WS_MOD) + (L * 5 + ci) * 6144;
        f32x4 v[8]; float ss = 0.f;
#pragma unroll
        for (int j = 0; j < 8; ++j) { v[j] = *(const f32x4*)(x + 256 * j + 4 * lane); ss += (v[j][0] * v[j][0] + v[j][1] * v[j][1]) + (v[j][2] * v[j][2] + v[j][3] * v[j][3]); }
        const float rstd = rsqrtf(wave_sum(ss) * (1.f / 2048.f) + EPSN);
#pragma unroll
        for (int j = 0; j < 8; ++j) { const int c = 256 * j + 4 * lane;
            const f32x4 gg = *(const f32x4*)(g + c), sh = *(const f32x4*)(md + c), sc = *(const f32x4*)(md + 2048 + c);
            const f32x4 y = (v[j] * rstd * gg) * (sc + 1.f) + sh;
            u32x2 w; w.x = pk2(y[0], y[1]); w.y = pk2(y[2], y[3]);
            *(u32x2*)(H + (size_t)r * DM + c) = w; }
    }
}

__device__ __forceinline__ void phase_prep_ab(KArgs a, int j) {
    const int tid = otid(), lane = tid & 63, wave = tid >> 6;
    const int gw = obid() * NWAVES + wave, NGW = gridDim.x * NWAVES;
    const bf16_t* P = (const bf16_t*)(a->ws + WS_PROJ);
    bf16_t* QN = (bf16_t*)(a->ws + WS_QN); bf16_t* CKV = (bf16_t*)(a->ws + WS_CKV);
    const float* gq = a->in[14] + j * 512; const float* gkv = a->in[15] + j * 256;
    for (int r = gw; r < MKROWS; r += NGW) {
        if (r < MROWS) {
            const bf16_t* p = P + (size_t)r * LDP_AB;
            const bf16x8 q = *(const bf16x8*)(p + COL_QL + 8 * lane);
            float qv[8]; float ss = 0.f;
#pragma unroll
            for (int e = 0; e < 8; ++e) { qv[e] = bf2f((unsigned short)q[e]); ss += qv[e] * qv[e]; }
            const float rq = rsqrtf(wave_sum(ss) * (1.f / 512.f) + EPSN);
#pragma unroll
            for (int e = 0; e < 8; ++e) qv[e] = qv[e] * rq * gq[8 * lane + e];
            *(bf16x8*)(QN + (size_t)r * 512 + 8 * lane) = pack8(qv);
            const s16x4 kv = *(const s16x4*)(p + COL_KVL + 4 * lane);
            float kf[4]; float s2 = 0.f;
#pragma unroll
            for (int e = 0; e < 4; ++e) { kf[e] = bf2f((unsigned short)kv[e]); s2 += kf[e] * kf[e]; }
            const float rk = rsqrtf(wave_sum(s2) * (1.f / 256.f) + EPSN);
#pragma unroll
            for (int e = 0; e < 4; ++e) kf[e] = kf[e] * rk * gkv[4 * lane + e];
            u32x2 w; w.x = pk2(kf[0], kf[1]); w.y = pk2(kf[2], kf[3]);
            *(u32x2*)(CKV + (size_t)r * 256 + 4 * lane) = w;
            if (r < MC) { const int b = r >> 8, t = r & 255; const size_t rowo = (size_t)((b * 2 + j) * 256 + t);
                *(f32x4*)(a->out + O_CKV + rowo * 256 + 4 * lane) = (f32x4){kf[0], kf[1], kf[2], kf[3]};
                a->out[O_KPE + rowo * 64 + lane] = bf2f(p[COL_KPE + lane]); }
        } else {
            const int rr = r - MROWS, b = rr >> 8, t = rr & 255;
            const f32x4 x = *(const f32x4*)(a->in[2] + (size_t)((b * 2 + j) * 256 + t) * 256 + 4 * lane);
            u32x2 w; w.x = pk2(x[0], x[1]); w.y = pk2(x[2], x[3]);
            *(u32x2*)(CKV + (size_t)r * 256 + 4 * lane) = w;
        }
    }
}

__device__ __forceinline__ void phase_hn_ab(KArgs a, int j) {
    const int tid = otid(), lane = tid & 63, wave = tid >> 6, sub = lane & 15, hq = lane >> 4;
    const int gw = obid() * NWAVES + wave, NGW = gridDim.x * NWAVES;
    bf16_t* Q = (bf16_t*)(a->ws + WS_QRAW); const bf16_t* KV = (const bf16_t*)(a->ws + WS_KVRAW); bf16_t* KF = (bf16_t*)(a->ws + WS_KF);
    const bf16_t* P = (const bf16_t*)(a->ws + WS_PROJ);
    const float* RA = (const float*)(a->ws + WS_ROPEA);
    const float* gq = a->in[18] + j * 192; const float* gk = a->in[19] + j * 192;
    const int NQ = MROWS * 2, NK = MKROWS * 2;
    for (int it = gw; it < NQ + NK; it += NGW) {
        const bool isq = it < NQ; const int w = isq ? it : it - NQ; const int r = w >> 1, h = (w & 1) * 4 + hq;
        float xn[8], x1[2], x2[2];
        if (isq) {
            const bf16_t* p = Q + (size_t)r * 1536 + h * 192;
            const bf16x8 v = *(const bf16x8*)(p + 8 * sub); const unsigned a1 = *(const unsigned*)(p + 128 + 2 * sub), a2 = *(const unsigned*)(p + 160 + 2 * sub);
#pragma unroll
            for (int e = 0; e < 8; ++e) xn[e] = bf2f((unsigned short)v[e]);
            x1[0] = bf2f(a1 & 0xffff); x1[1] = bf2f(a1 >> 16); x2[0] = bf2f(a2 & 0xffff); x2[1] = bf2f(a2 >> 16);
        } else {
            const bf16_t* p = KV + (size_t)r * 2048 + h * 256;
            const bf16x8 v = *(const bf16x8*)(p + 8 * sub);
#pragma unroll
            for (int e = 0; e < 8; ++e) xn[e] = bf2f((unsigned short)v[e]);
            if (r < MROWS) { const bf16_t* pe = P + (size_t)r * LDP_AB + COL_KPE; const unsigned a1 = *(const unsigned*)(pe + 2 * sub), a2 = *(const unsigned*)(pe + 32 + 2 * sub);
                x1[0] = bf2f(a1 & 0xffff); x1[1] = bf2f(a1 >> 16); x2[0] = bf2f(a2 & 0xffff); x2[1] = bf2f(a2 >> 16); }
            else { const int rr = r - MROWS, b = rr >> 8, t = rr & 255; const float* pe = a->in[3] + (size_t)((b * 2 + j) * 256 + t) * 64;
                x1[0] = pe[2 * sub]; x1[1] = pe[2 * sub + 1]; x2[0] = pe[32 + 2 * sub]; x2[1] = pe[32 + 2 * sub + 1]; }
        }
        float ss = x1[0] * x1[0] + x1[1] * x1[1] + x2[0] * x2[0] + x2[1] * x2[1];
#pragma unroll
        for (int e = 0; e < 8; ++e) ss += xn[e] * xn[e];
        const float rstd = rsqrtf(sum16(ss) * (1.f / 192.f) + EPSN);
        const float* g = isq ? gq : gk;
#pragma unroll
        for (int e = 0; e < 8; ++e) xn[e] = xn[e] * rstd * g[8 * sub + e];
        x1[0] *= rstd * g[128 + 2 * sub]; x1[1] *= rstd * g[128 + 2 * sub + 1]; x2[0] *= rstd * g[160 + 2 * sub]; x2[1] *= rstd * g[160 + 2 * sub + 1];
        if (r >= MC && r < MROWS) { const int t = (r - MC) & 2047;
#pragma unroll
            for (int u = 0; u < 2; ++u) { const float c = RA[(t * 32 + 2 * sub + u) * 2], s = RA[(t * 32 + 2 * sub + u) * 2 + 1];
                const float y1 = x1[u] * c - x2[u] * s, y2 = x1[u] * s + x2[u] * c; x1[u] = y1; x2[u] = y2; } }
        if (isq) {
#pragma unroll
            for (int e = 0; e < 8; ++e) xn[e] *= QSC_A;
            x1[0] *= QSC_A; x1[1] *= QSC_A; x2[0] *= QSC_A; x2[1] *= QSC_A;
            bf16_t* p = Q + (size_t)r * 1536 + h * 192;
            *(bf16x8*)(p + 8 * sub) = pack8(xn); *(unsigned*)(p + 128 + 2 * sub) = pk2(x1[0], x1[1]); *(unsigned*)(p + 160 + 2 * sub) = pk2(x2[0], x2[1]);
        } else {
            bf16_t* p = KF + (size_t)r * 1536 + h * 192;
            *(bf16x8*)(p + 8 * sub) = pack8(xn); *(unsigned*)(p + 128 + 2 * sub) = pk2(x1[0], x1[1]); *(unsigned*)(p + 160 + 2 * sub) = pk2(x2[0], x2[1]);
        }
    }
}

__device__ __forceinline__ void phase_fin_ab(KArgs a, int j) {
    const int tid = otid(), lane = tid & 63, wave = tid >> 6, sub = lane & 15, hq = lane >> 4;
    const int gw = obid() * NWAVES + wave, NGW = gridDim.x * NWAVES;
    const bf16_t* OF = (const bf16_t*)(a->ws + WS_OF); const bf16_t* OB = (const bf16_t*)(a->ws + WS_OB);
    const bf16_t* P = (const bf16_t*)(a->ws + WS_PROJ); bf16_t* MIX = (bf16_t*)(a->ws + WS_H);
    const float* g = a->in[21] + j * 128;
    for (int it = gw; it < MROWS * 2; it += NGW) {
        const int r = it >> 1, h = (it & 1) * 4 + hq; const size_t o = (size_t)r * 1024 + h * 128 + 8 * sub;
        const bf16x8 va = *(const bf16x8*)(OF + o), vb = *(const bf16x8*)(OB + o), vg = *(const bf16x8*)(P + (size_t)r * LDP_AB + COL_BG + h * 128 + 8 * sub);
        float s[8]; float ss = 0.f;
#pragma unroll
        for (int e = 0; e < 8; ++e) { s[e] = bf2f((unsigned short)va[e]) + bf2f((unsigned short)vb[e]); ss += s[e] * s[e]; }
        const float rstd = rsqrtf(sum16(ss) * (1.f / 128.f) + EPSN);
#pragma unroll
        for (int e = 0; e < 8; ++e) s[e] = s[e] * rstd * g[8 * sub + e] * silu_f(bf2f((unsigned short)vg[e]));
        *(bf16x8*)(MIX + (size_t)r * DM + 1024 + h * 128 + 8 * sub) = pack8(s);
    }
}

__device__ __forceinline__ void phase_hn_c(KArgs a, int j) {
    const int tid = otid(), lane = tid & 63, wave = tid >> 6, sub = lane & 15, hq = lane >> 4;
    const int gw = obid() * NWAVES + wave, NGW = gridDim.x * NWAVES;
    bf16_t* P = (bf16_t*)(a->ws + WS_PROJ);
    const float* RC = (const float*)(a->ws + WS_ROPEC);
    const float* gq = a->in[27] + j * 128; const float* gk = a->in[28] + j * 128;
    for (int it = gw; it < MROWS * 6; it += NGW) {
        const int r = it / 6, st = it % 6;
        if (st == 5) {
            if (r < MC) { const int b = r >> 8, t = r & 255; const bf16x8 v = *(const bf16x8*)(P + (size_t)r * LDP_C + 2560 + 8 * lane);
                float* o = a->out + O_VC + (size_t)((b * 2 + j) * 256 + t) * 512 + 8 * lane;
                *(f32x4*)o = (f32x4){bf2f((unsigned short)v[0]), bf2f((unsigned short)v[1]), bf2f((unsigned short)v[2]), bf2f((unsigned short)v[3])};
                *(f32x4*)(o + 4) = (f32x4){bf2f((unsigned short)v[4]), bf2f((unsigned short)v[5]), bf2f((unsigned short)v[6]), bf2f((unsigned short)v[7])}; }
            continue;
        }
        const int h = st * 4 + hq;
        const bool isq = h < 16;
        bf16_t* p = P + (size_t)r * LDP_C + (isq ? h * 128 : 2048 + (h - 16) * 128);
        const s16x4 v1 = *(const s16x4*)(p + 4 * sub), v2 = *(const s16x4*)(p + 64 + 4 * sub);
        float x1[4], x2[4]; float ss = 0.f;
#pragma unroll
        for (int e = 0; e < 4; ++e) { x1[e] = bf2f((unsigned short)v1[e]); x2[e] = bf2f((unsigned short)v2[e]); ss += x1[e] * x1[e] + x2[e] * x2[e]; }
        const float rstd = rsqrtf(sum16(ss) * (1.f / 128.f) + EPSN);
        const float* g = isq ? gq : gk;
#pragma unroll
        for (int e = 0; e < 4; ++e) { x1[e] *= rstd * g[4 * sub + e]; x2[e] *= rstd * g[64 + 4 * sub + e]; }
        if (r >= MC) { const int t = (r - MC) & 2047;
#pragma unroll
            for (int e = 0; e < 4; ++e) { const float c = RC[(t * 64 + 4 * sub + e) * 2], s = RC[(t * 64 + 4 * sub + e) * 2 + 1];
                const float y1 = x1[e] * c - x2[e] * s, y2 = x1[e] * s + x2[e] * c; x1[e] = y1; x2[e] = y2; } }
        else if (!isq) { const int b = r >> 8, t = r & 255; float* o = a->out + O_KC + (size_t)((b * 2 + j) * 256 + t) * 512 + (h - 16) * 128;
            *(f32x4*)(o + 4 * sub) = (f32x4){x1[0], x1[1], x1[2], x1[3]}; *(f32x4*)(o + 64 + 4 * sub) = (f32x4){x2[0], x2[1], x2[2], x2[3]}; }
        if (isq) {
#pragma unroll
            for (int e = 0; e < 4; ++e) { x1[e] *= QSC_C; x2[e] *= QSC_C; } }
        u32x2 w1, w2; w1.x = pk2(x1[0], x1[1]); w1.y = pk2(x1[2], x1[3]); w2.x = pk2(x2[0], x2[1]); w2.y = pk2(x2[2], x2[3]);
        *(u32x2*)(p + 4 * sub) = w1; *(u32x2*)(p + 64 + 4 * sub) = w2;
    }
}

namespace att {
__device__ __forceinline__ int crow(int r, int hi) { return (r & 3) + 8 * (r >> 2) + 4 * hi; }
__device__ __forceinline__ unsigned cvtpk(float lo, float hi) { unsigned r; asm volatile("v_cvt_pk_bf16_f32 %0, %1, %2" : "=v"(r) : "v"(lo), "v"(hi)); return r; }
__device__ __forceinline__ int v_st(int k, int c) { const int kk = (k & ~0xC) | ((k & 4) << 1) | ((k & 8) >> 1); return ((kk >> 3) * 4 + (c >> 5)) * 512 + ((kk & 7) * 32 + (c & 31)) * 2; }
__device__ __forceinline__ int v_rd_base(int lane) { return ((lane & 3) << 3) | (((lane >> 2) & 3) << 6) | (((lane >> 4) & 1) << 5) | (((lane >> 5) & 1) << 8); }
constexpr int v_rd_off(int d0, int ks, int half) { return d0 * 512 + ks * 4096 + half * 2048; }
template <int OFF> __device__ __forceinline__ s16x4 tr_read(int vb) {
    s16x4 r; asm volatile("ds_read_b64_tr_b16 %0, %1 offset:%2" : "=&v"(r) : "v"(vb), "i"(OFF) : "memory"); return r;
}
template <int D0> __device__ __forceinline__ void pv_one(f32x16& od, int vb, bf16x8 pa0, bf16x8 pa1, bf16x8 pa2, bf16x8 pa3) {
    const s16x4 l0 = tr_read<v_rd_off(D0, 0, 0)>(vb), h0 = tr_read<v_rd_off(D0, 0, 1)>(vb), l1 = tr_read<v_rd_off(D0, 1, 0)>(vb), h1 = tr_read<v_rd_off(D0, 1, 1)>(vb);
    const s16x4 l2 = tr_read<v_rd_off(D0, 2, 0)>(vb), h2 = tr_read<v_rd_off(D0, 2, 1)>(vb), l3 = tr_read<v_rd_off(D0, 3, 0)>(vb), h3 = tr_read<v_rd_off(D0, 3, 1)>(vb);
    asm volatile("s_waitcnt lgkmcnt(0)" ::: "memory"); __builtin_amdgcn_sched_barrier(0);
#define ATT_PK(L, H) (bf16x8){L[0], L[1], L[2], L[3], H[0], H[1], H[2], H[3]}
    od = __builtin_amdgcn_mfma_f32_32x32x16_bf16(pa0, ATT_PK(l0, h0), od, 0, 0, 0);
    od = __builtin_amdgcn_mfma_f32_32x32x16_bf16(pa1, ATT_PK(l1, h1), od, 0, 0, 0);
    od = __builtin_amdgcn_mfma_f32_32x32x16_bf16(pa2, ATT_PK(l2, h2), od, 0, 0, 0);
    od = __builtin_amdgcn_mfma_f32_32x32x16_bf16(pa3, ATT_PK(l3, h3), od, 0, 0, 0);
#undef ATT_PK
}
struct Item {
    const bf16_t* Q; int ldq;
    const bf16_t* K0; const bf16_t* V0; int n0;
    const bf16_t* K1; const bf16_t* V1; int ldk, ldv, t_lo, t_hi;
    int q0, band; float m0, l0;
    const bf16_t* G; int ldg; bf16_t* O; int ldo;
};
template <int DQK>
__device__ __forceinline__ void attn_item(LAS unsigned char* lds, const Item& it) {
    constexpr int KROW = DQK * 2, SHM_K = 64 * KROW, SHM_V = 64 * 128 * 2, ND = DQK / 16;
    const int tid = otid(), wid = tid >> 6, lane = tid & 63, r32 = lane & 31, hi = lane >> 5;
    LAS unsigned char* V_lds = lds; LAS unsigned char* K_lds = lds + 2 * SHM_V;
    LAS float* wsx = (LAS float*)(lds + 2 * SHM_V + 2 * SHM_K) + wid * 64; LAS float* li_l = wsx; LAS float* al_l = wsx + 32;
    float m_reg = it.m0, l_reg = it.l0;
    f32x16 o[4];
#pragma unroll
    for (int d = 0; d < 4; ++d)
#pragma unroll
        for (int r = 0; r < 16; ++r) o[d][r] = 0.f;
    bf16x8 qr[ND];
    { const bf16_t* Qw = it.Q + (size_t)(wid * 32 + r32) * it.ldq + hi * 8;
#pragma unroll
      for (int d0 = 0; d0 < ND; ++d0) qr[d0] = *(const bf16x8*)(Qw + d0 * 16); }
    const int NT = it.n0 + (it.t_hi - it.t_lo);
    const int wvu = __builtin_amdgcn_readfirstlane(wid);
    const int vb0 = (int)(uintptr_t)V_lds + v_rd_base(lane);
    constexpr int NKI = SHM_K / 8192;
    unsigned kog[NKI], vog[2];
#pragma unroll
    for (int i = 0; i < NKI; ++i) { const int off = i * 8192 + wid * 1024 + lane * 16, row = off / KROW, pos = off % KROW; kog[i] = (unsigned)(row * it.ldk + ((pos ^ ((row & 7) << 4)) >> 1)); }
#pragma unroll
    for (int i = 0; i < 2; ++i) { const int q = (i * 8192 + wid * 1024 + lane * 16) >> 4, sub = q >> 5, rem = q & 31, rowin = rem >> 2, cch = rem & 3;
        const int kk = (sub >> 2) * 8 + rowin; vog[i] = (unsigned)(((kk & ~0xC) | ((kk & 4) << 1) | ((kk & 8) >> 1)) * it.ldv + (sub & 3) * 32 + cch * 8); }
    int koff[4];
#pragma unroll
    for (int dl = 0; dl < 4; ++dl) koff[dl] = r32 * KROW + ((dl * 32 + hi * 16) ^ ((r32 & 7) << 4));
#define ATT_STAGE(jj, b) do { const int _j = (jj); const bool _s0 = _j < it.n0; const int _t = _s0 ? _j : it.t_lo + (_j - it.n0); \
        const bf16_t* _Kp = (_s0 ? it.K0 : it.K1) + (size_t)(64 * _t) * it.ldk; const bf16_t* _Vp = (_s0 ? it.V0 : it.V1) + (size_t)(64 * _t) * it.ldv; \
        _Pragma("unroll") for (int _i = 0; _i < NKI; ++_i) __builtin_amdgcn_global_load_lds((const unsigned*)(_Kp + kog[_i]), (LAS unsigned*)(K_lds + (b) * SHM_K + _i * 8192 + wvu * 1024), 16, 0, 0); \
        _Pragma("unroll") for (int _i = 0; _i < 2; ++_i) __builtin_amdgcn_global_load_lds((const unsigned*)(_Vp + vog[_i]), (LAS unsigned*)(V_lds + (b) * SHM_V + _i * 8192 + wvu * 1024), 16, 0, 0); } while (0)
    ATT_STAGE(0, 0); asm volatile("s_waitcnt vmcnt(0)" ::: "memory"); __syncthreads();
    for (int j = 0; j < NT; ++j) {
        const int cur = j & 1;
        if (j + 1 < NT) ATT_STAGE(j + 1, cur ^ 1);
        bool act = true; const bool domask = it.band && j >= it.n0; int kpos0 = 0;
        if (domask) { kpos0 = 64 * (it.t_lo + j - it.n0); const int qlo = it.q0 + wid * 32; act = (kpos0 + 63 >= qlo - 128) && (kpos0 <= qlo + 31 + 128); }
        if (act) {
            f32x16 p0, p1;
#pragma unroll
            for (int r = 0; r < 16; ++r) { p0[r] = 0.f; p1[r] = 0.f; }
            const LAS unsigned char* Ks = K_lds + cur * SHM_K;
#pragma unroll
            for (int d0 = 0; d0 < ND; ++d0) {
                const bf16x8 b0 = *(const LAS bf16x8*)(Ks + koff[d0 & 3] + (d0 >> 2) * 128);
                const bf16x8 b1 = *(const LAS bf16x8*)(Ks + koff[d0 & 3] + (d0 >> 2) * 128 + 32 * KROW);
                p0 = __builtin_amdgcn_mfma_f32_32x32x16_bf16(b0, qr[d0], p0, 0, 0, 0);
                p1 = __builtin_amdgcn_mfma_f32_32x32x16_bf16(b1, qr[d0], p1, 0, 0, 0);
                if ((d0 & 3) == 3) __builtin_amdgcn_sched_barrier(0); }
            if (domask) { const int qp = it.q0 + wid * 32 + r32;
#pragma unroll
                for (int r = 0; r < 16; ++r) { const int d = kpos0 + crow(r, hi) - qp;
                    if (d > 128 || d < -128) p0[r] = -1e30f;
                    if (d + 32 > 128 || d + 32 < -128) p1[r] = -1e30f; } }
            float pmax = p0[0];
#pragma unroll
            for (int r = 1; r < 16; ++r) pmax = fmaxf(pmax, p0[r]);
#pragma unroll
            for (int r = 0; r < 16; ++r) pmax = fmaxf(pmax, p1[r]);
            { auto rr = __builtin_amdgcn_permlane32_swap(__float_as_uint(pmax), __float_as_uint(pmax), false, false);
              pmax = fmaxf(__uint_as_float(rr[0]), __uint_as_float(rr[1])); }
            const float mn = fmaxf(m_reg, pmax); const float alpha = __builtin_amdgcn_exp2f(m_reg - mn); m_reg = mn;
            float ps = 0.f;
#pragma unroll
            for (int r = 0; r < 16; ++r) { p0[r] = __builtin_amdgcn_exp2f(p0[r] - mn); p1[r] = __builtin_amdgcn_exp2f(p1[r] - mn); ps += p0[r] + p1[r]; }
            { auto rr = __builtin_amdgcn_permlane32_swap(__float_as_uint(ps), __float_as_uint(ps), false, false);
              ps = __uint_as_float(rr[0]) + __uint_as_float(rr[1]); }
            l_reg = l_reg * alpha + ps;
            bf16x8 pa0, pa1, pa2, pa3;
#define ATT_PK4(P, BASE, OUT) do { unsigned a0 = cvtpk(P[BASE + 0], P[BASE + 1]), a1 = cvtpk(P[BASE + 2], P[BASE + 3]);   \
    unsigned b0 = cvtpk(P[BASE + 4], P[BASE + 5]), b1 = cvtpk(P[BASE + 6], P[BASE + 7]);                              \
    auto r0 = __builtin_amdgcn_permlane32_swap(a0, b0, false, false); auto r1 = __builtin_amdgcn_permlane32_swap(a1, b1, false, false); \
    u32x4 w = {r0[0], r1[0], r0[1], r1[1]}; OUT = __builtin_bit_cast(bf16x8, w); } while (0)
            ATT_PK4(p0, 0, pa0); ATT_PK4(p0, 8, pa1); ATT_PK4(p1, 0, pa2); ATT_PK4(p1, 8, pa3);
#undef ATT_PK4
            if (__any(alpha < 1.f)) { if (hi == 0) al_l[r32] = alpha; asm volatile("s_waitcnt lgkmcnt(0)" ::: "memory");
#pragma unroll
                for (int r = 0; r < 16; ++r) { const float al = al_l[crow(r, hi)];
#pragma unroll
                    for (int d = 0; d < 4; ++d) o[d][r] *= al; } }
            const int vb = vb0 + cur * SHM_V;
            pv_one<0>(o[0], vb, pa0, pa1, pa2, pa3); pv_one<1>(o[1], vb, pa0, pa1, pa2, pa3); pv_one<2>(o[2], vb, pa0, pa1, pa2, pa3); pv_one<3>(o[3], vb, pa0, pa1, pa2, pa3);
        }
        asm volatile("s_waitcnt vmcnt(0)" ::: "memory"); __syncthreads();
    }
#undef ATT_STAGE
    if (hi == 0) li_l[r32] = l_reg; asm volatile("s_waitcnt lgkmcnt(0)" ::: "memory");
#pragma unroll
    for (int r = 0; r < 16; ++r) { const int orow = wid * 32 + crow(r, hi); const float rli = 1.f / li_l[crow(r, hi)];
#pragma unroll
        for (int d0 = 0; d0 < 4; ++d0) { const int col = d0 * 32 + r32; const float g = bf2f(it.G[(size_t)orow * it.ldg + col]);
            it.O[(size_t)orow * it.ldo + col] = (bf16_t)f2bf(o[d0][r] * rli * silu_f(g)); }
        asm volatile("" ::: "memory"); }
    __syncthreads();
}
}

__device__ __forceinline__ void hgrn_item(LAS unsigned char* lds, const bf16_t* PROJ, int rowbase, int T, int h, int dir,
                                          const float* lb, const float* s0, float* sout, bf16_t* OUT) {
    LAS float* GS = (LAS float*)lds;
    LAS float* DEC = (LAS float*)(lds + 2048);
    LAS bf16_t* QT = (LAS bf16_t*)(lds + 2560);
    LAS bf16_t* KT = QT + 32 * 136;
    LAS bf16_t* KTt = KT + 32 * 136;
    LAS bf16_t* Vt = KTt + 128 * 40;
    const int tid = otid(), wid = tid >> 6, lane = tid & 63, fr = lane & 15, fq = lane >> 4;
    const int c2 = tid & 127, part = tid >> 7, n0 = wid * 16;
    f32x4 S[8];
#pragma unroll
    for (int kt = 0; kt < 8; ++kt) {
        if (s0) {
#pragma unroll
            for (int r = 0; r < 4; ++r) S[kt][r] = s0[(size_t)(16 * kt + 4 * fq + r) * 128 + n0 + fr]; }
        else S[kt] = (f32x4){0.f, 0.f, 0.f, 0.f}; }
    const float oml = 1.f - lb[c2];
    const int nch = T / 32;
    const bf16_t* pq = PROJ + COL_BQ + h * 128 + c2; const bf16_t* pf = PROJ + (dir ? COL_FB : COL_FF) + h * 128 + c2; const bf16_t* pv = PROJ + COL_BI + h * 128 + c2;
    unsigned short rq[8], rf[8], rv[8];
#define HG_LOAD(cc) do { _Pragma("unroll") for (int _i = 0; _i < 8; ++_i) { const int _p = 32 * (cc) + 8 * part + _i; const int _tok = dir ? T - 1 - _p : _p; \
        const size_t _o = (size_t)(rowbase + _tok) * LDP_AB; rq[_i] = pq[_o]; rf[_i] = pf[_o]; rv[_i] = pv[_o]; } } while (0)
    HG_LOAD(0);
    for (int c = 0; c < nch; ++c) {
        float b[8], kk[8], sq[8]; unsigned short vv[8];
        { float run = 0.f;
#pragma unroll
            for (int i = 0; i < 8; ++i) { const float x = bf2f(rf[i]); const float omf = oml * __builtin_amdgcn_rcpf(1.f + __expf(x));
                const float lf = fmaxf(__logf(1.f - omf), -30.f); run += lf; b[i] = run; kk[i] = omf; sq[i] = silu_f(bf2f(rq[i])); vv[i] = rv[i]; }
            GS[part * 128 + c2] = run; }
        if (c + 1 < nch) HG_LOAD(c + 1);
        __syncthreads();
        { float off = 0.f;
#pragma unroll
            for (int p = 0; p < 3; ++p) if (p < part) off += GS[p * 128 + c2];
            float kt_[8];
#pragma unroll
            for (int i = 0; i < 8; ++i) { const float bb = b[i] + off; const int t = 8 * part + i;
                const float qv = sq[i] * __expf(bb); kt_[i] = kk[i] * __expf(fminf(-bb, 80.f));
                QT[t * 136 + c2] = (bf16_t)f2bf(qv); KT[t * 136 + c2] = (bf16_t)f2bf(kt_[i]);
                if (i == 7 && part == 3) DEC[c2] = __expf(bb); }
            *(LAS bf16x8*)(KTt + c2 * 40 + 8 * part) = pack8(kt_);
            u32x4 wv; wv.x = (unsigned)vv[0] | ((unsigned)vv[1] << 16); wv.y = (unsigned)vv[2] | ((unsigned)vv[3] << 16); wv.z = (unsigned)vv[4] | ((unsigned)vv[5] << 16); wv.w = (unsigned)vv[6] | ((unsigned)vv[7] << 16);
            *(LAS u32x4*)(Vt + c2 * 40 + 8 * part) = wv; }
        __syncthreads();
        f32x4 pt00 = {0.f, 0.f, 0.f, 0.f}, pt01 = pt00, pt11 = pt00;
#pragma unroll
        for (int ks = 0; ks < 4; ++ks) {
            const bf16x8 a0 = *(const LAS bf16x8*)(KT + fr * 136 + 32 * ks + 8 * fq), a1 = *(const LAS bf16x8*)(KT + (16 + fr) * 136 + 32 * ks + 8 * fq);
            const bf16x8 b0 = *(const LAS bf16x8*)(QT + fr * 136 + 32 * ks + 8 * fq), b1 = *(const LAS bf16x8*)(QT + (16 + fr) * 136 + 32 * ks + 8 * fq);
            pt00 = __builtin_amdgcn_mfma_f32_16x16x32_bf16(a0, b0, pt00, 0, 0, 0);
            pt01 = __builtin_amdgcn_mfma_f32_16x16x32_bf16(a0, b1, pt01, 0, 0, 0);
            pt11 = __builtin_amdgcn_mfma_f32_16x16x32_bf16(a1, b1, pt11, 0, 0, 0); }
#pragma unroll
        for (int r = 0; r < 4; ++r) { if (4 * fq + r > fr) { pt00[r] = 0.f; pt11[r] = 0.f; } }
        u32x4 wA0, wA1;
        wA0.x = pk2(pt00[0], pt00[1]); wA0.y = pk2(pt00[2], pt00[3]); wA0.z = 0u; wA0.w = 0u;
        wA1.x = pk2(pt01[0], pt01[1]); wA1.y = pk2(pt01[2], pt01[3]); wA1.z = pk2(pt11[0], pt11[1]); wA1.w = pk2(pt11[2], pt11[3]);
        const u32x2 vlo = *(const LAS u32x2*)(Vt + (n0 + fr) * 40 + 4 * fq), vhi = *(const LAS u32x2*)(Vt + (n0 + fr) * 40 + 16 + 4 * fq);
        const u32x4 wV = {vlo.x, vlo.y, vhi.x, vhi.y};
        f32x4 o0 = {0.f, 0.f, 0.f, 0.f}, o1 = o0;
        o0 = __builtin_amdgcn_mfma_f32_16x16x32_bf16(__builtin_bit_cast(bf16x8, wA0), __builtin_bit_cast(bf16x8, wV), o0, 0, 0, 0);
        o1 = __builtin_amdgcn_mfma_f32_16x16x32_bf16(__builtin_bit_cast(bf16x8, wA1), __builtin_bit_cast(bf16x8, wV), o1, 0, 0, 0);
#pragma unroll
        for (int aa = 0; aa < 4; ++aa) {
            u32x4 wS; wS.x = pk2(S[2 * aa][0], S[2 * aa][1]); wS.y = pk2(S[2 * aa][2], S[2 * aa][3]); wS.z = pk2(S[2 * aa + 1][0], S[2 * aa + 1][1]); wS.w = pk2(S[2 * aa + 1][2], S[2 * aa + 1][3]);
            const u32x2 q0l = *(const LAS u32x2*)(QT + fr * 136 + 32 * aa + 4 * fq), q0h = *(const LAS u32x2*)(QT + fr * 136 + 32 * aa + 16 + 4 * fq);
            const u32x2 q1l = *(const LAS u32x2*)(QT + (16 + fr) * 136 + 32 * aa + 4 * fq), q1h = *(const LAS u32x2*)(QT + (16 + fr) * 136 + 32 * aa + 16 + 4 * fq);
            const u32x4 wQ0 = {q0l.x, q0l.y, q0h.x, q0h.y}, wQ1 = {q1l.x, q1l.y, q1h.x, q1h.y};
            o0 = __builtin_amdgcn_mfma_f32_16x16x32_bf16(__builtin_bit_cast(bf16x8, wQ0), __builtin_bit_cast(bf16x8, wS), o0, 0, 0, 0);
            o1 = __builtin_amdgcn_mfma_f32_16x16x32_bf16(__builtin_bit_cast(bf16x8, wQ1), __builtin_bit_cast(bf16x8, wS), o1, 0, 0, 0); }
        { const bf16x8 vn = *(const LAS bf16x8*)(Vt + (n0 + fr) * 40 + 8 * fq);
#pragma unroll
            for (int kt = 0; kt < 8; ++kt) { const bf16x8 ka = *(const LAS bf16x8*)(KTt + (16 * kt + fr) * 40 + 8 * fq);
                S[kt] = __builtin_amdgcn_mfma_f32_16x16x32_bf16(ka, vn, S[kt], 0, 0, 0);
                const f32x4 d = *(const LAS f32x4*)(DEC + 16 * kt + 4 * fq); S[kt] = S[kt] * d; } }
#pragma unroll
        for (int r = 0; r < 4; ++r) {
            const int i0 = 4 * fq + r, i1 = 16 + 4 * fq + r;
            const int tok0 = dir ? T - 1 - (32 * c + i0) : 32 * c + i0, tok1 = dir ? T - 1 - (32 * c + i1) : 32 * c + i1;
            OUT[(size_t)(rowbase + tok0) * 1024 + h * 128 + n0 + fr] = (bf16_t)f2bf(o0[r]);
            OUT[(size_t)(rowbase + tok1) * 1024 + h * 128 + n0 + fr] = (bf16_t)f2bf(o1[r]); }
    }
#undef HG_LOAD
    if (sout) {
#pragma unroll
        for (int kt = 0; kt < 8; ++kt)
#pragma unroll
            for (int r = 0; r < 4; ++r) sout[(size_t)(16 * kt + 4 * fq + r) * 128 + n0 + fr] = S[kt][r]; }
    __syncthreads();
}

__device__ __forceinline__ int fetch_item(unsigned* ctr, LAS int* slot) {
    __syncthreads();
    if (otid() == 0) *slot = (int)atomicAdd(ctr, 1u);
    __syncthreads();
    return *slot;
}

#define XB_TMO      128
#define XB_XCNT(j)  (256  + 64 * (j))
#define XB_XSUB(j)  (1280 + 64 * (j))
#define XB_XGEN(j)  (2304 + 64 * (j))
#define XB_TOP      3328
#define XB_TOPGEN   3392
#define XCD_BAR_WORDS 3456
#define XB_SPIN_CAP (1u << 18)

__device__ __forceinline__ unsigned xb_ld(unsigned* p)              { return __hip_atomic_load(p, __ATOMIC_RELAXED, __HIP_MEMORY_SCOPE_AGENT); }
__device__ __forceinline__ unsigned xb_add(unsigned* p, unsigned v) { return __hip_atomic_fetch_add(p, v, __ATOMIC_RELAXED, __HIP_MEMORY_SCOPE_AGENT); }
__device__ __forceinline__ unsigned xb_xcc_id() { return (unsigned)__builtin_amdgcn_s_getreg((3 << 11) | 20) & 0xFu; }
#define XB_SPIN(cond, bar) do { unsigned _sp = 0; while (cond) { __builtin_amdgcn_s_sleep(1); \
    if ((++_sp & 255u) == 0u) { if (xb_ld(&(bar)[XB_TMO])) break; if (_sp > XB_SPIN_CAP) { atomicAdd(&(bar)[XB_TMO], 1u); break; } } } } while (0)

struct XcdBarrier {
    unsigned* bar; unsigned x;
    volatile LAS unsigned* st;
};

__device__ __forceinline__ XcdBarrier xcd_barrier_post(unsigned* bar, volatile LAS unsigned* st) {
    XcdBarrier b; b.bar = bar; b.x = xb_xcc_id(); b.st = st;
    if (threadIdx.x == 0) (void)xb_add(&bar[XB_XCNT(b.x)], 1u);
    return b;
}
__device__ __forceinline__ void xcd_barrier_complete(unsigned* bar, unsigned x, unsigned& nloc, unsigned& nx) {
    const unsigned G = gridDim.x * gridDim.y * gridDim.z;
    unsigned sum, cnt, mine, sp = 0u;
    for (;;) {
        sum = 0u; cnt = 0u; mine = 0u;
#pragma unroll
        for (unsigned j = 0; j < 16; ++j) { const unsigned c = xb_ld(&bar[XB_XCNT(j)]); sum += c; cnt += (c > 0u) ? 1u : 0u; mine = (j == x) ? c : mine; }
        if (sum == G) break;
        __builtin_amdgcn_s_sleep(1);
        if ((++sp & 255u) == 0u) { if (xb_ld(&bar[XB_TMO])) break; if (sp > XB_SPIN_CAP) { atomicAdd(&bar[XB_TMO], 1u); break; } }
    }
    nloc = mine > 0u ? mine : 1u; nx = cnt > 0u ? cnt : 1u;
}

__device__ __forceinline__ void xcd_barrier(const XcdBarrier& b) {
    asm volatile("s_waitcnt vmcnt(0)" ::: "memory");
    __syncthreads();
    if (threadIdx.x == 0) {
        unsigned* bar = b.bar;
        __builtin_amdgcn_s_waitcnt(0);
        unsigned nloc = b.st[0], nx = b.st[1];
        if (nloc == 0u) { xcd_barrier_complete(bar, b.x, nloc, nx); b.st[0] = nloc; b.st[1] = nx; }
        const unsigned old = xb_add(&bar[XB_XSUB(b.x)], 1u);
        const unsigned gen = old / nloc;
        if (old + 1u == (gen + 1u) * nloc) {
            __builtin_amdgcn_fence(__ATOMIC_RELEASE, "agent");
            asm volatile("s_waitcnt vmcnt(0)" ::: "memory");
            const unsigned og = xb_add(&bar[XB_TOP], 1u);
            const unsigned tg = og / nx;
            if (og + 1u == (tg + 1u) * nx) xb_add(&bar[XB_TOPGEN], 1u);
            else XB_SPIN(xb_ld(&bar[XB_TOPGEN]) == tg, bar);
            __builtin_amdgcn_fence(__ATOMIC_ACQUIRE, "agent");
            xb_add(&bar[XB_XGEN(b.x)], 1u);
            asm volatile("s_waitcnt vmcnt(0)" ::: "memory");
        } else {
            XB_SPIN(xb_ld(&bar[XB_XGEN(b.x)]) == gen, bar);
            __builtin_amdgcn_fence(__ATOMIC_ACQUIRE, "agent");
            asm volatile("s_waitcnt vmcnt(0)" ::: "memory");
        }
    }
    __syncthreads();
}

enum { K_P0 = 0, K_MODNORM, K_GEMM_IN, K_PREP_AB, K_GEMM_QUP, K_GEMM_KVUP, K_HN_AB, K_MIX_AB, K_FIN_AB, K_GEMM_OUT, K_HN_C, K_ATTN_C };

__global__ void __launch_bounds__(NTHR, 2) mk_fwd(Args a_byval) {
    extern __shared__ __attribute__((aligned(16))) unsigned char lds_raw[];
    LAS unsigned char* lds = (LAS unsigned char*)lds_raw;
    LAS int* slot = (LAS int*)(lds + LDS_PHASE);
    cg::grid_group grid = cg::this_grid();
    const int G = gridDim.x;
    volatile LAS unsigned* bst = (volatile LAS unsigned*)(lds + LDS_PHASE + 64);
    if (threadIdx.x < 2) bst[threadIdx.x] = 0u;
    __syncthreads();
    XcdBarrier xbar = xcd_barrier_post((unsigned*)(a_byval.ws + WS_CTL) + 8192, bst);

    for (int step = 0; step < 29; ++step) {
        asm volatile("" : "+s"(step));
        KArgs a = (KArgs)__builtin_amdgcn_kernarg_segment_ptr();
        asm volatile("" : "+s"(a));
        unsigned char* ws = a->ws;
        unsigned* ctl = (unsigned*)(ws + WS_CTL);
        int kind, L = 0; bool sync_after = true;
        if (step == 0) kind = K_P0;
        else { const int s = step - 1, pair = s / 14, r = s % 14;
            if (r < 9) { L = 2 * pair; kind = r == 0 ? K_MODNORM : r == 1 ? K_GEMM_IN : r == 2 ? K_PREP_AB : r == 3 ? K_GEMM_QUP : r == 4 ? K_GEMM_KVUP : r == 5 ? K_HN_AB : r == 6 ? K_MIX_AB : r == 7 ? K_FIN_AB : K_GEMM_OUT; }
            else { L = 2 * pair + 1; const int q = r - 9; kind = q == 0 ? K_MODNORM : q == 1 ? K_GEMM_IN : q == 2 ? K_HN_C : q == 3 ? K_ATTN_C : K_GEMM_OUT; } }
        const int j = L >> 1; const bool isC = (L & 1) != 0;
        if (kind == K_GEMM_QUP) sync_after = false;
        if (step == 28) sync_after = false;

#ifndef PROBE_MASK
#define PROBE_MASK 0
#endif
#ifndef PROBE_SEL
#define PROBE_SEL 0
#endif
#ifndef PROBE_REPS
#define PROBE_REPS 2
#endif
        const int nrep = ((PROBE_MASK >> kind) & 1) ? 1 + PROBE_REPS : 1;
        for (int rep = 0; rep < nrep; ++rep) {
        if (PROBE_MASK == 0x1000) { for (int q = 0; q < 2; ++q) xcd_barrier(xbar); }
        if (kind == K_P0) phase_p0(a, lds);
        else if (kind == K_MODNORM) phase_modnorm(a, L);
        else if (kind == K_GEMM_IN || kind == K_GEMM_QUP || kind == K_GEMM_KVUP) {
            pg8::Gemm g; pg8::EpiStore E;
            if (kind == K_GEMM_IN) {
                if (!isC) { g = pg8::Gemm{(const bf16_t*)(ws + WS_H), (const bf16_t*)(ws + WS_WINAB) + (size_t)j * 7168 * 2048, MROWS, 7168, 2048}; E = pg8::EpiStore{(bf16_t*)(ws + WS_PROJ), LDP_AB}; }
                else { g = pg8::Gemm{(const bf16_t*)(ws + WS_H), (const bf16_t*)(ws + WS_WINC) + (size_t)j * 5120 * 2048, MROWS, 5120, 2048}; E = pg8::EpiStore{(bf16_t*)(ws + WS_PROJ), LDP_C}; }
            } else if (kind == K_GEMM_QUP) { g = pg8::Gemm{(const bf16_t*)(ws + WS_QN), (const bf16_t*)(ws + WS_WQUP) + (size_t)j * 1536 * 512, MROWS, 1536, 512}; E = pg8::EpiStore{(bf16_t*)(ws + WS_QRAW), 1536}; }
            else { g = pg8::Gemm{(const bf16_t*)(ws + WS_CKV), (const bf16_t*)(ws + WS_WKVUP) + (size_t)j * 2048 * 256, MKROWS, 2048, 256}; E = pg8::EpiStore{(bf16_t*)(ws + WS_KVRAW), 2048}; }
            pg8::StaticOrder S; S.init(g.M, g.N, G, obid());
            pg8::gemm_phase<pg8::EpiStore, pg8::StaticOrder, true, true>(lds, g, S, E);
        }
        else if (kind == K_GEMM_OUT) {
            pg8::Gemm g{(const bf16_t*)(ws + WS_H), (const bf16_t*)(ws + (isC ? WS_WOUTC : WS_WOUTAB)) + (size_t)j * 2048 * 2048, MROWS, 2048, 2048};
            pg8::EpiResid E{L == 0 ? a->in[0] : a->out, L == 0 ? a->in[1] : a->out + (size_t)MC * DM, a->out, (const float*)(ws + WS_MOD) + (size_t)L * 5 * 6144 + 4096};
            pg8::StaticOrder S; S.init(g.M, g.N, G, obid());
            pg8::gemm_phase<pg8::EpiResid, pg8::StaticOrder, true, true>(lds, g, S, E);
        }
        else if (kind == K_PREP_AB) phase_prep_ab(a, j);
        else if (kind == K_HN_AB) phase_hn_ab(a, j);
        else if (kind == K_FIN_AB) phase_fin_ab(a, j);
        else if (kind == K_HN_C) phase_hn_c(a, j);
        else if (kind == K_MIX_AB) {
            unsigned* ctr = ctl + 64 * step + 8 * rep;
            const bf16_t* P = (const bf16_t*)(ws + WS_PROJ); bf16_t* MIX = (bf16_t*)(ws + WS_H);
            const bf16_t* QF = (const bf16_t*)(ws + WS_QRAW); const bf16_t* KF = (const bf16_t*)(ws + WS_KF); const bf16_t* KV = (const bf16_t*)(ws + WS_KVRAW);
            for (;;) {
                const int idx = fetch_item(ctr, slot);
                if (idx >= 704) break;
                if (idx < 64 || (idx >= 320 && idx < 576)) {
                    const bool lat = idx < 64; const int i = lat ? idx : idx - 320; const int b = i >> 4, h = (i >> 1) & 7, dir = i & 1;
                    const float* lb = (const float*)(ws + WS_LB) + (j * 2 + dir) * 1024 + h * 128;
                    const float* s0 = lat ? a->in[4 + dir] + (size_t)((b * 2 + j) * 8 + h) * 16384 : nullptr;
                    float* so = lat ? nullptr : a->out + (dir ? O_SB : O_SF) + (size_t)((b * 2 + j) * 8 + h) * 16384;
                    if (PROBE_SEL != 1 || rep == 0) hgrn_item(lds, P, lat ? MC + b * 2048 : b * 256, lat ? 2048 : 256, h, dir, lb, s0, so, (bf16_t*)(ws + (dir ? WS_OB : WS_OF)));
                } else {
                    att::Item it;
                    const bool lat = idx < 320; int b, h, r0;
                    if (lat) { const int i = idx - 64; b = i >> 6; h = (i >> 3) & 7; const int qb = i & 7; r0 = MC + b * 2048 + qb * 256;
                        it.K0 = KF + (size_t)(MROWS + b * 256) * 1536 + h * 192; it.V0 = KV + (size_t)(MROWS + b * 256) * 2048 + h * 256 + 128; it.n0 = 4;
                        it.K1 = KF + (size_t)(MC + b * 2048) * 1536 + h * 192; it.V1 = KV + (size_t)(MC + b * 2048) * 2048 + h * 256 + 128; it.t_lo = 0; it.t_hi = 32; }
                    else { const int i = idx - 576; b = i >> 3; h = i & 7; r0 = b * 256;
                        it.K0 = KF; it.V0 = KV; it.n0 = 0;
                        it.K1 = KF + (size_t)r0 * 1536 + h * 192; it.V1 = KV + (size_t)r0 * 2048 + h * 256 + 128; it.t_lo = 0; it.t_hi = 4; }
                    it.ldk = 1536; it.ldv = 2048;
                    it.Q = QF + (size_t)r0 * 1536 + h * 192; it.ldq = 1536; it.q0 = 0; it.band = 0; it.m0 = -1e30f; it.l0 = 0.f;
                    it.G = P + (size_t)r0 * LDP_AB + COL_AG + h * 128; it.ldg = LDP_AB; it.O = MIX + (size_t)r0 * DM + h * 128; it.ldo = DM;
                    if (PROBE_SEL != 2 || rep == 0) att::attn_item<192>(lds, it);
                }
            }
        }
        else if (kind == K_ATTN_C) {
            unsigned* ctr = ctl + 64 * step + 8 * rep;
            const bf16_t* P = (const bf16_t*)(ws + WS_PROJ); bf16_t* MIX = (bf16_t*)(ws + WS_H);
            const bf16_t* KCC = (const bf16_t*)(ws + WS_KCC);
            for (;;) {
                const int idx = fetch_item(ctr, slot);
                if (idx >= 768) break;
                att::Item it; int b, h, r0;
                if (idx < 512) { b = idx >> 7; h = (idx >> 3) & 15; const int qb = idx & 7; r0 = MC + b * 2048 + qb * 256; const int kvh = h >> 2;
                    it.K0 = KCC + (size_t)((b * 2 + j) * 256) * LDP_C + kvh * 128; it.V0 = KCC + (size_t)((b * 2 + j) * 256) * LDP_C + 512 + kvh * 128; it.n0 = 4;
                    it.K1 = P + (size_t)(MC + b * 2048) * LDP_C + 2048 + kvh * 128; it.V1 = P + (size_t)(MC + b * 2048) * LDP_C + 2560 + kvh * 128;
                    it.t_lo = 4 * qb - 2 < 0 ? 0 : 4 * qb - 2; it.t_hi = 4 * qb + 6 > 32 ? 32 : 4 * qb + 6; it.q0 = qb * 256; it.band = 1; }
                else { const int i = idx - 512; b = i >> 4; h = i & 15; r0 = b * 256; const int kvh = h >> 2;
                    it.K0 = KCC; it.V0 = KCC; it.n0 = 0;
                    it.K1 = P + (size_t)r0 * LDP_C + 2048 + kvh * 128; it.V1 = P + (size_t)r0 * LDP_C + 2560 + kvh * 128; it.t_lo = 0; it.t_hi = 4; it.q0 = 0; it.band = 0; }
                it.ldk = LDP_C; it.ldv = LDP_C;
                it.Q = P + (size_t)r0 * LDP_C + h * 128; it.ldq = LDP_C; it.m0 = a->in[29][j * 16 + h] * LOG2E; it.l0 = 1.f;
                it.G = P + (size_t)r0 * LDP_C + 3072 + h * 128; it.ldg = LDP_C; it.O = MIX + (size_t)r0 * DM + h * 128; it.ldo = DM;
                att::attn_item<128>(lds, it);
            }
        }
        if (rep + 1 < nrep) xcd_barrier(xbar);
        }
        if (sync_after) { if (step == 0) grid.sync(); else xcd_barrier(xbar); }
    }
}

extern "C" void kernel_launch(void* const* d_in, const int* in_sizes, int n_in, void* d_out, int out_size, void* d_ws, size_t ws_size, hipStream_t stream) {
    static int grid = 0;
    if (grid == 0) {
        if (n_in != 31 || ws_size < WS_END) { fprintf(stderr, "kernel_launch: unexpected n_in %d or ws_size %zu (< %zu)\n", n_in, ws_size, (size_t)WS_END); grid = -1; return; }
        int dev = 0, cus = 0, per_cu = 0;
        hipGetDevice(&dev); hipDeviceGetAttribute(&cus, hipDeviceAttributeMultiprocessorCount, dev);
        if (hipFuncSetAttribute((const void*)mk_fwd, hipFuncAttributeMaxDynamicSharedMemorySize, LDS_BYTES) != hipSuccess) { fprintf(stderr, "kernel_launch: hipFuncSetAttribute failed\n"); grid = -1; return; }
        if (hipOccupancyMaxActiveBlocksPerMultiprocessor(&per_cu, (const void*)mk_fwd, NTHR, LDS_BYTES) != hipSuccess || per_cu < 1) per_cu = 1;
        (void)hipGetLastError();
        grid = cus > 0 ? cus : 256;
    }
    if (grid < 0) return;
    hipMemsetAsync((char*)d_ws + WS_CTL, 0, CTL_BYTES, stream);
    Args a{};
    for (int i = 0; i < 31; ++i) a.in[i] = (const float*)d_in[i];
    a.out = (float*)d_out; a.ws = (unsigned char*)d_ws;
    void* args[] = {&a};
    hipError_t e = hipLaunchCooperativeKernel((const void*)mk_fwd, dim3(grid), dim3(NTHR), args, LDS_BYTES, stream);
    if (e != hipSuccess) fprintf(stderr, "cooperative launch failed: %s (grid %d)\n", hipGetErrorString(e), grid);
}
```

```cpp
#include <hip/hip_runtime.h>
#include <hip/hip_cooperative_groups.h>
#include <cstdio>
#include <cstdint>
namespace cg = cooperative_groups;

namespace pg8 {
#define PG8_LAS __attribute__((address_space(3)))
typedef unsigned short bf16_t;
typedef short bf16x8 __attribute__((ext_vector_type(8)));
typedef float f32x4 __attribute__((ext_vector_type(4)));
typedef unsigned u32x4 __attribute__((ext_vector_type(4)));
constexpr int BM = 256, BK = 64, HALF = 128, HTB = HALF * BK * 2  , STAGE_BYTES = 8 * HTB, NXCD = 8, WGM = 8;
__device__ __forceinline__ int pg8_otid() { int t = threadIdx.x; asm volatile("" : "+v"(t)); return t; }

__host__ __device__ __forceinline__ int lds_byte(int r, int c) { const int st = (r >> 4) * 2 + (c >> 5), rr = r & 15, cc = c & 31, ob = rr * 64 + cc * 2; return st * 1024 + (ob ^ (((ob >> 9) & 1) << 5)); }
__host__ __device__ __forceinline__ void stage_rc(int b, int& R, int& C) { const int st = b / 1024, sb = b % 1024, swz = sb ^ (((sb >> 9) & 1) << 5); R = (st >> 1) * 16 + swz / 64; C = (st & 1) * 32 + (swz % 64) / 2; }
__host__ __device__ __forceinline__ int perm32(int rho) { const int n = rho >> 4, i = rho & 15; return 8 * (i >> 2) + 4 * n + (i & 3); }

struct Unit { int pm, pn; };
struct Gemm { const bf16_t* A; const bf16_t* Bt; int M, N, K; };

struct StaticOrder {
    int nM, nN, nwg, G, c;
    __host__ __device__ void init(int M, int N, int G_, int c_) { nM = M / BM; nN = N / BM; nwg = nM * nN; G = G_; c = c_; }
    __host__ __device__ bool next(int i, Unit& u) const {
        const long L = (long)i * G + c; if (L >= nwg) return false;
        int wgid = (int)L; { const int q = nwg / NXCD, r = nwg % NXCD, xcd = wgid % NXCD, off = wgid / NXCD; wgid = (xcd < r ? xcd * (q + 1) : r * (q + 1) + (xcd - r) * q) + off; }
        const int nig = WGM * nN, gid = wgid / nig, fm = gid * WGM, gsz = (nM - fm) < WGM ? (nM - fm) : WGM;
        u.pm = fm + ((wgid % nig) % gsz); u.pn = (wgid % nig) / gsz; return true;
    }
    __device__ __forceinline__ void a_ready(const Unit&) const {}
    __device__ __forceinline__ void done(const Unit&) const {}
};

typedef float f32x2c __attribute__((ext_vector_type(2)));
typedef __bf16 bf16x2c __attribute__((ext_vector_type(2)));
__device__ __forceinline__ unsigned cvt_pk_bf16(float lo, float hi) { const f32x2c v = {lo, hi}; const bf16x2c b = __builtin_convertvector(v, bf16x2c); return __builtin_bit_cast(unsigned, b); }

struct EpiStore {
    static constexpr bool PERM = true, AFTER_DRAIN = false;
    bf16_t* O; int ldc;
    __device__ __forceinline__ void operator()(const f32x4 (&acc)[2][2][4][2], const Unit& u, int wr, int wc, int fr, int fq) const {
        const int row0 = u.pm * BM + wr * 64 + fr; const int col0 = u.pn * BM + wc * 32 + 8 * fq;
#pragma unroll
        for (int ai = 0; ai < 2; ++ai)
#pragma unroll
            for (int m = 0; m < 4; ++m) { bf16_t* rowp = O + (size_t)(row0 + ai * HALF + m * 16) * ldc + col0;
#pragma unroll
                for (int bj = 0; bj < 2; ++bj) { const f32x4 v0 = acc[ai][bj][m][0], v1 = acc[ai][bj][m][1];
                    u32x4 w; w.x = cvt_pk_bf16(v0[0], v0[1]); w.y = cvt_pk_bf16(v0[2], v0[3]); w.z = cvt_pk_bf16(v1[0], v1[1]); w.w = cvt_pk_bf16(v1[2], v1[3]);
                    *(u32x4*)(rowp + bj * HALF) = w; } }
    }
};
struct EpiResid {
    static constexpr bool PERM = true, AFTER_DRAIN = false;
    const float* xin_ctx; const float* xin_lat; float* out; const float* gate_base;
    __device__ __forceinline__ void operator()(const f32x4 (&acc)[2][2][4][2], const Unit& u, int wr, int wc, int fr, int fq) const {
        const int pm = u.pm;
        const float* xin = pm < 16 ? xin_ctx + (size_t)pm * 256 * 2048 : xin_lat + (size_t)(pm - 16) * 256 * 2048;
        float* xo = out + (size_t)pm * 256 * 2048;
        const int ci = pm < 16 ? 4 : ((pm - 16) >> 3);
        const float* gt = gate_base + ci * 6144;
        const int rl0 = wr * 64 + fr, col0 = u.pn * BM + wc * 32 + 8 * fq;
        f32x4 g0[2], g1[2];
#pragma unroll
        for (int bj = 0; bj < 2; ++bj) { g0[bj] = *(const f32x4*)(gt + col0 + bj * HALF); g1[bj] = *(const f32x4*)(gt + col0 + bj * HALF + 4); }
#pragma unroll
        for (int ai = 0; ai < 2; ++ai)
#pragma unroll
            for (int m = 0; m < 4; ++m) { const size_t off = (size_t)(rl0 + ai * HALF + m * 16) * 2048 + col0;
#pragma unroll
                for (int bj = 0; bj < 2; ++bj) {
                    const f32x4 x0 = *(const f32x4*)(xin + off + bj * HALF), x1 = *(const f32x4*)(xin + off + bj * HALF + 4);
                    *(f32x4*)(xo + off + bj * HALF) = x0 + g0[bj] * acc[ai][bj][m][0];
                    *(f32x4*)(xo + off + bj * HALF + 4) = x1 + g1[bj] * acc[ai][bj][m][1]; }
                asm volatile("" ::: "memory"); }
    }
};

template <class Epi, class Sched, bool ALIGN_EPI = false, bool SP2 = false>
__device__ __forceinline__ void gemm_phase(PG8_LAS unsigned char* lds, const Gemm g, const Sched& S, const Epi& E) {
    const int tid = pg8_otid(), wid = __builtin_amdgcn_readfirstlane(tid >> 6), lane = tid & 63, wr = wid >> 2, wc = wid & 3, fr = lane & 15, fq = lane >> 4;
    const int K = g.K, nt = K / BK;
    unsigned voffA[2], voffB[2];
#pragma unroll
    for (int i = 0; i < 2; ++i) { int R, C; stage_rc(tid * 16 + i * 8192, R, C); const int Rb = Epi::PERM ? ((R & ~31) + perm32(R & 31)) : R;
        voffA[i] = (unsigned)(R * K + C) * 2u; voffB[i] = (unsigned)(Rb * K + C) * 2u; }
    const size_t kstep = (size_t)(BK * 2);
    const size_t hstep = (size_t)HALF * K * 2;
    const size_t tstep = 2 * hstep;
    const unsigned ldsw = (unsigned)wid * 1024u;
    const int aoff = lds_byte(wr * 64 + fr, fq * 8), boff = lds_byte(wc * 32 + fr, fq * 8);
#define PG8_SA(b, h) (((b) * 2 + (h)) * HTB)
#define PG8_SB(b, h) ((4 + (b) * 2 + (h)) * HTB)
#define PG8_STAGE(bufoff, gbase, voff) do { _Pragma("unroll") for (int _i = 0; _i < 2; ++_i) \
        __builtin_amdgcn_global_load_lds((const unsigned*)((const char*)(gbase) + (voff)[_i]), (PG8_LAS unsigned*)(lds + (bufoff) + ldsw + _i * 8192), 16, 0, 0); } while (0)
#define PG8_LDA(dst, b, h) do { _Pragma("unroll") for (int m = 0; m < 4; ++m) _Pragma("unroll") for (int k = 0; k < 2; ++k) dst[m][k] = *(const PG8_LAS bf16x8*)(lds + PG8_SA(b, h) + aoff + m * 2048 + k * 1024); } while (0)
#define PG8_LDB(dst, b, h) do { _Pragma("unroll") for (int n = 0; n < 2; ++n) _Pragma("unroll") for (int k = 0; k < 2; ++k) dst[n][k] = *(const PG8_LAS bf16x8*)(lds + PG8_SB(b, h) + boff + n * 2048 + k * 1024); } while (0)
#define PG8_MMA(ai, bj, At, Bt) do { __builtin_amdgcn_s_setprio(1); _Pragma("unroll") for (int m = 0; m < 4; ++m) _Pragma("unroll") for (int n = 0; n < 2; ++n) _Pragma("unroll") for (int k = 0; k < 2; ++k) \
        acc[ai][bj][m][n] = __builtin_amdgcn_mfma_f32_16x16x32_bf16(Bt[n][k], At[m][k], acc[ai][bj][m][n], 0, 0, 0); __builtin_amdgcn_s_setprio(0); } while (0)
#define PG8_WAIT_V(n) asm volatile("s_waitcnt vmcnt(" #n ")" ::: "memory")
#define PG8_WAIT_L(n) asm volatile("s_waitcnt lgkmcnt(" #n ")" ::: "memory")
#define PG8_BAR __builtin_amdgcn_s_barrier()
#define PG8_SCHED __builtin_amdgcn_sched_barrier(0)
    Unit cur, nxt; int ui = 0;
    if (!S.next(0, cur)) return;
    f32x4 acc[2][2][4][2];
#pragma unroll
    for (int a = 0; a < 2; ++a)
#pragma unroll
        for (int b = 0; b < 2; ++b)
#pragma unroll
            for (int m = 0; m < 4; ++m)
#pragma unroll
                for (int n = 0; n < 2; ++n) acc[a][b][m][n] = (f32x4){0.f, 0.f, 0.f, 0.f};
    bf16x8 At[4][2], B0[2][2], B1[2][2];
    const char* cA = (const char*)g.A + (size_t)cur.pm * tstep; const char* cB = (const char*)g.Bt + (size_t)cur.pn * tstep;
    S.a_ready(cur);
    if constexpr (SP2) {
        PG8_STAGE(PG8_SB(0, 0), cB, voffB); PG8_STAGE(PG8_SB(0, 1), cB + hstep, voffB); PG8_STAGE(PG8_SA(0, 0), cA, voffA); PG8_STAGE(PG8_SA(0, 1), cA + hstep, voffA);
        if (wr == 1) PG8_BAR;
        PG8_WAIT_V(2); PG8_BAR;
        PG8_STAGE(PG8_SB(1, 0), cB + kstep, voffB); PG8_STAGE(PG8_SA(1, 0), cA + kstep, voffA); PG8_STAGE(PG8_SB(1, 1), cB + hstep + kstep, voffB);
        PG8_WAIT_V(6); PG8_BAR;
    } else {
        PG8_STAGE(PG8_SB(0, 0), cB, voffB); PG8_STAGE(PG8_SA(0, 0), cA, voffA); PG8_STAGE(PG8_SB(0, 1), cB + hstep, voffB); PG8_STAGE(PG8_SA(0, 1), cA + hstep, voffA);
        if (wr == 1) PG8_BAR;
        PG8_WAIT_V(4); PG8_BAR;
        PG8_STAGE(PG8_SB(1, 0), cB + kstep, voffB); PG8_STAGE(PG8_SA(1, 0), cA + kstep, voffA); PG8_STAGE(PG8_SB(1, 1), cB + hstep + kstep, voffB);
        PG8_WAIT_V(6); PG8_BAR;
    }
    for (;;) {
        const bool has_next = S.next(ui + 1, nxt);
        const char* nA = has_next ? (const char*)g.A + (size_t)nxt.pm * tstep : cA; const char* nB = has_next ? (const char*)g.Bt + (size_t)nxt.pn * tstep : cB;
        for (int t = 0; t < nt; t += 2) {
            const bool last = (t == nt - 2);
            const char* a1 = cA + (size_t)(t + 1) * kstep;
            const char* a2 = last ? nA : cA + (size_t)(t + 2) * kstep; const char* b2 = last ? nB : cB + (size_t)(t + 2) * kstep;
            const char* a3 = a2 + kstep; const char* b3 = b2 + kstep;
            if (last && has_next) S.a_ready(nxt);
            if constexpr (SP2) {
            PG8_LDB(B0, 0, 0); PG8_LDB(B1, 0, 1); PG8_SCHED; PG8_LDA(At, 0, 0); PG8_STAGE(PG8_SA(1, 1), a1 + hstep, voffA);
            PG8_WAIT_V(8); PG8_WAIT_L(0); PG8_BAR; PG8_MMA(0, 0, At, B0); PG8_MMA(0, 1, At, B1); PG8_BAR; PG8_SCHED;
            PG8_LDA(At, 0, 1); PG8_STAGE(PG8_SB(0, 0), b2, voffB); PG8_STAGE(PG8_SB(0, 1), b2 + hstep, voffB); PG8_STAGE(PG8_SA(0, 0), a2, voffA);
            PG8_WAIT_V(8); PG8_WAIT_L(0); PG8_BAR; PG8_MMA(1, 0, At, B0); PG8_MMA(1, 1, At, B1); PG8_BAR; PG8_SCHED;
            PG8_LDB(B0, 1, 0); PG8_LDB(B1, 1, 1); PG8_SCHED; PG8_LDA(At, 1, 0); PG8_STAGE(PG8_SA(0, 1), a2 + hstep, voffA);
            PG8_WAIT_V(8); PG8_WAIT_L(0); PG8_BAR; PG8_MMA(0, 0, At, B0); PG8_MMA(0, 1, At, B1); PG8_BAR; PG8_SCHED;
            PG8_LDA(At, 1, 1); PG8_STAGE(PG8_SB(1, 0), b3, voffB); PG8_STAGE(PG8_SB(1, 1), b3 + hstep, voffB); PG8_STAGE(PG8_SA(1, 0), a3, voffA);
            PG8_WAIT_V(8); PG8_WAIT_L(0); PG8_BAR; PG8_MMA(1, 0, At, B0); PG8_MMA(1, 1, At, B1); PG8_BAR; PG8_SCHED;
            } else {
            PG8_LDB(B0, 0, 0); PG8_SCHED; PG8_LDA(At, 0, 0); PG8_STAGE(PG8_SA(1, 1), a1 + hstep, voffA);
            PG8_WAIT_L(8); PG8_BAR; PG8_WAIT_L(0); PG8_MMA(0, 0, At, B0); PG8_BAR; PG8_SCHED;
            PG8_LDB(B1, 0, 1); PG8_STAGE(PG8_SB(0, 0), b2, voffB);
            PG8_BAR; PG8_WAIT_L(0); PG8_MMA(0, 1, At, B1); PG8_BAR;
            PG8_LDA(At, 0, 1); PG8_STAGE(PG8_SA(0, 0), a2, voffA);
            PG8_BAR; PG8_WAIT_L(0); PG8_MMA(1, 0, At, B0); PG8_BAR; PG8_SCHED;
            PG8_STAGE(PG8_SB(0, 1), b2 + hstep, voffB);
            PG8_WAIT_V(6); PG8_BAR; PG8_MMA(1, 1, At, B1); PG8_BAR;
            PG8_LDB(B0, 1, 0); PG8_SCHED; PG8_LDA(At, 1, 0); PG8_STAGE(PG8_SA(0, 1), a2 + hstep, voffA);
            PG8_WAIT_L(8); PG8_BAR; PG8_WAIT_L(0); PG8_MMA(0, 0, At, B0); PG8_BAR; PG8_SCHED;
            PG8_LDB(B1, 1, 1); PG8_STAGE(PG8_SB(1, 0), b3, voffB);
            PG8_BAR; PG8_WAIT_L(0); PG8_MMA(0, 1, At, B1); PG8_BAR;
            PG8_LDA(At, 1, 1); PG8_STAGE(PG8_SA(1, 0), a3, voffA);
            PG8_BAR; PG8_WAIT_L(0); PG8_MMA(1, 0, At, B0); PG8_BAR; PG8_SCHED;
            PG8_STAGE(PG8_SB(1, 1), b3 + hstep, voffB);
            PG8_WAIT_V(6); PG8_BAR; PG8_MMA(1, 1, At, B1); PG8_BAR;
            }
        }
        if constexpr (ALIGN_EPI) { if (wr == 0) PG8_BAR; }
        if constexpr (!Epi::AFTER_DRAIN) { E(acc, cur, wr, wc, fr, fq); S.done(cur); }
        if (!has_next) break;
#pragma unroll
        for (int a = 0; a < 2; ++a)
#pragma unroll
            for (int b = 0; b < 2; ++b)
#pragma unroll
                for (int m = 0; m < 4; ++m)
#pragma unroll
                    for (int n = 0; n < 2; ++n) acc[a][b][m][n] = (f32x4){0.f, 0.f, 0.f, 0.f};
        cur = nxt; cA = nA; cB = nB; ++ui;
        if constexpr (ALIGN_EPI) { if (wr == 1) PG8_BAR; }
    }
    PG8_WAIT_V(0);
    if constexpr (!ALIGN_EPI) { if (wr == 0) PG8_BAR; }
    PG8_BAR;
    if constexpr (Epi::AFTER_DRAIN) { E.fused(acc, cur, wr, wc, fr, fq, lds, wid, lane); S.done(cur); }
#undef PG8_SA
#undef PG8_SB
#undef PG8_STAGE
#undef PG8_LDA
#undef PG8_LDB
#undef PG8_MMA
#undef PG8_WAIT_V
#undef PG8_WAIT_L
#undef PG8_BAR
#undef PG8_SCHED
}
}

#define LAS __attribute__((address_space(3)))
typedef unsigned short bf16_t;
typedef short bf16x8 __attribute__((ext_vector_type(8)));
typedef short s16x4 __attribute__((ext_vector_type(4)));
typedef float f32x4 __attribute__((ext_vector_type(4)));
typedef float f32x16 __attribute__((ext_vector_type(16)));
typedef unsigned u32x4 __attribute__((ext_vector_type(4)));
typedef unsigned u32x2 __attribute__((ext_vector_type(2)));


__device__ __forceinline__ int otid() { int t = threadIdx.x; asm volatile("" : "+v"(t)); return t; }
__device__ __forceinline__ int obid() { int b = blockIdx.x; asm volatile("" : "+s"(b)); return b; }
constexpr int NWAVES = 8, NTHR = 512;
constexpr int DM = 2048, MC = 4096, ML = 8192, MROWS = 12288, MKROWS = 13312;
constexpr int LDP_AB = 7168, LDP_C = 5120;
constexpr int COL_QL = 0, COL_KVL = 512, COL_AG = 768, COL_BQ = 1792, COL_FF = 2816, COL_FB = 3840, COL_BI = 4864, COL_BG = 5888, COL_KPE = 6912;
constexpr float EPSN = 1e-6f;
constexpr float LOG2E = 1.4426950408889634f;
constexpr float QSC_A = 0.07216878364870322f * LOG2E;
constexpr float QSC_C = 0.08838834764831845f * LOG2E;

constexpr size_t O_YP = 0, O_YS = 8388608, O_CKV = 25165824, O_KPE = 27262976, O_SF = 27787264, O_SB = 31981568, O_KC = 36175872, O_VC = 40370176;

constexpr size_t MiB = 1u << 20;
constexpr size_t WS_CTL = 0, CTL_BYTES = 65536;
constexpr size_t WS_MOD = 1 * MiB, WS_LB = WS_MOD + 512 * 1024, WS_ROPEA = WS_LB + 64 * 1024, WS_ROPEC = WS_ROPEA + 512 * 1024;
constexpr size_t WS_KCC = 532 * MiB;
constexpr size_t WS_WINAB = 8 * MiB, WS_WQUP = 64 * MiB, WS_WKVUP = 67 * MiB, WS_WOUTAB = 69 * MiB, WS_WINC = 85 * MiB, WS_WOUTC = 125 * MiB;
constexpr size_t WS_H = 141 * MiB, WS_PROJ = 189 * MiB, WS_QRAW = 357 * MiB, WS_KVRAW = 393 * MiB, WS_KF = 445 * MiB, WS_OF = 484 * MiB, WS_OB = 508 * MiB;
constexpr size_t WS_QN = WS_OF, WS_CKV = WS_OF + 12 * MiB, WS_END = 552 * MiB;

constexpr int LDS_PHASE = 131072, LDS_BYTES = LDS_PHASE + 1024;

__device__ __forceinline__ float bf2f(unsigned short b) { return __uint_as_float((unsigned)b << 16); }
typedef float f32x2_t __attribute__((ext_vector_type(2)));
typedef __bf16 bf16x2_t __attribute__((ext_vector_type(2)));
__device__ __forceinline__ unsigned pk2(float lo, float hi) { const f32x2_t v = {lo, hi}; const bf16x2_t b = __builtin_convertvector(v, bf16x2_t); return __builtin_bit_cast(unsigned, b); }
__device__ __forceinline__ unsigned f2bf(float f) { return pk2(f, 0.f) & 0xffffu; }
__device__ __forceinline__ float silu_f(float x) { return x * __builtin_amdgcn_rcpf(1.f + __expf(-x)); }
__device__ __forceinline__ float wave_sum(float v) {
#pragma unroll
    for (int o = 1; o < 64; o <<= 1) v += __shfl_xor(v, o);
    return v;
}
__device__ __forceinline__ float sum16(float v) {
    v += __shfl_xor(v, 1); v += __shfl_xor(v, 2); v += __shfl_xor(v, 4); v += __shfl_xor(v, 8); return v;
}
__device__ __forceinline__ bf16x8 pack8(const float* v) {
    u32x4 w; w.x = pk2(v[0], v[1]); w.y = pk2(v[2], v[3]); w.z = pk2(v[4], v[5]); w.w = pk2(v[6], v[7]); return __builtin_bit_cast(bf16x8, w);
}

struct Args { const float* in[31]; float* out; unsigned char* ws; };
typedef const Args __attribute__((address_space(4)))* KArgs;

struct P0Item { const float* W; bf16_t* WT; int K, N, k0, n0, d0; };
__device__ __forceinline__ void p0_load(const P0Item& q, float (&v)[32], int lane) {
#pragma unroll
    for (int i = 0; i < 32; ++i) { const int kk = 2 * i + (lane >> 5); v[i] = q.W[(size_t)(q.k0 + kk) * q.N + q.n0 + (lane & 31)]; }
}
__device__ __forceinline__ void p0_emit(const P0Item& q, const float (&v)[32], LAS float* scr, int lane) {
#pragma unroll
    for (int i = 0; i < 32; ++i) { const int kk = 2 * i + (lane >> 5); scr[kk * 33 + (lane & 31)] = v[i]; }
    asm volatile("s_waitcnt lgkmcnt(0)" ::: "memory");
    const int c = lane & 7;
#pragma unroll
    for (int j = 0; j < 4; ++j) { const int n = (lane >> 3) + 8 * j; const LAS float* s = scr + (8 * c) * 33 + n;
        u32x4 o; o.x = pk2(s[0 * 33], s[1 * 33]); o.y = pk2(s[2 * 33], s[3 * 33]); o.z = pk2(s[4 * 33], s[5 * 33]); o.w = pk2(s[6 * 33], s[7 * 33]);
        *(u32x4*)(q.WT + (size_t)(q.d0 + n) * q.K + q.k0 + 8 * c) = o; }
    asm volatile("s_waitcnt lgkmcnt(0)" ::: "memory");
}
__device__ __forceinline__ P0Item p0_decode(KArgs a, int it) {
    constexpr int I_INAB = 32 * 218, I_QUP = 8 * 48, I_KVUP = 4 * 64, I_OUT = 32 * 64, I_INC = 32 * 160;
    constexpr int PER_J = I_INAB + I_QUP + I_KVUP + I_OUT + I_INC + I_OUT;
    unsigned char* ws = a->ws; P0Item q;
    const int j = it / PER_J; int r = it % PER_J;
    if (r < I_INAB) { const int kb = r / 218, nb = r % 218, n0 = nb * 32;
        q.W = a->in[13] + (size_t)j * 2048 * 6976; q.WT = (bf16_t*)(ws + WS_WINAB) + (size_t)j * 7168 * 2048; q.K = 2048; q.N = 6976; q.k0 = kb * 64; q.n0 = n0; q.d0 = n0 < 768 ? n0 : (n0 < 832 ? n0 + 6144 : n0 - 64); return q; }
    r -= I_INAB;
    if (r < I_QUP) { const int kb = r / 48, nb = r % 48;
        q.W = a->in[16] + (size_t)j * 512 * 1536; q.WT = (bf16_t*)(ws + WS_WQUP) + (size_t)j * 1536 * 512; q.K = 512; q.N = 1536; q.k0 = kb * 64; q.n0 = nb * 32; q.d0 = nb * 32; return q; }
    r -= I_QUP;
    if (r < I_KVUP) { const int kb = r / 64, nb = r % 64;
        q.W = a->in[17] + (size_t)j * 256 * 2048; q.WT = (bf16_t*)(ws + WS_WKVUP) + (size_t)j * 2048 * 256; q.K = 256; q.N = 2048; q.k0 = kb * 64; q.n0 = nb * 32; q.d0 = nb * 32; return q; }
    r -= I_KVUP;
    if (r < I_OUT) { const int kb = r / 64, nb = r % 64;
        q.W = a->in[22] + (size_t)j * 2048 * 2048; q.WT = (bf16_t*)(ws + WS_WOUTAB) + (size_t)j * 2048 * 2048; q.K = 2048; q.N = 2048; q.k0 = kb * 64; q.n0 = nb * 32; q.d0 = nb * 32; return q; }
    r -= I_OUT;
    if (r < I_INC) { const int kb = r / 160, nb = r % 160;
        q.W = a->in[26] + (size_t)j * 2048 * 5120; q.WT = (bf16_t*)(ws + WS_WINC) + (size_t)j * 5120 * 2048; q.K = 2048; q.N = 5120; q.k0 = kb * 64; q.n0 = nb * 32; q.d0 = nb * 32; return q; }
    r -= I_INC;
    { const int kb = r / 64, nb = r % 64;
        q.W = a->in[30] + (size_t)j * 2048 * 2048; q.WT = (bf16_t*)(ws + WS_WOUTC) + (size_t)j * 2048 * 2048; q.K = 2048; q.N = 2048; q.k0 = kb * 64; q.n0 = nb * 32; q.d0 = nb * 32; return q; }
}

__device__ __forceinline__ void phase_p0(KArgs a, LAS unsigned char* lds) {
    const int tid = otid(), lane = tid & 63, wave = tid >> 6;
    const int G = gridDim.x, bid = obid();
    const int gw = bid * NWAVES + wave, NGW = G * NWAVES;
    unsigned char* ws = a->ws;
    {
        LAS float* scr = (LAS float*)(lds + wave * 8448);
        constexpr int TOTAL = 2 * (32 * 218 + 8 * 48 + 4 * 64 + 32 * 64 + 32 * 160 + 32 * 64);
        for (int it = gw; it < TOTAL; it += 2 * NGW) {
            const bool two = it + NGW < TOTAL;
            const P0Item qa = p0_decode(a, it); const P0Item qb = p0_decode(a, two ? it + NGW : it);
            float va[32], vb[32];
            p0_load(qa, va, lane); if (two) p0_load(qb, vb, lane);
            p0_emit(qa, va, scr, lane); if (two) p0_emit(qb, vb, scr, lane);
        }
    }
    const int gt = bid * NTHR + tid, NGT = G * NTHR;
    for (int i = gt; i < 2 * 192 * 256; i += NGT) { const int j = i / (192 * 256), r = i % (192 * 256);
        *(u32x4*)((bf16_t*)(ws + WS_WINAB) + (size_t)j * 7168 * 2048 + (size_t)6976 * 2048 + (size_t)r * 8) = (u32x4){0u, 0u, 0u, 0u}; }
    for (int i = gt; i < 2 * 131072; i += NGT) { const int which = i / 131072, e = (i % 131072) * 8;
        const float* src = a->in[6 + which] + e; const f32x4 x0 = *(const f32x4*)src, x1 = *(const f32x4*)(src + 4);
        u32x4 w; w.x = pk2(x0[0], x0[1]); w.y = pk2(x0[2], x0[3]); w.z = pk2(x1[0], x1[1]); w.w = pk2(x1[2], x1[3]);
        *(u32x4*)((bf16_t*)(ws + WS_KCC) + (size_t)(e >> 9) * LDP_C + (which ? 512 : 0) + (e & 511)) = w; }
    for (int i = gt; i < 2 * 2048; i += NGT) { const int j = i / 2048, r = i % 2048; const float l0 = a->in[20][r], l1 = a->in[20][2048 + r];
        ((float*)(ws + WS_LB))[i] = j == 0 ? 0.f : 1.f / (1.f + __expf(l0 - l1)); }
    for (int i = gt; i < 2048 * 32; i += NGT) { const int t = i >> 5, f = i & 31; const float pos = f < 16 ? (float)(t >> 6) : (float)(t & 63);
        const float inv = exp2f(-(float)(f & 15) * (13.287712379549449f / 16.f)); const float ang = pos * inv;
        ((float*)(ws + WS_ROPEA))[2 * i] = __cosf(ang); ((float*)(ws + WS_ROPEA))[2 * i + 1] = __sinf(ang); }
    for (int i = gt; i < 2048 * 64; i += NGT) { const int t = i >> 6, f = i & 63; const float pos = f < 32 ? (float)(t >> 6) : (float)(t & 63);
        const float inv = exp2f(-(float)(f & 31) * (13.287712379549449f / 32.f)); const float ang = pos * inv;
        ((float*)(ws + WS_ROPEC))[2 * i] = __cosf(ang); ((float*)(ws + WS_ROPEC))[2 * i + 1] = __sinf(ang); }
    __syncthreads();
    {
        LAS float* SC = (LAS float*)lds;
        LAS float* RED = (LAS float*)(lds + 40960);
        for (int i = tid; i < 5 * 2048; i += NTHR) { const int b = i >> 11, k = i & 2047; const float x = b < 4 ? a->in[8][b * 2048 + k] : a->in[9][k]; SC[i] = silu_f(x); }
        __syncthreads();
        const int cq = tid & 7, ks = tid >> 3;
        for (int u = bid; u < 768; u += G) {
            const int L = u / 192, col0 = (u % 192) * 32;
            const float* W = ((L & 1) ? a->in[23] : a->in[10]) + (size_t)(L >> 1) * 2048 * 6144;
            const float* bias = ((L & 1) ? a->in[24] : a->in[11]) + (size_t)(L >> 1) * 6144;
            f32x4 acc[5];
#pragma unroll
            for (int b = 0; b < 5; ++b) acc[b] = (f32x4){0.f, 0.f, 0.f, 0.f};
#pragma unroll 16
            for (int kk = 0; kk < 32; ++kk) { const int k = 32 * ks + kk; const f32x4 w = *(const f32x4*)(W + (size_t)k * 6144 + col0 + 4 * cq);
#pragma unroll
                for (int b = 0; b < 5; ++b) acc[b] += SC[b * 2048 + k] * w; }
#pragma unroll
            for (int b = 0; b < 5; ++b) *(LAS f32x4*)(RED + (ks * 5 + b) * 32 + 4 * cq) = acc[b];
            __syncthreads();
            if (tid < 160) { const int b = tid >> 5, c = tid & 31; float s = 0.f;
                for (int q = 0; q < 64; ++q) s += RED[(q * 5 + b) * 32 + c];
                ((float*)(ws + WS_MOD))[(L * 5 + b) * 6144 + col0 + c] = s + bias[col0 + c]; }
            __syncthreads();
        }
    }
}

__device__ __forceinline__ void phase_modnorm(KArgs a, int L) {
    const int tid = otid(), lane = tid & 63, wave = tid >> 6;
    const int gw = obid() * NWAVES + wave, NGW = gridDim.x * NWAVES;
    const float* g = ((L & 1) ? a->in[25] : a->in[12]) + (L >> 1) * 2048;
    bf16_t* H = (bf16_t*)(a->ws + WS_H);
    for (int r = gw; r < MROWS; r += NGW) {
        const float* x = L == 0 ? (r < MC ? a->in[0] + (size_t)r * DM : a->in[1] + (size_t)(r - MC) * DM) : a->out + (size_t)r * DM;
        const int ci = r < MC ? 4 : ((r - MC) >> 11);
        const float* md = (const float*)(a->ws + WS_MOD) + (L * 5 + ci) * 6144;
        f32x4 v[8]; float ss = 0.f;
#pragma unroll
        for (int j = 0; j < 8; ++j) { v[j] = *(const f32x4*)(x + 256 * j + 4 * lane); ss += (v[j][0] * v[j][0] + v[j][1] * v[j][1]) + (v[j][2] * v[j][2] + v[j][3] * v[j][3]); }
        const float rstd = rsqrtf(wave_sum(ss) * (1.f / 2048.f) + EPSN);
#pragma unroll
        for (int j = 0; j < 8; ++j) { const int c = 256 * j + 4 * lane;
            const f32x4 gg = *(const f32x4*)(g + c), sh = *(const f32x4*)(md + c), sc = *(const f32x4*)(md + 2048 + c);
            const f32x4 y = (v[j] * rstd * gg) * (sc + 1.f) + sh;
            u32x2 w; w.x = pk2(y[0], y[1]); w.y = pk2(y[2], y[3]);
            *(u32x2*)(H + (size_t)r * DM + c) = w; }
    }
}

__device__ __forceinline__ void phase_prep_ab(KArgs a, int j) {
    const int tid = otid(), lane = tid & 63, wave = tid >> 6;
    const int gw = obid() * NWAVES + wave, NGW = gridDim.x * NWAVES;
    const bf16_t* P = (const bf16_t*)(a->ws + WS_PROJ);
    bf16_t* QN = (bf16_t*)(a->ws + WS_QN); bf16_t* CKV = (bf16_t*)(a->ws + WS_CKV);
    const float* gq = a->in[14] + j * 512; const float* gkv = a->in[15] + j * 256;
    for (int r = gw; r < MKROWS; r += NGW) {
        if (r < MROWS) {
            const bf16_t* p = P + (size_t)r * LDP_AB;
            const bf16x8 q = *(const bf16x8*)(p + COL_QL + 8 * lane);
            float qv[8]; float ss = 0.f;
#pragma unroll
            for (int e = 0; e < 8; ++e) { qv[e] = bf2f((unsigned short)q[e]); ss += qv[e] * qv[e]; }
            const float rq = rsqrtf(wave_sum(ss) * (1.f / 512.f) + EPSN);
#pragma unroll
            for (int e = 0; e < 8; ++e) qv[e] = qv[e] * rq * gq[8 * lane + e];
            *(bf16x8*)(QN + (size_t)r * 512 + 8 * lane) = pack8(qv);
            const s16x4 kv = *(const s16x4*)(p + COL_KVL + 4 * lane);
            float kf[4]; float s2 = 0.f;
#pragma unroll
            for (int e = 0; e < 4; ++e) { kf[e] = bf2f((unsigned short)kv[e]); s2 += kf[e] * kf[e]; }
            const float rk = rsqrtf(wave_sum(s2) * (1.f / 256.f) + EPSN);
#pragma unroll
            for (int e = 0; e < 4; ++e) kf[e] = kf[e] * rk * gkv[4 * lane + e];
            u32x2 w; w.x = pk2(kf[0], kf[1]); w.y = pk2(kf[2], kf[3]);
            *(u32x2*)(CKV + (size_t)r * 256 + 4 * lane) = w;
            if (r < MC) { const int b = r >> 8, t = r & 255; const size_t rowo = (size_t)((b * 2 + j) * 256 + t);
                *(f32x4*)(a->out + O_CKV + rowo * 256 + 4 * lane) = (f32x4){kf[0], kf[1], kf[2], kf[3]};
                a->out[O_KPE + rowo * 64 + lane] = bf2f(p[COL_KPE + lane]); }
        } else {
            const int rr = r - MROWS, b = rr >> 8, t = rr & 255;
            const f32x4 x = *(const f32x4*)(a->in[2] + (size_t)((b * 2 + j) * 256 + t) * 256 + 4 * lane);
            u32x2 w; w.x = pk2(x[0], x[1]); w.y = pk2(x[2], x[3]);
            *(u32x2*)(CKV + (size_t)r * 256 + 4 * lane) = w;
        }
    }
}

__device__ __forceinline__ void phase_hn_ab(KArgs a, int j) {
    const int tid = otid(), lane = tid & 63, wave = tid >> 6, sub = lane & 15, hq = lane >> 4;
    const int gw = obid() * NWAVES + wave, NGW = gridDim.x * NWAVES;
    bf16_t* Q = (bf16_t*)(a->ws + WS_QRAW); const bf16_t* KV = (const bf16_t*)(a->ws + WS_KVRAW); bf16_t* KF = (bf16_t*)(a->ws + WS_KF);
    const bf16_t* P = (const bf16_t*)(a->ws + WS_PROJ);
    const float* RA = (const float*)(a->ws + WS_ROPEA);
    const float* gq = a->in[18] + j * 192; const float* gk = a->in[19] + j * 192;
    const float* ckpe = a->in[3];
    constexpr int U = 4;
    const int NQ = 0, NIT = MKROWS * 2;
    for (int base = gw * U; base < NIT; base += NGW * U) {
        bf16x8 vn[U]; float x1[U][2], x2[U][2]; f32x4 cs[U];
#pragma unroll
        for (int u = 0; u < U; ++u) { const int it = base + u; if (it < NIT) {
            const bool isq = it < NQ; const int w = isq ? it : it - NQ; const int r = w >> 1, h = (w & 1) * 4 + hq;
            if (isq) { const bf16_t* p = Q + (size_t)r * 1536 + h * 192;
                vn[u] = *(const bf16x8*)(p + 8 * sub); const unsigned a1 = *(const unsigned*)(p + 128 + 2 * sub), a2 = *(const unsigned*)(p + 160 + 2 * sub);
                x1[u][0] = bf2f(a1 & 0xffff); x1[u][1] = bf2f(a1 >> 16); x2[u][0] = bf2f(a2 & 0xffff); x2[u][1] = bf2f(a2 >> 16);
            } else { vn[u] = *(const bf16x8*)(KV + (size_t)r * 2048 + h * 256 + 8 * sub);
                if (r < MROWS) { const bf16_t* pe = P + (size_t)r * LDP_AB + COL_KPE; const unsigned a1 = *(const unsigned*)(pe + 2 * sub), a2 = *(const unsigned*)(pe + 32 + 2 * sub);
                    x1[u][0] = bf2f(a1 & 0xffff); x1[u][1] = bf2f(a1 >> 16); x2[u][0] = bf2f(a2 & 0xffff); x2[u][1] = bf2f(a2 >> 16); }
                else { const int rr = r - MROWS, b = rr >> 8, t = rr & 255; const float* pe = ckpe + (size_t)((b * 2 + j) * 256 + t) * 64;
                    x1[u][0] = pe[2 * sub]; x1[u][1] = pe[2 * sub + 1]; x2[u][0] = pe[32 + 2 * sub]; x2[u][1] = pe[32 + 2 * sub + 1]; } }
            if (r >= MC && r < MROWS) cs[u] = *(const f32x4*)(RA + (((r - MC) & 2047) * 32 + 2 * sub) * 2);
        } }
#pragma unroll
        for (int u = 0; u < U; ++u) { const int it = base + u; if (it < NIT) {
            const bool isq = it < NQ; const int w = isq ? it : it - NQ; const int r = w >> 1, h = (w & 1) * 4 + hq;
            float xn[8];
#pragma unroll
            for (int e = 0; e < 8; ++e) xn[e] = bf2f((unsigned short)vn[u][e]);
            float ss = x1[u][0] * x1[u][0] + x1[u][1] * x1[u][1] + x2[u][0] * x2[u][0] + x2[u][1] * x2[u][1];
#pragma unroll
            for (int e = 0; e < 8; ++e) ss += xn[e] * xn[e];
            const float rstd = rsqrtf(sum16(ss) * (1.f / 192.f) + EPSN);
            const float* g = isq ? gq : gk;
#pragma unroll
            for (int e = 0; e < 8; ++e) xn[e] = xn[e] * rstd * g[8 * sub + e];
            float y1[2], y2[2];
            y1[0] = x1[u][0] * rstd * g[128 + 2 * sub]; y1[1] = x1[u][1] * rstd * g[128 + 2 * sub + 1]; y2[0] = x2[u][0] * rstd * g[160 + 2 * sub]; y2[1] = x2[u][1] * rstd * g[160 + 2 * sub + 1];
            if (r >= MC && r < MROWS) {
#pragma unroll
                for (int q = 0; q < 2; ++q) { const float c = cs[u][2 * q], sn = cs[u][2 * q + 1];
                    const float z1 = y1[q] * c - y2[q] * sn, z2 = y1[q] * sn + y2[q] * c; y1[q] = z1; y2[q] = z2; } }
            bf16_t* p;
            if (isq) {
#pragma unroll
                for (int e = 0; e < 8; ++e) xn[e] *= QSC_A;
                y1[0] *= QSC_A; y1[1] *= QSC_A; y2[0] *= QSC_A; y2[1] *= QSC_A;
                p = Q + (size_t)r * 1536 + h * 192;
            } else p = KF + (size_t)r * 1536 + h * 192;
            *(bf16x8*)(p + 8 * sub) = pack8(xn); *(unsigned*)(p + 128 + 2 * sub) = pk2(y1[0], y1[1]); *(unsigned*)(p + 160 + 2 * sub) = pk2(y2[0], y2[1]);
        } }
    }
}

__device__ __forceinline__ void phase_fin_ab(KArgs a, int j) {
    const int tid = otid(), lane = tid & 63, wave = tid >> 6, sub = lane & 15, hq = lane >> 4;
    const int gw = obid() * NWAVES + wave, NGW = gridDim.x * NWAVES;
    const bf16_t* OF = (const bf16_t*)(a->ws + WS_OF); const bf16_t* OB = (const bf16_t*)(a->ws + WS_OB);
    const bf16_t* P = (const bf16_t*)(a->ws + WS_PROJ); bf16_t* MIX = (bf16_t*)(a->ws + WS_H);
    const float* g = a->in[21] + j * 128;
    for (int it = gw; it < MROWS * 2; it += NGW) {
        const int r = it >> 1, h = (it & 1) * 4 + hq; const size_t o = (size_t)r * 1024 + h * 128 + 8 * sub;
        const bf16x8 va = *(const bf16x8*)(OF + o), vb = *(const bf16x8*)(OB + o), vg = *(const bf16x8*)(P + (size_t)r * LDP_AB + COL_BG + h * 128 + 8 * sub);
        float s[8]; float ss = 0.f;
#pragma unroll
        for (int e = 0; e < 8; ++e) { s[e] = bf2f((unsigned short)va[e]) + bf2f((unsigned short)vb[e]); ss += s[e] * s[e]; }
        const float rstd = rsqrtf(sum16(ss) * (1.f / 128.f) + EPSN);
#pragma unroll
        for (int e = 0; e < 8; ++e) s[e] = s[e] * rstd * g[8 * sub + e] * silu_f(bf2f((unsigned short)vg[e]));
        *(bf16x8*)(MIX + (size_t)r * DM + 1024 + h * 128 + 8 * sub) = pack8(s);
    }
}

__device__ __forceinline__ void phase_hn_c(KArgs a, int j) {
    const int tid = otid(), lane = tid & 63, wave = tid >> 6, sub = lane & 15, hq = lane >> 4;
    const int gw = obid() * NWAVES + wave, NGW = gridDim.x * NWAVES;
    bf16_t* P = (bf16_t*)(a->ws + WS_PROJ);
    const float* RC = (const float*)(a->ws + WS_ROPEC);
    const float* gq = a->in[27] + j * 128; const float* gk = a->in[28] + j * 128;
    float* outp = a->out;
    for (int r = gw; r < MC; r += NGW) { const int b = r >> 8, t = r & 255; const bf16x8 v = *(const bf16x8*)(P + (size_t)r * LDP_C + 2560 + 8 * lane);
        float* o = outp + O_VC + (size_t)((b * 2 + j) * 256 + t) * 512 + 8 * lane;
        *(f32x4*)o = (f32x4){bf2f((unsigned short)v[0]), bf2f((unsigned short)v[1]), bf2f((unsigned short)v[2]), bf2f((unsigned short)v[3])};
        *(f32x4*)(o + 4) = (f32x4){bf2f((unsigned short)v[4]), bf2f((unsigned short)v[5]), bf2f((unsigned short)v[6]), bf2f((unsigned short)v[7])}; }
    constexpr int U = 4;
    const int NIT = MROWS;
    for (int base = gw * U; base < NIT; base += NGW * U) {
        s16x4 v1[U], v2[U]; f32x4 ca[U], cb[U];
#pragma unroll
        for (int u = 0; u < U; ++u) { const int it = base + u; if (it < NIT) {
            const int r = it, h = 16 + hq; const bool isq = false;
            const bf16_t* p = P + (size_t)r * LDP_C + (isq ? h * 128 : 2048 + (h - 16) * 128);
            v1[u] = *(const s16x4*)(p + 4 * sub); v2[u] = *(const s16x4*)(p + 64 + 4 * sub);
            if (r >= MC) { const float* rc = RC + (((r - MC) & 2047) * 64 + 4 * sub) * 2; ca[u] = *(const f32x4*)rc; cb[u] = *(const f32x4*)(rc + 4); }
        } }
#pragma unroll
        for (int u = 0; u < U; ++u) { const int it = base + u; if (it < NIT) {
            const int r = it, h = 16 + hq; const bool isq = false;
            bf16_t* p = P + (size_t)r * LDP_C + (isq ? h * 128 : 2048 + (h - 16) * 128);
            float x1[4], x2[4]; float ss = 0.f;
#pragma unroll
            for (int e = 0; e < 4; ++e) { x1[e] = bf2f((unsigned short)v1[u][e]); x2[e] = bf2f((unsigned short)v2[u][e]); ss += x1[e] * x1[e] + x2[e] * x2[e]; }
            const float rstd = rsqrtf(sum16(ss) * (1.f / 128.f) + EPSN);
            const float* g = isq ? gq : gk;
#pragma unroll
            for (int e = 0; e < 4; ++e) { x1[e] *= rstd * g[4 * sub + e]; x2[e] *= rstd * g[64 + 4 * sub + e]; }
            if (r >= MC) {
#pragma unroll
                for (int e = 0; e < 4; ++e) { const float c = e < 2 ? ca[u][2 * e] : cb[u][2 * (e - 2)], sn = e < 2 ? ca[u][2 * e + 1] : cb[u][2 * (e - 2) + 1];
                    const float y1 = x1[e] * c - x2[e] * sn, y2 = x1[e] * sn + x2[e] * c; x1[e] = y1; x2[e] = y2; } }
            else if (!isq) { const int b = r >> 8, t = r & 255; float* o = outp + O_KC + (size_t)((b * 2 + j) * 256 + t) * 512 + (h - 16) * 128;
                *(f32x4*)(o + 4 * sub) = (f32x4){x1[0], x1[1], x1[2], x1[3]}; *(f32x4*)(o + 64 + 4 * sub) = (f32x4){x2[0], x2[1], x2[2], x2[3]}; }
            if (isq) {
#pragma unroll
                for (int e = 0; e < 4; ++e) { x1[e] *= QSC_C; x2[e] *= QSC_C; } }
            u32x2 w1, w2; w1.x = pk2(x1[0], x1[1]); w1.y = pk2(x1[2], x1[3]); w2.x = pk2(x2[0], x2[1]); w2.y = pk2(x2[2], x2[3]);
            *(u32x2*)(p + 4 * sub) = w1; *(u32x2*)(p + 64 + 4 * sub) = w2;
        } }
    }
}

namespace att {
__device__ __forceinline__ int crow(int r, int hi) { return (r & 3) + 8 * (r >> 2) + 4 * hi; }
__device__ __forceinline__ unsigned cvtpk(float lo, float hi) { return pk2(lo, hi); }
__device__ __forceinline__ int v_st(int k, int c) { const int kk = (k & ~0xC) | ((k & 4) << 1) | ((k & 8) >> 1); return ((kk >> 3) * 4 + (c >> 5)) * 512 + ((kk & 7) * 32 + (c & 31)) * 2; }
__device__ __forceinline__ int v_rd_base(int lane) { return ((lane & 3) << 3) | (((lane >> 2) & 3) << 6) | (((lane >> 4) & 1) << 5) | (((lane >> 5) & 1) << 8); }
constexpr int v_rd_off(int d0, int ks, int half) { return d0 * 512 + ks * 4096 + half * 2048; }
template <int OFF> __device__ __forceinline__ s16x4 tr_read(int vb) {
    s16x4 r; asm volatile("ds_read_b64_tr_b16 %0, %1 offset:%2" : "=&v"(r) : "v"(vb), "i"(OFF) : "memory"); return r;
}
template <int D0> __device__ __forceinline__ void pv_one(f32x16& od, int vb, bf16x8 pa0, bf16x8 pa1, bf16x8 pa2, bf16x8 pa3) {
    const s16x4 l0 = tr_read<v_rd_off(D0, 0, 0)>(vb), h0 = tr_read<v_rd_off(D0, 0, 1)>(vb), l1 = tr_read<v_rd_off(D0, 1, 0)>(vb), h1 = tr_read<v_rd_off(D0, 1, 1)>(vb);
    const s16x4 l2 = tr_read<v_rd_off(D0, 2, 0)>(vb), h2 = tr_read<v_rd_off(D0, 2, 1)>(vb), l3 = tr_read<v_rd_off(D0, 3, 0)>(vb), h3 = tr_read<v_rd_off(D0, 3, 1)>(vb);
    asm volatile("s_waitcnt lgkmcnt(0)" ::: "memory"); __builtin_amdgcn_sched_barrier(0);
#define ATT_PK(L, H) (bf16x8){L[0], L[1], L[2], L[3], H[0], H[1], H[2], H[3]}
    od = __builtin_amdgcn_mfma_f32_32x32x16_bf16(pa0, ATT_PK(l0, h0), od, 0, 0, 0);
    od = __builtin_amdgcn_mfma_f32_32x32x16_bf16(pa1, ATT_PK(l1, h1), od, 0, 0, 0);
    od = __builtin_amdgcn_mfma_f32_32x32x16_bf16(pa2, ATT_PK(l2, h2), od, 0, 0, 0);
    od = __builtin_amdgcn_mfma_f32_32x32x16_bf16(pa3, ATT_PK(l3, h3), od, 0, 0, 0);
#undef ATT_PK
}
struct Item {
    const bf16_t* Q; int ldq;
    const bf16_t* K0; const bf16_t* V0; int n0;
    const bf16_t* K1; const bf16_t* V1; int ldk, ldv, t_lo, t_hi;
    int q0, band; float m0, l0;
    const float* qg; const float* rope; float qscale;
    const bf16_t* G; int ldg; bf16_t* O; int ldo;
};
template <int DQK>
__device__ __forceinline__ void attn_item(LAS unsigned char* lds, const Item& it) {
    constexpr int KROW = DQK * 2, SHM_K = 64 * KROW, SHM_V = 64 * 128 * 2, ND = DQK / 16;
    const int tid = otid(), wid = tid >> 6, lane = tid & 63, r32 = lane & 31, hi = lane >> 5;
    LAS unsigned char* V_lds = lds; LAS unsigned char* K_lds = lds + 2 * SHM_V;
    LAS float* wsx = (LAS float*)(lds + 2 * SHM_V + 2 * SHM_K) + wid * 64; LAS float* li_l = wsx; LAS float* al_l = wsx + 32;
    float m_reg = it.m0, l_reg = it.l0;
    f32x16 o[4];
#pragma unroll
    for (int d = 0; d < 4; ++d)
#pragma unroll
        for (int r = 0; r < 16; ++r) o[d][r] = 0.f;
    bf16x8 qr[ND];
    {
      const bf16_t* Qw = it.Q + (size_t)(wid * 32 + r32) * it.ldq + hi * 8;
      float xf[ND][8]; float ss = 0.f;
#pragma unroll
      for (int d0 = 0; d0 < ND; ++d0) { const bf16x8 v = *(const bf16x8*)(Qw + d0 * 16);
#pragma unroll
          for (int e = 0; e < 8; ++e) { xf[d0][e] = bf2f((unsigned short)v[e]); ss += xf[d0][e] * xf[d0][e]; } }
      ss += __shfl_xor(ss, 32);
      const float rstd = rsqrtf(ss * (1.f / (float)DQK) + EPSN);
#pragma unroll
      for (int d0 = 0; d0 < ND; ++d0) { const f32x4 g0 = *(const f32x4*)(it.qg + d0 * 16 + hi * 8), g1 = *(const f32x4*)(it.qg + d0 * 16 + hi * 8 + 4);
#pragma unroll
          for (int e = 0; e < 8; ++e) xf[d0][e] *= rstd * (e < 4 ? g0[e & 3] : g1[e & 3]); }
      if (it.rope) { constexpr int NR = DQK == 128 ? 4 : 2, RB = DQK == 128 ? 0 : 8, RS = DQK == 128 ? 64 : 32;
          const float* rp = it.rope + (size_t)((it.q0 + wid * 32 + r32) * RS + hi * 8) * 2;
#pragma unroll
          for (int p = 0; p < NR; ++p) { f32x4 cs4[4];
#pragma unroll
              for (int q = 0; q < 4; ++q) cs4[q] = *(const f32x4*)(rp + p * 32 + 4 * q);
#pragma unroll
              for (int e = 0; e < 8; ++e) { const float c = cs4[e >> 1][(e & 1) * 2], sn = cs4[e >> 1][(e & 1) * 2 + 1];
                  const float x1 = xf[RB + p][e], x2 = xf[RB + NR + p][e]; xf[RB + p][e] = x1 * c - x2 * sn; xf[RB + NR + p][e] = x1 * sn + x2 * c; } } }
#pragma unroll
      for (int d0 = 0; d0 < ND; ++d0) { float t8[8];
#pragma unroll
          for (int e = 0; e < 8; ++e) t8[e] = xf[d0][e] * it.qscale;
          qr[d0] = pack8(t8); } }
    const int NT = it.n0 + (it.t_hi - it.t_lo);
    const int wvu = __builtin_amdgcn_readfirstlane(wid);
    const int vb0 = (int)(uintptr_t)V_lds + v_rd_base(lane);
    constexpr int NKI = SHM_K / 8192;
    unsigned kog[NKI], vog[2];
#pragma unroll
    for (int i = 0; i < NKI; ++i) { const int off = i * 8192 + wid * 1024 + lane * 16, row = off / KROW, pos = off % KROW; kog[i] = (unsigned)(row * it.ldk + ((pos ^ ((row & 7) << 4)) >> 1)); }
#pragma unroll
    for (int i = 0; i < 2; ++i) { const int q = (i * 8192 + wid * 1024 + lane * 16) >> 4, sub = q >> 5, rem = q & 31, rowin = rem >> 2, cch = rem & 3;
        const int kk = (sub >> 2) * 8 + rowin; vog[i] = (unsigned)(((kk & ~0xC) | ((kk & 4) << 1) | ((kk & 8) >> 1)) * it.ldv + (sub & 3) * 32 + cch * 8); }
    int koff[4];
#pragma unroll
    for (int dl = 0; dl < 4; ++dl) koff[dl] = r32 * KROW + ((dl * 32 + hi * 16) ^ ((r32 & 7) << 4));
#define ATT_STAGE(jj, b) do { const int _j = (jj); const bool _s0 = _j < it.n0; const int _t = _s0 ? _j : it.t_lo + (_j - it.n0); \
        const bf16_t* _Kp = (_s0 ? it.K0 : it.K1) + (size_t)(64 * _t) * it.ldk; const bf16_t* _Vp = (_s0 ? it.V0 : it.V1) + (size_t)(64 * _t) * it.ldv; \
        _Pragma("unroll") for (int _i = 0; _i < NKI; ++_i) __builtin_amdgcn_global_load_lds((const unsigned*)(_Kp + kog[_i]), (LAS unsigned*)(K_lds + (b) * SHM_K + _i * 8192 + wvu * 1024), 16, 0, 0); \
        _Pragma("unroll") for (int _i = 0; _i < 2; ++_i) __builtin_amdgcn_global_load_lds((const unsigned*)(_Vp + vog[_i]), (LAS unsigned*)(V_lds + (b) * SHM_V + _i * 8192 + wvu * 1024), 16, 0, 0); } while (0)
    ATT_STAGE(0, 0); asm volatile("s_waitcnt vmcnt(0)" ::: "memory"); __syncthreads();
    for (int j = 0; j < NT; ++j) {
        const int cur = j & 1;
        if (j + 1 < NT) ATT_STAGE(j + 1, cur ^ 1);
        bool act = true; const bool domask = it.band && j >= it.n0; int kpos0 = 0;
        if (domask) { kpos0 = 64 * (it.t_lo + j - it.n0); const int qlo = it.q0 + wid * 32; act = (kpos0 + 63 >= qlo - 128) && (kpos0 <= qlo + 31 + 128); }
        if (act) {
            f32x16 p0, p1;
#pragma unroll
            for (int r = 0; r < 16; ++r) { p0[r] = 0.f; p1[r] = 0.f; }
            const LAS unsigned char* Ks = K_lds + cur * SHM_K;
#pragma unroll
            for (int d0 = 0; d0 < ND; ++d0) {
                const bf16x8 b0 = *(const LAS bf16x8*)(Ks + koff[d0 & 3] + (d0 >> 2) * 128);
                const bf16x8 b1 = *(const LAS bf16x8*)(Ks + koff[d0 & 3] + (d0 >> 2) * 128 + 32 * KROW);
                p0 = __builtin_amdgcn_mfma_f32_32x32x16_bf16(b0, qr[d0], p0, 0, 0, 0);
                p1 = __builtin_amdgcn_mfma_f32_32x32x16_bf16(b1, qr[d0], p1, 0, 0, 0);
                if ((d0 & 3) == 3) __builtin_amdgcn_sched_barrier(0); }
            if (domask) { const int qp = it.q0 + wid * 32 + r32;
#pragma unroll
                for (int r = 0; r < 16; ++r) { const int d = kpos0 + crow(r, hi) - qp;
                    if (d > 128 || d < -128) p0[r] = -1e30f;
                    if (d + 32 > 128 || d + 32 < -128) p1[r] = -1e30f; } }
            float pmax = p0[0];
#pragma unroll
            for (int r = 1; r < 16; ++r) pmax = fmaxf(pmax, p0[r]);
#pragma unroll
            for (int r = 0; r < 16; ++r) pmax = fmaxf(pmax, p1[r]);
            { auto rr = __builtin_amdgcn_permlane32_swap(__float_as_uint(pmax), __float_as_uint(pmax), false, false);
              pmax = fmaxf(__uint_as_float(rr[0]), __uint_as_float(rr[1])); }
            const float mn = fmaxf(m_reg, pmax); const float alpha = __builtin_amdgcn_exp2f(m_reg - mn); m_reg = mn;
            float ps = 0.f;
#pragma unroll
            for (int r = 0; r < 16; ++r) { p0[r] = __builtin_amdgcn_exp2f(p0[r] - mn); p1[r] = __builtin_amdgcn_exp2f(p1[r] - mn); ps += p0[r] + p1[r]; }
            { auto rr = __builtin_amdgcn_permlane32_swap(__float_as_uint(ps), __float_as_uint(ps), false, false);
              ps = __uint_as_float(rr[0]) + __uint_as_float(rr[1]); }
            l_reg = l_reg * alpha + ps;
            bf16x8 pa0, pa1, pa2, pa3;
#define ATT_PK4(P, BASE, OUT) do { unsigned a0 = cvtpk(P[BASE + 0], P[BASE + 1]), a1 = cvtpk(P[BASE + 2], P[BASE + 3]);   \
    unsigned b0 = cvtpk(P[BASE + 4], P[BASE + 5]), b1 = cvtpk(P[BASE + 6], P[BASE + 7]);                              \
    auto r0 = __builtin_amdgcn_permlane32_swap(a0, b0, false, false); auto r1 = __builtin_amdgcn_permlane32_swap(a1, b1, false, false); \
    u32x4 w = {r0[0], r1[0], r0[1], r1[1]}; OUT = __builtin_bit_cast(bf16x8, w); } while (0)
            ATT_PK4(p0, 0, pa0); ATT_PK4(p0, 8, pa1); ATT_PK4(p1, 0, pa2); ATT_PK4(p1, 8, pa3);
#undef ATT_PK4
            if (__any(alpha < 1.f)) { if (hi == 0) al_l[r32] = alpha; asm volatile("s_waitcnt lgkmcnt(0)" ::: "memory");
#pragma unroll
                for (int r = 0; r < 16; ++r) { const float al = al_l[crow(r, hi)];
#pragma unroll
                    for (int d = 0; d < 4; ++d) o[d][r] *= al; } }
            const int vb = vb0 + cur * SHM_V;
            pv_one<0>(o[0], vb, pa0, pa1, pa2, pa3); pv_one<1>(o[1], vb, pa0, pa1, pa2, pa3); pv_one<2>(o[2], vb, pa0, pa1, pa2, pa3); pv_one<3>(o[3], vb, pa0, pa1, pa2, pa3);
        }
        asm volatile("s_waitcnt vmcnt(0)" ::: "memory"); __syncthreads();
    }
#undef ATT_STAGE
    if (hi == 0) li_l[r32] = l_reg; asm volatile("s_waitcnt lgkmcnt(0)" ::: "memory");
#pragma unroll
    for (int r = 0; r < 16; ++r) { const int orow = wid * 32 + crow(r, hi); const float rli = 1.f / li_l[crow(r, hi)];
#pragma unroll
        for (int d0 = 0; d0 < 4; ++d0) { const int col = d0 * 32 + r32; const float g = bf2f(it.G[(size_t)orow * it.ldg + col]);
            it.O[(size_t)orow * it.ldo + col] = (bf16_t)f2bf(o[d0][r] * rli * silu_f(g)); }
        asm volatile("" ::: "memory"); }
    __syncthreads();
}
}

__device__ __forceinline__ void hgrn_item(LAS unsigned char* lds, const bf16_t* PROJ, int rowbase, int T, int h, int dir,
                                          const float* lb, const float* s0, float* sout, bf16_t* OUT) {
    LAS float* GS = (LAS float*)lds;
    LAS float* DEC = (LAS float*)(lds + 2048);
    LAS bf16_t* QT = (LAS bf16_t*)(lds + 2560);
    LAS bf16_t* KT = QT + 32 * 136;
    LAS bf16_t* KTt = KT + 32 * 136;
    LAS bf16_t* Vt = KTt + 128 * 40;
    const int tid = otid(), wid = tid >> 6, lane = tid & 63, fr = lane & 15, fq = lane >> 4;
    const int c2 = tid & 127, part = tid >> 7, n0 = wid * 16;
    f32x4 S[8];
#pragma unroll
    for (int kt = 0; kt < 8; ++kt) {
        if (s0) {
#pragma unroll
            for (int r = 0; r < 4; ++r) S[kt][r] = s0[(size_t)(16 * kt + 4 * fq + r) * 128 + n0 + fr]; }
        else S[kt] = (f32x4){0.f, 0.f, 0.f, 0.f}; }
    const float oml = 1.f - lb[c2];
    const int nch = T / 32;
    const bf16_t* pq = PROJ + COL_BQ + h * 128 + c2; const bf16_t* pf = PROJ + (dir ? COL_FB : COL_FF) + h * 128 + c2; const bf16_t* pv = PROJ + COL_BI + h * 128 + c2;
    unsigned short rq[8], rf[8], rv[8];
#define HG_LOAD(cc) do { _Pragma("unroll") for (int _i = 0; _i < 8; ++_i) { const int _p = 32 * (cc) + 8 * part + _i; const int _tok = dir ? T - 1 - _p : _p; \
        const size_t _o = (size_t)(rowbase + _tok) * LDP_AB; rq[_i] = pq[_o]; rf[_i] = pf[_o]; rv[_i] = pv[_o]; } } while (0)
    HG_LOAD(0);
    for (int c = 0; c < nch; ++c) {
        float b[8], kk[8], sq[8]; unsigned short vv[8];
        { float run = 0.f;
#pragma unroll
            for (int i = 0; i < 8; ++i) { const float x = bf2f(rf[i]); const float omf = oml * __builtin_amdgcn_rcpf(1.f + __expf(x));
                const float lf = fmaxf(__logf(1.f - omf), -30.f); run += lf; b[i] = run; kk[i] = omf; sq[i] = silu_f(bf2f(rq[i])); vv[i] = rv[i]; }
            GS[part * 128 + c2] = run; }
        if (c + 1 < nch) HG_LOAD(c + 1);
        __syncthreads();
        { float off = 0.f;
#pragma unroll
            for (int p = 0; p < 3; ++p) if (p < part) off += GS[p * 128 + c2];
            float kt_[8];
#pragma unroll
            for (int i = 0; i < 8; ++i) { const float bb = b[i] + off; const int t = 8 * part + i;
                const float qv = sq[i] * __expf(bb); kt_[i] = kk[i] * __expf(fminf(-bb, 80.f));
                QT[t * 136 + c2] = (bf16_t)f2bf(qv); KT[t * 136 + c2] = (bf16_t)f2bf(kt_[i]);
                if (i == 7 && part == 3) DEC[c2] = __expf(bb); }
            *(LAS bf16x8*)(KTt + c2 * 40 + 8 * part) = pack8(kt_);
            u32x4 wv; wv.x = (unsigned)vv[0] | ((unsigned)vv[1] << 16); wv.y = (unsigned)vv[2] | ((unsigned)vv[3] << 16); wv.z = (unsigned)vv[4] | ((unsigned)vv[5] << 16); wv.w = (unsigned)vv[6] | ((unsigned)vv[7] << 16);
            *(LAS u32x4*)(Vt + c2 * 40 + 8 * part) = wv; }
        __syncthreads();
        f32x4 pt00 = {0.f, 0.f, 0.f, 0.f}, pt01 = pt00, pt11 = pt00;
#pragma unroll
        for (int ks = 0; ks < 4; ++ks) {
            const bf16x8 a0 = *(const LAS bf16x8*)(KT + fr * 136 + 32 * ks + 8 * fq), a1 = *(const LAS bf16x8*)(KT + (16 + fr) * 136 + 32 * ks + 8 * fq);
            const bf16x8 b0 = *(const LAS bf16x8*)(QT + fr * 136 + 32 * ks + 8 * fq), b1 = *(const LAS bf16x8*)(QT + (16 + fr) * 136 + 32 * ks + 8 * fq);
            pt00 = __builtin_amdgcn_mfma_f32_16x16x32_bf16(a0, b0, pt00, 0, 0, 0);
            pt01 = __builtin_amdgcn_mfma_f32_16x16x32_bf16(a0, b1, pt01, 0, 0, 0);
            pt11 = __builtin_amdgcn_mfma_f32_16x16x32_bf16(a1, b1, pt11, 0, 0, 0); }
#pragma unroll
        for (int r = 0; r < 4; ++r) { if (4 * fq + r > fr) { pt00[r] = 0.f; pt11[r] = 0.f; } }
        u32x4 wA0, wA1;
        wA0.x = pk2(pt00[0], pt00[1]); wA0.y = pk2(pt00[2], pt00[3]); wA0.z = 0u; wA0.w = 0u;
        wA1.x = pk2(pt01[0], pt01[1]); wA1.y = pk2(pt01[2], pt01[3]); wA1.z = pk2(pt11[0], pt11[1]); wA1.w = pk2(pt11[2], pt11[3]);
        const u32x2 vlo = *(const LAS u32x2*)(Vt + (n0 + fr) * 40 + 4 * fq), vhi = *(const LAS u32x2*)(Vt + (n0 + fr) * 40 + 16 + 4 * fq);
        const u32x4 wV = {vlo.x, vlo.y, vhi.x, vhi.y};
        f32x4 o0 = {0.f, 0.f, 0.f, 0.f}, o1 = o0;
        o0 = __builtin_amdgcn_mfma_f32_16x16x32_bf16(__builtin_bit_cast(bf16x8, wA0), __builtin_bit_cast(bf16x8, wV), o0, 0, 0, 0);
        o1 = __builtin_amdgcn_mfma_f32_16x16x32_bf16(__builtin_bit_cast(bf16x8, wA1), __builtin_bit_cast(bf16x8, wV), o1, 0, 0, 0);
#pragma unroll
        for (int aa = 0; aa < 4; ++aa) {
            u32x4 wS; wS.x = pk2(S[2 * aa][0], S[2 * aa][1]); wS.y = pk2(S[2 * aa][2], S[2 * aa][3]); wS.z = pk2(S[2 * aa + 1][0], S[2 * aa + 1][1]); wS.w = pk2(S[2 * aa + 1][2], S[2 * aa + 1][3]);
            const u32x2 q0l = *(const LAS u32x2*)(QT + fr * 136 + 32 * aa + 4 * fq), q0h = *(const LAS u32x2*)(QT + fr * 136 + 32 * aa + 16 + 4 * fq);
            const u32x2 q1l = *(const LAS u32x2*)(QT + (16 + fr) * 136 + 32 * aa + 4 * fq), q1h = *(const LAS u32x2*)(QT + (16 + fr) * 136 + 32 * aa + 16 + 4 * fq);
            const u32x4 wQ0 = {q0l.x, q0l.y, q0h.x, q0h.y}, wQ1 = {q1l.x, q1l.y, q1h.x, q1h.y};
            o0 = __builtin_amdgcn_mfma_f32_16x16x32_bf16(__builtin_bit_cast(bf16x8, wQ0), __builtin_bit_cast(bf16x8, wS), o0, 0, 0, 0);
            o1 = __builtin_amdgcn_mfma_f32_16x16x32_bf16(__builtin_bit_cast(bf16x8, wQ1), __builtin_bit_cast(bf16x8, wS), o1, 0, 0, 0); }
        { const bf16x8 vn = *(const LAS bf16x8*)(Vt + (n0 + fr) * 40 + 8 * fq);
#pragma unroll
            for (int kt = 0; kt < 8; ++kt) { const bf16x8 ka = *(const LAS bf16x8*)(KTt + (16 * kt + fr) * 40 + 8 * fq);
                S[kt] = __builtin_amdgcn_mfma_f32_16x16x32_bf16(ka, vn, S[kt], 0, 0, 0);
                const f32x4 d = *(const LAS f32x4*)(DEC + 16 * kt + 4 * fq); S[kt] = S[kt] * d; } }
#pragma unroll
        for (int r = 0; r < 4; ++r) {
            const int i0 = 4 * fq + r, i1 = 16 + 4 * fq + r;
            const int tok0 = dir ? T - 1 - (32 * c + i0) : 32 * c + i0, tok1 = dir ? T - 1 - (32 * c + i1) : 32 * c + i1;
            OUT[(size_t)(rowbase + tok0) * 1024 + h * 128 + n0 + fr] = (bf16_t)f2bf(o0[r]);
            OUT[(size_t)(rowbase + tok1) * 1024 + h * 128 + n0 + fr] = (bf16_t)f2bf(o1[r]); }
    }
#undef HG_LOAD
    if (sout) {
#pragma unroll
        for (int kt = 0; kt < 8; ++kt)
#pragma unroll
            for (int r = 0; r < 4; ++r) sout[(size_t)(16 * kt + 4 * fq + r) * 128 + n0 + fr] = S[kt][r]; }
    __syncthreads();
}

__device__ __forceinline__ int fetch_item(unsigned* ctr, LAS int* slot) {
    __syncthreads();
    if (otid() == 0) *slot = (int)atomicAdd(ctr, 1u);
    __syncthreads();
    return *slot;
}

#define XB_TMO      128
#define XB_XCNT(j)  (256  + 64 * (j))
#define XB_XSUB(j)  (1280 + 64 * (j))
#define XB_XGEN(j)  (2304 + 64 * (j))
#define XB_TOP      3328
#define XB_TOPGEN   3392
#define XCD_BAR_WORDS 3456
#define XB_SPIN_CAP (1u << 18)

__device__ __forceinline__ unsigned xb_ld(unsigned* p)              { return __hip_atomic_load(p, __ATOMIC_RELAXED, __HIP_MEMORY_SCOPE_AGENT); }
__device__ __forceinline__ unsigned xb_add(unsigned* p, unsigned v) { return __hip_atomic_fetch_add(p, v, __ATOMIC_RELAXED, __HIP_MEMORY_SCOPE_AGENT); }
__device__ __forceinline__ unsigned xb_xcc_id() { return (unsigned)__builtin_amdgcn_s_getreg((3 << 11) | 20) & 0xFu; }
#define XB_SPIN(cond, bar) do { unsigned _sp = 0; while (cond) { __builtin_amdgcn_s_sleep(1); \
    if ((++_sp & 255u) == 0u) { if (xb_ld(&(bar)[XB_TMO])) break; if (_sp > XB_SPIN_CAP) { atomicAdd(&(bar)[XB_TMO], 1u); break; } } } } while (0)

struct XcdBarrier {
    unsigned* bar; unsigned x;
    volatile LAS unsigned* st;
};

__device__ __forceinline__ XcdBarrier xcd_barrier_post(unsigned* bar, volatile LAS unsigned* st) {
    XcdBarrier b; b.bar = bar; b.x = xb_xcc_id(); b.st = st;
    if (threadIdx.x == 0) (void)xb_add(&bar[XB_XCNT(b.x)], 1u);
    return b;
}
__device__ __forceinline__ void xcd_barrier_complete(unsigned* bar, unsigned x, unsigned& nloc, unsigned& nx) {
    const unsigned G = gridDim.x * gridDim.y * gridDim.z;
    unsigned sum, cnt, mine, sp = 0u;
    for (;;) {
        sum = 0u; cnt = 0u; mine = 0u;
#pragma unroll
        for (unsigned j = 0; j < 16; ++j) { const unsigned c = xb_ld(&bar[XB_XCNT(j)]); sum += c; cnt += (c > 0u) ? 1u : 0u; mine = (j == x) ? c : mine; }
        if (sum == G) break;
        __builtin_amdgcn_s_sleep(1);
        if ((++sp & 255u) == 0u) { if (xb_ld(&bar[XB_TMO])) break; if (sp > XB_SPIN_CAP) { atomicAdd(&bar[XB_TMO], 1u); break; } }
    }
    nloc = mine > 0u ? mine : 1u; nx = cnt > 0u ? cnt : 1u;
}

__device__ __forceinline__ void xcd_barrier(const XcdBarrier& b) {
    asm volatile("s_waitcnt vmcnt(0)" ::: "memory");
    __syncthreads();
    if (threadIdx.x == 0) {
        unsigned* bar = b.bar;
        __builtin_amdgcn_s_waitcnt(0);
        unsigned nloc = b.st[0], nx = b.st[1];
        if (nloc == 0u) { xcd_barrier_complete(bar, b.x, nloc, nx); b.st[0] = nloc; b.st[1] = nx; }
        const unsigned old = xb_add(&bar[XB_XSUB(b.x)], 1u);
        const unsigned gen = old / nloc;
        if (old + 1u == (gen + 1u) * nloc) {
            __builtin_amdgcn_fence(__ATOMIC_RELEASE, "agent");
            asm volatile("s_waitcnt vmcnt(0)" ::: "memory");
            const unsigned og = xb_add(&bar[XB_TOP], 1u);
            const unsigned tg = og / nx;
            if (og + 1u == (tg + 1u) * nx) xb_add(&bar[XB_TOPGEN], 1u);
            else XB_SPIN(xb_ld(&bar[XB_TOPGEN]) == tg, bar);
            __builtin_amdgcn_fence(__ATOMIC_ACQUIRE, "agent");
            xb_add(&bar[XB_XGEN(b.x)], 1u);
            asm volatile("s_waitcnt vmcnt(0)" ::: "memory");
        } else {
            XB_SPIN(xb_ld(&bar[XB_XGEN(b.x)]) == gen, bar);
            __builtin_amdgcn_fence(__ATOMIC_ACQUIRE, "agent");
            asm volatile("s_waitcnt vmcnt(0)" ::: "memory");
        }
    }
    __syncthreads();
}

enum { K_P0 = 0, K_MODNORM, K_GEMM_IN, K_PREP_AB, K_GEMM_QUP, K_GEMM_KVUP, K_HN_AB, K_MIX_AB, K_FIN_AB, K_GEMM_OUT, K_HN_C, K_ATTN_C };

__global__ void __launch_bounds__(NTHR, 2) mk_fwd(Args a_byval) {
    extern __shared__ __attribute__((aligned(16))) unsigned char lds_raw[];
    LAS unsigned char* lds = (LAS unsigned char*)lds_raw;
    LAS int* slot = (LAS int*)(lds + LDS_PHASE);
    cg::grid_group grid = cg::this_grid();
    const int G = gridDim.x;
    volatile LAS unsigned* bst = (volatile LAS unsigned*)(lds + LDS_PHASE + 64);
    if (threadIdx.x < 2) bst[threadIdx.x] = 0u;
    __syncthreads();
    XcdBarrier xbar = xcd_barrier_post((unsigned*)(a_byval.ws + WS_CTL) + 8192, bst);

    for (int step = 0; step < 29; ++step) {
        asm volatile("" : "+s"(step));
        KArgs a = (KArgs)__builtin_amdgcn_kernarg_segment_ptr();
        asm volatile("" : "+s"(a));
        unsigned char* ws = a->ws;
        unsigned* ctl = (unsigned*)(ws + WS_CTL);
        int kind, L = 0; bool sync_after = true;
        if (step == 0) kind = K_P0;
        else { const int s = step - 1, pair = s / 14, r = s % 14;
            if (r < 9) { L = 2 * pair; kind = r == 0 ? K_MODNORM : r == 1 ? K_GEMM_IN : r == 2 ? K_PREP_AB : r == 3 ? K_GEMM_QUP : r == 4 ? K_GEMM_KVUP : r == 5 ? K_HN_AB : r == 6 ? K_MIX_AB : r == 7 ? K_FIN_AB : K_GEMM_OUT; }
            else { L = 2 * pair + 1; const int q = r - 9; kind = q == 0 ? K_MODNORM : q == 1 ? K_GEMM_IN : q == 2 ? K_HN_C : q == 3 ? K_ATTN_C : K_GEMM_OUT; } }
        const int j = L >> 1; const bool isC = (L & 1) != 0;
        if (kind == K_GEMM_QUP) sync_after = false;
        if (step == 28) sync_after = false;

#ifndef PROBE_MASK
#define PROBE_MASK 0
#endif
#ifndef PROBE_SEL
#define PROBE_SEL 0
#endif
#ifndef PROBE_REPS
#define PROBE_REPS 2
#endif
        const int nrep = (((PROBE_MASK >> kind) & 1) && (kind != K_GEMM_OUT || L == 0)) ? 1 + PROBE_REPS : 1;
        for (int rep = 0; rep < nrep; ++rep) {
        if (PROBE_MASK == 0x1000) { for (int q = 0; q < 2; ++q) xcd_barrier(xbar); }
        if (kind == K_P0) phase_p0(a, lds);
        else if (kind == K_MODNORM) phase_modnorm(a, L);
        else if (kind == K_GEMM_IN || kind == K_GEMM_QUP || kind == K_GEMM_KVUP) {
            pg8::Gemm g; pg8::EpiStore E;
            if (kind == K_GEMM_IN) {
                if (!isC) { g = pg8::Gemm{(const bf16_t*)(ws + WS_H), (const bf16_t*)(ws + WS_WINAB) + (size_t)j * 7168 * 2048, MROWS, 7168, 2048}; E = pg8::EpiStore{(bf16_t*)(ws + WS_PROJ), LDP_AB}; }
                else { g = pg8::Gemm{(const bf16_t*)(ws + WS_H), (const bf16_t*)(ws + WS_WINC) + (size_t)j * 5120 * 2048, MROWS, 5120, 2048}; E = pg8::EpiStore{(bf16_t*)(ws + WS_PROJ), LDP_C}; }
            } else if (kind == K_GEMM_QUP) { g = pg8::Gemm{(const bf16_t*)(ws + WS_QN), (const bf16_t*)(ws + WS_WQUP) + (size_t)j * 1536 * 512, MROWS, 1536, 512}; E = pg8::EpiStore{(bf16_t*)(ws + WS_QRAW), 1536}; }
            else { g = pg8::Gemm{(const bf16_t*)(ws + WS_CKV), (const bf16_t*)(ws + WS_WKVUP) + (size_t)j * 2048 * 256, MKROWS, 2048, 256}; E = pg8::EpiStore{(bf16_t*)(ws + WS_KVRAW), 2048}; }
            pg8::StaticOrder S; S.init(g.M, g.N, G, obid());
            pg8::gemm_phase<pg8::EpiStore, pg8::StaticOrder, true, true>(lds, g, S, E);
        }
        else if (kind == K_GEMM_OUT) {
            pg8::Gemm g{(const bf16_t*)(ws + WS_H), (const bf16_t*)(ws + (isC ? WS_WOUTC : WS_WOUTAB)) + (size_t)j * 2048 * 2048, MROWS, 2048, 2048};
            pg8::EpiResid E{L == 0 ? a->in[0] : a->out, L == 0 ? a->in[1] : a->out + (size_t)MC * DM, a->out, (const float*)(ws + WS_MOD) + (size_t)L * 5 * 6144 + 4096};
            pg8::StaticOrder S; S.init(g.M, g.N, G, obid());
            pg8::gemm_phase<pg8::EpiResid, pg8::StaticOrder, true, true>(lds, g, S, E);
        }
        else if (kind == K_PREP_AB) phase_prep_ab(a, j);
        else if (kind == K_HN_AB) phase_hn_ab(a, j);
        else if (kind == K_FIN_AB) phase_fin_ab(a, j);
        else if (kind == K_HN_C) phase_hn_c(a, j);
        else if (kind == K_MIX_AB) {
            unsigned* ctr = ctl + 64 * step + 8 * rep;
            const bf16_t* P = (const bf16_t*)(ws + WS_PROJ); bf16_t* MIX = (bf16_t*)(ws + WS_H);
            const bf16_t* QF = (const bf16_t*)(ws + WS_QRAW); const bf16_t* KF = (const bf16_t*)(ws + WS_KF); const bf16_t* KV = (const bf16_t*)(ws + WS_KVRAW);
            for (;;) {
                const int idx = fetch_item(ctr, slot);
                if (idx >= 704) break;
                if (idx < 64 || (idx >= 320 && idx < 576)) {
                    const bool lat = idx < 64; const int i = lat ? idx : idx - 320; const int b = i >> 4, h = (i >> 1) & 7, dir = i & 1;
                    const float* lb = (const float*)(ws + WS_LB) + (j * 2 + dir) * 1024 + h * 128;
                    const float* s0 = lat ? a->in[4 + dir] + (size_t)((b * 2 + j) * 8 + h) * 16384 : nullptr;
                    float* so = lat ? nullptr : a->out + (dir ? O_SB : O_SF) + (size_t)((b * 2 + j) * 8 + h) * 16384;
                    if (PROBE_SEL != 1 || rep == 0) hgrn_item(lds, P, lat ? MC + b * 2048 : b * 256, lat ? 2048 : 256, h, dir, lb, s0, so, (bf16_t*)(ws + (dir ? WS_OB : WS_OF)));
                } else {
                    att::Item it;
                    const bool lat = idx < 320; int b, h, r0;
                    if (lat) { const int i = idx - 64; b = i >> 6; h = (i >> 3) & 7; const int qb = i & 7; r0 = MC + b * 2048 + qb * 256; it.q0 = qb * 256;
                        it.K0 = KF + (size_t)(MROWS + b * 256) * 1536 + h * 192; it.V0 = KV + (size_t)(MROWS + b * 256) * 2048 + h * 256 + 128; it.n0 = 4;
                        it.K1 = KF + (size_t)(MC + b * 2048) * 1536 + h * 192; it.V1 = KV + (size_t)(MC + b * 2048) * 2048 + h * 256 + 128; it.t_lo = 0; it.t_hi = 32; }
                    else { const int i = idx - 576; b = i >> 3; h = i & 7; r0 = b * 256; it.q0 = 0;
                        it.K0 = KF; it.V0 = KV; it.n0 = 0;
                        it.K1 = KF + (size_t)r0 * 1536 + h * 192; it.V1 = KV + (size_t)r0 * 2048 + h * 256 + 128; it.t_lo = 0; it.t_hi = 4; }
                    it.ldk = 1536; it.ldv = 2048;
                    it.Q = QF + (size_t)r0 * 1536 + h * 192; it.ldq = 1536; it.band = 0; it.m0 = -1e30f; it.l0 = 0.f;
                    it.qg = a->in[18] + j * 192; it.rope = lat ? (const float*)(ws + WS_ROPEA) : nullptr; it.qscale = QSC_A;
                    it.G = P + (size_t)r0 * LDP_AB + COL_AG + h * 128; it.ldg = LDP_AB; it.O = MIX + (size_t)r0 * DM + h * 128; it.ldo = DM;
                    if (PROBE_SEL != 2 || rep == 0) att::attn_item<192>(lds, it);
                }
            }
        }
        else if (kind == K_ATTN_C) {
            unsigned* ctr = ctl + 64 * step + 8 * rep;
            const bf16_t* P = (const bf16_t*)(ws + WS_PROJ); bf16_t* MIX = (bf16_t*)(ws + WS_H);
            const bf16_t* KCC = (const bf16_t*)(ws + WS_KCC);
            for (;;) {
                const int idx = fetch_item(ctr, slot);
                if (idx >= 768) break;
                att::Item it; int b, h, r0;
                if (idx < 512) { b = idx >> 7; h = (idx >> 3) & 15; const int qb = idx & 7; r0 = MC + b * 2048 + qb * 256; const int kvh = h >> 2;
                    it.K0 = KCC + (size_t)((b * 2 + j) * 256) * LDP_C + kvh * 128; it.V0 = KCC + (size_t)((b * 2 + j) * 256) * LDP_C + 512 + kvh * 128; it.n0 = 4;
                    it.K1 = P + (size_t)(MC + b * 2048) * LDP_C + 2048 + kvh * 128; it.V1 = P + (size_t)(MC + b * 2048) * LDP_C + 2560 + kvh * 128;
                    it.t_lo = 4 * qb - 2 < 0 ? 0 : 4 * qb - 2; it.t_hi = 4 * qb + 6 > 32 ? 32 : 4 * qb + 6; it.q0 = qb * 256; it.band = 1; }
                else { const int i = idx - 512; b = i >> 4; h = i & 15; r0 = b * 256; const int kvh = h >> 2;
                    it.K0 = KCC; it.V0 = KCC; it.n0 = 0;
                    it.K1 = P + (size_t)r0 * LDP_C + 2048 + kvh * 128; it.V1 = P + (size_t)r0 * LDP_C + 2560 + kvh * 128; it.t_lo = 0; it.t_hi = 4; it.q0 = 0; it.band = 0; }
                it.ldk = LDP_C; it.ldv = LDP_C;
                it.Q = P + (size_t)r0 * LDP_C + h * 128; it.ldq = LDP_C; it.m0 = a->in[29][j * 16 + h] * LOG2E; it.l0 = 1.f;
                it.qg = a->in[27] + j * 128; it.rope = idx < 512 ? (const float*)(ws + WS_ROPEC) : nullptr; it.qscale = QSC_C;
                it.G = P + (size_t)r0 * LDP_C + 3072 + h * 128; it.ldg = LDP_C; it.O = MIX + (size_t)r0 * DM + h * 128; it.ldo = DM;
                att::attn_item<128>(lds, it);
            }
        }
        if (rep + 1 < nrep) xcd_barrier(xbar);
        }
        if (sync_after) { if (step == 0) grid.sync(); xcd_barrier(xbar); }
    }
}

extern "C" void kernel_launch(void* const* d_in, const int* in_sizes, int n_in, void* d_out, int out_size, void* d_ws, size_t ws_size, hipStream_t stream) {
    static int grid = 0;
    if (grid == 0) {
        if (n_in != 31 || ws_size < WS_END) { fprintf(stderr, "kernel_launch: unexpected n_in %d or ws_size %zu (< %zu)\n", n_in, ws_size, (size_t)WS_END); grid = -1; return; }
        int dev = 0, cus = 0, per_cu = 0;
        hipGetDevice(&dev); hipDeviceGetAttribute(&cus, hipDeviceAttributeMultiprocessorCount, dev);
        if (hipFuncSetAttribute((const void*)mk_fwd, hipFuncAttributeMaxDynamicSharedMemorySize, LDS_BYTES) != hipSuccess) { fprintf(stderr, "kernel_launch: hipFuncSetAttribute failed\n"); grid = -1; return; }
        if (hipOccupancyMaxActiveBlocksPerMultiprocessor(&per_cu, (const void*)mk_fwd, NTHR, LDS_BYTES) != hipSuccess || per_cu < 1) per_cu = 1;
        (void)hipGetLastError();
        grid = cus > 0 ? cus : 256;
    }
    if (grid < 0) return;
    hipMemsetAsync((char*)d_ws + WS_CTL, 0, CTL_BYTES, stream);
    Args a{};
    for (int i = 0; i < 31; ++i) a.in[i] = (const float*)d_in[i];
    a.out = (float*)d_out; a.ws = (unsigned char*)d_ws;
    void* args[] = {&a};
    hipError_t e = hipLaunchCooperativeKernel((const void*)mk_fwd, dim3(grid), dim3(NTHR), args, LDS_BYTES, stream);
    if (e != hipSuccess) fprintf(stderr, "cooperative launch failed: %s (grid %d)\n", hipGetErrorString(e), grid);
}
```

```cpp
#include <hip/hip_runtime.h>
#include <hip/hip_cooperative_groups.h>
#include <cstdio>
#include <cstdint>
namespace cg = cooperative_groups;

namespace pg8 {
#define PG8_LAS __attribute__((address_space(3)))
typedef unsigned short bf16_t;
typedef short bf16x8 __attribute__((ext_vector_type(8)));
typedef float f32x4 __attribute__((ext_vector_type(4)));
typedef unsigned u32x4 __attribute__((ext_vector_type(4)));
constexpr int BM = 256, BK = 64, HALF = 128, HTB = HALF * BK * 2  , STAGE_BYTES = 8 * HTB, NXCD = 8, WGM = 8;
__device__ __forceinline__ int pg8_otid() { int t = threadIdx.x; asm volatile("" : "+v"(t)); return t; }

__host__ __device__ __forceinline__ int lds_byte(int r, int c) { const int st = (r >> 4) * 2 + (c >> 5), rr = r & 15, cc = c & 31, ob = rr * 64 + cc * 2; return st * 1024 + (ob ^ (((ob >> 9) & 1) << 5)); }
__host__ __device__ __forceinline__ void stage_rc(int b, int& R, int& C) { const int st = b / 1024, sb = b % 1024, swz = sb ^ (((sb >> 9) & 1) << 5); R = (st >> 1) * 16 + swz / 64; C = (st & 1) * 32 + (swz % 64) / 2; }
__host__ __device__ __forceinline__ int perm32(int rho) { const int n = rho >> 4, i = rho & 15; return 8 * (i >> 2) + 4 * n + (i & 3); }

struct Unit { int pm, pn, kp, np, tix; };
struct Gemm { const bf16_t* A; const bf16_t* Bt; int M, N, K; };

struct StaticOrder {
    int nM, nN, nwg, G, c;
    __host__ __device__ void init(int M, int N, int G_, int c_) { nM = M / BM; nN = N / BM; nwg = nM * nN; G = G_; c = c_; }
    __host__ __device__ bool next(int i, Unit& u) const {
        const long L = (long)i * G + c; if (L >= nwg) return false;
        int wgid = (int)L; { const int q = nwg / NXCD, r = nwg % NXCD, xcd = wgid % NXCD, off = wgid / NXCD; wgid = (xcd < r ? xcd * (q + 1) : r * (q + 1) + (xcd - r) * q) + off; }
        const int nig = WGM * nN, gid = wgid / nig, fm = gid * WGM, gsz = (nM - fm) < WGM ? (nM - fm) : WGM;
        u.pm = fm + ((wgid % nig) % gsz); u.pn = (wgid % nig) / gsz; u.kp = 0; u.np = 1; u.tix = 0; return true;
    }
    __device__ __forceinline__ void a_ready(const Unit&) const {}
    __device__ __forceinline__ void done(const Unit&) const {}
};
struct SplitOrder {
    StaticOrder so; int R, np;
    __host__ __device__ void init(int M, int N, int K, int G_, int c_) { so.init(M, N, G_, c_); R = so.nwg / G_; const int left = so.nwg - R * G_;
        np = 1; if (left > 0 && G_ % left == 0) { const int q = G_ / left; if (q == 2 && (K / q) % 128 == 0) np = q; } }
    __host__ __device__ bool next(int i, Unit& u) const {
        if (np == 1 || i < R) return so.next(i, u);
        if (i > R) return false;
        StaticOrder t = so; t.c = so.c / np; const bool ok = t.next(i, u); u.kp = so.c % np; u.np = np; u.tix = so.c / np; return ok;
    }
    __device__ __forceinline__ void a_ready(const Unit&) const {}
    __device__ __forceinline__ void done(const Unit&) const {}
};

typedef float f32x2c __attribute__((ext_vector_type(2)));
typedef __bf16 bf16x2c __attribute__((ext_vector_type(2)));
__device__ __forceinline__ unsigned cvt_pk_bf16(float lo, float hi) { const f32x2c v = {lo, hi}; const bf16x2c b = __builtin_convertvector(v, bf16x2c); return __builtin_bit_cast(unsigned, b); }

struct EpiStore {
    static constexpr bool PERM = true, AFTER_DRAIN = false;
    bf16_t* O; int ldc;
    __device__ __forceinline__ void operator()(const f32x4 (&acc)[2][2][4][2], const Unit& u, int wr, int wc, int fr, int fq) const {
        const int row0 = u.pm * BM + wr * 64 + fr; const int col0 = u.pn * BM + wc * 32 + 8 * fq;
#pragma unroll
        for (int ai = 0; ai < 2; ++ai)
#pragma unroll
            for (int m = 0; m < 4; ++m) { bf16_t* rowp = O + (size_t)(row0 + ai * HALF + m * 16) * ldc + col0;
#pragma unroll
                for (int bj = 0; bj < 2; ++bj) { const f32x4 v0 = acc[ai][bj][m][0], v1 = acc[ai][bj][m][1];
                    u32x4 w; w.x = cvt_pk_bf16(v0[0], v0[1]); w.y = cvt_pk_bf16(v0[2], v0[3]); w.z = cvt_pk_bf16(v1[0], v1[1]); w.w = cvt_pk_bf16(v1[2], v1[3]);
                    *(u32x4*)(rowp + bj * HALF) = w; } }
    }
};
struct EpiResid {
    static constexpr bool PERM = true, AFTER_DRAIN = false;
    const float* xin_ctx; const float* xin_lat; float* out; const float* gate_base;
    float* slab; unsigned* cnt;
    __device__ __forceinline__ void operator()(f32x4 (&acc)[2][2][4][2], const Unit& u, int wr, int wc, int fr, int fq) const {
        const int tid = (wr * 4 + wc) * 64 + fq * 16 + fr;
        const f32x4* sl = nullptr;
        if (u.np > 1) {
            float* sb = slab + (size_t)u.tix * (u.np - 1) * 65536;
            if (u.kp < u.np - 1) {
                f32x4* sp = (f32x4*)(sb + (size_t)u.kp * 65536) + tid;
#pragma unroll
                for (int ai = 0; ai < 2; ++ai)
#pragma unroll
                    for (int bj = 0; bj < 2; ++bj)
#pragma unroll
                        for (int m = 0; m < 4; ++m)
#pragma unroll
                            for (int n = 0; n < 2; ++n) sp[(((ai * 2 + bj) * 4 + m) * 2 + n) * 512] = acc[ai][bj][m][n];
                asm volatile("s_waitcnt vmcnt(0)" ::: "memory");
                __syncthreads();
                if (tid == 0) { __builtin_amdgcn_fence(__ATOMIC_RELEASE, "agent"); asm volatile("s_waitcnt vmcnt(0)" ::: "memory");
                    __hip_atomic_fetch_add(cnt + u.tix, 1u, __ATOMIC_RELAXED, __HIP_MEMORY_SCOPE_AGENT); }
                return;
            }
            if (tid == 0) { unsigned sp_ = 0;
                while (__hip_atomic_load(cnt + u.tix, __ATOMIC_RELAXED, __HIP_MEMORY_SCOPE_AGENT) < (unsigned)(u.np - 1)) { __builtin_amdgcn_s_sleep(2); if (++sp_ > (1u << 22)) break; }
                __builtin_amdgcn_fence(__ATOMIC_ACQUIRE, "agent"); asm volatile("s_waitcnt vmcnt(0)" ::: "memory"); }
            __syncthreads();
            sl = (const f32x4*)sb + tid;
        }
        const int pm = u.pm;
        const float* xin = pm < 16 ? xin_ctx + (size_t)pm * 256 * 2048 : xin_lat + (size_t)(pm - 16) * 256 * 2048;
        float* xo = out + (size_t)pm * 256 * 2048;
        const int ci = pm < 16 ? 4 : ((pm - 16) >> 3);
        const float* gt = gate_base + ci * 6144;
        const int rl0 = wr * 64 + fr, col0 = u.pn * BM + wc * 32 + 8 * fq;
        f32x4 xa[4][2], xb[4][2];
#define EPI_LOADQ(dst, ai_, bj_) do { _Pragma("unroll") for (int m = 0; m < 4; ++m) { const unsigned off = (unsigned)((rl0 + (ai_) * HALF + m * 16) * 2048 + col0 + (bj_) * HALF); \
            dst[m][0] = *(const f32x4*)(xin + off); dst[m][1] = *(const f32x4*)(xin + off + 4); } } while (0)
#define EPI_EMITQ(src, ai_, bj_) do { const f32x4 gq0 = *(const f32x4*)(gt + col0 + (bj_) * HALF), gq1 = *(const f32x4*)(gt + col0 + (bj_) * HALF + 4); _Pragma("unroll") for (int m = 0; m < 4; ++m) { const unsigned off = (unsigned)((rl0 + (ai_) * HALF + m * 16) * 2048 + col0 + (bj_) * HALF); \
            f32x4 a0 = acc[ai_][bj_][m][0], a1 = acc[ai_][bj_][m][1]; \
            if (sl) { a0 += sl[((((ai_) * 2 + (bj_)) * 4 + m) * 2 + 0) * 512]; a1 += sl[((((ai_) * 2 + (bj_)) * 4 + m) * 2 + 1) * 512]; } \
            *(f32x4*)(xo + off) = src[m][0] + gq0 * a0; *(f32x4*)(xo + off + 4) = src[m][1] + gq1 * a1; } } while (0)
        EPI_LOADQ(xa, 0, 0); EPI_LOADQ(xb, 0, 1);
        EPI_EMITQ(xa, 0, 0); asm volatile("" ::: "memory");
        EPI_LOADQ(xa, 1, 0);
        EPI_EMITQ(xb, 0, 1); asm volatile("" ::: "memory");
        EPI_LOADQ(xb, 1, 1);
        EPI_EMITQ(xa, 1, 0); asm volatile("" ::: "memory");
        EPI_EMITQ(xb, 1, 1);
#undef EPI_LOADQ
#undef EPI_EMITQ
    }
};

template <class Epi, class Sched, bool ALIGN_EPI = false, bool SP2 = false>
__device__ __forceinline__ void gemm_phase(PG8_LAS unsigned char* lds, const Gemm g, const Sched& S, const Epi& E) {
    const int tid = pg8_otid(), wid = __builtin_amdgcn_readfirstlane(tid >> 6), lane = tid & 63, wr = wid >> 2, wc = wid & 3, fr = lane & 15, fq = lane >> 4;
    const int K = g.K, nt = K / BK;
    unsigned voffA[2], voffB[2];
#pragma unroll
    for (int i = 0; i < 2; ++i) { int R, C; stage_rc(tid * 16 + i * 8192, R, C); const int Rb = Epi::PERM ? ((R & ~31) + perm32(R & 31)) : R;
        voffA[i] = (unsigned)(R * K + C) * 2u; voffB[i] = (unsigned)(Rb * K + C) * 2u; }
    const size_t kstep = (size_t)(BK * 2);
    const size_t hstep = (size_t)HALF * K * 2;
    const size_t tstep = 2 * hstep;
    const unsigned ldsw = (unsigned)wid * 1024u;
    const int aoff = lds_byte(wr * 64 + fr, fq * 8), boff = lds_byte(wc * 32 + fr, fq * 8);
#define PG8_SA(b, h) (((b) * 2 + (h)) * HTB)
#define PG8_SB(b, h) ((4 + (b) * 2 + (h)) * HTB)
#define PG8_STAGE(bufoff, gbase, voff) do { _Pragma("unroll") for (int _i = 0; _i < 2; ++_i) \
        __builtin_amdgcn_global_load_lds((const unsigned*)((const char*)(gbase) + (voff)[_i]), (PG8_LAS unsigned*)(lds + (bufoff) + ldsw + _i * 8192), 16, 0, 0); } while (0)
#define PG8_LDA(dst, b, h) do { _Pragma("unroll") for (int m = 0; m < 4; ++m) _Pragma("unroll") for (int k = 0; k < 2; ++k) dst[m][k] = *(const PG8_LAS bf16x8*)(lds + PG8_SA(b, h) + aoff + m * 2048 + k * 1024); } while (0)
#define PG8_LDB(dst, b, h) do { _Pragma("unroll") for (int n = 0; n < 2; ++n) _Pragma("unroll") for (int k = 0; k < 2; ++k) dst[n][k] = *(const PG8_LAS bf16x8*)(lds + PG8_SB(b, h) + boff + n * 2048 + k * 1024); } while (0)
#define PG8_MMA(ai, bj, At, Bt) do { __builtin_amdgcn_s_setprio(1); _Pragma("unroll") for (int m = 0; m < 4; ++m) _Pragma("unroll") for (int n = 0; n < 2; ++n) _Pragma("unroll") for (int k = 0; k < 2; ++k) \
        acc[ai][bj][m][n] = __builtin_amdgcn_mfma_f32_16x16x32_bf16(Bt[n][k], At[m][k], acc[ai][bj][m][n], 0, 0, 0); __builtin_amdgcn_s_setprio(0); } while (0)
#define PG8_WAIT_V(n) asm volatile("s_waitcnt vmcnt(" #n ")" ::: "memory")
#define PG8_WAIT_L(n) asm volatile("s_waitcnt lgkmcnt(" #n ")" ::: "memory")
#define PG8_BAR __builtin_amdgcn_s_barrier()
#define PG8_SCHED __builtin_amdgcn_sched_barrier(0)
    Unit cur, nxt; int ui = 0;
    if (!S.next(0, cur)) return;
    f32x4 acc[2][2][4][2];
#pragma unroll
    for (int a = 0; a < 2; ++a)
#pragma unroll
        for (int b = 0; b < 2; ++b)
#pragma unroll
            for (int m = 0; m < 4; ++m)
#pragma unroll
                for (int n = 0; n < 2; ++n) acc[a][b][m][n] = (f32x4){0.f, 0.f, 0.f, 0.f};
    bf16x8 At[4][2], B0[2][2], B1[2][2];
    const char* cA = (const char*)g.A + (size_t)cur.pm * tstep + (size_t)cur.kp * (K / cur.np) * 2; const char* cB = (const char*)g.Bt + (size_t)cur.pn * tstep + (size_t)cur.kp * (K / cur.np) * 2;
    S.a_ready(cur);
    if constexpr (SP2) {
        PG8_STAGE(PG8_SB(0, 0), cB, voffB); PG8_STAGE(PG8_SB(0, 1), cB + hstep, voffB); PG8_STAGE(PG8_SA(0, 0), cA, voffA); PG8_STAGE(PG8_SA(0, 1), cA + hstep, voffA);
        if (wr == 1) PG8_BAR;
        PG8_WAIT_V(2); PG8_BAR;
        PG8_STAGE(PG8_SB(1, 0), cB + kstep, voffB); PG8_STAGE(PG8_SA(1, 0), cA + kstep, voffA); PG8_STAGE(PG8_SB(1, 1), cB + hstep + kstep, voffB);
        PG8_WAIT_V(6); PG8_BAR;
    } else {
        PG8_STAGE(PG8_SB(0, 0), cB, voffB); PG8_STAGE(PG8_SA(0, 0), cA, voffA); PG8_STAGE(PG8_SB(0, 1), cB + hstep, voffB); PG8_STAGE(PG8_SA(0, 1), cA + hstep, voffA);
        if (wr == 1) PG8_BAR;
        PG8_WAIT_V(4); PG8_BAR;
        PG8_STAGE(PG8_SB(1, 0), cB + kstep, voffB); PG8_STAGE(PG8_SA(1, 0), cA + kstep, voffA); PG8_STAGE(PG8_SB(1, 1), cB + hstep + kstep, voffB);
        PG8_WAIT_V(6); PG8_BAR;
    }
    for (;;) {
        const bool has_next = S.next(ui + 1, nxt);
        const size_t nko = has_next ? (size_t)nxt.kp * (K / nxt.np) * 2 : 0; const char* nA = has_next ? (const char*)g.A + (size_t)nxt.pm * tstep + nko : cA; const char* nB = has_next ? (const char*)g.Bt + (size_t)nxt.pn * tstep + nko : cB;
        const int ntc = nt / cur.np;
        for (int t = 0; t < ntc; t += 2) {
            const bool last = (t == ntc - 2);
            const char* a1 = cA + (size_t)(t + 1) * kstep;
            const char* a2 = last ? nA : cA + (size_t)(t + 2) * kstep; const char* b2 = last ? nB : cB + (size_t)(t + 2) * kstep;
            const char* a3 = a2 + kstep; const char* b3 = b2 + kstep;
            if (last && has_next) S.a_ready(nxt);
            if constexpr (SP2) {
            PG8_LDB(B0, 0, 0); PG8_LDB(B1, 0, 1); PG8_SCHED; PG8_LDA(At, 0, 0); PG8_STAGE(PG8_SA(1, 1), a1 + hstep, voffA);
            PG8_WAIT_V(8); PG8_WAIT_L(0); PG8_BAR; PG8_MMA(0, 0, At, B0); PG8_MMA(0, 1, At, B1); PG8_BAR; PG8_SCHED;
            PG8_LDA(At, 0, 1); PG8_STAGE(PG8_SB(0, 0), b2, voffB); PG8_STAGE(PG8_SB(0, 1), b2 + hstep, voffB); PG8_STAGE(PG8_SA(0, 0), a2, voffA);
            PG8_WAIT_V(8); PG8_WAIT_L(0); PG8_BAR; PG8_MMA(1, 0, At, B0); PG8_MMA(1, 1, At, B1); PG8_BAR; PG8_SCHED;
            PG8_LDB(B0, 1, 0); PG8_LDB(B1, 1, 1); PG8_SCHED; PG8_LDA(At, 1, 0); PG8_STAGE(PG8_SA(0, 1), a2 + hstep, voffA);
            PG8_WAIT_V(8); PG8_WAIT_L(0); PG8_BAR; PG8_MMA(0, 0, At, B0); PG8_MMA(0, 1, At, B1); PG8_BAR; PG8_SCHED;
            PG8_LDA(At, 1, 1); PG8_STAGE(PG8_SB(1, 0), b3, voffB); PG8_STAGE(PG8_SB(1, 1), b3 + hstep, voffB); PG8_STAGE(PG8_SA(1, 0), a3, voffA);
            PG8_WAIT_V(8); PG8_WAIT_L(0); PG8_BAR; PG8_MMA(1, 0, At, B0); PG8_MMA(1, 1, At, B1); PG8_BAR; PG8_SCHED;
            } else {
            PG8_LDB(B0, 0, 0); PG8_SCHED; PG8_LDA(At, 0, 0); PG8_STAGE(PG8_SA(1, 1), a1 + hstep, voffA);
            PG8_WAIT_L(8); PG8_BAR; PG8_WAIT_L(0); PG8_MMA(0, 0, At, B0); PG8_BAR; PG8_SCHED;
            PG8_LDB(B1, 0, 1); PG8_STAGE(PG8_SB(0, 0), b2, voffB);
            PG8_BAR; PG8_WAIT_L(0); PG8_MMA(0, 1, At, B1); PG8_BAR;
            PG8_LDA(At, 0, 1); PG8_STAGE(PG8_SA(0, 0), a2, voffA);
            PG8_BAR; PG8_WAIT_L(0); PG8_MMA(1, 0, At, B0); PG8_BAR; PG8_SCHED;
            PG8_STAGE(PG8_SB(0, 1), b2 + hstep, voffB);
            PG8_WAIT_V(6); PG8_BAR; PG8_MMA(1, 1, At, B1); PG8_BAR;
            PG8_LDB(B0, 1, 0); PG8_SCHED; PG8_LDA(At, 1, 0); PG8_STAGE(PG8_SA(0, 1), a2 + hstep, voffA);
            PG8_WAIT_L(8); PG8_BAR; PG8_WAIT_L(0); PG8_MMA(0, 0, At, B0); PG8_BAR; PG8_SCHED;
            PG8_LDB(B1, 1, 1); PG8_STAGE(PG8_SB(1, 0), b3, voffB);
            PG8_BAR; PG8_WAIT_L(0); PG8_MMA(0, 1, At, B1); PG8_BAR;
            PG8_LDA(At, 1, 1); PG8_STAGE(PG8_SA(1, 0), a3, voffA);
            PG8_BAR; PG8_WAIT_L(0); PG8_MMA(1, 0, At, B0); PG8_BAR; PG8_SCHED;
            PG8_STAGE(PG8_SB(1, 1), b3 + hstep, voffB);
            PG8_WAIT_V(6); PG8_BAR; PG8_MMA(1, 1, At, B1); PG8_BAR;
            }
        }
        if constexpr (ALIGN_EPI) { if (wr == 0) PG8_BAR; }
        if constexpr (!Epi::AFTER_DRAIN) { E(acc, cur, wr, wc, fr, fq); S.done(cur); }
        if (!has_next) break;
#pragma unroll
        for (int a = 0; a < 2; ++a)
#pragma unroll
            for (int b = 0; b < 2; ++b)
#pragma unroll
                for (int m = 0; m < 4; ++m)
#pragma unroll
                    for (int n = 0; n < 2; ++n) acc[a][b][m][n] = (f32x4){0.f, 0.f, 0.f, 0.f};
        cur = nxt; cA = nA; cB = nB; ++ui;
        if constexpr (ALIGN_EPI) { if (wr == 1) PG8_BAR; }
    }
    PG8_WAIT_V(0);
    if constexpr (!ALIGN_EPI) { if (wr == 0) PG8_BAR; }
    PG8_BAR;
    if constexpr (Epi::AFTER_DRAIN) { E.fused(acc, cur, wr, wc, fr, fq, lds, wid, lane); S.done(cur); }
#undef PG8_SA
#undef PG8_SB
#undef PG8_STAGE
#undef PG8_LDA
#undef PG8_LDB
#undef PG8_MMA
#undef PG8_WAIT_V
#undef PG8_WAIT_L
#undef PG8_BAR
#undef PG8_SCHED
}
}

#define LAS __attribute__((address_space(3)))
typedef unsigned short bf16_t;
typedef short bf16x8 __attribute__((ext_vector_type(8)));
typedef short s16x4 __attribute__((ext_vector_type(4)));
typedef float f32x4 __attribute__((ext_vector_type(4)));
typedef float f32x16 __attribute__((ext_vector_type(16)));
typedef unsigned u32x4 __attribute__((ext_vector_type(4)));
typedef unsigned u32x2 __attribute__((ext_vector_type(2)));


__device__ __forceinline__ int otid() { int t = threadIdx.x; asm volatile("" : "+v"(t)); return t; }
__device__ __forceinline__ unsigned ozero() { unsigned z = 0u; asm volatile("" : "+v"(z)); return z; }
__device__ __forceinline__ int obid() { int b = blockIdx.x; asm volatile("" : "+s"(b)); return b; }
constexpr int NWAVES = 8, NTHR = 512;
constexpr int DM = 2048, MC = 4096, ML = 8192, MROWS = 12288, MKROWS = 13312;
constexpr int LDP_AB = 7168, LDP_C = 5120;
constexpr int COL_QL = 0, COL_KVL = 512, COL_AG = 768, COL_BQ = 1792, COL_FF = 2816, COL_FB = 3840, COL_BI = 4864, COL_BG = 5888, COL_KPE = 6912;
constexpr float EPSN = 1e-6f;
constexpr float LOG2E = 1.4426950408889634f;
constexpr float QSC_A = 0.07216878364870322f * LOG2E;
constexpr float QSC_C = 0.08838834764831845f * LOG2E;

constexpr size_t O_YP = 0, O_YS = 8388608, O_CKV = 25165824, O_KPE = 27262976, O_SF = 27787264, O_SB = 31981568, O_KC = 36175872, O_VC = 40370176;

constexpr size_t MiB = 1u << 20;
constexpr size_t WS_CTL = 0, CTL_BYTES = 131072;
constexpr size_t WS_MOD = 1 * MiB, WS_LB = WS_MOD + 512 * 1024, WS_ROPEA = WS_LB + 64 * 1024, WS_ROPEC = WS_ROPEA + 512 * 1024;
constexpr size_t WS_KCC = 532 * MiB;
constexpr size_t WS_WINAB = 8 * MiB, WS_WQUP = 64 * MiB, WS_WKVUP = 67 * MiB, WS_WOUTAB = 69 * MiB, WS_WINC = 85 * MiB, WS_WOUTC = 125 * MiB;
constexpr size_t WS_H = 141 * MiB, WS_PROJ = 189 * MiB, WS_QRAW = 357 * MiB, WS_KVRAW = 393 * MiB, WS_KF = 445 * MiB, WS_OF = 484 * MiB, WS_OB = 508 * MiB;
constexpr size_t WS_QN = WS_OF, WS_CKV = WS_OF + 12 * MiB, WS_END = 552 * MiB;

constexpr int LDS_PHASE = 131072, LDS_BYTES = LDS_PHASE + 1024;

__device__ __forceinline__ float bf2f(unsigned short b) { return __uint_as_float((unsigned)b << 16); }
typedef float f32x2_t __attribute__((ext_vector_type(2)));
typedef __bf16 bf16x2_t __attribute__((ext_vector_type(2)));
__device__ __forceinline__ unsigned pk2(float lo, float hi) { const f32x2_t v = {lo, hi}; const bf16x2_t b = __builtin_convertvector(v, bf16x2_t); return __builtin_bit_cast(unsigned, b); }
__device__ __forceinline__ unsigned f2bf(float f) { return pk2(f, 0.f) & 0xffffu; }
__device__ __forceinline__ float silu_f(float x) { return x * __builtin_amdgcn_rcpf(1.f + __expf(-x)); }
__device__ __forceinline__ float wave_sum(float v) {
#pragma unroll
    for (int o = 1; o < 64; o <<= 1) v += __shfl_xor(v, o);
    return v;
}
__device__ __forceinline__ float sum16(float v) {
    v += __shfl_xor(v, 1); v += __shfl_xor(v, 2); v += __shfl_xor(v, 4); v += __shfl_xor(v, 8); return v;
}
__device__ __forceinline__ bf16x8 pack8(const float* v) {
    u32x4 w; w.x = pk2(v[0], v[1]); w.y = pk2(v[2], v[3]); w.z = pk2(v[4], v[5]); w.w = pk2(v[6], v[7]); return __builtin_bit_cast(bf16x8, w);
}

struct Args { const float* in[31]; float* out; unsigned char* ws; };
typedef const Args __attribute__((address_space(4)))* KArgs;

struct P0Item { const float* W; bf16_t* WT; int K, N, k0, n0, d0; };
__device__ __forceinline__ void p0_load(const P0Item& q, float (&v)[32], int lane) {
#pragma unroll
    for (int i = 0; i < 32; ++i) { const int kk = 2 * i + (lane >> 5); v[i] = q.W[(size_t)(q.k0 + kk) * q.N + q.n0 + (lane & 31)]; }
}
__device__ __forceinline__ void p0_emit(const P0Item& q, const float (&v)[32], LAS float* scr, int lane) {
#pragma unroll
    for (int i = 0; i < 32; ++i) { const int kk = 2 * i + (lane >> 5); scr[kk * 33 + (lane & 31)] = v[i]; }
    asm volatile("s_waitcnt lgkmcnt(0)" ::: "memory");
    const int c = lane & 7;
#pragma unroll
    for (int j = 0; j < 4; ++j) { const int n = (lane >> 3) + 8 * j; const LAS float* s = scr + (8 * c) * 33 + n;
        u32x4 o; o.x = pk2(s[0 * 33], s[1 * 33]); o.y = pk2(s[2 * 33], s[3 * 33]); o.z = pk2(s[4 * 33], s[5 * 33]); o.w = pk2(s[6 * 33], s[7 * 33]);
        *(u32x4*)(q.WT + (size_t)(q.d0 + n) * q.K + q.k0 + 8 * c) = o; }
    asm volatile("s_waitcnt lgkmcnt(0)" ::: "memory");
}
__device__ __forceinline__ P0Item p0_decode(KArgs a, int it) {
    constexpr int I_INAB = 32 * 218, I_QUP = 8 * 48, I_KVUP = 4 * 64, I_OUT = 32 * 64, I_INC = 32 * 160;
    constexpr int PER_J = I_INAB + I_QUP + I_KVUP + I_OUT + I_INC + I_OUT;
    unsigned char* ws = a->ws; P0Item q;
    const int j = it / PER_J; int r = it % PER_J;
    if (r < I_INAB) { const int kb = r / 218, nb = r % 218, n0 = nb * 32;
        q.W = a->in[13] + (size_t)j * 2048 * 6976; q.WT = (bf16_t*)(ws + WS_WINAB) + (size_t)j * 7168 * 2048; q.K = 2048; q.N = 6976; q.k0 = kb * 64; q.n0 = n0; q.d0 = n0 < 768 ? n0 : (n0 < 832 ? n0 + 6144 : n0 - 64); return q; }
    r -= I_INAB;
    if (r < I_QUP) { const int kb = r / 48, nb = r % 48;
        q.W = a->in[16] + (size_t)j * 512 * 1536; q.WT = (bf16_t*)(ws + WS_WQUP) + (size_t)j * 1536 * 512; q.K = 512; q.N = 1536; q.k0 = kb * 64; q.n0 = nb * 32; q.d0 = nb * 32; return q; }
    r -= I_QUP;
    if (r < I_KVUP) { const int kb = r / 64, nb = r % 64;
        q.W = a->in[17] + (size_t)j * 256 * 2048; q.WT = (bf16_t*)(ws + WS_WKVUP) + (size_t)j * 2048 * 256; q.K = 256; q.N = 2048; q.k0 = kb * 64; q.n0 = nb * 32; q.d0 = nb * 32; return q; }
    r -= I_KVUP;
    if (r < I_OUT) { const int kb = r / 64, nb = r % 64;
        q.W = a->in[22] + (size_t)j * 2048 * 2048; q.WT = (bf16_t*)(ws + WS_WOUTAB) + (size_t)j * 2048 * 2048; q.K = 2048; q.N = 2048; q.k0 = kb * 64; q.n0 = nb * 32; q.d0 = nb * 32; return q; }
    r -= I_OUT;
    if (r < I_INC) { const int kb = r / 160, nb = r % 160;
        q.W = a->in[26] + (size_t)j * 2048 * 5120; q.WT = (bf16_t*)(ws + WS_WINC) + (size_t)j * 5120 * 2048; q.K = 2048; q.N = 5120; q.k0 = kb * 64; q.n0 = nb * 32; q.d0 = nb * 32; return q; }
    r -= I_INC;
    { const int kb = r / 64, nb = r % 64;
        q.W = a->in[30] + (size_t)j * 2048 * 2048; q.WT = (bf16_t*)(ws + WS_WOUTC) + (size_t)j * 2048 * 2048; q.K = 2048; q.N = 2048; q.k0 = kb * 64; q.n0 = nb * 32; q.d0 = nb * 32; return q; }
}

__device__ __forceinline__ void phase_p0(KArgs a, LAS unsigned char* lds) {
    const int tid = otid(), lane = tid & 63, wave = tid >> 6;
    const int G = gridDim.x, bid = obid();
    const int gw = bid * NWAVES + wave, NGW = G * NWAVES;
    unsigned char* ws = a->ws;
    {
        LAS float* scr = (LAS float*)(lds + wave * 8448);
        constexpr int TOTAL = 2 * (32 * 218 + 8 * 48 + 4 * 64 + 32 * 64 + 32 * 160 + 32 * 64);
        for (int it = gw; it < TOTAL; it += 2 * NGW) {
            const bool two = it + NGW < TOTAL;
            const P0Item qa = p0_decode(a, it); const P0Item qb = p0_decode(a, two ? it + NGW : it);
            float va[32], vb[32];
            p0_load(qa, va, lane); if (two) p0_load(qb, vb, lane);
            p0_emit(qa, va, scr, lane); if (two) p0_emit(qb, vb, scr, lane);
        }
    }
    const int gt = bid * NTHR + tid, NGT = G * NTHR;
    const unsigned zz = ozero();
    for (int i = gt; i < 2 * 192 * 256; i += NGT) { const int j = i / (192 * 256), r = i % (192 * 256);
        *(u32x4*)((bf16_t*)(ws + WS_WINAB) + (size_t)j * 7168 * 2048 + (size_t)6976 * 2048 + (size_t)r * 8) = (u32x4){zz, zz, zz, zz}; }
    for (int i = gt; i < 2 * 131072; i += NGT) { const int which = i / 131072, e = (i % 131072) * 8;
        const float* src = a->in[6 + which] + e; const f32x4 x0 = *(const f32x4*)src, x1 = *(const f32x4*)(src + 4);
        u32x4 w; w.x = pk2(x0[0], x0[1]); w.y = pk2(x0[2], x0[3]); w.z = pk2(x1[0], x1[1]); w.w = pk2(x1[2], x1[3]);
        *(u32x4*)((bf16_t*)(ws + WS_KCC) + (size_t)(e >> 9) * LDP_C + (which ? 512 : 0) + (e & 511)) = w; }
    for (int i = gt; i < 2 * 2048; i += NGT) { const int j = i / 2048, r = i % 2048; const float l0 = a->in[20][r], l1 = a->in[20][2048 + r];
        ((float*)(ws + WS_LB))[i] = j == 0 ? 0.f : 1.f / (1.f + __expf(l0 - l1)); }
    for (int i = gt; i < 2048 * 32; i += NGT) { const int t = i >> 5, f = i & 31; const float pos = f < 16 ? (float)(t >> 6) : (float)(t & 63);
        const float inv = exp2f(-(float)(f & 15) * (13.287712379549449f / 16.f)); const float ang = pos * inv;
        ((float*)(ws + WS_ROPEA))[2 * i] = __cosf(ang); ((float*)(ws + WS_ROPEA))[2 * i + 1] = __sinf(ang); }
    for (int i = gt; i < 2048 * 64; i += NGT) { const int t = i >> 6, f = i & 63; const float pos = f < 32 ? (float)(t >> 6) : (float)(t & 63);
        const float inv = exp2f(-(float)(f & 31) * (13.287712379549449f / 32.f)); const float ang = pos * inv;
        ((float*)(ws + WS_ROPEC))[2 * i] = __cosf(ang); ((float*)(ws + WS_ROPEC))[2 * i + 1] = __sinf(ang); }
    __syncthreads();
    {
        LAS float* SC = (LAS float*)lds;
        LAS float* RED = (LAS float*)(lds + 40960);
        for (int i = tid; i < 5 * 2048; i += NTHR) { const int b = i >> 11, k = i & 2047; const float x = b < 4 ? a->in[8][b * 2048 + k] : a->in[9][k]; SC[i] = silu_f(x); }
        __syncthreads();
        const int cq = tid & 7, ks = tid >> 3;
        for (int u = bid; u < 768; u += G) {
            const int L = u / 192, col0 = (u % 192) * 32;
            const float* W = ((L & 1) ? a->in[23] : a->in[10]) + (size_t)(L >> 1) * 2048 * 6144;
            const float* bias = ((L & 1) ? a->in[24] : a->in[11]) + (size_t)(L >> 1) * 6144;
            f32x4 acc[5];
#pragma unroll
            for (int b = 0; b < 5; ++b) acc[b] = (f32x4){0.f, 0.f, 0.f, 0.f};
#pragma unroll 16
            for (int kk = 0; kk < 32; ++kk) { const int k = 32 * ks + kk; const f32x4 w = *(const f32x4*)(W + (size_t)k * 6144 + col0 + 4 * cq);
#pragma unroll
                for (int b = 0; b < 5; ++b) acc[b] += SC[b * 2048 + k] * w; }
#pragma unroll
            for (int b = 0; b < 5; ++b) *(LAS f32x4*)(RED + (ks * 5 + b) * 32 + 4 * cq) = acc[b];
            __syncthreads();
            if (tid < 160) { const int b = tid >> 5, c = tid & 31; float s = 0.f;
                for (int q = 0; q < 64; ++q) s += RED[(q * 5 + b) * 32 + c];
                ((float*)(ws + WS_MOD))[(L * 5 + b) * 6144 + col0 + c] = s + bias[col0 + c]; }
            __syncthreads();
        }
    }
}

__device__ __forceinline__ void phase_modnorm(KArgs a, int L) {
    const int tid = otid(), lane = tid & 63, wave = tid >> 6;
    const int gw = obid() * NWAVES + wave, NGW = gridDim.x * NWAVES;
    const float* g = ((L & 1) ? a->in[25] : a->in[12]) + (L >> 1) * 2048;
    bf16_t* H = (bf16_t*)(a->ws + WS_H);
    for (int r = gw; r < MROWS; r += NGW) {
        const float* x = L == 0 ? (r < MC ? a->in[0] + (size_t)r * DM : a->in[1] + (size_t)(r - MC) * DM) : a->out + (size_t)r * DM;
        const int ci = r < MC ? 4 : ((r - MC) >> 11);
        const float* md = (const float*)(a->ws + WS_MOD) + (L * 5 + ci) * 6144;
        f32x4 v[8]; float ss = 0.f;
#pragma unroll
        for (int j = 0; j < 8; ++j) { v[j] = *(const f32x4*)(x + 256 * j + 4 * lane); ss += (v[j][0] * v[j][0] + v[j][1] * v[j][1]) + (v[j][2] * v[j][2] + v[j][3] * v[j][3]); }
        const float rstd = rsqrtf(wave_sum(ss) * (1.f / 2048.f) + EPSN);
#pragma unroll
        for (int j = 0; j < 8; ++j) { const int c = 256 * j + 4 * lane;
            const f32x4 gg = *(const f32x4*)(g + c), sh = *(const f32x4*)(md + c), sc = *(const f32x4*)(md + 2048 + c);
            const f32x4 y = (v[j] * rstd * gg) * (sc + 1.f) + sh;
            u32x2 w; w.x = pk2(y[0], y[1]); w.y = pk2(y[2], y[3]);
            *(u32x2*)(H + (size_t)r * DM + c) = w; }
    }
}

__device__ __forceinline__ void phase_prep_ab(KArgs a, int j) {
    const int tid = otid(), lane = tid & 63, wave = tid >> 6;
    const int gw = obid() * NWAVES + wave, NGW = gridDim.x * NWAVES;
    const bf16_t* P = (const bf16_t*)(a->ws + WS_PROJ);
    bf16_t* QN = (bf16_t*)(a->ws + WS_QN); bf16_t* CKV = (bf16_t*)(a->ws + WS_CKV);
    const float* gq = a->in[14] + j * 512; const float* gkv = a->in[15] + j * 256;
    for (int r = gw; r < MKROWS; r += NGW) {
        if (r < MROWS) {
            const bf16_t* p = P + (size_t)r * LDP_AB;
            const bf16x8 q = *(const bf16x8*)(p + COL_QL + 8 * lane);
            float qv[8]; float ss = 0.f;
#pragma unroll
            for (int e = 0; e < 8; ++e) { qv[e] = bf2f((unsigned short)q[e]); ss += qv[e] * qv[e]; }
            const float rq = rsqrtf(wave_sum(ss) * (1.f / 512.f) + EPSN);
#pragma unroll
            for (int e = 0; e < 8; ++e) qv[e] = qv[e] * rq * gq[8 * lane + e];
            *(bf16x8*)(QN + (size_t)r * 512 + 8 * lane) = pack8(qv);
            const s16x4 kv = *(const s16x4*)(p + COL_KVL + 4 * lane);
            float kf[4]; float s2 = 0.f;
#pragma unroll
            for (int e = 0; e < 4; ++e) { kf[e] = bf2f((unsigned short)kv[e]); s2 += kf[e] * kf[e]; }
            const float rk = rsqrtf(wave_sum(s2) * (1.f / 256.f) + EPSN);
#pragma unroll
            for (int e = 0; e < 4; ++e) kf[e] = kf[e] * rk * gkv[4 * lane + e];
            u32x2 w; w.x = pk2(kf[0], kf[1]); w.y = pk2(kf[2], kf[3]);
            *(u32x2*)(CKV + (size_t)r * 256 + 4 * lane) = w;
            if (r < MC) { const int b = r >> 8, t = r & 255; const size_t rowo = (size_t)((b * 2 + j) * 256 + t);
                *(f32x4*)(a->out + O_CKV + rowo * 256 + 4 * lane) = (f32x4){kf[0], kf[1], kf[2], kf[3]};
                a->out[O_KPE + rowo * 64 + lane] = bf2f(p[COL_KPE + lane]); }
        } else {
            const int rr = r - MROWS, b = rr >> 8, t = rr & 255;
            const f32x4 x = *(const f32x4*)(a->in[2] + (size_t)((b * 2 + j) * 256 + t) * 256 + 4 * lane);
            u32x2 w; w.x = pk2(x[0], x[1]); w.y = pk2(x[2], x[3]);
            *(u32x2*)(CKV + (size_t)r * 256 + 4 * lane) = w;
        }
    }
}

__device__ __forceinline__ void phase_hn_ab(KArgs a, int j) {
    const int tid = otid(), lane = tid & 63, wave = tid >> 6, sub = lane & 15, hq = lane >> 4;
    const int gw = obid() * NWAVES + wave, NGW = gridDim.x * NWAVES;
    bf16_t* Q = (bf16_t*)(a->ws + WS_QRAW); const bf16_t* KV = (const bf16_t*)(a->ws + WS_KVRAW); bf16_t* KF = (bf16_t*)(a->ws + WS_KF);
    const bf16_t* P = (const bf16_t*)(a->ws + WS_PROJ);
    const float* RA = (const float*)(a->ws + WS_ROPEA);
    const float* gq = a->in[18] + j * 192; const float* gk = a->in[19] + j * 192;
    const float* ckpe = a->in[3];
    constexpr int U = 4;
    const int NQ = 0, NIT = MKROWS * 2;
    for (int base = gw * U; base < NIT; base += NGW * U) {
        bf16x8 vn[U]; float x1[U][2], x2[U][2]; f32x4 cs[U];
#pragma unroll
        for (int u = 0; u < U; ++u) { const int it = base + u; if (it < NIT) {
            const bool isq = it < NQ; const int w = isq ? it : it - NQ; const int r = w >> 1, h = (w & 1) * 4 + hq;
            if (isq) { const bf16_t* p = Q + (size_t)r * 1536 + h * 192;
                vn[u] = *(const bf16x8*)(p + 8 * sub); const unsigned a1 = *(const unsigned*)(p + 128 + 2 * sub), a2 = *(const unsigned*)(p + 160 + 2 * sub);
                x1[u][0] = bf2f(a1 & 0xffff); x1[u][1] = bf2f(a1 >> 16); x2[u][0] = bf2f(a2 & 0xffff); x2[u][1] = bf2f(a2 >> 16);
            } else { vn[u] = *(const bf16x8*)(KV + (size_t)r * 2048 + h * 256 + 8 * sub);
                if (r < MROWS) { const bf16_t* pe = P + (size_t)r * LDP_AB + COL_KPE; const unsigned a1 = *(const unsigned*)(pe + 2 * sub), a2 = *(const unsigned*)(pe + 32 + 2 * sub);
                    x1[u][0] = bf2f(a1 & 0xffff); x1[u][1] = bf2f(a1 >> 16); x2[u][0] = bf2f(a2 & 0xffff); x2[u][1] = bf2f(a2 >> 16); }
                else { const int rr = r - MROWS, b = rr >> 8, t = rr & 255; const float* pe = ckpe + (size_t)((b * 2 + j) * 256 + t) * 64;
                    x1[u][0] = pe[2 * sub]; x1[u][1] = pe[2 * sub + 1]; x2[u][0] = pe[32 + 2 * sub]; x2[u][1] = pe[32 + 2 * sub + 1]; } }
            if (r >= MC && r < MROWS) cs[u] = *(const f32x4*)(RA + (((r - MC) & 2047) * 32 + 2 * sub) * 2);
        } }
#pragma unroll
        for (int u = 0; u < U; ++u) { const int it = base + u; if (it < NIT) {
            const bool isq = it < NQ; const int w = isq ? it : it - NQ; const int r = w >> 1, h = (w & 1) * 4 + hq;
            float xn[8];
#pragma unroll
            for (int e = 0; e < 8; ++e) xn[e] = bf2f((unsigned short)vn[u][e]);
            float ss = x1[u][0] * x1[u][0] + x1[u][1] * x1[u][1] + x2[u][0] * x2[u][0] + x2[u][1] * x2[u][1];
#pragma unroll
            for (int e = 0; e < 8; ++e) ss += xn[e] * xn[e];
            const float rstd = rsqrtf(sum16(ss) * (1.f / 192.f) + EPSN);
            const float* g = isq ? gq : gk;
#pragma unroll
            for (int e = 0; e < 8; ++e) xn[e] = xn[e] * rstd * g[8 * sub + e];
            float y1[2], y2[2];
            y1[0] = x1[u][0] * rstd * g[128 + 2 * sub]; y1[1] = x1[u][1] * rstd * g[128 + 2 * sub + 1]; y2[0] = x2[u][0] * rstd * g[160 + 2 * sub]; y2[1] = x2[u][1] * rstd * g[160 + 2 * sub + 1];
            if (r >= MC && r < MROWS) {
#pragma unroll
                for (int q = 0; q < 2; ++q) { const float c = cs[u][2 * q], sn = cs[u][2 * q + 1];
                    const float z1 = y1[q] * c - y2[q] * sn, z2 = y1[q] * sn + y2[q] * c; y1[q] = z1; y2[q] = z2; } }
            bf16_t* p;
            if (isq) {
#pragma unroll
                for (int e = 0; e < 8; ++e) xn[e] *= QSC_A;
                y1[0] *= QSC_A; y1[1] *= QSC_A; y2[0] *= QSC_A; y2[1] *= QSC_A;
                p = Q + (size_t)r * 1536 + h * 192;
            } else p = KF + (size_t)r * 1536 + h * 192;
            *(bf16x8*)(p + 8 * sub) = pack8(xn); *(unsigned*)(p + 128 + 2 * sub) = pk2(y1[0], y1[1]); *(unsigned*)(p + 160 + 2 * sub) = pk2(y2[0], y2[1]);
        } }
    }
}

__device__ __forceinline__ void phase_fin_ab(KArgs a, int j) {
    const int tid = otid(), lane = tid & 63, wave = tid >> 6, sub = lane & 15, hq = lane >> 4;
    const int gw = obid() * NWAVES + wave, NGW = gridDim.x * NWAVES;
    const bf16_t* OF = (const bf16_t*)(a->ws + WS_OF); const bf16_t* OB = (const bf16_t*)(a->ws + WS_OB);
    const bf16_t* P = (const bf16_t*)(a->ws + WS_PROJ); bf16_t* MIX = (bf16_t*)(a->ws + WS_H);
    const float* g = a->in[21] + j * 128;
    for (int it = gw; it < MROWS * 2; it += NGW) {
        const int r = it >> 1, h = (it & 1) * 4 + hq; const size_t o = (size_t)r * 1024 + h * 128 + 8 * sub;
        const bf16x8 va = *(const bf16x8*)(OF + o), vb = *(const bf16x8*)(OB + o), vg = *(const bf16x8*)(P + (size_t)r * LDP_AB + COL_BG + h * 128 + 8 * sub);
        float s[8]; float ss = 0.f;
#pragma unroll
        for (int e = 0; e < 8; ++e) { s[e] = bf2f((unsigned short)va[e]) + bf2f((unsigned short)vb[e]); ss += s[e] * s[e]; }
        const float rstd = rsqrtf(sum16(ss) * (1.f / 128.f) + EPSN);
#pragma unroll
        for (int e = 0; e < 8; ++e) s[e] = s[e] * rstd * g[8 * sub + e] * silu_f(bf2f((unsigned short)vg[e]));
        *(bf16x8*)(MIX + (size_t)r * DM + 1024 + h * 128 + 8 * sub) = pack8(s);
    }
}

__device__ __forceinline__ void phase_hn_c(KArgs a, int j) {
    const int tid = otid(), lane = tid & 63, wave = tid >> 6, sub = lane & 15, hq = lane >> 4;
    const int gw = obid() * NWAVES + wave, NGW = gridDim.x * NWAVES;
    bf16_t* P = (bf16_t*)(a->ws + WS_PROJ);
    const float* RC = (const float*)(a->ws + WS_ROPEC);
    const float* gq = a->in[27] + j * 128; const float* gk = a->in[28] + j * 128;
    float* outp = a->out;
    for (int r = gw; r < MC; r += NGW) { const int b = r >> 8, t = r & 255; const bf16x8 v = *(const bf16x8*)(P + (size_t)r * LDP_C + 2560 + 8 * lane);
        float* o = outp + O_VC + (size_t)((b * 2 + j) * 256 + t) * 512 + 8 * lane;
        *(f32x4*)o = (f32x4){bf2f((unsigned short)v[0]), bf2f((unsigned short)v[1]), bf2f((unsigned short)v[2]), bf2f((unsigned short)v[3])};
        *(f32x4*)(o + 4) = (f32x4){bf2f((unsigned short)v[4]), bf2f((unsigned short)v[5]), bf2f((unsigned short)v[6]), bf2f((unsigned short)v[7])}; }
    constexpr int U = 4;
    const int NIT = MROWS;
    for (int base = gw * U; base < NIT; base += NGW * U) {
        s16x4 v1[U], v2[U]; f32x4 ca[U], cb[U];
#pragma unroll
        for (int u = 0; u < U; ++u) { const int it = base + u; if (it < NIT) {
            const int r = it, h = 16 + hq; const bool isq = false;
            const bf16_t* p = P + (size_t)r * LDP_C + (isq ? h * 128 : 2048 + (h - 16) * 128);
            v1[u] = *(const s16x4*)(p + 4 * sub); v2[u] = *(const s16x4*)(p + 64 + 4 * sub);
            if (r >= MC) { const float* rc = RC + (((r - MC) & 2047) * 64 + 4 * sub) * 2; ca[u] = *(const f32x4*)rc; cb[u] = *(const f32x4*)(rc + 4); }
        } }
#pragma unroll
        for (int u = 0; u < U; ++u) { const int it = base + u; if (it < NIT) {
            const int r = it, h = 16 + hq; const bool isq = false;
            bf16_t* p = P + (size_t)r * LDP_C + (isq ? h * 128 : 2048 + (h - 16) * 128);
            float x1[4], x2[4]; float ss = 0.f;
#pragma unroll
            for (int e = 0; e < 4; ++e) { x1[e] = bf2f((unsigned short)v1[u][e]); x2[e] = bf2f((unsigned short)v2[u][e]); ss += x1[e] * x1[e] + x2[e] * x2[e]; }
            const float rstd = rsqrtf(sum16(ss) * (1.f / 128.f) + EPSN);
            const float* g = isq ? gq : gk;
#pragma unroll
            for (int e = 0; e < 4; ++e) { x1[e] *= rstd * g[4 * sub + e]; x2[e] *= rstd * g[64 + 4 * sub + e]; }
            if (r >= MC) {
#pragma unroll
                for (int e = 0; e < 4; ++e) { const float c = e < 2 ? ca[u][2 * e] : cb[u][2 * (e - 2)], sn = e < 2 ? ca[u][2 * e + 1] : cb[u][2 * (e - 2) + 1];
                    const float y1 = x1[e] * c - x2[e] * sn, y2 = x1[e] * sn + x2[e] * c; x1[e] = y1; x2[e] = y2; } }
            else if (!isq) { const int b = r >> 8, t = r & 255; float* o = outp + O_KC + (size_t)((b * 2 + j) * 256 + t) * 512 + (h - 16) * 128;
                *(f32x4*)(o + 4 * sub) = (f32x4){x1[0], x1[1], x1[2], x1[3]}; *(f32x4*)(o + 64 + 4 * sub) = (f32x4){x2[0], x2[1], x2[2], x2[3]}; }
            if (isq) {
#pragma unroll
                for (int e = 0; e < 4; ++e) { x1[e] *= QSC_C; x2[e] *= QSC_C; } }
            u32x2 w1, w2; w1.x = pk2(x1[0], x1[1]); w1.y = pk2(x1[2], x1[3]); w2.x = pk2(x2[0], x2[1]); w2.y = pk2(x2[2], x2[3]);
            *(u32x2*)(p + 4 * sub) = w1; *(u32x2*)(p + 64 + 4 * sub) = w2;
        } }
    }
}

namespace att {
__device__ __forceinline__ int crow(int r, int hi) { return (r & 3) + 8 * (r >> 2) + 4 * hi; }
__device__ __forceinline__ unsigned cvtpk(float lo, float hi) { return pk2(lo, hi); }
__device__ __forceinline__ int v_st(int k, int c) { const int kk = (k & ~0xC) | ((k & 4) << 1) | ((k & 8) >> 1); return ((kk >> 3) * 4 + (c >> 5)) * 512 + ((kk & 7) * 32 + (c & 31)) * 2; }
__device__ __forceinline__ int v_rd_base(int lane) { return ((lane & 3) << 3) | (((lane >> 2) & 3) << 6) | (((lane >> 4) & 1) << 5) | (((lane >> 5) & 1) << 8); }
constexpr int v_rd_off(int d0, int ks, int half) { return d0 * 512 + ks * 4096 + half * 2048; }
template <int OFF> __device__ __forceinline__ s16x4 tr_read(int vb) {
    s16x4 r; asm volatile("ds_read_b64_tr_b16 %0, %1 offset:%2" : "=&v"(r) : "v"(vb), "i"(OFF) : "memory"); return r;
}
template <int D0> __device__ __forceinline__ void pv_one(f32x16& od, int vb, bf16x8 pa0, bf16x8 pa1, bf16x8 pa2, bf16x8 pa3) {
    const s16x4 l0 = tr_read<v_rd_off(D0, 0, 0)>(vb), h0 = tr_read<v_rd_off(D0, 0, 1)>(vb), l1 = tr_read<v_rd_off(D0, 1, 0)>(vb), h1 = tr_read<v_rd_off(D0, 1, 1)>(vb);
    const s16x4 l2 = tr_read<v_rd_off(D0, 2, 0)>(vb), h2 = tr_read<v_rd_off(D0, 2, 1)>(vb), l3 = tr_read<v_rd_off(D0, 3, 0)>(vb), h3 = tr_read<v_rd_off(D0, 3, 1)>(vb);
    asm volatile("s_waitcnt lgkmcnt(0)" ::: "memory"); __builtin_amdgcn_sched_barrier(0);
#define ATT_PK(L, H) (bf16x8){L[0], L[1], L[2], L[3], H[0], H[1], H[2], H[3]}
    od = __builtin_amdgcn_mfma_f32_32x32x16_bf16(pa0, ATT_PK(l0, h0), od, 0, 0, 0);
    od = __builtin_amdgcn_mfma_f32_32x32x16_bf16(pa1, ATT_PK(l1, h1), od, 0, 0, 0);
    od = __builtin_amdgcn_mfma_f32_32x32x16_bf16(pa2, ATT_PK(l2, h2), od, 0, 0, 0);
    od = __builtin_amdgcn_mfma_f32_32x32x16_bf16(pa3, ATT_PK(l3, h3), od, 0, 0, 0);
#undef ATT_PK
}
struct Item {
    const bf16_t* Q; int ldq;
    const bf16_t* K0; const bf16_t* V0; int n0;
    const bf16_t* K1; const bf16_t* V1; int ldk, ldv, t_lo, t_hi;
    int q0, band; float m0, l0;
    const float* qg; const float* rope; float qscale;
    const bf16_t* G; int ldg; bf16_t* O; int ldo;
};
template <int DQK>
__device__ __forceinline__ void attn_item(LAS unsigned char* lds, const Item& it) {
    constexpr int KROW = DQK * 2, SHM_K = 64 * KROW, SHM_V = 64 * 128 * 2, ND = DQK / 16;
    const int tid = otid(), wid = tid >> 6, lane = tid & 63, r32 = lane & 31, hi = lane >> 5;
    LAS unsigned char* V_lds = lds; LAS unsigned char* K_lds = lds + 2 * SHM_V;
    LAS float* wsx = (LAS float*)(lds + 2 * SHM_V + 2 * SHM_K) + wid * 64; LAS float* li_l = wsx; LAS float* al_l = wsx + 32;
    float m_reg = it.m0, l_reg = it.l0;
    f32x16 o[4];
#pragma unroll
    for (int d = 0; d < 4; ++d)
#pragma unroll
        for (int r = 0; r < 16; ++r) o[d][r] = 0.f;
    bf16x8 qr[ND];
    {
      const bf16_t* Qw = it.Q + (size_t)(wid * 32 + r32) * it.ldq + hi * 8;
      float xf[ND][8]; float ss = 0.f;
#pragma unroll
      for (int d0 = 0; d0 < ND; ++d0) { const bf16x8 v = *(const bf16x8*)(Qw + d0 * 16);
#pragma unroll
          for (int e = 0; e < 8; ++e) { xf[d0][e] = bf2f((unsigned short)v[e]); ss += xf[d0][e] * xf[d0][e]; } }
      ss += __shfl_xor(ss, 32);
      const float rstd = rsqrtf(ss * (1.f / (float)DQK) + EPSN);
#pragma unroll
      for (int d0 = 0; d0 < ND; ++d0) { const f32x4 g0 = *(const f32x4*)(it.qg + d0 * 16 + hi * 8), g1 = *(const f32x4*)(it.qg + d0 * 16 + hi * 8 + 4);
#pragma unroll
          for (int e = 0; e < 8; ++e) xf[d0][e] *= rstd * (e < 4 ? g0[e & 3] : g1[e & 3]); }
      if (it.rope) { constexpr int NR = DQK == 128 ? 4 : 2, RB = DQK == 128 ? 0 : 8, RS = DQK == 128 ? 64 : 32;
          const float* rp = it.rope + (size_t)((it.q0 + wid * 32 + r32) * RS + hi * 8) * 2;
#pragma unroll
          for (int p = 0; p < NR; ++p) { f32x4 cs4[4];
#pragma unroll
              for (int q = 0; q < 4; ++q) cs4[q] = *(const f32x4*)(rp + p * 32 + 4 * q);
#pragma unroll
              for (int e = 0; e < 8; ++e) { const float c = cs4[e >> 1][(e & 1) * 2], sn = cs4[e >> 1][(e & 1) * 2 + 1];
                  const float x1 = xf[RB + p][e], x2 = xf[RB + NR + p][e]; xf[RB + p][e] = x1 * c - x2 * sn; xf[RB + NR + p][e] = x1 * sn + x2 * c; } } }
#pragma unroll
      for (int d0 = 0; d0 < ND; ++d0) { float t8[8];
#pragma unroll
          for (int e = 0; e < 8; ++e) t8[e] = xf[d0][e] * it.qscale;
          qr[d0] = pack8(t8); } }
    const int NT = it.n0 + (it.t_hi - it.t_lo);
    const int wvu = __builtin_amdgcn_readfirstlane(wid);
    const int vb0 = (int)(uintptr_t)V_lds + v_rd_base(lane);
    constexpr int NKI = SHM_K / 8192;
    unsigned kog[NKI], vog[2];
#pragma unroll
    for (int i = 0; i < NKI; ++i) { const int off = i * 8192 + wid * 1024 + lane * 16, row = off / KROW, pos = off % KROW; kog[i] = (unsigned)(row * it.ldk + ((pos ^ ((row & 7) << 4)) >> 1)); }
#pragma unroll
    for (int i = 0; i < 2; ++i) { const int q = (i * 8192 + wid * 1024 + lane * 16) >> 4, sub = q >> 5, rem = q & 31, rowin = rem >> 2, cch = rem & 3;
        const int kk = (sub >> 2) * 8 + rowin; vog[i] = (unsigned)(((kk & ~0xC) | ((kk & 4) << 1) | ((kk & 8) >> 1)) * it.ldv + (sub & 3) * 32 + cch * 8); }
    int koff[4];
#pragma unroll
    for (int dl = 0; dl < 4; ++dl) koff[dl] = r32 * KROW + ((dl * 32 + hi * 16) ^ ((r32 & 7) << 4));
#define ATT_STAGE(jj, b) do { const int _j = (jj); const bool _s0 = _j < it.n0; const int _t = _s0 ? _j : it.t_lo + (_j - it.n0); \
        const bf16_t* _Kp = (_s0 ? it.K0 : it.K1) + (size_t)(64 * _t) * it.ldk; const bf16_t* _Vp = (_s0 ? it.V0 : it.V1) + (size_t)(64 * _t) * it.ldv; \
        _Pragma("unroll") for (int _i = 0; _i < NKI; ++_i) __builtin_amdgcn_global_load_lds((const unsigned*)(_Kp + kog[_i]), (LAS unsigned*)(K_lds + (b) * SHM_K + _i * 8192 + wvu * 1024), 16, 0, 0); \
        _Pragma("unroll") for (int _i = 0; _i < 2; ++_i) __builtin_amdgcn_global_load_lds((const unsigned*)(_Vp + vog[_i]), (LAS unsigned*)(V_lds + (b) * SHM_V + _i * 8192 + wvu * 1024), 16, 0, 0); } while (0)
    ATT_STAGE(0, 0); asm volatile("s_waitcnt vmcnt(0)" ::: "memory"); __syncthreads();
    for (int j = 0; j < NT; ++j) {
        const int cur = j & 1;
        if (j + 1 < NT) ATT_STAGE(j + 1, cur ^ 1);
        bool act = true; const bool domask = it.band && j >= it.n0; int kpos0 = 0;
        if (domask) { kpos0 = 64 * (it.t_lo + j - it.n0); const int qlo = it.q0 + wid * 32; act = (kpos0 + 63 >= qlo - 128) && (kpos0 <= qlo + 31 + 128); }
        if (act) {
            f32x16 p0, p1;
#pragma unroll
            for (int r = 0; r < 16; ++r) { p0[r] = 0.f; p1[r] = 0.f; }
            const LAS unsigned char* Ks = K_lds + cur * SHM_K;
#pragma unroll
            for (int d0 = 0; d0 < ND; ++d0) {
                const bf16x8 b0 = *(const LAS bf16x8*)(Ks + koff[d0 & 3] + (d0 >> 2) * 128);
                const bf16x8 b1 = *(const LAS bf16x8*)(Ks + koff[d0 & 3] + (d0 >> 2) * 128 + 32 * KROW);
                p0 = __builtin_amdgcn_mfma_f32_32x32x16_bf16(b0, qr[d0], p0, 0, 0, 0);
                p1 = __builtin_amdgcn_mfma_f32_32x32x16_bf16(b1, qr[d0], p1, 0, 0, 0);
                if ((d0 & 3) == 3) __builtin_amdgcn_sched_barrier(0); }
            if (domask) { const int qp = it.q0 + wid * 32 + r32;
#pragma unroll
                for (int r = 0; r < 16; ++r) { const int d = kpos0 + crow(r, hi) - qp;
                    if (d > 128 || d < -128) p0[r] = -1e30f;
                    if (d + 32 > 128 || d + 32 < -128) p1[r] = -1e30f; } }
            float pmax = p0[0];
#pragma unroll
            for (int r = 1; r < 16; ++r) pmax = fmaxf(pmax, p0[r]);
#pragma unroll
            for (int r = 0; r < 16; ++r) pmax = fmaxf(pmax, p1[r]);
            { auto rr = __builtin_amdgcn_permlane32_swap(__float_as_uint(pmax), __float_as_uint(pmax), false, false);
              pmax = fmaxf(__uint_as_float(rr[0]), __uint_as_float(rr[1])); }
            const float mn = fmaxf(m_reg, pmax); const float alpha = __builtin_amdgcn_exp2f(m_reg - mn); m_reg = mn;
            float ps = 0.f;
#pragma unroll
            for (int r = 0; r < 16; ++r) { p0[r] = __builtin_amdgcn_exp2f(p0[r] - mn); p1[r] = __builtin_amdgcn_exp2f(p1[r] - mn); ps += p0[r] + p1[r]; }
            { auto rr = __builtin_amdgcn_permlane32_swap(__float_as_uint(ps), __float_as_uint(ps), false, false);
              ps = __uint_as_float(rr[0]) + __uint_as_float(rr[1]); }
            l_reg = l_reg * alpha + ps;
            bf16x8 pa0, pa1, pa2, pa3;
#define ATT_PK4(P, BASE, OUT) do { unsigned a0 = cvtpk(P[BASE + 0], P[BASE + 1]), a1 = cvtpk(P[BASE + 2], P[BASE + 3]);   \
    unsigned b0 = cvtpk(P[BASE + 4], P[BASE + 5]), b1 = cvtpk(P[BASE + 6], P[BASE + 7]);                              \
    auto r0 = __builtin_amdgcn_permlane32_swap(a0, b0, false, false); auto r1 = __builtin_amdgcn_permlane32_swap(a1, b1, false, false); \
    u32x4 w = {r0[0], r1[0], r0[1], r1[1]}; OUT = __builtin_bit_cast(bf16x8, w); } while (0)
            ATT_PK4(p0, 0, pa0); ATT_PK4(p0, 8, pa1); ATT_PK4(p1, 0, pa2); ATT_PK4(p1, 8, pa3);
#undef ATT_PK4
            if (__any(alpha < 1.f)) { if (hi == 0) al_l[r32] = alpha; asm volatile("s_waitcnt lgkmcnt(0)" ::: "memory");
#pragma unroll
                for (int r = 0; r < 16; ++r) { const float al = al_l[crow(r, hi)];
#pragma unroll
                    for (int d = 0; d < 4; ++d) o[d][r] *= al; } }
            const int vb = vb0 + cur * SHM_V;
            pv_one<0>(o[0], vb, pa0, pa1, pa2, pa3); pv_one<1>(o[1], vb, pa0, pa1, pa2, pa3); pv_one<2>(o[2], vb, pa0, pa1, pa2, pa3); pv_one<3>(o[3], vb, pa0, pa1, pa2, pa3);
        }
        asm volatile("s_waitcnt vmcnt(0)" ::: "memory"); __syncthreads();
    }
#undef ATT_STAGE
    if (hi == 0) li_l[r32] = l_reg; asm volatile("s_waitcnt lgkmcnt(0)" ::: "memory");
#pragma unroll
    for (int r = 0; r < 16; ++r) { const int orow = wid * 32 + crow(r, hi); const float rli = 1.f / li_l[crow(r, hi)];
#pragma unroll
        for (int d0 = 0; d0 < 4; ++d0) { const int col = d0 * 32 + r32; const float g = bf2f(it.G[(size_t)orow * it.ldg + col]);
            it.O[(size_t)orow * it.ldo + col] = (bf16_t)f2bf(o[d0][r] * rli * silu_f(g)); }
        asm volatile("" ::: "memory"); }
    __syncthreads();
}
}

__device__ __forceinline__ void hgrn_item(LAS unsigned char* lds, const bf16_t* PROJ, int rowbase, int T, int h, int dir,
                                          const float* lb, const float* s0, float* sout, bf16_t* OUT) {
    LAS float* GS = (LAS float*)lds;
    LAS float* DEC = (LAS float*)(lds + 2048);
    LAS bf16_t* QT = (LAS bf16_t*)(lds + 2560);
    LAS bf16_t* KT = QT + 32 * 136;
    LAS bf16_t* KTt = KT + 32 * 136;
    LAS bf16_t* Vt = KTt + 128 * 40;
    const int tid = otid(), wid = tid >> 6, lane = tid & 63, fr = lane & 15, fq = lane >> 4;
    const int c2 = tid & 127, part = tid >> 7, n0 = wid * 16;
    f32x4 S[8];
#pragma unroll
    for (int kt = 0; kt < 8; ++kt) {
        if (s0) {
#pragma unroll
            for (int r = 0; r < 4; ++r) S[kt][r] = s0[(size_t)(16 * kt + 4 * fq + r) * 128 + n0 + fr]; }
        else S[kt] = (f32x4){0.f, 0.f, 0.f, 0.f}; }
    const float oml = 1.f - lb[c2];
    const unsigned hz = ozero();
    const int nch = T / 32;
    const bf16_t* pq = PROJ + COL_BQ + h * 128 + c2; const bf16_t* pf = PROJ + (dir ? COL_FB : COL_FF) + h * 128 + c2; const bf16_t* pv = PROJ + COL_BI + h * 128 + c2;
    unsigned short rq[8], rf[8], rv[8];
#define HG_LOAD(cc) do { _Pragma("unroll") for (int _i = 0; _i < 8; ++_i) { const int _p = 32 * (cc) + 8 * part + _i; const int _tok = dir ? T - 1 - _p : _p; \
        const size_t _o = (size_t)(rowbase + _tok) * LDP_AB; rq[_i] = pq[_o]; rf[_i] = pf[_o]; rv[_i] = pv[_o]; } } while (0)
    HG_LOAD(0);
    for (int c = 0; c < nch; ++c) {
        float b[8], kk[8], sq[8]; unsigned short vv[8];
        { float run = 0.f;
#pragma unroll
            for (int i = 0; i < 8; ++i) { const float x = bf2f(rf[i]); const float omf = oml * __builtin_amdgcn_rcpf(1.f + __expf(x));
                const float lf = fmaxf(__logf(1.f - omf), -30.f); run += lf; b[i] = run; kk[i] = omf; sq[i] = silu_f(bf2f(rq[i])); vv[i] = rv[i]; }
            GS[part * 128 + c2] = run; }
        if (c + 1 < nch) HG_LOAD(c + 1);
        __syncthreads();
        { float off = 0.f;
#pragma unroll
            for (int p = 0; p < 3; ++p) if (p < part) off += GS[p * 128 + c2];
            float kt_[8];
#pragma unroll
            for (int i = 0; i < 8; ++i) { const float bb = b[i] + off; const int t = 8 * part + i;
                const float qv = sq[i] * __expf(bb); kt_[i] = kk[i] * __expf(fminf(-bb, 80.f));
                QT[t * 136 + c2] = (bf16_t)f2bf(qv); KT[t * 136 + c2] = (bf16_t)f2bf(kt_[i]);
                if (i == 7 && part == 3) DEC[c2] = __expf(bb); }
            *(LAS bf16x8*)(KTt + c2 * 40 + 8 * part) = pack8(kt_);
            u32x4 wv; wv.x = (unsigned)vv[0] | ((unsigned)vv[1] << 16); wv.y = (unsigned)vv[2] | ((unsigned)vv[3] << 16); wv.z = (unsigned)vv[4] | ((unsigned)vv[5] << 16); wv.w = (unsigned)vv[6] | ((unsigned)vv[7] << 16);
            *(LAS u32x4*)(Vt + c2 * 40 + 8 * part) = wv; }
        __syncthreads();
        f32x4 pt00 = {0.f, 0.f, 0.f, 0.f}, pt01 = pt00, pt11 = pt00;
#pragma unroll
        for (int ks = 0; ks < 4; ++ks) {
            const bf16x8 a0 = *(const LAS bf16x8*)(KT + fr * 136 + 32 * ks + 8 * fq), a1 = *(const LAS bf16x8*)(KT + (16 + fr) * 136 + 32 * ks + 8 * fq);
            const bf16x8 b0 = *(const LAS bf16x8*)(QT + fr * 136 + 32 * ks + 8 * fq), b1 = *(const LAS bf16x8*)(QT + (16 + fr) * 136 + 32 * ks + 8 * fq);
            pt00 = __builtin_amdgcn_mfma_f32_16x16x32_bf16(a0, b0, pt00, 0, 0, 0);
            pt01 = __builtin_amdgcn_mfma_f32_16x16x32_bf16(a0, b1, pt01, 0, 0, 0);
            pt11 = __builtin_amdgcn_mfma_f32_16x16x32_bf16(a1, b1, pt11, 0, 0, 0); }
#pragma unroll
        for (int r = 0; r < 4; ++r) { if (4 * fq + r > fr) { pt00[r] = 0.f; pt11[r] = 0.f; } }
        u32x4 wA0, wA1;
        wA0.x = pk2(pt00[0], pt00[1]); wA0.y = pk2(pt00[2], pt00[3]); wA0.z = hz; wA0.w = hz;
        wA1.x = pk2(pt01[0], pt01[1]); wA1.y = pk2(pt01[2], pt01[3]); wA1.z = pk2(pt11[0], pt11[1]); wA1.w = pk2(pt11[2], pt11[3]);
        const u32x2 vlo = *(const LAS u32x2*)(Vt + (n0 + fr) * 40 + 4 * fq), vhi = *(const LAS u32x2*)(Vt + (n0 + fr) * 40 + 16 + 4 * fq);
        const u32x4 wV = {vlo.x, vlo.y, vhi.x, vhi.y};
        f32x4 o0 = {0.f, 0.f, 0.f, 0.f}, o1 = o0;
        o0 = __builtin_amdgcn_mfma_f32_16x16x32_bf16(__builtin_bit_cast(bf16x8, wA0), __builtin_bit_cast(bf16x8, wV), o0, 0, 0, 0);
        o1 = __builtin_amdgcn_mfma_f32_16x16x32_bf16(__builtin_bit_cast(bf16x8, wA1), __builtin_bit_cast(bf16x8, wV), o1, 0, 0, 0);
#pragma unroll
        for (int aa = 0; aa < 4; ++aa) {
            u32x4 wS; wS.x = pk2(S[2 * aa][0], S[2 * aa][1]); wS.y = pk2(S[2 * aa][2], S[2 * aa][3]); wS.z = pk2(S[2 * aa + 1][0], S[2 * aa + 1][1]); wS.w = pk2(S[2 * aa + 1][2], S[2 * aa + 1][3]);
            const u32x2 q0l = *(const LAS u32x2*)(QT + fr * 136 + 32 * aa + 4 * fq), q0h = *(const LAS u32x2*)(QT + fr * 136 + 32 * aa + 16 + 4 * fq);
            const u32x2 q1l = *(const LAS u32x2*)(QT + (16 + fr) * 136 + 32 * aa + 4 * fq), q1h = *(const LAS u32x2*)(QT + (16 + fr) * 136 + 32 * aa + 16 + 4 * fq);
            const u32x4 wQ0 = {q0l.x, q0l.y, q0h.x, q0h.y}, wQ1 = {q1l.x, q1l.y, q1h.x, q1h.y};
            o0 = __builtin_amdgcn_mfma_f32_16x16x32_bf16(__builtin_bit_cast(bf16x8, wQ0), __builtin_bit_cast(bf16x8, wS), o0, 0, 0, 0);
            o1 = __builtin_amdgcn_mfma_f32_16x16x32_bf16(__builtin_bit_cast(bf16x8, wQ1), __builtin_bit_cast(bf16x8, wS), o1, 0, 0, 0); }
        { const bf16x8 vn = *(const LAS bf16x8*)(Vt + (n0 + fr) * 40 + 8 * fq);
#pragma unroll
            for (int kt = 0; kt < 8; ++kt) { const bf16x8 ka = *(const LAS bf16x8*)(KTt + (16 * kt + fr) * 40 + 8 * fq);
                S[kt] = __builtin_amdgcn_mfma_f32_16x16x32_bf16(ka, vn, S[kt], 0, 0, 0);
                const f32x4 d = *(const LAS f32x4*)(DEC + 16 * kt + 4 * fq); S[kt] = S[kt] * d; } }
#pragma unroll
        for (int r = 0; r < 4; ++r) {
            const int i0 = 4 * fq + r, i1 = 16 + 4 * fq + r;
            const int tok0 = dir ? T - 1 - (32 * c + i0) : 32 * c + i0, tok1 = dir ? T - 1 - (32 * c + i1) : 32 * c + i1;
            OUT[(size_t)(rowbase + tok0) * 1024 + h * 128 + n0 + fr] = (bf16_t)f2bf(o0[r]);
            OUT[(size_t)(rowbase + tok1) * 1024 + h * 128 + n0 + fr] = (bf16_t)f2bf(o1[r]); }
    }
#undef HG_LOAD
    if (sout) {
#pragma unroll
        for (int kt = 0; kt < 8; ++kt)
#pragma unroll
            for (int r = 0; r < 4; ++r) sout[(size_t)(16 * kt + 4 * fq + r) * 128 + n0 + fr] = S[kt][r]; }
    __syncthreads();
}

__device__ __forceinline__ int fetch_item(unsigned* ctr, LAS int* slot) {
    __syncthreads();
    if (otid() == 0) *slot = (int)atomicAdd(ctr, 1u);
    __syncthreads();
    return *slot;
}

#define XB_TMO      128
#define XB_XCNT(j)  (256  + 64 * (j))
#define XB_XSUB(j)  (1280 + 64 * (j))
#define XB_XGEN(j)  (2304 + 64 * (j))
#define XB_TOP      3328
#define XB_TOPGEN   3392
#define XCD_BAR_WORDS 3456
#define XB_SPIN_CAP (1u << 18)

__device__ __forceinline__ unsigned xb_ld(unsigned* p)              { return __hip_atomic_load(p, __ATOMIC_RELAXED, __HIP_MEMORY_SCOPE_AGENT); }
__device__ __forceinline__ unsigned xb_add(unsigned* p, unsigned v) { return __hip_atomic_fetch_add(p, v, __ATOMIC_RELAXED, __HIP_MEMORY_SCOPE_AGENT); }
__device__ __forceinline__ unsigned xb_xcc_id() { return (unsigned)__builtin_amdgcn_s_getreg((3 << 11) | 20) & 0xFu; }
#define XB_SPIN(cond, bar) do { unsigned _sp = 0; while (cond) { __builtin_amdgcn_s_sleep(1); \
    if ((++_sp & 255u) == 0u) { if (xb_ld(&(bar)[XB_TMO])) break; if (_sp > XB_SPIN_CAP) { atomicAdd(&(bar)[XB_TMO], 1u); break; } } } } while (0)

struct XcdBarrier {
    unsigned* bar; unsigned x;
    volatile LAS unsigned* st;
};

__device__ __forceinline__ XcdBarrier xcd_barrier_post(unsigned* bar, volatile LAS unsigned* st) {
    XcdBarrier b; b.bar = bar; b.x = xb_xcc_id(); b.st = st;
    if (threadIdx.x == 0) (void)xb_add(&bar[XB_XCNT(b.x)], 1u);
    return b;
}
__device__ __forceinline__ void xcd_barrier_complete(unsigned* bar, unsigned x, unsigned& nloc, unsigned& nx) {
    const unsigned G = gridDim.x * gridDim.y * gridDim.z;
    unsigned sum, cnt, mine, sp = 0u;
    for (;;) {
        sum = 0u; cnt = 0u; mine = 0u;
#pragma unroll
        for (unsigned j = 0; j < 16; ++j) { const unsigned c = xb_ld(&bar[XB_XCNT(j)]); sum += c; cnt += (c > 0u) ? 1u : 0u; mine = (j == x) ? c : mine; }
        if (sum == G) break;
        __builtin_amdgcn_s_sleep(1);
        if ((++sp & 255u) == 0u) { if (xb_ld(&bar[XB_TMO])) break; if (sp > XB_SPIN_CAP) { atomicAdd(&bar[XB_TMO], 1u); break; } }
    }
    nloc = mine > 0u ? mine : 1u; nx = cnt > 0u ? cnt : 1u;
}

__device__ __forceinline__ void xcd_barrier(const XcdBarrier& b) {
    asm volatile("s_waitcnt vmcnt(0)" ::: "memory");
    __syncthreads();
    if (threadIdx.x == 0) {
        unsigned* bar = b.bar;
        __builtin_amdgcn_s_waitcnt(0);
        unsigned nloc = b.st[0], nx = b.st[1];
        if (nloc == 0u) { xcd_barrier_complete(bar, b.x, nloc, nx); b.st[0] = nloc; b.st[1] = nx; }
        const unsigned old = xb_add(&bar[XB_XSUB(b.x)], 1u);
        const unsigned gen = old / nloc;
        if (old + 1u == (gen + 1u) * nloc) {
            __builtin_amdgcn_fence(__ATOMIC_RELEASE, "agent");
            asm volatile("s_waitcnt vmcnt(0)" ::: "memory");
            const unsigned og = xb_add(&bar[XB_TOP], 1u);
            const unsigned tg = og / nx;
            if (og + 1u == (tg + 1u) * nx) xb_add(&bar[XB_TOPGEN], 1u);
            else XB_SPIN(xb_ld(&bar[XB_TOPGEN]) == tg, bar);
            __builtin_amdgcn_fence(__ATOMIC_ACQUIRE, "agent");
            xb_add(&bar[XB_XGEN(b.x)], 1u);
            asm volatile("s_waitcnt vmcnt(0)" ::: "memory");
        } else {
            XB_SPIN(xb_ld(&bar[XB_XGEN(b.x)]) == gen, bar);
            __builtin_amdgcn_fence(__ATOMIC_ACQUIRE, "agent");
            asm volatile("s_waitcnt vmcnt(0)" ::: "memory");
        }
    }
    __syncthreads();
}

enum { K_P0 = 0, K_MODNORM, K_GEMM_IN, K_PREP_AB, K_GEMM_QUP, K_GEMM_KVUP, K_HN_AB, K_MIX_AB, K_FIN_AB, K_GEMM_OUT, K_HN_C, K_ATTN_C };

__global__ void __launch_bounds__(NTHR, 2) mk_fwd(Args a_byval) {
    extern __shared__ __attribute__((aligned(16))) unsigned char lds_raw[];
    LAS unsigned char* lds = (LAS unsigned char*)lds_raw;
    LAS int* slot = (LAS int*)(lds + LDS_PHASE);
    cg::grid_group grid = cg::this_grid();
    const int G = gridDim.x;
    volatile LAS unsigned* bst = (volatile LAS unsigned*)(lds + LDS_PHASE + 64);
    if (threadIdx.x < 2) bst[threadIdx.x] = 0u;
    __syncthreads();
    (void)xcd_barrier_post((unsigned*)(a_byval.ws + WS_CTL) + 8192, bst);

    for (int step = 0; step < 29; ++step) {
        asm volatile("" : "+s"(step));
        KArgs a = (KArgs)__builtin_amdgcn_kernarg_segment_ptr();
        asm volatile("" : "+s"(a));
        unsigned char* ws = a->ws;
        unsigned* ctl = (unsigned*)(ws + WS_CTL);
        XcdBarrier xbar; xbar.bar = ctl + 8192; xbar.x = xb_xcc_id(); xbar.st = (volatile LAS unsigned*)(lds + LDS_PHASE + 64);
        int kind, L = 0; bool sync_after = true;
        if (step == 0) kind = K_P0;
        else { const int s = step - 1, pair = s / 14, r = s % 14;
            if (r < 9) { L = 2 * pair; kind = r == 0 ? K_MODNORM : r == 1 ? K_GEMM_IN : r == 2 ? K_PREP_AB : r == 3 ? K_GEMM_QUP : r == 4 ? K_GEMM_KVUP : r == 5 ? K_HN_AB : r == 6 ? K_MIX_AB : r == 7 ? K_FIN_AB : K_GEMM_OUT; }
            else { L = 2 * pair + 1; const int q = r - 9; kind = q == 0 ? K_MODNORM : q == 1 ? K_GEMM_IN : q == 2 ? K_HN_C : q == 3 ? K_ATTN_C : K_GEMM_OUT; } }
        const int j = L >> 1; const bool isC = (L & 1) != 0;
        if (kind == K_GEMM_QUP) sync_after = false;
        if (step == 28) sync_after = false;

#ifndef PROBE_MASK
#define PROBE_MASK 0
#endif
#ifndef PROBE_SEL
#define PROBE_SEL 0
#endif
#ifndef PROBE_REPS
#define PROBE_REPS 2
#endif
        const int nrep = (((PROBE_MASK >> kind) & 1) && (kind != K_GEMM_OUT || L == 0)) ? 1 + PROBE_REPS : 1;
        for (int rep = 0; rep < nrep; ++rep) {
        if (PROBE_MASK == 0x1000) { for (int q = 0; q < 2; ++q) xcd_barrier(xbar); }
        if (kind == K_P0) phase_p0(a, lds);
        else if (kind == K_MODNORM) phase_modnorm(a, L);
        else if (kind == K_GEMM_IN || kind == K_GEMM_QUP || kind == K_GEMM_KVUP) {
            pg8::Gemm g; pg8::EpiStore E;
            if (kind == K_GEMM_IN) {
                if (!isC) { g = pg8::Gemm{(const bf16_t*)(ws + WS_H), (const bf16_t*)(ws + WS_WINAB) + (size_t)j * 7168 * 2048, MROWS, 7168, 2048}; E = pg8::EpiStore{(bf16_t*)(ws + WS_PROJ), LDP_AB}; }
                else { g = pg8::Gemm{(const bf16_t*)(ws + WS_H), (const bf16_t*)(ws + WS_WINC) + (size_t)j * 5120 * 2048, MROWS, 5120, 2048}; E = pg8::EpiStore{(bf16_t*)(ws + WS_PROJ), LDP_C}; }
            } else if (kind == K_GEMM_QUP) { g = pg8::Gemm{(const bf16_t*)(ws + WS_QN), (const bf16_t*)(ws + WS_WQUP) + (size_t)j * 1536 * 512, MROWS, 1536, 512}; E = pg8::EpiStore{(bf16_t*)(ws + WS_QRAW), 1536}; }
            else { g = pg8::Gemm{(const bf16_t*)(ws + WS_CKV), (const bf16_t*)(ws + WS_WKVUP) + (size_t)j * 2048 * 256, MKROWS, 2048, 256}; E = pg8::EpiStore{(bf16_t*)(ws + WS_KVRAW), 2048}; }
            pg8::StaticOrder S; S.init(g.M, g.N, G, obid());
            pg8::gemm_phase<pg8::EpiStore, pg8::StaticOrder, true, true>(lds, g, S, E);
        }
        else if (kind == K_GEMM_OUT) {
            pg8::Gemm g{(const bf16_t*)(ws + WS_H), (const bf16_t*)(ws + (isC ? WS_WOUTC : WS_WOUTAB)) + (size_t)j * 2048 * 2048, MROWS, 2048, 2048};
            pg8::EpiResid E{L == 0 ? a->in[0] : a->out, L == 0 ? a->in[1] : a->out + (size_t)MC * DM, a->out, (const float*)(ws + WS_MOD) + (size_t)L * 5 * 6144 + 4096,
                            (float*)(ws + WS_QRAW), ctl + 16384 + step * 256};
            pg8::SplitOrder S; S.init(g.M, g.N, g.K, G, obid());
            pg8::gemm_phase<pg8::EpiResid, pg8::SplitOrder, true, true>(lds, g, S, E);
        }
        else if (kind == K_PREP_AB) phase_prep_ab(a, j);
        else if (kind == K_HN_AB) phase_hn_ab(a, j);
        else if (kind == K_FIN_AB) phase_fin_ab(a, j);
        else if (kind == K_HN_C) phase_hn_c(a, j);
        else if (kind == K_MIX_AB) {
            unsigned* ctr = ctl + 64 * step + 8 * rep;
            const bf16_t* P = (const bf16_t*)(ws + WS_PROJ); bf16_t* MIX = (bf16_t*)(ws + WS_H);
            const bf16_t* QF = (const bf16_t*)(ws + WS_QRAW); const bf16_t* KF = (const bf16_t*)(ws + WS_KF); const bf16_t* KV = (const bf16_t*)(ws + WS_KVRAW);
            for (;;) {
                const int idx = fetch_item(ctr, slot);
                if (idx >= 704) break;
                if (idx < 64 || (idx >= 320 && idx < 576)) {
                    const bool lat = idx < 64; const int i = lat ? idx : idx - 320; const int b = i >> 4, h = (i >> 1) & 7, dir = i & 1;
                    const float* lb = (const float*)(ws + WS_LB) + (j * 2 + dir) * 1024 + h * 128;
                    const float* s0 = lat ? a->in[4 + dir] + (size_t)((b * 2 + j) * 8 + h) * 16384 : nullptr;
                    float* so = lat ? nullptr : a->out + (dir ? O_SB : O_SF) + (size_t)((b * 2 + j) * 8 + h) * 16384;
                    if (PROBE_SEL != 1 || rep == 0) hgrn_item(lds, P, lat ? MC + b * 2048 : b * 256, lat ? 2048 : 256, h, dir, lb, s0, so, (bf16_t*)(ws + (dir ? WS_OB : WS_OF)));
                } else {
                    att::Item it;
                    const bool lat = idx < 320; int b, h, r0;
                    if (lat) { const int i = idx - 64; b = i >> 6; h = (i >> 3) & 7; const int qb = i & 7; r0 = MC + b * 2048 + qb * 256; it.q0 = qb * 256;
                        it.K0 = KF + (size_t)(MROWS + b * 256) * 1536 + h * 192; it.V0 = KV + (size_t)(MROWS + b * 256) * 2048 + h * 256 + 128; it.n0 = 4;
                        it.K1 = KF + (size_t)(MC + b * 2048) * 1536 + h * 192; it.V1 = KV + (size_t)(MC + b * 2048) * 2048 + h * 256 + 128; it.t_lo = 0; it.t_hi = 32; }
                    else { const int i = idx - 576; b = i >> 3; h = i & 7; r0 = b * 256; it.q0 = 0;
                        it.K0 = KF; it.V0 = KV; it.n0 = 0;
                        it.K1 = KF + (size_t)r0 * 1536 + h * 192; it.V1 = KV + (size_t)r0 * 2048 + h * 256 + 128; it.t_lo = 0; it.t_hi = 4; }
                    it.ldk = 1536; it.ldv = 2048;
                    it.Q = QF + (size_t)r0 * 1536 + h * 192; it.ldq = 1536; it.band = 0; it.m0 = -1e30f; it.l0 = 0.f;
                    it.qg = a->in[18] + j * 192; it.rope = lat ? (const float*)(ws + WS_ROPEA) : nullptr; it.qscale = QSC_A;
                    it.G = P + (size_t)r0 * LDP_AB + COL_AG + h * 128; it.ldg = LDP_AB; it.O = MIX + (size_t)r0 * DM + h * 128; it.ldo = DM;
                    if (PROBE_SEL != 2 || rep == 0) att::attn_item<192>(lds, it);
                }
            }
        }
        else if (kind == K_ATTN_C) {
            unsigned* ctr = ctl + 64 * step + 8 * rep;
            const bf16_t* P = (const bf16_t*)(ws + WS_PROJ); bf16_t* MIX = (bf16_t*)(ws + WS_H);
            const bf16_t* KCC = (const bf16_t*)(ws + WS_KCC);
            for (;;) {
                const int idx = fetch_item(ctr, slot);
                if (idx >= 768) break;
                att::Item it; int b, h, r0;
                if (idx < 512) { b = idx >> 7; h = (idx >> 3) & 15; const int qb = idx & 7; r0 = MC + b * 2048 + qb * 256; const int kvh = h >> 2;
                    it.K0 = KCC + (size_t)((b * 2 + j) * 256) * LDP_C + kvh * 128; it.V0 = KCC + (size_t)((b * 2 + j) * 256) * LDP_C + 512 + kvh * 128; it.n0 = 4;
                    it.K1 = P + (size_t)(MC + b * 2048) * LDP_C + 2048 + kvh * 128; it.V1 = P + (size_t)(MC + b * 2048) * LDP_C + 2560 + kvh * 128;
                    it.t_lo = 4 * qb - 2 < 0 ? 0 : 4 * qb - 2; it.t_hi = 4 * qb + 6 > 32 ? 32 : 4 * qb + 6; it.q0 = qb * 256; it.band = 1; }
                else { const int i = idx - 512; b = i >> 4; h = i & 15; r0 = b * 256; const int kvh = h >> 2;
                    it.K0 = KCC; it.V0 = KCC; it.n0 = 0;
                    it.K1 = P + (size_t)r0 * LDP_C + 2048 + kvh * 128; it.V1 = P + (size_t)r0 * LDP_C + 2560 + kvh * 128; it.t_lo = 0; it.t_hi = 4; it.q0 = 0; it.band = 0; }
                it.ldk = LDP_C; it.ldv = LDP_C;
                it.Q = P + (size_t)r0 * LDP_C + h * 128; it.ldq = LDP_C; it.m0 = a->in[29][j * 16 + h] * LOG2E; it.l0 = 1.f;
                it.qg = a->in[27] + j * 128; it.rope = idx < 512 ? (const float*)(ws + WS_ROPEC) : nullptr; it.qscale = QSC_C;
                it.G = P + (size_t)r0 * LDP_C + 3072 + h * 128; it.ldg = LDP_C; it.O = MIX + (size_t)r0 * DM + h * 128; it.ldo = DM;
                att::attn_item<128>(lds, it);
            }
        }
        if (rep + 1 < nrep) xcd_barrier(xbar);
        }
        if (sync_after) { if (step == 0) grid.sync(); xcd_barrier(xbar); }
    }
}

extern "C" void kernel_launch(void* const* d_in, const int* in_sizes, int n_in, void* d_out, int out_size, void* d_ws, size_t ws_size, hipStream_t stream) {
    static int grid = 0;
    if (grid == 0) {
        if (n_in != 31 || ws_size < WS_END) { fprintf(stderr, "kernel_launch: unexpected n_in %d or ws_size %zu (< %zu)\n", n_in, ws_size, (size_t)WS_END); grid = -1; return; }
        int dev = 0, cus = 0, per_cu = 0;
        hipGetDevice(&dev); hipDeviceGetAttribute(&cus, hipDeviceAttributeMultiprocessorCount, dev);
        if (hipFuncSetAttribute((const void*)mk_fwd, hipFuncAttributeMaxDynamicSharedMemorySize, LDS_BYTES) != hipSuccess) { fprintf(stderr, "kernel_launch: hipFuncSetAttribute failed\n"); grid = -1; return; }
        if (hipOccupancyMaxActiveBlocksPerMultiprocessor(&per_cu, (const void*)mk_fwd, NTHR, LDS_BYTES) != hipSuccess || per_cu < 1) per_cu = 1;
        (void)hipGetLastError();
        grid = cus > 0 ? cus : 256;
    }
    if (grid < 0) return;
    hipMemsetAsync((char*)d_ws + WS_CTL, 0, CTL_BYTES, stream);
    Args a{};
    for (int i = 0; i < 31; ++i) a.in[i] = (const float*)d_in[i];
    a.out = (float*)d_out; a.ws = (unsigned char*)d_ws;
    void* args[] = {&a};
    hipError_t e = hipLaunchCooperativeKernel((const void*)mk_fwd, dim3(grid), dim3(NTHR), args, LDS_BYTES, stream);
    if (e != hipSuccess) fprintf(stderr, "cooperative launch failed: %s (grid %d)\n", hipGetErrorString(e), grid);
}
```

```cpp
#include <hip/hip_runtime.h>
#include <hip/hip_cooperative_groups.h>
#include <cstdio>
#include <cstdint>
namespace cg = cooperative_groups;

namespace pg8 {
#define PG8_LAS __attribute__((address_space(3)))
typedef unsigned short bf16_t;
typedef short bf16x8 __attribute__((ext_vector_type(8)));
typedef float f32x4 __attribute__((ext_vector_type(4)));
typedef unsigned u32x4 __attribute__((ext_vector_type(4)));
constexpr int BM = 256, BK = 64, HALF = 128, HTB = HALF * BK * 2  , STAGE_BYTES = 8 * HTB, NXCD = 8, WGM = 8;
__device__ __forceinline__ int pg8_otid() { int t = threadIdx.x; asm volatile("" : "+v"(t)); return t; }

__host__ __device__ __forceinline__ int lds_byte(int r, int c) { const int st = (r >> 4) * 2 + (c >> 5), rr = r & 15, cc = c & 31, ob = rr * 64 + cc * 2; return st * 1024 + (ob ^ (((ob >> 9) & 1) << 5)); }
__host__ __device__ __forceinline__ void stage_rc(int b, int& R, int& C) { const int st = b / 1024, sb = b % 1024, swz = sb ^ (((sb >> 9) & 1) << 5); R = (st >> 1) * 16 + swz / 64; C = (st & 1) * 32 + (swz % 64) / 2; }
__host__ __device__ __forceinline__ int perm32(int rho) { const int n = rho >> 4, i = rho & 15; return 8 * (i >> 2) + 4 * n + (i & 3); }

struct Unit { int pm, pn, kp, np, tix; };
struct Gemm { const bf16_t* A; const bf16_t* Bt; int M, N, K; };

struct StaticOrder {
    int nM, nN, nwg, G, c;
    __host__ __device__ void init(int M, int N, int G_, int c_) { nM = M / BM; nN = N / BM; nwg = nM * nN; G = G_; c = c_; }
    __host__ __device__ bool next(int i, Unit& u) const {
        const long L = (long)i * G + c; if (L >= nwg) return false;
        int wgid = (int)L; { const int q = nwg / NXCD, r = nwg % NXCD, xcd = wgid % NXCD, off = wgid / NXCD; wgid = (xcd < r ? xcd * (q + 1) : r * (q + 1) + (xcd - r) * q) + off; }
        const int nig = WGM * nN, gid = wgid / nig, fm = gid * WGM, gsz = (nM - fm) < WGM ? (nM - fm) : WGM;
        u.pm = fm + ((wgid % nig) % gsz); u.pn = (wgid % nig) / gsz; u.kp = 0; u.np = 1; u.tix = 0; return true;
    }
    __device__ __forceinline__ void a_ready(const Unit&) const {}
    __device__ __forceinline__ void done(const Unit&) const {}
};
struct SplitOrder {
    StaticOrder so; int R, np;
    __host__ __device__ void init(int M, int N, int K, int G_, int c_) { so.init(M, N, G_, c_); R = so.nwg / G_; const int left = so.nwg - R * G_;
        np = 1; if (left > 0 && G_ % left == 0) { const int q = G_ / left; if (q == 2 && (K / q) % 128 == 0) np = q; } }
    __host__ __device__ bool next(int i, Unit& u) const {
        if (np == 1 || i < R) return so.next(i, u);
        if (i > R) return false;
        StaticOrder t = so; t.c = so.c / np; const bool ok = t.next(i, u); u.kp = so.c % np; u.np = np; u.tix = so.c / np; return ok;
    }
    __device__ __forceinline__ void a_ready(const Unit&) const {}
    __device__ __forceinline__ void done(const Unit&) const {}
};

typedef float f32x2c __attribute__((ext_vector_type(2)));
typedef __bf16 bf16x2c __attribute__((ext_vector_type(2)));
__device__ __forceinline__ unsigned cvt_pk_bf16(float lo, float hi) { const f32x2c v = {lo, hi}; const bf16x2c b = __builtin_convertvector(v, bf16x2c); return __builtin_bit_cast(unsigned, b); }

struct EpiStore {
    static constexpr bool PERM = true, AFTER_DRAIN = false;
    bf16_t* O; int ldc;
    __device__ __forceinline__ void operator()(const f32x4 (&acc)[2][2][4][2], const Unit& u, int wr, int wc, int fr, int fq) const {
        const int row0 = u.pm * BM + wr * 64 + fr; const int col0 = u.pn * BM + wc * 32 + 8 * fq;
#pragma unroll
        for (int ai = 0; ai < 2; ++ai)
#pragma unroll
            for (int m = 0; m < 4; ++m) { bf16_t* rowp = O + (size_t)(row0 + ai * HALF + m * 16) * ldc + col0;
#pragma unroll
                for (int bj = 0; bj < 2; ++bj) { const f32x4 v0 = acc[ai][bj][m][0], v1 = acc[ai][bj][m][1];
                    u32x4 w; w.x = cvt_pk_bf16(v0[0], v0[1]); w.y = cvt_pk_bf16(v0[2], v0[3]); w.z = cvt_pk_bf16(v1[0], v1[1]); w.w = cvt_pk_bf16(v1[2], v1[3]);
                    *(u32x4*)(rowp + bj * HALF) = w; } }
    }
};
struct EpiResid {
    static constexpr bool PERM = true, AFTER_DRAIN = false;
    const float* xin_ctx; const float* xin_lat; float* out; const float* gate_base;
    float* slab; unsigned* cnt;
    __device__ __forceinline__ void operator()(f32x4 (&acc)[2][2][4][2], const Unit& u, int wr, int wc, int fr, int fq) const {
        const int tid = (wr * 4 + wc) * 64 + fq * 16 + fr;
        const f32x4* sl = nullptr;
        if (u.np > 1) {
            float* sb = slab + (size_t)u.tix * (u.np - 1) * 65536;
            if (u.kp < u.np - 1) {
                f32x4* sp = (f32x4*)(sb + (size_t)u.kp * 65536) + tid;
#pragma unroll
                for (int ai = 0; ai < 2; ++ai)
#pragma unroll
                    for (int bj = 0; bj < 2; ++bj)
#pragma unroll
                        for (int m = 0; m < 4; ++m)
#pragma unroll
                            for (int n = 0; n < 2; ++n) sp[(((ai * 2 + bj) * 4 + m) * 2 + n) * 512] = acc[ai][bj][m][n];
                asm volatile("s_waitcnt vmcnt(0)" ::: "memory");
                __syncthreads();
                if (tid == 0) { __builtin_amdgcn_fence(__ATOMIC_RELEASE, "agent"); asm volatile("s_waitcnt vmcnt(0)" ::: "memory");
                    __hip_atomic_fetch_add(cnt + u.tix, 1u, __ATOMIC_RELAXED, __HIP_MEMORY_SCOPE_AGENT); }
                return;
            }
            if (tid == 0) { unsigned sp_ = 0;
                while (__hip_atomic_load(cnt + u.tix, __ATOMIC_RELAXED, __HIP_MEMORY_SCOPE_AGENT) < (unsigned)(u.np - 1)) { __builtin_amdgcn_s_sleep(2); if (++sp_ > (1u << 22)) break; }
                __builtin_amdgcn_fence(__ATOMIC_ACQUIRE, "agent"); asm volatile("s_waitcnt vmcnt(0)" ::: "memory"); }
            __syncthreads();
            sl = (const f32x4*)sb + tid;
        }
        const int pm = u.pm;
        const float* xin = pm < 16 ? xin_ctx + (size_t)pm * 256 * 2048 : xin_lat + (size_t)(pm - 16) * 256 * 2048;
        float* xo = out + (size_t)pm * 256 * 2048;
        const int ci = pm < 16 ? 4 : ((pm - 16) >> 3);
        const float* gt = gate_base + ci * 6144;
        const int rl0 = wr * 64 + fr, col0 = u.pn * BM + wc * 32 + 8 * fq;
        f32x4 xa[4][2], xb[4][2];
#define EPI_LOADQ(dst, ai_, bj_) do { _Pragma("unroll") for (int m = 0; m < 4; ++m) { const unsigned off = (unsigned)((rl0 + (ai_) * HALF + m * 16) * 2048 + col0 + (bj_) * HALF); \
            dst[m][0] = *(const f32x4*)(xin + off); dst[m][1] = *(const f32x4*)(xin + off + 4); } } while (0)
#define EPI_EMITQ(src, ai_, bj_) do { const f32x4 gq0 = *(const f32x4*)(gt + col0 + (bj_) * HALF), gq1 = *(const f32x4*)(gt + col0 + (bj_) * HALF + 4); _Pragma("unroll") for (int m = 0; m < 4; ++m) { const unsigned off = (unsigned)((rl0 + (ai_) * HALF + m * 16) * 2048 + col0 + (bj_) * HALF); \
            f32x4 a0 = acc[ai_][bj_][m][0], a1 = acc[ai_][bj_][m][1]; \
            if (sl) { a0 += sl[((((ai_) * 2 + (bj_)) * 4 + m) * 2 + 0) * 512]; a1 += sl[((((ai_) * 2 + (bj_)) * 4 + m) * 2 + 1) * 512]; } \
            *(f32x4*)(xo + off) = src[m][0] + gq0 * a0; *(f32x4*)(xo + off + 4) = src[m][1] + gq1 * a1; } } while (0)
        EPI_LOADQ(xa, 0, 0); EPI_LOADQ(xb, 0, 1);
        EPI_EMITQ(xa, 0, 0); asm volatile("" ::: "memory");
        EPI_LOADQ(xa, 1, 0);
        EPI_EMITQ(xb, 0, 1); asm volatile("" ::: "memory");
        EPI_LOADQ(xb, 1, 1);
        EPI_EMITQ(xa, 1, 0); asm volatile("" ::: "memory");
        EPI_EMITQ(xb, 1, 1);
#undef EPI_LOADQ
#undef EPI_EMITQ
    }
};

template <class Epi, class Sched, bool ALIGN_EPI = false, bool SP2 = false>
__device__ __forceinline__ void gemm_phase(PG8_LAS unsigned char* lds, const Gemm g, const Sched& S, const Epi& E) {
    const int tid = pg8_otid(), wid = __builtin_amdgcn_readfirstlane(tid >> 6), lane = tid & 63, wr = wid >> 2, wc = wid & 3, fr = lane & 15, fq = lane >> 4;
    const int K = g.K, nt = K / BK;
    unsigned voffA[2], voffB[2];
#pragma unroll
    for (int i = 0; i < 2; ++i) { int R, C; stage_rc(tid * 16 + i * 8192, R, C); const int Rb = Epi::PERM ? ((R & ~31) + perm32(R & 31)) : R;
        voffA[i] = (unsigned)(R * K + C) * 2u; voffB[i] = (unsigned)(Rb * K + C) * 2u; }
    const size_t kstep = (size_t)(BK * 2);
    const size_t hstep = (size_t)HALF * K * 2;
    const size_t tstep = 2 * hstep;
    const unsigned ldsw = (unsigned)wid * 1024u;
    const int aoff = lds_byte(wr * 64 + fr, fq * 8), boff = lds_byte(wc * 32 + fr, fq * 8);
#define PG8_SA(b, h) (((b) * 2 + (h)) * HTB)
#define PG8_SB(b, h) ((4 + (b) * 2 + (h)) * HTB)
#define PG8_STAGE(bufoff, gbase, voff) do { _Pragma("unroll") for (int _i = 0; _i < 2; ++_i) \
        __builtin_amdgcn_global_load_lds((const unsigned*)((const char*)(gbase) + (voff)[_i]), (PG8_LAS unsigned*)(lds + (bufoff) + ldsw + _i * 8192), 16, 0, 0); } while (0)
#define PG8_LDA(dst, b, h) do { _Pragma("unroll") for (int m = 0; m < 4; ++m) _Pragma("unroll") for (int k = 0; k < 2; ++k) dst[m][k] = *(const PG8_LAS bf16x8*)(lds + PG8_SA(b, h) + aoff + m * 2048 + k * 1024); } while (0)
#define PG8_LDB(dst, b, h) do { _Pragma("unroll") for (int n = 0; n < 2; ++n) _Pragma("unroll") for (int k = 0; k < 2; ++k) dst[n][k] = *(const PG8_LAS bf16x8*)(lds + PG8_SB(b, h) + boff + n * 2048 + k * 1024); } while (0)
#define PG8_MMA(ai, bj, At, Bt) do { __builtin_amdgcn_s_setprio(1); _Pragma("unroll") for (int m = 0; m < 4; ++m) _Pragma("unroll") for (int n = 0; n < 2; ++n) _Pragma("unroll") for (int k = 0; k < 2; ++k) \
        acc[ai][bj][m][n] = __builtin_amdgcn_mfma_f32_16x16x32_bf16(Bt[n][k], At[m][k], acc[ai][bj][m][n], 0, 0, 0); __builtin_amdgcn_s_setprio(0); } while (0)
#define PG8_WAIT_V(n) asm volatile("s_waitcnt vmcnt(" #n ")" ::: "memory")
#define PG8_WAIT_L(n) asm volatile("s_waitcnt lgkmcnt(" #n ")" ::: "memory")
#define PG8_BAR __builtin_amdgcn_s_barrier()
#define PG8_SCHED __builtin_amdgcn_sched_barrier(0)
    Unit cur, nxt; int ui = 0;
    if (!S.next(0, cur)) return;
    f32x4 acc[2][2][4][2];
#pragma unroll
    for (int a = 0; a < 2; ++a)
#pragma unroll
        for (int b = 0; b < 2; ++b)
#pragma unroll
            for (int m = 0; m < 4; ++m)
#pragma unroll
                for (int n = 0; n < 2; ++n) acc[a][b][m][n] = (f32x4){0.f, 0.f, 0.f, 0.f};
    bf16x8 At[4][2], B0[2][2], B1[2][2];
    const char* cA = (const char*)g.A + (size_t)cur.pm * tstep + (size_t)cur.kp * (K / cur.np) * 2; const char* cB = (const char*)g.Bt + (size_t)cur.pn * tstep + (size_t)cur.kp * (K / cur.np) * 2;
    S.a_ready(cur);
    if constexpr (SP2) {
        PG8_STAGE(PG8_SB(0, 0), cB, voffB); PG8_STAGE(PG8_SB(0, 1), cB + hstep, voffB); PG8_STAGE(PG8_SA(0, 0), cA, voffA); PG8_STAGE(PG8_SA(0, 1), cA + hstep, voffA);
        if (wr == 1) PG8_BAR;
        PG8_WAIT_V(2); PG8_BAR;
        PG8_STAGE(PG8_SB(1, 0), cB + kstep, voffB); PG8_STAGE(PG8_SA(1, 0), cA + kstep, voffA); PG8_STAGE(PG8_SB(1, 1), cB + hstep + kstep, voffB);
        PG8_WAIT_V(6); PG8_BAR;
    } else {
        PG8_STAGE(PG8_SB(0, 0), cB, voffB); PG8_STAGE(PG8_SA(0, 0), cA, voffA); PG8_STAGE(PG8_SB(0, 1), cB + hstep, voffB); PG8_STAGE(PG8_SA(0, 1), cA + hstep, voffA);
        if (wr == 1) PG8_BAR;
        PG8_WAIT_V(4); PG8_BAR;
        PG8_STAGE(PG8_SB(1, 0), cB + kstep, voffB); PG8_STAGE(PG8_SA(1, 0), cA + kstep, voffA); PG8_STAGE(PG8_SB(1, 1), cB + hstep + kstep, voffB);
        PG8_WAIT_V(6); PG8_BAR;
    }
    for (;;) {
        const bool has_next = S.next(ui + 1, nxt);
        const size_t nko = has_next ? (size_t)nxt.kp * (K / nxt.np) * 2 : 0; const char* nA = has_next ? (const char*)g.A + (size_t)nxt.pm * tstep + nko : cA; const char* nB = has_next ? (const char*)g.Bt + (size_t)nxt.pn * tstep + nko : cB;
        const int ntc = nt / cur.np;
        for (int t = 0; t < ntc; t += 2) {
            const bool last = (t == ntc - 2);
            const char* a1 = cA + (size_t)(t + 1) * kstep;
            const char* a2 = last ? nA : cA + (size_t)(t + 2) * kstep; const char* b2 = last ? nB : cB + (size_t)(t + 2) * kstep;
            const char* a3 = a2 + kstep; const char* b3 = b2 + kstep;
            if (last && has_next) S.a_ready(nxt);
            if constexpr (SP2) {
            PG8_LDB(B0, 0, 0); PG8_LDB(B1, 0, 1); PG8_SCHED; PG8_LDA(At, 0, 0); PG8_STAGE(PG8_SA(1, 1), a1 + hstep, voffA);
            PG8_WAIT_V(8); PG8_WAIT_L(0); PG8_BAR; PG8_MMA(0, 0, At, B0); PG8_MMA(0, 1, At, B1); PG8_BAR; PG8_SCHED;
            PG8_LDA(At, 0, 1); PG8_STAGE(PG8_SB(0, 0), b2, voffB); PG8_STAGE(PG8_SB(0, 1), b2 + hstep, voffB); PG8_STAGE(PG8_SA(0, 0), a2, voffA);
            PG8_WAIT_V(8); PG8_WAIT_L(0); PG8_BAR; PG8_MMA(1, 0, At, B0); PG8_MMA(1, 1, At, B1); PG8_BAR; PG8_SCHED;
            PG8_LDB(B0, 1, 0); PG8_LDB(B1, 1, 1); PG8_SCHED; PG8_LDA(At, 1, 0); PG8_STAGE(PG8_SA(0, 1), a2 + hstep, voffA);
            PG8_WAIT_V(8); PG8_WAIT_L(0); PG8_BAR; PG8_MMA(0, 0, At, B0); PG8_MMA(0, 1, At, B1); PG8_BAR; PG8_SCHED;
            PG8_LDA(At, 1, 1); PG8_STAGE(PG8_SB(1, 0), b3, voffB); PG8_STAGE(PG8_SB(1, 1), b3 + hstep, voffB); PG8_STAGE(PG8_SA(1, 0), a3, voffA);
            PG8_WAIT_V(8); PG8_WAIT_L(0); PG8_BAR; PG8_MMA(1, 0, At, B0); PG8_MMA(1, 1, At, B1); PG8_BAR; PG8_SCHED;
            } else {
            PG8_LDB(B0, 0, 0); PG8_SCHED; PG8_LDA(At, 0, 0); PG8_STAGE(PG8_SA(1, 1), a1 + hstep, voffA);
            PG8_WAIT_L(8); PG8_BAR; PG8_WAIT_L(0); PG8_MMA(0, 0, At, B0); PG8_BAR; PG8_SCHED;
            PG8_LDB(B1, 0, 1); PG8_STAGE(PG8_SB(0, 0), b2, voffB);
            PG8_BAR; PG8_WAIT_L(0); PG8_MMA(0, 1, At, B1); PG8_BAR;
            PG8_LDA(At, 0, 1); PG8_STAGE(PG8_SA(0, 0), a2, voffA);
            PG8_BAR; PG8_WAIT_L(0); PG8_MMA(1, 0, At, B0); PG8_BAR; PG8_SCHED;
            PG8_STAGE(PG8_SB(0, 1), b2 + hstep, voffB);
            PG8_WAIT_V(6); PG8_BAR; PG8_MMA(1, 1, At, B1); PG8_BAR;
            PG8_LDB(B0, 1, 0); PG8_SCHED; PG8_LDA(At, 1, 0); PG8_STAGE(PG8_SA(0, 1), a2 + hstep, voffA);
            PG8_WAIT_L(8); PG8_BAR; PG8_WAIT_L(0); PG8_MMA(0, 0, At, B0); PG8_BAR; PG8_SCHED;
            PG8_LDB(B1, 1, 1); PG8_STAGE(PG8_SB(1, 0), b3, voffB);
            PG8_BAR; PG8_WAIT_L(0); PG8_MMA(0, 1, At, B1); PG8_BAR;
            PG8_LDA(At, 1, 1); PG8_STAGE(PG8_SA(1, 0), a3, voffA);
            PG8_BAR; PG8_WAIT_L(0); PG8_MMA(1, 0, At, B0); PG8_BAR; PG8_SCHED;
            PG8_STAGE(PG8_SB(1, 1), b3 + hstep, voffB);
            PG8_WAIT_V(6); PG8_BAR; PG8_MMA(1, 1, At, B1); PG8_BAR;
            }
        }
        if constexpr (ALIGN_EPI) { if (wr == 0) PG8_BAR; }
        if constexpr (!Epi::AFTER_DRAIN) { E(acc, cur, wr, wc, fr, fq); S.done(cur); }
        if (!has_next) break;
#pragma unroll
        for (int a = 0; a < 2; ++a)
#pragma unroll
            for (int b = 0; b < 2; ++b)
#pragma unroll
                for (int m = 0; m < 4; ++m)
#pragma unroll
                    for (int n = 0; n < 2; ++n) acc[a][b][m][n] = (f32x4){0.f, 0.f, 0.f, 0.f};
        cur = nxt; cA = nA; cB = nB; ++ui;
        if constexpr (ALIGN_EPI) { if (wr == 1) PG8_BAR; }
    }
    PG8_WAIT_V(0);
    if constexpr (!ALIGN_EPI) { if (wr == 0) PG8_BAR; }
    PG8_BAR;
    if constexpr (Epi::AFTER_DRAIN) { E.fused(acc, cur, wr, wc, fr, fq, lds, wid, lane); S.done(cur); }
#undef PG8_SA
#undef PG8_SB
#undef PG8_STAGE
#undef PG8_LDA
#undef PG8_LDB
#undef PG8_MMA
#undef PG8_WAIT_V
#undef PG8_WAIT_L
#undef PG8_BAR
#undef PG8_SCHED
}
}

#define LAS __attribute__((address_space(3)))
typedef unsigned short bf16_t;
typedef short bf16x8 __attribute__((ext_vector_type(8)));
typedef short s16x4 __attribute__((ext_vector_type(4)));
typedef float f32x4 __attribute__((ext_vector_type(4)));
typedef float f32x16 __attribute__((ext_vector_type(16)));
typedef unsigned u32x4 __attribute__((ext_vector_type(4)));
typedef unsigned u32x2 __attribute__((ext_vector_type(2)));


__device__ __forceinline__ int otid() { int t = threadIdx.x; asm volatile("" : "+v"(t)); return t; }
__device__ __forceinline__ unsigned ozero() { unsigned z = 0u; asm volatile("" : "+v"(z)); return z; }
__device__ __forceinline__ int obid() { int b = blockIdx.x; asm volatile("" : "+s"(b)); return b; }
constexpr int NWAVES = 8, NTHR = 512;
constexpr int DM = 2048, MC = 4096, ML = 8192, MROWS = 12288, MKROWS = 13312;
constexpr int LDP_AB = 7168, LDP_C = 5120;
constexpr int COL_QL = 0, COL_KVL = 512, COL_AG = 768, COL_BQ = 1792, COL_FF = 2816, COL_FB = 3840, COL_BI = 4864, COL_BG = 5888, COL_KPE = 6912;
constexpr float EPSN = 1e-6f;
constexpr float LOG2E = 1.4426950408889634f;
constexpr float QSC_A = 0.07216878364870322f * LOG2E;
constexpr float QSC_C = 0.08838834764831845f * LOG2E;

constexpr size_t O_YP = 0, O_YS = 8388608, O_CKV = 25165824, O_KPE = 27262976, O_SF = 27787264, O_SB = 31981568, O_KC = 36175872, O_VC = 40370176;

constexpr size_t MiB = 1u << 20;
constexpr size_t WS_CTL = 0, CTL_BYTES = 131072;
constexpr size_t WS_MOD = 1 * MiB, WS_LB = WS_MOD + 512 * 1024, WS_ROPEA = WS_LB + 64 * 1024, WS_ROPEC = WS_ROPEA + 512 * 1024;
constexpr size_t WS_KCC = 532 * MiB;
constexpr size_t WS_WINAB = 8 * MiB, WS_WQUP = 64 * MiB, WS_WKVUP = 67 * MiB, WS_WOUTAB = 69 * MiB, WS_WINC = 85 * MiB, WS_WOUTC = 125 * MiB;
constexpr size_t WS_H = 141 * MiB, WS_PROJ = 189 * MiB, WS_QRAW = 357 * MiB, WS_KVRAW = 393 * MiB, WS_KF = 445 * MiB, WS_OF = 484 * MiB, WS_OB = 508 * MiB;
constexpr size_t WS_QN = WS_OF, WS_CKV = WS_OF + 12 * MiB, WS_END = 552 * MiB;

constexpr int LDS_PHASE = 131072, LDS_BYTES = LDS_PHASE + 1024;

__device__ __forceinline__ float bf2f(unsigned short b) { return __uint_as_float((unsigned)b << 16); }
typedef float f32x2_t __attribute__((ext_vector_type(2)));
typedef __bf16 bf16x2_t __attribute__((ext_vector_type(2)));
__device__ __forceinline__ unsigned pk2(float lo, float hi) { const f32x2_t v = {lo, hi}; const bf16x2_t b = __builtin_convertvector(v, bf16x2_t); return __builtin_bit_cast(unsigned, b); }
__device__ __forceinline__ unsigned f2bf(float f) { return pk2(f, 0.f) & 0xffffu; }
__device__ __forceinline__ float silu_f(float x) { return x * __builtin_amdgcn_rcpf(1.f + __expf(-x)); }
__device__ __forceinline__ float wave_sum(float v) {
#pragma unroll
    for (int o = 1; o < 64; o <<= 1) v += __shfl_xor(v, o);
    return v;
}
__device__ __forceinline__ float sum16(float v) {
    v += __shfl_xor(v, 1); v += __shfl_xor(v, 2); v += __shfl_xor(v, 4); v += __shfl_xor(v, 8); return v;
}
__device__ __forceinline__ bf16x8 pack8(const float* v) {
    u32x4 w; w.x = pk2(v[0], v[1]); w.y = pk2(v[2], v[3]); w.z = pk2(v[4], v[5]); w.w = pk2(v[6], v[7]); return __builtin_bit_cast(bf16x8, w);
}

struct Args { const float* in[31]; float* out; unsigned char* ws; };
typedef const Args __attribute__((address_space(4)))* KArgs;

struct P0Item { const float* W; bf16_t* WT; int K, N, k0, n0, d0; };
__device__ __forceinline__ void p0_load(const P0Item& q, float (&v)[32], int lane) {
#pragma unroll
    for (int i = 0; i < 32; ++i) { const int kk = 2 * i + (lane >> 5); v[i] = q.W[(size_t)(q.k0 + kk) * q.N + q.n0 + (lane & 31)]; }
}
__device__ __forceinline__ void p0_emit(const P0Item& q, const float (&v)[32], LAS float* scr, int lane) {
#pragma unroll
    for (int i = 0; i < 32; ++i) { const int kk = 2 * i + (lane >> 5); scr[kk * 33 + (lane & 31)] = v[i]; }
    asm volatile("s_waitcnt lgkmcnt(0)" ::: "memory");
    const int c = lane & 7;
#pragma unroll
    for (int j = 0; j < 4; ++j) { const int n = (lane >> 3) + 8 * j; const LAS float* s = scr + (8 * c) * 33 + n;
        u32x4 o; o.x = pk2(s[0 * 33], s[1 * 33]); o.y = pk2(s[2 * 33], s[3 * 33]); o.z = pk2(s[4 * 33], s[5 * 33]); o.w = pk2(s[6 * 33], s[7 * 33]);
        *(u32x4*)(q.WT + (size_t)(q.d0 + n) * q.K + q.k0 + 8 * c) = o; }
    asm volatile("s_waitcnt lgkmcnt(0)" ::: "memory");
}
__device__ __forceinline__ P0Item p0_decode(KArgs a, int it) {
    constexpr int I_INAB = 32 * 218, I_QUP = 8 * 48, I_KVUP = 4 * 64, I_OUT = 32 * 64, I_INC = 32 * 160;
    constexpr int PER_J = I_INAB + I_QUP + I_KVUP + I_OUT + I_INC + I_OUT;
    unsigned char* ws = a->ws; P0Item q;
    const int j = it / PER_J; int r = it % PER_J;
    if (r < I_INAB) { const int kb = r / 218, nb = r % 218, n0 = nb * 32;
        q.W = a->in[13] + (size_t)j * 2048 * 6976; q.WT = (bf16_t*)(ws + WS_WINAB) + (size_t)j * 7168 * 2048; q.K = 2048; q.N = 6976; q.k0 = kb * 64; q.n0 = n0; q.d0 = n0 < 768 ? n0 : (n0 < 832 ? n0 + 6144 : n0 - 64); return q; }
    r -= I_INAB;
    if (r < I_QUP) { const int kb = r / 48, nb = r % 48;
        q.W = a->in[16] + (size_t)j * 512 * 1536; q.WT = (bf16_t*)(ws + WS_WQUP) + (size_t)j * 1536 * 512; q.K = 512; q.N = 1536; q.k0 = kb * 64; q.n0 = nb * 32; q.d0 = nb * 32; return q; }
    r -= I_QUP;
    if (r < I_KVUP) { const int kb = r / 64, nb = r % 64;
        q.W = a->in[17] + (size_t)j * 256 * 2048; q.WT = (bf16_t*)(ws + WS_WKVUP) + (size_t)j * 2048 * 256; q.K = 256; q.N = 2048; q.k0 = kb * 64; q.n0 = nb * 32; q.d0 = nb * 32; return q; }
    r -= I_KVUP;
    if (r < I_OUT) { const int kb = r / 64, nb = r % 64;
        q.W = a->in[22] + (size_t)j * 2048 * 2048; q.WT = (bf16_t*)(ws + WS_WOUTAB) + (size_t)j * 2048 * 2048; q.K = 2048; q.N = 2048; q.k0 = kb * 64; q.n0 = nb * 32; q.d0 = nb * 32; return q; }
    r -= I_OUT;
    if (r < I_INC) { const int kb = r / 160, nb = r % 160;
        q.W = a->in[26] + (size_t)j * 2048 * 5120; q.WT = (bf16_t*)(ws + WS_WINC) + (size_t)j * 5120 * 2048; q.K = 2048; q.N = 5120; q.k0 = kb * 64; q.n0 = nb * 32; q.d0 = nb * 32; return q; }
    r -= I_INC;
    { const int kb = r / 64, nb = r % 64;
        q.W = a->in[30] + (size_t)j * 2048 * 2048; q.WT = (bf16_t*)(ws + WS_WOUTC) + (size_t)j * 2048 * 2048; q.K = 2048; q.N = 2048; q.k0 = kb * 64; q.n0 = nb * 32; q.d0 = nb * 32; return q; }
}

__device__ __forceinline__ void phase_p0(KArgs a, LAS unsigned char* lds) {
    const int tid = otid(), lane = tid & 63, wave = tid >> 6;
    const int G = gridDim.x, bid = obid();
    const int gw = bid * NWAVES + wave, NGW = G * NWAVES;
    unsigned char* ws = a->ws;
    {
        LAS float* scr = (LAS float*)(lds + wave * 8448);
        constexpr int TOTAL = 2 * (32 * 218 + 8 * 48 + 4 * 64 + 32 * 64 + 32 * 160 + 32 * 64);
        for (int it = gw; it < TOTAL; it += 2 * NGW) {
            const bool two = it + NGW < TOTAL;
            const P0Item qa = p0_decode(a, it); const P0Item qb = p0_decode(a, two ? it + NGW : it);
            float va[32], vb[32];
            p0_load(qa, va, lane); if (two) p0_load(qb, vb, lane);
            p0_emit(qa, va, scr, lane); if (two) p0_emit(qb, vb, scr, lane);
        }
    }
    const int gt = bid * NTHR + tid, NGT = G * NTHR;
    const unsigned zz = ozero();
    for (int i = gt; i < 2 * 192 * 256; i += NGT) { const int j = i / (192 * 256), r = i % (192 * 256);
        *(u32x4*)((bf16_t*)(ws + WS_WINAB) + (size_t)j * 7168 * 2048 + (size_t)6976 * 2048 + (size_t)r * 8) = (u32x4){zz, zz, zz, zz}; }
    for (int i = gt; i < 2 * 131072; i += NGT) { const int which = i / 131072, e = (i % 131072) * 8;
        const float* src = a->in[6 + which] + e; const f32x4 x0 = *(const f32x4*)src, x1 = *(const f32x4*)(src + 4);
        u32x4 w; w.x = pk2(x0[0], x0[1]); w.y = pk2(x0[2], x0[3]); w.z = pk2(x1[0], x1[1]); w.w = pk2(x1[2], x1[3]);
        *(u32x4*)((bf16_t*)(ws + WS_KCC) + (size_t)(e >> 9) * LDP_C + (which ? 512 : 0) + (e & 511)) = w; }
    for (int i = gt; i < 2 * 2048; i += NGT) { const int j = i / 2048, r = i % 2048; const float l0 = a->in[20][r], l1 = a->in[20][2048 + r];
        ((float*)(ws + WS_LB))[i] = j == 0 ? 0.f : 1.f / (1.f + __expf(l0 - l1)); }
    for (int i = gt; i < 2048 * 32; i += NGT) { const int t = i >> 5, f = i & 31; const float pos = f < 16 ? (float)(t >> 6) : (float)(t & 63);
        const float inv = exp2f(-(float)(f & 15) * (13.287712379549449f / 16.f)); const float ang = pos * inv;
        ((float*)(ws + WS_ROPEA))[2 * i] = __cosf(ang); ((float*)(ws + WS_ROPEA))[2 * i + 1] = __sinf(ang); }
    for (int i = gt; i < 2048 * 64; i += NGT) { const int t = i >> 6, f = i & 63; const float pos = f < 32 ? (float)(t >> 6) : (float)(t & 63);
        const float inv = exp2f(-(float)(f & 31) * (13.287712379549449f / 32.f)); const float ang = pos * inv;
        ((float*)(ws + WS_ROPEC))[2 * i] = __cosf(ang); ((float*)(ws + WS_ROPEC))[2 * i + 1] = __sinf(ang); }
    __syncthreads();
    {
        LAS float* SC = (LAS float*)lds;
        LAS float* RED = (LAS float*)(lds + 40960);
        for (int i = tid; i < 5 * 2048; i += NTHR) { const int b = i >> 11, k = i & 2047; const float x = b < 4 ? a->in[8][b * 2048 + k] : a->in[9][k]; SC[i] = silu_f(x); }
        __syncthreads();
        const int cq = tid & 7, ks = tid >> 3;
        for (int u = bid; u < 768; u += G) {
            const int L = u / 192, col0 = (u % 192) * 32;
            const float* W = ((L & 1) ? a->in[23] : a->in[10]) + (size_t)(L >> 1) * 2048 * 6144;
            const float* bias = ((L & 1) ? a->in[24] : a->in[11]) + (size_t)(L >> 1) * 6144;
            f32x4 acc[5];
#pragma unroll
            for (int b = 0; b < 5; ++b) acc[b] = (f32x4){0.f, 0.f, 0.f, 0.f};
#pragma unroll 16
            for (int kk = 0; kk < 32; ++kk) { const int k = 32 * ks + kk; const f32x4 w = *(const f32x4*)(W + (size_t)k * 6144 + col0 + 4 * cq);
#pragma unroll
                for (int b = 0; b < 5; ++b) acc[b] += SC[b * 2048 + k] * w; }
#pragma unroll
            for (int b = 0; b < 5; ++b) *(LAS f32x4*)(RED + (ks * 5 + b) * 32 + 4 * cq) = acc[b];
            __syncthreads();
            if (tid < 160) { const int b = tid >> 5, c = tid & 31; float s = 0.f;
                for (int q = 0; q < 64; ++q) s += RED[(q * 5 + b) * 32 + c];
                ((float*)(ws + WS_MOD))[(L * 5 + b) * 6144 + col0 + c] = s + bias[col0 + c]; }
            __syncthreads();
        }
    }
}

__device__ __forceinline__ void phase_modnorm(KArgs a, int L) {
    const int tid = otid(), lane = tid & 63, wave = tid >> 6;
    const int gw = obid() * NWAVES + wave, NGW = gridDim.x * NWAVES;
    const float* g = ((L & 1) ? a->in[25] : a->in[12]) + (L >> 1) * 2048;
    bf16_t* H = (bf16_t*)(a->ws + WS_H);
    for (int r0 = gw * 2; r0 < MROWS; r0 += NGW * 2) {
        f32x4 v[2][8]; float ss[2] = {0.f, 0.f};
#pragma unroll
        for (int u = 0; u < 2; ++u) { const int r = r0 + u;
            const float* x = L == 0 ? (r < MC ? a->in[0] + (size_t)r * DM : a->in[1] + (size_t)(r - MC) * DM) : a->out + (size_t)r * DM;
#pragma unroll
            for (int j = 0; j < 8; ++j) v[u][j] = *(const f32x4*)(x + 256 * j + 4 * lane); }
#pragma unroll
        for (int u = 0; u < 2; ++u) {
#pragma unroll
            for (int j = 0; j < 8; ++j) ss[u] += (v[u][j][0] * v[u][j][0] + v[u][j][1] * v[u][j][1]) + (v[u][j][2] * v[u][j][2] + v[u][j][3] * v[u][j][3]); }
#pragma unroll
        for (int u = 0; u < 2; ++u) { const int r = r0 + u;
            const int ci = r < MC ? 4 : ((r - MC) >> 11);
            const float* md = (const float*)(a->ws + WS_MOD) + (L * 5 + ci) * 6144;
            const float rstd = rsqrtf(wave_sum(ss[u]) * (1.f / 2048.f) + EPSN);
#pragma unroll
            for (int j = 0; j < 8; ++j) { const int c = 256 * j + 4 * lane;
                const f32x4 gg = *(const f32x4*)(g + c), sh = *(const f32x4*)(md + c), sc = *(const f32x4*)(md + 2048 + c);
                const f32x4 y = (v[u][j] * rstd * gg) * (sc + 1.f) + sh;
                u32x2 w; w.x = pk2(y[0], y[1]); w.y = pk2(y[2], y[3]);
                *(u32x2*)(H + (size_t)r * DM + c) = w; } }
    }
}

__device__ __forceinline__ void phase_prep_ab(KArgs a, int j) {
    const int tid = otid(), lane = tid & 63, wave = tid >> 6;
    const int gw = obid() * NWAVES + wave, NGW = gridDim.x * NWAVES;
    const bf16_t* P = (const bf16_t*)(a->ws + WS_PROJ);
    bf16_t* QN = (bf16_t*)(a->ws + WS_QN); bf16_t* CKV = (bf16_t*)(a->ws + WS_CKV);
    const float* gq = a->in[14] + j * 512; const float* gkv = a->in[15] + j * 256;
    for (int r = gw; r < MKROWS; r += NGW) {
        if (r < MROWS) {
            const bf16_t* p = P + (size_t)r * LDP_AB;
            const bf16x8 q = *(const bf16x8*)(p + COL_QL + 8 * lane);
            float qv[8]; float ss = 0.f;
#pragma unroll
            for (int e = 0; e < 8; ++e) { qv[e] = bf2f((unsigned short)q[e]); ss += qv[e] * qv[e]; }
            const float rq = rsqrtf(wave_sum(ss) * (1.f / 512.f) + EPSN);
#pragma unroll
            for (int e = 0; e < 8; ++e) qv[e] = qv[e] * rq * gq[8 * lane + e];
            *(bf16x8*)(QN + (size_t)r * 512 + 8 * lane) = pack8(qv);
            const s16x4 kv = *(const s16x4*)(p + COL_KVL + 4 * lane);
            float kf[4]; float s2 = 0.f;
#pragma unroll
            for (int e = 0; e < 4; ++e) { kf[e] = bf2f((unsigned short)kv[e]); s2 += kf[e] * kf[e]; }
            const float rk = rsqrtf(wave_sum(s2) * (1.f / 256.f) + EPSN);
#pragma unroll
            for (int e = 0; e < 4; ++e) kf[e] = kf[e] * rk * gkv[4 * lane + e];
            u32x2 w; w.x = pk2(kf[0], kf[1]); w.y = pk2(kf[2], kf[3]);
            *(u32x2*)(CKV + (size_t)r * 256 + 4 * lane) = w;
            if (r < MC) { const int b = r >> 8, t = r & 255; const size_t rowo = (size_t)((b * 2 + j) * 256 + t);
                *(f32x4*)(a->out + O_CKV + rowo * 256 + 4 * lane) = (f32x4){kf[0], kf[1], kf[2], kf[3]};
                a->out[O_KPE + rowo * 64 + lane] = bf2f(p[COL_KPE + lane]); }
        } else {
            const int rr = r - MROWS, b = rr >> 8, t = rr & 255;
            const f32x4 x = *(const f32x4*)(a->in[2] + (size_t)((b * 2 + j) * 256 + t) * 256 + 4 * lane);
            u32x2 w; w.x = pk2(x[0], x[1]); w.y = pk2(x[2], x[3]);
            *(u32x2*)(CKV + (size_t)r * 256 + 4 * lane) = w;
        }
    }
}

__device__ __forceinline__ void phase_hn_ab(KArgs a, int j) {
    const int tid = otid(), lane = tid & 63, wave = tid >> 6, sub = lane & 15, hq = lane >> 4;
    const int gw = obid() * NWAVES + wave, NGW = gridDim.x * NWAVES;
    bf16_t* Q = (bf16_t*)(a->ws + WS_QRAW); const bf16_t* KV = (const bf16_t*)(a->ws + WS_KVRAW); bf16_t* KF = (bf16_t*)(a->ws + WS_KF);
    const bf16_t* P = (const bf16_t*)(a->ws + WS_PROJ);
    const float* RA = (const float*)(a->ws + WS_ROPEA);
    const float* gq = a->in[18] + j * 192; const float* gk = a->in[19] + j * 192;
    const float* ckpe = a->in[3];
    constexpr int U = 4;
    const int NQ = 0, NIT = MKROWS * 2;
    for (int base = gw * U; base < NIT; base += NGW * U) {
        bf16x8 vn[U]; float x1[U][2], x2[U][2]; f32x4 cs[U];
#pragma unroll
        for (int u = 0; u < U; ++u) { const int it = base + u; if (it < NIT) {
            const bool isq = it < NQ; const int w = isq ? it : it - NQ; const int r = w >> 1, h = (w & 1) * 4 + hq;
            if (isq) { const bf16_t* p = Q + (size_t)r * 1536 + h * 192;
                vn[u] = *(const bf16x8*)(p + 8 * sub); const unsigned a1 = *(const unsigned*)(p + 128 + 2 * sub), a2 = *(const unsigned*)(p + 160 + 2 * sub);
                x1[u][0] = bf2f(a1 & 0xffff); x1[u][1] = bf2f(a1 >> 16); x2[u][0] = bf2f(a2 & 0xffff); x2[u][1] = bf2f(a2 >> 16);
            } else { vn[u] = *(const bf16x8*)(KV + (size_t)r * 2048 + h * 256 + 8 * sub);
                if (r < MROWS) { const bf16_t* pe = P + (size_t)r * LDP_AB + COL_KPE; const unsigned a1 = *(const unsigned*)(pe + 2 * sub), a2 = *(const unsigned*)(pe + 32 + 2 * sub);
                    x1[u][0] = bf2f(a1 & 0xffff); x1[u][1] = bf2f(a1 >> 16); x2[u][0] = bf2f(a2 & 0xffff); x2[u][1] = bf2f(a2 >> 16); }
                else { const int rr = r - MROWS, b = rr >> 8, t = rr & 255; const float* pe = ckpe + (size_t)((b * 2 + j) * 256 + t) * 64;
                    x1[u][0] = pe[2 * sub]; x1[u][1] = pe[2 * sub + 1]; x2[u][0] = pe[32 + 2 * sub]; x2[u][1] = pe[32 + 2 * sub + 1]; } }
            if (r >= MC && r < MROWS) cs[u] = *(const f32x4*)(RA + (((r - MC) & 2047) * 32 + 2 * sub) * 2);
        } }
#pragma unroll
        for (int u = 0; u < U; ++u) { const int it = base + u; if (it < NIT) {
            const bool isq = it < NQ; const int w = isq ? it : it - NQ; const int r = w >> 1, h = (w & 1) * 4 + hq;
            float xn[8];
#pragma unroll
            for (int e = 0; e < 8; ++e) xn[e] = bf2f((unsigned short)vn[u][e]);
            float ss = x1[u][0] * x1[u][0] + x1[u][1] * x1[u][1] + x2[u][0] * x2[u][0] + x2[u][1] * x2[u][1];
#pragma unroll
            for (int e = 0; e < 8; ++e) ss += xn[e] * xn[e];
            const float rstd = rsqrtf(sum16(ss) * (1.f / 192.f) + EPSN);
            const float* g = isq ? gq : gk;
#pragma unroll
            for (int e = 0; e < 8; ++e) xn[e] = xn[e] * rstd * g[8 * sub + e];
            float y1[2], y2[2];
            y1[0] = x1[u][0] * rstd * g[128 + 2 * sub]; y1[1] = x1[u][1] * rstd * g[128 + 2 * sub + 1]; y2[0] = x2[u][0] * rstd * g[160 + 2 * sub]; y2[1] = x2[u][1] * rstd * g[160 + 2 * sub + 1];
            if (r >= MC && r < MROWS) {
#pragma unroll
                for (int q = 0; q < 2; ++q) { const float c = cs[u][2 * q], sn = cs[u][2 * q + 1];
                    const float z1 = y1[q] * c - y2[q] * sn, z2 = y1[q] * sn + y2[q] * c; y1[q] = z1; y2[q] = z2; } }
            bf16_t* p;
            if (isq) {
#pragma unroll
                for (int e = 0; e < 8; ++e) xn[e] *= QSC_A;
                y1[0] *= QSC_A; y1[1] *= QSC_A; y2[0] *= QSC_A; y2[1] *= QSC_A;
                p = Q + (size_t)r * 1536 + h * 192;
            } else p = KF + (size_t)r * 1536 + h * 192;
            *(bf16x8*)(p + 8 * sub) = pack8(xn); *(unsigned*)(p + 128 + 2 * sub) = pk2(y1[0], y1[1]); *(unsigned*)(p + 160 + 2 * sub) = pk2(y2[0], y2[1]);
        } }
    }
}

__device__ __forceinline__ void phase_fin_ab(KArgs a, int j) {
    const int tid = otid(), lane = tid & 63, wave = tid >> 6, sub = lane & 15, hq = lane >> 4;
    const int gw = obid() * NWAVES + wave, NGW = gridDim.x * NWAVES;
    const bf16_t* OF = (const bf16_t*)(a->ws + WS_OF); const bf16_t* OB = (const bf16_t*)(a->ws + WS_OB);
    const bf16_t* P = (const bf16_t*)(a->ws + WS_PROJ); bf16_t* MIX = (bf16_t*)(a->ws + WS_H);
    const float* g = a->in[21] + j * 128;
    constexpr int U = 4;
    for (int base = gw * U; base < MROWS * 2; base += NGW * U) {
        bf16x8 va[U], vb[U], vg[U];
#pragma unroll
        for (int u = 0; u < U; ++u) { const int it = base + u; const int r = it >> 1, h = (it & 1) * 4 + hq; const size_t o = (size_t)r * 1024 + h * 128 + 8 * sub;
            va[u] = *(const bf16x8*)(OF + o); vb[u] = *(const bf16x8*)(OB + o); vg[u] = *(const bf16x8*)(P + (size_t)r * LDP_AB + COL_BG + h * 128 + 8 * sub); }
#pragma unroll
        for (int u = 0; u < U; ++u) { const int it = base + u; const int r = it >> 1, h = (it & 1) * 4 + hq;
            float s[8]; float ss = 0.f;
#pragma unroll
            for (int e = 0; e < 8; ++e) { s[e] = bf2f((unsigned short)va[u][e]) + bf2f((unsigned short)vb[u][e]); ss += s[e] * s[e]; }
            const float rstd = rsqrtf(sum16(ss) * (1.f / 128.f) + EPSN);
#pragma unroll
            for (int e = 0; e < 8; ++e) s[e] = s[e] * rstd * g[8 * sub + e] * silu_f(bf2f((unsigned short)vg[u][e]));
            *(bf16x8*)(MIX + (size_t)r * DM + 1024 + h * 128 + 8 * sub) = pack8(s); }
    }
}

__device__ __forceinline__ void phase_hn_c(KArgs a, int j) {
    const int tid = otid(), lane = tid & 63, wave = tid >> 6, sub = lane & 15, hq = lane >> 4;
    const int gw = obid() * NWAVES + wave, NGW = gridDim.x * NWAVES;
    bf16_t* P = (bf16_t*)(a->ws + WS_PROJ);
    const float* RC = (const float*)(a->ws + WS_ROPEC);
    const float* gq = a->in[27] + j * 128; const float* gk = a->in[28] + j * 128;
    float* outp = a->out;
    for (int r = gw; r < MC; r += NGW) { const int b = r >> 8, t = r & 255; const bf16x8 v = *(const bf16x8*)(P + (size_t)r * LDP_C + 2560 + 8 * lane);
        float* o = outp + O_VC + (size_t)((b * 2 + j) * 256 + t) * 512 + 8 * lane;
        *(f32x4*)o = (f32x4){bf2f((unsigned short)v[0]), bf2f((unsigned short)v[1]), bf2f((unsigned short)v[2]), bf2f((unsigned short)v[3])};
        *(f32x4*)(o + 4) = (f32x4){bf2f((unsigned short)v[4]), bf2f((unsigned short)v[5]), bf2f((unsigned short)v[6]), bf2f((unsigned short)v[7])}; }
    constexpr int U = 4;
    const int NIT = MROWS;
    for (int base = gw * U; base < NIT; base += NGW * U) {
        s16x4 v1[U], v2[U]; f32x4 ca[U], cb[U];
#pragma unroll
        for (int u = 0; u < U; ++u) { const int it = base + u; if (it < NIT) {
            const int r = it, h = 16 + hq; const bool isq = false;
            const bf16_t* p = P + (size_t)r * LDP_C + (isq ? h * 128 : 2048 + (h - 16) * 128);
            v1[u] = *(const s16x4*)(p + 4 * sub); v2[u] = *(const s16x4*)(p + 64 + 4 * sub);
            if (r >= MC) { const float* rc = RC + (((r - MC) & 2047) * 64 + 4 * sub) * 2; ca[u] = *(const f32x4*)rc; cb[u] = *(const f32x4*)(rc + 4); }
        } }
#pragma unroll
        for (int u = 0; u < U; ++u) { const int it = base + u; if (it < NIT) {
            const int r = it, h = 16 + hq; const bool isq = false;
            bf16_t* p = P + (size_t)r * LDP_C + (isq ? h * 128 : 2048 + (h - 16) * 128);
            float x1[4], x2[4]; float ss = 0.f;
#pragma unroll
            for (int e = 0; e < 4; ++e) { x1[e] = bf2f((unsigned short)v1[u][e]); x2[e] = bf2f((unsigned short)v2[u][e]); ss += x1[e] * x1[e] + x2[e] * x2[e]; }
            const float rstd = rsqrtf(sum16(ss) * (1.f / 128.f) + EPSN);
            const float* g = isq ? gq : gk;
#pragma unroll
            for (int e = 0; e < 4; ++e) { x1[e] *= rstd * g[4 * sub + e]; x2[e] *= rstd * g[64 + 4 * sub + e]; }
            if (r >= MC) {
#pragma unroll
                for (int e = 0; e < 4; ++e) { const float c = e < 2 ? ca[u][2 * e] : cb[u][2 * (e - 2)], sn = e < 2 ? ca[u][2 * e + 1] : cb[u][2 * (e - 2) + 1];
                    const float y1 = x1[e] * c - x2[e] * sn, y2 = x1[e] * sn + x2[e] * c; x1[e] = y1; x2[e] = y2; } }
            else if (!isq) { const int b = r >> 8, t = r & 255; float* o = outp + O_KC + (size_t)((b * 2 + j) * 256 + t) * 512 + (h - 16) * 128;
                *(f32x4*)(o + 4 * sub) = (f32x4){x1[0], x1[1], x1[2], x1[3]}; *(f32x4*)(o + 64 + 4 * sub) = (f32x4){x2[0], x2[1], x2[2], x2[3]}; }
            if (isq) {
#pragma unroll
                for (int e = 0; e < 4; ++e) { x1[e] *= QSC_C; x2[e] *= QSC_C; } }
            u32x2 w1, w2; w1.x = pk2(x1[0], x1[1]); w1.y = pk2(x1[2], x1[3]); w2.x = pk2(x2[0], x2[1]); w2.y = pk2(x2[2], x2[3]);
            *(u32x2*)(p + 4 * sub) = w1; *(u32x2*)(p + 64 + 4 * sub) = w2;
        } }
    }
}

namespace att {
__device__ __forceinline__ int crow(int r, int hi) { return (r & 3) + 8 * (r >> 2) + 4 * hi; }
__device__ __forceinline__ unsigned cvtpk(float lo, float hi) { return pk2(lo, hi); }
__device__ __forceinline__ int v_st(int k, int c) { const int kk = (k & ~0xC) | ((k & 4) << 1) | ((k & 8) >> 1); return ((kk >> 3) * 4 + (c >> 5)) * 512 + ((kk & 7) * 32 + (c & 31)) * 2; }
__device__ __forceinline__ int v_rd_base(int lane) { return ((lane & 3) << 3) | (((lane >> 2) & 3) << 6) | (((lane >> 4) & 1) << 5) | (((lane >> 5) & 1) << 8); }
constexpr int v_rd_off(int d0, int ks, int half) { return d0 * 512 + ks * 4096 + half * 2048; }
template <int OFF> __device__ __forceinline__ s16x4 tr_read(int vb) {
    s16x4 r; asm volatile("ds_read_b64_tr_b16 %0, %1 offset:%2" : "=&v"(r) : "v"(vb), "i"(OFF) : "memory"); return r;
}
template <int D0> __device__ __forceinline__ void pv_read8(s16x4 (&r)[8], int vb) {
    r[0] = tr_read<v_rd_off(D0, 0, 0)>(vb); r[1] = tr_read<v_rd_off(D0, 0, 1)>(vb); r[2] = tr_read<v_rd_off(D0, 1, 0)>(vb); r[3] = tr_read<v_rd_off(D0, 1, 1)>(vb);
    r[4] = tr_read<v_rd_off(D0, 2, 0)>(vb); r[5] = tr_read<v_rd_off(D0, 2, 1)>(vb); r[6] = tr_read<v_rd_off(D0, 3, 0)>(vb); r[7] = tr_read<v_rd_off(D0, 3, 1)>(vb);
}
__device__ __forceinline__ void pv_mma4(f32x16& od, const s16x4 (&r)[8], bf16x8 pa0, bf16x8 pa1, bf16x8 pa2, bf16x8 pa3) {
#define ATT_PK(L, H) (bf16x8){L[0], L[1], L[2], L[3], H[0], H[1], H[2], H[3]}
    od = __builtin_amdgcn_mfma_f32_32x32x16_bf16(pa0, ATT_PK(r[0], r[1]), od, 0, 0, 0);
    od = __builtin_amdgcn_mfma_f32_32x32x16_bf16(pa1, ATT_PK(r[2], r[3]), od, 0, 0, 0);
    od = __builtin_amdgcn_mfma_f32_32x32x16_bf16(pa2, ATT_PK(r[4], r[5]), od, 0, 0, 0);
    od = __builtin_amdgcn_mfma_f32_32x32x16_bf16(pa3, ATT_PK(r[6], r[7]), od, 0, 0, 0);
#undef ATT_PK
}
__device__ __forceinline__ void pv_all(f32x16 (&o)[4], int vb, bf16x8 pa0, bf16x8 pa1, bf16x8 pa2, bf16x8 pa3) {
    s16x4 ra[8], rb[8];
    pv_read8<0>(ra, vb);
    pv_read8<1>(rb, vb); asm volatile("s_waitcnt lgkmcnt(8)" ::: "memory"); __builtin_amdgcn_sched_barrier(0);
    pv_mma4(o[0], ra, pa0, pa1, pa2, pa3); __builtin_amdgcn_sched_barrier(0);
    pv_read8<2>(ra, vb); asm volatile("s_waitcnt lgkmcnt(8)" ::: "memory"); __builtin_amdgcn_sched_barrier(0);
    pv_mma4(o[1], rb, pa0, pa1, pa2, pa3); __builtin_amdgcn_sched_barrier(0);
    pv_read8<3>(rb, vb); asm volatile("s_waitcnt lgkmcnt(8)" ::: "memory"); __builtin_amdgcn_sched_barrier(0);
    pv_mma4(o[2], ra, pa0, pa1, pa2, pa3); __builtin_amdgcn_sched_barrier(0);
    asm volatile("s_waitcnt lgkmcnt(0)" ::: "memory"); __builtin_amdgcn_sched_barrier(0);
    pv_mma4(o[3], rb, pa0, pa1, pa2, pa3);
}
struct Item {
    const bf16_t* Q; int ldq;
    const bf16_t* K0; const bf16_t* V0; int n0;
    const bf16_t* K1; const bf16_t* V1; int ldk, ldv, t_lo, t_hi;
    int q0, band; float m0, l0;
    const float* qg; const float* rope; float qscale;
    const bf16_t* G; int ldg; bf16_t* O; int ldo;
};
template <int DQK>
__device__ __forceinline__ void attn_item(LAS unsigned char* lds, const Item& it) {
    constexpr int KROW = DQK * 2, SHM_K = 64 * KROW, SHM_V = 64 * 128 * 2, ND = DQK / 16;
    const int tid = otid(), wid = tid >> 6, lane = tid & 63, r32 = lane & 31, hi = lane >> 5;
    LAS unsigned char* V_lds = lds; LAS unsigned char* K_lds = lds + 3 * SHM_V;
    LAS float* wsx = (LAS float*)(lds + 3 * SHM_V + 3 * SHM_K) + wid * 64; LAS float* li_l = wsx; LAS float* al_l = wsx + 32;
    float m_reg = it.m0, l_reg = it.l0;
    f32x16 o[4];
#pragma unroll
    for (int d = 0; d < 4; ++d)
#pragma unroll
        for (int r = 0; r < 16; ++r) o[d][r] = 0.f;
    bf16x8 qr[ND];
    {
      const bf16_t* Qw = it.Q + (size_t)(wid * 32 + r32) * it.ldq + hi * 8;
      float xf[ND][8]; float ss = 0.f;
#pragma unroll
      for (int d0 = 0; d0 < ND; ++d0) { const bf16x8 v = *(const bf16x8*)(Qw + d0 * 16);
#pragma unroll
          for (int e = 0; e < 8; ++e) { xf[d0][e] = bf2f((unsigned short)v[e]); ss += xf[d0][e] * xf[d0][e]; } }
      ss += __shfl_xor(ss, 32);
      const float rstd = rsqrtf(ss * (1.f / (float)DQK) + EPSN);
#pragma unroll
      for (int d0 = 0; d0 < ND; ++d0) { const f32x4 g0 = *(const f32x4*)(it.qg + d0 * 16 + hi * 8), g1 = *(const f32x4*)(it.qg + d0 * 16 + hi * 8 + 4);
#pragma unroll
          for (int e = 0; e < 8; ++e) xf[d0][e] *= rstd * (e < 4 ? g0[e & 3] : g1[e & 3]); }
      if (it.rope) { constexpr int NR = DQK == 128 ? 4 : 2, RB = DQK == 128 ? 0 : 8, RS = DQK == 128 ? 64 : 32;
          const float* rp = it.rope + (size_t)((it.q0 + wid * 32 + r32) * RS + hi * 8) * 2;
#pragma unroll
          for (int p = 0; p < NR; ++p) { f32x4 cs4[4];
#pragma unroll
              for (int q = 0; q < 4; ++q) cs4[q] = *(const f32x4*)(rp + p * 32 + 4 * q);
#pragma unroll
              for (int e = 0; e < 8; ++e) { const float c = cs4[e >> 1][(e & 1) * 2], sn = cs4[e >> 1][(e & 1) * 2 + 1];
                  const float x1 = xf[RB + p][e], x2 = xf[RB + NR + p][e]; xf[RB + p][e] = x1 * c - x2 * sn; xf[RB + NR + p][e] = x1 * sn + x2 * c; } } }
#pragma unroll
      for (int d0 = 0; d0 < ND; ++d0) { float t8[8];
#pragma unroll
          for (int e = 0; e < 8; ++e) t8[e] = xf[d0][e] * it.qscale;
          qr[d0] = pack8(t8); } }
    const int NT = it.n0 + (it.t_hi - it.t_lo);
    const int wvu = __builtin_amdgcn_readfirstlane(wid);
    const int vb0 = (int)(uintptr_t)V_lds + v_rd_base(lane);
    constexpr int NKI = SHM_K / 8192;
    unsigned kog[NKI], vog[2];
#pragma unroll
    for (int i = 0; i < NKI; ++i) { const int off = i * 8192 + wid * 1024 + lane * 16, row = off / KROW, pos = off % KROW; kog[i] = (unsigned)(row * it.ldk + ((pos ^ ((row & 7) << 4)) >> 1)); }
#pragma unroll
    for (int i = 0; i < 2; ++i) { const int q = (i * 8192 + wid * 1024 + lane * 16) >> 4, sub = q >> 5, rem = q & 31, rowin = rem >> 2, cch = rem & 3;
        const int kk = (sub >> 2) * 8 + rowin; vog[i] = (unsigned)(((kk & ~0xC) | ((kk & 4) << 1) | ((kk & 8) >> 1)) * it.ldv + (sub & 3) * 32 + cch * 8); }
    int koff[4];
#pragma unroll
    for (int dl = 0; dl < 4; ++dl) koff[dl] = r32 * KROW + ((dl * 32 + hi * 16) ^ ((r32 & 7) << 4));
#define ATT_STAGE(jj, b) do { const int _j = (jj); const bool _s0 = _j < it.n0; const int _t = _s0 ? _j : it.t_lo + (_j - it.n0); \
        const bf16_t* _Kp = (_s0 ? it.K0 : it.K1) + (size_t)(64 * _t) * it.ldk; const bf16_t* _Vp = (_s0 ? it.V0 : it.V1) + (size_t)(64 * _t) * it.ldv; \
        _Pragma("unroll") for (int _i = 0; _i < NKI; ++_i) __builtin_amdgcn_global_load_lds((const unsigned*)(_Kp + kog[_i]), (LAS unsigned*)(K_lds + (b) * SHM_K + _i * 8192 + wvu * 1024), 16, 0, 0); \
        _Pragma("unroll") for (int _i = 0; _i < 2; ++_i) __builtin_amdgcn_global_load_lds((const unsigned*)(_Vp + vog[_i]), (LAS unsigned*)(V_lds + (b) * SHM_V + _i * 8192 + wvu * 1024), 16, 0, 0); } while (0)
#define ATT_WAIT_TILE(more) do { if (more) { if constexpr (NKI == 3) asm volatile("s_waitcnt vmcnt(5)" ::: "memory"); else asm volatile("s_waitcnt vmcnt(4)" ::: "memory"); } \
        else asm volatile("s_waitcnt vmcnt(0)" ::: "memory"); \
        asm volatile("s_waitcnt lgkmcnt(0)" ::: "memory"); __builtin_amdgcn_s_barrier(); asm volatile("" ::: "memory"); } while (0)
    ATT_STAGE(0, 0); if (NT > 1) ATT_STAGE(1, 1);
    ATT_WAIT_TILE(NT > 1);
    int cur = 0;
    for (int j = 0; j < NT; ++j) {
        if (j + 2 < NT) ATT_STAGE(j + 2, (cur == 0 ? 2 : cur - 1));
        bool act = true; const bool domask = it.band && j >= it.n0; int kpos0 = 0;
        if (domask) { kpos0 = 64 * (it.t_lo + j - it.n0); const int qlo = it.q0 + wid * 32; act = (kpos0 + 63 >= qlo - 128) && (kpos0 <= qlo + 31 + 128); }
        if (act) {
            f32x16 p0, p1;
#pragma unroll
            for (int r = 0; r < 16; ++r) { p0[r] = 0.f; p1[r] = 0.f; }
            const LAS unsigned char* Ks = K_lds + cur * SHM_K;
            {
                constexpr int NG = ND / 4;
                bf16x8 kf[2][8];
#define ATT_LOADG(g_, dst) do { _Pragma("unroll") for (int u_ = 0; u_ < 4; ++u_) { dst[2 * u_] = *(const LAS bf16x8*)(Ks + koff[u_] + (g_) * 128); dst[2 * u_ + 1] = *(const LAS bf16x8*)(Ks + koff[u_] + (g_) * 128 + 32 * KROW); } } while (0)
                ATT_LOADG(0, kf[0]);
#pragma unroll
                for (int g = 0; g < NG; ++g) {
                    if (g + 1 < NG) ATT_LOADG(g + 1, kf[(g + 1) & 1]);
                    __builtin_amdgcn_sched_barrier(0);
#pragma unroll
                    for (int u_ = 0; u_ < 4; ++u_) { p0 = __builtin_amdgcn_mfma_f32_32x32x16_bf16(kf[g & 1][2 * u_], qr[4 * g + u_], p0, 0, 0, 0);
                        p1 = __builtin_amdgcn_mfma_f32_32x32x16_bf16(kf[g & 1][2 * u_ + 1], qr[4 * g + u_], p1, 0, 0, 0); }
                    __builtin_amdgcn_sched_barrier(0); }
#undef ATT_LOADG
            }
            if (domask) { const int qp = it.q0 + wid * 32 + r32;
#pragma unroll
                for (int r = 0; r < 16; ++r) { const int d = kpos0 + crow(r, hi) - qp;
                    if (d > 128 || d < -128) p0[r] = -1e30f;
                    if (d + 32 > 128 || d + 32 < -128) p1[r] = -1e30f; } }
            float pmax = p0[0];
#pragma unroll
            for (int r = 1; r < 16; ++r) pmax = fmaxf(pmax, p0[r]);
#pragma unroll
            for (int r = 0; r < 16; ++r) pmax = fmaxf(pmax, p1[r]);
            { auto rr = __builtin_amdgcn_permlane32_swap(__float_as_uint(pmax), __float_as_uint(pmax), false, false);
              pmax = fmaxf(__uint_as_float(rr[0]), __uint_as_float(rr[1])); }
            const float mn = fmaxf(m_reg, pmax); const float alpha = __builtin_amdgcn_exp2f(m_reg - mn); m_reg = mn;
            float ps = 0.f;
#pragma unroll
            for (int r = 0; r < 16; ++r) { p0[r] = __builtin_amdgcn_exp2f(p0[r] - mn); p1[r] = __builtin_amdgcn_exp2f(p1[r] - mn); ps += p0[r] + p1[r]; }
            { auto rr = __builtin_amdgcn_permlane32_swap(__float_as_uint(ps), __float_as_uint(ps), false, false);
              ps = __uint_as_float(rr[0]) + __uint_as_float(rr[1]); }
            l_reg = l_reg * alpha + ps;
            bf16x8 pa0, pa1, pa2, pa3;
#define ATT_PK4(P, BASE, OUT) do { unsigned a0 = cvtpk(P[BASE + 0], P[BASE + 1]), a1 = cvtpk(P[BASE + 2], P[BASE + 3]);   \
    unsigned b0 = cvtpk(P[BASE + 4], P[BASE + 5]), b1 = cvtpk(P[BASE + 6], P[BASE + 7]);                              \
    auto r0 = __builtin_amdgcn_permlane32_swap(a0, b0, false, false); auto r1 = __builtin_amdgcn_permlane32_swap(a1, b1, false, false); \
    u32x4 w = {r0[0], r1[0], r0[1], r1[1]}; OUT = __builtin_bit_cast(bf16x8, w); } while (0)
            ATT_PK4(p0, 0, pa0); ATT_PK4(p0, 8, pa1); ATT_PK4(p1, 0, pa2); ATT_PK4(p1, 8, pa3);
#undef ATT_PK4
            if (__any(alpha < 1.f)) { if (hi == 0) al_l[r32] = alpha; asm volatile("s_waitcnt lgkmcnt(0)" ::: "memory");
#pragma unroll
                for (int r = 0; r < 16; ++r) { const float al = al_l[crow(r, hi)];
#pragma unroll
                    for (int d = 0; d < 4; ++d) o[d][r] *= al; } }
            const int vb = vb0 + cur * SHM_V;
            pv_all(o, vb, pa0, pa1, pa2, pa3);
        }
        ATT_WAIT_TILE(j + 2 < NT);
        cur = cur == 2 ? 0 : cur + 1;
    }
#undef ATT_STAGE
#undef ATT_WAIT_TILE
    const int er = lane >> 4, ec = (lane & 15) * 8;
    bf16x8 gv[8];
    { const bf16_t* Gw = it.G + (size_t)(wid * 32 + er) * it.ldg + ec;
#pragma unroll
      for (int c = 0; c < 8; ++c) gv[c] = *(const bf16x8*)(Gw + (size_t)(4 * c) * it.ldg); }
    if (hi == 0) li_l[r32] = l_reg; asm volatile("s_waitcnt lgkmcnt(0)" ::: "memory");
    LAS bf16_t* ost = (LAS bf16_t*)(lds + wid * 8192);
#pragma unroll
    for (int r = 0; r < 16; ++r) { const float rli = 1.f / li_l[crow(r, hi)];
#pragma unroll
        for (int d0 = 0; d0 < 4; ++d0) ost[crow(r, hi) * 128 + d0 * 32 + r32] = (bf16_t)f2bf(o[d0][r] * rli); }
    asm volatile("s_waitcnt lgkmcnt(0)" ::: "memory");
    { bf16_t* Ow = it.O + (size_t)(wid * 32 + er) * it.ldo + ec;
#pragma unroll
      for (int c = 0; c < 8; ++c) { const bf16x8 ov = *(const LAS bf16x8*)(ost + (4 * c + er) * 128 + ec); float t8[8];
#pragma unroll
          for (int e = 0; e < 8; ++e) t8[e] = bf2f((unsigned short)ov[e]) * silu_f(bf2f((unsigned short)gv[c][e]));
          *(bf16x8*)(Ow + (size_t)(4 * c) * it.ldo) = pack8(t8); } }
    __syncthreads();
}
}

__device__ __forceinline__ void hgrn_item(LAS unsigned char* lds, const bf16_t* PROJ, int rowbase, int T, int h, int dir,
                                          const float* lb, const float* s0, float* sout, bf16_t* OUT) {
    LAS float* GS = (LAS float*)lds;
    LAS float* DEC = (LAS float*)(lds + 2048);
    LAS bf16_t* QT = (LAS bf16_t*)(lds + 2560);
    LAS bf16_t* KT = QT + 32 * 136;
    LAS bf16_t* KTt = KT + 32 * 136;
    LAS bf16_t* Vt = KTt + 128 * 40;
    const int tid = otid(), wid = tid >> 6, lane = tid & 63, fr = lane & 15, fq = lane >> 4;
    const int c2 = tid & 127, part = tid >> 7, n0 = wid * 16;
    f32x4 S[8];
#pragma unroll
    for (int kt = 0; kt < 8; ++kt) {
        if (s0) {
#pragma unroll
            for (int r = 0; r < 4; ++r) S[kt][r] = s0[(size_t)(16 * kt + 4 * fq + r) * 128 + n0 + fr]; }
        else S[kt] = (f32x4){0.f, 0.f, 0.f, 0.f}; }
    const float oml = 1.f - lb[c2];
    const unsigned hz = ozero();
    const int nch = T / 32;
    const bf16_t* pq = PROJ + COL_BQ + h * 128 + c2; const bf16_t* pf = PROJ + (dir ? COL_FB : COL_FF) + h * 128 + c2; const bf16_t* pv = PROJ + COL_BI + h * 128 + c2;
    unsigned short rq[2][8], rf[2][8], rv[2][8];
#define HG_LOAD(s_, cc) do { _Pragma("unroll") for (int _i = 0; _i < 8; ++_i) { const int _p = 32 * (cc) + 8 * part + _i; const int _tok = dir ? T - 1 - _p : _p; \
        const size_t _o = (size_t)(rowbase + _tok) * LDP_AB; rq[s_][_i] = pq[_o]; rf[s_][_i] = pf[_o]; rv[s_][_i] = pv[_o]; } } while (0)
    HG_LOAD(0, 0); HG_LOAD(1, 1);
    for (int c = 0; c < nch; c += 2) {
#pragma unroll
    for (int hf = 0; hf < 2; ++hf) { const int cc = c + hf;
        float b[8], kk[8], sq[8]; unsigned short vv[8];
        { float run = 0.f;
#pragma unroll
            for (int i = 0; i < 8; ++i) { const float x = bf2f(rf[hf][i]); const float omf = oml * __builtin_amdgcn_rcpf(1.f + __expf(x));
                const float lf = fmaxf(__logf(1.f - omf), -30.f); run += lf; b[i] = run; kk[i] = omf; sq[i] = silu_f(bf2f(rq[hf][i])); vv[i] = rv[hf][i]; }
            GS[part * 128 + c2] = run; }
        if (cc + 2 < nch) HG_LOAD(hf, cc + 2);
        __syncthreads();
        { float off = 0.f;
#pragma unroll
            for (int p = 0; p < 3; ++p) if (p < part) off += GS[p * 128 + c2];
            float kt_[8];
#pragma unroll
            for (int i = 0; i < 8; ++i) { const float bb = b[i] + off; const int t = 8 * part + i;
                const float qv = sq[i] * __expf(bb); kt_[i] = kk[i] * __expf(fminf(-bb, 80.f));
                QT[t * 136 + c2] = (bf16_t)f2bf(qv); KT[t * 136 + c2] = (bf16_t)f2bf(kt_[i]);
                if (i == 7 && part == 3) DEC[c2] = __expf(bb); }
            *(LAS bf16x8*)(KTt + c2 * 40 + 8 * part) = pack8(kt_);
            u32x4 wv; wv.x = (unsigned)vv[0] | ((unsigned)vv[1] << 16); wv.y = (unsigned)vv[2] | ((unsigned)vv[3] << 16); wv.z = (unsigned)vv[4] | ((unsigned)vv[5] << 16); wv.w = (unsigned)vv[6] | ((unsigned)vv[7] << 16);
            *(LAS u32x4*)(Vt + c2 * 40 + 8 * part) = wv; }
        __syncthreads();
        f32x4 pt00 = {0.f, 0.f, 0.f, 0.f}, pt01 = pt00, pt11 = pt00;
#pragma unroll
        for (int ks = 0; ks < 4; ++ks) {
            const bf16x8 a0 = *(const LAS bf16x8*)(KT + fr * 136 + 32 * ks + 8 * fq), a1 = *(const LAS bf16x8*)(KT + (16 + fr) * 136 + 32 * ks + 8 * fq);
            const bf16x8 b0 = *(const LAS bf16x8*)(QT + fr * 136 + 32 * ks + 8 * fq), b1 = *(const LAS bf16x8*)(QT + (16 + fr) * 136 + 32 * ks + 8 * fq);
            pt00 = __builtin_amdgcn_mfma_f32_16x16x32_bf16(a0, b0, pt00, 0, 0, 0);
            pt01 = __builtin_amdgcn_mfma_f32_16x16x32_bf16(a0, b1, pt01, 0, 0, 0);
            pt11 = __builtin_amdgcn_mfma_f32_16x16x32_bf16(a1, b1, pt11, 0, 0, 0); }
#pragma unroll
        for (int r = 0; r < 4; ++r) { if (4 * fq + r > fr) { pt00[r] = 0.f; pt11[r] = 0.f; } }
        u32x4 wA0, wA1;
        wA0.x = pk2(pt00[0], pt00[1]); wA0.y = pk2(pt00[2], pt00[3]); wA0.z = hz; wA0.w = hz;
        wA1.x = pk2(pt01[0], pt01[1]); wA1.y = pk2(pt01[2], pt01[3]); wA1.z = pk2(pt11[0], pt11[1]); wA1.w = pk2(pt11[2], pt11[3]);
        const u32x2 vlo = *(const LAS u32x2*)(Vt + (n0 + fr) * 40 + 4 * fq), vhi = *(const LAS u32x2*)(Vt + (n0 + fr) * 40 + 16 + 4 * fq);
        const u32x4 wV = {vlo.x, vlo.y, vhi.x, vhi.y};
        f32x4 o0 = {0.f, 0.f, 0.f, 0.f}, o1 = o0;
        o0 = __builtin_amdgcn_mfma_f32_16x16x32_bf16(__builtin_bit_cast(bf16x8, wA0), __builtin_bit_cast(bf16x8, wV), o0, 0, 0, 0);
        o1 = __builtin_amdgcn_mfma_f32_16x16x32_bf16(__builtin_bit_cast(bf16x8, wA1), __builtin_bit_cast(bf16x8, wV), o1, 0, 0, 0);
#pragma unroll
        for (int aa = 0; aa < 4; ++aa) {
            u32x4 wS; wS.x = pk2(S[2 * aa][0], S[2 * aa][1]); wS.y = pk2(S[2 * aa][2], S[2 * aa][3]); wS.z = pk2(S[2 * aa + 1][0], S[2 * aa + 1][1]); wS.w = pk2(S[2 * aa + 1][2], S[2 * aa + 1][3]);
            const u32x2 q0l = *(const LAS u32x2*)(QT + fr * 136 + 32 * aa + 4 * fq), q0h = *(const LAS u32x2*)(QT + fr * 136 + 32 * aa + 16 + 4 * fq);
            const u32x2 q1l = *(const LAS u32x2*)(QT + (16 + fr) * 136 + 32 * aa + 4 * fq), q1h = *(const LAS u32x2*)(QT + (16 + fr) * 136 + 32 * aa + 16 + 4 * fq);
            const u32x4 wQ0 = {q0l.x, q0l.y, q0h.x, q0h.y}, wQ1 = {q1l.x, q1l.y, q1h.x, q1h.y};
            o0 = __builtin_amdgcn_mfma_f32_16x16x32_bf16(__builtin_bit_cast(bf16x8, wQ0), __builtin_bit_cast(bf16x8, wS), o0, 0, 0, 0);
            o1 = __builtin_amdgcn_mfma_f32_16x16x32_bf16(__builtin_bit_cast(bf16x8, wQ1), __builtin_bit_cast(bf16x8, wS), o1, 0, 0, 0); }
        { const bf16x8 vn = *(const LAS bf16x8*)(Vt + (n0 + fr) * 40 + 8 * fq);
#pragma unroll
            for (int kt = 0; kt < 8; ++kt) { const bf16x8 ka = *(const LAS bf16x8*)(KTt + (16 * kt + fr) * 40 + 8 * fq);
                S[kt] = __builtin_amdgcn_mfma_f32_16x16x32_bf16(ka, vn, S[kt], 0, 0, 0);
                const f32x4 d = *(const LAS f32x4*)(DEC + 16 * kt + 4 * fq); S[kt] = S[kt] * d; } }
#pragma unroll
        for (int r = 0; r < 4; ++r) {
            const int i0 = 4 * fq + r, i1 = 16 + 4 * fq + r;
            const int tok0 = dir ? T - 1 - (32 * cc + i0) : 32 * cc + i0, tok1 = dir ? T - 1 - (32 * cc + i1) : 32 * cc + i1;
            OUT[(size_t)(rowbase + tok0) * 1024 + h * 128 + n0 + fr] = (bf16_t)f2bf(o0[r]);
            OUT[(size_t)(rowbase + tok1) * 1024 + h * 128 + n0 + fr] = (bf16_t)f2bf(o1[r]); }
    } }
#undef HG_LOAD
    if (sout) {
#pragma unroll
        for (int kt = 0; kt < 8; ++kt)
#pragma unroll
            for (int r = 0; r < 4; ++r) sout[(size_t)(16 * kt + 4 * fq + r) * 128 + n0 + fr] = S[kt][r]; }
    __syncthreads();
}

__device__ __forceinline__ int fetch_item(unsigned* ctr, LAS int* slot) {
    __syncthreads();
    if (otid() == 0) *slot = (int)atomicAdd(ctr, 1u);
    __syncthreads();
    return *slot;
}

#define XB_TMO      128
#define XB_XCNT(j)  (256  + 64 * (j))
#define XB_XSUB(j)  (1280 + 64 * (j))
#define XB_XGEN(j)  (2304 + 64 * (j))
#define XB_TOP      3328
#define XB_TOPGEN   3392
#define XCD_BAR_WORDS 3456
#define XB_SPIN_CAP (1u << 18)

__device__ __forceinline__ unsigned xb_ld(unsigned* p)              { return __hip_atomic_load(p, __ATOMIC_RELAXED, __HIP_MEMORY_SCOPE_AGENT); }
__device__ __forceinline__ unsigned xb_add(unsigned* p, unsigned v) { return __hip_atomic_fetch_add(p, v, __ATOMIC_RELAXED, __HIP_MEMORY_SCOPE_AGENT); }
__device__ __forceinline__ unsigned xb_xcc_id() { return (unsigned)__builtin_amdgcn_s_getreg((3 << 11) | 20) & 0xFu; }
#define XB_SPIN(cond, bar) do { unsigned _sp = 0; while (cond) { __builtin_amdgcn_s_sleep(1); \
    if ((++_sp & 255u) == 0u) { if (xb_ld(&(bar)[XB_TMO])) break; if (_sp > XB_SPIN_CAP) { atomicAdd(&(bar)[XB_TMO], 1u); break; } } } } while (0)

struct XcdBarrier {
    unsigned* bar; unsigned x;
    volatile LAS unsigned* st;
};

__device__ __forceinline__ XcdBarrier xcd_barrier_post(unsigned* bar, volatile LAS unsigned* st) {
    XcdBarrier b; b.bar = bar; b.x = xb_xcc_id(); b.st = st;
    if (threadIdx.x == 0) (void)xb_add(&bar[XB_XCNT(b.x)], 1u);
    return b;
}
__device__ __forceinline__ void xcd_barrier_complete(unsigned* bar, unsigned x, unsigned& nloc, unsigned& nx) {
    const unsigned G = gridDim.x * gridDim.y * gridDim.z;
    unsigned sum, cnt, mine, sp = 0u;
    for (;;) {
        sum = 0u; cnt = 0u; mine = 0u;
#pragma unroll
        for (unsigned j = 0; j < 16; ++j) { const unsigned c = xb_ld(&bar[XB_XCNT(j)]); sum += c; cnt += (c > 0u) ? 1u : 0u; mine = (j == x) ? c : mine; }
        if (sum == G) break;
        __builtin_amdgcn_s_sleep(1);
        if ((++sp & 255u) == 0u) { if (xb_ld(&bar[XB_TMO])) break; if (sp > XB_SPIN_CAP) { atomicAdd(&bar[XB_TMO], 1u); break; } }
    }
    nloc = mine > 0u ? mine : 1u; nx = cnt > 0u ? cnt : 1u;
}

__device__ __forceinline__ void xcd_barrier(const XcdBarrier& b) {
    asm volatile("s_waitcnt vmcnt(0)" ::: "memory");
    __syncthreads();
    if (threadIdx.x == 0) {
        unsigned* bar = b.bar;
        __builtin_amdgcn_s_waitcnt(0);
        unsigned nloc = b.st[0], nx = b.st[1];
        if (nloc == 0u) { xcd_barrier_complete(bar, b.x, nloc, nx); b.st[0] = nloc; b.st[1] = nx; }
        const unsigned old = xb_add(&bar[XB_XSUB(b.x)], 1u);
        const unsigned gen = old / nloc;
        if (old + 1u == (gen + 1u) * nloc) {
            __builtin_amdgcn_fence(__ATOMIC_RELEASE, "agent");
            asm volatile("s_waitcnt vmcnt(0)" ::: "memory");
            const unsigned og = xb_add(&bar[XB_TOP], 1u);
            const unsigned tg = og / nx;
            if (og + 1u == (tg + 1u) * nx) xb_add(&bar[XB_TOPGEN], 1u);
            else XB_SPIN(xb_ld(&bar[XB_TOPGEN]) == tg, bar);
            __builtin_amdgcn_fence(__ATOMIC_ACQUIRE, "agent");
            xb_add(&bar[XB_XGEN(b.x)], 1u);
            asm volatile("s_waitcnt vmcnt(0)" ::: "memory");
        } else {
            XB_SPIN(xb_ld(&bar[XB_XGEN(b.x)]) == gen, bar);
            __builtin_amdgcn_fence(__ATOMIC_ACQUIRE, "agent");
            asm volatile("s_waitcnt vmcnt(0)" ::: "memory");
        }
    }
    __syncthreads();
}

enum { K_P0 = 0, K_MODNORM, K_GEMM_IN, K_PREP_AB, K_GEMM_QUP, K_GEMM_KVUP, K_HN_AB, K_MIX_AB, K_FIN_AB, K_GEMM_OUT, K_HN_C, K_ATTN_C };

__global__ void __launch_bounds__(NTHR, 2) mk_fwd(Args a_byval) {
    extern __shared__ __attribute__((aligned(16))) unsigned char lds_raw[];
    LAS unsigned char* lds = (LAS unsigned char*)lds_raw;
    LAS int* slot = (LAS int*)(lds + LDS_PHASE);
    cg::grid_group grid = cg::this_grid();
    const int G = gridDim.x;
    volatile LAS unsigned* bst = (volatile LAS unsigned*)(lds + LDS_PHASE + 64);
    if (threadIdx.x < 2) bst[threadIdx.x] = 0u;
    __syncthreads();
    (void)xcd_barrier_post((unsigned*)(a_byval.ws + WS_CTL) + 8192, bst);

#ifndef PROBE_TSEL
#define PROBE_TSEL 0
#endif
    unsigned long long t_acc = 0ull;
    for (int step = 0; step < 29; ++step) {
        unsigned long long t_begin = 0ull; if (PROBE_TSEL) t_begin = __builtin_amdgcn_s_memrealtime();
        asm volatile("" : "+s"(step));
        KArgs a = (KArgs)__builtin_amdgcn_kernarg_segment_ptr();
        asm volatile("" : "+s"(a));
        unsigned char* ws = a->ws;
        unsigned* ctl = (unsigned*)(ws + WS_CTL);
        XcdBarrier xbar; xbar.bar = ctl + 8192; xbar.x = xb_xcc_id(); xbar.st = (volatile LAS unsigned*)(lds + LDS_PHASE + 64);
        int kind, L = 0; bool sync_after = true;
        if (step == 0) kind = K_P0;
        else { const int s = step - 1, pair = s / 14, r = s % 14;
            if (r < 9) { L = 2 * pair; kind = r == 0 ? K_MODNORM : r == 1 ? K_GEMM_IN : r == 2 ? K_PREP_AB : r == 3 ? K_GEMM_QUP : r == 4 ? K_GEMM_KVUP : r == 5 ? K_HN_AB : r == 6 ? K_MIX_AB : r == 7 ? K_FIN_AB : K_GEMM_OUT; }
            else { L = 2 * pair + 1; const int q = r - 9; kind = q == 0 ? K_MODNORM : q == 1 ? K_GEMM_IN : q == 2 ? K_HN_C : q == 3 ? K_ATTN_C : K_GEMM_OUT; } }
        const int j = L >> 1; const bool isC = (L & 1) != 0;
        if (kind == K_GEMM_QUP) sync_after = false;
        if (step == 28) sync_after = false;

#ifndef PROBE_MASK
#define PROBE_MASK 0
#endif
#ifndef PROBE_SEL
#define PROBE_SEL 0
#endif
#ifndef PROBE_REPS
#define PROBE_REPS 2
#endif
        const int nrep = (((PROBE_MASK >> kind) & 1) && (kind != K_GEMM_OUT || L == 0)) ? 1 + PROBE_REPS : 1;
        for (int rep = 0; rep < nrep; ++rep) {
        if (PROBE_MASK == 0x1000) { for (int q = 0; q < 2; ++q) xcd_barrier(xbar); }
        if (kind == K_P0) phase_p0(a, lds);
        else if (kind == K_MODNORM) phase_modnorm(a, L);
        else if (kind == K_GEMM_IN || kind == K_GEMM_QUP || kind == K_GEMM_KVUP) {
            pg8::Gemm g; pg8::EpiStore E;
            if (kind == K_GEMM_IN) {
                if (!isC) { g = pg8::Gemm{(const bf16_t*)(ws + WS_H), (const bf16_t*)(ws + WS_WINAB) + (size_t)j * 7168 * 2048, MROWS, 7168, 2048}; E = pg8::EpiStore{(bf16_t*)(ws + WS_PROJ), LDP_AB}; }
                else { g = pg8::Gemm{(const bf16_t*)(ws + WS_H), (const bf16_t*)(ws + WS_WINC) + (size_t)j * 5120 * 2048, MROWS, 5120, 2048}; E = pg8::EpiStore{(bf16_t*)(ws + WS_PROJ), LDP_C}; }
            } else if (kind == K_GEMM_QUP) { g = pg8::Gemm{(const bf16_t*)(ws + WS_QN), (const bf16_t*)(ws + WS_WQUP) + (size_t)j * 1536 * 512, MROWS, 1536, 512}; E = pg8::EpiStore{(bf16_t*)(ws + WS_QRAW), 1536}; }
            else { g = pg8::Gemm{(const bf16_t*)(ws + WS_CKV), (const bf16_t*)(ws + WS_WKVUP) + (size_t)j * 2048 * 256, MKROWS, 2048, 256}; E = pg8::EpiStore{(bf16_t*)(ws + WS_KVRAW), 2048}; }
            pg8::StaticOrder S; S.init(g.M, g.N, G, obid());
            pg8::gemm_phase<pg8::EpiStore, pg8::StaticOrder, true, true>(lds, g, S, E);
        }
        else if (kind == K_GEMM_OUT) {
            pg8::Gemm g{(const bf16_t*)(ws + WS_H), (const bf16_t*)(ws + (isC ? WS_WOUTC : WS_WOUTAB)) + (size_t)j * 2048 * 2048, MROWS, 2048, 2048};
            pg8::EpiResid E{L == 0 ? a->in[0] : a->out, L == 0 ? a->in[1] : a->out + (size_t)MC * DM, a->out, (const float*)(ws + WS_MOD) + (size_t)L * 5 * 6144 + 4096,
                            (float*)(ws + WS_QRAW), ctl + 16384 + step * 256};
            pg8::SplitOrder S; S.init(g.M, g.N, g.K, G, obid());
            pg8::gemm_phase<pg8::EpiResid, pg8::SplitOrder, true, true>(lds, g, S, E);
        }
        else if (kind == K_PREP_AB) phase_prep_ab(a, j);
        else if (kind == K_HN_AB) phase_hn_ab(a, j);
        else if (kind == K_FIN_AB) phase_fin_ab(a, j);
        else if (kind == K_HN_C) phase_hn_c(a, j);
        else if (kind == K_MIX_AB) {
            unsigned* ctr = ctl + 64 * step + 8 * rep;
            const bf16_t* P = (const bf16_t*)(ws + WS_PROJ); bf16_t* MIX = (bf16_t*)(ws + WS_H);
            const bf16_t* QF = (const bf16_t*)(ws + WS_QRAW); const bf16_t* KF = (const bf16_t*)(ws + WS_KF); const bf16_t* KV = (const bf16_t*)(ws + WS_KVRAW);
            for (;;) {
                const int idx = fetch_item(ctr, slot);
                if (idx >= 704) break;
                if (idx < 64 || (idx >= 320 && idx < 576)) {
                    const bool lat = idx < 64; const int i = lat ? idx : idx - 320; const int b = i >> 4, h = (i >> 1) & 7, dir = i & 1;
                    const float* lb = (const float*)(ws + WS_LB) + (j * 2 + dir) * 1024 + h * 128;
                    const float* s0 = lat ? a->in[4 + dir] + (size_t)((b * 2 + j) * 8 + h) * 16384 : nullptr;
                    float* so = lat ? nullptr : a->out + (dir ? O_SB : O_SF) + (size_t)((b * 2 + j) * 8 + h) * 16384;
                    if (PROBE_SEL != 1 || rep == 0) hgrn_item(lds, P, lat ? MC + b * 2048 : b * 256, lat ? 2048 : 256, h, dir, lb, s0, so, (bf16_t*)(ws + (dir ? WS_OB : WS_OF)));
                } else {
                    att::Item it;
                    const bool lat = idx < 320; int b, h, r0;
                    if (lat) { const int i = idx - 64; b = i >> 6; h = (i >> 3) & 7; const int qb = i & 7; r0 = MC + b * 2048 + qb * 256; it.q0 = qb * 256;
                        it.K0 = KF + (size_t)(MROWS + b * 256) * 1536 + h * 192; it.V0 = KV + (size_t)(MROWS + b * 256) * 2048 + h * 256 + 128; it.n0 = 4;
                        it.K1 = KF + (size_t)(MC + b * 2048) * 1536 + h * 192; it.V1 = KV + (size_t)(MC + b * 2048) * 2048 + h * 256 + 128; it.t_lo = 0; it.t_hi = 32; }
                    else { const int i = idx - 576; b = i >> 3; h = i & 7; r0 = b * 256; it.q0 = 0;
                        it.K0 = KF; it.V0 = KV; it.n0 = 0;
                        it.K1 = KF + (size_t)r0 * 1536 + h * 192; it.V1 = KV + (size_t)r0 * 2048 + h * 256 + 128; it.t_lo = 0; it.t_hi = 4; }
                    it.ldk = 1536; it.ldv = 2048;
                    it.Q = QF + (size_t)r0 * 1536 + h * 192; it.ldq = 1536; it.band = 0; it.m0 = -1e30f; it.l0 = 0.f;
                    it.qg = a->in[18] + j * 192; it.rope = lat ? (const float*)(ws + WS_ROPEA) : nullptr; it.qscale = QSC_A;
                    it.G = P + (size_t)r0 * LDP_AB + COL_AG + h * 128; it.ldg = LDP_AB; it.O = MIX + (size_t)r0 * DM + h * 128; it.ldo = DM;
                    if (PROBE_SEL != 2 || rep == 0) att::attn_item<192>(lds, it);
                }
            }
        }
        else if (kind == K_ATTN_C) {
            unsigned* ctr = ctl + 64 * step + 8 * rep;
            const bf16_t* P = (const bf16_t*)(ws + WS_PROJ); bf16_t* MIX = (bf16_t*)(ws + WS_H);
            const bf16_t* KCC = (const bf16_t*)(ws + WS_KCC);
            for (;;) {
                const int idx = fetch_item(ctr, slot);
                if (idx >= 768) break;
                att::Item it; int b, h, r0;
                if (idx < 512) { b = idx >> 7; h = (idx >> 3) & 15; const int qb = idx & 7; r0 = MC + b * 2048 + qb * 256; const int kvh = h >> 2;
                    it.K0 = KCC + (size_t)((b * 2 + j) * 256) * LDP_C + kvh * 128; it.V0 = KCC + (size_t)((b * 2 + j) * 256) * LDP_C + 512 + kvh * 128; it.n0 = 4;
                    it.K1 = P + (size_t)(MC + b * 2048) * LDP_C + 2048 + kvh * 128; it.V1 = P + (size_t)(MC + b * 2048) * LDP_C + 2560 + kvh * 128;
                    it.t_lo = 4 * qb - 2 < 0 ? 0 : 4 * qb - 2; it.t_hi = 4 * qb + 6 > 32 ? 32 : 4 * qb + 6; it.q0 = qb * 256; it.band = 1; }
                else { const int i = idx - 512; b = i >> 4; h = i & 15; r0 = b * 256; const int kvh = h >> 2;
                    it.K0 = KCC; it.V0 = KCC; it.n0 = 0;
                    it.K1 = P + (size_t)r0 * LDP_C + 2048 + kvh * 128; it.V1 = P + (size_t)r0 * LDP_C + 2560 + kvh * 128; it.t_lo = 0; it.t_hi = 4; it.q0 = 0; it.band = 0; }
                it.ldk = LDP_C; it.ldv = LDP_C;
                it.Q = P + (size_t)r0 * LDP_C + h * 128; it.ldq = LDP_C; it.m0 = a->in[29][j * 16 + h] * LOG2E; it.l0 = 1.f;
                it.qg = a->in[27] + j * 128; it.rope = idx < 512 ? (const float*)(ws + WS_ROPEC) : nullptr; it.qscale = QSC_C;
                it.G = P + (size_t)r0 * LDP_C + 3072 + h * 128; it.ldg = LDP_C; it.O = MIX + (size_t)r0 * DM + h * 128; it.ldo = DM;
                att::attn_item<128>(lds, it);
            }
        }
        if (rep + 1 < nrep) xcd_barrier(xbar);
        }
        if (sync_after) { if (step == 0) grid.sync(); xcd_barrier(xbar); }
        if (PROBE_TSEL) { if ((PROBE_TSEL >> kind) & 1) t_acc += __builtin_amdgcn_s_memrealtime() - t_begin; }
    }
    if (PROBE_TSEL) { if (blockIdx.x == 0) { const unsigned long long t_end = __builtin_amdgcn_s_memrealtime() + 2ull * t_acc;
        while (__builtin_amdgcn_s_memrealtime() < t_end) __builtin_amdgcn_s_sleep(32); } }
}

extern "C" void kernel_launch(void* const* d_in, const int* in_sizes, int n_in, void* d_out, int out_size, void* d_ws, size_t ws_size, hipStream_t stream) {
    static int grid = 0;
    if (grid == 0) {
        if (n_in != 31 || ws_size < WS_END) { fprintf(stderr, "kernel_launch: unexpected n_in %d or ws_size %zu (< %zu)\n", n_in, ws_size, (size_t)WS_END); grid = -1; return; }
        int dev = 0, cus = 0, per_cu = 0;
        hipGetDevice(&dev); hipDeviceGetAttribute(&cus, hipDeviceAttributeMultiprocessorCount, dev);
        if (hipFuncSetAttribute((const void*)mk_fwd, hipFuncAttributeMaxDynamicSharedMemorySize, LDS_BYTES) != hipSuccess) { fprintf(stderr, "kernel_launch: hipFuncSetAttribute failed\n"); grid = -1; return; }
        if (hipOccupancyMaxActiveBlocksPerMultiprocessor(&per_cu, (const void*)mk_fwd, NTHR, LDS_BYTES) != hipSuccess || per_cu < 1) per_cu = 1;
        (void)hipGetLastError();
        grid = cus > 0 ? cus : 256;
    }
    if (grid < 0) return;
    hipMemsetAsync((char*)d_ws + WS_CTL, 0, CTL_BYTES, stream);
    Args a{};
    for (int i = 0; i < 31; ++i) a.in[i] = (const float*)d_in[i];
    a.out = (float*)d_out; a.ws = (unsigned char*)d_ws;
    void* args[] = {&a};
    hipError_t e = hipLaunchCooperativeKernel((const void*)mk_fwd, dim3(grid), dim3(NTHR), args, LDS_BYTES, stream);
    if (e != hipSuccess) fprintf(stderr, "cooperative launch failed: %s (grid %d)\n", hipGetErrorString(e), grid);
}
```

```cpp
#include <hip/hip_runtime.h>
#include <hip/hip_cooperative_groups.h>
#include <cstdio>
#include <cstdint>
namespace cg = cooperative_groups;

namespace pg8 {
#define PG8_LAS __attribute__((address_space(3)))
typedef unsigned short bf16_t;
typedef short bf16x8 __attribute__((ext_vector_type(8)));
typedef float f32x4 __attribute__((ext_vector_type(4)));
typedef unsigned u32x4 __attribute__((ext_vector_type(4)));
constexpr int BM = 256, BK = 64, HALF = 128, HTB = HALF * BK * 2  , STAGE_BYTES = 8 * HTB, NXCD = 8, WGM = 8;
__device__ __forceinline__ int pg8_otid() { int t = threadIdx.x; asm volatile("" : "+v"(t)); return t; }

__host__ __device__ __forceinline__ int lds_byte(int r, int c) { const int st = (r >> 4) * 2 + (c >> 5), rr = r & 15, cc = c & 31, ob = rr * 64 + cc * 2; return st * 1024 + (ob ^ (((ob >> 9) & 1) << 5)); }
__host__ __device__ __forceinline__ void stage_rc(int b, int& R, int& C) { const int st = b / 1024, sb = b % 1024, swz = sb ^ (((sb >> 9) & 1) << 5); R = (st >> 1) * 16 + swz / 64; C = (st & 1) * 32 + (swz % 64) / 2; }
__host__ __device__ __forceinline__ int perm32(int rho) { const int n = rho >> 4, i = rho & 15; return 8 * (i >> 2) + 4 * n + (i & 3); }

struct Unit { int pm, pn, kp, np, tix; };
struct Gemm { const bf16_t* A; const bf16_t* Bt; int M, N, K; };

struct StaticOrder {
    int nM, nN, nwg, G, c;
    __host__ __device__ void init(int M, int N, int G_, int c_) { nM = M / BM; nN = N / BM; nwg = nM * nN; G = G_; c = c_; }
    __host__ __device__ bool next(int i, Unit& u) const {
        const long L = (long)i * G + c; if (L >= nwg) return false;
        int wgid = (int)L; { const int q = nwg / NXCD, r = nwg % NXCD, xcd = wgid % NXCD, off = wgid / NXCD; wgid = (xcd < r ? xcd * (q + 1) : r * (q + 1) + (xcd - r) * q) + off; }
        const int nig = WGM * nN, gid = wgid / nig, fm = gid * WGM, gsz = (nM - fm) < WGM ? (nM - fm) : WGM;
        u.pm = fm + ((wgid % nig) % gsz); u.pn = (wgid % nig) / gsz; u.kp = 0; u.np = 1; u.tix = 0; return true;
    }
    __device__ __forceinline__ void a_ready(const Unit&) const {}
    __device__ __forceinline__ void done(const Unit&) const {}
};
struct SplitOrder {
    StaticOrder so; int R, np;
    __host__ __device__ void init(int M, int N, int K, int G_, int c_) { so.init(M, N, G_, c_); R = so.nwg / G_; const int left = so.nwg - R * G_;
        np = 1; if (left > 0 && G_ % left == 0) { const int q = G_ / left; if (q == 2 && (K / q) % 128 == 0) np = q; } }
    __host__ __device__ bool next(int i, Unit& u) const {
        if (np == 1 || i < R) return so.next(i, u);
        if (i > R) return false;
        StaticOrder t = so; t.c = so.c / np; const bool ok = t.next(i, u); u.kp = so.c % np; u.np = np; u.tix = so.c / np; return ok;
    }
    __device__ __forceinline__ void a_ready(const Unit&) const {}
    __device__ __forceinline__ void done(const Unit&) const {}
};

typedef float f32x2c __attribute__((ext_vector_type(2)));
typedef __bf16 bf16x2c __attribute__((ext_vector_type(2)));
__device__ __forceinline__ unsigned cvt_pk_bf16(float lo, float hi) { const f32x2c v = {lo, hi}; const bf16x2c b = __builtin_convertvector(v, bf16x2c); return __builtin_bit_cast(unsigned, b); }

struct EpiStore {
    static constexpr bool PERM = true, AFTER_DRAIN = false;
    bf16_t* O; int ldc;
    __device__ __forceinline__ void operator()(const f32x4 (&acc)[2][2][4][2], const Unit& u, int wr, int wc, int fr, int fq) const {
        const int row0 = u.pm * BM + wr * 64 + fr; const int col0 = u.pn * BM + wc * 32 + 8 * fq;
#pragma unroll
        for (int ai = 0; ai < 2; ++ai)
#pragma unroll
            for (int m = 0; m < 4; ++m) { bf16_t* rowp = O + (size_t)(row0 + ai * HALF + m * 16) * ldc + col0;
#pragma unroll
                for (int bj = 0; bj < 2; ++bj) { const f32x4 v0 = acc[ai][bj][m][0], v1 = acc[ai][bj][m][1];
                    u32x4 w; w.x = cvt_pk_bf16(v0[0], v0[1]); w.y = cvt_pk_bf16(v0[2], v0[3]); w.z = cvt_pk_bf16(v1[0], v1[1]); w.w = cvt_pk_bf16(v1[2], v1[3]);
                    *(u32x4*)(rowp + bj * HALF) = w; } }
    }
};
struct EpiResid {
    static constexpr bool PERM = true, AFTER_DRAIN = false;
    bf16_t* dout; const float* gate_base;
    float* slab; unsigned* cnt;
    __device__ __forceinline__ void operator()(f32x4 (&acc)[2][2][4][2], const Unit& u, int wr, int wc, int fr, int fq) const {
        const int tid = (wr * 4 + wc) * 64 + fq * 16 + fr;
        const f32x4* sl = nullptr;
        if (u.np > 1) {
            float* sb = slab + (size_t)u.tix * (u.np - 1) * 65536;
            if (u.kp < u.np - 1) {
                f32x4* sp = (f32x4*)(sb + (size_t)u.kp * 65536) + tid;
#pragma unroll
                for (int ai = 0; ai < 2; ++ai)
#pragma unroll
                    for (int bj = 0; bj < 2; ++bj)
#pragma unroll
                        for (int m = 0; m < 4; ++m)
#pragma unroll
                            for (int n = 0; n < 2; ++n) sp[(((ai * 2 + bj) * 4 + m) * 2 + n) * 512] = acc[ai][bj][m][n];
                asm volatile("s_waitcnt vmcnt(0)" ::: "memory");
                __syncthreads();
                if (tid == 0) { __builtin_amdgcn_fence(__ATOMIC_RELEASE, "agent"); asm volatile("s_waitcnt vmcnt(0)" ::: "memory");
                    __hip_atomic_fetch_add(cnt + u.tix, 1u, __ATOMIC_RELAXED, __HIP_MEMORY_SCOPE_AGENT); }
                return;
            }
            if (tid == 0) { unsigned sp_ = 0;
                while (__hip_atomic_load(cnt + u.tix, __ATOMIC_RELAXED, __HIP_MEMORY_SCOPE_AGENT) < (unsigned)(u.np - 1)) { __builtin_amdgcn_s_sleep(2); if (++sp_ > (1u << 22)) break; }
                __builtin_amdgcn_fence(__ATOMIC_ACQUIRE, "agent"); asm volatile("s_waitcnt vmcnt(0)" ::: "memory"); }
            __syncthreads();
            sl = (const f32x4*)sb + tid;
        }
        const int pm = u.pm;
        const int ci = pm < 16 ? 4 : ((pm - 16) >> 3);
        const float* gt = gate_base + ci * 6144;
        const int row0 = pm * BM + wr * 64 + fr, col0 = u.pn * BM + wc * 32 + 8 * fq;
#pragma unroll
        for (int bj = 0; bj < 2; ++bj) { const f32x4 gq0 = *(const f32x4*)(gt + col0 + bj * HALF), gq1 = *(const f32x4*)(gt + col0 + bj * HALF + 4);
#pragma unroll
            for (int ai = 0; ai < 2; ++ai) {
#pragma unroll
                for (int m = 0; m < 4; ++m) { f32x4 a0 = acc[ai][bj][m][0], a1 = acc[ai][bj][m][1];
                    if (sl) { a0 += sl[(((ai * 2 + bj) * 4 + m) * 2 + 0) * 512]; a1 += sl[(((ai * 2 + bj) * 4 + m) * 2 + 1) * 512]; }
                    a0 = a0 * gq0; a1 = a1 * gq1;
                    u32x4 w; w.x = cvt_pk_bf16(a0[0], a0[1]); w.y = cvt_pk_bf16(a0[2], a0[3]); w.z = cvt_pk_bf16(a1[0], a1[1]); w.w = cvt_pk_bf16(a1[2], a1[3]);
                    *(u32x4*)(dout + (size_t)(row0 + ai * HALF + m * 16) * 2048 + col0 + bj * HALF) = w; }
                asm volatile("" ::: "memory"); } }
    }
};

template <class Epi, class Sched, bool ALIGN_EPI = false, bool SP2 = false>
__device__ __forceinline__ void gemm_phase(PG8_LAS unsigned char* lds, const Gemm g, const Sched& S, const Epi& E) {
    const int tid = pg8_otid(), wid = __builtin_amdgcn_readfirstlane(tid >> 6), lane = tid & 63, wr = wid >> 2, wc = wid & 3, fr = lane & 15, fq = lane >> 4;
    const int K = g.K, nt = K / BK;
    unsigned voffA[2], voffB[2];
#pragma unroll
    for (int i = 0; i < 2; ++i) { int R, C; stage_rc(tid * 16 + i * 8192, R, C); const int Rb = Epi::PERM ? ((R & ~31) + perm32(R & 31)) : R;
        voffA[i] = (unsigned)(R * K + C) * 2u; voffB[i] = (unsigned)(Rb * K + C) * 2u; }
    const size_t kstep = (size_t)(BK * 2);
    const size_t hstep = (size_t)HALF * K * 2;
    const size_t tstep = 2 * hstep;
    const unsigned ldsw = (unsigned)wid * 1024u;
    const int aoff = lds_byte(wr * 64 + fr, fq * 8), boff = lds_byte(wc * 32 + fr, fq * 8);
#define PG8_SA(b, h) (((b) * 2 + (h)) * HTB)
#define PG8_SB(b, h) ((4 + (b) * 2 + (h)) * HTB)
#define PG8_STAGE(bufoff, gbase, voff) do { _Pragma("unroll") for (int _i = 0; _i < 2; ++_i) \
        __builtin_amdgcn_global_load_lds((const unsigned*)((const char*)(gbase) + (voff)[_i]), (PG8_LAS unsigned*)(lds + (bufoff) + ldsw + _i * 8192), 16, 0, 0); } while (0)
#define PG8_LDA(dst, b, h) do { _Pragma("unroll") for (int m = 0; m < 4; ++m) _Pragma("unroll") for (int k = 0; k < 2; ++k) dst[m][k] = *(const PG8_LAS bf16x8*)(lds + PG8_SA(b, h) + aoff + m * 2048 + k * 1024); } while (0)
#define PG8_LDB(dst, b, h) do { _Pragma("unroll") for (int n = 0; n < 2; ++n) _Pragma("unroll") for (int k = 0; k < 2; ++k) dst[n][k] = *(const PG8_LAS bf16x8*)(lds + PG8_SB(b, h) + boff + n * 2048 + k * 1024); } while (0)
#define PG8_MMA(ai, bj, At, Bt) do { __builtin_amdgcn_s_setprio(1); _Pragma("unroll") for (int m = 0; m < 4; ++m) _Pragma("unroll") for (int n = 0; n < 2; ++n) _Pragma("unroll") for (int k = 0; k < 2; ++k) \
        acc[ai][bj][m][n] = __builtin_amdgcn_mfma_f32_16x16x32_bf16(Bt[n][k], At[m][k], acc[ai][bj][m][n], 0, 0, 0); __builtin_amdgcn_s_setprio(0); } while (0)
#define PG8_WAIT_V(n) asm volatile("s_waitcnt vmcnt(" #n ")" ::: "memory")
#define PG8_WAIT_L(n) asm volatile("s_waitcnt lgkmcnt(" #n ")" ::: "memory")
#define PG8_BAR __builtin_amdgcn_s_barrier()
#define PG8_SCHED __builtin_amdgcn_sched_barrier(0)
    Unit cur, nxt; int ui = 0;
    if (!S.next(0, cur)) return;
    f32x4 acc[2][2][4][2];
#pragma unroll
    for (int a = 0; a < 2; ++a)
#pragma unroll
        for (int b = 0; b < 2; ++b)
#pragma unroll
            for (int m = 0; m < 4; ++m)
#pragma unroll
                for (int n = 0; n < 2; ++n) acc[a][b][m][n] = (f32x4){0.f, 0.f, 0.f, 0.f};
    bf16x8 At[4][2], B0[2][2], B1[2][2];
    const char* cA = (const char*)g.A + (size_t)cur.pm * tstep + (size_t)cur.kp * (K / cur.np) * 2; const char* cB = (const char*)g.Bt + (size_t)cur.pn * tstep + (size_t)cur.kp * (K / cur.np) * 2;
    S.a_ready(cur);
    if constexpr (SP2) {
        PG8_STAGE(PG8_SB(0, 0), cB, voffB); PG8_STAGE(PG8_SB(0, 1), cB + hstep, voffB); PG8_STAGE(PG8_SA(0, 0), cA, voffA); PG8_STAGE(PG8_SA(0, 1), cA + hstep, voffA);
        if (wr == 1) PG8_BAR;
        PG8_WAIT_V(2); PG8_BAR;
        PG8_STAGE(PG8_SB(1, 0), cB + kstep, voffB); PG8_STAGE(PG8_SA(1, 0), cA + kstep, voffA); PG8_STAGE(PG8_SB(1, 1), cB + hstep + kstep, voffB);
        PG8_WAIT_V(6); PG8_BAR;
    } else {
        PG8_STAGE(PG8_SB(0, 0), cB, voffB); PG8_STAGE(PG8_SA(0, 0), cA, voffA); PG8_STAGE(PG8_SB(0, 1), cB + hstep, voffB); PG8_STAGE(PG8_SA(0, 1), cA + hstep, voffA);
        if (wr == 1) PG8_BAR;
        PG8_WAIT_V(4); PG8_BAR;
        PG8_STAGE(PG8_SB(1, 0), cB + kstep, voffB); PG8_STAGE(PG8_SA(1, 0), cA + kstep, voffA); PG8_STAGE(PG8_SB(1, 1), cB + hstep + kstep, voffB);
        PG8_WAIT_V(6); PG8_BAR;
    }
    for (;;) {
        const bool has_next = S.next(ui + 1, nxt);
        const size_t nko = has_next ? (size_t)nxt.kp * (K / nxt.np) * 2 : 0; const char* nA = has_next ? (const char*)g.A + (size_t)nxt.pm * tstep + nko : cA; const char* nB = has_next ? (const char*)g.Bt + (size_t)nxt.pn * tstep + nko : cB;
        const int ntc = nt / cur.np;
        for (int t = 0; t < ntc; t += 2) {
            const bool last = (t == ntc - 2);
            const char* a1 = cA + (size_t)(t + 1) * kstep;
            const char* a2 = last ? nA : cA + (size_t)(t + 2) * kstep; const char* b2 = last ? nB : cB + (size_t)(t + 2) * kstep;
            const char* a3 = a2 + kstep; const char* b3 = b2 + kstep;
            if (last && has_next) S.a_ready(nxt);
            if constexpr (SP2) {
            PG8_LDB(B0, 0, 0); PG8_LDB(B1, 0, 1); PG8_SCHED; PG8_LDA(At, 0, 0); PG8_STAGE(PG8_SA(1, 1), a1 + hstep, voffA);
            PG8_WAIT_V(8); PG8_WAIT_L(0); PG8_BAR; PG8_MMA(0, 0, At, B0); PG8_MMA(0, 1, At, B1); PG8_BAR; PG8_SCHED;
            PG8_LDA(At, 0, 1); PG8_STAGE(PG8_SB(0, 0), b2, voffB); PG8_STAGE(PG8_SB(0, 1), b2 + hstep, voffB); PG8_STAGE(PG8_SA(0, 0), a2, voffA);
            PG8_WAIT_V(8); PG8_WAIT_L(0); PG8_BAR; PG8_MMA(1, 0, At, B0); PG8_MMA(1, 1, At, B1); PG8_BAR; PG8_SCHED;
            PG8_LDB(B0, 1, 0); PG8_LDB(B1, 1, 1); PG8_SCHED; PG8_LDA(At, 1, 0); PG8_STAGE(PG8_SA(0, 1), a2 + hstep, voffA);
            PG8_WAIT_V(8); PG8_WAIT_L(0); PG8_BAR; PG8_MMA(0, 0, At, B0); PG8_MMA(0, 1, At, B1); PG8_BAR; PG8_SCHED;
            PG8_LDA(At, 1, 1); PG8_STAGE(PG8_SB(1, 0), b3, voffB); PG8_STAGE(PG8_SB(1, 1), b3 + hstep, voffB); PG8_STAGE(PG8_SA(1, 0), a3, voffA);
            PG8_WAIT_V(8); PG8_WAIT_L(0); PG8_BAR; PG8_MMA(1, 0, At, B0); PG8_MMA(1, 1, At, B1); PG8_BAR; PG8_SCHED;
            } else {
            PG8_LDB(B0, 0, 0); PG8_SCHED; PG8_LDA(At, 0, 0); PG8_STAGE(PG8_SA(1, 1), a1 + hstep, voffA);
            PG8_WAIT_L(8); PG8_BAR; PG8_WAIT_L(0); PG8_MMA(0, 0, At, B0); PG8_BAR; PG8_SCHED;
            PG8_LDB(B1, 0, 1); PG8_STAGE(PG8_SB(0, 0), b2, voffB);
            PG8_BAR; PG8_WAIT_L(0); PG8_MMA(0, 1, At, B1); PG8_BAR;
            PG8_LDA(At, 0, 1); PG8_STAGE(PG8_SA(0, 0), a2, voffA);
            PG8_BAR; PG8_WAIT_L(0); PG8_MMA(1, 0, At, B0); PG8_BAR; PG8_SCHED;
            PG8_STAGE(PG8_SB(0, 1), b2 + hstep, voffB);
            PG8_WAIT_V(6); PG8_BAR; PG8_MMA(1, 1, At, B1); PG8_BAR;
            PG8_LDB(B0, 1, 0); PG8_SCHED; PG8_LDA(At, 1, 0); PG8_STAGE(PG8_SA(0, 1), a2 + hstep, voffA);
            PG8_WAIT_L(8); PG8_BAR; PG8_WAIT_L(0); PG8_MMA(0, 0, At, B0); PG8_BAR; PG8_SCHED;
            PG8_LDB(B1, 1, 1); PG8_STAGE(PG8_SB(1, 0), b3, voffB);
            PG8_BAR; PG8_WAIT_L(0); PG8_MMA(0, 1, At, B1); PG8_BAR;
            PG8_LDA(At, 1, 1); PG8_STAGE(PG8_SA(1, 0), a3, voffA);
            PG8_BAR; PG8_WAIT_L(0); PG8_MMA(1, 0, At, B0); PG8_BAR; PG8_SCHED;
            PG8_STAGE(PG8_SB(1, 1), b3 + hstep, voffB);
            PG8_WAIT_V(6); PG8_BAR; PG8_MMA(1, 1, At, B1); PG8_BAR;
            }
        }
        if constexpr (ALIGN_EPI) { if (wr == 0) PG8_BAR; }
        if constexpr (!Epi::AFTER_DRAIN) { E(acc, cur, wr, wc, fr, fq); S.done(cur); }
        if (!has_next) break;
#pragma unroll
        for (int a = 0; a < 2; ++a)
#pragma unroll
            for (int b = 0; b < 2; ++b)
#pragma unroll
                for (int m = 0; m < 4; ++m)
#pragma unroll
                    for (int n = 0; n < 2; ++n) acc[a][b][m][n] = (f32x4){0.f, 0.f, 0.f, 0.f};
        cur = nxt; cA = nA; cB = nB; ++ui;
        if constexpr (ALIGN_EPI) { if (wr == 1) PG8_BAR; }
    }
    PG8_WAIT_V(0);
    if constexpr (!ALIGN_EPI) { if (wr == 0) PG8_BAR; }
    PG8_BAR;
    if constexpr (Epi::AFTER_DRAIN) { E.fused(acc, cur, wr, wc, fr, fq, lds, wid, lane); S.done(cur); }
#undef PG8_SA
#undef PG8_SB
#undef PG8_STAGE
#undef PG8_LDA
#undef PG8_LDB
#undef PG8_MMA
#undef PG8_WAIT_V
#undef PG8_WAIT_L
#undef PG8_BAR
#undef PG8_SCHED
}
}

#define LAS __attribute__((address_space(3)))
typedef unsigned short bf16_t;
typedef short bf16x8 __attribute__((ext_vector_type(8)));
typedef short s16x4 __attribute__((ext_vector_type(4)));
typedef float f32x4 __attribute__((ext_vector_type(4)));
typedef float f32x16 __attribute__((ext_vector_type(16)));
typedef unsigned u32x4 __attribute__((ext_vector_type(4)));
typedef unsigned u32x2 __attribute__((ext_vector_type(2)));


__device__ __forceinline__ int otid() { int t = threadIdx.x; asm volatile("" : "+v"(t)); return t; }
__device__ __forceinline__ unsigned ozero() { unsigned z = 0u; asm volatile("" : "+v"(z)); return z; }
__device__ __forceinline__ int obid() { int b = blockIdx.x; asm volatile("" : "+s"(b)); return b; }
constexpr int NWAVES = 8, NTHR = 512;
constexpr int DM = 2048, MC = 4096, ML = 8192, MROWS = 12288, MKROWS = 13312;
constexpr int LDP_AB = 7168, LDP_C = 5120;
constexpr int COL_QL = 0, COL_KVL = 512, COL_AG = 768, COL_BQ = 1792, COL_FF = 2816, COL_FB = 3840, COL_BI = 4864, COL_BG = 5888, COL_KPE = 6912;
constexpr float EPSN = 1e-6f;
constexpr float LOG2E = 1.4426950408889634f;
constexpr float QSC_A = 0.07216878364870322f * LOG2E;
constexpr float QSC_C = 0.08838834764831845f * LOG2E;

constexpr size_t O_YP = 0, O_YS = 8388608, O_CKV = 25165824, O_KPE = 27262976, O_SF = 27787264, O_SB = 31981568, O_KC = 36175872, O_VC = 40370176;

constexpr size_t MiB = 1u << 20;
constexpr size_t WS_CTL = 0, CTL_BYTES = 131072;
constexpr size_t WS_MOD = 1 * MiB, WS_LB = WS_MOD + 512 * 1024, WS_ROPEA = WS_LB + 64 * 1024, WS_ROPEC = WS_ROPEA + 512 * 1024;
constexpr size_t WS_KCC = 532 * MiB;
constexpr size_t WS_WINAB = 8 * MiB, WS_WQUP = 64 * MiB, WS_WKVUP = 67 * MiB, WS_WOUTAB = 69 * MiB, WS_WINC = 85 * MiB, WS_WOUTC = 125 * MiB;
constexpr size_t WS_H = 141 * MiB, WS_PROJ = 189 * MiB, WS_QRAW = 357 * MiB, WS_KVRAW = 393 * MiB, WS_KF = 445 * MiB, WS_OF = 484 * MiB, WS_OB = 508 * MiB;
constexpr size_t WS_QN = WS_H, WS_CKV = WS_H + 12 * MiB, WS_END = 552 * MiB;
constexpr size_t WS_SBUF = 4 * MiB;
constexpr int NBG = 64;

constexpr int LDS_PHASE = 131072, LDS_BYTES = LDS_PHASE + 1024;

__device__ __forceinline__ float bf2f(unsigned short b) { return __uint_as_float((unsigned)b << 16); }
typedef float f32x2_t __attribute__((ext_vector_type(2)));
typedef __bf16 bf16x2_t __attribute__((ext_vector_type(2)));
__device__ __forceinline__ unsigned pk2(float lo, float hi) { const f32x2_t v = {lo, hi}; const bf16x2_t b = __builtin_convertvector(v, bf16x2_t); return __builtin_bit_cast(unsigned, b); }
__device__ __forceinline__ unsigned f2bf(float f) { return pk2(f, 0.f) & 0xffffu; }
__device__ __forceinline__ float silu_f(float x) { return x * __builtin_amdgcn_rcpf(1.f + __expf(-x)); }
__device__ __forceinline__ float wave_sum(float v) {
#pragma unroll
    for (int o = 1; o < 64; o <<= 1) v += __shfl_xor(v, o);
    return v;
}
__device__ __forceinline__ float sum16(float v) {
    v += __shfl_xor(v, 1); v += __shfl_xor(v, 2); v += __shfl_xor(v, 4); v += __shfl_xor(v, 8); return v;
}
__device__ __forceinline__ bf16x8 pack8(const float* v) {
    u32x4 w; w.x = pk2(v[0], v[1]); w.y = pk2(v[2], v[3]); w.z = pk2(v[4], v[5]); w.w = pk2(v[6], v[7]); return __builtin_bit_cast(bf16x8, w);
}

struct Args { const float* in[31]; float* out; unsigned char* ws; };
typedef const Args __attribute__((address_space(4)))* KArgs;

struct P0Item { const float* W; bf16_t* WT; int K, N, k0, n0, d0; };
__device__ __forceinline__ void p0_load(const P0Item& q, float (&v)[32], int lane) {
#pragma unroll
    for (int i = 0; i < 32; ++i) { const int kk = 2 * i + (lane >> 5); v[i] = q.W[(size_t)(q.k0 + kk) * q.N + q.n0 + (lane & 31)]; }
}
__device__ __forceinline__ void p0_emit(const P0Item& q, const float (&v)[32], LAS float* scr, int lane) {
#pragma unroll
    for (int i = 0; i < 32; ++i) { const int kk = 2 * i + (lane >> 5); scr[kk * 33 + (lane & 31)] = v[i]; }
    asm volatile("s_waitcnt lgkmcnt(0)" ::: "memory");
    const int c = lane & 7;
#pragma unroll
    for (int j = 0; j < 4; ++j) { const int n = (lane >> 3) + 8 * j; const LAS float* s = scr + (8 * c) * 33 + n;
        u32x4 o; o.x = pk2(s[0 * 33], s[1 * 33]); o.y = pk2(s[2 * 33], s[3 * 33]); o.z = pk2(s[4 * 33], s[5 * 33]); o.w = pk2(s[6 * 33], s[7 * 33]);
        *(u32x4*)(q.WT + (size_t)(q.d0 + n) * q.K + q.k0 + 8 * c) = o; }
    asm volatile("s_waitcnt lgkmcnt(0)" ::: "memory");
}
__device__ __forceinline__ P0Item p0_decode(KArgs a, int it) {
    constexpr int I_INAB = 32 * 218, I_QUP = 8 * 48, I_KVUP = 4 * 64, I_OUT = 32 * 64, I_INC = 32 * 160;
    constexpr int PER_J = I_INAB + I_QUP + I_KVUP + I_OUT + I_INC + I_OUT;
    unsigned char* ws = a->ws; P0Item q;
    const int j = it / PER_J; int r = it % PER_J;
    if (r < I_INAB) { const int kb = r / 218, nb = r % 218, n0 = nb * 32;
        q.W = a->in[13] + (size_t)j * 2048 * 6976; q.WT = (bf16_t*)(ws + WS_WINAB) + (size_t)j * 7168 * 2048; q.K = 2048; q.N = 6976; q.k0 = kb * 64; q.n0 = n0; q.d0 = n0 < 768 ? n0 : (n0 < 832 ? n0 + 6144 : n0 - 64); return q; }
    r -= I_INAB;
    if (r < I_QUP) { const int kb = r / 48, nb = r % 48;
        q.W = a->in[16] + (size_t)j * 512 * 1536; q.WT = (bf16_t*)(ws + WS_WQUP) + (size_t)j * 1536 * 512; q.K = 512; q.N = 1536; q.k0 = kb * 64; q.n0 = nb * 32; q.d0 = nb * 32; return q; }
    r -= I_QUP;
    if (r < I_KVUP) { const int kb = r / 64, nb = r % 64;
        q.W = a->in[17] + (size_t)j * 256 * 2048; q.WT = (bf16_t*)(ws + WS_WKVUP) + (size_t)j * 2048 * 256; q.K = 256; q.N = 2048; q.k0 = kb * 64; q.n0 = nb * 32; q.d0 = nb * 32; return q; }
    r -= I_KVUP;
    if (r < I_OUT) { const int kb = r / 64, nb = r % 64;
        q.W = a->in[22] + (size_t)j * 2048 * 2048; q.WT = (bf16_t*)(ws + WS_WOUTAB) + (size_t)j * 2048 * 2048; q.K = 2048; q.N = 2048; q.k0 = kb * 64; q.n0 = nb * 32; q.d0 = nb * 32; return q; }
    r -= I_OUT;
    if (r < I_INC) { const int kb = r / 160, nb = r % 160;
        q.W = a->in[26] + (size_t)j * 2048 * 5120; q.WT = (bf16_t*)(ws + WS_WINC) + (size_t)j * 5120 * 2048; q.K = 2048; q.N = 5120; q.k0 = kb * 64; q.n0 = nb * 32; q.d0 = nb * 32; return q; }
    r -= I_INC;
    { const int kb = r / 64, nb = r % 64;
        q.W = a->in[30] + (size_t)j * 2048 * 2048; q.WT = (bf16_t*)(ws + WS_WOUTC) + (size_t)j * 2048 * 2048; q.K = 2048; q.N = 2048; q.k0 = kb * 64; q.n0 = nb * 32; q.d0 = nb * 32; return q; }
}

__device__ __forceinline__ void phase_p0(KArgs a, LAS unsigned char* lds) {
    const int tid = otid(), lane = tid & 63, wave = tid >> 6;
    const int G = gridDim.x, bid = obid();
    const int gw = bid * NWAVES + wave, NGW = G * NWAVES;
    unsigned char* ws = a->ws;
    {
        LAS float* scr = (LAS float*)(lds + wave * 8448);
        constexpr int TOTAL = 2 * (32 * 218 + 8 * 48 + 4 * 64 + 32 * 64 + 32 * 160 + 32 * 64);
        for (int it = gw; it < TOTAL; it += 2 * NGW) {
            const bool two = it + NGW < TOTAL;
            const P0Item qa = p0_decode(a, it); const P0Item qb = p0_decode(a, two ? it + NGW : it);
            float va[32], vb[32];
            p0_load(qa, va, lane); if (two) p0_load(qb, vb, lane);
            p0_emit(qa, va, scr, lane); if (two) p0_emit(qb, vb, scr, lane);
        }
    }
    const int gt = bid * NTHR + tid, NGT = G * NTHR;
    const unsigned zz = ozero();
    for (int i = gt; i < 2 * 192 * 256; i += NGT) { const int j = i / (192 * 256), r = i % (192 * 256);
        *(u32x4*)((bf16_t*)(ws + WS_WINAB) + (size_t)j * 7168 * 2048 + (size_t)6976 * 2048 + (size_t)r * 8) = (u32x4){zz, zz, zz, zz}; }
    for (int i = gt; i < 2 * 131072; i += NGT) { const int which = i / 131072, e = (i % 131072) * 8;
        const float* src = a->in[6 + which] + e; const f32x4 x0 = *(const f32x4*)src, x1 = *(const f32x4*)(src + 4);
        u32x4 w; w.x = pk2(x0[0], x0[1]); w.y = pk2(x0[2], x0[3]); w.z = pk2(x1[0], x1[1]); w.w = pk2(x1[2], x1[3]);
        *(u32x4*)((bf16_t*)(ws + WS_KCC) + (size_t)(e >> 9) * LDP_C + (which ? 512 : 0) + (e & 511)) = w; }
    for (int i = gt; i < 2 * 2048; i += NGT) { const int j = i / 2048, r = i % 2048; const float l0 = a->in[20][r], l1 = a->in[20][2048 + r];
        ((float*)(ws + WS_LB))[i] = j == 0 ? 0.f : 1.f / (1.f + __expf(l0 - l1)); }
    for (int i = gt; i < 2048 * 32; i += NGT) { const int t = i >> 5, f = i & 31; const float pos = f < 16 ? (float)(t >> 6) : (float)(t & 63);
        const float inv = exp2f(-(float)(f & 15) * (13.287712379549449f / 16.f)); const float ang = pos * inv;
        ((float*)(ws + WS_ROPEA))[2 * i] = __cosf(ang); ((float*)(ws + WS_ROPEA))[2 * i + 1] = __sinf(ang); }
    for (int i = gt; i < 2048 * 64; i += NGT) { const int t = i >> 6, f = i & 63; const float pos = f < 32 ? (float)(t >> 6) : (float)(t & 63);
        const float inv = exp2f(-(float)(f & 31) * (13.287712379549449f / 32.f)); const float ang = pos * inv;
        ((float*)(ws + WS_ROPEC))[2 * i] = __cosf(ang); ((float*)(ws + WS_ROPEC))[2 * i + 1] = __sinf(ang); }
    __syncthreads();
    {
        LAS float* SC = (LAS float*)lds;
        LAS float* RED = (LAS float*)(lds + 40960);
        for (int i = tid; i < 5 * 2048; i += NTHR) { const int b = i >> 11, k = i & 2047; const float x = b < 4 ? a->in[8][b * 2048 + k] : a->in[9][k]; SC[i] = silu_f(x); }
        __syncthreads();
        const int cq = tid & 7, ks = tid >> 3;
        for (int u = bid; u < 768; u += G) {
            const int L = u / 192, col0 = (u % 192) * 32;
            const float* W = ((L & 1) ? a->in[23] : a->in[10]) + (size_t)(L >> 1) * 2048 * 6144;
            const float* bias = ((L & 1) ? a->in[24] : a->in[11]) + (size_t)(L >> 1) * 6144;
            f32x4 acc[5];
#pragma unroll
            for (int b = 0; b < 5; ++b) acc[b] = (f32x4){0.f, 0.f, 0.f, 0.f};
#pragma unroll 16
            for (int kk = 0; kk < 32; ++kk) { const int k = 32 * ks + kk; const f32x4 w = *(const f32x4*)(W + (size_t)k * 6144 + col0 + 4 * cq);
#pragma unroll
                for (int b = 0; b < 5; ++b) acc[b] += SC[b * 2048 + k] * w; }
#pragma unroll
            for (int b = 0; b < 5; ++b) *(LAS f32x4*)(RED + (ks * 5 + b) * 32 + 4 * cq) = acc[b];
            __syncthreads();
            if (tid < 160) { const int b = tid >> 5, c = tid & 31; float s = 0.f;
                for (int q = 0; q < 64; ++q) s += RED[(q * 5 + b) * 32 + c];
                ((float*)(ws + WS_MOD))[(L * 5 + b) * 6144 + col0 + c] = s + bias[col0 + c]; }
            __syncthreads();
        }
    }
}

__device__ __forceinline__ void phase_modnorm(KArgs a, int L) {
    const int tid = otid(), lane = tid & 63, wave = tid >> 6;
    const int gw = obid() * NWAVES + wave, NGW = gridDim.x * NWAVES;
    const float* g = ((L & 1) ? a->in[25] : a->in[12]) + (L >> 1) * 2048;
    bf16_t* H = (bf16_t*)(a->ws + WS_H);
    for (int r0 = gw * 2; r0 < MROWS; r0 += NGW * 2) {
        f32x4 v[2][8]; float ss[2] = {0.f, 0.f};
#pragma unroll
        for (int u = 0; u < 2; ++u) { const int r = r0 + u;
            const float* x = L <= 1 ? (r < MC ? a->in[0] + (size_t)r * DM : a->in[1] + (size_t)(r - MC) * DM) : a->out + (size_t)r * DM;
#pragma unroll
            for (int j = 0; j < 8; ++j) v[u][j] = *(const f32x4*)(x + 256 * j + 4 * lane);
            if (L > 0) { const bf16_t* dp = (const bf16_t*)(a->ws + WS_PROJ) + (size_t)r * DM;
#pragma unroll
                for (int j = 0; j < 8; ++j) { const u32x2 dv = *(const u32x2*)(dp + 256 * j + 4 * lane);
                    v[u][j][0] += __uint_as_float(dv.x << 16); v[u][j][1] += __uint_as_float(dv.x & 0xffff0000u); v[u][j][2] += __uint_as_float(dv.y << 16); v[u][j][3] += __uint_as_float(dv.y & 0xffff0000u);
                    *(f32x4*)(a->out + (size_t)r * DM + 256 * j + 4 * lane) = v[u][j]; } } }
#pragma unroll
        for (int u = 0; u < 2; ++u) {
#pragma unroll
            for (int j = 0; j < 8; ++j) ss[u] += (v[u][j][0] * v[u][j][0] + v[u][j][1] * v[u][j][1]) + (v[u][j][2] * v[u][j][2] + v[u][j][3] * v[u][j][3]); }
#pragma unroll
        for (int u = 0; u < 2; ++u) { const int r = r0 + u;
            const int ci = r < MC ? 4 : ((r - MC) >> 11);
            const float* md = (const float*)(a->ws + WS_MOD) + (L * 5 + ci) * 6144;
            const float rstd = rsqrtf(wave_sum(ss[u]) * (1.f / 2048.f) + EPSN);
#pragma unroll
            for (int j = 0; j < 8; ++j) { const int c = 256 * j + 4 * lane;
                const f32x4 gg = *(const f32x4*)(g + c), sh = *(const f32x4*)(md + c), sc = *(const f32x4*)(md + 2048 + c);
                const f32x4 y = (v[u][j] * rstd * gg) * (sc + 1.f) + sh;
                u32x2 w; w.x = pk2(y[0], y[1]); w.y = pk2(y[2], y[3]);
                *(u32x2*)(H + (size_t)r * DM + c) = w; } }
    }
}

__device__ __forceinline__ void phase_final(KArgs a) {
    const int tid = otid();
    const int gt = obid() * NTHR + tid, NGT = gridDim.x * NTHR;
    const bf16_t* D = (const bf16_t*)(a->ws + WS_PROJ); float* out = a->out;
    for (int i = gt; i < MROWS * DM / 8; i += NGT) { const size_t e = (size_t)i * 8;
        const bf16x8 dv = *(const bf16x8*)(D + e); f32x4 x0 = *(const f32x4*)(out + e), x1 = *(const f32x4*)(out + e + 4);
        x0[0] += bf2f((unsigned short)dv[0]); x0[1] += bf2f((unsigned short)dv[1]); x0[2] += bf2f((unsigned short)dv[2]); x0[3] += bf2f((unsigned short)dv[3]);
        x1[0] += bf2f((unsigned short)dv[4]); x1[1] += bf2f((unsigned short)dv[5]); x1[2] += bf2f((unsigned short)dv[6]); x1[3] += bf2f((unsigned short)dv[7]);
        *(f32x4*)(out + e) = x0; *(f32x4*)(out + e + 4) = x1; }
}

__device__ __forceinline__ void phase_prep_ab(KArgs a, int j, int wg, int nwg) {
    const int tid = otid(), lane = tid & 63, wave = tid >> 6;
    const int gw = wg * NWAVES + wave, NGW = nwg * NWAVES;
    const bf16_t* P = (const bf16_t*)(a->ws + WS_PROJ);
    bf16_t* QN = (bf16_t*)(a->ws + WS_QN); bf16_t* CKV = (bf16_t*)(a->ws + WS_CKV);
    const float* gq = a->in[14] + j * 512; const float* gkv = a->in[15] + j * 256;
    for (int r = gw; r < MKROWS; r += NGW) {
        if (r < MROWS) {
            const bf16_t* p = P + (size_t)r * LDP_AB;
            const bf16x8 q = *(const bf16x8*)(p + COL_QL + 8 * lane);
            float qv[8]; float ss = 0.f;
#pragma unroll
            for (int e = 0; e < 8; ++e) { qv[e] = bf2f((unsigned short)q[e]); ss += qv[e] * qv[e]; }
            const float rq = rsqrtf(wave_sum(ss) * (1.f / 512.f) + EPSN);
#pragma unroll
            for (int e = 0; e < 8; ++e) qv[e] = qv[e] * rq * gq[8 * lane + e];
            *(bf16x8*)(QN + (size_t)r * 512 + 8 * lane) = pack8(qv);
            const s16x4 kv = *(const s16x4*)(p + COL_KVL + 4 * lane);
            float kf[4]; float s2 = 0.f;
#pragma unroll
            for (int e = 0; e < 4; ++e) { kf[e] = bf2f((unsigned short)kv[e]); s2 += kf[e] * kf[e]; }
            const float rk = rsqrtf(wave_sum(s2) * (1.f / 256.f) + EPSN);
#pragma unroll
            for (int e = 0; e < 4; ++e) kf[e] = kf[e] * rk * gkv[4 * lane + e];
            u32x2 w; w.x = pk2(kf[0], kf[1]); w.y = pk2(kf[2], kf[3]);
            *(u32x2*)(CKV + (size_t)r * 256 + 4 * lane) = w;
            if (r < MC) { const int b = r >> 8, t = r & 255; const size_t rowo = (size_t)((b * 2 + j) * 256 + t);
                *(f32x4*)(a->out + O_CKV + rowo * 256 + 4 * lane) = (f32x4){kf[0], kf[1], kf[2], kf[3]};
                a->out[O_KPE + rowo * 64 + lane] = bf2f(p[COL_KPE + lane]); }
        } else {
            const int rr = r - MROWS, b = rr >> 8, t = rr & 255;
            const f32x4 x = *(const f32x4*)(a->in[2] + (size_t)((b * 2 + j) * 256 + t) * 256 + 4 * lane);
            u32x2 w; w.x = pk2(x[0], x[1]); w.y = pk2(x[2], x[3]);
            *(u32x2*)(CKV + (size_t)r * 256 + 4 * lane) = w;
        }
    }
}

__device__ __forceinline__ void phase_hn_ab(KArgs a, int j, int wg, int nwg) {
    const int tid = otid(), lane = tid & 63, wave = tid >> 6, sub = lane & 15, hq = lane >> 4;
    const int gw = wg * NWAVES + wave, NGW = nwg * NWAVES;
    bf16_t* Q = (bf16_t*)(a->ws + WS_QRAW); const bf16_t* KV = (const bf16_t*)(a->ws + WS_KVRAW); bf16_t* KF = (bf16_t*)(a->ws + WS_KF);
    const bf16_t* P = (const bf16_t*)(a->ws + WS_PROJ);
    const float* RA = (const float*)(a->ws + WS_ROPEA);
    const float* gq = a->in[18] + j * 192; const float* gk = a->in[19] + j * 192;
    const float* ckpe = a->in[3];
    constexpr int U = 4;
    const int NQ = 0, NIT = MKROWS * 2;
    for (int base = gw * U; base < NIT; base += NGW * U) {
        bf16x8 vn[U]; float x1[U][2], x2[U][2]; f32x4 cs[U];
#pragma unroll
        for (int u = 0; u < U; ++u) { const int it = base + u; if (it < NIT) {
            const bool isq = it < NQ; const int w = isq ? it : it - NQ; const int r = w >> 1, h = (w & 1) * 4 + hq;
            if (isq) { const bf16_t* p = Q + (size_t)r * 1536 + h * 192;
                vn[u] = *(const bf16x8*)(p + 8 * sub); const unsigned a1 = *(const unsigned*)(p + 128 + 2 * sub), a2 = *(const unsigned*)(p + 160 + 2 * sub);
                x1[u][0] = bf2f(a1 & 0xffff); x1[u][1] = bf2f(a1 >> 16); x2[u][0] = bf2f(a2 & 0xffff); x2[u][1] = bf2f(a2 >> 16);
            } else { vn[u] = *(const bf16x8*)(KV + (size_t)r * 2048 + h * 256 + 8 * sub);
                if (r < MROWS) { const bf16_t* pe = P + (size_t)r * LDP_AB + COL_KPE; const unsigned a1 = *(const unsigned*)(pe + 2 * sub), a2 = *(const unsigned*)(pe + 32 + 2 * sub);
                    x1[u][0] = bf2f(a1 & 0xffff); x1[u][1] = bf2f(a1 >> 16); x2[u][0] = bf2f(a2 & 0xffff); x2[u][1] = bf2f(a2 >> 16); }
                else { const int rr = r - MROWS, b = rr >> 8, t = rr & 255; const float* pe = ckpe + (size_t)((b * 2 + j) * 256 + t) * 64;
                    x1[u][0] = pe[2 * sub]; x1[u][1] = pe[2 * sub + 1]; x2[u][0] = pe[32 + 2 * sub]; x2[u][1] = pe[32 + 2 * sub + 1]; } }
            if (r >= MC && r < MROWS) cs[u] = *(const f32x4*)(RA + (((r - MC) & 2047) * 32 + 2 * sub) * 2);
        } }
#pragma unroll
        for (int u = 0; u < U; ++u) { const int it = base + u; if (it < NIT) {
            const bool isq = it < NQ; const int w = isq ? it : it - NQ; const int r = w >> 1, h = (w & 1) * 4 + hq;
            float xn[8];
#pragma unroll
            for (int e = 0; e < 8; ++e) xn[e] = bf2f((unsigned short)vn[u][e]);
            float ss = x1[u][0] * x1[u][0] + x1[u][1] * x1[u][1] + x2[u][0] * x2[u][0] + x2[u][1] * x2[u][1];
#pragma unroll
            for (int e = 0; e < 8; ++e) ss += xn[e] * xn[e];
            const float rstd = rsqrtf(sum16(ss) * (1.f / 192.f) + EPSN);
            const float* g = isq ? gq : gk;
#pragma unroll
            for (int e = 0; e < 8; ++e) xn[e] = xn[e] * rstd * g[8 * sub + e];
            float y1[2], y2[2];
            y1[0] = x1[u][0] * rstd * g[128 + 2 * sub]; y1[1] = x1[u][1] * rstd * g[128 + 2 * sub + 1]; y2[0] = x2[u][0] * rstd * g[160 + 2 * sub]; y2[1] = x2[u][1] * rstd * g[160 + 2 * sub + 1];
            if (r >= MC && r < MROWS) {
#pragma unroll
                for (int q = 0; q < 2; ++q) { const float c = cs[u][2 * q], sn = cs[u][2 * q + 1];
                    const float z1 = y1[q] * c - y2[q] * sn, z2 = y1[q] * sn + y2[q] * c; y1[q] = z1; y2[q] = z2; } }
            bf16_t* p;
            if (isq) {
#pragma unroll
                for (int e = 0; e < 8; ++e) xn[e] *= QSC_A;
                y1[0] *= QSC_A; y1[1] *= QSC_A; y2[0] *= QSC_A; y2[1] *= QSC_A;
                p = Q + (size_t)r * 1536 + h * 192;
            } else p = KF + (size_t)r * 1536 + h * 192;
            *(bf16x8*)(p + 8 * sub) = pack8(xn); *(unsigned*)(p + 128 + 2 * sub) = pk2(y1[0], y1[1]); *(unsigned*)(p + 160 + 2 * sub) = pk2(y2[0], y2[1]);
        } }
    }
}

__device__ __forceinline__ void phase_fin_ab(KArgs a, int j) {
    const int tid = otid(), lane = tid & 63, wave = tid >> 6, sub = lane & 15, hq = lane >> 4;
    const int gw = obid() * NWAVES + wave, NGW = gridDim.x * NWAVES;
    const bf16_t* OF = (const bf16_t*)(a->ws + WS_OF); const bf16_t* OB = (const bf16_t*)(a->ws + WS_OB);
    const bf16_t* P = (const bf16_t*)(a->ws + WS_PROJ); bf16_t* MIX = (bf16_t*)(a->ws + WS_H);
    const float* g = a->in[21] + j * 128;
    constexpr int U = 4;
    for (int base = gw * U; base < MROWS * 2; base += NGW * U) {
        bf16x8 va[U], vb[U], vg[U];
#pragma unroll
        for (int u = 0; u < U; ++u) { const int it = base + u; const int r = it >> 1, h = (it & 1) * 4 + hq; const size_t o = (size_t)r * 1024 + h * 128 + 8 * sub;
            va[u] = *(const bf16x8*)(OF + o); vb[u] = *(const bf16x8*)(OB + o); vg[u] = *(const bf16x8*)(P + (size_t)r * LDP_AB + COL_BG + h * 128 + 8 * sub); }
#pragma unroll
        for (int u = 0; u < U; ++u) { const int it = base + u; const int r = it >> 1, h = (it & 1) * 4 + hq;
            float s[8]; float ss = 0.f;
#pragma unroll
            for (int e = 0; e < 8; ++e) { s[e] = bf2f((unsigned short)va[u][e]) + bf2f((unsigned short)vb[u][e]); ss += s[e] * s[e]; }
            const float rstd = rsqrtf(sum16(ss) * (1.f / 128.f) + EPSN);
#pragma unroll
            for (int e = 0; e < 8; ++e) s[e] = s[e] * rstd * g[8 * sub + e] * silu_f(bf2f((unsigned short)vg[u][e]));
            *(bf16x8*)(MIX + (size_t)r * DM + 1024 + h * 128 + 8 * sub) = pack8(s); }
    }
}

__device__ __forceinline__ void phase_hn_c(KArgs a, int j) {
    const int tid = otid(), lane = tid & 63, wave = tid >> 6, sub = lane & 15, hq = lane >> 4;
    const int gw = obid() * NWAVES + wave, NGW = gridDim.x * NWAVES;
    bf16_t* P = (bf16_t*)(a->ws + WS_PROJ);
    const float* RC = (const float*)(a->ws + WS_ROPEC);
    const float* gq = a->in[27] + j * 128; const float* gk = a->in[28] + j * 128;
    float* outp = a->out;
    for (int r = gw; r < MC; r += NGW) { const int b = r >> 8, t = r & 255; const bf16x8 v = *(const bf16x8*)(P + (size_t)r * LDP_C + 2560 + 8 * lane);
        float* o = outp + O_VC + (size_t)((b * 2 + j) * 256 + t) * 512 + 8 * lane;
        *(f32x4*)o = (f32x4){bf2f((unsigned short)v[0]), bf2f((unsigned short)v[1]), bf2f((unsigned short)v[2]), bf2f((unsigned short)v[3])};
        *(f32x4*)(o + 4) = (f32x4){bf2f((unsigned short)v[4]), bf2f((unsigned short)v[5]), bf2f((unsigned short)v[6]), bf2f((unsigned short)v[7])}; }
    constexpr int U = 4;
    const int NIT = MROWS;
    for (int base = gw * U; base < NIT; base += NGW * U) {
        s16x4 v1[U], v2[U]; f32x4 ca[U], cb[U];
#pragma unroll
        for (int u = 0; u < U; ++u) { const int it = base + u; if (it < NIT) {
            const int r = it, h = 16 + hq; const bool isq = false;
            const bf16_t* p = P + (size_t)r * LDP_C + (isq ? h * 128 : 2048 + (h - 16) * 128);
            v1[u] = *(const s16x4*)(p + 4 * sub); v2[u] = *(const s16x4*)(p + 64 + 4 * sub);
            if (r >= MC) { const float* rc = RC + (((r - MC) & 2047) * 64 + 4 * sub) * 2; ca[u] = *(const f32x4*)rc; cb[u] = *(const f32x4*)(rc + 4); }
        } }
#pragma unroll
        for (int u = 0; u < U; ++u) { const int it = base + u; if (it < NIT) {
            const int r = it, h = 16 + hq; const bool isq = false;
            bf16_t* p = P + (size_t)r * LDP_C + (isq ? h * 128 : 2048 + (h - 16) * 128);
            float x1[4], x2[4]; float ss = 0.f;
#pragma unroll
            for (int e = 0; e < 4; ++e) { x1[e] = bf2f((unsigned short)v1[u][e]); x2[e] = bf2f((unsigned short)v2[u][e]); ss += x1[e] * x1[e] + x2[e] * x2[e]; }
            const float rstd = rsqrtf(sum16(ss) * (1.f / 128.f) + EPSN);
            const float* g = isq ? gq : gk;
#pragma unroll
            for (int e = 0; e < 4; ++e) { x1[e] *= rstd * g[4 * sub + e]; x2[e] *= rstd * g[64 + 4 * sub + e]; }
            if (r >= MC) {
#pragma unroll
                for (int e = 0; e < 4; ++e) { const float c = e < 2 ? ca[u][2 * e] : cb[u][2 * (e - 2)], sn = e < 2 ? ca[u][2 * e + 1] : cb[u][2 * (e - 2) + 1];
                    const float y1 = x1[e] * c - x2[e] * sn, y2 = x1[e] * sn + x2[e] * c; x1[e] = y1; x2[e] = y2; } }
            else if (!isq) { const int b = r >> 8, t = r & 255; float* o = outp + O_KC + (size_t)((b * 2 + j) * 256 + t) * 512 + (h - 16) * 128;
                *(f32x4*)(o + 4 * sub) = (f32x4){x1[0], x1[1], x1[2], x1[3]}; *(f32x4*)(o + 64 + 4 * sub) = (f32x4){x2[0], x2[1], x2[2], x2[3]}; }
            if (isq) {
#pragma unroll
                for (int e = 0; e < 4; ++e) { x1[e] *= QSC_C; x2[e] *= QSC_C; } }
            u32x2 w1, w2; w1.x = pk2(x1[0], x1[1]); w1.y = pk2(x1[2], x1[3]); w2.x = pk2(x2[0], x2[1]); w2.y = pk2(x2[2], x2[3]);
            *(u32x2*)(p + 4 * sub) = w1; *(u32x2*)(p + 64 + 4 * sub) = w2;
        } }
    }
}

namespace att {
__device__ __forceinline__ int crow(int r, int hi) { return (r & 3) + 8 * (r >> 2) + 4 * hi; }
__device__ __forceinline__ unsigned cvtpk(float lo, float hi) { return pk2(lo, hi); }
__device__ __forceinline__ int v_st(int k, int c) { const int kk = (k & ~0xC) | ((k & 4) << 1) | ((k & 8) >> 1); return ((kk >> 3) * 4 + (c >> 5)) * 512 + ((kk & 7) * 32 + (c & 31)) * 2; }
__device__ __forceinline__ int v_rd_base(int lane) { return ((lane & 3) << 3) | (((lane >> 2) & 3) << 6) | (((lane >> 4) & 1) << 5) | (((lane >> 5) & 1) << 8); }
constexpr int v_rd_off(int d0, int ks, int half) { return d0 * 512 + ks * 4096 + half * 2048; }
template <int OFF> __device__ __forceinline__ s16x4 tr_read(int vb) {
    s16x4 r; asm volatile("ds_read_b64_tr_b16 %0, %1 offset:%2" : "=&v"(r) : "v"(vb), "i"(OFF) : "memory"); return r;
}
template <int D0> __device__ __forceinline__ void pv_read8(s16x4 (&r)[8], int vb) {
    r[0] = tr_read<v_rd_off(D0, 0, 0)>(vb); r[1] = tr_read<v_rd_off(D0, 0, 1)>(vb); r[2] = tr_read<v_rd_off(D0, 1, 0)>(vb); r[3] = tr_read<v_rd_off(D0, 1, 1)>(vb);
    r[4] = tr_read<v_rd_off(D0, 2, 0)>(vb); r[5] = tr_read<v_rd_off(D0, 2, 1)>(vb); r[6] = tr_read<v_rd_off(D0, 3, 0)>(vb); r[7] = tr_read<v_rd_off(D0, 3, 1)>(vb);
}
__device__ __forceinline__ void pv_mma4(f32x16& od, const s16x4 (&r)[8], bf16x8 pa0, bf16x8 pa1, bf16x8 pa2, bf16x8 pa3) {
#define ATT_PK(L, H) (bf16x8){L[0], L[1], L[2], L[3], H[0], H[1], H[2], H[3]}
    od = __builtin_amdgcn_mfma_f32_32x32x16_bf16(pa0, ATT_PK(r[0], r[1]), od, 0, 0, 0);
    od = __builtin_amdgcn_mfma_f32_32x32x16_bf16(pa1, ATT_PK(r[2], r[3]), od, 0, 0, 0);
    od = __builtin_amdgcn_mfma_f32_32x32x16_bf16(pa2, ATT_PK(r[4], r[5]), od, 0, 0, 0);
    od = __builtin_amdgcn_mfma_f32_32x32x16_bf16(pa3, ATT_PK(r[6], r[7]), od, 0, 0, 0);
#undef ATT_PK
}
__device__ __forceinline__ void pv_all(f32x16 (&o)[4], int vb, bf16x8 pa0, bf16x8 pa1, bf16x8 pa2, bf16x8 pa3) {
    s16x4 ra[8], rb[8];
    pv_read8<0>(ra, vb);
    pv_read8<1>(rb, vb); asm volatile("s_waitcnt lgkmcnt(8)" ::: "memory"); __builtin_amdgcn_sched_barrier(0);
    pv_mma4(o[0], ra, pa0, pa1, pa2, pa3); __builtin_amdgcn_sched_barrier(0);
    pv_read8<2>(ra, vb); asm volatile("s_waitcnt lgkmcnt(8)" ::: "memory"); __builtin_amdgcn_sched_barrier(0);
    pv_mma4(o[1], rb, pa0, pa1, pa2, pa3); __builtin_amdgcn_sched_barrier(0);
    pv_read8<3>(rb, vb); asm volatile("s_waitcnt lgkmcnt(8)" ::: "memory"); __builtin_amdgcn_sched_barrier(0);
    pv_mma4(o[2], ra, pa0, pa1, pa2, pa3); __builtin_amdgcn_sched_barrier(0);
    asm volatile("s_waitcnt lgkmcnt(0)" ::: "memory"); __builtin_amdgcn_sched_barrier(0);
    pv_mma4(o[3], rb, pa0, pa1, pa2, pa3);
}
struct Item {
    const bf16_t* Q; int ldq;
    const bf16_t* K0; const bf16_t* V0; int n0;
    const bf16_t* K1; const bf16_t* V1; int ldk, ldv, t_lo, t_hi;
    int q0, band; float m0, l0;
    const float* qg; const float* rope; float qscale;
    const bf16_t* G; int ldg; bf16_t* O; int ldo;
};
template <int DQK>
__device__ __forceinline__ void attn_item(LAS unsigned char* lds, const Item& it) {
    constexpr int KROW = DQK * 2, SHM_K = 64 * KROW, SHM_V = 64 * 128 * 2, ND = DQK / 16;
    const int tid = otid(), wid = tid >> 6, lane = tid & 63, r32 = lane & 31, hi = lane >> 5;
    LAS unsigned char* V_lds = lds; LAS unsigned char* K_lds = lds + 3 * SHM_V;
    LAS float* wsx = (LAS float*)(lds + 3 * SHM_V + 3 * SHM_K) + wid * 64; LAS float* li_l = wsx; LAS float* al_l = wsx + 32;
    float m_reg = it.m0, l_reg = it.l0;
    f32x16 o[4];
#pragma unroll
    for (int d = 0; d < 4; ++d)
#pragma unroll
        for (int r = 0; r < 16; ++r) o[d][r] = 0.f;
    bf16x8 qr[ND];
    {
      const bf16_t* Qw = it.Q + (size_t)(wid * 32 + r32) * it.ldq + hi * 8;
      float xf[ND][8]; float ss = 0.f;
#pragma unroll
      for (int d0 = 0; d0 < ND; ++d0) { const bf16x8 v = *(const bf16x8*)(Qw + d0 * 16);
#pragma unroll
          for (int e = 0; e < 8; ++e) { xf[d0][e] = bf2f((unsigned short)v[e]); ss += xf[d0][e] * xf[d0][e]; } }
      ss += __shfl_xor(ss, 32);
      const float rstd = rsqrtf(ss * (1.f / (float)DQK) + EPSN);
#pragma unroll
      for (int d0 = 0; d0 < ND; ++d0) { const f32x4 g0 = *(const f32x4*)(it.qg + d0 * 16 + hi * 8), g1 = *(const f32x4*)(it.qg + d0 * 16 + hi * 8 + 4);
#pragma unroll
          for (int e = 0; e < 8; ++e) xf[d0][e] *= rstd * (e < 4 ? g0[e & 3] : g1[e & 3]); }
      if (it.rope) { constexpr int NR = DQK == 128 ? 4 : 2, RB = DQK == 128 ? 0 : 8, RS = DQK == 128 ? 64 : 32;
          const float* rp = it.rope + (size_t)((it.q0 + wid * 32 + r32) * RS + hi * 8) * 2;
#pragma unroll
          for (int p = 0; p < NR; ++p) { f32x4 cs4[4];
#pragma unroll
              for (int q = 0; q < 4; ++q) cs4[q] = *(const f32x4*)(rp + p * 32 + 4 * q);
#pragma unroll
              for (int e = 0; e < 8; ++e) { const float c = cs4[e >> 1][(e & 1) * 2], sn = cs4[e >> 1][(e & 1) * 2 + 1];
                  const float x1 = xf[RB + p][e], x2 = xf[RB + NR + p][e]; xf[RB + p][e] = x1 * c - x2 * sn; xf[RB + NR + p][e] = x1 * sn + x2 * c; } } }
#pragma unroll
      for (int d0 = 0; d0 < ND; ++d0) { float t8[8];
#pragma unroll
          for (int e = 0; e < 8; ++e) t8[e] = xf[d0][e] * it.qscale;
          qr[d0] = pack8(t8); } }
    const int NT = it.n0 + (it.t_hi - it.t_lo);
    const int wvu = __builtin_amdgcn_readfirstlane(wid);
    const int vb0 = (int)(uintptr_t)V_lds + v_rd_base(lane);
    constexpr int NKI = SHM_K / 8192;
    unsigned kog[NKI], vog[2];
#pragma unroll
    for (int i = 0; i < NKI; ++i) { const int off = i * 8192 + wid * 1024 + lane * 16, row = off / KROW, pos = off % KROW; kog[i] = (unsigned)(row * it.ldk + ((pos ^ ((row & 7) << 4)) >> 1)); }
#pragma unroll
    for (int i = 0; i < 2; ++i) { const int q = (i * 8192 + wid * 1024 + lane * 16) >> 4, sub = q >> 5, rem = q & 31, rowin = rem >> 2, cch = rem & 3;
        const int kk = (sub >> 2) * 8 + rowin; vog[i] = (unsigned)(((kk & ~0xC) | ((kk & 4) << 1) | ((kk & 8) >> 1)) * it.ldv + (sub & 3) * 32 + cch * 8); }
    int koff[4];
#pragma unroll
    for (int dl = 0; dl < 4; ++dl) koff[dl] = r32 * KROW + ((dl * 32 + hi * 16) ^ ((r32 & 7) << 4));
#define ATT_STAGE(jj, b) do { const int _j = (jj); const bool _s0 = _j < it.n0; const int _t = _s0 ? _j : it.t_lo + (_j - it.n0); \
        const bf16_t* _Kp = (_s0 ? it.K0 : it.K1) + (size_t)(64 * _t) * it.ldk; const bf16_t* _Vp = (_s0 ? it.V0 : it.V1) + (size_t)(64 * _t) * it.ldv; \
        _Pragma("unroll") for (int _i = 0; _i < NKI; ++_i) __builtin_amdgcn_global_load_lds((const unsigned*)(_Kp + kog[_i]), (LAS unsigned*)(K_lds + (b) * SHM_K + _i * 8192 + wvu * 1024), 16, 0, 0); \
        _Pragma("unroll") for (int _i = 0; _i < 2; ++_i) __builtin_amdgcn_global_load_lds((const unsigned*)(_Vp + vog[_i]), (LAS unsigned*)(V_lds + (b) * SHM_V + _i * 8192 + wvu * 1024), 16, 0, 0); } while (0)
#define ATT_WAIT_TILE(more) do { if (more) { if constexpr (NKI == 3) asm volatile("s_waitcnt vmcnt(5)" ::: "memory"); else asm volatile("s_waitcnt vmcnt(4)" ::: "memory"); } \
        else asm volatile("s_waitcnt vmcnt(0)" ::: "memory"); \
        asm volatile("s_waitcnt lgkmcnt(0)" ::: "memory"); __builtin_amdgcn_s_barrier(); asm volatile("" ::: "memory"); } while (0)
    ATT_STAGE(0, 0); if (NT > 1) ATT_STAGE(1, 1);
    ATT_WAIT_TILE(NT > 1);
    int cur = 0;
    for (int j = 0; j < NT; ++j) {
        if (j + 2 < NT) ATT_STAGE(j + 2, (cur == 0 ? 2 : cur - 1));
        bool act = true; const bool domask = it.band && j >= it.n0; int kpos0 = 0;
        if (domask) { kpos0 = 64 * (it.t_lo + j - it.n0); const int qlo = it.q0 + wid * 32; act = (kpos0 + 63 >= qlo - 128) && (kpos0 <= qlo + 31 + 128); }
        if (act) {
            f32x16 p0, p1;
#pragma unroll
            for (int r = 0; r < 16; ++r) { p0[r] = 0.f; p1[r] = 0.f; }
            const LAS unsigned char* Ks = K_lds + cur * SHM_K;
            {
                constexpr int NG = ND / 4;
                bf16x8 kf[2][8];
#define ATT_LOADG(g_, dst) do { _Pragma("unroll") for (int u_ = 0; u_ < 4; ++u_) { dst[2 * u_] = *(const LAS bf16x8*)(Ks + koff[u_] + (g_) * 128); dst[2 * u_ + 1] = *(const LAS bf16x8*)(Ks + koff[u_] + (g_) * 128 + 32 * KROW); } } while (0)
                ATT_LOADG(0, kf[0]);
#pragma unroll
                for (int g = 0; g < NG; ++g) {
                    if (g + 1 < NG) ATT_LOADG(g + 1, kf[(g + 1) & 1]);
                    __builtin_amdgcn_sched_barrier(0);
#pragma unroll
                    for (int u_ = 0; u_ < 4; ++u_) { p0 = __builtin_amdgcn_mfma_f32_32x32x16_bf16(kf[g & 1][2 * u_], qr[4 * g + u_], p0, 0, 0, 0);
                        p1 = __builtin_amdgcn_mfma_f32_32x32x16_bf16(kf[g & 1][2 * u_ + 1], qr[4 * g + u_], p1, 0, 0, 0); }
                    __builtin_amdgcn_sched_barrier(0); }
#undef ATT_LOADG
            }
            if (domask) { const int qp = it.q0 + wid * 32 + r32;
#pragma unroll
                for (int r = 0; r < 16; ++r) { const int d = kpos0 + crow(r, hi) - qp;
                    if (d > 128 || d < -128) p0[r] = -1e30f;
                    if (d + 32 > 128 || d + 32 < -128) p1[r] = -1e30f; } }
            float pmax = p0[0];
#pragma unroll
            for (int r = 1; r < 16; ++r) pmax = fmaxf(pmax, p0[r]);
#pragma unroll
            for (int r = 0; r < 16; ++r) pmax = fmaxf(pmax, p1[r]);
            { auto rr = __builtin_amdgcn_permlane32_swap(__float_as_uint(pmax), __float_as_uint(pmax), false, false);
              pmax = fmaxf(__uint_as_float(rr[0]), __uint_as_float(rr[1])); }
            const float mn = fmaxf(m_reg, pmax); const float alpha = __builtin_amdgcn_exp2f(m_reg - mn); m_reg = mn;
            float ps = 0.f;
#pragma unroll
            for (int r = 0; r < 16; ++r) { p0[r] = __builtin_amdgcn_exp2f(p0[r] - mn); p1[r] = __builtin_amdgcn_exp2f(p1[r] - mn); ps += p0[r] + p1[r]; }
            { auto rr = __builtin_amdgcn_permlane32_swap(__float_as_uint(ps), __float_as_uint(ps), false, false);
              ps = __uint_as_float(rr[0]) + __uint_as_float(rr[1]); }
            l_reg = l_reg * alpha + ps;
            bf16x8 pa0, pa1, pa2, pa3;
#define ATT_PK4(P, BASE, OUT) do { unsigned a0 = cvtpk(P[BASE + 0], P[BASE + 1]), a1 = cvtpk(P[BASE + 2], P[BASE + 3]);   \
    unsigned b0 = cvtpk(P[BASE + 4], P[BASE + 5]), b1 = cvtpk(P[BASE + 6], P[BASE + 7]);                              \
    auto r0 = __builtin_amdgcn_permlane32_swap(a0, b0, false, false); auto r1 = __builtin_amdgcn_permlane32_swap(a1, b1, false, false); \
    u32x4 w = {r0[0], r1[0], r0[1], r1[1]}; OUT = __builtin_bit_cast(bf16x8, w); } while (0)
            ATT_PK4(p0, 0, pa0); ATT_PK4(p0, 8, pa1); ATT_PK4(p1, 0, pa2); ATT_PK4(p1, 8, pa3);
#undef ATT_PK4
            if (__any(alpha < 1.f)) { if (hi == 0) al_l[r32] = alpha; asm volatile("s_waitcnt lgkmcnt(0)" ::: "memory");
#pragma unroll
                for (int r = 0; r < 16; ++r) { const float al = al_l[crow(r, hi)];
#pragma unroll
                    for (int d = 0; d < 4; ++d) o[d][r] *= al; } }
            const int vb = vb0 + cur * SHM_V;
            pv_all(o, vb, pa0, pa1, pa2, pa3);
        }
        ATT_WAIT_TILE(j + 2 < NT);
        cur = cur == 2 ? 0 : cur + 1;
    }
#undef ATT_STAGE
#undef ATT_WAIT_TILE
    const int er = lane >> 4, ec = (lane & 15) * 8;
    bf16x8 gv[8];
    { const bf16_t* Gw = it.G + (size_t)(wid * 32 + er) * it.ldg + ec;
#pragma unroll
      for (int c = 0; c < 8; ++c) gv[c] = *(const bf16x8*)(Gw + (size_t)(4 * c) * it.ldg); }
    if (hi == 0) li_l[r32] = l_reg; asm volatile("s_waitcnt lgkmcnt(0)" ::: "memory");
    LAS bf16_t* ost = (LAS bf16_t*)(lds + wid * 8192);
#pragma unroll
    for (int r = 0; r < 16; ++r) { const float rli = 1.f / li_l[crow(r, hi)];
#pragma unroll
        for (int d0 = 0; d0 < 4; ++d0) ost[crow(r, hi) * 128 + d0 * 32 + r32] = (bf16_t)f2bf(o[d0][r] * rli); }
    asm volatile("s_waitcnt lgkmcnt(0)" ::: "memory");
    { bf16_t* Ow = it.O + (size_t)(wid * 32 + er) * it.ldo + ec;
#pragma unroll
      for (int c = 0; c < 8; ++c) { const bf16x8 ov = *(const LAS bf16x8*)(ost + (4 * c + er) * 128 + ec); float t8[8];
#pragma unroll
          for (int e = 0; e < 8; ++e) t8[e] = bf2f((unsigned short)ov[e]) * silu_f(bf2f((unsigned short)gv[c][e]));
          *(bf16x8*)(Ow + (size_t)(4 * c) * it.ldo) = pack8(t8); } }
    __syncthreads();
}
}

__device__ __forceinline__ void hgrn_item(LAS unsigned char* lds, const bf16_t* PROJ, int rowbase, int T, int h, int dir,
                                          const float* lb, const float* s0, float* sout, bf16_t* OUT, int c0, int c1, float* sbuf) {
    LAS float* GS = (LAS float*)lds;
    LAS float* DEC = (LAS float*)(lds + 2048);
    LAS bf16_t* QT = (LAS bf16_t*)(lds + 2560);
    LAS bf16_t* KT = QT + 32 * 136;
    LAS bf16_t* KTt = KT + 32 * 136;
    LAS bf16_t* Vt = KTt + 128 * 40;
    const int tid = otid(), wid = tid >> 6, lane = tid & 63, fr = lane & 15, fq = lane >> 4;
    const int c2 = tid & 127, part = tid >> 7, n0 = wid * 16;
    f32x4 S[8];
    { const float* sin_ = c0 > 0 ? sbuf : (s0 ? s0 : sbuf);
      const float ssc = (c0 > 0 || s0) ? 1.f : 0.f;
#pragma unroll
      for (int kt = 0; kt < 8; ++kt)
#pragma unroll
          for (int r = 0; r < 4; ++r) S[kt][r] = sin_[(size_t)(16 * kt + 4 * fq + r) * 128 + n0 + fr] * ssc; }
    __builtin_amdgcn_s_waitcnt(0x0F70);
    const float oml = 1.f - lb[c2];
    const unsigned hz = ozero();
    const int nch = T / 32;
    LAS unsigned char* RAW = lds + 40960;
    const int wvu = __builtin_amdgcn_readfirstlane(wid);
    const int dtl = 4 * wid + (lane >> 4), dch = (lane & 15) * 8;
    const bf16_t* dsrc = PROJ + h * 128 + dch;
    const int colf = dir ? COL_FB : COL_FF;
#define HG_DMA(cc, slot) do { const int _p = 32 * (cc) + dtl; const int _tok = dir ? T - 1 - _p : _p; const bf16_t* _s = dsrc + (size_t)(rowbase + _tok) * LDP_AB; \
        __builtin_amdgcn_global_load_lds((const unsigned*)(_s + COL_BQ), (LAS unsigned*)(RAW + (slot) * 24576 + wvu * 1024), 16, 0, 0); \
        __builtin_amdgcn_global_load_lds((const unsigned*)(_s + colf), (LAS unsigned*)(RAW + (slot) * 24576 + 8192 + wvu * 1024), 16, 0, 0); \
        __builtin_amdgcn_global_load_lds((const unsigned*)(_s + COL_BI), (LAS unsigned*)(RAW + (slot) * 24576 + 16384 + wvu * 1024), 16, 0, 0); } while (0)
#define HG_BAR() do { asm volatile("s_waitcnt lgkmcnt(0)" ::: "memory"); __builtin_amdgcn_s_barrier(); asm volatile("" ::: "memory"); } while (0)
    HG_DMA(c0, 0); if (c0 + 1 < c1) HG_DMA(c0 + 1, 1);
    if (c0 + 1 < c1) asm volatile("s_waitcnt vmcnt(3)" ::: "memory"); else asm volatile("s_waitcnt vmcnt(0)" ::: "memory");
    HG_BAR();
    int cur = 0;
    for (int cc = c0; cc < c1; ++cc) {
        if (cc + 2 < c1) HG_DMA(cc + 2, (cur == 0 ? 2 : cur - 1));
        float b[8], kk[8], sq[8]; unsigned short vv[8];
        { const LAS bf16_t* rw = (const LAS bf16_t*)(RAW + cur * 24576) + (8 * part) * 128 + c2;
            unsigned short rq[8], rf[8];
#pragma unroll
            for (int i = 0; i < 8; ++i) { rq[i] = rw[i * 128]; rf[i] = rw[4096 + i * 128]; vv[i] = rw[8192 + i * 128]; }
            float run = 0.f;
#pragma unroll
            for (int i = 0; i < 8; ++i) { const float x = bf2f(rf[i]); const float omf = oml * __builtin_amdgcn_rcpf(1.f + __expf(x));
                const float lf = fmaxf(__logf(1.f - omf), -30.f); run += lf; b[i] = run; kk[i] = omf; sq[i] = silu_f(bf2f(rq[i])); }
            GS[part * 128 + c2] = run; }
        HG_BAR();
        { float off = 0.f;
#pragma unroll
            for (int p = 0; p < 3; ++p) if (p < part) off += GS[p * 128 + c2];
            float kt_[8];
#pragma unroll
            for (int i = 0; i < 8; ++i) { const float bb = b[i] + off; const int t = 8 * part + i;
                const float qv = sq[i] * __expf(bb); kt_[i] = kk[i] * __expf(fminf(-bb, 80.f));
                QT[t * 136 + c2] = (bf16_t)f2bf(qv); KT[t * 136 + c2] = (bf16_t)f2bf(kt_[i]);
                if (i == 7 && part == 3) DEC[c2] = __expf(bb); }
            *(LAS bf16x8*)(KTt + c2 * 40 + 8 * part) = pack8(kt_);
            u32x4 wv; wv.x = (unsigned)vv[0] | ((unsigned)vv[1] << 16); wv.y = (unsigned)vv[2] | ((unsigned)vv[3] << 16); wv.z = (unsigned)vv[4] | ((unsigned)vv[5] << 16); wv.w = (unsigned)vv[6] | ((unsigned)vv[7] << 16);
            *(LAS u32x4*)(Vt + c2 * 40 + 8 * part) = wv; }
        if (cc + 2 < c1) { if (cc > c0) asm volatile("s_waitcnt vmcnt(11)" ::: "memory"); else asm volatile("s_waitcnt vmcnt(3)" ::: "memory"); }
        else asm volatile("s_waitcnt vmcnt(0)" ::: "memory");
        HG_BAR();
        f32x4 pt00 = {0.f, 0.f, 0.f, 0.f}, pt01 = pt00, pt11 = pt00;
#pragma unroll
        for (int ks = 0; ks < 4; ++ks) {
            const bf16x8 a0 = *(const LAS bf16x8*)(KT + fr * 136 + 32 * ks + 8 * fq), a1 = *(const LAS bf16x8*)(KT + (16 + fr) * 136 + 32 * ks + 8 * fq);
            const bf16x8 b0 = *(const LAS bf16x8*)(QT + fr * 136 + 32 * ks + 8 * fq), b1 = *(const LAS bf16x8*)(QT + (16 + fr) * 136 + 32 * ks + 8 * fq);
            pt00 = __builtin_amdgcn_mfma_f32_16x16x32_bf16(a0, b0, pt00, 0, 0, 0);
            pt01 = __builtin_amdgcn_mfma_f32_16x16x32_bf16(a0, b1, pt01, 0, 0, 0);
            pt11 = __builtin_amdgcn_mfma_f32_16x16x32_bf16(a1, b1, pt11, 0, 0, 0); }
#pragma unroll
        for (int r = 0; r < 4; ++r) { if (4 * fq + r > fr) { pt00[r] = 0.f; pt11[r] = 0.f; } }
        u32x4 wA0, wA1;
        wA0.x = pk2(pt00[0], pt00[1]); wA0.y = pk2(pt00[2], pt00[3]); wA0.z = hz; wA0.w = hz;
        wA1.x = pk2(pt01[0], pt01[1]); wA1.y = pk2(pt01[2], pt01[3]); wA1.z = pk2(pt11[0], pt11[1]); wA1.w = pk2(pt11[2], pt11[3]);
        const u32x2 vlo = *(const LAS u32x2*)(Vt + (n0 + fr) * 40 + 4 * fq), vhi = *(const LAS u32x2*)(Vt + (n0 + fr) * 40 + 16 + 4 * fq);
        const u32x4 wV = {vlo.x, vlo.y, vhi.x, vhi.y};
        f32x4 o0 = {0.f, 0.f, 0.f, 0.f}, o1 = o0;
        o0 = __builtin_amdgcn_mfma_f32_16x16x32_bf16(__builtin_bit_cast(bf16x8, wA0), __builtin_bit_cast(bf16x8, wV), o0, 0, 0, 0);
        o1 = __builtin_amdgcn_mfma_f32_16x16x32_bf16(__builtin_bit_cast(bf16x8, wA1), __builtin_bit_cast(bf16x8, wV), o1, 0, 0, 0);
#pragma unroll
        for (int aa = 0; aa < 4; ++aa) {
            u32x4 wS; wS.x = pk2(S[2 * aa][0], S[2 * aa][1]); wS.y = pk2(S[2 * aa][2], S[2 * aa][3]); wS.z = pk2(S[2 * aa + 1][0], S[2 * aa + 1][1]); wS.w = pk2(S[2 * aa + 1][2], S[2 * aa + 1][3]);
            const u32x2 q0l = *(const LAS u32x2*)(QT + fr * 136 + 32 * aa + 4 * fq), q0h = *(const LAS u32x2*)(QT + fr * 136 + 32 * aa + 16 + 4 * fq);
            const u32x2 q1l = *(const LAS u32x2*)(QT + (16 + fr) * 136 + 32 * aa + 4 * fq), q1h = *(const LAS u32x2*)(QT + (16 + fr) * 136 + 32 * aa + 16 + 4 * fq);
            const u32x4 wQ0 = {q0l.x, q0l.y, q0h.x, q0h.y}, wQ1 = {q1l.x, q1l.y, q1h.x, q1h.y};
            o0 = __builtin_amdgcn_mfma_f32_16x16x32_bf16(__builtin_bit_cast(bf16x8, wQ0), __builtin_bit_cast(bf16x8, wS), o0, 0, 0, 0);
            o1 = __builtin_amdgcn_mfma_f32_16x16x32_bf16(__builtin_bit_cast(bf16x8, wQ1), __builtin_bit_cast(bf16x8, wS), o1, 0, 0, 0); }
        { const bf16x8 vn = *(const LAS bf16x8*)(Vt + (n0 + fr) * 40 + 8 * fq);
#pragma unroll
            for (int kt = 0; kt < 8; ++kt) { const bf16x8 ka = *(const LAS bf16x8*)(KTt + (16 * kt + fr) * 40 + 8 * fq);
                S[kt] = __builtin_amdgcn_mfma_f32_16x16x32_bf16(ka, vn, S[kt], 0, 0, 0);
                const f32x4 d = *(const LAS f32x4*)(DEC + 16 * kt + 4 * fq); S[kt] = S[kt] * d; } }
#pragma unroll
        for (int r = 0; r < 4; ++r) {
            const int i0 = 4 * fq + r, i1 = 16 + 4 * fq + r;
            const int tok0 = dir ? T - 1 - (32 * cc + i0) : 32 * cc + i0, tok1 = dir ? T - 1 - (32 * cc + i1) : 32 * cc + i1;
            OUT[(size_t)(rowbase + tok0) * 1024 + h * 128 + n0 + fr] = (bf16_t)f2bf(o0[r]);
            OUT[(size_t)(rowbase + tok1) * 1024 + h * 128 + n0 + fr] = (bf16_t)f2bf(o1[r]); }
        cur = cur == 2 ? 0 : cur + 1;
    }
#undef HG_DMA
#undef HG_BAR
    { float* so_ = c1 < nch ? sbuf : sout;
      if (so_) {
#pragma unroll
        for (int kt = 0; kt < 8; ++kt)
#pragma unroll
            for (int r = 0; r < 4; ++r) so_[(size_t)(16 * kt + 4 * fq + r) * 128 + n0 + fr] = S[kt][r]; } }
    __syncthreads();
}

__device__ __forceinline__ int fetch_item(unsigned* ctr, LAS int* slot) {
    __syncthreads();
    if (otid() == 0) *slot = (int)atomicAdd(ctr, 1u);
    __syncthreads();
    return __builtin_amdgcn_readfirstlane(*slot);
}

#define XB_TMO      128
#define XB_XCNT(j)  (256  + 64 * (j))
#define XB_XSUB(j)  (1280 + 64 * (j))
#define XB_XGEN(j)  (2304 + 64 * (j))
#define XB_TOP      3328
#define XB_TOPGEN   3392
#define XCD_BAR_WORDS 3456
#define XB_SPIN_CAP (1u << 18)

__device__ __forceinline__ unsigned xb_ld(unsigned* p)              { return __hip_atomic_load(p, __ATOMIC_RELAXED, __HIP_MEMORY_SCOPE_AGENT); }
__device__ __forceinline__ unsigned xb_add(unsigned* p, unsigned v) { return __hip_atomic_fetch_add(p, v, __ATOMIC_RELAXED, __HIP_MEMORY_SCOPE_AGENT); }
__device__ __forceinline__ unsigned xb_xcc_id() { return (unsigned)__builtin_amdgcn_s_getreg((3 << 11) | 20) & 0xFu; }
#define XB_SPIN(cond, bar) do { unsigned _sp = 0; while (cond) { __builtin_amdgcn_s_sleep(1); \
    if ((++_sp & 255u) == 0u) { if (xb_ld(&(bar)[XB_TMO])) break; if (_sp > XB_SPIN_CAP) { atomicAdd(&(bar)[XB_TMO], 1u); break; } } } } while (0)

struct XcdBarrier {
    unsigned* bar; unsigned x;
    volatile LAS unsigned* st;
};

__device__ __forceinline__ XcdBarrier xcd_barrier_post(unsigned* bar, volatile LAS unsigned* st) {
    XcdBarrier b; b.bar = bar; b.x = xb_xcc_id(); b.st = st;
    if (threadIdx.x == 0) (void)xb_add(&bar[XB_XCNT(b.x)], 1u);
    return b;
}
__device__ __forceinline__ void xcd_barrier_complete(unsigned* bar, unsigned x, unsigned& nloc, unsigned& nx) {
    const unsigned G = gridDim.x * gridDim.y * gridDim.z;
    unsigned sum, cnt, mine, sp = 0u;
    for (;;) {
        sum = 0u; cnt = 0u; mine = 0u;
#pragma unroll
        for (unsigned j = 0; j < 16; ++j) { const unsigned c = xb_ld(&bar[XB_XCNT(j)]); sum += c; cnt += (c > 0u) ? 1u : 0u; mine = (j == x) ? c : mine; }
        if (sum == G) break;
        __builtin_amdgcn_s_sleep(1);
        if ((++sp & 255u) == 0u) { if (xb_ld(&bar[XB_TMO])) break; if (sp > XB_SPIN_CAP) { atomicAdd(&bar[XB_TMO], 1u); break; } }
    }
    nloc = mine > 0u ? mine : 1u; nx = cnt > 0u ? cnt : 1u;
}

__device__ __forceinline__ void xcd_barrier(const XcdBarrier& b) {
    asm volatile("s_waitcnt vmcnt(0)" ::: "memory");
    __syncthreads();
    if (threadIdx.x == 0) {
        unsigned* bar = b.bar;
        __builtin_amdgcn_s_waitcnt(0);
        unsigned nloc = b.st[0], nx = b.st[1];
        if (nloc == 0u) { xcd_barrier_complete(bar, b.x, nloc, nx); b.st[0] = nloc; b.st[1] = nx; }
        const unsigned old = xb_add(&bar[XB_XSUB(b.x)], 1u);
        const unsigned gen = old / nloc;
        if (old + 1u == (gen + 1u) * nloc) {
            __builtin_amdgcn_fence(__ATOMIC_RELEASE, "agent");
            asm volatile("s_waitcnt vmcnt(0)" ::: "memory");
            const unsigned og = xb_add(&bar[XB_TOP], 1u);
            const unsigned tg = og / nx;
            if (og + 1u == (tg + 1u) * nx) xb_add(&bar[XB_TOPGEN], 1u);
            else XB_SPIN(xb_ld(&bar[XB_TOPGEN]) == tg, bar);
            __builtin_amdgcn_fence(__ATOMIC_ACQUIRE, "agent");
            xb_add(&bar[XB_XGEN(b.x)], 1u);
            asm volatile("s_waitcnt vmcnt(0)" ::: "memory");
        } else {
            XB_SPIN(xb_ld(&bar[XB_XGEN(b.x)]) == gen, bar);
            __builtin_amdgcn_fence(__ATOMIC_ACQUIRE, "agent");
            asm volatile("s_waitcnt vmcnt(0)" ::: "memory");
        }
    }
    __syncthreads();
}

#ifndef BG_C1
#define BG_C1 4
#define BG_C2 12
#define BG_C3 16
#endif
enum { K_FINAL = 12, K_P0 = 0, K_MODNORM, K_GEMM_IN, K_PREP_AB, K_GEMM_QUP, K_GEMM_KVUP, K_HN_AB, K_MIX_AB, K_FIN_AB, K_GEMM_OUT, K_HN_C, K_ATTN_C };

__global__ void __launch_bounds__(NTHR, 2) mk_fwd(Args a_byval) {
    extern __shared__ __attribute__((aligned(16))) unsigned char lds_raw[];
    LAS unsigned char* lds = (LAS unsigned char*)lds_raw;
    LAS int* slot = (LAS int*)(lds + LDS_PHASE);
    cg::grid_group grid = cg::this_grid();
    const int G = gridDim.x;
    volatile LAS unsigned* bst = (volatile LAS unsigned*)(lds + LDS_PHASE + 64);
    if (threadIdx.x < 2) bst[threadIdx.x] = 0u;
    __syncthreads();
    (void)xcd_barrier_post((unsigned*)(a_byval.ws + WS_CTL) + 8192, bst);

#ifndef PROBE_TSEL
#define PROBE_TSEL 0
#endif
    unsigned long long t_acc = 0ull;
    for (int step = 0; step < 30; ++step) {
        unsigned long long t_begin = 0ull; if (PROBE_TSEL) t_begin = __builtin_amdgcn_s_memrealtime();
        asm volatile("" : "+s"(step));
        KArgs a = (KArgs)__builtin_amdgcn_kernarg_segment_ptr();
        asm volatile("" : "+s"(a));
        unsigned char* ws = a->ws;
        unsigned* ctl = (unsigned*)(ws + WS_CTL);
        XcdBarrier xbar; xbar.bar = ctl + 8192; xbar.x = xb_xcc_id(); xbar.st = (volatile LAS unsigned*)(lds + LDS_PHASE + 64);
        int kind, L = 0; bool sync_after = true;
        if (step == 0) kind = K_P0;
        else if (step == 29) { kind = K_FINAL; L = 4; }
        else { const int s = step - 1, pair = s / 14, r = s % 14;
            if (r < 9) { L = 2 * pair; kind = r == 0 ? K_MODNORM : r == 1 ? K_GEMM_IN : r == 2 ? K_PREP_AB : r == 3 ? K_GEMM_QUP : r == 4 ? K_GEMM_KVUP : r == 5 ? K_HN_AB : r == 6 ? K_MIX_AB : r == 7 ? K_FIN_AB : K_GEMM_OUT; }
            else { L = 2 * pair + 1; const int q = r - 9; kind = q == 0 ? K_MODNORM : q == 1 ? K_GEMM_IN : q == 2 ? K_HN_C : q == 3 ? K_ATTN_C : K_GEMM_OUT; } }
        const int j = L >> 1; const bool isC = (L & 1) != 0;
        if (kind == K_GEMM_QUP) sync_after = false;
        if (step == 29) sync_after = false;

#ifndef PROBE_MASK
#define PROBE_MASK 0
#endif
#ifndef PROBE_SEL
#define PROBE_SEL 0
#endif
#ifndef PROBE_REPS
#define PROBE_REPS 2
#endif
        const int nrep = (((PROBE_MASK >> kind) & 1) && (kind != K_GEMM_OUT || L == 0)) ? 1 + PROBE_REPS : 1;
        for (int rep = 0; rep < nrep; ++rep) {
        if (PROBE_MASK == 0x1000) { for (int q = 0; q < 2; ++q) xcd_barrier(xbar); }
        const int bid = obid();
        const bool bgphase = kind == K_PREP_AB || kind == K_GEMM_QUP || kind == K_GEMM_KVUP || kind == K_HN_AB;
        if (rep == 0 && bid < NBG && (kind == K_PREP_AB || kind == K_GEMM_QUP || kind == K_HN_AB || kind == K_MIX_AB)) {
            const int b = bid >> 4, h = (bid >> 1) & 7, dir = bid & 1;
            const int c0 = kind == K_PREP_AB ? 0 : kind == K_GEMM_QUP ? BG_C1 : kind == K_HN_AB ? BG_C2 : BG_C3;
            const int c1 = kind == K_PREP_AB ? BG_C1 : kind == K_GEMM_QUP ? BG_C2 : kind == K_HN_AB ? BG_C3 : 64;
            hgrn_item(lds, (const bf16_t*)(ws + WS_PROJ), MC + b * 2048, 2048, h, dir, (const float*)(ws + WS_LB) + (j * 2 + dir) * 1024 + h * 128,
                      a->in[4 + dir] + (size_t)((b * 2 + j) * 8 + h) * 16384, nullptr, (bf16_t*)(ws + (dir ? WS_OB : WS_OF)), c0, c1, (float*)(ws + WS_SBUF) + (size_t)bid * 16384);
        }
        const int ewg = bgphase ? bid - NBG : bid, enwg = bgphase ? G - NBG : G;
        if (bgphase && bid < NBG) {}
        else
        if (kind == K_P0) phase_p0(a, lds);
        else if (kind == K_MODNORM) phase_modnorm(a, L);
        else if (kind == K_GEMM_IN || kind == K_GEMM_QUP || kind == K_GEMM_KVUP) {
            pg8::Gemm g; pg8::EpiStore E;
            if (kind == K_GEMM_IN) {
                if (!isC) { g = pg8::Gemm{(const bf16_t*)(ws + WS_H), (const bf16_t*)(ws + WS_WINAB) + (size_t)j * 7168 * 2048, MROWS, 7168, 2048}; E = pg8::EpiStore{(bf16_t*)(ws + WS_PROJ), LDP_AB}; }
                else { g = pg8::Gemm{(const bf16_t*)(ws + WS_H), (const bf16_t*)(ws + WS_WINC) + (size_t)j * 5120 * 2048, MROWS, 5120, 2048}; E = pg8::EpiStore{(bf16_t*)(ws + WS_PROJ), LDP_C}; }
            } else if (kind == K_GEMM_QUP) { g = pg8::Gemm{(const bf16_t*)(ws + WS_QN), (const bf16_t*)(ws + WS_WQUP) + (size_t)j * 1536 * 512, MROWS, 1536, 512}; E = pg8::EpiStore{(bf16_t*)(ws + WS_QRAW), 1536}; }
            else { g = pg8::Gemm{(const bf16_t*)(ws + WS_CKV), (const bf16_t*)(ws + WS_WKVUP) + (size_t)j * 2048 * 256, MKROWS, 2048, 256}; E = pg8::EpiStore{(bf16_t*)(ws + WS_KVRAW), 2048}; }
            pg8::StaticOrder S; S.init(g.M, g.N, enwg, ewg);
            pg8::gemm_phase<pg8::EpiStore, pg8::StaticOrder, true, true>(lds, g, S, E);
        }
        else if (kind == K_GEMM_OUT) {
            pg8::Gemm g{(const bf16_t*)(ws + WS_H), (const bf16_t*)(ws + (isC ? WS_WOUTC : WS_WOUTAB)) + (size_t)j * 2048 * 2048, MROWS, 2048, 2048};
            pg8::EpiResid E{(bf16_t*)(ws + WS_PROJ), (const float*)(ws + WS_MOD) + (size_t)L * 5 * 6144 + 4096,
                            (float*)(ws + WS_QRAW), ctl + 16384 + step * 256};
            pg8::SplitOrder S; S.init(g.M, g.N, g.K, G, obid());
            pg8::gemm_phase<pg8::EpiResid, pg8::SplitOrder, true, true>(lds, g, S, E);
        }
        else if (kind == K_FINAL) phase_final(a);
        else if (kind == K_PREP_AB) phase_prep_ab(a, j, ewg, enwg);
        else if (kind == K_HN_AB) phase_hn_ab(a, j, ewg, enwg);
        else if (kind == K_FIN_AB) phase_fin_ab(a, j);
        else if (kind == K_HN_C) phase_hn_c(a, j);
        else if (kind == K_MIX_AB) {
            unsigned* ctr = ctl + 64 * step + 8 * rep;
            const bf16_t* P = (const bf16_t*)(ws + WS_PROJ); bf16_t* MIX = (bf16_t*)(ws + WS_H);
            const bf16_t* QF = (const bf16_t*)(ws + WS_QRAW); const bf16_t* KF = (const bf16_t*)(ws + WS_KF); const bf16_t* KV = (const bf16_t*)(ws + WS_KVRAW);
            for (;;) {
                const int idx = fetch_item(ctr, slot);
                if (idx >= 640) break;
                if (idx >= 256 && idx < 512) {
                    const int i = idx - 256; const int b = i >> 4, h = (i >> 1) & 7, dir = i & 1;
                    const float* lb = (const float*)(ws + WS_LB) + (j * 2 + dir) * 1024 + h * 128;
                    float* so = a->out + (dir ? O_SB : O_SF) + (size_t)((b * 2 + j) * 8 + h) * 16384;
                    if (PROBE_SEL != 1 || rep == 0) hgrn_item(lds, P, b * 256, 256, h, dir, lb, nullptr, so, (bf16_t*)(ws + (dir ? WS_OB : WS_OF)), 0, 8, (float*)(ws + WS_SBUF));
                } else {
                    att::Item it;
                    const bool lat = idx < 256; int b, h, r0;
                    if (lat) { const int i = idx; b = i >> 6; h = (i >> 3) & 7; const int qb = i & 7; r0 = MC + b * 2048 + qb * 256; it.q0 = qb * 256;
                        it.K0 = KF + (size_t)(MROWS + b * 256) * 1536 + h * 192; it.V0 = KV + (size_t)(MROWS + b * 256) * 2048 + h * 256 + 128; it.n0 = 4;
                        it.K1 = KF + (size_t)(MC + b * 2048) * 1536 + h * 192; it.V1 = KV + (size_t)(MC + b * 2048) * 2048 + h * 256 + 128; it.t_lo = 0; it.t_hi = 32; }
                    else { const int i = idx - 512; b = i >> 3; h = i & 7; r0 = b * 256; it.q0 = 0;
                        it.K0 = KF; it.V0 = KV; it.n0 = 0;
                        it.K1 = KF + (size_t)r0 * 1536 + h * 192; it.V1 = KV + (size_t)r0 * 2048 + h * 256 + 128; it.t_lo = 0; it.t_hi = 4; }
                    it.ldk = 1536; it.ldv = 2048;
                    it.Q = QF + (size_t)r0 * 1536 + h * 192; it.ldq = 1536; it.band = 0; it.m0 = -1e30f; it.l0 = 0.f;
                    it.qg = a->in[18] + j * 192; it.rope = lat ? (const float*)(ws + WS_ROPEA) : nullptr; it.qscale = QSC_A;
                    it.G = P + (size_t)r0 * LDP_AB + COL_AG + h * 128; it.ldg = LDP_AB; it.O = MIX + (size_t)r0 * DM + h * 128; it.ldo = DM;
                    if (PROBE_SEL != 2 || rep == 0) att::attn_item<192>(lds, it);
                }
            }
        }
        else if (kind == K_ATTN_C) {
            unsigned* ctr = ctl + 64 * step + 8 * rep;
            const bf16_t* P = (const bf16_t*)(ws + WS_PROJ); bf16_t* MIX = (bf16_t*)(ws + WS_H);
            const bf16_t* KCC = (const bf16_t*)(ws + WS_KCC);
            for (;;) {
                const int idx = fetch_item(ctr, slot);
                if (idx >= 768) break;
                att::Item it; int b, h, r0;
                if (idx < 512) { b = idx >> 7; h = (idx >> 3) & 15; const int qb = idx & 7; r0 = MC + b * 2048 + qb * 256; const int kvh = h >> 2;
                    it.K0 = KCC + (size_t)((b * 2 + j) * 256) * LDP_C + kvh * 128; it.V0 = KCC + (size_t)((b * 2 + j) * 256) * LDP_C + 512 + kvh * 128; it.n0 = 4;
                    it.K1 = P + (size_t)(MC + b * 2048) * LDP_C + 2048 + kvh * 128; it.V1 = P + (size_t)(MC + b * 2048) * LDP_C + 2560 + kvh * 128;
                    it.t_lo = 4 * qb - 2 < 0 ? 0 : 4 * qb - 2; it.t_hi = 4 * qb + 6 > 32 ? 32 : 4 * qb + 6; it.q0 = qb * 256; it.band = 1; }
                else { const int i = idx - 512; b = i >> 4; h = i & 15; r0 = b * 256; const int kvh = h >> 2;
                    it.K0 = KCC; it.V0 = KCC; it.n0 = 0;
                    it.K1 = P + (size_t)r0 * LDP_C + 2048 + kvh * 128; it.V1 = P + (size_t)r0 * LDP_C + 2560 + kvh * 128; it.t_lo = 0; it.t_hi = 4; it.q0 = 0; it.band = 0; }
                it.ldk = LDP_C; it.ldv = LDP_C;
                it.Q = P + (size_t)r0 * LDP_C + h * 128; it.ldq = LDP_C; it.m0 = a->in[29][j * 16 + h] * LOG2E; it.l0 = 1.f;
                it.qg = a->in[27] + j * 128; it.rope = idx < 512 ? (const float*)(ws + WS_ROPEC) : nullptr; it.qscale = QSC_C;
                it.G = P + (size_t)r0 * LDP_C + 3072 + h * 128; it.ldg = LDP_C; it.O = MIX + (size_t)r0 * DM + h * 128; it.ldo = DM;
                att::attn_item<128>(lds, it);
            }
        }
        if (rep + 1 < nrep) xcd_barrier(xbar);
        }
        if (sync_after) { if (step == 0) grid.sync(); else xcd_barrier(xbar); }
        if (PROBE_TSEL) { if ((PROBE_TSEL >> kind) & 1) t_acc += __builtin_amdgcn_s_memrealtime() - t_begin; }
    }
    if (PROBE_TSEL) { if (blockIdx.x == 0) { const unsigned long long t_end = __builtin_amdgcn_s_memrealtime() + 2ull * t_acc;
        while (__builtin_amdgcn_s_memrealtime() < t_end) __builtin_amdgcn_s_sleep(32); } }
}

extern "C" void kernel_launch(void* const* d_in, const int* in_sizes, int n_in, void* d_out, int out_size, void* d_ws, size_t ws_size, hipStream_t stream) {
    static int grid = 0;
    if (grid == 0) {
        if (n_in != 31 || ws_size < WS_END) { fprintf(stderr, "kernel_launch: unexpected n_in %d or ws_size %zu (< %zu)\n", n_in, ws_size, (size_t)WS_END); grid = -1; return; }
        int dev = 0, cus = 0, per_cu = 0;
        hipGetDevice(&dev); hipDeviceGetAttribute(&cus, hipDeviceAttributeMultiprocessorCount, dev);
        if (hipFuncSetAttribute((const void*)mk_fwd, hipFuncAttributeMaxDynamicSharedMemorySize, LDS_BYTES) != hipSuccess) { fprintf(stderr, "kernel_launch: hipFuncSetAttribute failed\n"); grid = -1; return; }
        if (hipOccupancyMaxActiveBlocksPerMultiprocessor(&per_cu, (const void*)mk_fwd, NTHR, LDS_BYTES) != hipSuccess || per_cu < 1) per_cu = 1;
        (void)hipGetLastError();
        grid = cus > 0 ? cus : 256;
    }
    if (grid < 0) return;
    hipMemsetAsync((char*)d_ws + WS_CTL, 0, CTL_BYTES, stream);
    Args a{};
    for (int i = 0; i < 31; ++i) a.in[i] = (const float*)d_in[i];
    a.out = (float*)d_out; a.ws = (unsigned char*)d_ws;
    void* args[] = {&a};
    hipError_t e = hipLaunchCooperativeKernel((const void*)mk_fwd, dim3(grid), dim3(NTHR), args, LDS_BYTES, stream);
    if (e != hipSuccess) fprintf(stderr, "cooperative launch failed: %s (grid %d)\n", hipGetErrorString(e), grid);
}
```

```cpp
#include <hip/hip_runtime.h>
#include <hip/hip_cooperative_groups.h>
#include <cstdio>
#include <cstdint>
namespace cg = cooperative_groups;

namespace pg8 {
#define PG8_LAS __attribute__((address_space(3)))
typedef unsigned short bf16_t;
typedef short bf16x8 __attribute__((ext_vector_type(8)));
typedef float f32x4 __attribute__((ext_vector_type(4)));
typedef unsigned u32x4 __attribute__((ext_vector_type(4)));
constexpr int BM = 256, BK = 64, HALF = 128, HTB = HALF * BK * 2  , STAGE_BYTES = 8 * HTB, NXCD = 8, WGM = 8;
__device__ __forceinline__ int pg8_otid() { int t = threadIdx.x; asm volatile("" : "+v"(t)); return t; }

__host__ __device__ __forceinline__ int lds_byte(int r, int c) { const int st = (r >> 4) * 2 + (c >> 5), rr = r & 15, cc = c & 31, ob = rr * 64 + cc * 2; return st * 1024 + (ob ^ (((ob >> 9) & 1) << 5)); }
__host__ __device__ __forceinline__ void stage_rc(int b, int& R, int& C) { const int st = b / 1024, sb = b % 1024, swz = sb ^ (((sb >> 9) & 1) << 5); R = (st >> 1) * 16 + swz / 64; C = (st & 1) * 32 + (swz % 64) / 2; }
__host__ __device__ __forceinline__ int perm32(int rho) { const int n = rho >> 4, i = rho & 15; return 8 * (i >> 2) + 4 * n + (i & 3); }

struct Unit { int pm, pn, kp, np, tix; };
struct Gemm { const bf16_t* A; const bf16_t* Bt; int M, N, K; };

struct StaticOrder {
    int nM, nN, nwg, G, c;
    __host__ __device__ void init(int M, int N, int G_, int c_) { nM = M / BM; nN = N / BM; nwg = nM * nN; G = G_; c = c_; }
    __host__ __device__ bool next(int i, Unit& u) const {
        const long L = (long)i * G + c; if (L >= nwg) return false;
        int wgid = (int)L; { const int q = nwg / NXCD, r = nwg % NXCD, xcd = wgid % NXCD, off = wgid / NXCD; wgid = (xcd < r ? xcd * (q + 1) : r * (q + 1) + (xcd - r) * q) + off; }
        const int nig = WGM * nN, gid = wgid / nig, fm = gid * WGM, gsz = (nM - fm) < WGM ? (nM - fm) : WGM;
        u.pm = fm + ((wgid % nig) % gsz); u.pn = (wgid % nig) / gsz; u.kp = 0; u.np = 1; u.tix = 0; return true;
    }
    __device__ __forceinline__ void a_ready(const Unit&) const {}
    __device__ __forceinline__ void done(const Unit&) const {}
};
struct SplitOrder {
    StaticOrder so; int R, np;
    __host__ __device__ void init(int M, int N, int K, int G_, int c_) { so.init(M, N, G_, c_); R = so.nwg / G_; const int left = so.nwg - R * G_;
        np = 1; if (left > 0 && G_ % left == 0) { const int q = G_ / left; if (q == 2 && (K / q) % 128 == 0) np = q; } }
    __host__ __device__ bool next(int i, Unit& u) const {
        if (np == 1 || i < R) return so.next(i, u);
        if (i > R) return false;
        StaticOrder t = so; t.c = so.c / np; const bool ok = t.next(i, u); u.kp = so.c % np; u.np = np; u.tix = so.c / np; return ok;
    }
    __device__ __forceinline__ void a_ready(const Unit&) const {}
    __device__ __forceinline__ void done(const Unit&) const {}
};

typedef float f32x2c __attribute__((ext_vector_type(2)));
typedef __bf16 bf16x2c __attribute__((ext_vector_type(2)));
__device__ __forceinline__ unsigned cvt_pk_bf16(float lo, float hi) { const f32x2c v = {lo, hi}; const bf16x2c b = __builtin_convertvector(v, bf16x2c); return __builtin_bit_cast(unsigned, b); }

struct EpiStore {
    static constexpr bool PERM = true, AFTER_DRAIN = false;
    bf16_t* O; int ldc;
    __device__ __forceinline__ void operator()(const f32x4 (&acc)[2][2][4][2], const Unit& u, int wr, int wc, int fr, int fq) const {
        const int row0 = u.pm * BM + wr * 64 + fr; const int col0 = u.pn * BM + wc * 32 + 8 * fq;
#pragma unroll
        for (int ai = 0; ai < 2; ++ai)
#pragma unroll
            for (int m = 0; m < 4; ++m) { bf16_t* rowp = O + (size_t)(row0 + ai * HALF + m * 16) * ldc + col0;
#pragma unroll
                for (int bj = 0; bj < 2; ++bj) { const f32x4 v0 = acc[ai][bj][m][0], v1 = acc[ai][bj][m][1];
                    u32x4 w; w.x = cvt_pk_bf16(v0[0], v0[1]); w.y = cvt_pk_bf16(v0[2], v0[3]); w.z = cvt_pk_bf16(v1[0], v1[1]); w.w = cvt_pk_bf16(v1[2], v1[3]);
                    *(u32x4*)(rowp + bj * HALF) = w; } }
    }
};
struct EpiResid {
    static constexpr bool PERM = true, AFTER_DRAIN = false;
    bf16_t* dout; const float* gate_base;
    float* slab; unsigned* cnt;
    __device__ __forceinline__ void operator()(f32x4 (&acc)[2][2][4][2], const Unit& u, int wr, int wc, int fr, int fq) const {
        const int tid = (wr * 4 + wc) * 64 + fq * 16 + fr;
        const f32x4* sl = nullptr;
        if (u.np > 1) {
            float* sb = slab + (size_t)u.tix * (u.np - 1) * 65536;
            if (u.kp < u.np - 1) {
                f32x4* sp = (f32x4*)(sb + (size_t)u.kp * 65536) + tid;
#pragma unroll
                for (int ai = 0; ai < 2; ++ai)
#pragma unroll
                    for (int bj = 0; bj < 2; ++bj)
#pragma unroll
                        for (int m = 0; m < 4; ++m)
#pragma unroll
                            for (int n = 0; n < 2; ++n) sp[(((ai * 2 + bj) * 4 + m) * 2 + n) * 512] = acc[ai][bj][m][n];
                asm volatile("s_waitcnt vmcnt(0)" ::: "memory");
                __syncthreads();
                if (tid == 0) { __builtin_amdgcn_fence(__ATOMIC_RELEASE, "agent"); asm volatile("s_waitcnt vmcnt(0)" ::: "memory");
                    __hip_atomic_fetch_add(cnt + u.tix, 1u, __ATOMIC_RELAXED, __HIP_MEMORY_SCOPE_AGENT); }
                return;
            }
            if (tid == 0) { unsigned sp_ = 0;
                while (__hip_atomic_load(cnt + u.tix, __ATOMIC_RELAXED, __HIP_MEMORY_SCOPE_AGENT) < (unsigned)(u.np - 1)) { __builtin_amdgcn_s_sleep(2); if (++sp_ > (1u << 22)) break; }
                __builtin_amdgcn_fence(__ATOMIC_ACQUIRE, "agent"); asm volatile("s_waitcnt vmcnt(0)" ::: "memory"); }
            __syncthreads();
            sl = (const f32x4*)sb + tid;
        }
        const int pm = u.pm;
        const int ci = pm < 16 ? 4 : ((pm - 16) >> 3);
        const float* gt = gate_base + ci * 6144;
        const int row0 = pm * BM + wr * 64 + fr, col0 = u.pn * BM + wc * 32 + 8 * fq;
#pragma unroll
        for (int bj = 0; bj < 2; ++bj) { const f32x4 gq0 = *(const f32x4*)(gt + col0 + bj * HALF), gq1 = *(const f32x4*)(gt + col0 + bj * HALF + 4);
#pragma unroll
            for (int ai = 0; ai < 2; ++ai) {
#pragma unroll
                for (int m = 0; m < 4; ++m) { f32x4 a0 = acc[ai][bj][m][0], a1 = acc[ai][bj][m][1];
                    if (sl) { a0 += sl[(((ai * 2 + bj) * 4 + m) * 2 + 0) * 512]; a1 += sl[(((ai * 2 + bj) * 4 + m) * 2 + 1) * 512]; }
                    a0 = a0 * gq0; a1 = a1 * gq1;
                    u32x4 w; w.x = cvt_pk_bf16(a0[0], a0[1]); w.y = cvt_pk_bf16(a0[2], a0[3]); w.z = cvt_pk_bf16(a1[0], a1[1]); w.w = cvt_pk_bf16(a1[2], a1[3]);
                    *(u32x4*)(dout + (size_t)(row0 + ai * HALF + m * 16) * 2048 + col0 + bj * HALF) = w; }
                asm volatile("" ::: "memory"); } }
    }
};

template <class Epi, class Sched, bool ALIGN_EPI = false, bool SP2 = false>
__device__ __forceinline__ void gemm_phase(PG8_LAS unsigned char* lds, const Gemm g, const Sched& S, const Epi& E) {
    const int tid = pg8_otid(), wid = __builtin_amdgcn_readfirstlane(tid >> 6), lane = tid & 63, wr = wid >> 2, wc = wid & 3, fr = lane & 15, fq = lane >> 4;
    const int K = g.K, nt = K / BK;
    unsigned voffA[2], voffB[2];
#pragma unroll
    for (int i = 0; i < 2; ++i) { int R, C; stage_rc(tid * 16 + i * 8192, R, C); const int Rb = Epi::PERM ? ((R & ~31) + perm32(R & 31)) : R;
        voffA[i] = (unsigned)(R * K + C) * 2u; voffB[i] = (unsigned)(Rb * K + C) * 2u; }
    const size_t kstep = (size_t)(BK * 2);
    const size_t hstep = (size_t)HALF * K * 2;
    const size_t tstep = 2 * hstep;
    const unsigned ldsw = (unsigned)wid * 1024u;
    const int aoff = lds_byte(wr * 64 + fr, fq * 8), boff = lds_byte(wc * 32 + fr, fq * 8);
#define PG8_SA(b, h) (((b) * 2 + (h)) * HTB)
#define PG8_SB(b, h) ((4 + (b) * 2 + (h)) * HTB)
#define PG8_STAGE(bufoff, gbase, voff) do { _Pragma("unroll") for (int _i = 0; _i < 2; ++_i) \
        __builtin_amdgcn_global_load_lds((const unsigned*)((const char*)(gbase) + (voff)[_i]), (PG8_LAS unsigned*)(lds + (bufoff) + ldsw + _i * 8192), 16, 0, 0); } while (0)
#define PG8_LDA(dst, b, h) do { _Pragma("unroll") for (int m = 0; m < 4; ++m) _Pragma("unroll") for (int k = 0; k < 2; ++k) dst[m][k] = *(const PG8_LAS bf16x8*)(lds + PG8_SA(b, h) + aoff + m * 2048 + k * 1024); } while (0)
#define PG8_LDB(dst, b, h) do { _Pragma("unroll") for (int n = 0; n < 2; ++n) _Pragma("unroll") for (int k = 0; k < 2; ++k) dst[n][k] = *(const PG8_LAS bf16x8*)(lds + PG8_SB(b, h) + boff + n * 2048 + k * 1024); } while (0)
#define PG8_MMA(ai, bj, At, Bt) do { __builtin_amdgcn_s_setprio(1); _Pragma("unroll") for (int m = 0; m < 4; ++m) _Pragma("unroll") for (int n = 0; n < 2; ++n) _Pragma("unroll") for (int k = 0; k < 2; ++k) \
        acc[ai][bj][m][n] = __builtin_amdgcn_mfma_f32_16x16x32_bf16(Bt[n][k], At[m][k], acc[ai][bj][m][n], 0, 0, 0); __builtin_amdgcn_s_setprio(0); } while (0)
#define PG8_WAIT_V(n) asm volatile("s_waitcnt vmcnt(" #n ")" ::: "memory")
#define PG8_WAIT_L(n) asm volatile("s_waitcnt lgkmcnt(" #n ")" ::: "memory")
#define PG8_BAR __builtin_amdgcn_s_barrier()
#define PG8_SCHED __builtin_amdgcn_sched_barrier(0)
    Unit cur, nxt; int ui = 0;
    if (!S.next(0, cur)) return;
    f32x4 acc[2][2][4][2];
#pragma unroll
    for (int a = 0; a < 2; ++a)
#pragma unroll
        for (int b = 0; b < 2; ++b)
#pragma unroll
            for (int m = 0; m < 4; ++m)
#pragma unroll
                for (int n = 0; n < 2; ++n) acc[a][b][m][n] = (f32x4){0.f, 0.f, 0.f, 0.f};
    bf16x8 At[4][2], B0[2][2], B1[2][2];
    const char* cA = (const char*)g.A + (size_t)cur.pm * tstep + (size_t)cur.kp * (K / cur.np) * 2; const char* cB = (const char*)g.Bt + (size_t)cur.pn * tstep + (size_t)cur.kp * (K / cur.np) * 2;
    S.a_ready(cur);
    if constexpr (SP2) {
        PG8_STAGE(PG8_SB(0, 0), cB, voffB); PG8_STAGE(PG8_SB(0, 1), cB + hstep, voffB); PG8_STAGE(PG8_SA(0, 0), cA, voffA); PG8_STAGE(PG8_SA(0, 1), cA + hstep, voffA);
        if (wr == 1) PG8_BAR;
        PG8_WAIT_V(2); PG8_BAR;
        PG8_STAGE(PG8_SB(1, 0), cB + kstep, voffB); PG8_STAGE(PG8_SA(1, 0), cA + kstep, voffA); PG8_STAGE(PG8_SB(1, 1), cB + hstep + kstep, voffB);
        PG8_WAIT_V(6); PG8_BAR;
    } else {
        PG8_STAGE(PG8_SB(0, 0), cB, voffB); PG8_STAGE(PG8_SA(0, 0), cA, voffA); PG8_STAGE(PG8_SB(0, 1), cB + hstep, voffB); PG8_STAGE(PG8_SA(0, 1), cA + hstep, voffA);
        if (wr == 1) PG8_BAR;
        PG8_WAIT_V(4); PG8_BAR;
        PG8_STAGE(PG8_SB(1, 0), cB + kstep, voffB); PG8_STAGE(PG8_SA(1, 0), cA + kstep, voffA); PG8_STAGE(PG8_SB(1, 1), cB + hstep + kstep, voffB);
        PG8_WAIT_V(6); PG8_BAR;
    }
    for (;;) {
        const bool has_next = S.next(ui + 1, nxt);
        const size_t nko = has_next ? (size_t)nxt.kp * (K / nxt.np) * 2 : 0; const char* nA = has_next ? (const char*)g.A + (size_t)nxt.pm * tstep + nko : cA; const char* nB = has_next ? (const char*)g.Bt + (size_t)nxt.pn * tstep + nko : cB;
        const int ntc = nt / cur.np;
        for (int t = 0; t < ntc; t += 2) {
            const bool last = (t == ntc - 2);
            const char* a1 = cA + (size_t)(t + 1) * kstep;
            const char* a2 = last ? nA : cA + (size_t)(t + 2) * kstep; const char* b2 = last ? nB : cB + (size_t)(t + 2) * kstep;
            const char* a3 = a2 + kstep; const char* b3 = b2 + kstep;
            if (last && has_next) S.a_ready(nxt);
            if constexpr (SP2) {
            PG8_LDB(B0, 0, 0); PG8_LDB(B1, 0, 1); PG8_SCHED; PG8_LDA(At, 0, 0); PG8_STAGE(PG8_SA(1, 1), a1 + hstep, voffA);
            PG8_WAIT_V(8); PG8_WAIT_L(0); PG8_BAR; PG8_MMA(0, 0, At, B0); PG8_MMA(0, 1, At, B1); PG8_BAR; PG8_SCHED;
            PG8_LDA(At, 0, 1); PG8_STAGE(PG8_SB(0, 0), b2, voffB); PG8_STAGE(PG8_SB(0, 1), b2 + hstep, voffB); PG8_STAGE(PG8_SA(0, 0), a2, voffA);
            PG8_WAIT_V(8); PG8_WAIT_L(0); PG8_BAR; PG8_MMA(1, 0, At, B0); PG8_MMA(1, 1, At, B1); PG8_BAR; PG8_SCHED;
            PG8_LDB(B0, 1, 0); PG8_LDB(B1, 1, 1); PG8_SCHED; PG8_LDA(At, 1, 0); PG8_STAGE(PG8_SA(0, 1), a2 + hstep, voffA);
            PG8_WAIT_V(8); PG8_WAIT_L(0); PG8_BAR; PG8_MMA(0, 0, At, B0); PG8_MMA(0, 1, At, B1); PG8_BAR; PG8_SCHED;
            PG8_LDA(At, 1, 1); PG8_STAGE(PG8_SB(1, 0), b3, voffB); PG8_STAGE(PG8_SB(1, 1), b3 + hstep, voffB); PG8_STAGE(PG8_SA(1, 0), a3, voffA);
            PG8_WAIT_V(8); PG8_WAIT_L(0); PG8_BAR; PG8_MMA(1, 0, At, B0); PG8_MMA(1, 1, At, B1); PG8_BAR; PG8_SCHED;
            } else {
            PG8_LDB(B0, 0, 0); PG8_SCHED; PG8_LDA(At, 0, 0); PG8_STAGE(PG8_SA(1, 1), a1 + hstep, voffA);
            PG8_WAIT_L(8); PG8_BAR; PG8_WAIT_L(0); PG8_MMA(0, 0, At, B0); PG8_BAR; PG8_SCHED;
            PG8_LDB(B1, 0, 1); PG8_STAGE(PG8_SB(0, 0), b2, voffB);
            PG8_BAR; PG8_WAIT_L(0); PG8_MMA(0, 1, At, B1); PG8_BAR;
            PG8_LDA(At, 0, 1); PG8_STAGE(PG8_SA(0, 0), a2, voffA);
            PG8_BAR; PG8_WAIT_L(0); PG8_MMA(1, 0, At, B0); PG8_BAR; PG8_SCHED;
            PG8_STAGE(PG8_SB(0, 1), b2 + hstep, voffB);
            PG8_WAIT_V(6); PG8_BAR; PG8_MMA(1, 1, At, B1); PG8_BAR;
            PG8_LDB(B0, 1, 0); PG8_SCHED; PG8_LDA(At, 1, 0); PG8_STAGE(PG8_SA(0, 1), a2 + hstep, voffA);
            PG8_WAIT_L(8); PG8_BAR; PG8_WAIT_L(0); PG8_MMA(0, 0, At, B0); PG8_BAR; PG8_SCHED;
            PG8_LDB(B1, 1, 1); PG8_STAGE(PG8_SB(1, 0), b3, voffB);
            PG8_BAR; PG8_WAIT_L(0); PG8_MMA(0, 1, At, B1); PG8_BAR;
            PG8_LDA(At, 1, 1); PG8_STAGE(PG8_SA(1, 0), a3, voffA);
            PG8_BAR; PG8_WAIT_L(0); PG8_MMA(1, 0, At, B0); PG8_BAR; PG8_SCHED;
            PG8_STAGE(PG8_SB(1, 1), b3 + hstep, voffB);
            PG8_WAIT_V(6); PG8_BAR; PG8_MMA(1, 1, At, B1); PG8_BAR;
            }
        }
        if constexpr (ALIGN_EPI) { if (wr == 0) PG8_BAR; }
        if constexpr (!Epi::AFTER_DRAIN) { E(acc, cur, wr, wc, fr, fq); S.done(cur); }
        if (!has_next) break;
#pragma unroll
        for (int a = 0; a < 2; ++a)
#pragma unroll
            for (int b = 0; b < 2; ++b)
#pragma unroll
                for (int m = 0; m < 4; ++m)
#pragma unroll
                    for (int n = 0; n < 2; ++n) acc[a][b][m][n] = (f32x4){0.f, 0.f, 0.f, 0.f};
        cur = nxt; cA = nA; cB = nB; ++ui;
        if constexpr (ALIGN_EPI) { if (wr == 1) PG8_BAR; }
    }
    PG8_WAIT_V(0);
    if constexpr (!ALIGN_EPI) { if (wr == 0) PG8_BAR; }
    PG8_BAR;
    if constexpr (Epi::AFTER_DRAIN) { E.fused(acc, cur, wr, wc, fr, fq, lds, wid, lane); S.done(cur); }
#undef PG8_SA
#undef PG8_SB
#undef PG8_STAGE
#undef PG8_LDA
#undef PG8_LDB
#undef PG8_MMA
#undef PG8_WAIT_V
#undef PG8_WAIT_L
#undef PG8_BAR
#undef PG8_SCHED
}
}

#define LAS __attribute__((address_space(3)))
typedef unsigned short bf16_t;
typedef short bf16x8 __attribute__((ext_vector_type(8)));
typedef short s16x4 __attribute__((ext_vector_type(4)));
typedef float f32x4 __attribute__((ext_vector_type(4)));
typedef float f32x16 __attribute__((ext_vector_type(16)));
typedef unsigned u32x4 __attribute__((ext_vector_type(4)));
typedef unsigned u32x2 __attribute__((ext_vector_type(2)));


__device__ __forceinline__ int otid() { int t = threadIdx.x; asm volatile("" : "+v"(t)); return t; }
__device__ __forceinline__ unsigned ozero() { unsigned z = 0u; asm volatile("" : "+v"(z)); return z; }
__device__ __forceinline__ int obid() { int b = blockIdx.x; asm volatile("" : "+s"(b)); return b; }
constexpr int NWAVES = 8, NTHR = 512;
constexpr int DM = 2048, MC = 4096, ML = 8192, MROWS = 12288, MKROWS = 13312;
constexpr int LDP_AB = 7168, LDP_C = 5120;
constexpr int COL_QL = 0, COL_KVL = 512, COL_AG = 768, COL_BQ = 1792, COL_FF = 2816, COL_FB = 3840, COL_BI = 4864, COL_BG = 5888, COL_KPE = 6912;
constexpr float EPSN = 1e-6f;
constexpr float LOG2E = 1.4426950408889634f;
constexpr float QSC_A = 0.07216878364870322f * LOG2E;
constexpr float QSC_C = 0.08838834764831845f * LOG2E;

constexpr size_t O_YP = 0, O_YS = 8388608, O_CKV = 25165824, O_KPE = 27262976, O_SF = 27787264, O_SB = 31981568, O_KC = 36175872, O_VC = 40370176;

constexpr size_t MiB = 1u << 20;
constexpr size_t WS_CTL = 0, CTL_BYTES = 131072;
constexpr size_t WS_MOD = 1 * MiB, WS_LB = WS_MOD + 512 * 1024, WS_ROPEA = WS_LB + 64 * 1024, WS_ROPEC = WS_ROPEA + 512 * 1024;
constexpr size_t WS_KCC = 532 * MiB;
constexpr size_t WS_WINAB = 8 * MiB, WS_WQUP = 64 * MiB, WS_WKVUP = 67 * MiB, WS_WOUTAB = 69 * MiB, WS_WINC = 85 * MiB, WS_WOUTC = 125 * MiB;
constexpr size_t WS_H = 141 * MiB, WS_PROJ = 189 * MiB, WS_QRAW = 357 * MiB, WS_KVRAW = 393 * MiB, WS_KF = 445 * MiB, WS_OF = 484 * MiB, WS_OB = 508 * MiB;
constexpr size_t WS_QN = WS_H, WS_CKV = WS_H + 12 * MiB, WS_END = 552 * MiB;
constexpr size_t WS_SBUF = 4 * MiB;
constexpr int NBG = 64;

constexpr int LDS_PHASE = 131072, LDS_BYTES = LDS_PHASE + 1024;

__device__ __forceinline__ float bf2f(unsigned short b) { return __uint_as_float((unsigned)b << 16); }
typedef float f32x2_t __attribute__((ext_vector_type(2)));
typedef __bf16 bf16x2_t __attribute__((ext_vector_type(2)));
__device__ __forceinline__ unsigned pk2(float lo, float hi) { const f32x2_t v = {lo, hi}; const bf16x2_t b = __builtin_convertvector(v, bf16x2_t); return __builtin_bit_cast(unsigned, b); }
__device__ __forceinline__ unsigned f2bf(float f) { return pk2(f, 0.f) & 0xffffu; }
__device__ __forceinline__ float silu_f(float x) { return x * __builtin_amdgcn_rcpf(1.f + __expf(-x)); }
__device__ __forceinline__ float wave_sum(float v) {
#pragma unroll
    for (int o = 1; o < 64; o <<= 1) v += __shfl_xor(v, o);
    return v;
}
__device__ __forceinline__ float sum16(float v) {
    v += __shfl_xor(v, 1); v += __shfl_xor(v, 2); v += __shfl_xor(v, 4); v += __shfl_xor(v, 8); return v;
}
__device__ __forceinline__ bf16x8 pack8(const float* v) {
    u32x4 w; w.x = pk2(v[0], v[1]); w.y = pk2(v[2], v[3]); w.z = pk2(v[4], v[5]); w.w = pk2(v[6], v[7]); return __builtin_bit_cast(bf16x8, w);
}

struct Args { const float* in[31]; float* out; unsigned char* ws; };
typedef const Args __attribute__((address_space(4)))* KArgs;

struct P0Item { const float* W; bf16_t* WT; int K, N, k0, n0, d0; };
__device__ __forceinline__ void p0_load(const P0Item& q, float (&v)[32], int lane) {
#pragma unroll
    for (int i = 0; i < 32; ++i) { const int kk = 2 * i + (lane >> 5); v[i] = q.W[(size_t)(q.k0 + kk) * q.N + q.n0 + (lane & 31)]; }
}
__device__ __forceinline__ void p0_emit(const P0Item& q, const float (&v)[32], LAS float* scr, int lane) {
#pragma unroll
    for (int i = 0; i < 32; ++i) { const int kk = 2 * i + (lane >> 5); scr[kk * 33 + (lane & 31)] = v[i]; }
    asm volatile("s_waitcnt lgkmcnt(0)" ::: "memory");
    const int c = lane & 7;
#pragma unroll
    for (int j = 0; j < 4; ++j) { const int n = (lane >> 3) + 8 * j; const LAS float* s = scr + (8 * c) * 33 + n;
        u32x4 o; o.x = pk2(s[0 * 33], s[1 * 33]); o.y = pk2(s[2 * 33], s[3 * 33]); o.z = pk2(s[4 * 33], s[5 * 33]); o.w = pk2(s[6 * 33], s[7 * 33]);
        *(u32x4*)(q.WT + (size_t)(q.d0 + n) * q.K + q.k0 + 8 * c) = o; }
    asm volatile("s_waitcnt lgkmcnt(0)" ::: "memory");
}
__device__ __forceinline__ P0Item p0_decode(KArgs a, int it) {
    constexpr int I_INAB = 32 * 218, I_QUP = 8 * 48, I_KVUP = 4 * 64, I_OUT = 32 * 64, I_INC = 32 * 160;
    constexpr int PER_J = I_INAB + I_QUP + I_KVUP + I_OUT + I_INC + I_OUT;
    unsigned char* ws = a->ws; P0Item q;
    const int j = it / PER_J; int r = it % PER_J;
    if (r < I_INAB) { const int kb = r / 218, nb = r % 218, n0 = nb * 32;
        q.W = a->in[13] + (size_t)j * 2048 * 6976; q.WT = (bf16_t*)(ws + WS_WINAB) + (size_t)j * 7168 * 2048; q.K = 2048; q.N = 6976; q.k0 = kb * 64; q.n0 = n0; q.d0 = n0 < 768 ? n0 : (n0 < 832 ? n0 + 6144 : n0 - 64); return q; }
    r -= I_INAB;
    if (r < I_QUP) { const int kb = r / 48, nb = r % 48;
        q.W = a->in[16] + (size_t)j * 512 * 1536; q.WT = (bf16_t*)(ws + WS_WQUP) + (size_t)j * 1536 * 512; q.K = 512; q.N = 1536; q.k0 = kb * 64; q.n0 = nb * 32; q.d0 = nb * 32; return q; }
    r -= I_QUP;
    if (r < I_KVUP) { const int kb = r / 64, nb = r % 64;
        q.W = a->in[17] + (size_t)j * 256 * 2048; q.WT = (bf16_t*)(ws + WS_WKVUP) + (size_t)j * 2048 * 256; q.K = 256; q.N = 2048; q.k0 = kb * 64; q.n0 = nb * 32; q.d0 = nb * 32; return q; }
    r -= I_KVUP;
    if (r < I_OUT) { const int kb = r / 64, nb = r % 64;
        q.W = a->in[22] + (size_t)j * 2048 * 2048; q.WT = (bf16_t*)(ws + WS_WOUTAB) + (size_t)j * 2048 * 2048; q.K = 2048; q.N = 2048; q.k0 = kb * 64; q.n0 = nb * 32; q.d0 = nb * 32; return q; }
    r -= I_OUT;
    if (r < I_INC) { const int kb = r / 160, nb = r % 160;
        q.W = a->in[26] + (size_t)j * 2048 * 5120; q.WT = (bf16_t*)(ws + WS_WINC) + (size_t)j * 5120 * 2048; q.K = 2048; q.N = 5120; q.k0 = kb * 64; q.n0 = nb * 32; q.d0 = nb * 32; return q; }
    r -= I_INC;
    { const int kb = r / 64, nb = r % 64;
        q.W = a->in[30] + (size_t)j * 2048 * 2048; q.WT = (bf16_t*)(ws + WS_WOUTC) + (size_t)j * 2048 * 2048; q.K = 2048; q.N = 2048; q.k0 = kb * 64; q.n0 = nb * 32; q.d0 = nb * 32; return q; }
}

__device__ __forceinline__ void phase_p0(KArgs a, LAS unsigned char* lds) {
    const int tid = otid(), lane = tid & 63, wave = tid >> 6;
    const int G = gridDim.x, bid = obid();
    const int gw = bid * NWAVES + wave, NGW = G * NWAVES;
    unsigned char* ws = a->ws;
    {
        LAS float* scr = (LAS float*)(lds + wave * 8448);
        constexpr int TOTAL = 2 * (32 * 218 + 8 * 48 + 4 * 64 + 32 * 64 + 32 * 160 + 32 * 64);
        for (int it = gw; it < TOTAL; it += 2 * NGW) {
            const bool two = it + NGW < TOTAL;
            const P0Item qa = p0_decode(a, it); const P0Item qb = p0_decode(a, two ? it + NGW : it);
            float va[32], vb[32];
            p0_load(qa, va, lane); if (two) p0_load(qb, vb, lane);
            p0_emit(qa, va, scr, lane); if (two) p0_emit(qb, vb, scr, lane);
        }
    }
    const int gt = bid * NTHR + tid, NGT = G * NTHR;
    const unsigned zz = ozero();
    for (int i = gt; i < 2 * 192 * 256; i += NGT) { const int j = i / (192 * 256), r = i % (192 * 256);
        *(u32x4*)((bf16_t*)(ws + WS_WINAB) + (size_t)j * 7168 * 2048 + (size_t)6976 * 2048 + (size_t)r * 8) = (u32x4){zz, zz, zz, zz}; }
    for (int i = gt; i < 2 * 131072; i += NGT) { const int which = i / 131072, e = (i % 131072) * 8;
        const float* src = a->in[6 + which] + e; const f32x4 x0 = *(const f32x4*)src, x1 = *(const f32x4*)(src + 4);
        u32x4 w; w.x = pk2(x0[0], x0[1]); w.y = pk2(x0[2], x0[3]); w.z = pk2(x1[0], x1[1]); w.w = pk2(x1[2], x1[3]);
        *(u32x4*)((bf16_t*)(ws + WS_KCC) + (size_t)(e >> 9) * LDP_C + (which ? 512 : 0) + (e & 511)) = w; }
    for (int i = gt; i < 2 * 2048; i += NGT) { const int j = i / 2048, r = i % 2048; const float l0 = a->in[20][r], l1 = a->in[20][2048 + r];
        ((float*)(ws + WS_LB))[i] = j == 0 ? 0.f : 1.f / (1.f + __expf(l0 - l1)); }
    for (int i = gt; i < 2048 * 32; i += NGT) { const int t = i >> 5, f = i & 31; const float pos = f < 16 ? (float)(t >> 6) : (float)(t & 63);
        const float inv = exp2f(-(float)(f & 15) * (13.287712379549449f / 16.f)); const float ang = pos * inv;
        ((float*)(ws + WS_ROPEA))[2 * i] = __cosf(ang); ((float*)(ws + WS_ROPEA))[2 * i + 1] = __sinf(ang); }
    for (int i = gt; i < 2048 * 64; i += NGT) { const int t = i >> 6, f = i & 63; const float pos = f < 32 ? (float)(t >> 6) : (float)(t & 63);
        const float inv = exp2f(-(float)(f & 31) * (13.287712379549449f / 32.f)); const float ang = pos * inv;
        ((float*)(ws + WS_ROPEC))[2 * i] = __cosf(ang); ((float*)(ws + WS_ROPEC))[2 * i + 1] = __sinf(ang); }
    __syncthreads();
    {
        LAS float* SC = (LAS float*)lds;
        LAS float* RED = (LAS float*)(lds + 40960);
        for (int i = tid; i < 5 * 2048; i += NTHR) { const int b = i >> 11, k = i & 2047; const float x = b < 4 ? a->in[8][b * 2048 + k] : a->in[9][k]; SC[i] = silu_f(x); }
        __syncthreads();
        const int cq = tid & 7, ks = tid >> 3;
        for (int u = bid; u < 768; u += G) {
            const int L = u / 192, col0 = (u % 192) * 32;
            const float* W = ((L & 1) ? a->in[23] : a->in[10]) + (size_t)(L >> 1) * 2048 * 6144;
            const float* bias = ((L & 1) ? a->in[24] : a->in[11]) + (size_t)(L >> 1) * 6144;
            f32x4 acc[5];
#pragma unroll
            for (int b = 0; b < 5; ++b) acc[b] = (f32x4){0.f, 0.f, 0.f, 0.f};
#pragma unroll 16
            for (int kk = 0; kk < 32; ++kk) { const int k = 32 * ks + kk; const f32x4 w = *(const f32x4*)(W + (size_t)k * 6144 + col0 + 4 * cq);
#pragma unroll
                for (int b = 0; b < 5; ++b) acc[b] += SC[b * 2048 + k] * w; }
#pragma unroll
            for (int b = 0; b < 5; ++b) *(LAS f32x4*)(RED + (ks * 5 + b) * 32 + 4 * cq) = acc[b];
            __syncthreads();
            if (tid < 160) { const int b = tid >> 5, c = tid & 31; float s = 0.f;
                for (int q = 0; q < 64; ++q) s += RED[(q * 5 + b) * 32 + c];
                ((float*)(ws + WS_MOD))[(L * 5 + b) * 6144 + col0 + c] = s + bias[col0 + c]; }
            __syncthreads();
        }
    }
}

__device__ __forceinline__ void phase_modnorm(KArgs a, int L) {
    const int tid = otid(), lane = tid & 63, wave = tid >> 6;
    const int gw = obid() * NWAVES + wave, NGW = gridDim.x * NWAVES;
    const float* g = ((L & 1) ? a->in[25] : a->in[12]) + (L >> 1) * 2048;
    bf16_t* H = (bf16_t*)(a->ws + WS_H);
    for (int r0 = gw * 2; r0 < MROWS; r0 += NGW * 2) {
        f32x4 v[2][8]; float ss[2] = {0.f, 0.f};
#pragma unroll
        for (int u = 0; u < 2; ++u) { const int r = r0 + u;
            const float* x = L <= 1 ? (r < MC ? a->in[0] + (size_t)r * DM : a->in[1] + (size_t)(r - MC) * DM) : a->out + (size_t)r * DM;
#pragma unroll
            for (int j = 0; j < 8; ++j) v[u][j] = *(const f32x4*)(x + 256 * j + 4 * lane);
            if (L > 0) { const bf16_t* dp = (const bf16_t*)(a->ws + WS_PROJ) + (size_t)r * DM;
#pragma unroll
                for (int j = 0; j < 8; ++j) { const u32x2 dv = *(const u32x2*)(dp + 256 * j + 4 * lane);
                    v[u][j][0] += __uint_as_float(dv.x << 16); v[u][j][1] += __uint_as_float(dv.x & 0xffff0000u); v[u][j][2] += __uint_as_float(dv.y << 16); v[u][j][3] += __uint_as_float(dv.y & 0xffff0000u);
                    *(f32x4*)(a->out + (size_t)r * DM + 256 * j + 4 * lane) = v[u][j]; } } }
#pragma unroll
        for (int u = 0; u < 2; ++u) {
#pragma unroll
            for (int j = 0; j < 8; ++j) ss[u] += (v[u][j][0] * v[u][j][0] + v[u][j][1] * v[u][j][1]) + (v[u][j][2] * v[u][j][2] + v[u][j][3] * v[u][j][3]); }
#pragma unroll
        for (int u = 0; u < 2; ++u) { const int r = r0 + u;
            const int ci = r < MC ? 4 : ((r - MC) >> 11);
            const float* md = (const float*)(a->ws + WS_MOD) + (L * 5 + ci) * 6144;
            const float rstd = rsqrtf(wave_sum(ss[u]) * (1.f / 2048.f) + EPSN);
#pragma unroll
            for (int j = 0; j < 8; ++j) { const int c = 256 * j + 4 * lane;
                const f32x4 gg = *(const f32x4*)(g + c), sh = *(const f32x4*)(md + c), sc = *(const f32x4*)(md + 2048 + c);
                const f32x4 y = (v[u][j] * rstd * gg) * (sc + 1.f) + sh;
                u32x2 w; w.x = pk2(y[0], y[1]); w.y = pk2(y[2], y[3]);
                *(u32x2*)(H + (size_t)r * DM + c) = w; } }
    }
}

__device__ __forceinline__ void phase_final(KArgs a) {
    const int tid = otid();
    const int gt = obid() * NTHR + tid, NGT = gridDim.x * NTHR;
    const bf16_t* D = (const bf16_t*)(a->ws + WS_PROJ); float* out = a->out;
    for (int i = gt; i < MROWS * DM / 8; i += NGT) { const size_t e = (size_t)i * 8;
        const bf16x8 dv = *(const bf16x8*)(D + e); f32x4 x0 = *(const f32x4*)(out + e), x1 = *(const f32x4*)(out + e + 4);
        x0[0] += bf2f((unsigned short)dv[0]); x0[1] += bf2f((unsigned short)dv[1]); x0[2] += bf2f((unsigned short)dv[2]); x0[3] += bf2f((unsigned short)dv[3]);
        x1[0] += bf2f((unsigned short)dv[4]); x1[1] += bf2f((unsigned short)dv[5]); x1[2] += bf2f((unsigned short)dv[6]); x1[3] += bf2f((unsigned short)dv[7]);
        *(f32x4*)(out + e) = x0; *(f32x4*)(out + e + 4) = x1; }
}

__device__ __forceinline__ void phase_prep_ab(KArgs a, int j, int wg, int nwg) {
    const int tid = otid(), lane = tid & 63, wave = tid >> 6;
    const int gw = wg * NWAVES + wave, NGW = nwg * NWAVES;
    const bf16_t* P = (const bf16_t*)(a->ws + WS_PROJ);
    bf16_t* QN = (bf16_t*)(a->ws + WS_QN); bf16_t* CKV = (bf16_t*)(a->ws + WS_CKV);
    const float* gq = a->in[14] + j * 512; const float* gkv = a->in[15] + j * 256;
    for (int r = gw; r < MKROWS; r += NGW) {
        if (r < MROWS) {
            const bf16_t* p = P + (size_t)r * LDP_AB;
            const bf16x8 q = *(const bf16x8*)(p + COL_QL + 8 * lane);
            float qv[8]; float ss = 0.f;
#pragma unroll
            for (int e = 0; e < 8; ++e) { qv[e] = bf2f((unsigned short)q[e]); ss += qv[e] * qv[e]; }
            const float rq = rsqrtf(wave_sum(ss) * (1.f / 512.f) + EPSN);
#pragma unroll
            for (int e = 0; e < 8; ++e) qv[e] = qv[e] * rq * gq[8 * lane + e];
            *(bf16x8*)(QN + (size_t)r * 512 + 8 * lane) = pack8(qv);
            const s16x4 kv = *(const s16x4*)(p + COL_KVL + 4 * lane);
            float kf[4]; float s2 = 0.f;
#pragma unroll
            for (int e = 0; e < 4; ++e) { kf[e] = bf2f((unsigned short)kv[e]); s2 += kf[e] * kf[e]; }
            const float rk = rsqrtf(wave_sum(s2) * (1.f / 256.f) + EPSN);
#pragma unroll
            for (int e = 0; e < 4; ++e) kf[e] = kf[e] * rk * gkv[4 * lane + e];
            u32x2 w; w.x = pk2(kf[0], kf[1]); w.y = pk2(kf[2], kf[3]);
            *(u32x2*)(CKV + (size_t)r * 256 + 4 * lane) = w;
            if (r < MC) { const int b = r >> 8, t = r & 255; const size_t rowo = (size_t)((b * 2 + j) * 256 + t);
                *(f32x4*)(a->out + O_CKV + rowo * 256 + 4 * lane) = (f32x4){kf[0], kf[1], kf[2], kf[3]};
                a->out[O_KPE + rowo * 64 + lane] = bf2f(p[COL_KPE + lane]); }
        } else {
            const int rr = r - MROWS, b = rr >> 8, t = rr & 255;
            const f32x4 x = *(const f32x4*)(a->in[2] + (size_t)((b * 2 + j) * 256 + t) * 256 + 4 * lane);
            u32x2 w; w.x = pk2(x[0], x[1]); w.y = pk2(x[2], x[3]);
            *(u32x2*)(CKV + (size_t)r * 256 + 4 * lane) = w;
        }
    }
}

__device__ __forceinline__ void phase_hn_ab(KArgs a, int j, int wg, int nwg) {
    const int tid = otid(), lane = tid & 63, wave = tid >> 6, sub = lane & 15, hq = lane >> 4;
    const int gw = wg * NWAVES + wave, NGW = nwg * NWAVES;
    bf16_t* Q = (bf16_t*)(a->ws + WS_QRAW); const bf16_t* KV = (const bf16_t*)(a->ws + WS_KVRAW); bf16_t* KF = (bf16_t*)(a->ws + WS_KF);
    const bf16_t* P = (const bf16_t*)(a->ws + WS_PROJ);
    const float* RA = (const float*)(a->ws + WS_ROPEA);
    const float* gq = a->in[18] + j * 192; const float* gk = a->in[19] + j * 192;
    const float* ckpe = a->in[3];
    constexpr int U = 4;
    const int NQ = 0, NIT = MKROWS * 2;
    for (int base = gw * U; base < NIT; base += NGW * U) {
        bf16x8 vn[U]; float x1[U][2], x2[U][2]; f32x4 cs[U];
#pragma unroll
        for (int u = 0; u < U; ++u) { const int it = base + u; if (it < NIT) {
            const bool isq = it < NQ; const int w = isq ? it : it - NQ; const int r = w >> 1, h = (w & 1) * 4 + hq;
            if (isq) { const bf16_t* p = Q + (size_t)r * 1536 + h * 192;
                vn[u] = *(const bf16x8*)(p + 8 * sub); const unsigned a1 = *(const unsigned*)(p + 128 + 2 * sub), a2 = *(const unsigned*)(p + 160 + 2 * sub);
                x1[u][0] = bf2f(a1 & 0xffff); x1[u][1] = bf2f(a1 >> 16); x2[u][0] = bf2f(a2 & 0xffff); x2[u][1] = bf2f(a2 >> 16);
            } else { vn[u] = *(const bf16x8*)(KV + (size_t)r * 2048 + h * 256 + 8 * sub);
                if (r < MROWS) { const bf16_t* pe = P + (size_t)r * LDP_AB + COL_KPE; const unsigned a1 = *(const unsigned*)(pe + 2 * sub), a2 = *(const unsigned*)(pe + 32 + 2 * sub);
                    x1[u][0] = bf2f(a1 & 0xffff); x1[u][1] = bf2f(a1 >> 16); x2[u][0] = bf2f(a2 & 0xffff); x2[u][1] = bf2f(a2 >> 16); }
                else { const int rr = r - MROWS, b = rr >> 8, t = rr & 255; const float* pe = ckpe + (size_t)((b * 2 + j) * 256 + t) * 64;
                    x1[u][0] = pe[2 * sub]; x1[u][1] = pe[2 * sub + 1]; x2[u][0] = pe[32 + 2 * sub]; x2[u][1] = pe[32 + 2 * sub + 1]; } }
            if (r >= MC && r < MROWS) cs[u] = *(const f32x4*)(RA + (((r - MC) & 2047) * 32 + 2 * sub) * 2);
        } }
#pragma unroll
        for (int u = 0; u < U; ++u) { const int it = base + u; if (it < NIT) {
            const bool isq = it < NQ; const int w = isq ? it : it - NQ; const int r = w >> 1, h = (w & 1) * 4 + hq;
            float xn[8];
#pragma unroll
            for (int e = 0; e < 8; ++e) xn[e] = bf2f((unsigned short)vn[u][e]);
            float ss = x1[u][0] * x1[u][0] + x1[u][1] * x1[u][1] + x2[u][0] * x2[u][0] + x2[u][1] * x2[u][1];
#pragma unroll
            for (int e = 0; e < 8; ++e) ss += xn[e] * xn[e];
            const float rstd = rsqrtf(sum16(ss) * (1.f / 192.f) + EPSN);
            const float* g = isq ? gq : gk;
#pragma unroll
            for (int e = 0; e < 8; ++e) xn[e] = xn[e] * rstd * g[8 * sub + e];
            float y1[2], y2[2];
            y1[0] = x1[u][0] * rstd * g[128 + 2 * sub]; y1[1] = x1[u][1] * rstd * g[128 + 2 * sub + 1]; y2[0] = x2[u][0] * rstd * g[160 + 2 * sub]; y2[1] = x2[u][1] * rstd * g[160 + 2 * sub + 1];
            if (r >= MC && r < MROWS) {
#pragma unroll
                for (int q = 0; q < 2; ++q) { const float c = cs[u][2 * q], sn = cs[u][2 * q + 1];
                    const float z1 = y1[q] * c - y2[q] * sn, z2 = y1[q] * sn + y2[q] * c; y1[q] = z1; y2[q] = z2; } }
            bf16_t* p;
            if (isq) {
#pragma unroll
                for (int e = 0; e < 8; ++e) xn[e] *= QSC_A;
                y1[0] *= QSC_A; y1[1] *= QSC_A; y2[0] *= QSC_A; y2[1] *= QSC_A;
                p = Q + (size_t)r * 1536 + h * 192;
            } else p = KF + (size_t)r * 1536 + h * 192;
            *(bf16x8*)(p + 8 * sub) = pack8(xn); *(unsigned*)(p + 128 + 2 * sub) = pk2(y1[0], y1[1]); *(unsigned*)(p + 160 + 2 * sub) = pk2(y2[0], y2[1]);
        } }
    }
}

__device__ __forceinline__ void phase_fin_ab(KArgs a, int j) {
    const int tid = otid(), lane = tid & 63, wave = tid >> 6, sub = lane & 15, hq = lane >> 4;
    const int gw = obid() * NWAVES + wave, NGW = gridDim.x * NWAVES;
    const bf16_t* OF = (const bf16_t*)(a->ws + WS_OF); const bf16_t* OB = (const bf16_t*)(a->ws + WS_OB);
    const bf16_t* P = (const bf16_t*)(a->ws + WS_PROJ); bf16_t* MIX = (bf16_t*)(a->ws + WS_H);
    const float* g = a->in[21] + j * 128;
    constexpr int U = 4;
    for (int base = gw * U; base < MROWS * 2; base += NGW * U) {
        bf16x8 va[U], vb[U], vg[U];
#pragma unroll
        for (int u = 0; u < U; ++u) { const int it = base + u; const int r = it >> 1, h = (it & 1) * 4 + hq; const size_t o = (size_t)r * 1024 + h * 128 + 8 * sub;
            va[u] = *(const bf16x8*)(OF + o); vb[u] = *(const bf16x8*)(OB + o); vg[u] = *(const bf16x8*)(P + (size_t)r * LDP_AB + COL_BG + h * 128 + 8 * sub); }
#pragma unroll
        for (int u = 0; u < U; ++u) { const int it = base + u; const int r = it >> 1, h = (it & 1) * 4 + hq;
            float s[8]; float ss = 0.f;
#pragma unroll
            for (int e = 0; e < 8; ++e) { s[e] = bf2f((unsigned short)va[u][e]) + bf2f((unsigned short)vb[u][e]); ss += s[e] * s[e]; }
            const float rstd = rsqrtf(sum16(ss) * (1.f / 128.f) + EPSN);
#pragma unroll
            for (int e = 0; e < 8; ++e) s[e] = s[e] * rstd * g[8 * sub + e] * silu_f(bf2f((unsigned short)vg[u][e]));
            *(bf16x8*)(MIX + (size_t)r * DM + 1024 + h * 128 + 8 * sub) = pack8(s); }
    }
}

__device__ __forceinline__ void phase_hn_c(KArgs a, int j) {
    const int tid = otid(), lane = tid & 63, wave = tid >> 6, sub = lane & 15, hq = lane >> 4;
    const int gw = obid() * NWAVES + wave, NGW = gridDim.x * NWAVES;
    bf16_t* P = (bf16_t*)(a->ws + WS_PROJ);
    const float* RC = (const float*)(a->ws + WS_ROPEC);
    const float* gq = a->in[27] + j * 128; const float* gk = a->in[28] + j * 128;
    float* outp = a->out;
    for (int r = gw; r < MC; r += NGW) { const int b = r >> 8, t = r & 255; const bf16x8 v = *(const bf16x8*)(P + (size_t)r * LDP_C + 2560 + 8 * lane);
        float* o = outp + O_VC + (size_t)((b * 2 + j) * 256 + t) * 512 + 8 * lane;
        *(f32x4*)o = (f32x4){bf2f((unsigned short)v[0]), bf2f((unsigned short)v[1]), bf2f((unsigned short)v[2]), bf2f((unsigned short)v[3])};
        *(f32x4*)(o + 4) = (f32x4){bf2f((unsigned short)v[4]), bf2f((unsigned short)v[5]), bf2f((unsigned short)v[6]), bf2f((unsigned short)v[7])}; }
    constexpr int U = 4;
    const int NIT = MROWS;
    for (int base = gw * U; base < NIT; base += NGW * U) {
        s16x4 v1[U], v2[U]; f32x4 ca[U], cb[U];
#pragma unroll
        for (int u = 0; u < U; ++u) { const int it = base + u; if (it < NIT) {
            const int r = it, h = 16 + hq; const bool isq = false;
            const bf16_t* p = P + (size_t)r * LDP_C + (isq ? h * 128 : 2048 + (h - 16) * 128);
            v1[u] = *(const s16x4*)(p + 4 * sub); v2[u] = *(const s16x4*)(p + 64 + 4 * sub);
            if (r >= MC) { const float* rc = RC + (((r - MC) & 2047) * 64 + 4 * sub) * 2; ca[u] = *(const f32x4*)rc; cb[u] = *(const f32x4*)(rc + 4); }
        } }
#pragma unroll
        for (int u = 0; u < U; ++u) { const int it = base + u; if (it < NIT) {
            const int r = it, h = 16 + hq; const bool isq = false;
            bf16_t* p = P + (size_t)r * LDP_C + (isq ? h * 128 : 2048 + (h - 16) * 128);
            float x1[4], x2[4]; float ss = 0.f;
#pragma unroll
            for (int e = 0; e < 4; ++e) { x1[e] = bf2f((unsigned short)v1[u][e]); x2[e] = bf2f((unsigned short)v2[u][e]); ss += x1[e] * x1[e] + x2[e] * x2[e]; }
            const float rstd = rsqrtf(sum16(ss) * (1.f / 128.f) + EPSN);
            const float* g = isq ? gq : gk;
#pragma unroll
            for (int e = 0; e < 4; ++e) { x1[e] *= rstd * g[4 * sub + e]; x2[e] *= rstd * g[64 + 4 * sub + e]; }
            if (r >= MC) {
#pragma unroll
                for (int e = 0; e < 4; ++e) { const float c = e < 2 ? ca[u][2 * e] : cb[u][2 * (e - 2)], sn = e < 2 ? ca[u][2 * e + 1] : cb[u][2 * (e - 2) + 1];
                    const float y1 = x1[e] * c - x2[e] * sn, y2 = x1[e] * sn + x2[e] * c; x1[e] = y1; x2[e] = y2; } }
            else if (!isq) { const int b = r >> 8, t = r & 255; float* o = outp + O_KC + (size_t)((b * 2 + j) * 256 + t) * 512 + (h - 16) * 128;
                *(f32x4*)(o + 4 * sub) = (f32x4){x1[0], x1[1], x1[2], x1[3]}; *(f32x4*)(o + 64 + 4 * sub) = (f32x4){x2[0], x2[1], x2[2], x2[3]}; }
            if (isq) {
#pragma unroll
                for (int e = 0; e < 4; ++e) { x1[e] *= QSC_C; x2[e] *= QSC_C; } }
            u32x2 w1, w2; w1.x = pk2(x1[0], x1[1]); w1.y = pk2(x1[2], x1[3]); w2.x = pk2(x2[0], x2[1]); w2.y = pk2(x2[2], x2[3]);
            *(u32x2*)(p + 4 * sub) = w1; *(u32x2*)(p + 64 + 4 * sub) = w2;
        } }
    }
}

namespace att {
__device__ __forceinline__ int crow(int r, int hi) { return (r & 3) + 8 * (r >> 2) + 4 * hi; }
__device__ __forceinline__ unsigned cvtpk(float lo, float hi) { return pk2(lo, hi); }
__device__ __forceinline__ int v_st(int k, int c) { const int kk = (k & ~0xC) | ((k & 4) << 1) | ((k & 8) >> 1); return ((kk >> 3) * 4 + (c >> 5)) * 512 + ((kk & 7) * 32 + (c & 31)) * 2; }
__device__ __forceinline__ int v_rd_base(int lane) { return ((lane & 3) << 3) | (((lane >> 2) & 3) << 6) | (((lane >> 4) & 1) << 5) | (((lane >> 5) & 1) << 8); }
constexpr int v_rd_off(int d0, int ks, int half) { return d0 * 512 + ks * 4096 + half * 2048; }
template <int OFF> __device__ __forceinline__ s16x4 tr_read(int vb) {
    s16x4 r; asm volatile("ds_read_b64_tr_b16 %0, %1 offset:%2" : "=&v"(r) : "v"(vb), "i"(OFF) : "memory"); return r;
}
template <int D0> __device__ __forceinline__ void pv_read8(s16x4 (&r)[8], int vb) {
    r[0] = tr_read<v_rd_off(D0, 0, 0)>(vb); r[1] = tr_read<v_rd_off(D0, 0, 1)>(vb); r[2] = tr_read<v_rd_off(D0, 1, 0)>(vb); r[3] = tr_read<v_rd_off(D0, 1, 1)>(vb);
    r[4] = tr_read<v_rd_off(D0, 2, 0)>(vb); r[5] = tr_read<v_rd_off(D0, 2, 1)>(vb); r[6] = tr_read<v_rd_off(D0, 3, 0)>(vb); r[7] = tr_read<v_rd_off(D0, 3, 1)>(vb);
}
__device__ __forceinline__ void pv_mma4(f32x16& od, const s16x4 (&r)[8], bf16x8 pa0, bf16x8 pa1, bf16x8 pa2, bf16x8 pa3) {
#define ATT_PK(L, H) (bf16x8){L[0], L[1], L[2], L[3], H[0], H[1], H[2], H[3]}
    od = __builtin_amdgcn_mfma_f32_32x32x16_bf16(pa0, ATT_PK(r[0], r[1]), od, 0, 0, 0);
    od = __builtin_amdgcn_mfma_f32_32x32x16_bf16(pa1, ATT_PK(r[2], r[3]), od, 0, 0, 0);
    od = __builtin_amdgcn_mfma_f32_32x32x16_bf16(pa2, ATT_PK(r[4], r[5]), od, 0, 0, 0);
    od = __builtin_amdgcn_mfma_f32_32x32x16_bf16(pa3, ATT_PK(r[6], r[7]), od, 0, 0, 0);
#undef ATT_PK
}
__device__ __forceinline__ void pv_all(f32x16 (&o)[4], int vb, bf16x8 pa0, bf16x8 pa1, bf16x8 pa2, bf16x8 pa3) {
    s16x4 ra[8], rb[8];
    pv_read8<0>(ra, vb);
    pv_read8<1>(rb, vb); asm volatile("s_waitcnt lgkmcnt(8)" ::: "memory"); __builtin_amdgcn_sched_barrier(0);
    pv_mma4(o[0], ra, pa0, pa1, pa2, pa3); __builtin_amdgcn_sched_barrier(0);
    pv_read8<2>(ra, vb); asm volatile("s_waitcnt lgkmcnt(8)" ::: "memory"); __builtin_amdgcn_sched_barrier(0);
    pv_mma4(o[1], rb, pa0, pa1, pa2, pa3); __builtin_amdgcn_sched_barrier(0);
    pv_read8<3>(rb, vb); asm volatile("s_waitcnt lgkmcnt(8)" ::: "memory"); __builtin_amdgcn_sched_barrier(0);
    pv_mma4(o[2], ra, pa0, pa1, pa2, pa3); __builtin_amdgcn_sched_barrier(0);
    asm volatile("s_waitcnt lgkmcnt(0)" ::: "memory"); __builtin_amdgcn_sched_barrier(0);
    pv_mma4(o[3], rb, pa0, pa1, pa2, pa3);
}
struct Item {
    const bf16_t* Q; int ldq;
    const bf16_t* K0; const bf16_t* V0; int n0;
    const bf16_t* K1; const bf16_t* V1; int ldk, ldv, t_lo, t_hi;
    int q0, band; float m0, l0;
    const float* qg; const float* rope; float qscale;
    const bf16_t* G; int ldg; bf16_t* O; int ldo;
};
template <int DQK>
__device__ __forceinline__ void attn_item(LAS unsigned char* lds, const Item& it) {
    constexpr int KROW = DQK * 2, SHM_K = 64 * KROW, SHM_V = 64 * 128 * 2, ND = DQK / 16;
    const int tid = otid(), wid = tid >> 6, lane = tid & 63, r32 = lane & 31, hi = lane >> 5;
    LAS unsigned char* V_lds = lds; LAS unsigned char* K_lds = lds + 3 * SHM_V;
    LAS float* wsx = (LAS float*)(lds + 3 * SHM_V + 3 * SHM_K) + wid * 64; LAS float* li_l = wsx; LAS float* al_l = wsx + 32;
    float m_reg = it.m0, l_reg = it.l0;
    f32x16 o[4];
#pragma unroll
    for (int d = 0; d < 4; ++d)
#pragma unroll
        for (int r = 0; r < 16; ++r) o[d][r] = 0.f;
    bf16x8 qr[ND];
    {
      const bf16_t* Qw = it.Q + (size_t)(wid * 32 + r32) * it.ldq + hi * 8;
      float xf[ND][8]; float ss = 0.f;
#pragma unroll
      for (int d0 = 0; d0 < ND; ++d0) { const bf16x8 v = *(const bf16x8*)(Qw + d0 * 16);
#pragma unroll
          for (int e = 0; e < 8; ++e) { xf[d0][e] = bf2f((unsigned short)v[e]); ss += xf[d0][e] * xf[d0][e]; } }
      ss += __shfl_xor(ss, 32);
      const float rstd = rsqrtf(ss * (1.f / (float)DQK) + EPSN);
#pragma unroll
      for (int d0 = 0; d0 < ND; ++d0) { const f32x4 g0 = *(const f32x4*)(it.qg + d0 * 16 + hi * 8), g1 = *(const f32x4*)(it.qg + d0 * 16 + hi * 8 + 4);
#pragma unroll
          for (int e = 0; e < 8; ++e) xf[d0][e] *= rstd * (e < 4 ? g0[e & 3] : g1[e & 3]); }
      if (it.rope) { constexpr int NR = DQK == 128 ? 4 : 2, RB = DQK == 128 ? 0 : 8, RS = DQK == 128 ? 64 : 32;
          const float* rp = it.rope + (size_t)((it.q0 + wid * 32 + r32) * RS + hi * 8) * 2;
#pragma unroll
          for (int p = 0; p < NR; ++p) { f32x4 cs4[4];
#pragma unroll
              for (int q = 0; q < 4; ++q) cs4[q] = *(const f32x4*)(rp + p * 32 + 4 * q);
#pragma unroll
              for (int e = 0; e < 8; ++e) { const float c = cs4[e >> 1][(e & 1) * 2], sn = cs4[e >> 1][(e & 1) * 2 + 1];
                  const float x1 = xf[RB + p][e], x2 = xf[RB + NR + p][e]; xf[RB + p][e] = x1 * c - x2 * sn; xf[RB + NR + p][e] = x1 * sn + x2 * c; } } }
#pragma unroll
      for (int d0 = 0; d0 < ND; ++d0) { float t8[8];
#pragma unroll
          for (int e = 0; e < 8; ++e) t8[e] = xf[d0][e] * it.qscale;
          qr[d0] = pack8(t8); } }
    const int NT = it.n0 + (it.t_hi - it.t_lo);
    const int wvu = __builtin_amdgcn_readfirstlane(wid);
    const int vb0 = (int)(uintptr_t)V_lds + v_rd_base(lane);
    constexpr int NKI = SHM_K / 8192;
    unsigned kog[NKI], vog[2];
#pragma unroll
    for (int i = 0; i < NKI; ++i) { const int off = i * 8192 + wid * 1024 + lane * 16, row = off / KROW, pos = off % KROW; kog[i] = (unsigned)(row * it.ldk + ((pos ^ ((row & 7) << 4)) >> 1)); }
#pragma unroll
    for (int i = 0; i < 2; ++i) { const int q = (i * 8192 + wid * 1024 + lane * 16) >> 4, sub = q >> 5, rem = q & 31, rowin = rem >> 2, cch = rem & 3;
        const int kk = (sub >> 2) * 8 + rowin; vog[i] = (unsigned)(((kk & ~0xC) | ((kk & 4) << 1) | ((kk & 8) >> 1)) * it.ldv + (sub & 3) * 32 + cch * 8); }
    int koff[4];
#pragma unroll
    for (int dl = 0; dl < 4; ++dl) koff[dl] = r32 * KROW + ((dl * 32 + hi * 16) ^ ((r32 & 7) << 4));
#define ATT_STAGE(jj, b) do { const int _j = (jj); const bool _s0 = _j < it.n0; const int _t = _s0 ? _j : it.t_lo + (_j - it.n0); \
        const bf16_t* _Kp = (_s0 ? it.K0 : it.K1) + (size_t)(64 * _t) * it.ldk; const bf16_t* _Vp = (_s0 ? it.V0 : it.V1) + (size_t)(64 * _t) * it.ldv; \
        _Pragma("unroll") for (int _i = 0; _i < NKI; ++_i) __builtin_amdgcn_global_load_lds((const unsigned*)(_Kp + kog[_i]), (LAS unsigned*)(K_lds + (b) * SHM_K + _i * 8192 + wvu * 1024), 16, 0, 0); \
        _Pragma("unroll") for (int _i = 0; _i < 2; ++_i) __builtin_amdgcn_global_load_lds((const unsigned*)(_Vp + vog[_i]), (LAS unsigned*)(V_lds + (b) * SHM_V + _i * 8192 + wvu * 1024), 16, 0, 0); } while (0)
#define ATT_WAIT_TILE(more) do { if (more) { if constexpr (NKI == 3) asm volatile("s_waitcnt vmcnt(5)" ::: "memory"); else asm volatile("s_waitcnt vmcnt(4)" ::: "memory"); } \
        else asm volatile("s_waitcnt vmcnt(0)" ::: "memory"); \
        asm volatile("s_waitcnt lgkmcnt(0)" ::: "memory"); __builtin_amdgcn_s_barrier(); asm volatile("" ::: "memory"); } while (0)
    ATT_STAGE(0, 0); if (NT > 1) ATT_STAGE(1, 1);
    ATT_WAIT_TILE(NT > 1);
    int cur = 0;
    for (int j = 0; j < NT; ++j) {
        if (j + 2 < NT) ATT_STAGE(j + 2, (cur == 0 ? 2 : cur - 1));
        bool act = true; const bool domask = it.band && j >= it.n0; int kpos0 = 0;
        if (domask) { kpos0 = 64 * (it.t_lo + j - it.n0); const int qlo = it.q0 + wid * 32; act = (kpos0 + 63 >= qlo - 128) && (kpos0 <= qlo + 31 + 128); }
        if (act) {
            f32x16 p0, p1;
#pragma unroll
            for (int r = 0; r < 16; ++r) { p0[r] = 0.f; p1[r] = 0.f; }
            const LAS unsigned char* Ks = K_lds + cur * SHM_K;
            {
                constexpr int NG = ND / 4;
                bf16x8 kf[2][8];
#define ATT_LOADG(g_, dst) do { _Pragma("unroll") for (int u_ = 0; u_ < 4; ++u_) { dst[2 * u_] = *(const LAS bf16x8*)(Ks + koff[u_] + (g_) * 128); dst[2 * u_ + 1] = *(const LAS bf16x8*)(Ks + koff[u_] + (g_) * 128 + 32 * KROW); } } while (0)
                ATT_LOADG(0, kf[0]);
#pragma unroll
                for (int g = 0; g < NG; ++g) {
                    if (g + 1 < NG) ATT_LOADG(g + 1, kf[(g + 1) & 1]);
                    __builtin_amdgcn_sched_barrier(0);
#pragma unroll
                    for (int u_ = 0; u_ < 4; ++u_) { p0 = __builtin_amdgcn_mfma_f32_32x32x16_bf16(kf[g & 1][2 * u_], qr[4 * g + u_], p0, 0, 0, 0);
                        p1 = __builtin_amdgcn_mfma_f32_32x32x16_bf16(kf[g & 1][2 * u_ + 1], qr[4 * g + u_], p1, 0, 0, 0); }
                    __builtin_amdgcn_sched_barrier(0); }
#undef ATT_LOADG
            }
            if (domask) { const int qp = it.q0 + wid * 32 + r32;
#pragma unroll
                for (int r = 0; r < 16; ++r) { const int d = kpos0 + crow(r, hi) - qp;
                    if (d > 128 || d < -128) p0[r] = -1e30f;
                    if (d + 32 > 128 || d + 32 < -128) p1[r] = -1e30f; } }
            float pmax = p0[0];
#pragma unroll
            for (int r = 1; r < 16; ++r) pmax = fmaxf(pmax, p0[r]);
#pragma unroll
            for (int r = 0; r < 16; ++r) pmax = fmaxf(pmax, p1[r]);
            { auto rr = __builtin_amdgcn_permlane32_swap(__float_as_uint(pmax), __float_as_uint(pmax), false, false);
              pmax = fmaxf(__uint_as_float(rr[0]), __uint_as_float(rr[1])); }
            const float mn = fmaxf(m_reg, pmax); const float alpha = __builtin_amdgcn_exp2f(m_reg - mn); m_reg = mn;
            float ps = 0.f;
#pragma unroll
            for (int r = 0; r < 16; ++r) { p0[r] = __builtin_amdgcn_exp2f(p0[r] - mn); p1[r] = __builtin_amdgcn_exp2f(p1[r] - mn); ps += p0[r] + p1[r]; }
            { auto rr = __builtin_amdgcn_permlane32_swap(__float_as_uint(ps), __float_as_uint(ps), false, false);
              ps = __uint_as_float(rr[0]) + __uint_as_float(rr[1]); }
            l_reg = l_reg * alpha + ps;
            bf16x8 pa0, pa1, pa2, pa3;
#define ATT_PK4(P, BASE, OUT) do { unsigned a0 = cvtpk(P[BASE + 0], P[BASE + 1]), a1 = cvtpk(P[BASE + 2], P[BASE + 3]);   \
    unsigned b0 = cvtpk(P[BASE + 4], P[BASE + 5]), b1 = cvtpk(P[BASE + 6], P[BASE + 7]);                              \
    auto r0 = __builtin_amdgcn_permlane32_swap(a0, b0, false, false); auto r1 = __builtin_amdgcn_permlane32_swap(a1, b1, false, false); \
    u32x4 w = {r0[0], r1[0], r0[1], r1[1]}; OUT = __builtin_bit_cast(bf16x8, w); } while (0)
            ATT_PK4(p0, 0, pa0); ATT_PK4(p0, 8, pa1); ATT_PK4(p1, 0, pa2); ATT_PK4(p1, 8, pa3);
#undef ATT_PK4
            if (__any(alpha < 1.f)) { if (hi == 0) al_l[r32] = alpha; asm volatile("s_waitcnt lgkmcnt(0)" ::: "memory");
#pragma unroll
                for (int r = 0; r < 16; ++r) { const float al = al_l[crow(r, hi)];
#pragma unroll
                    for (int d = 0; d < 4; ++d) o[d][r] *= al; } }
            const int vb = vb0 + cur * SHM_V;
            pv_all(o, vb, pa0, pa1, pa2, pa3);
        }
        ATT_WAIT_TILE(j + 2 < NT);
        cur = cur == 2 ? 0 : cur + 1;
    }
#undef ATT_STAGE
#undef ATT_WAIT_TILE
    const int er = lane >> 4, ec = (lane & 15) * 8;
    bf16x8 gv[8];
    { const bf16_t* Gw = it.G + (size_t)(wid * 32 + er) * it.ldg + ec;
#pragma unroll
      for (int c = 0; c < 8; ++c) gv[c] = *(const bf16x8*)(Gw + (size_t)(4 * c) * it.ldg); }
    if (hi == 0) li_l[r32] = l_reg; asm volatile("s_waitcnt lgkmcnt(0)" ::: "memory");
    LAS bf16_t* ost = (LAS bf16_t*)(lds + wid * 8192);
#pragma unroll
    for (int r = 0; r < 16; ++r) { const float rli = 1.f / li_l[crow(r, hi)];
#pragma unroll
        for (int d0 = 0; d0 < 4; ++d0) ost[crow(r, hi) * 128 + d0 * 32 + r32] = (bf16_t)f2bf(o[d0][r] * rli); }
    asm volatile("s_waitcnt lgkmcnt(0)" ::: "memory");
    { bf16_t* Ow = it.O + (size_t)(wid * 32 + er) * it.ldo + ec;
#pragma unroll
      for (int c = 0; c < 8; ++c) { const bf16x8 ov = *(const LAS bf16x8*)(ost + (4 * c + er) * 128 + ec); float t8[8];
#pragma unroll
          for (int e = 0; e < 8; ++e) t8[e] = bf2f((unsigned short)ov[e]) * silu_f(bf2f((unsigned short)gv[c][e]));
          *(bf16x8*)(Ow + (size_t)(4 * c) * it.ldo) = pack8(t8); } }
    __syncthreads();
}
}

__device__ __forceinline__ void hgrn_item(LAS unsigned char* lds, const bf16_t* PROJ, int rowbase, int T, int h, int dir,
                                          const float* lb, const float* s0, float* sout, bf16_t* OUT, int c0, int c1, float* sbuf) {
    LAS float* GS = (LAS float*)lds;
    LAS float* DEC = (LAS float*)(lds + 2048);
    LAS bf16_t* QT = (LAS bf16_t*)(lds + 2560);
    LAS bf16_t* KT = QT + 32 * 136;
    LAS bf16_t* KTt = KT + 32 * 136;
    LAS bf16_t* Vt = KTt + 128 * 40;
    const int tid = otid(), wid = tid >> 6, lane = tid & 63, fr = lane & 15, fq = lane >> 4;
    const int c2 = tid & 127, part = tid >> 7, n0 = wid * 16;
    f32x4 S[8];
    { const float* sin_ = c0 > 0 ? sbuf : (s0 ? s0 : sbuf);
      const float ssc = (c0 > 0 || s0) ? 1.f : 0.f;
#pragma unroll
      for (int kt = 0; kt < 8; ++kt)
#pragma unroll
          for (int r = 0; r < 4; ++r) S[kt][r] = sin_[(size_t)(16 * kt + 4 * fq + r) * 128 + n0 + fr] * ssc; }
    __builtin_amdgcn_s_waitcnt(0x0F70);
    const float oml = 1.f - lb[c2];
    const unsigned hz = ozero();
    const int nch = T / 32;
    LAS unsigned char* RAW = lds + 40960;
    const int wvu = __builtin_amdgcn_readfirstlane(wid);
    const int dtl = 4 * wid + (lane >> 4), dch = (lane & 15) * 8;
    const bf16_t* dsrc = PROJ + h * 128 + dch;
    const int colf = dir ? COL_FB : COL_FF;
#define HG_DMA(cc, slot) do { const int _p = 32 * (cc) + dtl; const int _tok = dir ? T - 1 - _p : _p; const bf16_t* _s = dsrc + (size_t)(rowbase + _tok) * LDP_AB; \
        __builtin_amdgcn_global_load_lds((const unsigned*)(_s + COL_BQ), (LAS unsigned*)(RAW + (slot) * 24576 + wvu * 1024), 16, 0, 0); \
        __builtin_amdgcn_global_load_lds((const unsigned*)(_s + colf), (LAS unsigned*)(RAW + (slot) * 24576 + 8192 + wvu * 1024), 16, 0, 0); \
        __builtin_amdgcn_global_load_lds((const unsigned*)(_s + COL_BI), (LAS unsigned*)(RAW + (slot) * 24576 + 16384 + wvu * 1024), 16, 0, 0); } while (0)
#define HG_BAR() do { asm volatile("s_waitcnt lgkmcnt(0)" ::: "memory"); __builtin_amdgcn_s_barrier(); asm volatile("" ::: "memory"); } while (0)
    HG_DMA(c0, 0); if (c0 + 1 < c1) HG_DMA(c0 + 1, 1);
    if (c0 + 1 < c1) asm volatile("s_waitcnt vmcnt(3)" ::: "memory"); else asm volatile("s_waitcnt vmcnt(0)" ::: "memory");
    HG_BAR();
    int cur = 0;
    for (int cc = c0; cc < c1; ++cc) {
        if (cc + 2 < c1) HG_DMA(cc + 2, (cur == 0 ? 2 : cur - 1));
        float b[8], kk[8], sq[8]; unsigned short vv[8];
        { const LAS bf16_t* rw = (const LAS bf16_t*)(RAW + cur * 24576) + (8 * part) * 128 + c2;
            unsigned short rq[8], rf[8];
#pragma unroll
            for (int i = 0; i < 8; ++i) { rq[i] = rw[i * 128]; rf[i] = rw[4096 + i * 128]; vv[i] = rw[8192 + i * 128]; }
            float run = 0.f;
#pragma unroll
            for (int i = 0; i < 8; ++i) { const float x = bf2f(rf[i]); const float omf = oml * __builtin_amdgcn_rcpf(1.f + __expf(x));
                const float lf = fmaxf(__logf(1.f - omf), -30.f); run += lf; b[i] = run; kk[i] = omf; sq[i] = silu_f(bf2f(rq[i])); }
            GS[part * 128 + c2] = run; }
        HG_BAR();
        { float off = 0.f;
#pragma unroll
            for (int p = 0; p < 3; ++p) if (p < part) off += GS[p * 128 + c2];
            float kt_[8];
#pragma unroll
            for (int i = 0; i < 8; ++i) { const float bb = b[i] + off; const int t = 8 * part + i;
                const float qv = sq[i] * __expf(bb); kt_[i] = kk[i] * __expf(fminf(-bb, 80.f));
                QT[t * 136 + c2] = (bf16_t)f2bf(qv); KT[t * 136 + c2] = (bf16_t)f2bf(kt_[i]);
                if (i == 7 && part == 3) DEC[c2] = __expf(bb); }
            *(LAS bf16x8*)(KTt + c2 * 40 + 8 * part) = pack8(kt_);
            u32x4 wv; wv.x = (unsigned)vv[0] | ((unsigned)vv[1] << 16); wv.y = (unsigned)vv[2] | ((unsigned)vv[3] << 16); wv.z = (unsigned)vv[4] | ((unsigned)vv[5] << 16); wv.w = (unsigned)vv[6] | ((unsigned)vv[7] << 16);
            *(LAS u32x4*)(Vt + c2 * 40 + 8 * part) = wv; }
        if (cc + 2 < c1) { if (cc > c0) asm volatile("s_waitcnt vmcnt(11)" ::: "memory"); else asm volatile("s_waitcnt vmcnt(3)" ::: "memory"); }
        else asm volatile("s_waitcnt vmcnt(0)" ::: "memory");
        HG_BAR();
        f32x4 pt00 = {0.f, 0.f, 0.f, 0.f}, pt01 = pt00, pt11 = pt00;
#pragma unroll
        for (int ks = 0; ks < 4; ++ks) {
            const bf16x8 a0 = *(const LAS bf16x8*)(KT + fr * 136 + 32 * ks + 8 * fq), a1 = *(const LAS bf16x8*)(KT + (16 + fr) * 136 + 32 * ks + 8 * fq);
            const bf16x8 b0 = *(const LAS bf16x8*)(QT + fr * 136 + 32 * ks + 8 * fq), b1 = *(const LAS bf16x8*)(QT + (16 + fr) * 136 + 32 * ks + 8 * fq);
            pt00 = __builtin_amdgcn_mfma_f32_16x16x32_bf16(a0, b0, pt00, 0, 0, 0);
            pt01 = __builtin_amdgcn_mfma_f32_16x16x32_bf16(a0, b1, pt01, 0, 0, 0);
            pt11 = __builtin_amdgcn_mfma_f32_16x16x32_bf16(a1, b1, pt11, 0, 0, 0); }
#pragma unroll
        for (int r = 0; r < 4; ++r) { if (4 * fq + r > fr) { pt00[r] = 0.f; pt11[r] = 0.f; } }
        u32x4 wA0, wA1;
        wA0.x = pk2(pt00[0], pt00[1]); wA0.y = pk2(pt00[2], pt00[3]); wA0.z = hz; wA0.w = hz;
        wA1.x = pk2(pt01[0], pt01[1]); wA1.y = pk2(pt01[2], pt01[3]); wA1.z = pk2(pt11[0], pt11[1]); wA1.w = pk2(pt11[2], pt11[3]);
        const u32x2 vlo = *(const LAS u32x2*)(Vt + (n0 + fr) * 40 + 4 * fq), vhi = *(const LAS u32x2*)(Vt + (n0 + fr) * 40 + 16 + 4 * fq);
        const u32x4 wV = {vlo.x, vlo.y, vhi.x, vhi.y};
        f32x4 o0 = {0.f, 0.f, 0.f, 0.f}, o1 = o0;
        o0 = __builtin_amdgcn_mfma_f32_16x16x32_bf16(__builtin_bit_cast(bf16x8, wA0), __builtin_bit_cast(bf16x8, wV), o0, 0, 0, 0);
        o1 = __builtin_amdgcn_mfma_f32_16x16x32_bf16(__builtin_bit_cast(bf16x8, wA1), __builtin_bit_cast(bf16x8, wV), o1, 0, 0, 0);
#pragma unroll
        for (int aa = 0; aa < 4; ++aa) {
            u32x4 wS; wS.x = pk2(S[2 * aa][0], S[2 * aa][1]); wS.y = pk2(S[2 * aa][2], S[2 * aa][3]); wS.z = pk2(S[2 * aa + 1][0], S[2 * aa + 1][1]); wS.w = pk2(S[2 * aa + 1][2], S[2 * aa + 1][3]);
            const u32x2 q0l = *(const LAS u32x2*)(QT + fr * 136 + 32 * aa + 4 * fq), q0h = *(const LAS u32x2*)(QT + fr * 136 + 32 * aa + 16 + 4 * fq);
            const u32x2 q1l = *(const LAS u32x2*)(QT + (16 + fr) * 136 + 32 * aa + 4 * fq), q1h = *(const LAS u32x2*)(QT + (16 + fr) * 136 + 32 * aa + 16 + 4 * fq);
            const u32x4 wQ0 = {q0l.x, q0l.y, q0h.x, q0h.y}, wQ1 = {q1l.x, q1l.y, q1h.x, q1h.y};
            o0 = __builtin_amdgcn_mfma_f32_16x16x32_bf16(__builtin_bit_cast(bf16x8, wQ0), __builtin_bit_cast(bf16x8, wS), o0, 0, 0, 0);
            o1 = __builtin_amdgcn_mfma_f32_16x16x32_bf16(__builtin_bit_cast(bf16x8, wQ1), __builtin_bit_cast(bf16x8, wS), o1, 0, 0, 0); }
        { const bf16x8 vn = *(const LAS bf16x8*)(Vt + (n0 + fr) * 40 + 8 * fq);
#pragma unroll
            for (int kt = 0; kt < 8; ++kt) { const bf16x8 ka = *(const LAS bf16x8*)(KTt + (16 * kt + fr) * 40 + 8 * fq);
                S[kt] = __builtin_amdgcn_mfma_f32_16x16x32_bf16(ka, vn, S[kt], 0, 0, 0);
                const f32x4 d = *(const LAS f32x4*)(DEC + 16 * kt + 4 * fq); S[kt] = S[kt] * d; } }
#pragma unroll
        for (int r = 0; r < 4; ++r) {
            const int i0 = 4 * fq + r, i1 = 16 + 4 * fq + r;
            const int tok0 = dir ? T - 1 - (32 * cc + i0) : 32 * cc + i0, tok1 = dir ? T - 1 - (32 * cc + i1) : 32 * cc + i1;
            OUT[(size_t)(rowbase + tok0) * 1024 + h * 128 + n0 + fr] = (bf16_t)f2bf(o0[r]);
            OUT[(size_t)(rowbase + tok1) * 1024 + h * 128 + n0 + fr] = (bf16_t)f2bf(o1[r]); }
        cur = cur == 2 ? 0 : cur + 1;
    }
#undef HG_DMA
#undef HG_BAR
    { float* so_ = c1 < nch ? sbuf : sout;
      if (so_) {
#pragma unroll
        for (int kt = 0; kt < 8; ++kt)
#pragma unroll
            for (int r = 0; r < 4; ++r) so_[(size_t)(16 * kt + 4 * fq + r) * 128 + n0 + fr] = S[kt][r]; } }
    __syncthreads();
}

__device__ __forceinline__ int fetch_item(unsigned* ctr, LAS int* slot) {
    __syncthreads();
    if (otid() == 0) *slot = (int)atomicAdd(ctr, 1u);
    __syncthreads();
    return __builtin_amdgcn_readfirstlane(*slot);
}

#define XB_TMO      128
#define XB_XCNT(j)  (256  + 64 * (j))
#define XB_XSUB(j)  (1280 + 64 * (j))
#define XB_XGEN(j)  (2304 + 64 * (j))
#define XB_TOP      3328
#define XB_TOPGEN   3392
#define XCD_BAR_WORDS 3456
#define XB_SPIN_CAP (1u << 18)

__device__ __forceinline__ unsigned xb_ld(unsigned* p)              { return __hip_atomic_load(p, __ATOMIC_RELAXED, __HIP_MEMORY_SCOPE_AGENT); }
__device__ __forceinline__ unsigned xb_add(unsigned* p, unsigned v) { return __hip_atomic_fetch_add(p, v, __ATOMIC_RELAXED, __HIP_MEMORY_SCOPE_AGENT); }
__device__ __forceinline__ unsigned xb_xcc_id() { return (unsigned)__builtin_amdgcn_s_getreg((3 << 11) | 20) & 0xFu; }
#define XB_SPIN(cond, bar) do { unsigned _sp = 0; while (cond) { __builtin_amdgcn_s_sleep(1); \
    if ((++_sp & 255u) == 0u) { if (xb_ld(&(bar)[XB_TMO])) break; if (_sp > XB_SPIN_CAP) { atomicAdd(&(bar)[XB_TMO], 1u); break; } } } } while (0)

struct XcdBarrier {
    unsigned* bar; unsigned x;
    volatile LAS unsigned* st;
};

__device__ __forceinline__ XcdBarrier xcd_barrier_post(unsigned* bar, volatile LAS unsigned* st) {
    XcdBarrier b; b.bar = bar; b.x = xb_xcc_id(); b.st = st;
    if (threadIdx.x == 0) (void)xb_add(&bar[XB_XCNT(b.x)], 1u);
    return b;
}
__device__ __forceinline__ void xcd_barrier_complete(unsigned* bar, unsigned x, unsigned& nloc, unsigned& nx) {
    const unsigned G = gridDim.x * gridDim.y * gridDim.z;
    unsigned sum, cnt, mine, sp = 0u;
    for (;;) {
        sum = 0u; cnt = 0u; mine = 0u;
#pragma unroll
        for (unsigned j = 0; j < 16; ++j) { const unsigned c = xb_ld(&bar[XB_XCNT(j)]); sum += c; cnt += (c > 0u) ? 1u : 0u; mine = (j == x) ? c : mine; }
        if (sum == G) break;
        __builtin_amdgcn_s_sleep(1);
        if ((++sp & 255u) == 0u) { if (xb_ld(&bar[XB_TMO])) break; if (sp > XB_SPIN_CAP) { atomicAdd(&bar[XB_TMO], 1u); break; } }
    }
    nloc = mine > 0u ? mine : 1u; nx = cnt > 0u ? cnt : 1u;
}

__device__ __forceinline__ void xcd_barrier(const XcdBarrier& b) {
    asm volatile("s_waitcnt vmcnt(0)" ::: "memory");
    __syncthreads();
    if (threadIdx.x == 0) {
        unsigned* bar = b.bar;
        __builtin_amdgcn_s_waitcnt(0);
        unsigned nloc = b.st[0], nx = b.st[1];
        if (nloc == 0u) { xcd_barrier_complete(bar, b.x, nloc, nx); b.st[0] = nloc; b.st[1] = nx; }
        const unsigned old = xb_add(&bar[XB_XSUB(b.x)], 1u);
        const unsigned gen = old / nloc;
        if (old + 1u == (gen + 1u) * nloc) {
            __builtin_amdgcn_fence(__ATOMIC_RELEASE, "agent");
            asm volatile("s_waitcnt vmcnt(0)" ::: "memory");
            const unsigned og = xb_add(&bar[XB_TOP], 1u);
            const unsigned tg = og / nx;
            if (og + 1u == (tg + 1u) * nx) xb_add(&bar[XB_TOPGEN], 1u);
            else XB_SPIN(xb_ld(&bar[XB_TOPGEN]) == tg, bar);
            __builtin_amdgcn_fence(__ATOMIC_ACQUIRE, "agent");
            xb_add(&bar[XB_XGEN(b.x)], 1u);
            asm volatile("s_waitcnt vmcnt(0)" ::: "memory");
        } else {
            XB_SPIN(xb_ld(&bar[XB_XGEN(b.x)]) == gen, bar);
            __builtin_amdgcn_fence(__ATOMIC_ACQUIRE, "agent");
            asm volatile("s_waitcnt vmcnt(0)" ::: "memory");
        }
    }
    __syncthreads();
}

#ifndef BG_C1
#define BG_C1 4
#define BG_C2 12
#define BG_C3 16
#endif
enum { K_FINAL = 12, K_P0 = 0, K_MODNORM, K_GEMM_IN, K_PREP_AB, K_GEMM_QUP, K_GEMM_KVUP, K_HN_AB, K_MIX_AB, K_FIN_AB, K_GEMM_OUT, K_HN_C, K_ATTN_C };

__global__ void __launch_bounds__(NTHR, 2) mk_fwd(Args a_byval) {
    extern __shared__ __attribute__((aligned(16))) unsigned char lds_raw[];
    LAS unsigned char* lds = (LAS unsigned char*)lds_raw;
    LAS int* slot = (LAS int*)(lds + LDS_PHASE);
    cg::grid_group grid = cg::this_grid();
    const int G = gridDim.x;
    volatile LAS unsigned* bst = (volatile LAS unsigned*)(lds + LDS_PHASE + 64);
    if (threadIdx.x < 2) bst[threadIdx.x] = 0u;
    __syncthreads();
    (void)xcd_barrier_post((unsigned*)(a_byval.ws + WS_CTL) + 8192, bst);

#ifndef PROBE_TSEL
#define PROBE_TSEL 0
#endif
    unsigned long long t_acc = 0ull;
    for (int step = 0; step < 30; ++step) {
        unsigned long long t_begin = 0ull; if (PROBE_TSEL) t_begin = __builtin_amdgcn_s_memrealtime();
        asm volatile("" : "+s"(step));
        KArgs a = (KArgs)__builtin_amdgcn_kernarg_segment_ptr();
        asm volatile("" : "+s"(a));
        unsigned char* ws = a->ws;
        unsigned* ctl = (unsigned*)(ws + WS_CTL);
        XcdBarrier xbar; xbar.bar = ctl + 8192; xbar.x = xb_xcc_id(); xbar.st = (volatile LAS unsigned*)(lds + LDS_PHASE + 64);
        int kind, L = 0; bool sync_after = true;
        if (step == 0) kind = K_P0;
        else if (step == 29) { kind = K_FINAL; L = 4; }
        else { const int s = step - 1, pair = s / 14, r = s % 14;
            if (r < 9) { L = 2 * pair; kind = r == 0 ? K_MODNORM : r == 1 ? K_GEMM_IN : r == 2 ? K_PREP_AB : r == 3 ? K_GEMM_QUP : r == 4 ? K_GEMM_KVUP : r == 5 ? K_HN_AB : r == 6 ? K_MIX_AB : r == 7 ? K_FIN_AB : K_GEMM_OUT; }
            else { L = 2 * pair + 1; const int q = r - 9; kind = q == 0 ? K_MODNORM : q == 1 ? K_GEMM_IN : q == 2 ? K_HN_C : q == 3 ? K_ATTN_C : K_GEMM_OUT; } }
        const int j = L >> 1; const bool isC = (L & 1) != 0;
        if (kind == K_GEMM_QUP) sync_after = false;
        if (step == 29) sync_after = false;

#ifndef PROBE_MASK
#define PROBE_MASK 0
#endif
#ifndef PROBE_SEL
#define PROBE_SEL 0
#endif
#ifndef PROBE_REPS
#define PROBE_REPS 2
#endif
        const int nrep = (((PROBE_MASK >> kind) & 1) && (kind != K_GEMM_OUT || L == 0)) ? 1 + PROBE_REPS : 1;
        for (int rep = 0; rep < nrep; ++rep) {
        if (PROBE_MASK == 0x1000) { for (int q = 0; q < 2; ++q) xcd_barrier(xbar); }
        const int bid = obid();
        const bool bgphase = kind == K_PREP_AB || kind == K_GEMM_QUP || kind == K_GEMM_KVUP || kind == K_HN_AB;
        if (rep == 0 && bid < NBG && (kind == K_PREP_AB || kind == K_GEMM_QUP || kind == K_HN_AB || kind == K_MIX_AB)) {
            const int b = bid >> 4, h = (bid >> 1) & 7, dir = bid & 1;
            const int c0 = kind == K_PREP_AB ? 0 : kind == K_GEMM_QUP ? BG_C1 : kind == K_HN_AB ? BG_C2 : BG_C3;
            const int c1 = kind == K_PREP_AB ? BG_C1 : kind == K_GEMM_QUP ? BG_C2 : kind == K_HN_AB ? BG_C3 : 64;
            hgrn_item(lds, (const bf16_t*)(ws + WS_PROJ), MC + b * 2048, 2048, h, dir, (const float*)(ws + WS_LB) + (j * 2 + dir) * 1024 + h * 128,
                      a->in[4 + dir] + (size_t)((b * 2 + j) * 8 + h) * 16384, nullptr, (bf16_t*)(ws + (dir ? WS_OB : WS_OF)), c0, c1, (float*)(ws + WS_SBUF) + (size_t)bid * 16384);
        }
        const int ewg = bgphase ? bid - NBG : bid, enwg = bgphase ? G - NBG : G;
        if (bgphase && bid < NBG) {}
        else
        if (kind == K_P0) phase_p0(a, lds);
        else if (kind == K_MODNORM) phase_modnorm(a, L);
        else if (kind == K_GEMM_IN || kind == K_GEMM_QUP || kind == K_GEMM_KVUP) {
            pg8::Gemm g; pg8::EpiStore E;
            if (kind == K_GEMM_IN) {
                if (!isC) { g = pg8::Gemm{(const bf16_t*)(ws + WS_H), (const bf16_t*)(ws + WS_WINAB) + (size_t)j * 7168 * 2048, MROWS, 7168, 2048}; E = pg8::EpiStore{(bf16_t*)(ws + WS_PROJ), LDP_AB}; }
                else { g = pg8::Gemm{(const bf16_t*)(ws + WS_H), (const bf16_t*)(ws + WS_WINC) + (size_t)j * 5120 * 2048, MROWS, 5120, 2048}; E = pg8::EpiStore{(bf16_t*)(ws + WS_PROJ), LDP_C}; }
            } else if (kind == K_GEMM_QUP) { g = pg8::Gemm{(const bf16_t*)(ws + WS_QN), (const bf16_t*)(ws + WS_WQUP) + (size_t)j * 1536 * 512, MROWS, 1536, 512}; E = pg8::EpiStore{(bf16_t*)(ws + WS_QRAW), 1536}; }
            else { g = pg8::Gemm{(const bf16_t*)(ws + WS_CKV), (const bf16_t*)(ws + WS_WKVUP) + (size_t)j * 2048 * 256, MKROWS, 2048, 256}; E = pg8::EpiStore{(bf16_t*)(ws + WS_KVRAW), 2048}; }
            pg8::StaticOrder S; S.init(g.M, g.N, enwg, ewg);
            pg8::gemm_phase<pg8::EpiStore, pg8::StaticOrder, true, true>(lds, g, S, E);
        }
        else if (kind == K_GEMM_OUT) {
            pg8::Gemm g{(const bf16_t*)(ws + WS_H), (const bf16_t*)(ws + (isC ? WS_WOUTC : WS_WOUTAB)) + (size_t)j * 2048 * 2048, MROWS, 2048, 2048};
            pg8::EpiResid E{(bf16_t*)(ws + WS_PROJ), (const float*)(ws + WS_MOD) + (size_t)L * 5 * 6144 + 4096,
                            (float*)(ws + WS_QRAW), ctl + 16384 + step * 256};
            pg8::StaticOrder S; S.init(g.M, g.N, G, obid());
            pg8::gemm_phase<pg8::EpiResid, pg8::StaticOrder, true, true>(lds, g, S, E);
        }
        else if (kind == K_FINAL) phase_final(a);
        else if (kind == K_PREP_AB) phase_prep_ab(a, j, ewg, enwg);
        else if (kind == K_HN_AB) phase_hn_ab(a, j, ewg, enwg);
        else if (kind == K_FIN_AB) phase_fin_ab(a, j);
        else if (kind == K_HN_C) phase_hn_c(a, j);
        else if (kind == K_MIX_AB) {
            unsigned* ctr = ctl + 64 * step + 8 * rep;
            const bf16_t* P = (const bf16_t*)(ws + WS_PROJ); bf16_t* MIX = (bf16_t*)(ws + WS_H);
            const bf16_t* QF = (const bf16_t*)(ws + WS_QRAW); const bf16_t* KF = (const bf16_t*)(ws + WS_KF); const bf16_t* KV = (const bf16_t*)(ws + WS_KVRAW);
            for (;;) {
                const int idx = fetch_item(ctr, slot);
                if (idx >= 640) break;
                if (idx >= 256 && idx < 512) {
                    const int i = idx - 256; const int b = i >> 4, h = (i >> 1) & 7, dir = i & 1;
                    const float* lb = (const float*)(ws + WS_LB) + (j * 2 + dir) * 1024 + h * 128;
                    float* so = a->out + (dir ? O_SB : O_SF) + (size_t)((b * 2 + j) * 8 + h) * 16384;
                    if (PROBE_SEL != 1 || rep == 0) hgrn_item(lds, P, b * 256, 256, h, dir, lb, nullptr, so, (bf16_t*)(ws + (dir ? WS_OB : WS_OF)), 0, 8, (float*)(ws + WS_SBUF));
                } else {
                    att::Item it;
                    const bool lat = idx < 256; int b, h, r0;
                    if (lat) { const int i = idx; b = i >> 6; h = (i >> 3) & 7; const int qb = i & 7; r0 = MC + b * 2048 + qb * 256; it.q0 = qb * 256;
                        it.K0 = KF + (size_t)(MROWS + b * 256) * 1536 + h * 192; it.V0 = KV + (size_t)(MROWS + b * 256) * 2048 + h * 256 + 128; it.n0 = 4;
                        it.K1 = KF + (size_t)(MC + b * 2048) * 1536 + h * 192; it.V1 = KV + (size_t)(MC + b * 2048) * 2048 + h * 256 + 128; it.t_lo = 0; it.t_hi = 32; }
                    else { const int i = idx - 512; b = i >> 3; h = i & 7; r0 = b * 256; it.q0 = 0;
                        it.K0 = KF; it.V0 = KV; it.n0 = 0;
                        it.K1 = KF + (size_t)r0 * 1536 + h * 192; it.V1 = KV + (size_t)r0 * 2048 + h * 256 + 128; it.t_lo = 0; it.t_hi = 4; }
                    it.ldk = 1536; it.ldv = 2048;
                    it.Q = QF + (size_t)r0 * 1536 + h * 192; it.ldq = 1536; it.band = 0; it.m0 = -1e30f; it.l0 = 0.f;
                    it.qg = a->in[18] + j * 192; it.rope = lat ? (const float*)(ws + WS_ROPEA) : nullptr; it.qscale = QSC_A;
                    it.G = P + (size_t)r0 * LDP_AB + COL_AG + h * 128; it.ldg = LDP_AB; it.O = MIX + (size_t)r0 * DM + h * 128; it.ldo = DM;
                    if (PROBE_SEL != 2 || rep == 0) att::attn_item<192>(lds, it);
                }
            }
        }
        else if (kind == K_ATTN_C) {
            unsigned* ctr = ctl + 64 * step + 8 * rep;
            const bf16_t* P = (const bf16_t*)(ws + WS_PROJ); bf16_t* MIX = (bf16_t*)(ws + WS_H);
            const bf16_t* KCC = (const bf16_t*)(ws + WS_KCC);
            for (;;) {
                const int idx = fetch_item(ctr, slot);
                if (idx >= 768) break;
                att::Item it; int b, h, r0;
                if (idx < 512) { b = idx >> 7; h = (idx >> 3) & 15; const int qb = idx & 7; r0 = MC + b * 2048 + qb * 256; const int kvh = h >> 2;
                    it.K0 = KCC + (size_t)((b * 2 + j) * 256) * LDP_C + kvh * 128; it.V0 = KCC + (size_t)((b * 2 + j) * 256) * LDP_C + 512 + kvh * 128; it.n0 = 4;
                    it.K1 = P + (size_t)(MC + b * 2048) * LDP_C + 2048 + kvh * 128; it.V1 = P + (size_t)(MC + b * 2048) * LDP_C + 2560 + kvh * 128;
                    it.t_lo = 4 * qb - 2 < 0 ? 0 : 4 * qb - 2; it.t_hi = 4 * qb + 6 > 32 ? 32 : 4 * qb + 6; it.q0 = qb * 256; it.band = 1; }
                else { const int i = idx - 512; b = i >> 4; h = i & 15; r0 = b * 256; const int kvh = h >> 2;
                    it.K0 = KCC; it.V0 = KCC; it.n0 = 0;
                    it.K1 = P + (size_t)r0 * LDP_C + 2048 + kvh * 128; it.V1 = P + (size_t)r0 * LDP_C + 2560 + kvh * 128; it.t_lo = 0; it.t_hi = 4; it.q0 = 0; it.band = 0; }
                it.ldk = LDP_C; it.ldv = LDP_C;
                it.Q = P + (size_t)r0 * LDP_C + h * 128; it.ldq = LDP_C; it.m0 = a->in[29][j * 16 + h] * LOG2E; it.l0 = 1.f;
                it.qg = a->in[27] + j * 128; it.rope = idx < 512 ? (const float*)(ws + WS_ROPEC) : nullptr; it.qscale = QSC_C;
                it.G = P + (size_t)r0 * LDP_C + 3072 + h * 128; it.ldg = LDP_C; it.O = MIX + (size_t)r0 * DM + h * 128; it.ldo = DM;
                att::attn_item<128>(lds, it);
            }
        }
        if (rep + 1 < nrep) xcd_barrier(xbar);
        }
        if (sync_after) { if (step == 0) grid.sync(); else xcd_barrier(xbar); }
        if (PROBE_TSEL) { if ((PROBE_TSEL >> kind) & 1) t_acc += __builtin_amdgcn_s_memrealtime() - t_begin; }
    }
    if (PROBE_TSEL) { if (blockIdx.x == 0) { const unsigned long long t_end = __builtin_amdgcn_s_memrealtime() + 2ull * t_acc;
        while (__builtin_amdgcn_s_memrealtime() < t_end) __builtin_amdgcn_s_sleep(32); } }
}

extern "C" void kernel_launch(void* const* d_in, const int* in_sizes, int n_in, void* d_out, int out_size, void* d_ws, size_t ws_size, hipStream_t stream) {
    static int grid = 0;
    if (grid == 0) {
        if (n_in != 31 || ws_size < WS_END) { fprintf(stderr, "kernel_launch: unexpected n_in %d or ws_size %zu (< %zu)\n", n_in, ws_size, (size_t)WS_END); grid = -1; return; }
        int dev = 0, cus = 0, per_cu = 0;
        hipGetDevice(&dev); hipDeviceGetAttribute(&cus, hipDeviceAttributeMultiprocessorCount, dev);
        if (hipFuncSetAttribute((const void*)mk_fwd, hipFuncAttributeMaxDynamicSharedMemorySize, LDS_BYTES) != hipSuccess) { fprintf(stderr, "kernel_launch: hipFuncSetAttribute failed\n"); grid = -1; return; }
        if (hipOccupancyMaxActiveBlocksPerMultiprocessor(&per_cu, (const void*)mk_fwd, NTHR, LDS_BYTES) != hipSuccess || per_cu < 1) per_cu = 1;
        (void)hipGetLastError();
        grid = cus > 0 ? cus : 256;
    }
    if (grid < 0) return;
    hipMemsetAsync((char*)d_ws + WS_CTL, 0, CTL_BYTES, stream);
    Args a{};
    for (int i = 0; i < 31; ++i) a.in[i] = (const float*)d_in[i];
    a.out = (float*)d_out; a.ws = (unsigned char*)d_ws;
    void* args[] = {&a};
    hipError_t e = hipLaunchCooperativeKernel((const void*)mk_fwd, dim3(grid), dim3(NTHR), args, LDS_BYTES, stream);
    if (e != hipSuccess) fprintf(stderr, "cooperative launch failed: %s (grid %d)\n", hipGetErrorString(e), grid);
}
```

```cpp
#include <hip/hip_runtime.h>
#include <hip/hip_cooperative_groups.h>
#include <cstdio>
#include <cstdint>
namespace cg = cooperative_groups;

namespace pg8 {
#define PG8_LAS __attribute__((address_space(3)))
typedef unsigned short bf16_t;
typedef short bf16x8 __attribute__((ext_vector_type(8)));
typedef float f32x4 __attribute__((ext_vector_type(4)));
typedef unsigned u32x4 __attribute__((ext_vector_type(4)));
constexpr int BM = 256, BK = 64, HALF = 128, HTB = HALF * BK * 2  , STAGE_BYTES = 8 * HTB, NXCD = 8, WGM = 8;
__device__ __forceinline__ int pg8_otid() { int t = threadIdx.x; asm volatile("" : "+v"(t)); return t; }

__host__ __device__ __forceinline__ int lds_byte(int r, int c) { const int st = (r >> 4) * 2 + (c >> 5), rr = r & 15, cc = c & 31, ob = rr * 64 + cc * 2; return st * 1024 + (ob ^ (((ob >> 9) & 1) << 5)); }
__host__ __device__ __forceinline__ void stage_rc(int b, int& R, int& C) { const int st = b / 1024, sb = b % 1024, swz = sb ^ (((sb >> 9) & 1) << 5); R = (st >> 1) * 16 + swz / 64; C = (st & 1) * 32 + (swz % 64) / 2; }
__host__ __device__ __forceinline__ int perm32(int rho) { const int n = rho >> 4, i = rho & 15; return 8 * (i >> 2) + 4 * n + (i & 3); }

struct Unit { int pm, pn, kp, np, tix; };
struct Gemm { const bf16_t* A; const bf16_t* Bt; int M, N, K; };

struct StaticOrder {
    int nM, nN, nwg, G, c;
    __host__ __device__ void init(int M, int N, int G_, int c_) { nM = M / BM; nN = N / BM; nwg = nM * nN; G = G_; c = c_; }
    __host__ __device__ bool next(int i, Unit& u) const {
        const long L = (long)i * G + c; if (L >= nwg) return false;
        int wgid = (int)L; { const int q = nwg / NXCD, r = nwg % NXCD, xcd = wgid % NXCD, off = wgid / NXCD; wgid = (xcd < r ? xcd * (q + 1) : r * (q + 1) + (xcd - r) * q) + off; }
        const int nig = WGM * nN, gid = wgid / nig, fm = gid * WGM, gsz = (nM - fm) < WGM ? (nM - fm) : WGM;
        u.pm = fm + ((wgid % nig) % gsz); u.pn = (wgid % nig) / gsz; u.kp = 0; u.np = 1; u.tix = 0; return true;
    }
    __device__ __forceinline__ void a_ready(const Unit&) const {}
    __device__ __forceinline__ void done(const Unit&) const {}
};
struct SplitOrder {
    StaticOrder so; int R, np;
    __host__ __device__ void init(int M, int N, int K, int G_, int c_) { so.init(M, N, G_, c_); R = so.nwg / G_; const int left = so.nwg - R * G_;
        np = 1; if (left > 0 && G_ % left == 0) { const int q = G_ / left; if (q == 2 && (K / q) % 128 == 0) np = q; } }
    __host__ __device__ bool next(int i, Unit& u) const {
        if (np == 1 || i < R) return so.next(i, u);
        if (i > R) return false;
        StaticOrder t = so; t.c = so.c / np; const bool ok = t.next(i, u); u.kp = so.c % np; u.np = np; u.tix = so.c / np; return ok;
    }
    __device__ __forceinline__ void a_ready(const Unit&) const {}
    __device__ __forceinline__ void done(const Unit&) const {}
};

typedef float f32x2c __attribute__((ext_vector_type(2)));
typedef __bf16 bf16x2c __attribute__((ext_vector_type(2)));
__device__ __forceinline__ unsigned cvt_pk_bf16(float lo, float hi) { const f32x2c v = {lo, hi}; const bf16x2c b = __builtin_convertvector(v, bf16x2c); return __builtin_bit_cast(unsigned, b); }

struct EpiStore {
    static constexpr bool PERM = true, AFTER_DRAIN = false;
    bf16_t* O; int ldc;
    __device__ __forceinline__ void operator()(const f32x4 (&acc)[2][2][4][2], const Unit& u, int wr, int wc, int fr, int fq) const {
        const int row0 = u.pm * BM + wr * 64 + fr; const int col0 = u.pn * BM + wc * 32 + 8 * fq;
#pragma unroll
        for (int ai = 0; ai < 2; ++ai)
#pragma unroll
            for (int m = 0; m < 4; ++m) { bf16_t* rowp = O + (size_t)(row0 + ai * HALF + m * 16) * ldc + col0;
#pragma unroll
                for (int bj = 0; bj < 2; ++bj) { const f32x4 v0 = acc[ai][bj][m][0], v1 = acc[ai][bj][m][1];
                    u32x4 w; w.x = cvt_pk_bf16(v0[0], v0[1]); w.y = cvt_pk_bf16(v0[2], v0[3]); w.z = cvt_pk_bf16(v1[0], v1[1]); w.w = cvt_pk_bf16(v1[2], v1[3]);
                    *(u32x4*)(rowp + bj * HALF) = w; } }
    }
};
struct EpiResid {
    static constexpr bool PERM = true, AFTER_DRAIN = false;
    bf16_t* dout; const float* gate_base;
    float* slab; unsigned* cnt;
    __device__ __forceinline__ void operator()(f32x4 (&acc)[2][2][4][2], const Unit& u, int wr, int wc, int fr, int fq) const {
        const int tid = (wr * 4 + wc) * 64 + fq * 16 + fr;
        const f32x4* sl = nullptr;
        if (u.np > 1) {
            float* sb = slab + (size_t)u.tix * (u.np - 1) * 65536;
            if (u.kp < u.np - 1) {
                f32x4* sp = (f32x4*)(sb + (size_t)u.kp * 65536) + tid;
#pragma unroll
                for (int ai = 0; ai < 2; ++ai)
#pragma unroll
                    for (int bj = 0; bj < 2; ++bj)
#pragma unroll
                        for (int m = 0; m < 4; ++m)
#pragma unroll
                            for (int n = 0; n < 2; ++n) sp[(((ai * 2 + bj) * 4 + m) * 2 + n) * 512] = acc[ai][bj][m][n];
                asm volatile("s_waitcnt vmcnt(0)" ::: "memory");
                __syncthreads();
                if (tid == 0) { __builtin_amdgcn_fence(__ATOMIC_RELEASE, "agent"); asm volatile("s_waitcnt vmcnt(0)" ::: "memory");
                    __hip_atomic_fetch_add(cnt + u.tix, 1u, __ATOMIC_RELAXED, __HIP_MEMORY_SCOPE_AGENT); }
                return;
            }
            if (tid == 0) { unsigned sp_ = 0;
                while (__hip_atomic_load(cnt + u.tix, __ATOMIC_RELAXED, __HIP_MEMORY_SCOPE_AGENT) < (unsigned)(u.np - 1)) { __builtin_amdgcn_s_sleep(2); if (++sp_ > (1u << 22)) break; }
                __builtin_amdgcn_fence(__ATOMIC_ACQUIRE, "agent"); asm volatile("s_waitcnt vmcnt(0)" ::: "memory"); }
            __syncthreads();
            sl = (const f32x4*)sb + tid;
        }
        const int pm = u.pm;
        const int ci = pm < 16 ? 4 : ((pm - 16) >> 3);
        const float* gt = gate_base + ci * 6144;
        const int row0 = pm * BM + wr * 64 + fr, col0 = u.pn * BM + wc * 32 + 8 * fq;
#pragma unroll
        for (int bj = 0; bj < 2; ++bj) { const f32x4 gq0 = *(const f32x4*)(gt + col0 + bj * HALF), gq1 = *(const f32x4*)(gt + col0 + bj * HALF + 4);
#pragma unroll
            for (int ai = 0; ai < 2; ++ai) {
#pragma unroll
                for (int m = 0; m < 4; ++m) { f32x4 a0 = acc[ai][bj][m][0], a1 = acc[ai][bj][m][1];
                    if (sl) { a0 += sl[(((ai * 2 + bj) * 4 + m) * 2 + 0) * 512]; a1 += sl[(((ai * 2 + bj) * 4 + m) * 2 + 1) * 512]; }
                    a0 = a0 * gq0; a1 = a1 * gq1;
                    u32x4 w; w.x = cvt_pk_bf16(a0[0], a0[1]); w.y = cvt_pk_bf16(a0[2], a0[3]); w.z = cvt_pk_bf16(a1[0], a1[1]); w.w = cvt_pk_bf16(a1[2], a1[3]);
                    *(u32x4*)(dout + (size_t)(row0 + ai * HALF + m * 16) * 2048 + col0 + bj * HALF) = w; }
                asm volatile("" ::: "memory"); } }
    }
};

template <class Epi, class Sched, bool ALIGN_EPI = false, bool SP2 = false>
__device__ __forceinline__ void gemm_phase(PG8_LAS unsigned char* lds, const Gemm g, const Sched& S, const Epi& E) {
    const int tid = pg8_otid(), wid = __builtin_amdgcn_readfirstlane(tid >> 6), lane = tid & 63, wr = wid >> 2, wc = wid & 3, fr = lane & 15, fq = lane >> 4;
    const int K = g.K, nt = K / BK;
    unsigned voffA[2], voffB[2];
#pragma unroll
    for (int i = 0; i < 2; ++i) { int R, C; stage_rc(tid * 16 + i * 8192, R, C); const int Rb = Epi::PERM ? ((R & ~31) + perm32(R & 31)) : R;
        voffA[i] = (unsigned)(R * K + C) * 2u; voffB[i] = (unsigned)(Rb * K + C) * 2u; }
    const size_t kstep = (size_t)(BK * 2);
    const size_t hstep = (size_t)HALF * K * 2;
    const size_t tstep = 2 * hstep;
    const unsigned ldsw = (unsigned)wid * 1024u;
    const int aoff = lds_byte(wr * 64 + fr, fq * 8), boff = lds_byte(wc * 32 + fr, fq * 8);
#define PG8_SA(b, h) (((b) * 2 + (h)) * HTB)
#define PG8_SB(b, h) ((4 + (b) * 2 + (h)) * HTB)
#define PG8_STAGE(bufoff, gbase, voff) do { _Pragma("unroll") for (int _i = 0; _i < 2; ++_i) \
        __builtin_amdgcn_global_load_lds((const unsigned*)((const char*)(gbase) + (voff)[_i]), (PG8_LAS unsigned*)(lds + (bufoff) + ldsw + _i * 8192), 16, 0, 0); } while (0)
#define PG8_LDA(dst, b, h) do { _Pragma("unroll") for (int m = 0; m < 4; ++m) _Pragma("unroll") for (int k = 0; k < 2; ++k) dst[m][k] = *(const PG8_LAS bf16x8*)(lds + PG8_SA(b, h) + aoff + m * 2048 + k * 1024); } while (0)
#define PG8_LDB(dst, b, h) do { _Pragma("unroll") for (int n = 0; n < 2; ++n) _Pragma("unroll") for (int k = 0; k < 2; ++k) dst[n][k] = *(const PG8_LAS bf16x8*)(lds + PG8_SB(b, h) + boff + n * 2048 + k * 1024); } while (0)
#define PG8_MMA(ai, bj, At, Bt) do { __builtin_amdgcn_s_setprio(1); _Pragma("unroll") for (int m = 0; m < 4; ++m) _Pragma("unroll") for (int n = 0; n < 2; ++n) _Pragma("unroll") for (int k = 0; k < 2; ++k) \
        acc[ai][bj][m][n] = __builtin_amdgcn_mfma_f32_16x16x32_bf16(Bt[n][k], At[m][k], acc[ai][bj][m][n], 0, 0, 0); __builtin_amdgcn_s_setprio(0); } while (0)
#define PG8_WAIT_V(n) asm volatile("s_waitcnt vmcnt(" #n ")" ::: "memory")
#define PG8_WAIT_L(n) asm volatile("s_waitcnt lgkmcnt(" #n ")" ::: "memory")
#define PG8_BAR __builtin_amdgcn_s_barrier()
#define PG8_SCHED __builtin_amdgcn_sched_barrier(0)
    Unit cur, nxt; int ui = 0;
    if (!S.next(0, cur)) return;
    f32x4 acc[2][2][4][2];
#pragma unroll
    for (int a = 0; a < 2; ++a)
#pragma unroll
        for (int b = 0; b < 2; ++b)
#pragma unroll
            for (int m = 0; m < 4; ++m)
#pragma unroll
                for (int n = 0; n < 2; ++n) acc[a][b][m][n] = (f32x4){0.f, 0.f, 0.f, 0.f};
    bf16x8 At[4][2], B0[2][2], B1[2][2];
    const char* cA = (const char*)g.A + (size_t)cur.pm * tstep + (size_t)cur.kp * (K / cur.np) * 2; const char* cB = (const char*)g.Bt + (size_t)cur.pn * tstep + (size_t)cur.kp * (K / cur.np) * 2;
    S.a_ready(cur);
    if constexpr (SP2) {
        PG8_STAGE(PG8_SB(0, 0), cB, voffB); PG8_STAGE(PG8_SB(0, 1), cB + hstep, voffB); PG8_STAGE(PG8_SA(0, 0), cA, voffA); PG8_STAGE(PG8_SA(0, 1), cA + hstep, voffA);
        if (wr == 1) PG8_BAR;
        PG8_WAIT_V(2); PG8_BAR;
        PG8_STAGE(PG8_SB(1, 0), cB + kstep, voffB); PG8_STAGE(PG8_SA(1, 0), cA + kstep, voffA); PG8_STAGE(PG8_SB(1, 1), cB + hstep + kstep, voffB);
        PG8_WAIT_V(6); PG8_BAR;
    } else {
        PG8_STAGE(PG8_SB(0, 0), cB, voffB); PG8_STAGE(PG8_SA(0, 0), cA, voffA); PG8_STAGE(PG8_SB(0, 1), cB + hstep, voffB); PG8_STAGE(PG8_SA(0, 1), cA + hstep, voffA);
        if (wr == 1) PG8_BAR;
        PG8_WAIT_V(4); PG8_BAR;
        PG8_STAGE(PG8_SB(1, 0), cB + kstep, voffB); PG8_STAGE(PG8_SA(1, 0), cA + kstep, voffA); PG8_STAGE(PG8_SB(1, 1), cB + hstep + kstep, voffB);
        PG8_WAIT_V(6); PG8_BAR;
    }
    for (;;) {
        const bool has_next = S.next(ui + 1, nxt);
        const size_t nko = has_next ? (size_t)nxt.kp * (K / nxt.np) * 2 : 0; const char* nA = has_next ? (const char*)g.A + (size_t)nxt.pm * tstep + nko : cA; const char* nB = has_next ? (const char*)g.Bt + (size_t)nxt.pn * tstep + nko : cB;
        const int ntc = nt / cur.np;
        for (int t = 0; t < ntc; t += 2) {
            const bool last = (t == ntc - 2);
            const char* a1 = cA + (size_t)(t + 1) * kstep;
            const char* a2 = last ? nA : cA + (size_t)(t + 2) * kstep; const char* b2 = last ? nB : cB + (size_t)(t + 2) * kstep;
            const char* a3 = a2 + kstep; const char* b3 = b2 + kstep;
            if (last && has_next) S.a_ready(nxt);
            if constexpr (SP2) {
            PG8_LDB(B0, 0, 0); PG8_LDB(B1, 0, 1); PG8_SCHED; PG8_LDA(At, 0, 0); PG8_STAGE(PG8_SA(1, 1), a1 + hstep, voffA);
            PG8_WAIT_V(8); PG8_WAIT_L(0); PG8_BAR; PG8_MMA(0, 0, At, B0); PG8_MMA(0, 1, At, B1); PG8_BAR; PG8_SCHED;
            PG8_LDA(At, 0, 1); PG8_STAGE(PG8_SB(0, 0), b2, voffB); PG8_STAGE(PG8_SB(0, 1), b2 + hstep, voffB); PG8_STAGE(PG8_SA(0, 0), a2, voffA);
            PG8_WAIT_V(8); PG8_WAIT_L(0); PG8_BAR; PG8_MMA(1, 0, At, B0); PG8_MMA(1, 1, At, B1); PG8_BAR; PG8_SCHED;
            PG8_LDB(B0, 1, 0); PG8_LDB(B1, 1, 1); PG8_SCHED; PG8_LDA(At, 1, 0); PG8_STAGE(PG8_SA(0, 1), a2 + hstep, voffA);
            PG8_WAIT_V(8); PG8_WAIT_L(0); PG8_BAR; PG8_MMA(0, 0, At, B0); PG8_MMA(0, 1, At, B1); PG8_BAR; PG8_SCHED;
            PG8_LDA(At, 1, 1); PG8_STAGE(PG8_SB(1, 0), b3, voffB); PG8_STAGE(PG8_SB(1, 1), b3 + hstep, voffB); PG8_STAGE(PG8_SA(1, 0), a3, voffA);
            PG8_WAIT_V(8); PG8_WAIT_L(0); PG8_BAR; PG8_MMA(1, 0, At, B0); PG8_MMA(1, 1, At, B1); PG8_BAR; PG8_SCHED;
            } else {
            PG8_LDB(B0, 0, 0); PG8_SCHED; PG8_LDA(At, 0, 0); PG8_STAGE(PG8_SA(1, 1), a1 + hstep, voffA);
            PG8_WAIT_L(8); PG8_BAR; PG8_WAIT_L(0); PG8_MMA(0, 0, At, B0); PG8_BAR; PG8_SCHED;
            PG8_LDB(B1, 0, 1); PG8_STAGE(PG8_SB(0, 0), b2, voffB);
            PG8_BAR; PG8_WAIT_L(0); PG8_MMA(0, 1, At, B1); PG8_BAR;
            PG8_LDA(At, 0, 1); PG8_STAGE(PG8_SA(0, 0), a2, voffA);
            PG8_BAR; PG8_WAIT_L(0); PG8_MMA(1, 0, At, B0); PG8_BAR; PG8_SCHED;
            PG8_STAGE(PG8_SB(0, 1), b2 + hstep, voffB);
            PG8_WAIT_V(6); PG8_BAR; PG8_MMA(1, 1, At, B1); PG8_BAR;
            PG8_LDB(B0, 1, 0); PG8_SCHED; PG8_LDA(At, 1, 0); PG8_STAGE(PG8_SA(0, 1), a2 + hstep, voffA);
            PG8_WAIT_L(8); PG8_BAR; PG8_WAIT_L(0); PG8_MMA(0, 0, At, B0); PG8_BAR; PG8_SCHED;
            PG8_LDB(B1, 1, 1); PG8_STAGE(PG8_SB(1, 0), b3, voffB);
            PG8_BAR; PG8_WAIT_L(0); PG8_MMA(0, 1, At, B1); PG8_BAR;
            PG8_LDA(At, 1, 1); PG8_STAGE(PG8_SA(1, 0), a3, voffA);
            PG8_BAR; PG8_WAIT_L(0); PG8_MMA(1, 0, At, B0); PG8_BAR; PG8_SCHED;
            PG8_STAGE(PG8_SB(1, 1), b3 + hstep, voffB);
            PG8_WAIT_V(6); PG8_BAR; PG8_MMA(1, 1, At, B1); PG8_BAR;
            }
        }
        if constexpr (ALIGN_EPI) { if (wr == 0) PG8_BAR; }
        if constexpr (!Epi::AFTER_DRAIN) { E(acc, cur, wr, wc, fr, fq); S.done(cur); }
        if (!has_next) break;
#pragma unroll
        for (int a = 0; a < 2; ++a)
#pragma unroll
            for (int b = 0; b < 2; ++b)
#pragma unroll
                for (int m = 0; m < 4; ++m)
#pragma unroll
                    for (int n = 0; n < 2; ++n) acc[a][b][m][n] = (f32x4){0.f, 0.f, 0.f, 0.f};
        cur = nxt; cA = nA; cB = nB; ++ui;
        if constexpr (ALIGN_EPI) { if (wr == 1) PG8_BAR; }
    }
    PG8_WAIT_V(0);
    if constexpr (!ALIGN_EPI) { if (wr == 0) PG8_BAR; }
    PG8_BAR;
    if constexpr (Epi::AFTER_DRAIN) { E.fused(acc, cur, wr, wc, fr, fq, lds, wid, lane); S.done(cur); }
#undef PG8_SA
#undef PG8_SB
#undef PG8_STAGE
#undef PG8_LDA
#undef PG8_LDB
#undef PG8_MMA
#undef PG8_WAIT_V
#undef PG8_WAIT_L
#undef PG8_BAR
#undef PG8_SCHED
}
}

#define LAS __attribute__((address_space(3)))
typedef unsigned short bf16_t;
typedef short bf16x8 __attribute__((ext_vector_type(8)));
typedef short s16x4 __attribute__((ext_vector_type(4)));
typedef float f32x4 __attribute__((ext_vector_type(4)));
typedef float f32x16 __attribute__((ext_vector_type(16)));
typedef unsigned u32x4 __attribute__((ext_vector_type(4)));
typedef unsigned u32x2 __attribute__((ext_vector_type(2)));


__device__ __forceinline__ int otid() { int t = threadIdx.x; asm volatile("" : "+v"(t)); return t; }
__device__ __forceinline__ unsigned ozero() { unsigned z = 0u; asm volatile("" : "+v"(z)); return z; }
__device__ __forceinline__ int obid() { int b = blockIdx.x; asm volatile("" : "+s"(b)); return b; }
constexpr int NWAVES = 8, NTHR = 512;
constexpr int DM = 2048, MC = 4096, ML = 8192, MROWS = 12288, MKROWS = 13312;
constexpr int LDP_AB = 7168, LDP_C = 5120;
constexpr int COL_QL = 0, COL_KVL = 512, COL_AG = 768, COL_BQ = 1792, COL_FF = 2816, COL_FB = 3840, COL_BI = 4864, COL_BG = 5888, COL_KPE = 6912;
constexpr float EPSN = 1e-6f;
constexpr float LOG2E = 1.4426950408889634f;
constexpr float QSC_A = 0.07216878364870322f * LOG2E;
constexpr float QSC_C = 0.08838834764831845f * LOG2E;

constexpr size_t O_YP = 0, O_YS = 8388608, O_CKV = 25165824, O_KPE = 27262976, O_SF = 27787264, O_SB = 31981568, O_KC = 36175872, O_VC = 40370176;

constexpr size_t MiB = 1u << 20;
constexpr size_t WS_CTL = 0, CTL_BYTES = 131072;
constexpr size_t WS_MOD = 1 * MiB, WS_LB = WS_MOD + 512 * 1024, WS_ROPEA = WS_LB + 64 * 1024, WS_ROPEC = WS_ROPEA + 512 * 1024;
constexpr size_t WS_KCC = 532 * MiB;
constexpr size_t WS_WINAB = 8 * MiB, WS_WQUP = 64 * MiB, WS_WKVUP = 67 * MiB, WS_WOUTAB = 69 * MiB, WS_WINC = 85 * MiB, WS_WOUTC = 125 * MiB;
constexpr size_t WS_H = 141 * MiB, WS_PROJ = 189 * MiB, WS_QRAW = 357 * MiB, WS_KVRAW = 393 * MiB, WS_KF = 445 * MiB, WS_OF = 484 * MiB, WS_OB = 508 * MiB;
constexpr size_t WS_QN = WS_H, WS_CKV = WS_H + 12 * MiB, WS_END = 552 * MiB;
constexpr size_t WS_SBUF = 4 * MiB;
constexpr int NBG = 64;

constexpr int LDS_PHASE = 131072, LDS_BYTES = LDS_PHASE + 1024;

__device__ __forceinline__ float bf2f(unsigned short b) { return __uint_as_float((unsigned)b << 16); }
typedef float f32x2_t __attribute__((ext_vector_type(2)));
typedef __bf16 bf16x2_t __attribute__((ext_vector_type(2)));
__device__ __forceinline__ unsigned pk2(float lo, float hi) { const f32x2_t v = {lo, hi}; const bf16x2_t b = __builtin_convertvector(v, bf16x2_t); return __builtin_bit_cast(unsigned, b); }
__device__ __forceinline__ unsigned f2bf(float f) { return pk2(f, 0.f) & 0xffffu; }
__device__ __forceinline__ float silu_f(float x) { return x * __builtin_amdgcn_rcpf(1.f + __expf(-x)); }
__device__ __forceinline__ float wave_sum(float v) {
#pragma unroll
    for (int o = 1; o < 64; o <<= 1) v += __shfl_xor(v, o);
    return v;
}
__device__ __forceinline__ float sum16(float v) {
    v += __shfl_xor(v, 1); v += __shfl_xor(v, 2); v += __shfl_xor(v, 4); v += __shfl_xor(v, 8); return v;
}
__device__ __forceinline__ bf16x8 pack8(const float* v) {
    u32x4 w; w.x = pk2(v[0], v[1]); w.y = pk2(v[2], v[3]); w.z = pk2(v[4], v[5]); w.w = pk2(v[6], v[7]); return __builtin_bit_cast(bf16x8, w);
}

struct Args { const float* in[31]; float* out; unsigned char* ws; };
typedef const Args __attribute__((address_space(4)))* KArgs;

struct P0Item { const float* W; bf16_t* WT; int K, N, k0, n0, d0; };
__device__ __forceinline__ void p0_load(const P0Item& q, float (&v)[32], int lane) {
#pragma unroll
    for (int i = 0; i < 32; ++i) { const int kk = 2 * i + (lane >> 5); v[i] = q.W[(size_t)(q.k0 + kk) * q.N + q.n0 + (lane & 31)]; }
}
__device__ __forceinline__ void p0_emit(const P0Item& q, const float (&v)[32], LAS float* scr, int lane) {
#pragma unroll
    for (int i = 0; i < 32; ++i) { const int kk = 2 * i + (lane >> 5); scr[kk * 33 + (lane & 31)] = v[i]; }
    asm volatile("s_waitcnt lgkmcnt(0)" ::: "memory");
    const int c = lane & 7;
#pragma unroll
    for (int j = 0; j < 4; ++j) { const int n = (lane >> 3) + 8 * j; const LAS float* s = scr + (8 * c) * 33 + n;
        u32x4 o; o.x = pk2(s[0 * 33], s[1 * 33]); o.y = pk2(s[2 * 33], s[3 * 33]); o.z = pk2(s[4 * 33], s[5 * 33]); o.w = pk2(s[6 * 33], s[7 * 33]);
        *(u32x4*)(q.WT + (size_t)(q.d0 + n) * q.K + q.k0 + 8 * c) = o; }
    asm volatile("s_waitcnt lgkmcnt(0)" ::: "memory");
}
__device__ __forceinline__ P0Item p0_decode(KArgs a, int it) {
    constexpr int I_INAB = 32 * 218, I_QUP = 8 * 48, I_KVUP = 4 * 64, I_OUT = 32 * 64, I_INC = 32 * 160;
    constexpr int PER_J = I_INAB + I_QUP + I_KVUP + I_OUT + I_INC + I_OUT;
    unsigned char* ws = a->ws; P0Item q;
    const int j = it / PER_J; int r = it % PER_J;
    if (r < I_INAB) { const int kb = r / 218, nb = r % 218, n0 = nb * 32;
        q.W = a->in[13] + (size_t)j * 2048 * 6976; q.WT = (bf16_t*)(ws + WS_WINAB) + (size_t)j * 7168 * 2048; q.K = 2048; q.N = 6976; q.k0 = kb * 64; q.n0 = n0; q.d0 = n0 < 768 ? n0 : (n0 < 832 ? n0 + 6144 : n0 - 64); return q; }
    r -= I_INAB;
    if (r < I_QUP) { const int kb = r / 48, nb = r % 48;
        q.W = a->in[16] + (size_t)j * 512 * 1536; q.WT = (bf16_t*)(ws + WS_WQUP) + (size_t)j * 1536 * 512; q.K = 512; q.N = 1536; q.k0 = kb * 64; q.n0 = nb * 32; q.d0 = nb * 32; return q; }
    r -= I_QUP;
    if (r < I_KVUP) { const int kb = r / 64, nb = r % 64;
        q.W = a->in[17] + (size_t)j * 256 * 2048; q.WT = (bf16_t*)(ws + WS_WKVUP) + (size_t)j * 2048 * 256; q.K = 256; q.N = 2048; q.k0 = kb * 64; q.n0 = nb * 32; q.d0 = nb * 32; return q; }
    r -= I_KVUP;
    if (r < I_OUT) { const int kb = r / 64, nb = r % 64;
        q.W = a->in[22] + (size_t)j * 2048 * 2048; q.WT = (bf16_t*)(ws + WS_WOUTAB) + (size_t)j * 2048 * 2048; q.K = 2048; q.N = 2048; q.k0 = kb * 64; q.n0 = nb * 32; q.d0 = nb * 32; return q; }
    r -= I_OUT;
    if (r < I_INC) { const int kb = r / 160, nb = r % 160;
        q.W = a->in[26] + (size_t)j * 2048 * 5120; q.WT = (bf16_t*)(ws + WS_WINC) + (size_t)j * 5120 * 2048; q.K = 2048; q.N = 5120; q.k0 = kb * 64; q.n0 = nb * 32; q.d0 = nb * 32; return q; }
    r -= I_INC;
    { const int kb = r / 64, nb = r % 64;
        q.W = a->in[30] + (size_t)j * 2048 * 2048; q.WT = (bf16_t*)(ws + WS_WOUTC) + (size_t)j * 2048 * 2048; q.K = 2048; q.N = 2048; q.k0 = kb * 64; q.n0 = nb * 32; q.d0 = nb * 32; return q; }
}

__device__ __forceinline__ void p0_transposes(KArgs a, LAS unsigned char* lds, int lo, int hi, int w, int NW) {
    const int lane = otid() & 63, wave = (otid() >> 6);
    LAS float* scr = (LAS float*)(lds + wave * 8448);
    for (int it = lo + w; it < hi; it += 2 * NW) {
        const bool two = it + NW < hi;
        const P0Item qa = p0_decode(a, it); const P0Item qb = p0_decode(a, two ? it + NW : it);
        float va[32], vb[32];
        p0_load(qa, va, lane); if (two) p0_load(qb, vb, lane);
        p0_emit(qa, va, scr, lane); if (two) p0_emit(qb, vb, scr, lane);
    }
}
constexpr int P0_EARLY = 32 * 218 + 8 * 48 + 4 * 64 + 32 * 64;
constexpr int P0_TOTAL = 2 * (32 * 218 + 8 * 48 + 4 * 64 + 32 * 64 + 32 * 160 + 32 * 64);
__device__ __forceinline__ void phase_p0(KArgs a, LAS unsigned char* lds) {
    const int tid = otid(), lane = tid & 63, wave = tid >> 6;
    const int G = gridDim.x, bid = obid();
    const int gw = bid * NWAVES + wave, NGW = G * NWAVES;
    unsigned char* ws = a->ws;
    p0_transposes(a, lds, 0, P0_EARLY, gw, NGW);
    p0_transposes(a, lds, P0_EARLY + 16000, P0_TOTAL, gw, NGW);
    const int gt = bid * NTHR + tid, NGT = G * NTHR;
    const unsigned zz = ozero();
    for (int i = gt; i < 2 * 192 * 256; i += NGT) { const int j = i / (192 * 256), r = i % (192 * 256);
        *(u32x4*)((bf16_t*)(ws + WS_WINAB) + (size_t)j * 7168 * 2048 + (size_t)6976 * 2048 + (size_t)r * 8) = (u32x4){zz, zz, zz, zz}; }
    for (int i = gt; i < 2 * 131072; i += NGT) { const int which = i / 131072, e = (i % 131072) * 8;
        const float* src = a->in[6 + which] + e; const f32x4 x0 = *(const f32x4*)src, x1 = *(const f32x4*)(src + 4);
        u32x4 w; w.x = pk2(x0[0], x0[1]); w.y = pk2(x0[2], x0[3]); w.z = pk2(x1[0], x1[1]); w.w = pk2(x1[2], x1[3]);
        *(u32x4*)((bf16_t*)(ws + WS_KCC) + (size_t)(e >> 9) * LDP_C + (which ? 512 : 0) + (e & 511)) = w; }
    for (int i = gt; i < 2 * 2048; i += NGT) { const int j = i / 2048, r = i % 2048; const float l0 = a->in[20][r], l1 = a->in[20][2048 + r];
        ((float*)(ws + WS_LB))[i] = j == 0 ? 0.f : 1.f / (1.f + __expf(l0 - l1)); }
    for (int i = gt; i < 2048 * 32; i += NGT) { const int t = i >> 5, f = i & 31; const float pos = f < 16 ? (float)(t >> 6) : (float)(t & 63);
        const float inv = exp2f(-(float)(f & 15) * (13.287712379549449f / 16.f)); const float ang = pos * inv;
        ((float*)(ws + WS_ROPEA))[2 * i] = __cosf(ang); ((float*)(ws + WS_ROPEA))[2 * i + 1] = __sinf(ang); }
    for (int i = gt; i < 2048 * 64; i += NGT) { const int t = i >> 6, f = i & 63; const float pos = f < 32 ? (float)(t >> 6) : (float)(t & 63);
        const float inv = exp2f(-(float)(f & 31) * (13.287712379549449f / 32.f)); const float ang = pos * inv;
        ((float*)(ws + WS_ROPEC))[2 * i] = __cosf(ang); ((float*)(ws + WS_ROPEC))[2 * i + 1] = __sinf(ang); }
    __syncthreads();
    {
        LAS float* SC = (LAS float*)lds;
        LAS float* RED = (LAS float*)(lds + 40960);
        for (int i = tid; i < 5 * 2048; i += NTHR) { const int b = i >> 11, k = i & 2047; const float x = b < 4 ? a->in[8][b * 2048 + k] : a->in[9][k]; SC[i] = silu_f(x); }
        __syncthreads();
        const int cq = tid & 7, ks = tid >> 3;
        for (int u = bid; u < 768; u += G) {
            const int L = u / 192, col0 = (u % 192) * 32;
            const float* W = ((L & 1) ? a->in[23] : a->in[10]) + (size_t)(L >> 1) * 2048 * 6144;
            const float* bias = ((L & 1) ? a->in[24] : a->in[11]) + (size_t)(L >> 1) * 6144;
            f32x4 acc[5];
#pragma unroll
            for (int b = 0; b < 5; ++b) acc[b] = (f32x4){0.f, 0.f, 0.f, 0.f};
#pragma unroll 16
            for (int kk = 0; kk < 32; ++kk) { const int k = 32 * ks + kk; const f32x4 w = *(const f32x4*)(W + (size_t)k * 6144 + col0 + 4 * cq);
#pragma unroll
                for (int b = 0; b < 5; ++b) acc[b] += SC[b * 2048 + k] * w; }
#pragma unroll
            for (int b = 0; b < 5; ++b) *(LAS f32x4*)(RED + (ks * 5 + b) * 32 + 4 * cq) = acc[b];
            __syncthreads();
            if (tid < 160) { const int b = tid >> 5, c = tid & 31; float s = 0.f;
                for (int q = 0; q < 64; ++q) s += RED[(q * 5 + b) * 32 + c];
                ((float*)(ws + WS_MOD))[(L * 5 + b) * 6144 + col0 + c] = s + bias[col0 + c]; }
            __syncthreads();
        }
    }
}

__device__ __forceinline__ void phase_modnorm(KArgs a, int L) {
    const int tid = otid(), lane = tid & 63, wave = tid >> 6;
    const int gw = obid() * NWAVES + wave, NGW = gridDim.x * NWAVES;
    const float* g = ((L & 1) ? a->in[25] : a->in[12]) + (L >> 1) * 2048;
    bf16_t* H = (bf16_t*)(a->ws + WS_H);
    for (int r0 = gw * 2; r0 < MROWS; r0 += NGW * 2) {
        f32x4 v[2][8]; float ss[2] = {0.f, 0.f};
#pragma unroll
        for (int u = 0; u < 2; ++u) { const int r = r0 + u;
            const float* x = L <= 1 ? (r < MC ? a->in[0] + (size_t)r * DM : a->in[1] + (size_t)(r - MC) * DM) : a->out + (size_t)r * DM;
#pragma unroll
            for (int j = 0; j < 8; ++j) v[u][j] = *(const f32x4*)(x + 256 * j + 4 * lane);
            if (L > 0) { const bf16_t* dp = (const bf16_t*)(a->ws + WS_PROJ) + (size_t)r * DM;
#pragma unroll
                for (int j = 0; j < 8; ++j) { const u32x2 dv = *(const u32x2*)(dp + 256 * j + 4 * lane);
                    v[u][j][0] += __uint_as_float(dv.x << 16); v[u][j][1] += __uint_as_float(dv.x & 0xffff0000u); v[u][j][2] += __uint_as_float(dv.y << 16); v[u][j][3] += __uint_as_float(dv.y & 0xffff0000u);
                    *(f32x4*)(a->out + (size_t)r * DM + 256 * j + 4 * lane) = v[u][j]; } } }
#pragma unroll
        for (int u = 0; u < 2; ++u) {
#pragma unroll
            for (int j = 0; j < 8; ++j) ss[u] += (v[u][j][0] * v[u][j][0] + v[u][j][1] * v[u][j][1]) + (v[u][j][2] * v[u][j][2] + v[u][j][3] * v[u][j][3]); }
#pragma unroll
        for (int u = 0; u < 2; ++u) { const int r = r0 + u;
            const int ci = r < MC ? 4 : ((r - MC) >> 11);
            const float* md = (const float*)(a->ws + WS_MOD) + (L * 5 + ci) * 6144;
            const float rstd = rsqrtf(wave_sum(ss[u]) * (1.f / 2048.f) + EPSN);
#pragma unroll
            for (int j = 0; j < 8; ++j) { const int c = 256 * j + 4 * lane;
                const f32x4 gg = *(const f32x4*)(g + c), sh = *(const f32x4*)(md + c), sc = *(const f32x4*)(md + 2048 + c);
                const f32x4 y = (v[u][j] * rstd * gg) * (sc + 1.f) + sh;
                u32x2 w; w.x = pk2(y[0], y[1]); w.y = pk2(y[2], y[3]);
                *(u32x2*)(H + (size_t)r * DM + c) = w; } }
    }
}

__device__ __forceinline__ void phase_final(KArgs a) {
    const int tid = otid();
    const int gt = obid() * NTHR + tid, NGT = gridDim.x * NTHR;
    const bf16_t* D = (const bf16_t*)(a->ws + WS_PROJ); float* out = a->out;
    for (int i = gt; i < MROWS * DM / 8; i += NGT) { const size_t e = (size_t)i * 8;
        const bf16x8 dv = *(const bf16x8*)(D + e); f32x4 x0 = *(const f32x4*)(out + e), x1 = *(const f32x4*)(out + e + 4);
        x0[0] += bf2f((unsigned short)dv[0]); x0[1] += bf2f((unsigned short)dv[1]); x0[2] += bf2f((unsigned short)dv[2]); x0[3] += bf2f((unsigned short)dv[3]);
        x1[0] += bf2f((unsigned short)dv[4]); x1[1] += bf2f((unsigned short)dv[5]); x1[2] += bf2f((unsigned short)dv[6]); x1[3] += bf2f((unsigned short)dv[7]);
        *(f32x4*)(out + e) = x0; *(f32x4*)(out + e + 4) = x1; }
}

__device__ __forceinline__ void phase_prep_ab(KArgs a, int j, int wg, int nwg) {
    const int tid = otid(), lane = tid & 63, wave = tid >> 6;
    const int gw = wg * NWAVES + wave, NGW = nwg * NWAVES;
    const bf16_t* P = (const bf16_t*)(a->ws + WS_PROJ);
    bf16_t* QN = (bf16_t*)(a->ws + WS_QN); bf16_t* CKV = (bf16_t*)(a->ws + WS_CKV);
    const float* gq = a->in[14] + j * 512; const float* gkv = a->in[15] + j * 256;
    for (int r = gw; r < MKROWS; r += NGW) {
        if (r < MROWS) {
            const bf16_t* p = P + (size_t)r * LDP_AB;
            const bf16x8 q = *(const bf16x8*)(p + COL_QL + 8 * lane);
            float qv[8]; float ss = 0.f;
#pragma unroll
            for (int e = 0; e < 8; ++e) { qv[e] = bf2f((unsigned short)q[e]); ss += qv[e] * qv[e]; }
            const float rq = rsqrtf(wave_sum(ss) * (1.f / 512.f) + EPSN);
#pragma unroll
            for (int e = 0; e < 8; ++e) qv[e] = qv[e] * rq * gq[8 * lane + e];
            *(bf16x8*)(QN + (size_t)r * 512 + 8 * lane) = pack8(qv);
            const s16x4 kv = *(const s16x4*)(p + COL_KVL + 4 * lane);
            float kf[4]; float s2 = 0.f;
#pragma unroll
            for (int e = 0; e < 4; ++e) { kf[e] = bf2f((unsigned short)kv[e]); s2 += kf[e] * kf[e]; }
            const float rk = rsqrtf(wave_sum(s2) * (1.f / 256.f) + EPSN);
#pragma unroll
            for (int e = 0; e < 4; ++e) kf[e] = kf[e] * rk * gkv[4 * lane + e];
            u32x2 w; w.x = pk2(kf[0], kf[1]); w.y = pk2(kf[2], kf[3]);
            *(u32x2*)(CKV + (size_t)r * 256 + 4 * lane) = w;
            if (r < MC) { const int b = r >> 8, t = r & 255; const size_t rowo = (size_t)((b * 2 + j) * 256 + t);
                *(f32x4*)(a->out + O_CKV + rowo * 256 + 4 * lane) = (f32x4){kf[0], kf[1], kf[2], kf[3]};
                a->out[O_KPE + rowo * 64 + lane] = bf2f(p[COL_KPE + lane]); }
        } else {
            const int rr = r - MROWS, b = rr >> 8, t = rr & 255;
            const f32x4 x = *(const f32x4*)(a->in[2] + (size_t)((b * 2 + j) * 256 + t) * 256 + 4 * lane);
            u32x2 w; w.x = pk2(x[0], x[1]); w.y = pk2(x[2], x[3]);
            *(u32x2*)(CKV + (size_t)r * 256 + 4 * lane) = w;
        }
    }
}

__device__ __forceinline__ void phase_hn_ab(KArgs a, int j, int wg, int nwg) {
    const int tid = otid(), lane = tid & 63, wave = tid >> 6, sub = lane & 15, hq = lane >> 4;
    const int gw = wg * NWAVES + wave, NGW = nwg * NWAVES;
    bf16_t* Q = (bf16_t*)(a->ws + WS_QRAW); const bf16_t* KV = (const bf16_t*)(a->ws + WS_KVRAW); bf16_t* KF = (bf16_t*)(a->ws + WS_KF);
    const bf16_t* P = (const bf16_t*)(a->ws + WS_PROJ);
    const float* RA = (const float*)(a->ws + WS_ROPEA);
    const float* gq = a->in[18] + j * 192; const float* gk = a->in[19] + j * 192;
    const float* ckpe = a->in[3];
    constexpr int U = 4;
    const int NQ = 0, NIT = MKROWS * 2;
    for (int base = gw * U; base < NIT; base += NGW * U) {
        bf16x8 vn[U]; float x1[U][2], x2[U][2]; f32x4 cs[U];
#pragma unroll
        for (int u = 0; u < U; ++u) { const int it = base + u; if (it < NIT) {
            const bool isq = it < NQ; const int w = isq ? it : it - NQ; const int r = w >> 1, h = (w & 1) * 4 + hq;
            if (isq) { const bf16_t* p = Q + (size_t)r * 1536 + h * 192;
                vn[u] = *(const bf16x8*)(p + 8 * sub); const unsigned a1 = *(const unsigned*)(p + 128 + 2 * sub), a2 = *(const unsigned*)(p + 160 + 2 * sub);
                x1[u][0] = bf2f(a1 & 0xffff); x1[u][1] = bf2f(a1 >> 16); x2[u][0] = bf2f(a2 & 0xffff); x2[u][1] = bf2f(a2 >> 16);
            } else { vn[u] = *(const bf16x8*)(KV + (size_t)r * 2048 + h * 256 + 8 * sub);
                if (r < MROWS) { const bf16_t* pe = P + (size_t)r * LDP_AB + COL_KPE; const unsigned a1 = *(const unsigned*)(pe + 2 * sub), a2 = *(const unsigned*)(pe + 32 + 2 * sub);
                    x1[u][0] = bf2f(a1 & 0xffff); x1[u][1] = bf2f(a1 >> 16); x2[u][0] = bf2f(a2 & 0xffff); x2[u][1] = bf2f(a2 >> 16); }
                else { const int rr = r - MROWS, b = rr >> 8, t = rr & 255; const float* pe = ckpe + (size_t)((b * 2 + j) * 256 + t) * 64;
                    x1[u][0] = pe[2 * sub]; x1[u][1] = pe[2 * sub + 1]; x2[u][0] = pe[32 + 2 * sub]; x2[u][1] = pe[32 + 2 * sub + 1]; } }
            if (r >= MC && r < MROWS) cs[u] = *(const f32x4*)(RA + (((r - MC) & 2047) * 32 + 2 * sub) * 2);
        } }
#pragma unroll
        for (int u = 0; u < U; ++u) { const int it = base + u; if (it < NIT) {
            const bool isq = it < NQ; const int w = isq ? it : it - NQ; const int r = w >> 1, h = (w & 1) * 4 + hq;
            float xn[8];
#pragma unroll
            for (int e = 0; e < 8; ++e) xn[e] = bf2f((unsigned short)vn[u][e]);
            float ss = x1[u][0] * x1[u][0] + x1[u][1] * x1[u][1] + x2[u][0] * x2[u][0] + x2[u][1] * x2[u][1];
#pragma unroll
            for (int e = 0; e < 8; ++e) ss += xn[e] * xn[e];
            const float rstd = rsqrtf(sum16(ss) * (1.f / 192.f) + EPSN);
            const float* g = isq ? gq : gk;
#pragma unroll
            for (int e = 0; e < 8; ++e) xn[e] = xn[e] * rstd * g[8 * sub + e];
            float y1[2], y2[2];
            y1[0] = x1[u][0] * rstd * g[128 + 2 * sub]; y1[1] = x1[u][1] * rstd * g[128 + 2 * sub + 1]; y2[0] = x2[u][0] * rstd * g[160 + 2 * sub]; y2[1] = x2[u][1] * rstd * g[160 + 2 * sub + 1];
            if (r >= MC && r < MROWS) {
#pragma unroll
                for (int q = 0; q < 2; ++q) { const float c = cs[u][2 * q], sn = cs[u][2 * q + 1];
                    const float z1 = y1[q] * c - y2[q] * sn, z2 = y1[q] * sn + y2[q] * c; y1[q] = z1; y2[q] = z2; } }
            bf16_t* p;
            if (isq) {
#pragma unroll
                for (int e = 0; e < 8; ++e) xn[e] *= QSC_A;
                y1[0] *= QSC_A; y1[1] *= QSC_A; y2[0] *= QSC_A; y2[1] *= QSC_A;
                p = Q + (size_t)r * 1536 + h * 192;
            } else p = KF + (size_t)r * 1536 + h * 192;
            *(bf16x8*)(p + 8 * sub) = pack8(xn); *(unsigned*)(p + 128 + 2 * sub) = pk2(y1[0], y1[1]); *(unsigned*)(p + 160 + 2 * sub) = pk2(y2[0], y2[1]);
        } }
    }
}

__device__ __forceinline__ void phase_fin_ab(KArgs a, int j) {
    const int tid = otid(), lane = tid & 63, wave = tid >> 6, sub = lane & 15, hq = lane >> 4;
    const int gw = obid() * NWAVES + wave, NGW = gridDim.x * NWAVES;
    const bf16_t* OF = (const bf16_t*)(a->ws + WS_OF); const bf16_t* OB = (const bf16_t*)(a->ws + WS_OB);
    const bf16_t* P = (const bf16_t*)(a->ws + WS_PROJ); bf16_t* MIX = (bf16_t*)(a->ws + WS_H);
    const float* g = a->in[21] + j * 128;
    constexpr int U = 4;
    for (int base = gw * U; base < MROWS * 2; base += NGW * U) {
        bf16x8 va[U], vb[U], vg[U];
#pragma unroll
        for (int u = 0; u < U; ++u) { const int it = base + u; const int r = it >> 1, h = (it & 1) * 4 + hq; const size_t o = (size_t)r * 1024 + h * 128 + 8 * sub;
            va[u] = *(const bf16x8*)(OF + o); vb[u] = *(const bf16x8*)(OB + o); vg[u] = *(const bf16x8*)(P + (size_t)r * LDP_AB + COL_BG + h * 128 + 8 * sub); }
#pragma unroll
        for (int u = 0; u < U; ++u) { const int it = base + u; const int r = it >> 1, h = (it & 1) * 4 + hq;
            float s[8]; float ss = 0.f;
#pragma unroll
            for (int e = 0; e < 8; ++e) { s[e] = bf2f((unsigned short)va[u][e]) + bf2f((unsigned short)vb[u][e]); ss += s[e] * s[e]; }
            const float rstd = rsqrtf(sum16(ss) * (1.f / 128.f) + EPSN);
#pragma unroll
            for (int e = 0; e < 8; ++e) s[e] = s[e] * rstd * g[8 * sub + e] * silu_f(bf2f((unsigned short)vg[u][e]));
            *(bf16x8*)(MIX + (size_t)r * DM + 1024 + h * 128 + 8 * sub) = pack8(s); }
    }
}

__device__ __forceinline__ void phase_hn_c(KArgs a, int j) {
    const int tid = otid(), lane = tid & 63, wave = tid >> 6, sub = lane & 15, hq = lane >> 4;
    const int gw = obid() * NWAVES + wave, NGW = gridDim.x * NWAVES;
    bf16_t* P = (bf16_t*)(a->ws + WS_PROJ);
    const float* RC = (const float*)(a->ws + WS_ROPEC);
    const float* gq = a->in[27] + j * 128; const float* gk = a->in[28] + j * 128;
    float* outp = a->out;
    for (int r = gw; r < MC; r += NGW) { const int b = r >> 8, t = r & 255; const bf16x8 v = *(const bf16x8*)(P + (size_t)r * LDP_C + 2560 + 8 * lane);
        float* o = outp + O_VC + (size_t)((b * 2 + j) * 256 + t) * 512 + 8 * lane;
        *(f32x4*)o = (f32x4){bf2f((unsigned short)v[0]), bf2f((unsigned short)v[1]), bf2f((unsigned short)v[2]), bf2f((unsigned short)v[3])};
        *(f32x4*)(o + 4) = (f32x4){bf2f((unsigned short)v[4]), bf2f((unsigned short)v[5]), bf2f((unsigned short)v[6]), bf2f((unsigned short)v[7])}; }
    constexpr int U = 4;
    const int NIT = MROWS;
    for (int base = gw * U; base < NIT; base += NGW * U) {
        s16x4 v1[U], v2[U]; f32x4 ca[U], cb[U];
#pragma unroll
        for (int u = 0; u < U; ++u) { const int it = base + u; if (it < NIT) {
            const int r = it, h = 16 + hq; const bool isq = false;
            const bf16_t* p = P + (size_t)r * LDP_C + (isq ? h * 128 : 2048 + (h - 16) * 128);
            v1[u] = *(const s16x4*)(p + 4 * sub); v2[u] = *(const s16x4*)(p + 64 + 4 * sub);
            if (r >= MC) { const float* rc = RC + (((r - MC) & 2047) * 64 + 4 * sub) * 2; ca[u] = *(const f32x4*)rc; cb[u] = *(const f32x4*)(rc + 4); }
        } }
#pragma unroll
        for (int u = 0; u < U; ++u) { const int it = base + u; if (it < NIT) {
            const int r = it, h = 16 + hq; const bool isq = false;
            bf16_t* p = P + (size_t)r * LDP_C + (isq ? h * 128 : 2048 + (h - 16) * 128);
            float x1[4], x2[4]; float ss = 0.f;
#pragma unroll
            for (int e = 0; e < 4; ++e) { x1[e] = bf2f((unsigned short)v1[u][e]); x2[e] = bf2f((unsigned short)v2[u][e]); ss += x1[e] * x1[e] + x2[e] * x2[e]; }
            const float rstd = rsqrtf(sum16(ss) * (1.f / 128.f) + EPSN);
            const float* g = isq ? gq : gk;
#pragma unroll
            for (int e = 0; e < 4; ++e) { x1[e] *= rstd * g[4 * sub + e]; x2[e] *= rstd * g[64 + 4 * sub + e]; }
            if (r >= MC) {
#pragma unroll
                for (int e = 0; e < 4; ++e) { const float c = e < 2 ? ca[u][2 * e] : cb[u][2 * (e - 2)], sn = e < 2 ? ca[u][2 * e + 1] : cb[u][2 * (e - 2) + 1];
                    const float y1 = x1[e] * c - x2[e] * sn, y2 = x1[e] * sn + x2[e] * c; x1[e] = y1; x2[e] = y2; } }
            else if (!isq) { const int b = r >> 8, t = r & 255; float* o = outp + O_KC + (size_t)((b * 2 + j) * 256 + t) * 512 + (h - 16) * 128;
                *(f32x4*)(o + 4 * sub) = (f32x4){x1[0], x1[1], x1[2], x1[3]}; *(f32x4*)(o + 64 + 4 * sub) = (f32x4){x2[0], x2[1], x2[2], x2[3]}; }
            if (isq) {
#pragma unroll
                for (int e = 0; e < 4; ++e) { x1[e] *= QSC_C; x2[e] *= QSC_C; } }
            u32x2 w1, w2; w1.x = pk2(x1[0], x1[1]); w1.y = pk2(x1[2], x1[3]); w2.x = pk2(x2[0], x2[1]); w2.y = pk2(x2[2], x2[3]);
            *(u32x2*)(p + 4 * sub) = w1; *(u32x2*)(p + 64 + 4 * sub) = w2;
        } }
    }
}

namespace att {
__device__ __forceinline__ int crow(int r, int hi) { return (r & 3) + 8 * (r >> 2) + 4 * hi; }
__device__ __forceinline__ unsigned cvtpk(float lo, float hi) { return pk2(lo, hi); }
__device__ __forceinline__ int v_st(int k, int c) { const int kk = (k & ~0xC) | ((k & 4) << 1) | ((k & 8) >> 1); return ((kk >> 3) * 4 + (c >> 5)) * 512 + ((kk & 7) * 32 + (c & 31)) * 2; }
__device__ __forceinline__ int v_rd_base(int lane) { return ((lane & 3) << 3) | (((lane >> 2) & 3) << 6) | (((lane >> 4) & 1) << 5) | (((lane >> 5) & 1) << 8); }
constexpr int v_rd_off(int d0, int ks, int half) { return d0 * 512 + ks * 4096 + half * 2048; }
template <int OFF> __device__ __forceinline__ s16x4 tr_read(int vb) {
    s16x4 r; asm volatile("ds_read_b64_tr_b16 %0, %1 offset:%2" : "=&v"(r) : "v"(vb), "i"(OFF) : "memory"); return r;
}
template <int D0> __device__ __forceinline__ void pv_read8(s16x4 (&r)[8], int vb) {
    r[0] = tr_read<v_rd_off(D0, 0, 0)>(vb); r[1] = tr_read<v_rd_off(D0, 0, 1)>(vb); r[2] = tr_read<v_rd_off(D0, 1, 0)>(vb); r[3] = tr_read<v_rd_off(D0, 1, 1)>(vb);
    r[4] = tr_read<v_rd_off(D0, 2, 0)>(vb); r[5] = tr_read<v_rd_off(D0, 2, 1)>(vb); r[6] = tr_read<v_rd_off(D0, 3, 0)>(vb); r[7] = tr_read<v_rd_off(D0, 3, 1)>(vb);
}
__device__ __forceinline__ void pv_mma4(f32x16& od, const s16x4 (&r)[8], bf16x8 pa0, bf16x8 pa1, bf16x8 pa2, bf16x8 pa3) {
#define ATT_PK(L, H) (bf16x8){L[0], L[1], L[2], L[3], H[0], H[1], H[2], H[3]}
    od = __builtin_amdgcn_mfma_f32_32x32x16_bf16(pa0, ATT_PK(r[0], r[1]), od, 0, 0, 0);
    od = __builtin_amdgcn_mfma_f32_32x32x16_bf16(pa1, ATT_PK(r[2], r[3]), od, 0, 0, 0);
    od = __builtin_amdgcn_mfma_f32_32x32x16_bf16(pa2, ATT_PK(r[4], r[5]), od, 0, 0, 0);
    od = __builtin_amdgcn_mfma_f32_32x32x16_bf16(pa3, ATT_PK(r[6], r[7]), od, 0, 0, 0);
#undef ATT_PK
}
__device__ __forceinline__ void pv_all(f32x16 (&o)[4], int vb, bf16x8 pa0, bf16x8 pa1, bf16x8 pa2, bf16x8 pa3) {
    s16x4 ra[8], rb[8];
    pv_read8<0>(ra, vb);
    pv_read8<1>(rb, vb); asm volatile("s_waitcnt lgkmcnt(8)" ::: "memory"); __builtin_amdgcn_sched_barrier(0);
    pv_mma4(o[0], ra, pa0, pa1, pa2, pa3); __builtin_amdgcn_sched_barrier(0);
    pv_read8<2>(ra, vb); asm volatile("s_waitcnt lgkmcnt(8)" ::: "memory"); __builtin_amdgcn_sched_barrier(0);
    pv_mma4(o[1], rb, pa0, pa1, pa2, pa3); __builtin_amdgcn_sched_barrier(0);
    pv_read8<3>(rb, vb); asm volatile("s_waitcnt lgkmcnt(8)" ::: "memory"); __builtin_amdgcn_sched_barrier(0);
    pv_mma4(o[2], ra, pa0, pa1, pa2, pa3); __builtin_amdgcn_sched_barrier(0);
    asm volatile("s_waitcnt lgkmcnt(0)" ::: "memory"); __builtin_amdgcn_sched_barrier(0);
    pv_mma4(o[3], rb, pa0, pa1, pa2, pa3);
}
struct Item {
    const bf16_t* Q; int ldq;
    const bf16_t* K0; const bf16_t* V0; int n0;
    const bf16_t* K1; const bf16_t* V1; int ldk, ldv, t_lo, t_hi;
    int q0, band; float m0, l0;
    const float* qg; const float* rope; float qscale;
    const bf16_t* G; int ldg; bf16_t* O; int ldo;
};
template <int DQK>
__device__ __forceinline__ void attn_item(LAS unsigned char* lds, const Item& it) {
    constexpr int KROW = DQK * 2, SHM_K = 64 * KROW, SHM_V = 64 * 128 * 2, ND = DQK / 16;
    const int tid = otid(), wid = tid >> 6, lane = tid & 63, r32 = lane & 31, hi = lane >> 5;
    LAS unsigned char* V_lds = lds; LAS unsigned char* K_lds = lds + 3 * SHM_V;
    LAS float* wsx = (LAS float*)(lds + 3 * SHM_V + 3 * SHM_K) + wid * 64; LAS float* li_l = wsx; LAS float* al_l = wsx + 32;
    float m_reg = it.m0, l_reg = it.l0;
    f32x16 o[4];
#pragma unroll
    for (int d = 0; d < 4; ++d)
#pragma unroll
        for (int r = 0; r < 16; ++r) o[d][r] = 0.f;
    bf16x8 qr[ND];
    {
      const bf16_t* Qw = it.Q + (size_t)(wid * 32 + r32) * it.ldq + hi * 8;
      float xf[ND][8]; float ss = 0.f;
#pragma unroll
      for (int d0 = 0; d0 < ND; ++d0) { const bf16x8 v = *(const bf16x8*)(Qw + d0 * 16);
#pragma unroll
          for (int e = 0; e < 8; ++e) { xf[d0][e] = bf2f((unsigned short)v[e]); ss += xf[d0][e] * xf[d0][e]; } }
      ss += __shfl_xor(ss, 32);
      const float rstd = rsqrtf(ss * (1.f / (float)DQK) + EPSN);
#pragma unroll
      for (int d0 = 0; d0 < ND; ++d0) { const f32x4 g0 = *(const f32x4*)(it.qg + d0 * 16 + hi * 8), g1 = *(const f32x4*)(it.qg + d0 * 16 + hi * 8 + 4);
#pragma unroll
          for (int e = 0; e < 8; ++e) xf[d0][e] *= rstd * (e < 4 ? g0[e & 3] : g1[e & 3]); }
      if (it.rope) { constexpr int NR = DQK == 128 ? 4 : 2, RB = DQK == 128 ? 0 : 8, RS = DQK == 128 ? 64 : 32;
          const float* rp = it.rope + (size_t)((it.q0 + wid * 32 + r32) * RS + hi * 8) * 2;
#pragma unroll
          for (int p = 0; p < NR; ++p) { f32x4 cs4[4];
#pragma unroll
              for (int q = 0; q < 4; ++q) cs4[q] = *(const f32x4*)(rp + p * 32 + 4 * q);
#pragma unroll
              for (int e = 0; e < 8; ++e) { const float c = cs4[e >> 1][(e & 1) * 2], sn = cs4[e >> 1][(e & 1) * 2 + 1];
                  const float x1 = xf[RB + p][e], x2 = xf[RB + NR + p][e]; xf[RB + p][e] = x1 * c - x2 * sn; xf[RB + NR + p][e] = x1 * sn + x2 * c; } } }
#pragma unroll
      for (int d0 = 0; d0 < ND; ++d0) { float t8[8];
#pragma unroll
          for (int e = 0; e < 8; ++e) t8[e] = xf[d0][e] * it.qscale;
          qr[d0] = pack8(t8); } }
    const int NT = it.n0 + (it.t_hi - it.t_lo);
    const int wvu = __builtin_amdgcn_readfirstlane(wid);
    const int vb0 = (int)(uintptr_t)V_lds + v_rd_base(lane);
    constexpr int NKI = SHM_K / 8192;
    unsigned kog[NKI], vog[2];
#pragma unroll
    for (int i = 0; i < NKI; ++i) { const int off = i * 8192 + wid * 1024 + lane * 16, row = off / KROW, pos = off % KROW; kog[i] = (unsigned)(row * it.ldk + ((pos ^ ((row & 7) << 4)) >> 1)); }
#pragma unroll
    for (int i = 0; i < 2; ++i) { const int q = (i * 8192 + wid * 1024 + lane * 16) >> 4, sub = q >> 5, rem = q & 31, rowin = rem >> 2, cch = rem & 3;
        const int kk = (sub >> 2) * 8 + rowin; vog[i] = (unsigned)(((kk & ~0xC) | ((kk & 4) << 1) | ((kk & 8) >> 1)) * it.ldv + (sub & 3) * 32 + cch * 8); }
    int koff[4];
#pragma unroll
    for (int dl = 0; dl < 4; ++dl) koff[dl] = r32 * KROW + ((dl * 32 + hi * 16) ^ ((r32 & 7) << 4));
#define ATT_STAGE(jj, b) do { const int _j = (jj); const bool _s0 = _j < it.n0; const int _t = _s0 ? _j : it.t_lo + (_j - it.n0); \
        const bf16_t* _Kp = (_s0 ? it.K0 : it.K1) + (size_t)(64 * _t) * it.ldk; const bf16_t* _Vp = (_s0 ? it.V0 : it.V1) + (size_t)(64 * _t) * it.ldv; \
        _Pragma("unroll") for (int _i = 0; _i < NKI; ++_i) __builtin_amdgcn_global_load_lds((const unsigned*)(_Kp + kog[_i]), (LAS unsigned*)(K_lds + (b) * SHM_K + _i * 8192 + wvu * 1024), 16, 0, 0); \
        _Pragma("unroll") for (int _i = 0; _i < 2; ++_i) __builtin_amdgcn_global_load_lds((const unsigned*)(_Vp + vog[_i]), (LAS unsigned*)(V_lds + (b) * SHM_V + _i * 8192 + wvu * 1024), 16, 0, 0); } while (0)
#define ATT_WAIT_TILE(more) do { if (more) { if constexpr (NKI == 3) asm volatile("s_waitcnt vmcnt(5)" ::: "memory"); else asm volatile("s_waitcnt vmcnt(4)" ::: "memory"); } \
        else asm volatile("s_waitcnt vmcnt(0)" ::: "memory"); \
        asm volatile("s_waitcnt lgkmcnt(0)" ::: "memory"); __builtin_amdgcn_s_barrier(); asm volatile("" ::: "memory"); } while (0)
    ATT_STAGE(0, 0); if (NT > 1) ATT_STAGE(1, 1);
    ATT_WAIT_TILE(NT > 1);
    int cur = 0;
    for (int j = 0; j < NT; ++j) {
        if (j + 2 < NT) ATT_STAGE(j + 2, (cur == 0 ? 2 : cur - 1));
        bool act = true; const bool domask = it.band && j >= it.n0; int kpos0 = 0;
        if (domask) { kpos0 = 64 * (it.t_lo + j - it.n0); const int qlo = it.q0 + wid * 32; act = (kpos0 + 63 >= qlo - 128) && (kpos0 <= qlo + 31 + 128); }
        if (act) {
            f32x16 p0, p1;
#pragma unroll
            for (int r = 0; r < 16; ++r) { p0[r] = 0.f; p1[r] = 0.f; }
            const LAS unsigned char* Ks = K_lds + cur * SHM_K;
            {
                constexpr int NG = ND / 4;
                bf16x8 kf[2][8];
#define ATT_LOADG(g_, dst) do { _Pragma("unroll") for (int u_ = 0; u_ < 4; ++u_) { dst[2 * u_] = *(const LAS bf16x8*)(Ks + koff[u_] + (g_) * 128); dst[2 * u_ + 1] = *(const LAS bf16x8*)(Ks + koff[u_] + (g_) * 128 + 32 * KROW); } } while (0)
                ATT_LOADG(0, kf[0]);
#pragma unroll
                for (int g = 0; g < NG; ++g) {
                    if (g + 1 < NG) ATT_LOADG(g + 1, kf[(g + 1) & 1]);
                    __builtin_amdgcn_sched_barrier(0);
#pragma unroll
                    for (int u_ = 0; u_ < 4; ++u_) { p0 = __builtin_amdgcn_mfma_f32_32x32x16_bf16(kf[g & 1][2 * u_], qr[4 * g + u_], p0, 0, 0, 0);
                        p1 = __builtin_amdgcn_mfma_f32_32x32x16_bf16(kf[g & 1][2 * u_ + 1], qr[4 * g + u_], p1, 0, 0, 0); }
                    __builtin_amdgcn_sched_barrier(0); }
#undef ATT_LOADG
            }
            if (domask) { const int qp = it.q0 + wid * 32 + r32;
#pragma unroll
                for (int r = 0; r < 16; ++r) { const int d = kpos0 + crow(r, hi) - qp;
                    if (d > 128 || d < -128) p0[r] = -1e30f;
                    if (d + 32 > 128 || d + 32 < -128) p1[r] = -1e30f; } }
            float pmax = p0[0];
#pragma unroll
            for (int r = 1; r < 16; ++r) pmax = fmaxf(pmax, p0[r]);
#pragma unroll
            for (int r = 0; r < 16; ++r) pmax = fmaxf(pmax, p1[r]);
            { auto rr = __builtin_amdgcn_permlane32_swap(__float_as_uint(pmax), __float_as_uint(pmax), false, false);
              pmax = fmaxf(__uint_as_float(rr[0]), __uint_as_float(rr[1])); }
            const float mn = fmaxf(m_reg, pmax); const float alpha = __builtin_amdgcn_exp2f(m_reg - mn); m_reg = mn;
            float ps = 0.f;
#pragma unroll
            for (int r = 0; r < 16; ++r) { p0[r] = __builtin_amdgcn_exp2f(p0[r] - mn); p1[r] = __builtin_amdgcn_exp2f(p1[r] - mn); ps += p0[r] + p1[r]; }
            { auto rr = __builtin_amdgcn_permlane32_swap(__float_as_uint(ps), __float_as_uint(ps), false, false);
              ps = __uint_as_float(rr[0]) + __uint_as_float(rr[1]); }
            l_reg = l_reg * alpha + ps;
            bf16x8 pa0, pa1, pa2, pa3;
#define ATT_PK4(P, BASE, OUT) do { unsigned a0 = cvtpk(P[BASE + 0], P[BASE + 1]), a1 = cvtpk(P[BASE + 2], P[BASE + 3]);   \
    unsigned b0 = cvtpk(P[BASE + 4], P[BASE + 5]), b1 = cvtpk(P[BASE + 6], P[BASE + 7]);                              \
    auto r0 = __builtin_amdgcn_permlane32_swap(a0, b0, false, false); auto r1 = __builtin_amdgcn_permlane32_swap(a1, b1, false, false); \
    u32x4 w = {r0[0], r1[0], r0[1], r1[1]}; OUT = __builtin_bit_cast(bf16x8, w); } while (0)
            ATT_PK4(p0, 0, pa0); ATT_PK4(p0, 8, pa1); ATT_PK4(p1, 0, pa2); ATT_PK4(p1, 8, pa3);
#undef ATT_PK4
            if (__any(alpha < 1.f)) { if (hi == 0) al_l[r32] = alpha; asm volatile("s_waitcnt lgkmcnt(0)" ::: "memory");
#pragma unroll
                for (int r = 0; r < 16; ++r) { const float al = al_l[crow(r, hi)];
#pragma unroll
                    for (int d = 0; d < 4; ++d) o[d][r] *= al; } }
            const int vb = vb0 + cur * SHM_V;
            pv_all(o, vb, pa0, pa1, pa2, pa3);
        }
        ATT_WAIT_TILE(j + 2 < NT);
        cur = cur == 2 ? 0 : cur + 1;
    }
#undef ATT_STAGE
#undef ATT_WAIT_TILE
    const int er = lane >> 4, ec = (lane & 15) * 8;
    bf16x8 gv[8];
    { const bf16_t* Gw = it.G + (size_t)(wid * 32 + er) * it.ldg + ec;
#pragma unroll
      for (int c = 0; c < 8; ++c) gv[c] = *(const bf16x8*)(Gw + (size_t)(4 * c) * it.ldg); }
    if (hi == 0) li_l[r32] = l_reg; asm volatile("s_waitcnt lgkmcnt(0)" ::: "memory");
    LAS bf16_t* ost = (LAS bf16_t*)(lds + wid * 8192);
#pragma unroll
    for (int r = 0; r < 16; ++r) { const float rli = 1.f / li_l[crow(r, hi)];
#pragma unroll
        for (int d0 = 0; d0 < 4; ++d0) ost[crow(r, hi) * 128 + d0 * 32 + r32] = (bf16_t)f2bf(o[d0][r] * rli); }
    asm volatile("s_waitcnt lgkmcnt(0)" ::: "memory");
    { bf16_t* Ow = it.O + (size_t)(wid * 32 + er) * it.ldo + ec;
#pragma unroll
      for (int c = 0; c < 8; ++c) { const bf16x8 ov = *(const LAS bf16x8*)(ost + (4 * c + er) * 128 + ec); float t8[8];
#pragma unroll
          for (int e = 0; e < 8; ++e) t8[e] = bf2f((unsigned short)ov[e]) * silu_f(bf2f((unsigned short)gv[c][e]));
          *(bf16x8*)(Ow + (size_t)(4 * c) * it.ldo) = pack8(t8); } }
    __syncthreads();
}
}

__device__ __forceinline__ void hgrn_item(LAS unsigned char* lds, const bf16_t* PROJ, int rowbase, int T, int h, int dir,
                                          const float* lb, const float* s0, float* sout, bf16_t* OUT, int c0, int c1, float* sbuf) {
    LAS float* GS = (LAS float*)lds;
    LAS float* DEC = (LAS float*)(lds + 2048);
    LAS bf16_t* QT = (LAS bf16_t*)(lds + 2560);
    LAS bf16_t* KT = QT + 32 * 136;
    LAS bf16_t* KTt = KT + 32 * 136;
    LAS bf16_t* Vt = KTt + 128 * 40;
    const int tid = otid(), wid = tid >> 6, lane = tid & 63, fr = lane & 15, fq = lane >> 4;
    const int c2 = tid & 127, part = tid >> 7, n0 = wid * 16;
    f32x4 S[8];
    { const float* sin_ = c0 > 0 ? sbuf : (s0 ? s0 : sbuf);
      const float ssc = (c0 > 0 || s0) ? 1.f : 0.f;
#pragma unroll
      for (int kt = 0; kt < 8; ++kt)
#pragma unroll
          for (int r = 0; r < 4; ++r) S[kt][r] = sin_[(size_t)(16 * kt + 4 * fq + r) * 128 + n0 + fr] * ssc; }
    __builtin_amdgcn_s_waitcnt(0x0F70);
    const float oml = 1.f - lb[c2];
    const unsigned hz = ozero();
    const int nch = T / 32;
    LAS unsigned char* RAW = lds + 40960;
    const int wvu = __builtin_amdgcn_readfirstlane(wid);
    const int dtl = 4 * wid + (lane >> 4), dch = (lane & 15) * 8;
    const bf16_t* dsrc = PROJ + h * 128 + dch;
    const int colf = dir ? COL_FB : COL_FF;
#define HG_DMA(cc, slot) do { const int _p = 32 * (cc) + dtl; const int _tok = dir ? T - 1 - _p : _p; const bf16_t* _s = dsrc + (size_t)(rowbase + _tok) * LDP_AB; \
        __builtin_amdgcn_global_load_lds((const unsigned*)(_s + COL_BQ), (LAS unsigned*)(RAW + (slot) * 24576 + wvu * 1024), 16, 0, 0); \
        __builtin_amdgcn_global_load_lds((const unsigned*)(_s + colf), (LAS unsigned*)(RAW + (slot) * 24576 + 8192 + wvu * 1024), 16, 0, 0); \
        __builtin_amdgcn_global_load_lds((const unsigned*)(_s + COL_BI), (LAS unsigned*)(RAW + (slot) * 24576 + 16384 + wvu * 1024), 16, 0, 0); } while (0)
#define HG_BAR() do { asm volatile("s_waitcnt lgkmcnt(0)" ::: "memory"); __builtin_amdgcn_s_barrier(); asm volatile("" ::: "memory"); } while (0)
    HG_DMA(c0, 0); if (c0 + 1 < c1) HG_DMA(c0 + 1, 1);
    if (c0 + 1 < c1) asm volatile("s_waitcnt vmcnt(3)" ::: "memory"); else asm volatile("s_waitcnt vmcnt(0)" ::: "memory");
    HG_BAR();
    int cur = 0;
    for (int cc = c0; cc < c1; ++cc) {
        if (cc + 2 < c1) HG_DMA(cc + 2, (cur == 0 ? 2 : cur - 1));
        float b[8], kk[8], sq[8]; unsigned short vv[8];
        { const LAS bf16_t* rw = (const LAS bf16_t*)(RAW + cur * 24576) + (8 * part) * 128 + c2;
            unsigned short rq[8], rf[8];
#pragma unroll
            for (int i = 0; i < 8; ++i) { rq[i] = rw[i * 128]; rf[i] = rw[4096 + i * 128]; vv[i] = rw[8192 + i * 128]; }
            float run = 0.f;
#pragma unroll
            for (int i = 0; i < 8; ++i) { const float x = bf2f(rf[i]); const float omf = oml * __builtin_amdgcn_rcpf(1.f + __expf(x));
                const float lf = fmaxf(__logf(1.f - omf), -30.f); run += lf; b[i] = run; kk[i] = omf; sq[i] = silu_f(bf2f(rq[i])); }
            GS[part * 128 + c2] = run; }
        HG_BAR();
        { float off = 0.f;
#pragma unroll
            for (int p = 0; p < 3; ++p) if (p < part) off += GS[p * 128 + c2];
            float kt_[8];
#pragma unroll
            for (int i = 0; i < 8; ++i) { const float bb = b[i] + off; const int t = 8 * part + i;
                const float qv = sq[i] * __expf(bb); kt_[i] = kk[i] * __expf(fminf(-bb, 80.f));
                QT[t * 136 + c2] = (bf16_t)f2bf(qv); KT[t * 136 + c2] = (bf16_t)f2bf(kt_[i]);
                if (i == 7 && part == 3) DEC[c2] = __expf(bb); }
            *(LAS bf16x8*)(KTt + c2 * 40 + 8 * part) = pack8(kt_);
            u32x4 wv; wv.x = (unsigned)vv[0] | ((unsigned)vv[1] << 16); wv.y = (unsigned)vv[2] | ((unsigned)vv[3] << 16); wv.z = (unsigned)vv[4] | ((unsigned)vv[5] << 16); wv.w = (unsigned)vv[6] | ((unsigned)vv[7] << 16);
            *(LAS u32x4*)(Vt + c2 * 40 + 8 * part) = wv; }
        if (cc + 2 < c1) { if (cc > c0) asm volatile("s_waitcnt vmcnt(11)" ::: "memory"); else asm volatile("s_waitcnt vmcnt(3)" ::: "memory"); }
        else asm volatile("s_waitcnt vmcnt(0)" ::: "memory");
        HG_BAR();
        f32x4 pt00 = {0.f, 0.f, 0.f, 0.f}, pt01 = pt00, pt11 = pt00;
#pragma unroll
        for (int ks = 0; ks < 4; ++ks) {
            const bf16x8 a0 = *(const LAS bf16x8*)(KT + fr * 136 + 32 * ks + 8 * fq), a1 = *(const LAS bf16x8*)(KT + (16 + fr) * 136 + 32 * ks + 8 * fq);
            const bf16x8 b0 = *(const LAS bf16x8*)(QT + fr * 136 + 32 * ks + 8 * fq), b1 = *(const LAS bf16x8*)(QT + (16 + fr) * 136 + 32 * ks + 8 * fq);
            pt00 = __builtin_amdgcn_mfma_f32_16x16x32_bf16(a0, b0, pt00, 0, 0, 0);
            pt01 = __builtin_amdgcn_mfma_f32_16x16x32_bf16(a0, b1, pt01, 0, 0, 0);
            pt11 = __builtin_amdgcn_mfma_f32_16x16x32_bf16(a1, b1, pt11, 0, 0, 0); }
#pragma unroll
        for (int r = 0; r < 4; ++r) { if (4 * fq + r > fr) { pt00[r] = 0.f; pt11[r] = 0.f; } }
        u32x4 wA0, wA1;
        wA0.x = pk2(pt00[0], pt00[1]); wA0.y = pk2(pt00[2], pt00[3]); wA0.z = hz; wA0.w = hz;
        wA1.x = pk2(pt01[0], pt01[1]); wA1.y = pk2(pt01[2], pt01[3]); wA1.z = pk2(pt11[0], pt11[1]); wA1.w = pk2(pt11[2], pt11[3]);
        const u32x2 vlo = *(const LAS u32x2*)(Vt + (n0 + fr) * 40 + 4 * fq), vhi = *(const LAS u32x2*)(Vt + (n0 + fr) * 40 + 16 + 4 * fq);
        const u32x4 wV = {vlo.x, vlo.y, vhi.x, vhi.y};
        f32x4 o0 = {0.f, 0.f, 0.f, 0.f}, o1 = o0;
        o0 = __builtin_amdgcn_mfma_f32_16x16x32_bf16(__builtin_bit_cast(bf16x8, wA0), __builtin_bit_cast(bf16x8, wV), o0, 0, 0, 0);
        o1 = __builtin_amdgcn_mfma_f32_16x16x32_bf16(__builtin_bit_cast(bf16x8, wA1), __builtin_bit_cast(bf16x8, wV), o1, 0, 0, 0);
#pragma unroll
        for (int aa = 0; aa < 4; ++aa) {
            u32x4 wS; wS.x = pk2(S[2 * aa][0], S[2 * aa][1]); wS.y = pk2(S[2 * aa][2], S[2 * aa][3]); wS.z = pk2(S[2 * aa + 1][0], S[2 * aa + 1][1]); wS.w = pk2(S[2 * aa + 1][2], S[2 * aa + 1][3]);
            const u32x2 q0l = *(const LAS u32x2*)(QT + fr * 136 + 32 * aa + 4 * fq), q0h = *(const LAS u32x2*)(QT + fr * 136 + 32 * aa + 16 + 4 * fq);
            const u32x2 q1l = *(const LAS u32x2*)(QT + (16 + fr) * 136 + 32 * aa + 4 * fq), q1h = *(const LAS u32x2*)(QT + (16 + fr) * 136 + 32 * aa + 16 + 4 * fq);
            const u32x4 wQ0 = {q0l.x, q0l.y, q0h.x, q0h.y}, wQ1 = {q1l.x, q1l.y, q1h.x, q1h.y};
            o0 = __builtin_amdgcn_mfma_f32_16x16x32_bf16(__builtin_bit_cast(bf16x8, wQ0), __builtin_bit_cast(bf16x8, wS), o0, 0, 0, 0);
            o1 = __builtin_amdgcn_mfma_f32_16x16x32_bf16(__builtin_bit_cast(bf16x8, wQ1), __builtin_bit_cast(bf16x8, wS), o1, 0, 0, 0); }
        { const bf16x8 vn = *(const LAS bf16x8*)(Vt + (n0 + fr) * 40 + 8 * fq);
#pragma unroll
            for (int kt = 0; kt < 8; ++kt) { const bf16x8 ka = *(const LAS bf16x8*)(KTt + (16 * kt + fr) * 40 + 8 * fq);
                S[kt] = __builtin_amdgcn_mfma_f32_16x16x32_bf16(ka, vn, S[kt], 0, 0, 0);
                const f32x4 d = *(const LAS f32x4*)(DEC + 16 * kt + 4 * fq); S[kt] = S[kt] * d; } }
#pragma unroll
        for (int r = 0; r < 4; ++r) {
            const int i0 = 4 * fq + r, i1 = 16 + 4 * fq + r;
            const int tok0 = dir ? T - 1 - (32 * cc + i0) : 32 * cc + i0, tok1 = dir ? T - 1 - (32 * cc + i1) : 32 * cc + i1;
            OUT[(size_t)(rowbase + tok0) * 1024 + h * 128 + n0 + fr] = (bf16_t)f2bf(o0[r]);
            OUT[(size_t)(rowbase + tok1) * 1024 + h * 128 + n0 + fr] = (bf16_t)f2bf(o1[r]); }
        cur = cur == 2 ? 0 : cur + 1;
    }
#undef HG_DMA
#undef HG_BAR
    { float* so_ = c1 < nch ? sbuf : sout;
      if (so_) {
#pragma unroll
        for (int kt = 0; kt < 8; ++kt)
#pragma unroll
            for (int r = 0; r < 4; ++r) so_[(size_t)(16 * kt + 4 * fq + r) * 128 + n0 + fr] = S[kt][r]; } }
    __syncthreads();
}

__device__ __forceinline__ int fetch_item(unsigned* ctr, LAS int* slot) {
    __syncthreads();
    if (otid() == 0) *slot = (int)atomicAdd(ctr, 1u);
    __syncthreads();
    return __builtin_amdgcn_readfirstlane(*slot);
}

#define XB_TMO      128
#define XB_XCNT(j)  (256  + 64 * (j))
#define XB_XSUB(j)  (1280 + 64 * (j))
#define XB_XGEN(j)  (2304 + 64 * (j))
#define XB_TOP      3328
#define XB_TOPGEN   3392
#define XCD_BAR_WORDS 3456
#define XB_SPIN_CAP (1u << 18)

__device__ __forceinline__ unsigned xb_ld(unsigned* p)              { return __hip_atomic_load(p, __ATOMIC_RELAXED, __HIP_MEMORY_SCOPE_AGENT); }
__device__ __forceinline__ unsigned xb_add(unsigned* p, unsigned v) { return __hip_atomic_fetch_add(p, v, __ATOMIC_RELAXED, __HIP_MEMORY_SCOPE_AGENT); }
__device__ __forceinline__ unsigned xb_xcc_id() { return (unsigned)__builtin_amdgcn_s_getreg((3 << 11) | 20) & 0xFu; }
#define XB_SPIN(cond, bar) do { unsigned _sp = 0; while (cond) { __builtin_amdgcn_s_sleep(1); \
    if ((++_sp & 255u) == 0u) { if (xb_ld(&(bar)[XB_TMO])) break; if (_sp > XB_SPIN_CAP) { atomicAdd(&(bar)[XB_TMO], 1u); break; } } } } while (0)

struct XcdBarrier {
    unsigned* bar; unsigned x;
    volatile LAS unsigned* st;
};

__device__ __forceinline__ XcdBarrier xcd_barrier_post(unsigned* bar, volatile LAS unsigned* st) {
    XcdBarrier b; b.bar = bar; b.x = xb_xcc_id(); b.st = st;
    if (threadIdx.x == 0) (void)xb_add(&bar[XB_XCNT(b.x)], 1u);
    return b;
}
__device__ __forceinline__ void xcd_barrier_complete(unsigned* bar, unsigned x, unsigned& nloc, unsigned& nx) {
    const unsigned G = gridDim.x * gridDim.y * gridDim.z;
    unsigned sum, cnt, mine, sp = 0u;
    for (;;) {
        sum = 0u; cnt = 0u; mine = 0u;
#pragma unroll
        for (unsigned j = 0; j < 16; ++j) { const unsigned c = xb_ld(&bar[XB_XCNT(j)]); sum += c; cnt += (c > 0u) ? 1u : 0u; mine = (j == x) ? c : mine; }
        if (sum == G) break;
        __builtin_amdgcn_s_sleep(1);
        if ((++sp & 255u) == 0u) { if (xb_ld(&bar[XB_TMO])) break; if (sp > XB_SPIN_CAP) { atomicAdd(&bar[XB_TMO], 1u); break; } }
    }
    nloc = mine > 0u ? mine : 1u; nx = cnt > 0u ? cnt : 1u;
}

__device__ __forceinline__ void xcd_barrier(const XcdBarrier& b) {
    asm volatile("s_waitcnt vmcnt(0)" ::: "memory");
    __syncthreads();
    if (threadIdx.x == 0) {
        unsigned* bar = b.bar;
        __builtin_amdgcn_s_waitcnt(0);
        unsigned nloc = b.st[0], nx = b.st[1];
        if (nloc == 0u) { xcd_barrier_complete(bar, b.x, nloc, nx); b.st[0] = nloc; b.st[1] = nx; }
        const unsigned old = xb_add(&bar[XB_XSUB(b.x)], 1u);
        const unsigned gen = old / nloc;
        if (old + 1u == (gen + 1u) * nloc) {
            __builtin_amdgcn_fence(__ATOMIC_RELEASE, "agent");
            asm volatile("s_waitcnt vmcnt(0)" ::: "memory");
            const unsigned og = xb_add(&bar[XB_TOP], 1u);
            const unsigned tg = og / nx;
            if (og + 1u == (tg + 1u) * nx) xb_add(&bar[XB_TOPGEN], 1u);
            else XB_SPIN(xb_ld(&bar[XB_TOPGEN]) == tg, bar);
            __builtin_amdgcn_fence(__ATOMIC_ACQUIRE, "agent");
            xb_add(&bar[XB_XGEN(b.x)], 1u);
            asm volatile("s_waitcnt vmcnt(0)" ::: "memory");
        } else {
            XB_SPIN(xb_ld(&bar[XB_XGEN(b.x)]) == gen, bar);
            __builtin_amdgcn_fence(__ATOMIC_ACQUIRE, "agent");
            asm volatile("s_waitcnt vmcnt(0)" ::: "memory");
        }
    }
    __syncthreads();
}

#ifndef BG_C1
#define BG_C1 4
#define BG_C2 12
#define BG_C3 16
#endif
enum { K_FINAL = 12, K_P0 = 0, K_MODNORM, K_GEMM_IN, K_PREP_AB, K_GEMM_QUP, K_GEMM_KVUP, K_HN_AB, K_MIX_AB, K_FIN_AB, K_GEMM_OUT, K_HN_C, K_ATTN_C };

__global__ void __launch_bounds__(NTHR, 2) mk_fwd(Args a_byval) {
    extern __shared__ __attribute__((aligned(16))) unsigned char lds_raw[];
    LAS unsigned char* lds = (LAS unsigned char*)lds_raw;
    LAS int* slot = (LAS int*)(lds + LDS_PHASE);
    cg::grid_group grid = cg::this_grid();
    const int G = gridDim.x;
    volatile LAS unsigned* bst = (volatile LAS unsigned*)(lds + LDS_PHASE + 64);
    if (threadIdx.x < 2) bst[threadIdx.x] = 0u;
    __syncthreads();
    (void)xcd_barrier_post((unsigned*)(a_byval.ws + WS_CTL) + 8192, bst);

    grid.sync();
#ifndef PROBE_TSEL
#define PROBE_TSEL 0
#endif
    unsigned long long t_acc = 0ull;
    for (int step = 0; step < 30; ++step) {
        unsigned long long t_begin = 0ull; if (PROBE_TSEL) t_begin = __builtin_amdgcn_s_memrealtime();
        asm volatile("" : "+s"(step));
        KArgs a = (KArgs)__builtin_amdgcn_kernarg_segment_ptr();
        asm volatile("" : "+s"(a));
        unsigned char* ws = a->ws;
        unsigned* ctl = (unsigned*)(ws + WS_CTL);
        XcdBarrier xbar; xbar.bar = ctl + 8192; xbar.x = xb_xcc_id(); xbar.st = (volatile LAS unsigned*)(lds + LDS_PHASE + 64);
        int kind, L = 0; bool sync_after = true;
        if (step == 0) kind = K_P0;
        else if (step == 29) { kind = K_FINAL; L = 4; }
        else { const int s = step - 1, pair = s / 14, r = s % 14;
            if (r < 9) { L = 2 * pair; kind = r == 0 ? K_MODNORM : r == 1 ? K_GEMM_IN : r == 2 ? K_PREP_AB : r == 3 ? K_GEMM_QUP : r == 4 ? K_GEMM_KVUP : r == 5 ? K_HN_AB : r == 6 ? K_MIX_AB : r == 7 ? K_FIN_AB : K_GEMM_OUT; }
            else { L = 2 * pair + 1; const int q = r - 9; kind = q == 0 ? K_MODNORM : q == 1 ? K_GEMM_IN : q == 2 ? K_HN_C : q == 3 ? K_ATTN_C : K_GEMM_OUT; } }
        const int j = L >> 1; const bool isC = (L & 1) != 0;
        if (kind == K_GEMM_QUP) sync_after = false;
        if (step == 29) sync_after = false;

#ifndef PROBE_MASK
#define PROBE_MASK 0
#endif
#ifndef PROBE_SEL
#define PROBE_SEL 0
#endif
#ifndef PROBE_REPS
#define PROBE_REPS 2
#endif
        const int nrep = (((PROBE_MASK >> kind) & 1) && (kind != K_GEMM_OUT || L == 0)) ? 1 + PROBE_REPS : 1;
        for (int rep = 0; rep < nrep; ++rep) {
        if (PROBE_MASK == 0x1000) { for (int q = 0; q < 2; ++q) xcd_barrier(xbar); }
        const int bid = obid();
        const bool bgphase = kind == K_PREP_AB || kind == K_GEMM_QUP || kind == K_GEMM_KVUP || kind == K_HN_AB;
        if (rep == 0 && bid < NBG && (kind == K_PREP_AB || kind == K_GEMM_QUP || kind == K_HN_AB || kind == K_MIX_AB)) {
            const int b = bid >> 4, h = (bid >> 1) & 7, dir = bid & 1;
            const int c0 = kind == K_PREP_AB ? 0 : kind == K_GEMM_QUP ? BG_C1 : kind == K_HN_AB ? BG_C2 : BG_C3;
            const int c1 = kind == K_PREP_AB ? BG_C1 : kind == K_GEMM_QUP ? BG_C2 : kind == K_HN_AB ? BG_C3 : 64;
            hgrn_item(lds, (const bf16_t*)(ws + WS_PROJ), MC + b * 2048, 2048, h, dir, (const float*)(ws + WS_LB) + (j * 2 + dir) * 1024 + h * 128,
                      a->in[4 + dir] + (size_t)((b * 2 + j) * 8 + h) * 16384, nullptr, (bf16_t*)(ws + (dir ? WS_OB : WS_OF)), c0, c1, (float*)(ws + WS_SBUF) + (size_t)bid * 16384);
        }
        const int ewg = bgphase ? bid - NBG : bid, enwg = bgphase ? G - NBG : G;
        if (bgphase && bid < NBG) {}
        else
        if (kind == K_P0) phase_p0(a, lds);
        else if (kind == K_MODNORM) phase_modnorm(a, L);
        else if (kind == K_GEMM_IN || kind == K_GEMM_QUP || kind == K_GEMM_KVUP) {
            pg8::Gemm g; pg8::EpiStore E;
            if (kind == K_GEMM_IN) {
                if (!isC) { g = pg8::Gemm{(const bf16_t*)(ws + WS_H), (const bf16_t*)(ws + WS_WINAB) + (size_t)j * 7168 * 2048, MROWS, 7168, 2048}; E = pg8::EpiStore{(bf16_t*)(ws + WS_PROJ), LDP_AB}; }
                else { g = pg8::Gemm{(const bf16_t*)(ws + WS_H), (const bf16_t*)(ws + WS_WINC) + (size_t)j * 5120 * 2048, MROWS, 5120, 2048}; E = pg8::EpiStore{(bf16_t*)(ws + WS_PROJ), LDP_C}; }
            } else if (kind == K_GEMM_QUP) { g = pg8::Gemm{(const bf16_t*)(ws + WS_QN), (const bf16_t*)(ws + WS_WQUP) + (size_t)j * 1536 * 512, MROWS, 1536, 512}; E = pg8::EpiStore{(bf16_t*)(ws + WS_QRAW), 1536}; }
            else { g = pg8::Gemm{(const bf16_t*)(ws + WS_CKV), (const bf16_t*)(ws + WS_WKVUP) + (size_t)j * 2048 * 256, MKROWS, 2048, 256}; E = pg8::EpiStore{(bf16_t*)(ws + WS_KVRAW), 2048}; }
            pg8::StaticOrder S; S.init(g.M, g.N, enwg, ewg);
            pg8::gemm_phase<pg8::EpiStore, pg8::StaticOrder, true, true>(lds, g, S, E);
            if (kind == K_GEMM_IN && L <= 1) { const int left = ((g.M / 256) * (g.N / 256)) % G;
                if (left > 0 && bid >= left) { const int lo = L == 0 ? P0_EARLY : P0_EARLY + 10000, hi = L == 0 ? P0_EARLY + 6000 : P0_EARLY + 12000;
                    p0_transposes(a, lds, lo, hi, (bid - left) * NWAVES + (otid() >> 6), (G - left) * NWAVES); } }
        }
        else if (kind == K_GEMM_OUT) {
            pg8::Gemm g{(const bf16_t*)(ws + WS_H), (const bf16_t*)(ws + (isC ? WS_WOUTC : WS_WOUTAB)) + (size_t)j * 2048 * 2048, MROWS, 2048, 2048};
            pg8::EpiResid E{(bf16_t*)(ws + WS_PROJ), (const float*)(ws + WS_MOD) + (size_t)L * 5 * 6144 + 4096,
                            (float*)(ws + WS_QRAW), ctl + 16384 + step * 256};
            pg8::StaticOrder S; S.init(g.M, g.N, G, obid());
            pg8::gemm_phase<pg8::EpiResid, pg8::StaticOrder, true, true>(lds, g, S, E);
            if (L <= 1) { const int left = ((g.M / 256) * (g.N / 256)) % G;
                if (left > 0 && bid >= left) { const int lo = L == 0 ? P0_EARLY + 6000 : P0_EARLY + 12000, hi = L == 0 ? P0_EARLY + 10000 : P0_EARLY + 16000;
                    p0_transposes(a, lds, lo, hi, (bid - left) * NWAVES + (otid() >> 6), (G - left) * NWAVES); } }
        }
        else if (kind == K_FINAL) phase_final(a);
        else if (kind == K_PREP_AB) phase_prep_ab(a, j, ewg, enwg);
        else if (kind == K_HN_AB) phase_hn_ab(a, j, ewg, enwg);
        else if (kind == K_FIN_AB) phase_fin_ab(a, j);
        else if (kind == K_HN_C) phase_hn_c(a, j);
        else if (kind == K_MIX_AB) {
            unsigned* ctr = ctl + 64 * step + 8 * rep;
            const bf16_t* P = (const bf16_t*)(ws + WS_PROJ); bf16_t* MIX = (bf16_t*)(ws + WS_H);
            const bf16_t* QF = (const bf16_t*)(ws + WS_QRAW); const bf16_t* KF = (const bf16_t*)(ws + WS_KF); const bf16_t* KV = (const bf16_t*)(ws + WS_KVRAW);
            for (;;) {
                const int idx = fetch_item(ctr, slot);
                if (idx >= 640) break;
                if (idx >= 256 && idx < 512) {
                    const int i = idx - 256; const int b = i >> 4, h = (i >> 1) & 7, dir = i & 1;
                    const float* lb = (const float*)(ws + WS_LB) + (j * 2 + dir) * 1024 + h * 128;
                    float* so = a->out + (dir ? O_SB : O_SF) + (size_t)((b * 2 + j) * 8 + h) * 16384;
                    if (PROBE_SEL != 1 || rep == 0) hgrn_item(lds, P, b * 256, 256, h, dir, lb, nullptr, so, (bf16_t*)(ws + (dir ? WS_OB : WS_OF)), 0, 8, (float*)(ws + WS_SBUF));
                } else {
                    att::Item it;
                    const bool lat = idx < 256; int b, h, r0;
                    if (lat) { const int i = idx; b = i >> 6; h = (i >> 3) & 7; const int qb = i & 7; r0 = MC + b * 2048 + qb * 256; it.q0 = qb * 256;
                        it.K0 = KF + (size_t)(MROWS + b * 256) * 1536 + h * 192; it.V0 = KV + (size_t)(MROWS + b * 256) * 2048 + h * 256 + 128; it.n0 = 4;
                        it.K1 = KF + (size_t)(MC + b * 2048) * 1536 + h * 192; it.V1 = KV + (size_t)(MC + b * 2048) * 2048 + h * 256 + 128; it.t_lo = 0; it.t_hi = 32; }
                    else { const int i = idx - 512; b = i >> 3; h = i & 7; r0 = b * 256; it.q0 = 0;
                        it.K0 = KF; it.V0 = KV; it.n0 = 0;
                        it.K1 = KF + (size_t)r0 * 1536 + h * 192; it.V1 = KV + (size_t)r0 * 2048 + h * 256 + 128; it.t_lo = 0; it.t_hi = 4; }
                    it.ldk = 1536; it.ldv = 2048;
                    it.Q = QF + (size_t)r0 * 1536 + h * 192; it.ldq = 1536; it.band = 0; it.m0 = -1e30f; it.l0 = 0.f;
                    it.qg = a->in[18] + j * 192; it.rope = lat ? (const float*)(ws + WS_ROPEA) : nullptr; it.qscale = QSC_A;
                    it.G = P + (size_t)r0 * LDP_AB + COL_AG + h * 128; it.ldg = LDP_AB; it.O = MIX + (size_t)r0 * DM + h * 128; it.ldo = DM;
                    if (PROBE_SEL != 2 || rep == 0) att::attn_item<192>(lds, it);
                }
            }
        }
        else if (kind == K_ATTN_C) {
            unsigned* ctr = ctl + 64 * step + 8 * rep;
            const bf16_t* P = (const bf16_t*)(ws + WS_PROJ); bf16_t* MIX = (bf16_t*)(ws + WS_H);
            const bf16_t* KCC = (const bf16_t*)(ws + WS_KCC);
            for (;;) {
                const int idx = fetch_item(ctr, slot);
                if (idx >= 768) break;
                att::Item it; int b, h, r0;
                if (idx < 512) { b = idx >> 7; h = (idx >> 3) & 15; const int qb = idx & 7; r0 = MC + b * 2048 + qb * 256; const int kvh = h >> 2;
                    it.K0 = KCC + (size_t)((b * 2 + j) * 256) * LDP_C + kvh * 128; it.V0 = KCC + (size_t)((b * 2 + j) * 256) * LDP_C + 512 + kvh * 128; it.n0 = 4;
                    it.K1 = P + (size_t)(MC + b * 2048) * LDP_C + 2048 + kvh * 128; it.V1 = P + (size_t)(MC + b * 2048) * LDP_C + 2560 + kvh * 128;
                    it.t_lo = 4 * qb - 2 < 0 ? 0 : 4 * qb - 2; it.t_hi = 4 * qb + 6 > 32 ? 32 : 4 * qb + 6; it.q0 = qb * 256; it.band = 1; }
                else { const int i = idx - 512; b = i >> 4; h = i & 15; r0 = b * 256; const int kvh = h >> 2;
                    it.K0 = KCC; it.V0 = KCC; it.n0 = 0;
                    it.K1 = P + (size_t)r0 * LDP_C + 2048 + kvh * 128; it.V1 = P + (size_t)r0 * LDP_C + 2560 + kvh * 128; it.t_lo = 0; it.t_hi = 4; it.q0 = 0; it.band = 0; }
                it.ldk = LDP_C; it.ldv = LDP_C;
                it.Q = P + (size_t)r0 * LDP_C + h * 128; it.ldq = LDP_C; it.m0 = a->in[29][j * 16 + h] * LOG2E; it.l0 = 1.f;
                it.qg = a->in[27] + j * 128; it.rope = idx < 512 ? (const float*)(ws + WS_ROPEC) : nullptr; it.qscale = QSC_C;
                it.G = P + (size_t)r0 * LDP_C + 3072 + h * 128; it.ldg = LDP_C; it.O = MIX + (size_t)r0 * DM + h * 128; it.ldo = DM;
                att::attn_item<128>(lds, it);
            }
        }
        if (rep + 1 < nrep) xcd_barrier(xbar);
        }
        if (sync_after) xcd_barrier(xbar);
        if (PROBE_TSEL) { if ((PROBE_TSEL >> kind) & 1) t_acc += __builtin_amdgcn_s_memrealtime() - t_begin; }
    }
    if (PROBE_TSEL) { if (blockIdx.x == 0) { const unsigned long long t_end = __builtin_amdgcn_s_memrealtime() + 2ull * t_acc;
        while (__builtin_amdgcn_s_memrealtime() < t_end) __builtin_amdgcn_s_sleep(32); } }
}

extern "C" void kernel_launch(void* const* d_in, const int* in_sizes, int n_in, void* d_out, int out_size, void* d_ws, size_t ws_size, hipStream_t stream) {
    static int grid = 0;
    if (grid == 0) {
        if (n_in != 31 || ws_size < WS_END) { fprintf(stderr, "kernel_launch: unexpected n_in %d or ws_size %zu (< %zu)\n", n_in, ws_size, (size_t)WS_END); grid = -1; return; }
        int dev = 0, cus = 0, per_cu = 0;
        hipGetDevice(&dev); hipDeviceGetAttribute(&cus, hipDeviceAttributeMultiprocessorCount, dev);
        if (hipFuncSetAttribute((const void*)mk_fwd, hipFuncAttributeMaxDynamicSharedMemorySize, LDS_BYTES) != hipSuccess) { fprintf(stderr, "kernel_launch: hipFuncSetAttribute failed\n"); grid = -1; return; }
        if (hipOccupancyMaxActiveBlocksPerMultiprocessor(&per_cu, (const void*)mk_fwd, NTHR, LDS_BYTES) != hipSuccess || per_cu < 1) per_cu = 1;
        (void)hipGetLastError();
        grid = cus > 0 ? cus : 256;
    }
    if (grid < 0) return;
    hipMemsetAsync((char*)d_ws + WS_CTL, 0, CTL_BYTES, stream);
    Args a{};
    for (int i = 0; i < 31; ++i) a.in[i] = (const float*)d_in[i];
    a.out = (float*)d_out; a.ws = (unsigned char*)d_ws;
    void* args[] = {&a};
    hipError_t e = hipLaunchCooperativeKernel((const void*)mk_fwd, dim3(grid), dim3(NTHR), args, LDS_BYTES, stream);
    if (e != hipSuccess) fprintf(stderr, "cooperative launch failed: %s (grid %d)\n", hipGetErrorString(e), grid);
}
```

```cpp
#include <hip/hip_runtime.h>
#include <hip/hip_cooperative_groups.h>
#include <cstdio>
#include <cstdint>
namespace cg = cooperative_groups;

namespace pg8 {
#define PG8_LAS __attribute__((address_space(3)))
typedef unsigned short bf16_t;
typedef short bf16x8 __attribute__((ext_vector_type(8)));
typedef float f32x4 __attribute__((ext_vector_type(4)));
typedef unsigned u32x4 __attribute__((ext_vector_type(4)));
constexpr int BM = 256, BK = 64, HALF = 128, HTB = HALF * BK * 2  , STAGE_BYTES = 8 * HTB, NXCD = 8, WGM = 8;
__device__ __forceinline__ int pg8_otid() { int t = threadIdx.x; asm volatile("" : "+v"(t)); return t; }

__host__ __device__ __forceinline__ int lds_byte(int r, int c) { const int st = (r >> 4) * 2 + (c >> 5), rr = r & 15, cc = c & 31, ob = rr * 64 + cc * 2; return st * 1024 + (ob ^ (((ob >> 9) & 1) << 5)); }
__host__ __device__ __forceinline__ void stage_rc(int b, int& R, int& C) { const int st = b / 1024, sb = b % 1024, swz = sb ^ (((sb >> 9) & 1) << 5); R = (st >> 1) * 16 + swz / 64; C = (st & 1) * 32 + (swz % 64) / 2; }
__host__ __device__ __forceinline__ int perm32(int rho) { const int n = rho >> 4, i = rho & 15; return 8 * (i >> 2) + 4 * n + (i & 3); }

struct Unit { int pm, pn, kp, np, tix; };
struct Gemm { const bf16_t* A; const bf16_t* Bt; int M, N, K; };

struct StaticOrder {
    int nM, nN, nwg, G, c;
    __host__ __device__ void init(int M, int N, int G_, int c_) { nM = M / BM; nN = N / BM; nwg = nM * nN; G = G_; c = c_; }
    __host__ __device__ bool next(int i, Unit& u) const {
        const long L = (long)i * G + c; if (L >= nwg) return false;
        int wgid = (int)L; { const int q = nwg / NXCD, r = nwg % NXCD, xcd = wgid % NXCD, off = wgid / NXCD; wgid = (xcd < r ? xcd * (q + 1) : r * (q + 1) + (xcd - r) * q) + off; }
        const int nig = WGM * nN, gid = wgid / nig, fm = gid * WGM, gsz = (nM - fm) < WGM ? (nM - fm) : WGM;
        u.pm = fm + ((wgid % nig) % gsz); u.pn = (wgid % nig) / gsz; u.kp = 0; u.np = 1; u.tix = 0; return true;
    }
    __device__ __forceinline__ void a_ready(const Unit&) const {}
    __device__ __forceinline__ void done(const Unit&) const {}
};
struct SplitOrder {
    StaticOrder so; int R, np;
    __host__ __device__ void init(int M, int N, int K, int G_, int c_) { so.init(M, N, G_, c_); R = so.nwg / G_; const int left = so.nwg - R * G_;
        np = 1; if (left > 0 && G_ % left == 0) { const int q = G_ / left; if (q == 2 && (K / q) % 128 == 0) np = q; } }
    __host__ __device__ bool next(int i, Unit& u) const {
        if (np == 1 || i < R) return so.next(i, u);
        if (i > R) return false;
        StaticOrder t = so; t.c = so.c / np; const bool ok = t.next(i, u); u.kp = so.c % np; u.np = np; u.tix = so.c / np; return ok;
    }
    __device__ __forceinline__ void a_ready(const Unit&) const {}
    __device__ __forceinline__ void done(const Unit&) const {}
};

typedef float f32x2c __attribute__((ext_vector_type(2)));
typedef __bf16 bf16x2c __attribute__((ext_vector_type(2)));
__device__ __forceinline__ unsigned cvt_pk_bf16(float lo, float hi) { const f32x2c v = {lo, hi}; const bf16x2c b = __builtin_convertvector(v, bf16x2c); return __builtin_bit_cast(unsigned, b); }

struct EpiStore {
    static constexpr bool PERM = true, AFTER_DRAIN = false;
    bf16_t* O; int ldc;
    __device__ __forceinline__ void operator()(const f32x4 (&acc)[2][2][4][2], const Unit& u, int wr, int wc, int fr, int fq) const {
        const int row0 = u.pm * BM + wr * 64 + fr; const int col0 = u.pn * BM + wc * 32 + 8 * fq;
#pragma unroll
        for (int ai = 0; ai < 2; ++ai)
#pragma unroll
            for (int m = 0; m < 4; ++m) { bf16_t* rowp = O + (size_t)(row0 + ai * HALF + m * 16) * ldc + col0;
#pragma unroll
                for (int bj = 0; bj < 2; ++bj) { const f32x4 v0 = acc[ai][bj][m][0], v1 = acc[ai][bj][m][1];
                    u32x4 w; w.x = cvt_pk_bf16(v0[0], v0[1]); w.y = cvt_pk_bf16(v0[2], v0[3]); w.z = cvt_pk_bf16(v1[0], v1[1]); w.w = cvt_pk_bf16(v1[2], v1[3]);
                    *(u32x4*)(rowp + bj * HALF) = w; } }
    }
};
struct EpiResid {
    static constexpr bool PERM = true, AFTER_DRAIN = false;
    bf16_t* dout; const float* gate_base;
    float* slab; unsigned* cnt;
    __device__ __forceinline__ void operator()(f32x4 (&acc)[2][2][4][2], const Unit& u, int wr, int wc, int fr, int fq) const {
        const int tid = (wr * 4 + wc) * 64 + fq * 16 + fr;
        const f32x4* sl = nullptr;
        if (u.np > 1) {
            float* sb = slab + (size_t)u.tix * (u.np - 1) * 65536;
            if (u.kp < u.np - 1) {
                f32x4* sp = (f32x4*)(sb + (size_t)u.kp * 65536) + tid;
#pragma unroll
                for (int ai = 0; ai < 2; ++ai)
#pragma unroll
                    for (int bj = 0; bj < 2; ++bj)
#pragma unroll
                        for (int m = 0; m < 4; ++m)
#pragma unroll
                            for (int n = 0; n < 2; ++n) sp[(((ai * 2 + bj) * 4 + m) * 2 + n) * 512] = acc[ai][bj][m][n];
                asm volatile("s_waitcnt vmcnt(0)" ::: "memory");
                __syncthreads();
                if (tid == 0) { __builtin_amdgcn_fence(__ATOMIC_RELEASE, "agent"); asm volatile("s_waitcnt vmcnt(0)" ::: "memory");
                    __hip_atomic_fetch_add(cnt + u.tix, 1u, __ATOMIC_RELAXED, __HIP_MEMORY_SCOPE_AGENT); }
                return;
            }
            if (tid == 0) { unsigned sp_ = 0;
                while (__hip_atomic_load(cnt + u.tix, __ATOMIC_RELAXED, __HIP_MEMORY_SCOPE_AGENT) < (unsigned)(u.np - 1)) { __builtin_amdgcn_s_sleep(2); if (++sp_ > (1u << 22)) break; }
                __builtin_amdgcn_fence(__ATOMIC_ACQUIRE, "agent"); asm volatile("s_waitcnt vmcnt(0)" ::: "memory"); }
            __syncthreads();
            sl = (const f32x4*)sb + tid;
        }
        const int pm = u.pm;
        const int ci = pm < 16 ? 4 : ((pm - 16) >> 3);
        const float* gt = gate_base + ci * 6144;
        const int row0 = pm * BM + wr * 64 + fr, col0 = u.pn * BM + wc * 32 + 8 * fq;
#pragma unroll
        for (int bj = 0; bj < 2; ++bj) { const f32x4 gq0 = *(const f32x4*)(gt + col0 + bj * HALF), gq1 = *(const f32x4*)(gt + col0 + bj * HALF + 4);
#pragma unroll
            for (int ai = 0; ai < 2; ++ai) {
#pragma unroll
                for (int m = 0; m < 4; ++m) { f32x4 a0 = acc[ai][bj][m][0], a1 = acc[ai][bj][m][1];
                    if (sl) { a0 += sl[(((ai * 2 + bj) * 4 + m) * 2 + 0) * 512]; a1 += sl[(((ai * 2 + bj) * 4 + m) * 2 + 1) * 512]; }
                    a0 = a0 * gq0; a1 = a1 * gq1;
                    u32x4 w; w.x = cvt_pk_bf16(a0[0], a0[1]); w.y = cvt_pk_bf16(a0[2], a0[3]); w.z = cvt_pk_bf16(a1[0], a1[1]); w.w = cvt_pk_bf16(a1[2], a1[3]);
                    *(u32x4*)(dout + (size_t)(row0 + ai * HALF + m * 16) * 2048 + col0 + bj * HALF) = w; }
                asm volatile("" ::: "memory"); } }
    }
};

template <class Epi, class Sched, bool ALIGN_EPI = false, bool SP2 = false>
__device__ __forceinline__ void gemm_phase(PG8_LAS unsigned char* lds, const Gemm g, const Sched& S, const Epi& E) {
    const int tid = pg8_otid(), wid = __builtin_amdgcn_readfirstlane(tid >> 6), lane = tid & 63, wr = wid >> 2, wc = wid & 3, fr = lane & 15, fq = lane >> 4;
    const int K = g.K, nt = K / BK;
    unsigned voffA[2], voffB[2];
#pragma unroll
    for (int i = 0; i < 2; ++i) { int R, C; stage_rc(tid * 16 + i * 8192, R, C); const int Rb = Epi::PERM ? ((R & ~31) + perm32(R & 31)) : R;
        voffA[i] = (unsigned)(R * K + C) * 2u; voffB[i] = (unsigned)(Rb * K + C) * 2u; }
    const size_t kstep = (size_t)(BK * 2);
    const size_t hstep = (size_t)HALF * K * 2;
    const size_t tstep = 2 * hstep;
    const unsigned ldsw = (unsigned)wid * 1024u;
    const int aoff = lds_byte(wr * 64 + fr, fq * 8), boff = lds_byte(wc * 32 + fr, fq * 8);
#define PG8_SA(b, h) (((b) * 2 + (h)) * HTB)
#define PG8_SB(b, h) ((4 + (b) * 2 + (h)) * HTB)
#define PG8_STAGE(bufoff, gbase, voff) do { _Pragma("unroll") for (int _i = 0; _i < 2; ++_i) \
        __builtin_amdgcn_global_load_lds((const unsigned*)((const char*)(gbase) + (voff)[_i]), (PG8_LAS unsigned*)(lds + (bufoff) + ldsw + _i * 8192), 16, 0, 0); } while (0)
#define PG8_LDA(dst, b, h) do { _Pragma("unroll") for (int m = 0; m < 4; ++m) _Pragma("unroll") for (int k = 0; k < 2; ++k) dst[m][k] = *(const PG8_LAS bf16x8*)(lds + PG8_SA(b, h) + aoff + m * 2048 + k * 1024); } while (0)
#define PG8_LDB(dst, b, h) do { _Pragma("unroll") for (int n = 0; n < 2; ++n) _Pragma("unroll") for (int k = 0; k < 2; ++k) dst[n][k] = *(const PG8_LAS bf16x8*)(lds + PG8_SB(b, h) + boff + n * 2048 + k * 1024); } while (0)
#define PG8_MMA(ai, bj, At, Bt) do { __builtin_amdgcn_s_setprio(1); _Pragma("unroll") for (int m = 0; m < 4; ++m) _Pragma("unroll") for (int n = 0; n < 2; ++n) _Pragma("unroll") for (int k = 0; k < 2; ++k) \
        acc[ai][bj][m][n] = __builtin_amdgcn_mfma_f32_16x16x32_bf16(Bt[n][k], At[m][k], acc[ai][bj][m][n], 0, 0, 0); __builtin_amdgcn_s_setprio(0); } while (0)
#define PG8_WAIT_V(n) asm volatile("s_waitcnt vmcnt(" #n ")" ::: "memory")
#define PG8_WAIT_L(n) asm volatile("s_waitcnt lgkmcnt(" #n ")" ::: "memory")
#define PG8_BAR __builtin_amdgcn_s_barrier()
#define PG8_SCHED __builtin_amdgcn_sched_barrier(0)
    Unit cur, nxt; int ui = 0;
    if (!S.next(0, cur)) return;
    f32x4 acc[2][2][4][2];
#pragma unroll
    for (int a = 0; a < 2; ++a)
#pragma unroll
        for (int b = 0; b < 2; ++b)
#pragma unroll
            for (int m = 0; m < 4; ++m)
#pragma unroll
                for (int n = 0; n < 2; ++n) acc[a][b][m][n] = (f32x4){0.f, 0.f, 0.f, 0.f};
    bf16x8 At[4][2], B0[2][2], B1[2][2];
    const char* cA = (const char*)g.A + (size_t)cur.pm * tstep + (size_t)cur.kp * (K / cur.np) * 2; const char* cB = (const char*)g.Bt + (size_t)cur.pn * tstep + (size_t)cur.kp * (K / cur.np) * 2;
    S.a_ready(cur);
    if constexpr (SP2) {
        PG8_STAGE(PG8_SB(0, 0), cB, voffB); PG8_STAGE(PG8_SB(0, 1), cB + hstep, voffB); PG8_STAGE(PG8_SA(0, 0), cA, voffA); PG8_STAGE(PG8_SA(0, 1), cA + hstep, voffA);
        if (wr == 1) PG8_BAR;
        PG8_WAIT_V(2); PG8_BAR;
        PG8_STAGE(PG8_SB(1, 0), cB + kstep, voffB); PG8_STAGE(PG8_SA(1, 0), cA + kstep, voffA); PG8_STAGE(PG8_SB(1, 1), cB + hstep + kstep, voffB);
        PG8_WAIT_V(6); PG8_BAR;
    } else {
        PG8_STAGE(PG8_SB(0, 0), cB, voffB); PG8_STAGE(PG8_SA(0, 0), cA, voffA); PG8_STAGE(PG8_SB(0, 1), cB + hstep, voffB); PG8_STAGE(PG8_SA(0, 1), cA + hstep, voffA);
        if (wr == 1) PG8_BAR;
        PG8_WAIT_V(4); PG8_BAR;
        PG8_STAGE(PG8_SB(1, 0), cB + kstep, voffB); PG8_STAGE(PG8_SA(1, 0), cA + kstep, voffA); PG8_STAGE(PG8_SB(1, 1), cB + hstep + kstep, voffB);
        PG8_WAIT_V(6); PG8_BAR;
    }
    for (;;) {
        const bool has_next = S.next(ui + 1, nxt);
        const size_t nko = has_next ? (size_t)nxt.kp * (K / nxt.np) * 2 : 0; const char* nA = has_next ? (const char*)g.A + (size_t)nxt.pm * tstep + nko : cA; const char* nB = has_next ? (const char*)g.Bt + (size_t)nxt.pn * tstep + nko : cB;
        const int ntc = nt / cur.np;
        for (int t = 0; t < ntc; t += 2) {
            const bool last = (t == ntc - 2);
            const char* a1 = cA + (size_t)(t + 1) * kstep;
            const char* a2 = last ? nA : cA + (size_t)(t + 2) * kstep; const char* b2 = last ? nB : cB + (size_t)(t + 2) * kstep;
            const char* a3 = a2 + kstep; const char* b3 = b2 + kstep;
            if (last && has_next) S.a_ready(nxt);
            if constexpr (SP2) {
            PG8_LDB(B0, 0, 0); PG8_LDB(B1, 0, 1); PG8_SCHED; PG8_LDA(At, 0, 0); PG8_STAGE(PG8_SA(1, 1), a1 + hstep, voffA);
            PG8_WAIT_V(8); PG8_WAIT_L(0); PG8_BAR; PG8_MMA(0, 0, At, B0); PG8_MMA(0, 1, At, B1); PG8_BAR; PG8_SCHED;
            PG8_LDA(At, 0, 1); PG8_STAGE(PG8_SB(0, 0), b2, voffB); PG8_STAGE(PG8_SB(0, 1), b2 + hstep, voffB); PG8_STAGE(PG8_SA(0, 0), a2, voffA);
            PG8_WAIT_V(8); PG8_WAIT_L(0); PG8_BAR; PG8_MMA(1, 0, At, B0); PG8_MMA(1, 1, At, B1); PG8_BAR; PG8_SCHED;
            PG8_LDB(B0, 1, 0); PG8_LDB(B1, 1, 1); PG8_SCHED; PG8_LDA(At, 1, 0); PG8_STAGE(PG8_SA(0, 1), a2 + hstep, voffA);
            PG8_WAIT_V(8); PG8_WAIT_L(0); PG8_BAR; PG8_MMA(0, 0, At, B0); PG8_MMA(0, 1, At, B1); PG8_BAR; PG8_SCHED;
            PG8_LDA(At, 1, 1); PG8_STAGE(PG8_SB(1, 0), b3, voffB); PG8_STAGE(PG8_SB(1, 1), b3 + hstep, voffB); PG8_STAGE(PG8_SA(1, 0), a3, voffA);
            PG8_WAIT_V(8); PG8_WAIT_L(0); PG8_BAR; PG8_MMA(1, 0, At, B0); PG8_MMA(1, 1, At, B1); PG8_BAR; PG8_SCHED;
            } else {
            PG8_LDB(B0, 0, 0); PG8_SCHED; PG8_LDA(At, 0, 0); PG8_STAGE(PG8_SA(1, 1), a1 + hstep, voffA);
            PG8_WAIT_L(8); PG8_BAR; PG8_WAIT_L(0); PG8_MMA(0, 0, At, B0); PG8_BAR; PG8_SCHED;
            PG8_LDB(B1, 0, 1); PG8_STAGE(PG8_SB(0, 0), b2, voffB);
            PG8_BAR; PG8_WAIT_L(0); PG8_MMA(0, 1, At, B1); PG8_BAR;
            PG8_LDA(At, 0, 1); PG8_STAGE(PG8_SA(0, 0), a2, voffA);
            PG8_BAR; PG8_WAIT_L(0); PG8_MMA(1, 0, At, B0); PG8_BAR; PG8_SCHED;
            PG8_STAGE(PG8_SB(0, 1), b2 + hstep, voffB);
            PG8_WAIT_V(6); PG8_BAR; PG8_MMA(1, 1, At, B1); PG8_BAR;
            PG8_LDB(B0, 1, 0); PG8_SCHED; PG8_LDA(At, 1, 0); PG8_STAGE(PG8_SA(0, 1), a2 + hstep, voffA);
            PG8_WAIT_L(8); PG8_BAR; PG8_WAIT_L(0); PG8_MMA(0, 0, At, B0); PG8_BAR; PG8_SCHED;
            PG8_LDB(B1, 1, 1); PG8_STAGE(PG8_SB(1, 0), b3, voffB);
            PG8_BAR; PG8_WAIT_L(0); PG8_MMA(0, 1, At, B1); PG8_BAR;
            PG8_LDA(At, 1, 1); PG8_STAGE(PG8_SA(1, 0), a3, voffA);
            PG8_BAR; PG8_WAIT_L(0); PG8_MMA(1, 0, At, B0); PG8_BAR; PG8_SCHED;
            PG8_STAGE(PG8_SB(1, 1), b3 + hstep, voffB);
            PG8_WAIT_V(6); PG8_BAR; PG8_MMA(1, 1, At, B1); PG8_BAR;
            }
        }
        if constexpr (ALIGN_EPI) { if (wr == 0) PG8_BAR; }
        if constexpr (!Epi::AFTER_DRAIN) { E(acc, cur, wr, wc, fr, fq); S.done(cur); }
        if (!has_next) break;
#pragma unroll
        for (int a = 0; a < 2; ++a)
#pragma unroll
            for (int b = 0; b < 2; ++b)
#pragma unroll
                for (int m = 0; m < 4; ++m)
#pragma unroll
                    for (int n = 0; n < 2; ++n) acc[a][b][m][n] = (f32x4){0.f, 0.f, 0.f, 0.f};
        cur = nxt; cA = nA; cB = nB; ++ui;
        if constexpr (ALIGN_EPI) { if (wr == 1) PG8_BAR; }
    }
    PG8_WAIT_V(0);
    if constexpr (!ALIGN_EPI) { if (wr == 0) PG8_BAR; }
    PG8_BAR;
    if constexpr (Epi::AFTER_DRAIN) { E.fused(acc, cur, wr, wc, fr, fq, lds, wid, lane); S.done(cur); }
#undef PG8_SA
#undef PG8_SB
#undef PG8_STAGE
#undef PG8_LDA
#undef PG8_LDB
#undef PG8_MMA
#undef PG8_WAIT_V
#undef PG8_WAIT_L
#undef PG8_BAR
#undef PG8_SCHED
}
}

#define LAS __attribute__((address_space(3)))
typedef unsigned short bf16_t;
typedef short bf16x8 __attribute__((ext_vector_type(8)));
typedef short s16x4 __attribute__((ext_vector_type(4)));
typedef float f32x4 __attribute__((ext_vector_type(4)));
typedef float f32x16 __attribute__((ext_vector_type(16)));
typedef unsigned u32x4 __attribute__((ext_vector_type(4)));
typedef unsigned u32x2 __attribute__((ext_vector_type(2)));


__device__ __forceinline__ int otid() { int t = threadIdx.x; asm volatile("" : "+v"(t)); return t; }
__device__ __forceinline__ unsigned ozero() { unsigned z = 0u; asm volatile("" : "+v"(z)); return z; }
__device__ __forceinline__ int obid() { int b = blockIdx.x; asm volatile("" : "+s"(b)); return b; }
constexpr int NWAVES = 8, NTHR = 512;
constexpr int DM = 2048, MC = 4096, ML = 8192, MROWS = 12288, MKROWS = 13312;
constexpr int LDP_AB = 7168, LDP_C = 5120;
constexpr int COL_QL = 0, COL_KVL = 512, COL_AG = 768, COL_BQ = 1792, COL_FF = 2816, COL_FB = 3840, COL_BI = 4864, COL_BG = 5888, COL_KPE = 6912;
constexpr float EPSN = 1e-6f;
constexpr float LOG2E = 1.4426950408889634f;
constexpr float QSC_A = 0.07216878364870322f * LOG2E;
constexpr float QSC_C = 0.08838834764831845f * LOG2E;

constexpr size_t O_YP = 0, O_YS = 8388608, O_CKV = 25165824, O_KPE = 27262976, O_SF = 27787264, O_SB = 31981568, O_KC = 36175872, O_VC = 40370176;

constexpr size_t MiB = 1u << 20;
constexpr size_t WS_CTL = 0, CTL_BYTES = 131072;
constexpr size_t WS_MOD = 1 * MiB, WS_LB = WS_MOD + 512 * 1024, WS_ROPEA = WS_LB + 64 * 1024, WS_ROPEC = WS_ROPEA + 512 * 1024;
constexpr size_t WS_KCC = 532 * MiB;
constexpr size_t WS_WINAB = 8 * MiB, WS_WQUP = 64 * MiB, WS_WKVUP = 67 * MiB, WS_WOUTAB = 69 * MiB, WS_WINC = 85 * MiB, WS_WOUTC = 125 * MiB;
constexpr size_t WS_H = 141 * MiB, WS_PROJ = 189 * MiB, WS_QRAW = 357 * MiB, WS_KVRAW = 393 * MiB, WS_KF = 445 * MiB, WS_OF = 484 * MiB, WS_OB = 508 * MiB;
constexpr size_t WS_QN = WS_H, WS_CKV = WS_H + 12 * MiB, WS_END = 552 * MiB;
constexpr size_t WS_SBUF = 4 * MiB;
constexpr int NBG = 64;

constexpr int LDS_PHASE = 131072, LDS_BYTES = LDS_PHASE + 1024;

__device__ __forceinline__ float bf2f(unsigned short b) { return __uint_as_float((unsigned)b << 16); }
typedef float f32x2_t __attribute__((ext_vector_type(2)));
typedef __bf16 bf16x2_t __attribute__((ext_vector_type(2)));
__device__ __forceinline__ unsigned pk2(float lo, float hi) { const f32x2_t v = {lo, hi}; const bf16x2_t b = __builtin_convertvector(v, bf16x2_t); return __builtin_bit_cast(unsigned, b); }
__device__ __forceinline__ unsigned f2bf(float f) { return pk2(f, 0.f) & 0xffffu; }
__device__ __forceinline__ float silu_f(float x) { return x * __builtin_amdgcn_rcpf(1.f + __expf(-x)); }
__device__ __forceinline__ float wave_sum(float v) {
#pragma unroll
    for (int o = 1; o < 64; o <<= 1) v += __shfl_xor(v, o);
    return v;
}
__device__ __forceinline__ float sum16(float v) {
    v += __shfl_xor(v, 1); v += __shfl_xor(v, 2); v += __shfl_xor(v, 4); v += __shfl_xor(v, 8); return v;
}
__device__ __forceinline__ bf16x8 pack8(const float* v) {
    u32x4 w; w.x = pk2(v[0], v[1]); w.y = pk2(v[2], v[3]); w.z = pk2(v[4], v[5]); w.w = pk2(v[6], v[7]); return __builtin_bit_cast(bf16x8, w);
}

struct Args { const float* in[31]; float* out; unsigned char* ws; };
typedef const Args __attribute__((address_space(4)))* KArgs;

struct P0Item { const float* W; bf16_t* WT; int K, N, k0, n0, d0; };
__device__ __forceinline__ void p0_load(const P0Item& q, float (&v)[32], int lane) {
#pragma unroll
    for (int i = 0; i < 32; ++i) { const int kk = 2 * i + (lane >> 5); v[i] = q.W[(size_t)(q.k0 + kk) * q.N + q.n0 + (lane & 31)]; }
}
__device__ __forceinline__ void p0_emit(const P0Item& q, const float (&v)[32], LAS float* scr, int lane) {
#pragma unroll
    for (int i = 0; i < 32; ++i) { const int kk = 2 * i + (lane >> 5); scr[kk * 33 + (lane & 31)] = v[i]; }
    asm volatile("s_waitcnt lgkmcnt(0)" ::: "memory");
    const int c = lane & 7;
#pragma unroll
    for (int j = 0; j < 4; ++j) { const int n = (lane >> 3) + 8 * j; const LAS float* s = scr + (8 * c) * 33 + n;
        u32x4 o; o.x = pk2(s[0 * 33], s[1 * 33]); o.y = pk2(s[2 * 33], s[3 * 33]); o.z = pk2(s[4 * 33], s[5 * 33]); o.w = pk2(s[6 * 33], s[7 * 33]);
        *(u32x4*)(q.WT + (size_t)(q.d0 + n) * q.K + q.k0 + 8 * c) = o; }
    asm volatile("s_waitcnt lgkmcnt(0)" ::: "memory");
}
__device__ __forceinline__ P0Item p0_decode(KArgs a, int it) {
    constexpr int I_INAB = 32 * 218, I_QUP = 8 * 48, I_KVUP = 4 * 64, I_OUT = 32 * 64, I_INC = 32 * 160;
    constexpr int PER_J = I_INAB + I_QUP + I_KVUP + I_OUT + I_INC + I_OUT;
    unsigned char* ws = a->ws; P0Item q;
    const int j = it / PER_J; int r = it % PER_J;
    if (r < I_INAB) { const int kb = r / 218, nb = r % 218, n0 = nb * 32;
        q.W = a->in[13] + (size_t)j * 2048 * 6976; q.WT = (bf16_t*)(ws + WS_WINAB) + (size_t)j * 7168 * 2048; q.K = 2048; q.N = 6976; q.k0 = kb * 64; q.n0 = n0; q.d0 = n0 < 768 ? n0 : (n0 < 832 ? n0 + 6144 : n0 - 64); return q; }
    r -= I_INAB;
    if (r < I_QUP) { const int kb = r / 48, nb = r % 48;
        q.W = a->in[16] + (size_t)j * 512 * 1536; q.WT = (bf16_t*)(ws + WS_WQUP) + (size_t)j * 1536 * 512; q.K = 512; q.N = 1536; q.k0 = kb * 64; q.n0 = nb * 32; q.d0 = nb * 32; return q; }
    r -= I_QUP;
    if (r < I_KVUP) { const int kb = r / 64, nb = r % 64;
        q.W = a->in[17] + (size_t)j * 256 * 2048; q.WT = (bf16_t*)(ws + WS_WKVUP) + (size_t)j * 2048 * 256; q.K = 256; q.N = 2048; q.k0 = kb * 64; q.n0 = nb * 32; q.d0 = nb * 32; return q; }
    r -= I_KVUP;
    if (r < I_OUT) { const int kb = r / 64, nb = r % 64;
        q.W = a->in[22] + (size_t)j * 2048 * 2048; q.WT = (bf16_t*)(ws + WS_WOUTAB) + (size_t)j * 2048 * 2048; q.K = 2048; q.N = 2048; q.k0 = kb * 64; q.n0 = nb * 32; q.d0 = nb * 32; return q; }
    r -= I_OUT;
    if (r < I_INC) { const int kb = r / 160, nb = r % 160;
        q.W = a->in[26] + (size_t)j * 2048 * 5120; q.WT = (bf16_t*)(ws + WS_WINC) + (size_t)j * 5120 * 2048; q.K = 2048; q.N = 5120; q.k0 = kb * 64; q.n0 = nb * 32; q.d0 = nb * 32; return q; }
    r -= I_INC;
    { const int kb = r / 64, nb = r % 64;
        q.W = a->in[30] + (size_t)j * 2048 * 2048; q.WT = (bf16_t*)(ws + WS_WOUTC) + (size_t)j * 2048 * 2048; q.K = 2048; q.N = 2048; q.k0 = kb * 64; q.n0 = nb * 32; q.d0 = nb * 32; return q; }
}

__device__ __forceinline__ void p0_transposes(KArgs a, LAS unsigned char* lds, int lo, int hi, int w, int NW) {
    const int lane = otid() & 63, wave = (otid() >> 6);
    LAS float* scr = (LAS float*)(lds + wave * 8448);
    for (int it = lo + w; it < hi; it += 2 * NW) {
        const bool two = it + NW < hi;
        const P0Item qa = p0_decode(a, it); const P0Item qb = p0_decode(a, two ? it + NW : it);
        float va[32], vb[32];
        p0_load(qa, va, lane); if (two) p0_load(qb, vb, lane);
        p0_emit(qa, va, scr, lane); if (two) p0_emit(qb, vb, scr, lane);
    }
}
constexpr int P0_EARLY = 32 * 218 + 8 * 48 + 4 * 64 + 32 * 64;
constexpr int P0_TOTAL = 2 * (32 * 218 + 8 * 48 + 4 * 64 + 32 * 64 + 32 * 160 + 32 * 64);
__device__ __forceinline__ void phase_p0(KArgs a, LAS unsigned char* lds) {
    const int tid = otid(), lane = tid & 63, wave = tid >> 6;
    const int G = gridDim.x, bid = obid();
    const int gw = bid * NWAVES + wave, NGW = G * NWAVES;
    unsigned char* ws = a->ws;
    p0_transposes(a, lds, 0, P0_EARLY, gw, NGW);
    p0_transposes(a, lds, P0_EARLY + 16000, P0_TOTAL, gw, NGW);
    const int gt = bid * NTHR + tid, NGT = G * NTHR;
    const unsigned zz = ozero();
    for (int i = gt; i < 2 * 192 * 256; i += NGT) { const int j = i / (192 * 256), r = i % (192 * 256);
        *(u32x4*)((bf16_t*)(ws + WS_WINAB) + (size_t)j * 7168 * 2048 + (size_t)6976 * 2048 + (size_t)r * 8) = (u32x4){zz, zz, zz, zz}; }
    for (int i = gt; i < 2 * 131072; i += NGT) { const int which = i / 131072, e = (i % 131072) * 8;
        const float* src = a->in[6 + which] + e; const f32x4 x0 = *(const f32x4*)src, x1 = *(const f32x4*)(src + 4);
        u32x4 w; w.x = pk2(x0[0], x0[1]); w.y = pk2(x0[2], x0[3]); w.z = pk2(x1[0], x1[1]); w.w = pk2(x1[2], x1[3]);
        *(u32x4*)((bf16_t*)(ws + WS_KCC) + (size_t)(e >> 9) * LDP_C + (which ? 512 : 0) + (e & 511)) = w; }
    for (int i = gt; i < 2 * 2048; i += NGT) { const int j = i / 2048, r = i % 2048; const float l0 = a->in[20][r], l1 = a->in[20][2048 + r];
        ((float*)(ws + WS_LB))[i] = j == 0 ? 0.f : 1.f / (1.f + __expf(l0 - l1)); }
    for (int i = gt; i < 2048 * 32; i += NGT) { const int t = i >> 5, f = i & 31; const float pos = f < 16 ? (float)(t >> 6) : (float)(t & 63);
        const float inv = exp2f(-(float)(f & 15) * (13.287712379549449f / 16.f)); const float ang = pos * inv;
        ((float*)(ws + WS_ROPEA))[2 * i] = __cosf(ang); ((float*)(ws + WS_ROPEA))[2 * i + 1] = __sinf(ang); }
    for (int i = gt; i < 2048 * 64; i += NGT) { const int t = i >> 6, f = i & 63; const float pos = f < 32 ? (float)(t >> 6) : (float)(t & 63);
        const float inv = exp2f(-(float)(f & 31) * (13.287712379549449f / 32.f)); const float ang = pos * inv;
        ((float*)(ws + WS_ROPEC))[2 * i] = __cosf(ang); ((float*)(ws + WS_ROPEC))[2 * i + 1] = __sinf(ang); }
    __syncthreads();
    {
        LAS float* SC = (LAS float*)lds;
        LAS float* RED = (LAS float*)(lds + 40960);
        for (int i = tid; i < 5 * 2048; i += NTHR) { const int b = i >> 11, k = i & 2047; const float x = b < 4 ? a->in[8][b * 2048 + k] : a->in[9][k]; SC[i] = silu_f(x); }
        __syncthreads();
        const int cq = tid & 7, ks = tid >> 3;
        for (int u = bid; u < 768; u += G) {
            const int L = u / 192, col0 = (u % 192) * 32;
            const float* W = ((L & 1) ? a->in[23] : a->in[10]) + (size_t)(L >> 1) * 2048 * 6144;
            const float* bias = ((L & 1) ? a->in[24] : a->in[11]) + (size_t)(L >> 1) * 6144;
            f32x4 acc[5];
#pragma unroll
            for (int b = 0; b < 5; ++b) acc[b] = (f32x4){0.f, 0.f, 0.f, 0.f};
#pragma unroll 16
            for (int kk = 0; kk < 32; ++kk) { const int k = 32 * ks + kk; const f32x4 w = *(const f32x4*)(W + (size_t)k * 6144 + col0 + 4 * cq);
#pragma unroll
                for (int b = 0; b < 5; ++b) acc[b] += SC[b * 2048 + k] * w; }
#pragma unroll
            for (int b = 0; b < 5; ++b) *(LAS f32x4*)(RED + (ks * 5 + b) * 32 + 4 * cq) = acc[b];
            __syncthreads();
            if (tid < 160) { const int b = tid >> 5, c = tid & 31; float s = 0.f;
                for (int q = 0; q < 64; ++q) s += RED[(q * 5 + b) * 32 + c];
                ((float*)(ws + WS_MOD))[(L * 5 + b) * 6144 + col0 + c] = s + bias[col0 + c]; }
            __syncthreads();
        }
    }
}

__device__ __forceinline__ void phase_modnorm(KArgs a, int L) {
    const int tid = otid(), lane = tid & 63, wave = tid >> 6;
    const int gw = obid() * NWAVES + wave, NGW = gridDim.x * NWAVES;
    const float* g = ((L & 1) ? a->in[25] : a->in[12]) + (L >> 1) * 2048;
    bf16_t* H = (bf16_t*)(a->ws + WS_H);
    for (int r0 = gw * 2; r0 < MROWS; r0 += NGW * 2) {
        f32x4 v[2][8]; float ss[2] = {0.f, 0.f};
#pragma unroll
        for (int u = 0; u < 2; ++u) { const int r = r0 + u;
            const float* x = L <= 1 ? (r < MC ? a->in[0] + (size_t)r * DM : a->in[1] + (size_t)(r - MC) * DM) : a->out + (size_t)r * DM;
#pragma unroll
            for (int j = 0; j < 8; ++j) v[u][j] = *(const f32x4*)(x + 256 * j + 4 * lane);
            if (L > 0) { const bf16_t* dp = (const bf16_t*)(a->ws + WS_PROJ) + (size_t)r * DM;
#pragma unroll
                for (int j = 0; j < 8; ++j) { const u32x2 dv = *(const u32x2*)(dp + 256 * j + 4 * lane);
                    v[u][j][0] += __uint_as_float(dv.x << 16); v[u][j][1] += __uint_as_float(dv.x & 0xffff0000u); v[u][j][2] += __uint_as_float(dv.y << 16); v[u][j][3] += __uint_as_float(dv.y & 0xffff0000u);
                    *(f32x4*)(a->out + (size_t)r * DM + 256 * j + 4 * lane) = v[u][j]; } } }
#pragma unroll
        for (int u = 0; u < 2; ++u) {
#pragma unroll
            for (int j = 0; j < 8; ++j) ss[u] += (v[u][j][0] * v[u][j][0] + v[u][j][1] * v[u][j][1]) + (v[u][j][2] * v[u][j][2] + v[u][j][3] * v[u][j][3]); }
#pragma unroll
        for (int u = 0; u < 2; ++u) { const int r = r0 + u;
            const int ci = r < MC ? 4 : ((r - MC) >> 11);
            const float* md = (const float*)(a->ws + WS_MOD) + (L * 5 + ci) * 6144;
            const float rstd = rsqrtf(wave_sum(ss[u]) * (1.f / 2048.f) + EPSN);
#pragma unroll
            for (int j = 0; j < 8; ++j) { const int c = 256 * j + 4 * lane;
                const f32x4 gg = *(const f32x4*)(g + c), sh = *(const f32x4*)(md + c), sc = *(const f32x4*)(md + 2048 + c);
                const f32x4 y = (v[u][j] * rstd * gg) * (sc + 1.f) + sh;
                u32x2 w; w.x = pk2(y[0], y[1]); w.y = pk2(y[2], y[3]);
                *(u32x2*)(H + (size_t)r * DM + c) = w; } }
    }
}

__device__ __forceinline__ void phase_final(KArgs a) {
    const int tid = otid();
    const int gt = obid() * NTHR + tid, NGT = gridDim.x * NTHR;
    const bf16_t* D = (const bf16_t*)(a->ws + WS_PROJ); float* out = a->out;
    for (int i = gt; i < MROWS * DM / 8; i += NGT) { const size_t e = (size_t)i * 8;
        const bf16x8 dv = *(const bf16x8*)(D + e); f32x4 x0 = *(const f32x4*)(out + e), x1 = *(const f32x4*)(out + e + 4);
        x0[0] += bf2f((unsigned short)dv[0]); x0[1] += bf2f((unsigned short)dv[1]); x0[2] += bf2f((unsigned short)dv[2]); x0[3] += bf2f((unsigned short)dv[3]);
        x1[0] += bf2f((unsigned short)dv[4]); x1[1] += bf2f((unsigned short)dv[5]); x1[2] += bf2f((unsigned short)dv[6]); x1[3] += bf2f((unsigned short)dv[7]);
        *(f32x4*)(out + e) = x0; *(f32x4*)(out + e + 4) = x1; }
}

__device__ __forceinline__ void phase_prep_ab(KArgs a, int j, int wg, int nwg) {
    const int tid = otid(), lane = tid & 63, wave = tid >> 6;
    const int gw = wg * NWAVES + wave, NGW = nwg * NWAVES;
    const bf16_t* P = (const bf16_t*)(a->ws + WS_PROJ);
    bf16_t* QN = (bf16_t*)(a->ws + WS_QN); bf16_t* CKV = (bf16_t*)(a->ws + WS_CKV);
    const float* gq = a->in[14] + j * 512; const float* gkv = a->in[15] + j * 256;
    for (int r = gw; r < MKROWS; r += NGW) {
        if (r < MROWS) {
            const bf16_t* p = P + (size_t)r * LDP_AB;
            const bf16x8 q = *(const bf16x8*)(p + COL_QL + 8 * lane);
            float qv[8]; float ss = 0.f;
#pragma unroll
            for (int e = 0; e < 8; ++e) { qv[e] = bf2f((unsigned short)q[e]); ss += qv[e] * qv[e]; }
            const float rq = rsqrtf(wave_sum(ss) * (1.f / 512.f) + EPSN);
#pragma unroll
            for (int e = 0; e < 8; ++e) qv[e] = qv[e] * rq * gq[8 * lane + e];
            *(bf16x8*)(QN + (size_t)r * 512 + 8 * lane) = pack8(qv);
            const s16x4 kv = *(const s16x4*)(p + COL_KVL + 4 * lane);
            float kf[4]; float s2 = 0.f;
#pragma unroll
            for (int e = 0; e < 4; ++e) { kf[e] = bf2f((unsigned short)kv[e]); s2 += kf[e] * kf[e]; }
            const float rk = rsqrtf(wave_sum(s2) * (1.f / 256.f) + EPSN);
#pragma unroll
            for (int e = 0; e < 4; ++e) kf[e] = kf[e] * rk * gkv[4 * lane + e];
            u32x2 w; w.x = pk2(kf[0], kf[1]); w.y = pk2(kf[2], kf[3]);
            *(u32x2*)(CKV + (size_t)r * 256 + 4 * lane) = w;
            if (r < MC) { const int b = r >> 8, t = r & 255; const size_t rowo = (size_t)((b * 2 + j) * 256 + t);
                *(f32x4*)(a->out + O_CKV + rowo * 256 + 4 * lane) = (f32x4){kf[0], kf[1], kf[2], kf[3]};
                a->out[O_KPE + rowo * 64 + lane] = bf2f(p[COL_KPE + lane]); }
        } else {
            const int rr = r - MROWS, b = rr >> 8, t = rr & 255;
            const f32x4 x = *(const f32x4*)(a->in[2] + (size_t)((b * 2 + j) * 256 + t) * 256 + 4 * lane);
            u32x2 w; w.x = pk2(x[0], x[1]); w.y = pk2(x[2], x[3]);
            *(u32x2*)(CKV + (size_t)r * 256 + 4 * lane) = w;
        }
    }
}

__device__ __forceinline__ void phase_hn_ab(KArgs a, int j, int wg, int nwg) {
    const int tid = otid(), lane = tid & 63, wave = tid >> 6, sub = lane & 15, hq = lane >> 4;
    const int gw = wg * NWAVES + wave, NGW = nwg * NWAVES;
    bf16_t* Q = (bf16_t*)(a->ws + WS_QRAW); const bf16_t* KV = (const bf16_t*)(a->ws + WS_KVRAW); bf16_t* KF = (bf16_t*)(a->ws + WS_KF);
    const bf16_t* P = (const bf16_t*)(a->ws + WS_PROJ);
    const float* RA = (const float*)(a->ws + WS_ROPEA);
    const float* gq = a->in[18] + j * 192; const float* gk = a->in[19] + j * 192;
    const float* ckpe = a->in[3];
    constexpr int U = 4;
    const int NQ = 0, NIT = MKROWS * 2;
    for (int base = gw * U; base < NIT; base += NGW * U) {
        bf16x8 vn[U]; float x1[U][2], x2[U][2]; f32x4 cs[U];
#pragma unroll
        for (int u = 0; u < U; ++u) { const int it = base + u; if (it < NIT) {
            const bool isq = it < NQ; const int w = isq ? it : it - NQ; const int r = w >> 1, h = (w & 1) * 4 + hq;
            if (isq) { const bf16_t* p = Q + (size_t)r * 1536 + h * 192;
                vn[u] = *(const bf16x8*)(p + 8 * sub); const unsigned a1 = *(const unsigned*)(p + 128 + 2 * sub), a2 = *(const unsigned*)(p + 160 + 2 * sub);
                x1[u][0] = bf2f(a1 & 0xffff); x1[u][1] = bf2f(a1 >> 16); x2[u][0] = bf2f(a2 & 0xffff); x2[u][1] = bf2f(a2 >> 16);
            } else { vn[u] = *(const bf16x8*)(KV + (size_t)r * 2048 + h * 256 + 8 * sub);
                if (r < MROWS) { const bf16_t* pe = P + (size_t)r * LDP_AB + COL_KPE; const unsigned a1 = *(const unsigned*)(pe + 2 * sub), a2 = *(const unsigned*)(pe + 32 + 2 * sub);
                    x1[u][0] = bf2f(a1 & 0xffff); x1[u][1] = bf2f(a1 >> 16); x2[u][0] = bf2f(a2 & 0xffff); x2[u][1] = bf2f(a2 >> 16); }
                else { const int rr = r - MROWS, b = rr >> 8, t = rr & 255; const float* pe = ckpe + (size_t)((b * 2 + j) * 256 + t) * 64;
                    x1[u][0] = pe[2 * sub]; x1[u][1] = pe[2 * sub + 1]; x2[u][0] = pe[32 + 2 * sub]; x2[u][1] = pe[32 + 2 * sub + 1]; } }
            if (r >= MC && r < MROWS) cs[u] = *(const f32x4*)(RA + (((r - MC) & 2047) * 32 + 2 * sub) * 2);
        } }
#pragma unroll
        for (int u = 0; u < U; ++u) { const int it = base + u; if (it < NIT) {
            const bool isq = it < NQ; const int w = isq ? it : it - NQ; const int r = w >> 1, h = (w & 1) * 4 + hq;
            float xn[8];
#pragma unroll
            for (int e = 0; e < 8; ++e) xn[e] = bf2f((unsigned short)vn[u][e]);
            float ss = x1[u][0] * x1[u][0] + x1[u][1] * x1[u][1] + x2[u][0] * x2[u][0] + x2[u][1] * x2[u][1];
#pragma unroll
            for (int e = 0; e < 8; ++e) ss += xn[e] * xn[e];
            const float rstd = rsqrtf(sum16(ss) * (1.f / 192.f) + EPSN);
            const float* g = isq ? gq : gk;
#pragma unroll
            for (int e = 0; e < 8; ++e) xn[e] = xn[e] * rstd * g[8 * sub + e];
            float y1[2], y2[2];
            y1[0] = x1[u][0] * rstd * g[128 + 2 * sub]; y1[1] = x1[u][1] * rstd * g[128 + 2 * sub + 1]; y2[0] = x2[u][0] * rstd * g[160 + 2 * sub]; y2[1] = x2[u][1] * rstd * g[160 + 2 * sub + 1];
            if (r >= MC && r < MROWS) {
#pragma unroll
                for (int q = 0; q < 2; ++q) { const float c = cs[u][2 * q], sn = cs[u][2 * q + 1];
                    const float z1 = y1[q] * c - y2[q] * sn, z2 = y1[q] * sn + y2[q] * c; y1[q] = z1; y2[q] = z2; } }
            bf16_t* p;
            if (isq) {
#pragma unroll
                for (int e = 0; e < 8; ++e) xn[e] *= QSC_A;
                y1[0] *= QSC_A; y1[1] *= QSC_A; y2[0] *= QSC_A; y2[1] *= QSC_A;
                p = Q + (size_t)r * 1536 + h * 192;
            } else p = KF + (size_t)r * 1536 + h * 192;
            *(bf16x8*)(p + 8 * sub) = pack8(xn); *(unsigned*)(p + 128 + 2 * sub) = pk2(y1[0], y1[1]); *(unsigned*)(p + 160 + 2 * sub) = pk2(y2[0], y2[1]);
        } }
    }
}

__device__ __forceinline__ void phase_fin_ab(KArgs a, int j) {
    const int tid = otid(), lane = tid & 63, wave = tid >> 6, sub = lane & 15, hq = lane >> 4;
    const int gw = obid() * NWAVES + wave, NGW = gridDim.x * NWAVES;
    const bf16_t* OF = (const bf16_t*)(a->ws + WS_OF); const bf16_t* OB = (const bf16_t*)(a->ws + WS_OB);
    const bf16_t* P = (const bf16_t*)(a->ws + WS_PROJ); bf16_t* MIX = (bf16_t*)(a->ws + WS_H);
    const float* g = a->in[21] + j * 128;
    constexpr int U = 4;
    for (int base = gw * U; base < MROWS * 2; base += NGW * U) {
        bf16x8 va[U], vb[U], vg[U];
#pragma unroll
        for (int u = 0; u < U; ++u) { const int it = base + u; const int r = it >> 1, h = (it & 1) * 4 + hq; const size_t o = (size_t)r * 1024 + h * 128 + 8 * sub;
            va[u] = *(const bf16x8*)(OF + o); vb[u] = *(const bf16x8*)(OB + o); vg[u] = *(const bf16x8*)(P + (size_t)r * LDP_AB + COL_BG + h * 128 + 8 * sub); }
#pragma unroll
        for (int u = 0; u < U; ++u) { const int it = base + u; const int r = it >> 1, h = (it & 1) * 4 + hq;
            float s[8]; float ss = 0.f;
#pragma unroll
            for (int e = 0; e < 8; ++e) { s[e] = bf2f((unsigned short)va[u][e]) + bf2f((unsigned short)vb[u][e]); ss += s[e] * s[e]; }
            const float rstd = rsqrtf(sum16(ss) * (1.f / 128.f) + EPSN);
#pragma unroll
            for (int e = 0; e < 8; ++e) s[e] = s[e] * rstd * g[8 * sub + e] * silu_f(bf2f((unsigned short)vg[u][e]));
            *(bf16x8*)(MIX + (size_t)r * DM + 1024 + h * 128 + 8 * sub) = pack8(s); }
    }
}

__device__ __forceinline__ void phase_hn_c(KArgs a, int j) {
    const int tid = otid(), lane = tid & 63, wave = tid >> 6, sub = lane & 15, hq = lane >> 4;
    const int gw = obid() * NWAVES + wave, NGW = gridDim.x * NWAVES;
    bf16_t* P = (bf16_t*)(a->ws + WS_PROJ);
    const float* RC = (const float*)(a->ws + WS_ROPEC);
    const float* gq = a->in[27] + j * 128; const float* gk = a->in[28] + j * 128;
    float* outp = a->out;
    for (int r = gw; r < MC; r += NGW) { const int b = r >> 8, t = r & 255; const bf16x8 v = *(const bf16x8*)(P + (size_t)r * LDP_C + 2560 + 8 * lane);
        float* o = outp + O_VC + (size_t)((b * 2 + j) * 256 + t) * 512 + 8 * lane;
        *(f32x4*)o = (f32x4){bf2f((unsigned short)v[0]), bf2f((unsigned short)v[1]), bf2f((unsigned short)v[2]), bf2f((unsigned short)v[3])};
        *(f32x4*)(o + 4) = (f32x4){bf2f((unsigned short)v[4]), bf2f((unsigned short)v[5]), bf2f((unsigned short)v[6]), bf2f((unsigned short)v[7])}; }
    constexpr int U = 4;
    const int NIT = MROWS;
    for (int base = gw * U; base < NIT; base += NGW * U) {
        s16x4 v1[U], v2[U]; f32x4 ca[U], cb[U];
#pragma unroll
        for (int u = 0; u < U; ++u) { const int it = base + u; if (it < NIT) {
            const int r = it, h = 16 + hq; const bool isq = false;
            const bf16_t* p = P + (size_t)r * LDP_C + (isq ? h * 128 : 2048 + (h - 16) * 128);
            v1[u] = *(const s16x4*)(p + 4 * sub); v2[u] = *(const s16x4*)(p + 64 + 4 * sub);
            if (r >= MC) { const float* rc = RC + (((r - MC) & 2047) * 64 + 4 * sub) * 2; ca[u] = *(const f32x4*)rc; cb[u] = *(const f32x4*)(rc + 4); }
        } }
#pragma unroll
        for (int u = 0; u < U; ++u) { const int it = base + u; if (it < NIT) {
            const int r = it, h = 16 + hq; const bool isq = false;
            bf16_t* p = P + (size_t)r * LDP_C + (isq ? h * 128 : 2048 + (h - 16) * 128);
            float x1[4], x2[4]; float ss = 0.f;
#pragma unroll
            for (int e = 0; e < 4; ++e) { x1[e] = bf2f((unsigned short)v1[u][e]); x2[e] = bf2f((unsigned short)v2[u][e]); ss += x1[e] * x1[e] + x2[e] * x2[e]; }
            const float rstd = rsqrtf(sum16(ss) * (1.f / 128.f) + EPSN);
            const float* g = isq ? gq : gk;
#pragma unroll
            for (int e = 0; e < 4; ++e) { x1[e] *= rstd * g[4 * sub + e]; x2[e] *= rstd * g[64 + 4 * sub + e]; }
            if (r >= MC) {
#pragma unroll
                for (int e = 0; e < 4; ++e) { const float c = e < 2 ? ca[u][2 * e] : cb[u][2 * (e - 2)], sn = e < 2 ? ca[u][2 * e + 1] : cb[u][2 * (e - 2) + 1];
                    const float y1 = x1[e] * c - x2[e] * sn, y2 = x1[e] * sn + x2[e] * c; x1[e] = y1; x2[e] = y2; } }
            else if (!isq) { const int b = r >> 8, t = r & 255; float* o = outp + O_KC + (size_t)((b * 2 + j) * 256 + t) * 512 + (h - 16) * 128;
                *(f32x4*)(o + 4 * sub) = (f32x4){x1[0], x1[1], x1[2], x1[3]}; *(f32x4*)(o + 64 + 4 * sub) = (f32x4){x2[0], x2[1], x2[2], x2[3]}; }
            if (isq) {
#pragma unroll
                for (int e = 0; e < 4; ++e) { x1[e] *= QSC_C; x2[e] *= QSC_C; } }
            u32x2 w1, w2; w1.x = pk2(x1[0], x1[1]); w1.y = pk2(x1[2], x1[3]); w2.x = pk2(x2[0], x2[1]); w2.y = pk2(x2[2], x2[3]);
            *(u32x2*)(p + 4 * sub) = w1; *(u32x2*)(p + 64 + 4 * sub) = w2;
        } }
    }
}

namespace att {
__device__ __forceinline__ int crow(int r, int hi) { return (r & 3) + 8 * (r >> 2) + 4 * hi; }
__device__ __forceinline__ unsigned cvtpk(float lo, float hi) { return pk2(lo, hi); }
__device__ __forceinline__ int v_st(int k, int c) { const int kk = (k & ~0xC) | ((k & 4) << 1) | ((k & 8) >> 1); return ((kk >> 3) * 4 + (c >> 5)) * 512 + ((kk & 7) * 32 + (c & 31)) * 2; }
__device__ __forceinline__ int v_rd_base(int lane) { return ((lane & 3) << 3) | (((lane >> 2) & 3) << 6) | (((lane >> 4) & 1) << 5) | (((lane >> 5) & 1) << 8); }
constexpr int v_rd_off(int d0, int ks, int half) { return d0 * 512 + ks * 4096 + half * 2048; }
template <int OFF> __device__ __forceinline__ s16x4 tr_read(int vb) {
    s16x4 r; asm volatile("ds_read_b64_tr_b16 %0, %1 offset:%2" : "=&v"(r) : "v"(vb), "i"(OFF) : "memory"); return r;
}
template <int D0> __device__ __forceinline__ void pv_read8(s16x4 (&r)[8], int vb) {
    r[0] = tr_read<v_rd_off(D0, 0, 0)>(vb); r[1] = tr_read<v_rd_off(D0, 0, 1)>(vb); r[2] = tr_read<v_rd_off(D0, 1, 0)>(vb); r[3] = tr_read<v_rd_off(D0, 1, 1)>(vb);
    r[4] = tr_read<v_rd_off(D0, 2, 0)>(vb); r[5] = tr_read<v_rd_off(D0, 2, 1)>(vb); r[6] = tr_read<v_rd_off(D0, 3, 0)>(vb); r[7] = tr_read<v_rd_off(D0, 3, 1)>(vb);
}
__device__ __forceinline__ void pv_mma4(f32x16& od, const s16x4 (&r)[8], bf16x8 pa0, bf16x8 pa1, bf16x8 pa2, bf16x8 pa3) {
#define ATT_PK(L, H) (bf16x8){L[0], L[1], L[2], L[3], H[0], H[1], H[2], H[3]}
    od = __builtin_amdgcn_mfma_f32_32x32x16_bf16(pa0, ATT_PK(r[0], r[1]), od, 0, 0, 0);
    od = __builtin_amdgcn_mfma_f32_32x32x16_bf16(pa1, ATT_PK(r[2], r[3]), od, 0, 0, 0);
    od = __builtin_amdgcn_mfma_f32_32x32x16_bf16(pa2, ATT_PK(r[4], r[5]), od, 0, 0, 0);
    od = __builtin_amdgcn_mfma_f32_32x32x16_bf16(pa3, ATT_PK(r[6], r[7]), od, 0, 0, 0);
#undef ATT_PK
}
__device__ __forceinline__ void pv_all(f32x16 (&o)[4], int vb, bf16x8 pa0, bf16x8 pa1, bf16x8 pa2, bf16x8 pa3) {
    s16x4 ra[8], rb[8];
    pv_read8<0>(ra, vb);
    pv_read8<1>(rb, vb); asm volatile("s_waitcnt lgkmcnt(8)" ::: "memory"); __builtin_amdgcn_sched_barrier(0);
    pv_mma4(o[0], ra, pa0, pa1, pa2, pa3); __builtin_amdgcn_sched_barrier(0);
    pv_read8<2>(ra, vb); asm volatile("s_waitcnt lgkmcnt(8)" ::: "memory"); __builtin_amdgcn_sched_barrier(0);
    pv_mma4(o[1], rb, pa0, pa1, pa2, pa3); __builtin_amdgcn_sched_barrier(0);
    pv_read8<3>(rb, vb); asm volatile("s_waitcnt lgkmcnt(8)" ::: "memory"); __builtin_amdgcn_sched_barrier(0);
    pv_mma4(o[2], ra, pa0, pa1, pa2, pa3); __builtin_amdgcn_sched_barrier(0);
    asm volatile("s_waitcnt lgkmcnt(0)" ::: "memory"); __builtin_amdgcn_sched_barrier(0);
    pv_mma4(o[3], rb, pa0, pa1, pa2, pa3);
}
struct Item {
    const bf16_t* Q; int ldq;
    const bf16_t* K0; const bf16_t* V0; int n0;
    const bf16_t* K1; const bf16_t* V1; int ldk, ldv, t_lo, t_hi;
    int q0, band; float m0, l0;
    const float* qg; const float* rope; float qscale;
    const bf16_t* G; int ldg; bf16_t* O; int ldo;
};
template <int DQK>
__device__ __forceinline__ void attn_item(LAS unsigned char* lds, const Item& it) {
    constexpr int KROW = DQK * 2, SHM_K = 64 * KROW, SHM_V = 64 * 128 * 2, ND = DQK / 16;
    const int tid = otid(), wid = tid >> 6, lane = tid & 63, r32 = lane & 31, hi = lane >> 5;
    LAS unsigned char* V_lds = lds; LAS unsigned char* K_lds = lds + 3 * SHM_V;
    LAS float* wsx = (LAS float*)(lds + 3 * SHM_V + 3 * SHM_K) + wid * 64; LAS float* li_l = wsx; LAS float* al_l = wsx + 32;
    float m_reg = it.m0, l_reg = it.l0;
    f32x16 o[4];
#pragma unroll
    for (int d = 0; d < 4; ++d)
#pragma unroll
        for (int r = 0; r < 16; ++r) o[d][r] = 0.f;
    bf16x8 qr[ND];
    {
      const bf16_t* Qw = it.Q + (size_t)(wid * 32 + r32) * it.ldq + hi * 8;
      float xf[ND][8]; float ss = 0.f;
#pragma unroll
      for (int d0 = 0; d0 < ND; ++d0) { const bf16x8 v = *(const bf16x8*)(Qw + d0 * 16);
#pragma unroll
          for (int e = 0; e < 8; ++e) { xf[d0][e] = bf2f((unsigned short)v[e]); ss += xf[d0][e] * xf[d0][e]; } }
      ss += __shfl_xor(ss, 32);
      const float rstd = rsqrtf(ss * (1.f / (float)DQK) + EPSN);
#pragma unroll
      for (int d0 = 0; d0 < ND; ++d0) { const f32x4 g0 = *(const f32x4*)(it.qg + d0 * 16 + hi * 8), g1 = *(const f32x4*)(it.qg + d0 * 16 + hi * 8 + 4);
#pragma unroll
          for (int e = 0; e < 8; ++e) xf[d0][e] *= rstd * (e < 4 ? g0[e & 3] : g1[e & 3]); }
      if (it.rope) { constexpr int NR = DQK == 128 ? 4 : 2, RB = DQK == 128 ? 0 : 8, RS = DQK == 128 ? 64 : 32;
          const float* rp = it.rope + (size_t)((it.q0 + wid * 32 + r32) * RS + hi * 8) * 2;
#pragma unroll
          for (int p = 0; p < NR; ++p) { f32x4 cs4[4];
#pragma unroll
              for (int q = 0; q < 4; ++q) cs4[q] = *(const f32x4*)(rp + p * 32 + 4 * q);
#pragma unroll
              for (int e = 0; e < 8; ++e) { const float c = cs4[e >> 1][(e & 1) * 2], sn = cs4[e >> 1][(e & 1) * 2 + 1];
                  const float x1 = xf[RB + p][e], x2 = xf[RB + NR + p][e]; xf[RB + p][e] = x1 * c - x2 * sn; xf[RB + NR + p][e] = x1 * sn + x2 * c; } } }
#pragma unroll
      for (int d0 = 0; d0 < ND; ++d0) { float t8[8];
#pragma unroll
          for (int e = 0; e < 8; ++e) t8[e] = xf[d0][e] * it.qscale;
          qr[d0] = pack8(t8); } }
    const int NT = it.n0 + (it.t_hi - it.t_lo);
    const int wvu = __builtin_amdgcn_readfirstlane(wid);
    const int vb0 = (int)(uintptr_t)V_lds + v_rd_base(lane);
    constexpr int NKI = SHM_K / 8192;
    unsigned kog[NKI], vog[2];
#pragma unroll
    for (int i = 0; i < NKI; ++i) { const int off = i * 8192 + wid * 1024 + lane * 16, row = off / KROW, pos = off % KROW; kog[i] = (unsigned)(row * it.ldk + ((pos ^ ((row & 7) << 4)) >> 1)); }
#pragma unroll
    for (int i = 0; i < 2; ++i) { const int q = (i * 8192 + wid * 1024 + lane * 16) >> 4, sub = q >> 5, rem = q & 31, rowin = rem >> 2, cch = rem & 3;
        const int kk = (sub >> 2) * 8 + rowin; vog[i] = (unsigned)(((kk & ~0xC) | ((kk & 4) << 1) | ((kk & 8) >> 1)) * it.ldv + (sub & 3) * 32 + cch * 8); }
    int koff[4];
#pragma unroll
    for (int dl = 0; dl < 4; ++dl) koff[dl] = r32 * KROW + ((dl * 32 + hi * 16) ^ ((r32 & 7) << 4));
#define ATT_STAGE(jj, b) do { const int _j = (jj); const bool _s0 = _j < it.n0; const int _t = _s0 ? _j : it.t_lo + (_j - it.n0); \
        const bf16_t* _Kp = (_s0 ? it.K0 : it.K1) + (size_t)(64 * _t) * it.ldk; const bf16_t* _Vp = (_s0 ? it.V0 : it.V1) + (size_t)(64 * _t) * it.ldv; \
        _Pragma("unroll") for (int _i = 0; _i < NKI; ++_i) __builtin_amdgcn_global_load_lds((const unsigned*)(_Kp + kog[_i]), (LAS unsigned*)(K_lds + (b) * SHM_K + _i * 8192 + wvu * 1024), 16, 0, 0); \
        _Pragma("unroll") for (int _i = 0; _i < 2; ++_i) __builtin_amdgcn_global_load_lds((const unsigned*)(_Vp + vog[_i]), (LAS unsigned*)(V_lds + (b) * SHM_V + _i * 8192 + wvu * 1024), 16, 0, 0); } while (0)
#define ATT_WAIT_TILE(more) do { if (more) { if constexpr (NKI == 3) asm volatile("s_waitcnt vmcnt(5)" ::: "memory"); else asm volatile("s_waitcnt vmcnt(4)" ::: "memory"); } \
        else asm volatile("s_waitcnt vmcnt(0)" ::: "memory"); \
        asm volatile("s_waitcnt lgkmcnt(0)" ::: "memory"); __builtin_amdgcn_s_barrier(); asm volatile("" ::: "memory"); } while (0)
    ATT_STAGE(0, 0); if (NT > 1) ATT_STAGE(1, 1);
    ATT_WAIT_TILE(NT > 1);
    int cur = 0;
    for (int j = 0; j < NT; ++j) {
        if (j + 2 < NT) ATT_STAGE(j + 2, (cur == 0 ? 2 : cur - 1));
        bool act = true; const bool domask = it.band && j >= it.n0; int kpos0 = 0;
        if (domask) { kpos0 = 64 * (it.t_lo + j - it.n0); const int qlo = it.q0 + wid * 32; act = (kpos0 + 63 >= qlo - 128) && (kpos0 <= qlo + 31 + 128); }
        if (act) {
            f32x16 p0, p1;
#pragma unroll
            for (int r = 0; r < 16; ++r) { p0[r] = 0.f; p1[r] = 0.f; }
            const LAS unsigned char* Ks = K_lds + cur * SHM_K;
            {
                constexpr int NG = ND / 4;
                bf16x8 kf[2][8];
#define ATT_LOADG(g_, dst) do { _Pragma("unroll") for (int u_ = 0; u_ < 4; ++u_) { dst[2 * u_] = *(const LAS bf16x8*)(Ks + koff[u_] + (g_) * 128); dst[2 * u_ + 1] = *(const LAS bf16x8*)(Ks + koff[u_] + (g_) * 128 + 32 * KROW); } } while (0)
                ATT_LOADG(0, kf[0]);
#pragma unroll
                for (int g = 0; g < NG; ++g) {
                    if (g + 1 < NG) ATT_LOADG(g + 1, kf[(g + 1) & 1]);
                    __builtin_amdgcn_sched_barrier(0);
#pragma unroll
                    for (int u_ = 0; u_ < 4; ++u_) { p0 = __builtin_amdgcn_mfma_f32_32x32x16_bf16(kf[g & 1][2 * u_], qr[4 * g + u_], p0, 0, 0, 0);
                        p1 = __builtin_amdgcn_mfma_f32_32x32x16_bf16(kf[g & 1][2 * u_ + 1], qr[4 * g + u_], p1, 0, 0, 0); }
                    __builtin_amdgcn_sched_barrier(0); }
#undef ATT_LOADG
            }
            if (domask) { const int qp = it.q0 + wid * 32 + r32;
#pragma unroll
                for (int r = 0; r < 16; ++r) { const int d = kpos0 + crow(r, hi) - qp;
                    if (d > 128 || d < -128) p0[r] = -1e30f;
                    if (d + 32 > 128 || d + 32 < -128) p1[r] = -1e30f; } }
            float pmax = p0[0];
#pragma unroll
            for (int r = 1; r < 16; ++r) pmax = fmaxf(pmax, p0[r]);
#pragma unroll
            for (int r = 0; r < 16; ++r) pmax = fmaxf(pmax, p1[r]);
            { auto rr = __builtin_amdgcn_permlane32_swap(__float_as_uint(pmax), __float_as_uint(pmax), false, false);
              pmax = fmaxf(__uint_as_float(rr[0]), __uint_as_float(rr[1])); }
            const float mn = fmaxf(m_reg, pmax); const float alpha = __builtin_amdgcn_exp2f(m_reg - mn); m_reg = mn;
            float ps = 0.f;
#pragma unroll
            for (int r = 0; r < 16; ++r) { p0[r] = __builtin_amdgcn_exp2f(p0[r] - mn); p1[r] = __builtin_amdgcn_exp2f(p1[r] - mn); ps += p0[r] + p1[r]; }
            { auto rr = __builtin_amdgcn_permlane32_swap(__float_as_uint(ps), __float_as_uint(ps), false, false);
              ps = __uint_as_float(rr[0]) + __uint_as_float(rr[1]); }
            l_reg = l_reg * alpha + ps;
            bf16x8 pa0, pa1, pa2, pa3;
#define ATT_PK4(P, BASE, OUT) do { unsigned a0 = cvtpk(P[BASE + 0], P[BASE + 1]), a1 = cvtpk(P[BASE + 2], P[BASE + 3]);   \
    unsigned b0 = cvtpk(P[BASE + 4], P[BASE + 5]), b1 = cvtpk(P[BASE + 6], P[BASE + 7]);                              \
    auto r0 = __builtin_amdgcn_permlane32_swap(a0, b0, false, false); auto r1 = __builtin_amdgcn_permlane32_swap(a1, b1, false, false); \
    u32x4 w = {r0[0], r1[0], r0[1], r1[1]}; OUT = __builtin_bit_cast(bf16x8, w); } while (0)
            ATT_PK4(p0, 0, pa0); ATT_PK4(p0, 8, pa1); ATT_PK4(p1, 0, pa2); ATT_PK4(p1, 8, pa3);
#undef ATT_PK4
            if (__any(alpha < 1.f)) { if (hi == 0) al_l[r32] = alpha; asm volatile("s_waitcnt lgkmcnt(0)" ::: "memory");
#pragma unroll
                for (int r = 0; r < 16; ++r) { const float al = al_l[crow(r, hi)];
#pragma unroll
                    for (int d = 0; d < 4; ++d) o[d][r] *= al; } }
            const int vb = vb0 + cur * SHM_V;
            pv_all(o, vb, pa0, pa1, pa2, pa3);
        }
        ATT_WAIT_TILE(j + 2 < NT);
        cur = cur == 2 ? 0 : cur + 1;
    }
#undef ATT_STAGE
#undef ATT_WAIT_TILE
    const int er = lane >> 4, ec = (lane & 15) * 8;
    bf16x8 gv[8];
    { const bf16_t* Gw = it.G + (size_t)(wid * 32 + er) * it.ldg + ec;
#pragma unroll
      for (int c = 0; c < 8; ++c) gv[c] = *(const bf16x8*)(Gw + (size_t)(4 * c) * it.ldg); }
    if (hi == 0) li_l[r32] = l_reg; asm volatile("s_waitcnt lgkmcnt(0)" ::: "memory");
    LAS bf16_t* ost = (LAS bf16_t*)(lds + wid * 8192);
#pragma unroll
    for (int r = 0; r < 16; ++r) { const float rli = 1.f / li_l[crow(r, hi)];
#pragma unroll
        for (int d0 = 0; d0 < 4; ++d0) ost[crow(r, hi) * 128 + d0 * 32 + r32] = (bf16_t)f2bf(o[d0][r] * rli); }
    asm volatile("s_waitcnt lgkmcnt(0)" ::: "memory");
    { bf16_t* Ow = it.O + (size_t)(wid * 32 + er) * it.ldo + ec;
#pragma unroll
      for (int c = 0; c < 8; ++c) { const bf16x8 ov = *(const LAS bf16x8*)(ost + (4 * c + er) * 128 + ec); float t8[8];
#pragma unroll
          for (int e = 0; e < 8; ++e) t8[e] = bf2f((unsigned short)ov[e]) * silu_f(bf2f((unsigned short)gv[c][e]));
          *(bf16x8*)(Ow + (size_t)(4 * c) * it.ldo) = pack8(t8); } }
    __syncthreads();
}
}

__device__ __forceinline__ void hgrn_item(LAS unsigned char* lds, const bf16_t* PROJ, int rowbase, int T, int h, int dir,
                                          const float* lb, const float* s0, float* sout, bf16_t* OUT, int c0, int c1, float* sbuf) {
    const int tid = otid(), wid = tid >> 6, lane = tid & 63, fr = lane & 15, fq = lane >> 4;
    const int c2 = 16 * wid + (lane & 15), part = lane >> 4, n0 = wid * 16;
    f32x4 S[8];
    { const float* sin_ = c0 > 0 ? sbuf : (s0 ? s0 : sbuf);
      const float ssc = (c0 > 0 || s0) ? 1.f : 0.f;
#pragma unroll
      for (int kt = 0; kt < 8; ++kt)
#pragma unroll
          for (int r = 0; r < 4; ++r) S[kt][r] = sin_[(size_t)(16 * kt + 4 * fq + r) * 128 + n0 + fr] * ssc; }
    __builtin_amdgcn_s_waitcnt(0x0F70);
    const float oml = 1.f - lb[c2];
    const unsigned hz = ozero();
    const int nch = T / 32;
    LAS unsigned char* RAW = lds + 76800;
    const int wvu = __builtin_amdgcn_readfirstlane(wid);
    const int dtl = 4 * wid + (lane >> 4), dch = (lane & 15) * 8;
    const bf16_t* dsrc = PROJ + h * 128 + dch;
    const int colf = dir ? COL_FB : COL_FF;
#define HG_DMA(cc, slot) do { const int _p = 32 * (cc) + dtl; const int _tok = dir ? T - 1 - _p : _p; const bf16_t* _s = dsrc + (size_t)(rowbase + _tok) * LDP_AB; \
        __builtin_amdgcn_global_load_lds((const unsigned*)(_s + COL_BQ), (LAS unsigned*)(RAW + (slot) * 24576 + wvu * 1024), 16, 0, 0); \
        __builtin_amdgcn_global_load_lds((const unsigned*)(_s + colf), (LAS unsigned*)(RAW + (slot) * 24576 + 8192 + wvu * 1024), 16, 0, 0); \
        __builtin_amdgcn_global_load_lds((const unsigned*)(_s + COL_BI), (LAS unsigned*)(RAW + (slot) * 24576 + 16384 + wvu * 1024), 16, 0, 0); } while (0)
#define HG_BAR() do { asm volatile("s_waitcnt lgkmcnt(0)" ::: "memory"); __builtin_amdgcn_s_barrier(); asm volatile("" ::: "memory"); } while (0)
    HG_DMA(c0, 0);
    asm volatile("s_waitcnt vmcnt(0)" ::: "memory");
    HG_BAR();
    int cur = 0;
    for (int cc = c0; cc < c1; ++cc) {
        if (cc + 1 < c1) HG_DMA(cc + 1, cur ^ 1);
        LAS float* DEC = (LAS float*)lds + cur * 128;
        LAS bf16_t* QT = (LAS bf16_t*)(lds + 1024 + cur * 37888);
        LAS bf16_t* KT = QT + 32 * 136;
        LAS bf16_t* KTt = KT + 32 * 136;
        LAS bf16_t* Vt = KTt + 128 * 40;
        float b[8], kk[8], sq[8]; unsigned short vv[8]; float run = 0.f;
        { const LAS bf16_t* rw = (const LAS bf16_t*)(RAW + cur * 24576) + (8 * part) * 128 + c2;
            unsigned short rq[8], rf[8];
#pragma unroll
            for (int i = 0; i < 8; ++i) { rq[i] = rw[i * 128]; rf[i] = rw[4096 + i * 128]; vv[i] = rw[8192 + i * 128]; }
#pragma unroll
            for (int i = 0; i < 8; ++i) { const float x = bf2f(rf[i]); const float omf = oml * __builtin_amdgcn_rcpf(1.f + __expf(x));
                const float lf = fmaxf(__logf(1.f - omf), -30.f); run += lf; b[i] = run; kk[i] = omf; sq[i] = silu_f(bf2f(rq[i])); } }
        { const float r1 = __shfl_up(run, 16), r2 = __shfl_up(run, 32), r3 = __shfl_up(run, 48);
            const float off = (part >= 1 ? r1 : 0.f) + (part >= 2 ? r2 : 0.f) + (part >= 3 ? r3 : 0.f);
            float kt_[8];
#pragma unroll
            for (int i = 0; i < 8; ++i) { const float bb = b[i] + off; const int t = 8 * part + i;
                const float qv = sq[i] * __expf(bb); kt_[i] = kk[i] * __expf(fminf(-bb, 80.f));
                QT[t * 136 + c2] = (bf16_t)f2bf(qv); KT[t * 136 + c2] = (bf16_t)f2bf(kt_[i]);
                if (i == 7 && part == 3) DEC[c2] = __expf(bb); }
            *(LAS bf16x8*)(KTt + c2 * 40 + 8 * part) = pack8(kt_);
            u32x4 wv; wv.x = (unsigned)vv[0] | ((unsigned)vv[1] << 16); wv.y = (unsigned)vv[2] | ((unsigned)vv[3] << 16); wv.z = (unsigned)vv[4] | ((unsigned)vv[5] << 16); wv.w = (unsigned)vv[6] | ((unsigned)vv[7] << 16);
            *(LAS u32x4*)(Vt + c2 * 40 + 8 * part) = wv; }
        asm volatile("s_waitcnt vmcnt(0)" ::: "memory");
        HG_BAR();
        f32x4 pt00 = {0.f, 0.f, 0.f, 0.f}, pt01 = pt00, pt11 = pt00;
#pragma unroll
        for (int ks = 0; ks < 4; ++ks) {
            const bf16x8 a0 = *(const LAS bf16x8*)(KT + fr * 136 + 32 * ks + 8 * fq), a1 = *(const LAS bf16x8*)(KT + (16 + fr) * 136 + 32 * ks + 8 * fq);
            const bf16x8 b0 = *(const LAS bf16x8*)(QT + fr * 136 + 32 * ks + 8 * fq), b1 = *(const LAS bf16x8*)(QT + (16 + fr) * 136 + 32 * ks + 8 * fq);
            pt00 = __builtin_amdgcn_mfma_f32_16x16x32_bf16(a0, b0, pt00, 0, 0, 0);
            pt01 = __builtin_amdgcn_mfma_f32_16x16x32_bf16(a0, b1, pt01, 0, 0, 0);
            pt11 = __builtin_amdgcn_mfma_f32_16x16x32_bf16(a1, b1, pt11, 0, 0, 0); }
#pragma unroll
        for (int r = 0; r < 4; ++r) { if (4 * fq + r > fr) { pt00[r] = 0.f; pt11[r] = 0.f; } }
        u32x4 wA0, wA1;
        wA0.x = pk2(pt00[0], pt00[1]); wA0.y = pk2(pt00[2], pt00[3]); wA0.z = hz; wA0.w = hz;
        wA1.x = pk2(pt01[0], pt01[1]); wA1.y = pk2(pt01[2], pt01[3]); wA1.z = pk2(pt11[0], pt11[1]); wA1.w = pk2(pt11[2], pt11[3]);
        const u32x2 vlo = *(const LAS u32x2*)(Vt + (n0 + fr) * 40 + 4 * fq), vhi = *(const LAS u32x2*)(Vt + (n0 + fr) * 40 + 16 + 4 * fq);
        const u32x4 wV = {vlo.x, vlo.y, vhi.x, vhi.y};
        f32x4 o0 = {0.f, 0.f, 0.f, 0.f}, o1 = o0;
        o0 = __builtin_amdgcn_mfma_f32_16x16x32_bf16(__builtin_bit_cast(bf16x8, wA0), __builtin_bit_cast(bf16x8, wV), o0, 0, 0, 0);
        o1 = __builtin_amdgcn_mfma_f32_16x16x32_bf16(__builtin_bit_cast(bf16x8, wA1), __builtin_bit_cast(bf16x8, wV), o1, 0, 0, 0);
#pragma unroll
        for (int aa = 0; aa < 4; ++aa) {
            u32x4 wS; wS.x = pk2(S[2 * aa][0], S[2 * aa][1]); wS.y = pk2(S[2 * aa][2], S[2 * aa][3]); wS.z = pk2(S[2 * aa + 1][0], S[2 * aa + 1][1]); wS.w = pk2(S[2 * aa + 1][2], S[2 * aa + 1][3]);
            const u32x2 q0l = *(const LAS u32x2*)(QT + fr * 136 + 32 * aa + 4 * fq), q0h = *(const LAS u32x2*)(QT + fr * 136 + 32 * aa + 16 + 4 * fq);
            const u32x2 q1l = *(const LAS u32x2*)(QT + (16 + fr) * 136 + 32 * aa + 4 * fq), q1h = *(const LAS u32x2*)(QT + (16 + fr) * 136 + 32 * aa + 16 + 4 * fq);
            const u32x4 wQ0 = {q0l.x, q0l.y, q0h.x, q0h.y}, wQ1 = {q1l.x, q1l.y, q1h.x, q1h.y};
            o0 = __builtin_amdgcn_mfma_f32_16x16x32_bf16(__builtin_bit_cast(bf16x8, wQ0), __builtin_bit_cast(bf16x8, wS), o0, 0, 0, 0);
            o1 = __builtin_amdgcn_mfma_f32_16x16x32_bf16(__builtin_bit_cast(bf16x8, wQ1), __builtin_bit_cast(bf16x8, wS), o1, 0, 0, 0); }
        { const bf16x8 vn = *(const LAS bf16x8*)(Vt + (n0 + fr) * 40 + 8 * fq);
#pragma unroll
            for (int kt = 0; kt < 8; ++kt) { const bf16x8 ka = *(const LAS bf16x8*)(KTt + (16 * kt + fr) * 40 + 8 * fq);
                S[kt] = __builtin_amdgcn_mfma_f32_16x16x32_bf16(ka, vn, S[kt], 0, 0, 0);
                const f32x4 d = *(const LAS f32x4*)(DEC + 16 * kt + 4 * fq); S[kt] = S[kt] * d; } }
#pragma unroll
        for (int r = 0; r < 4; ++r) {
            const int i0 = 4 * fq + r, i1 = 16 + 4 * fq + r;
            const int tok0 = dir ? T - 1 - (32 * cc + i0) : 32 * cc + i0, tok1 = dir ? T - 1 - (32 * cc + i1) : 32 * cc + i1;
            OUT[(size_t)(rowbase + tok0) * 1024 + h * 128 + n0 + fr] = (bf16_t)f2bf(o0[r]);
            OUT[(size_t)(rowbase + tok1) * 1024 + h * 128 + n0 + fr] = (bf16_t)f2bf(o1[r]); }
        cur ^= 1;
    }
#undef HG_DMA
#undef HG_BAR
    { float* so_ = c1 < nch ? sbuf : sout;
      if (so_) {
#pragma unroll
        for (int kt = 0; kt < 8; ++kt)
#pragma unroll
            for (int r = 0; r < 4; ++r) so_[(size_t)(16 * kt + 4 * fq + r) * 128 + n0 + fr] = S[kt][r]; } }
    __syncthreads();
}

__device__ __forceinline__ int fetch_item(unsigned* ctr, LAS int* slot) {
    __syncthreads();
    if (otid() == 0) *slot = (int)atomicAdd(ctr, 1u);
    __syncthreads();
    return __builtin_amdgcn_readfirstlane(*slot);
}

#define XB_TMO      128
#define XB_XCNT(j)  (256  + 64 * (j))
#define XB_XSUB(j)  (1280 + 64 * (j))
#define XB_XGEN(j)  (2304 + 64 * (j))
#define XB_TOP      3328
#define XB_TOPGEN   3392
#define XCD_BAR_WORDS 3456
#define XB_SPIN_CAP (1u << 18)

__device__ __forceinline__ unsigned xb_ld(unsigned* p)              { return __hip_atomic_load(p, __ATOMIC_RELAXED, __HIP_MEMORY_SCOPE_AGENT); }
__device__ __forceinline__ unsigned xb_add(unsigned* p, unsigned v) { return __hip_atomic_fetch_add(p, v, __ATOMIC_RELAXED, __HIP_MEMORY_SCOPE_AGENT); }
__device__ __forceinline__ unsigned xb_xcc_id() { return (unsigned)__builtin_amdgcn_s_getreg((3 << 11) | 20) & 0xFu; }
#define XB_SPIN(cond, bar) do { unsigned _sp = 0; while (cond) { __builtin_amdgcn_s_sleep(1); \
    if ((++_sp & 255u) == 0u) { if (xb_ld(&(bar)[XB_TMO])) break; if (_sp > XB_SPIN_CAP) { atomicAdd(&(bar)[XB_TMO], 1u); break; } } } } while (0)

struct XcdBarrier {
    unsigned* bar; unsigned x;
    volatile LAS unsigned* st;
};

__device__ __forceinline__ XcdBarrier xcd_barrier_post(unsigned* bar, volatile LAS unsigned* st) {
    XcdBarrier b; b.bar = bar; b.x = xb_xcc_id(); b.st = st;
    if (threadIdx.x == 0) (void)xb_add(&bar[XB_XCNT(b.x)], 1u);
    return b;
}
__device__ __forceinline__ void xcd_barrier_complete(unsigned* bar, unsigned x, unsigned& nloc, unsigned& nx) {
    const unsigned G = gridDim.x * gridDim.y * gridDim.z;
    unsigned sum, cnt, mine, sp = 0u;
    for (;;) {
        sum = 0u; cnt = 0u; mine = 0u;
#pragma unroll
        for (unsigned j = 0; j < 16; ++j) { const unsigned c = xb_ld(&bar[XB_XCNT(j)]); sum += c; cnt += (c > 0u) ? 1u : 0u; mine = (j == x) ? c : mine; }
        if (sum == G) break;
        __builtin_amdgcn_s_sleep(1);
        if ((++sp & 255u) == 0u) { if (xb_ld(&bar[XB_TMO])) break; if (sp > XB_SPIN_CAP) { atomicAdd(&bar[XB_TMO], 1u); break; } }
    }
    nloc = mine > 0u ? mine : 1u; nx = cnt > 0u ? cnt : 1u;
}

__device__ __forceinline__ void xcd_barrier(const XcdBarrier& b) {
    asm volatile("s_waitcnt vmcnt(0)" ::: "memory");
    __syncthreads();
    if (threadIdx.x == 0) {
        unsigned* bar = b.bar;
        __builtin_amdgcn_s_waitcnt(0);
        unsigned nloc = b.st[0], nx = b.st[1];
        if (nloc == 0u) { xcd_barrier_complete(bar, b.x, nloc, nx); b.st[0] = nloc; b.st[1] = nx; }
        const unsigned old = xb_add(&bar[XB_XSUB(b.x)], 1u);
        const unsigned gen = old / nloc;
        if (old + 1u == (gen + 1u) * nloc) {
            __builtin_amdgcn_fence(__ATOMIC_RELEASE, "agent");
            asm volatile("s_waitcnt vmcnt(0)" ::: "memory");
            const unsigned og = xb_add(&bar[XB_TOP], 1u);
            const unsigned tg = og / nx;
            if (og + 1u == (tg + 1u) * nx) xb_add(&bar[XB_TOPGEN], 1u);
            else XB_SPIN(xb_ld(&bar[XB_TOPGEN]) == tg, bar);
            __builtin_amdgcn_fence(__ATOMIC_ACQUIRE, "agent");
            xb_add(&bar[XB_XGEN(b.x)], 1u);
            asm volatile("s_waitcnt vmcnt(0)" ::: "memory");
        } else {
            XB_SPIN(xb_ld(&bar[XB_XGEN(b.x)]) == gen, bar);
            __builtin_amdgcn_fence(__ATOMIC_ACQUIRE, "agent");
            asm volatile("s_waitcnt vmcnt(0)" ::: "memory");
        }
    }
    __syncthreads();
}

#ifndef BG_C1
#define BG_C1 4
#define BG_C2 12
#define BG_C3 16
#endif
enum { K_FINAL = 12, K_P0 = 0, K_MODNORM, K_GEMM_IN, K_PREP_AB, K_GEMM_QUP, K_GEMM_KVUP, K_HN_AB, K_MIX_AB, K_FIN_AB, K_GEMM_OUT, K_HN_C, K_ATTN_C };

__global__ void __launch_bounds__(NTHR, 2) mk_fwd(Args a_byval) {
    extern __shared__ __attribute__((aligned(16))) unsigned char lds_raw[];
    LAS unsigned char* lds = (LAS unsigned char*)lds_raw;
    LAS int* slot = (LAS int*)(lds + LDS_PHASE);
    cg::grid_group grid = cg::this_grid();
    const int G = gridDim.x;
    volatile LAS unsigned* bst = (volatile LAS unsigned*)(lds + LDS_PHASE + 64);
    if (threadIdx.x < 2) bst[threadIdx.x] = 0u;
    __syncthreads();
    (void)xcd_barrier_post((unsigned*)(a_byval.ws + WS_CTL) + 8192, bst);

    grid.sync();
#ifndef PROBE_TSEL
#define PROBE_TSEL 0
#endif
    unsigned long long t_acc = 0ull;
    for (int step = 0; step < 30; ++step) {
        unsigned long long t_begin = 0ull; if (PROBE_TSEL) t_begin = __builtin_amdgcn_s_memrealtime();
        asm volatile("" : "+s"(step));
        KArgs a = (KArgs)__builtin_amdgcn_kernarg_segment_ptr();
        asm volatile("" : "+s"(a));
        unsigned char* ws = a->ws;
        unsigned* ctl = (unsigned*)(ws + WS_CTL);
        XcdBarrier xbar; xbar.bar = ctl + 8192; xbar.x = xb_xcc_id(); xbar.st = (volatile LAS unsigned*)(lds + LDS_PHASE + 64);
        int kind, L = 0; bool sync_after = true;
        if (step == 0) kind = K_P0;
        else if (step == 29) { kind = K_FINAL; L = 4; }
        else { const int s = step - 1, pair = s / 14, r = s % 14;
            if (r < 9) { L = 2 * pair; kind = r == 0 ? K_MODNORM : r == 1 ? K_GEMM_IN : r == 2 ? K_PREP_AB : r == 3 ? K_GEMM_QUP : r == 4 ? K_GEMM_KVUP : r == 5 ? K_HN_AB : r == 6 ? K_MIX_AB : r == 7 ? K_FIN_AB : K_GEMM_OUT; }
            else { L = 2 * pair + 1; const int q = r - 9; kind = q == 0 ? K_MODNORM : q == 1 ? K_GEMM_IN : q == 2 ? K_HN_C : q == 3 ? K_ATTN_C : K_GEMM_OUT; } }
        const int j = L >> 1; const bool isC = (L & 1) != 0;
        if (kind == K_GEMM_QUP) sync_after = false;
        if (step == 29) sync_after = false;

#ifndef PROBE_MASK
#define PROBE_MASK 0
#endif
#ifndef PROBE_SEL
#define PROBE_SEL 0
#endif
#ifndef PROBE_REPS
#define PROBE_REPS 2
#endif
        const int nrep = (((PROBE_MASK >> kind) & 1) && (kind != K_GEMM_OUT || L == 0)) ? 1 + PROBE_REPS : 1;
        for (int rep = 0; rep < nrep; ++rep) {
        if (PROBE_MASK == 0x1000) { for (int q = 0; q < 2; ++q) xcd_barrier(xbar); }
        const int bid = obid();
        const bool bgphase = kind == K_PREP_AB || kind == K_GEMM_QUP || kind == K_GEMM_KVUP || kind == K_HN_AB;
        if (rep == 0 && bid < NBG && (kind == K_PREP_AB || kind == K_GEMM_QUP || kind == K_HN_AB || kind == K_MIX_AB)) {
            const int b = bid >> 4, h = (bid >> 1) & 7, dir = bid & 1;
            const int c0 = kind == K_PREP_AB ? 0 : kind == K_GEMM_QUP ? BG_C1 : kind == K_HN_AB ? BG_C2 : BG_C3;
            const int c1 = kind == K_PREP_AB ? BG_C1 : kind == K_GEMM_QUP ? BG_C2 : kind == K_HN_AB ? BG_C3 : 64;
            hgrn_item(lds, (const bf16_t*)(ws + WS_PROJ), MC + b * 2048, 2048, h, dir, (const float*)(ws + WS_LB) + (j * 2 + dir) * 1024 + h * 128,
                      a->in[4 + dir] + (size_t)((b * 2 + j) * 8 + h) * 16384, nullptr, (bf16_t*)(ws + (dir ? WS_OB : WS_OF)), c0, c1, (float*)(ws + WS_SBUF) + (size_t)bid * 16384);
        }
        const int ewg = bgphase ? bid - NBG : bid, enwg = bgphase ? G - NBG : G;
        if (bgphase && bid < NBG) {}
        else
        if (kind == K_P0) phase_p0(a, lds);
        else if (kind == K_MODNORM) phase_modnorm(a, L);
        else if (kind == K_GEMM_IN || kind == K_GEMM_QUP || kind == K_GEMM_KVUP) {
            pg8::Gemm g; pg8::EpiStore E;
            if (kind == K_GEMM_IN) {
                if (!isC) { g = pg8::Gemm{(const bf16_t*)(ws + WS_H), (const bf16_t*)(ws + WS_WINAB) + (size_t)j * 7168 * 2048, MROWS, 7168, 2048}; E = pg8::EpiStore{(bf16_t*)(ws + WS_PROJ), LDP_AB}; }
                else { g = pg8::Gemm{(const bf16_t*)(ws + WS_H), (const bf16_t*)(ws + WS_WINC) + (size_t)j * 5120 * 2048, MROWS, 5120, 2048}; E = pg8::EpiStore{(bf16_t*)(ws + WS_PROJ), LDP_C}; }
            } else if (kind == K_GEMM_QUP) { g = pg8::Gemm{(const bf16_t*)(ws + WS_QN), (const bf16_t*)(ws + WS_WQUP) + (size_t)j * 1536 * 512, MROWS, 1536, 512}; E = pg8::EpiStore{(bf16_t*)(ws + WS_QRAW), 1536}; }
            else { g = pg8::Gemm{(const bf16_t*)(ws + WS_CKV), (const bf16_t*)(ws + WS_WKVUP) + (size_t)j * 2048 * 256, MKROWS, 2048, 256}; E = pg8::EpiStore{(bf16_t*)(ws + WS_KVRAW), 2048}; }
            pg8::StaticOrder S; S.init(g.M, g.N, enwg, ewg);
            pg8::gemm_phase<pg8::EpiStore, pg8::StaticOrder, true, true>(lds, g, S, E);
            if (kind == K_GEMM_IN && L <= 1) { const int left = ((g.M / 256) * (g.N / 256)) % G;
                if (left > 0 && bid >= left) { const int lo = L == 0 ? P0_EARLY : P0_EARLY + 10000, hi = L == 0 ? P0_EARLY + 6000 : P0_EARLY + 12000;
                    p0_transposes(a, lds, lo, hi, (bid - left) * NWAVES + (otid() >> 6), (G - left) * NWAVES); } }
        }
        else if (kind == K_GEMM_OUT) {
            pg8::Gemm g{(const bf16_t*)(ws + WS_H), (const bf16_t*)(ws + (isC ? WS_WOUTC : WS_WOUTAB)) + (size_t)j * 2048 * 2048, MROWS, 2048, 2048};
            pg8::EpiResid E{(bf16_t*)(ws + WS_PROJ), (const float*)(ws + WS_MOD) + (size_t)L * 5 * 6144 + 4096,
                            (float*)(ws + WS_QRAW), ctl + 16384 + step * 256};
            pg8::StaticOrder S; S.init(g.M, g.N, G, obid());
            pg8::gemm_phase<pg8::EpiResid, pg8::StaticOrder, true, true>(lds, g, S, E);
            if (L <= 1) { const int left = ((g.M / 256) * (g.N / 256)) % G;
                if (left > 0 && bid >= left) { const int lo = L == 0 ? P0_EARLY + 6000 : P0_EARLY + 12000, hi = L == 0 ? P0_EARLY + 10000 : P0_EARLY + 16000;
                    p0_transposes(a, lds, lo, hi, (bid - left) * NWAVES + (otid() >> 6), (G - left) * NWAVES); } }
        }
        else if (kind == K_FINAL) phase_final(a);
        else if (kind == K_PREP_AB) phase_prep_ab(a, j, ewg, enwg);
        else if (kind == K_HN_AB) phase_hn_ab(a, j, ewg, enwg);
        else if (kind == K_FIN_AB) phase_fin_ab(a, j);
        else if (kind == K_HN_C) phase_hn_c(a, j);
        else if (kind == K_MIX_AB) {
            unsigned* ctr = ctl + 64 * step + 8 * rep;
            const bf16_t* P = (const bf16_t*)(ws + WS_PROJ); bf16_t* MIX = (bf16_t*)(ws + WS_H);
            const bf16_t* QF = (const bf16_t*)(ws + WS_QRAW); const bf16_t* KF = (const bf16_t*)(ws + WS_KF); const bf16_t* KV = (const bf16_t*)(ws + WS_KVRAW);
            for (;;) {
                const int idx = fetch_item(ctr, slot);
                if (idx >= 640) break;
                if (idx >= 256 && idx < 512) {
                    const int i = idx - 256; const int b = i >> 4, h = (i >> 1) & 7, dir = i & 1;
                    const float* lb = (const float*)(ws + WS_LB) + (j * 2 + dir) * 1024 + h * 128;
                    float* so = a->out + (dir ? O_SB : O_SF) + (size_t)((b * 2 + j) * 8 + h) * 16384;
                    if (PROBE_SEL != 1 || rep == 0) hgrn_item(lds, P, b * 256, 256, h, dir, lb, nullptr, so, (bf16_t*)(ws + (dir ? WS_OB : WS_OF)), 0, 8, (float*)(ws + WS_SBUF));
                } else {
                    att::Item it;
                    const bool lat = idx < 256; int b, h, r0;
                    if (lat) { const int i = idx; b = i >> 6; h = (i >> 3) & 7; const int qb = i & 7; r0 = MC + b * 2048 + qb * 256; it.q0 = qb * 256;
                        it.K0 = KF + (size_t)(MROWS + b * 256) * 1536 + h * 192; it.V0 = KV + (size_t)(MROWS + b * 256) * 2048 + h * 256 + 128; it.n0 = 4;
                        it.K1 = KF + (size_t)(MC + b * 2048) * 1536 + h * 192; it.V1 = KV + (size_t)(MC + b * 2048) * 2048 + h * 256 + 128; it.t_lo = 0; it.t_hi = 32; }
                    else { const int i = idx - 512; b = i >> 3; h = i & 7; r0 = b * 256; it.q0 = 0;
                        it.K0 = KF; it.V0 = KV; it.n0 = 0;
                        it.K1 = KF + (size_t)r0 * 1536 + h * 192; it.V1 = KV + (size_t)r0 * 2048 + h * 256 + 128; it.t_lo = 0; it.t_hi = 4; }
                    it.ldk = 1536; it.ldv = 2048;
                    it.Q = QF + (size_t)r0 * 1536 + h * 192; it.ldq = 1536; it.band = 0; it.m0 = -1e30f; it.l0 = 0.f;
                    it.qg = a->in[18] + j * 192; it.rope = lat ? (const float*)(ws + WS_ROPEA) : nullptr; it.qscale = QSC_A;
                    it.G = P + (size_t)r0 * LDP_AB + COL_AG + h * 128; it.ldg = LDP_AB; it.O = MIX + (size_t)r0 * DM + h * 128; it.ldo = DM;
                    if (PROBE_SEL != 2 || rep == 0) att::attn_item<192>(lds, it);
                }
            }
        }
        else if (kind == K_ATTN_C) {
            unsigned* ctr = ctl + 64 * step + 8 * rep;
            const bf16_t* P = (const bf16_t*)(ws + WS_PROJ); bf16_t* MIX = (bf16_t*)(ws + WS_H);
            const bf16_t* KCC = (const bf16_t*)(ws + WS_KCC);
            for (;;) {
                const int idx = fetch_item(ctr, slot);
                if (idx >= 768) break;
                att::Item it; int b, h, r0;
                if (idx < 512) { b = idx >> 7; h = (idx >> 3) & 15; const int qb = idx & 7; r0 = MC + b * 2048 + qb * 256; const int kvh = h >> 2;
                    it.K0 = KCC + (size_t)((b * 2 + j) * 256) * LDP_C + kvh * 128; it.V0 = KCC + (size_t)((b * 2 + j) * 256) * LDP_C + 512 + kvh * 128; it.n0 = 4;
                    it.K1 = P + (size_t)(MC + b * 2048) * LDP_C + 2048 + kvh * 128; it.V1 = P + (size_t)(MC + b * 2048) * LDP_C + 2560 + kvh * 128;
                    it.t_lo = 4 * qb - 2 < 0 ? 0 : 4 * qb - 2; it.t_hi = 4 * qb + 6 > 32 ? 32 : 4 * qb + 6; it.q0 = qb * 256; it.band = 1; }
                else { const int i = idx - 512; b = i >> 4; h = i & 15; r0 = b * 256; const int kvh = h >> 2;
                    it.K0 = KCC; it.V0 = KCC; it.n0 = 0;
                    it.K1 = P + (size_t)r0 * LDP_C + 2048 + kvh * 128; it.V1 = P + (size_t)r0 * LDP_C + 2560 + kvh * 128; it.t_lo = 0; it.t_hi = 4; it.q0 = 0; it.band = 0; }
                it.ldk = LDP_C; it.ldv = LDP_C;
                it.Q = P + (size_t)r0 * LDP_C + h * 128; it.ldq = LDP_C; it.m0 = a->in[29][j * 16 + h] * LOG2E; it.l0 = 1.f;
                it.qg = a->in[27] + j * 128; it.rope = idx < 512 ? (const float*)(ws + WS_ROPEC) : nullptr; it.qscale = QSC_C;
                it.G = P + (size_t)r0 * LDP_C + 3072 + h * 128; it.ldg = LDP_C; it.O = MIX + (size_t)r0 * DM + h * 128; it.ldo = DM;
                att::attn_item<128>(lds, it);
            }
        }
        if (rep + 1 < nrep) xcd_barrier(xbar);
        }
        if (sync_after) xcd_barrier(xbar);
        if (PROBE_TSEL) { if ((PROBE_TSEL >> kind) & 1) t_acc += __builtin_amdgcn_s_memrealtime() - t_begin; }
    }
    if (PROBE_TSEL) { if (blockIdx.x == 0) { const unsigned long long t_end = __builtin_amdgcn_s_memrealtime() + 2ull * t_acc;
        while (__builtin_amdgcn_s_memrealtime() < t_end) __builtin_amdgcn_s_sleep(32); } }
}

extern "C" void kernel_launch(void* const* d_in, const int* in_sizes, int n_in, void* d_out, int out_size, void* d_ws, size_t ws_size, hipStream_t stream) {
    static int grid = 0;
    if (grid == 0) {
        if (n_in != 31 || ws_size < WS_END) { fprintf(stderr, "kernel_launch: unexpected n_in %d or ws_size %zu (< %zu)\n", n_in, ws_size, (size_t)WS_END); grid = -1; return; }
        int dev = 0, cus = 0, per_cu = 0;
        hipGetDevice(&dev); hipDeviceGetAttribute(&cus, hipDeviceAttributeMultiprocessorCount, dev);
        if (hipFuncSetAttribute((const void*)mk_fwd, hipFuncAttributeMaxDynamicSharedMemorySize, LDS_BYTES) != hipSuccess) { fprintf(stderr, "kernel_launch: hipFuncSetAttribute failed\n"); grid = -1; return; }
        if (hipOccupancyMaxActiveBlocksPerMultiprocessor(&per_cu, (const void*)mk_fwd, NTHR, LDS_BYTES) != hipSuccess || per_cu < 1) per_cu = 1;
        (void)hipGetLastError();
        grid = cus > 0 ? cus : 256;
    }
    if (grid < 0) return;
    hipMemsetAsync((char*)d_ws + WS_CTL, 0, CTL_BYTES, stream);
    Args a{};
    for (int i = 0; i < 31; ++i) a.in[i] = (const float*)d_in[i];
    a.out = (float*)d_out; a.ws = (unsigned char*)d_ws;
    void* args[] = {&a};
    hipError_t e = hipLaunchCooperativeKernel((const void*)mk_fwd, dim3(grid), dim3(NTHR), args, LDS_BYTES, stream);
    if (e != hipSuccess) fprintf(stderr, "cooperative launch failed: %s (grid %d)\n", hipGetErrorString(e), grid);
}
```

```cpp
#include <hip/hip_runtime.h>
#include <hip/hip_cooperative_groups.h>
#include <cstdio>
#include <cstdint>
namespace cg = cooperative_groups;

namespace pg8 {
#define PG8_LAS __attribute__((address_space(3)))
typedef unsigned short bf16_t;
typedef short bf16x8 __attribute__((ext_vector_type(8)));
typedef float f32x4 __attribute__((ext_vector_type(4)));
typedef unsigned u32x4 __attribute__((ext_vector_type(4)));
constexpr int BM = 256, BK = 64, HALF = 128, HTB = HALF * BK * 2  , STAGE_BYTES = 8 * HTB, NXCD = 8, WGM = 8;
__device__ __forceinline__ int pg8_otid() { int t = threadIdx.x; asm volatile("" : "+v"(t)); return t; }

__host__ __device__ __forceinline__ int lds_byte(int r, int c) { const int st = (r >> 4) * 2 + (c >> 5), rr = r & 15, cc = c & 31, ob = rr * 64 + cc * 2; return st * 1024 + (ob ^ (((ob >> 9) & 1) << 5)); }
__host__ __device__ __forceinline__ void stage_rc(int b, int& R, int& C) { const int st = b / 1024, sb = b % 1024, swz = sb ^ (((sb >> 9) & 1) << 5); R = (st >> 1) * 16 + swz / 64; C = (st & 1) * 32 + (swz % 64) / 2; }
__host__ __device__ __forceinline__ int perm32(int rho) { const int n = rho >> 4, i = rho & 15; return 8 * (i >> 2) + 4 * n + (i & 3); }

struct Unit { int pm, pn, kp, np, tix; };
struct Gemm { const bf16_t* A; const bf16_t* Bt; int M, N, K; };

struct StaticOrder {
    int nM, nN, nwg, G, c;
    __host__ __device__ void init(int M, int N, int G_, int c_) { nM = M / BM; nN = N / BM; nwg = nM * nN; G = G_; c = c_; }
    __host__ __device__ bool next(int i, Unit& u) const {
        const long L = (long)i * G + c; if (L >= nwg) return false;
        int wgid = (int)L; { const int q = nwg / NXCD, r = nwg % NXCD, xcd = wgid % NXCD, off = wgid / NXCD; wgid = (xcd < r ? xcd * (q + 1) : r * (q + 1) + (xcd - r) * q) + off; }
        const int nig = WGM * nN, gid = wgid / nig, fm = gid * WGM, gsz = (nM - fm) < WGM ? (nM - fm) : WGM;
        u.pm = fm + ((wgid % nig) % gsz); u.pn = (wgid % nig) / gsz; u.kp = 0; u.np = 1; u.tix = 0; return true;
    }
    __device__ __forceinline__ void a_ready(const Unit&) const {}
    __device__ __forceinline__ void done(const Unit&) const {}
};
struct SplitOrder {
    StaticOrder so; int R, np;
    __host__ __device__ void init(int M, int N, int K, int G_, int c_) { so.init(M, N, G_, c_); R = so.nwg / G_; const int left = so.nwg - R * G_;
        np = 1; if (left > 0 && G_ % left == 0) { const int q = G_ / left; if (q == 2 && (K / q) % 128 == 0) np = q; } }
    __host__ __device__ bool next(int i, Unit& u) const {
        if (np == 1 || i < R) return so.next(i, u);
        if (i > R) return false;
        StaticOrder t = so; t.c = so.c / np; const bool ok = t.next(i, u); u.kp = so.c % np; u.np = np; u.tix = so.c / np; return ok;
    }
    __device__ __forceinline__ void a_ready(const Unit&) const {}
    __device__ __forceinline__ void done(const Unit&) const {}
};

typedef float f32x2c __attribute__((ext_vector_type(2)));
typedef __bf16 bf16x2c __attribute__((ext_vector_type(2)));
__device__ __forceinline__ unsigned cvt_pk_bf16(float lo, float hi) { const f32x2c v = {lo, hi}; const bf16x2c b = __builtin_convertvector(v, bf16x2c); return __builtin_bit_cast(unsigned, b); }

struct EpiStore {
    static constexpr bool PERM = true, AFTER_DRAIN = false;
    bf16_t* O; int ldc;
    __device__ __forceinline__ void operator()(const f32x4 (&acc)[2][2][4][2], const Unit& u, int wr, int wc, int fr, int fq) const {
        const int row0 = u.pm * BM + wr * 64 + fr; const int col0 = u.pn * BM + wc * 32 + 8 * fq;
#pragma unroll
        for (int ai = 0; ai < 2; ++ai)
#pragma unroll
            for (int m = 0; m < 4; ++m) { bf16_t* rowp = O + (size_t)(row0 + ai * HALF + m * 16) * ldc + col0;
#pragma unroll
                for (int bj = 0; bj < 2; ++bj) { const f32x4 v0 = acc[ai][bj][m][0], v1 = acc[ai][bj][m][1];
                    u32x4 w; w.x = cvt_pk_bf16(v0[0], v0[1]); w.y = cvt_pk_bf16(v0[2], v0[3]); w.z = cvt_pk_bf16(v1[0], v1[1]); w.w = cvt_pk_bf16(v1[2], v1[3]);
                    *(u32x4*)(rowp + bj * HALF) = w; } }
    }
};
struct EpiResid {
    static constexpr bool PERM = true, AFTER_DRAIN = false;
    bf16_t* dout; const float* gate_base;
    float* slab; unsigned* cnt;
    __device__ __forceinline__ void operator()(f32x4 (&acc)[2][2][4][2], const Unit& u, int wr, int wc, int fr, int fq) const {
        const int tid = (wr * 4 + wc) * 64 + fq * 16 + fr;
        const f32x4* sl = nullptr;
        if (u.np > 1) {
            float* sb = slab + (size_t)u.tix * (u.np - 1) * 65536;
            if (u.kp < u.np - 1) {
                f32x4* sp = (f32x4*)(sb + (size_t)u.kp * 65536) + tid;
#pragma unroll
                for (int ai = 0; ai < 2; ++ai)
#pragma unroll
                    for (int bj = 0; bj < 2; ++bj)
#pragma unroll
                        for (int m = 0; m < 4; ++m)
#pragma unroll
                            for (int n = 0; n < 2; ++n) sp[(((ai * 2 + bj) * 4 + m) * 2 + n) * 512] = acc[ai][bj][m][n];
                asm volatile("s_waitcnt vmcnt(0)" ::: "memory");
                __syncthreads();
                if (tid == 0) { __builtin_amdgcn_fence(__ATOMIC_RELEASE, "agent"); asm volatile("s_waitcnt vmcnt(0)" ::: "memory");
                    __hip_atomic_fetch_add(cnt + u.tix, 1u, __ATOMIC_RELAXED, __HIP_MEMORY_SCOPE_AGENT); }
                return;
            }
            if (tid == 0) { unsigned sp_ = 0;
                while (__hip_atomic_load(cnt + u.tix, __ATOMIC_RELAXED, __HIP_MEMORY_SCOPE_AGENT) < (unsigned)(u.np - 1)) { __builtin_amdgcn_s_sleep(2); if (++sp_ > (1u << 22)) break; }
                __builtin_amdgcn_fence(__ATOMIC_ACQUIRE, "agent"); asm volatile("s_waitcnt vmcnt(0)" ::: "memory"); }
            __syncthreads();
            sl = (const f32x4*)sb + tid;
        }
        const int pm = u.pm;
        const int ci = pm < 16 ? 4 : ((pm - 16) >> 3);
        const float* gt = gate_base + ci * 6144;
        const int row0 = pm * BM + wr * 64 + fr, col0 = u.pn * BM + wc * 32 + 8 * fq;
#pragma unroll
        for (int bj = 0; bj < 2; ++bj) { const f32x4 gq0 = *(const f32x4*)(gt + col0 + bj * HALF), gq1 = *(const f32x4*)(gt + col0 + bj * HALF + 4);
#pragma unroll
            for (int ai = 0; ai < 2; ++ai) {
#pragma unroll
                for (int m = 0; m < 4; ++m) { f32x4 a0 = acc[ai][bj][m][0], a1 = acc[ai][bj][m][1];
                    if (sl) { a0 += sl[(((ai * 2 + bj) * 4 + m) * 2 + 0) * 512]; a1 += sl[(((ai * 2 + bj) * 4 + m) * 2 + 1) * 512]; }
                    a0 = a0 * gq0; a1 = a1 * gq1;
                    u32x4 w; w.x = cvt_pk_bf16(a0[0], a0[1]); w.y = cvt_pk_bf16(a0[2], a0[3]); w.z = cvt_pk_bf16(a1[0], a1[1]); w.w = cvt_pk_bf16(a1[2], a1[3]);
                    *(u32x4*)(dout + (size_t)(row0 + ai * HALF + m * 16) * 2048 + col0 + bj * HALF) = w; }
                asm volatile("" ::: "memory"); } }
    }
};

template <class Epi, class Sched, bool ALIGN_EPI = false, bool SP2 = false>
__device__ __forceinline__ void gemm_phase(PG8_LAS unsigned char* lds, const Gemm g, const Sched& S, const Epi& E) {
    const int tid = pg8_otid(), wid = __builtin_amdgcn_readfirstlane(tid >> 6), lane = tid & 63, wr = wid >> 2, wc = wid & 3, fr = lane & 15, fq = lane >> 4;
    const int K = g.K, nt = K / BK;
    unsigned voffA[2], voffB[2];
#pragma unroll
    for (int i = 0; i < 2; ++i) { int R, C; stage_rc(tid * 16 + i * 8192, R, C); const int Rb = Epi::PERM ? ((R & ~31) + perm32(R & 31)) : R;
        voffA[i] = (unsigned)(R * K + C) * 2u; voffB[i] = (unsigned)(Rb * K + C) * 2u; }
    const size_t kstep = (size_t)(BK * 2);
    const size_t hstep = (size_t)HALF * K * 2;
    const size_t tstep = 2 * hstep;
    const unsigned ldsw = (unsigned)wid * 1024u;
    const int aoff = lds_byte(wr * 64 + fr, fq * 8), boff = lds_byte(wc * 32 + fr, fq * 8);
#define PG8_SA(b, h) (((b) * 2 + (h)) * HTB)
#define PG8_SB(b, h) ((4 + (b) * 2 + (h)) * HTB)
#define PG8_STAGE(bufoff, gbase, voff) do { _Pragma("unroll") for (int _i = 0; _i < 2; ++_i) \
        __builtin_amdgcn_global_load_lds((const unsigned*)((const char*)(gbase) + (voff)[_i]), (PG8_LAS unsigned*)(lds + (bufoff) + ldsw + _i * 8192), 16, 0, 0); } while (0)
#define PG8_LDA(dst, b, h) do { _Pragma("unroll") for (int m = 0; m < 4; ++m) _Pragma("unroll") for (int k = 0; k < 2; ++k) dst[m][k] = *(const PG8_LAS bf16x8*)(lds + PG8_SA(b, h) + aoff + m * 2048 + k * 1024); } while (0)
#define PG8_LDB(dst, b, h) do { _Pragma("unroll") for (int n = 0; n < 2; ++n) _Pragma("unroll") for (int k = 0; k < 2; ++k) dst[n][k] = *(const PG8_LAS bf16x8*)(lds + PG8_SB(b, h) + boff + n * 2048 + k * 1024); } while (0)
#define PG8_MMA(ai, bj, At, Bt) do { __builtin_amdgcn_s_setprio(1); _Pragma("unroll") for (int m = 0; m < 4; ++m) _Pragma("unroll") for (int n = 0; n < 2; ++n) _Pragma("unroll") for (int k = 0; k < 2; ++k) \
        acc[ai][bj][m][n] = __builtin_amdgcn_mfma_f32_16x16x32_bf16(Bt[n][k], At[m][k], acc[ai][bj][m][n], 0, 0, 0); __builtin_amdgcn_s_setprio(0); } while (0)
#define PG8_WAIT_V(n) asm volatile("s_waitcnt vmcnt(" #n ")" ::: "memory")
#define PG8_WAIT_L(n) asm volatile("s_waitcnt lgkmcnt(" #n ")" ::: "memory")
#define PG8_BAR __builtin_amdgcn_s_barrier()
#define PG8_SCHED __builtin_amdgcn_sched_barrier(0)
    Unit cur, nxt; int ui = 0;
    if (!S.next(0, cur)) return;
    f32x4 acc[2][2][4][2];
#pragma unroll
    for (int a = 0; a < 2; ++a)
#pragma unroll
        for (int b = 0; b < 2; ++b)
#pragma unroll
            for (int m = 0; m < 4; ++m)
#pragma unroll
                for (int n = 0; n < 2; ++n) acc[a][b][m][n] = (f32x4){0.f, 0.f, 0.f, 0.f};
    bf16x8 At[4][2], B0[2][2], B1[2][2];
    const char* cA = (const char*)g.A + (size_t)cur.pm * tstep + (size_t)cur.kp * (K / cur.np) * 2; const char* cB = (const char*)g.Bt + (size_t)cur.pn * tstep + (size_t)cur.kp * (K / cur.np) * 2;
    S.a_ready(cur);
    if constexpr (SP2) {
        PG8_STAGE(PG8_SB(0, 0), cB, voffB); PG8_STAGE(PG8_SB(0, 1), cB + hstep, voffB); PG8_STAGE(PG8_SA(0, 0), cA, voffA); PG8_STAGE(PG8_SA(0, 1), cA + hstep, voffA);
        if (wr == 1) PG8_BAR;
        PG8_WAIT_V(2); PG8_BAR;
        PG8_STAGE(PG8_SB(1, 0), cB + kstep, voffB); PG8_STAGE(PG8_SA(1, 0), cA + kstep, voffA); PG8_STAGE(PG8_SB(1, 1), cB + hstep + kstep, voffB);
        PG8_WAIT_V(6); PG8_BAR;
    } else {
        PG8_STAGE(PG8_SB(0, 0), cB, voffB); PG8_STAGE(PG8_SA(0, 0), cA, voffA); PG8_STAGE(PG8_SB(0, 1), cB + hstep, voffB); PG8_STAGE(PG8_SA(0, 1), cA + hstep, voffA);
        if (wr == 1) PG8_BAR;
        PG8_WAIT_V(4); PG8_BAR;
        PG8_STAGE(PG8_SB(1, 0), cB + kstep, voffB); PG8_STAGE(PG8_SA(1, 0), cA + kstep, voffA); PG8_STAGE(PG8_SB(1, 1), cB + hstep + kstep, voffB);
        PG8_WAIT_V(6); PG8_BAR;
    }
    for (;;) {
        const bool has_next = S.next(ui + 1, nxt);
        const size_t nko = has_next ? (size_t)nxt.kp * (K / nxt.np) * 2 : 0; const char* nA = has_next ? (const char*)g.A + (size_t)nxt.pm * tstep + nko : cA; const char* nB = has_next ? (const char*)g.Bt + (size_t)nxt.pn * tstep + nko : cB;
        const int ntc = nt / cur.np;
        for (int t = 0; t < ntc; t += 2) {
            const bool last = (t == ntc - 2);
            const char* a1 = cA + (size_t)(t + 1) * kstep;
            const char* a2 = last ? nA : cA + (size_t)(t + 2) * kstep; const char* b2 = last ? nB : cB + (size_t)(t + 2) * kstep;
            const char* a3 = a2 + kstep; const char* b3 = b2 + kstep;
            if (last && has_next) S.a_ready(nxt);
            if constexpr (SP2) {
            PG8_LDB(B0, 0, 0); PG8_LDB(B1, 0, 1); PG8_SCHED; PG8_LDA(At, 0, 0); PG8_STAGE(PG8_SA(1, 1), a1 + hstep, voffA);
            PG8_WAIT_V(8); PG8_WAIT_L(0); PG8_BAR; PG8_MMA(0, 0, At, B0); PG8_MMA(0, 1, At, B1); PG8_BAR; PG8_SCHED;
            PG8_LDA(At, 0, 1); PG8_STAGE(PG8_SB(0, 0), b2, voffB); PG8_STAGE(PG8_SB(0, 1), b2 + hstep, voffB); PG8_STAGE(PG8_SA(0, 0), a2, voffA);
            PG8_WAIT_V(8); PG8_WAIT_L(0); PG8_BAR; PG8_MMA(1, 0, At, B0); PG8_MMA(1, 1, At, B1); PG8_BAR; PG8_SCHED;
            PG8_LDB(B0, 1, 0); PG8_LDB(B1, 1, 1); PG8_SCHED; PG8_LDA(At, 1, 0); PG8_STAGE(PG8_SA(0, 1), a2 + hstep, voffA);
            PG8_WAIT_V(8); PG8_WAIT_L(0); PG8_BAR; PG8_MMA(0, 0, At, B0); PG8_MMA(0, 1, At, B1); PG8_BAR; PG8_SCHED;
            PG8_LDA(At, 1, 1); PG8_STAGE(PG8_SB(1, 0), b3, voffB); PG8_STAGE(PG8_SB(1, 1), b3 + hstep, voffB); PG8_STAGE(PG8_SA(1, 0), a3, voffA);
            PG8_WAIT_V(8); PG8_WAIT_L(0); PG8_BAR; PG8_MMA(1, 0, At, B0); PG8_MMA(1, 1, At, B1); PG8_BAR; PG8_SCHED;
            } else {
            PG8_LDB(B0, 0, 0); PG8_SCHED; PG8_LDA(At, 0, 0); PG8_STAGE(PG8_SA(1, 1), a1 + hstep, voffA);
            PG8_WAIT_L(8); PG8_BAR; PG8_WAIT_L(0); PG8_MMA(0, 0, At, B0); PG8_BAR; PG8_SCHED;
            PG8_LDB(B1, 0, 1); PG8_STAGE(PG8_SB(0, 0), b2, voffB);
            PG8_BAR; PG8_WAIT_L(0); PG8_MMA(0, 1, At, B1); PG8_BAR;
            PG8_LDA(At, 0, 1); PG8_STAGE(PG8_SA(0, 0), a2, voffA);
            PG8_BAR; PG8_WAIT_L(0); PG8_MMA(1, 0, At, B0); PG8_BAR; PG8_SCHED;
            PG8_STAGE(PG8_SB(0, 1), b2 + hstep, voffB);
            PG8_WAIT_V(6); PG8_BAR; PG8_MMA(1, 1, At, B1); PG8_BAR;
            PG8_LDB(B0, 1, 0); PG8_SCHED; PG8_LDA(At, 1, 0); PG8_STAGE(PG8_SA(0, 1), a2 + hstep, voffA);
            PG8_WAIT_L(8); PG8_BAR; PG8_WAIT_L(0); PG8_MMA(0, 0, At, B0); PG8_BAR; PG8_SCHED;
            PG8_LDB(B1, 1, 1); PG8_STAGE(PG8_SB(1, 0), b3, voffB);
            PG8_BAR; PG8_WAIT_L(0); PG8_MMA(0, 1, At, B1); PG8_BAR;
            PG8_LDA(At, 1, 1); PG8_STAGE(PG8_SA(1, 0), a3, voffA);
            PG8_BAR; PG8_WAIT_L(0); PG8_MMA(1, 0, At, B0); PG8_BAR; PG8_SCHED;
            PG8_STAGE(PG8_SB(1, 1), b3 + hstep, voffB);
            PG8_WAIT_V(6); PG8_BAR; PG8_MMA(1, 1, At, B1); PG8_BAR;
            }
        }
        if constexpr (ALIGN_EPI) { if (wr == 0) PG8_BAR; }
        if constexpr (!Epi::AFTER_DRAIN) { E(acc, cur, wr, wc, fr, fq); S.done(cur); }
        if (!has_next) break;
#pragma unroll
        for (int a = 0; a < 2; ++a)
#pragma unroll
            for (int b = 0; b < 2; ++b)
#pragma unroll
                for (int m = 0; m < 4; ++m)
#pragma unroll
                    for (int n = 0; n < 2; ++n) acc[a][b][m][n] = (f32x4){0.f, 0.f, 0.f, 0.f};
        cur = nxt; cA = nA; cB = nB; ++ui;
        if constexpr (ALIGN_EPI) { if (wr == 1) PG8_BAR; }
    }
    PG8_WAIT_V(0);
    if constexpr (!ALIGN_EPI) { if (wr == 0) PG8_BAR; }
    PG8_BAR;
    if constexpr (Epi::AFTER_DRAIN) { E.fused(acc, cur, wr, wc, fr, fq, lds, wid, lane); S.done(cur); }
#undef PG8_SA
#undef PG8_SB
#undef PG8_STAGE
#undef PG8_LDA
#undef PG8_LDB
#undef PG8_MMA
#undef PG8_WAIT_V
#undef PG8_WAIT_L
#undef PG8_BAR
#undef PG8_SCHED
}
}

#define LAS __attribute__((address_space(3)))
typedef unsigned short bf16_t;
typedef short bf16x8 __attribute__((ext_vector_type(8)));
typedef short s16x4 __attribute__((ext_vector_type(4)));
typedef float f32x4 __attribute__((ext_vector_type(4)));
typedef float f32x16 __attribute__((ext_vector_type(16)));
typedef unsigned u32x4 __attribute__((ext_vector_type(4)));
typedef unsigned u32x2 __attribute__((ext_vector_type(2)));


__device__ __forceinline__ int otid() { int t = threadIdx.x; asm volatile("" : "+v"(t)); return t; }
__device__ __forceinline__ unsigned ozero() { unsigned z = 0u; asm volatile("" : "+v"(z)); return z; }
__device__ __forceinline__ int obid() { int b = blockIdx.x; asm volatile("" : "+s"(b)); return b; }
constexpr int NWAVES = 8, NTHR = 512;
constexpr int DM = 2048, MC = 4096, ML = 8192, MROWS = 12288, MKROWS = 13312;
constexpr int LDP_AB = 7168, LDP_C = 5120;
constexpr int COL_QL = 0, COL_KVL = 512, COL_AG = 768, COL_BQ = 1792, COL_FF = 2816, COL_FB = 3840, COL_BI = 4864, COL_BG = 5888, COL_KPE = 6912;
constexpr float EPSN = 1e-6f;
constexpr float LOG2E = 1.4426950408889634f;
constexpr float QSC_A = 0.07216878364870322f * LOG2E;
constexpr float QSC_C = 0.08838834764831845f * LOG2E;

constexpr size_t O_YP = 0, O_YS = 8388608, O_CKV = 25165824, O_KPE = 27262976, O_SF = 27787264, O_SB = 31981568, O_KC = 36175872, O_VC = 40370176;

constexpr size_t MiB = 1u << 20;
constexpr size_t WS_CTL = 0, CTL_BYTES = 131072;
constexpr size_t WS_MOD = 1 * MiB, WS_LB = WS_MOD + 512 * 1024, WS_ROPEA = WS_LB + 64 * 1024, WS_ROPEC = WS_ROPEA + 512 * 1024;
constexpr size_t WS_KCC = 532 * MiB;
constexpr size_t WS_WINAB = 8 * MiB, WS_WQUP = 64 * MiB, WS_WKVUP = 67 * MiB, WS_WOUTAB = 69 * MiB, WS_WINC = 85 * MiB, WS_WOUTC = 125 * MiB;
constexpr size_t WS_H = 141 * MiB, WS_PROJ = 189 * MiB, WS_QRAW = 357 * MiB, WS_KVRAW = 393 * MiB, WS_KF = 445 * MiB, WS_OF = 484 * MiB, WS_OB = 508 * MiB;
constexpr size_t WS_QN = WS_H, WS_CKV = WS_H + 12 * MiB, WS_END = 552 * MiB;
constexpr size_t WS_SBUF = 4 * MiB;
constexpr int NBG = 64;

constexpr int LDS_PHASE = 131072, LDS_BYTES = LDS_PHASE + 1024;

__device__ __forceinline__ float bf2f(unsigned short b) { return __uint_as_float((unsigned)b << 16); }
typedef float f32x2_t __attribute__((ext_vector_type(2)));
typedef __bf16 bf16x2_t __attribute__((ext_vector_type(2)));
__device__ __forceinline__ unsigned pk2(float lo, float hi) { const f32x2_t v = {lo, hi}; const bf16x2_t b = __builtin_convertvector(v, bf16x2_t); return __builtin_bit_cast(unsigned, b); }
__device__ __forceinline__ unsigned f2bf(float f) { return pk2(f, 0.f) & 0xffffu; }
__device__ __forceinline__ float silu_f(float x) { return x * __builtin_amdgcn_rcpf(1.f + __expf(-x)); }
__device__ __forceinline__ float wave_sum(float v) {
#pragma unroll
    for (int o = 1; o < 64; o <<= 1) v += __shfl_xor(v, o);
    return v;
}
__device__ __forceinline__ float sum16(float v) {
    v += __shfl_xor(v, 1); v += __shfl_xor(v, 2); v += __shfl_xor(v, 4); v += __shfl_xor(v, 8); return v;
}
__device__ __forceinline__ bf16x8 pack8(const float* v) {
    u32x4 w; w.x = pk2(v[0], v[1]); w.y = pk2(v[2], v[3]); w.z = pk2(v[4], v[5]); w.w = pk2(v[6], v[7]); return __builtin_bit_cast(bf16x8, w);
}

struct Args { const float* in[31]; float* out; unsigned char* ws; };
typedef const Args __attribute__((address_space(4)))* KArgs;

struct P0Item { const float* W; bf16_t* WT; int K, N, k0, n0, d0; };
__device__ __forceinline__ void p0_load(const P0Item& q, float (&v)[32], int lane) {
#pragma unroll
    for (int i = 0; i < 32; ++i) { const int kk = 2 * i + (lane >> 5); v[i] = q.W[(size_t)(q.k0 + kk) * q.N + q.n0 + (lane & 31)]; }
}
__device__ __forceinline__ void p0_emit(const P0Item& q, const float (&v)[32], LAS float* scr, int lane) {
#pragma unroll
    for (int i = 0; i < 32; ++i) { const int kk = 2 * i + (lane >> 5); scr[kk * 33 + (lane & 31)] = v[i]; }
    asm volatile("s_waitcnt lgkmcnt(0)" ::: "memory");
    const int c = lane & 7;
#pragma unroll
    for (int j = 0; j < 4; ++j) { const int n = (lane >> 3) + 8 * j; const LAS float* s = scr + (8 * c) * 33 + n;
        u32x4 o; o.x = pk2(s[0 * 33], s[1 * 33]); o.y = pk2(s[2 * 33], s[3 * 33]); o.z = pk2(s[4 * 33], s[5 * 33]); o.w = pk2(s[6 * 33], s[7 * 33]);
        *(u32x4*)(q.WT + (size_t)(q.d0 + n) * q.K + q.k0 + 8 * c) = o; }
    asm volatile("s_waitcnt lgkmcnt(0)" ::: "memory");
}
__device__ __forceinline__ P0Item p0_decode(KArgs a, int it) {
    constexpr int I_INAB = 32 * 218, I_QUP = 8 * 48, I_KVUP = 4 * 64, I_OUT = 32 * 64, I_INC = 32 * 160;
    constexpr int PER_J = I_INAB + I_QUP + I_KVUP + I_OUT + I_INC + I_OUT;
    unsigned char* ws = a->ws; P0Item q;
    const int j = it / PER_J; int r = it % PER_J;
    if (r < I_INAB) { const int kb = r / 218, nb = r % 218, n0 = nb * 32;
        q.W = a->in[13] + (size_t)j * 2048 * 6976; q.WT = (bf16_t*)(ws + WS_WINAB) + (size_t)j * 7168 * 2048; q.K = 2048; q.N = 6976; q.k0 = kb * 64; q.n0 = n0; q.d0 = n0 < 768 ? n0 : (n0 < 832 ? n0 + 6144 : n0 - 64); return q; }
    r -= I_INAB;
    if (r < I_QUP) { const int kb = r / 48, nb = r % 48;
        q.W = a->in[16] + (size_t)j * 512 * 1536; q.WT = (bf16_t*)(ws + WS_WQUP) + (size_t)j * 1536 * 512; q.K = 512; q.N = 1536; q.k0 = kb * 64; q.n0 = nb * 32; q.d0 = nb * 32; return q; }
    r -= I_QUP;
    if (r < I_KVUP) { const int kb = r / 64, nb = r % 64;
        q.W = a->in[17] + (size_t)j * 256 * 2048; q.WT = (bf16_t*)(ws + WS_WKVUP) + (size_t)j * 2048 * 256; q.K = 256; q.N = 2048; q.k0 = kb * 64; q.n0 = nb * 32; q.d0 = nb * 32; return q; }
    r -= I_KVUP;
    if (r < I_OUT) { const int kb = r / 64, nb = r % 64;
        q.W = a->in[22] + (size_t)j * 2048 * 2048; q.WT = (bf16_t*)(ws + WS_WOUTAB) + (size_t)j * 2048 * 2048; q.K = 2048; q.N = 2048; q.k0 = kb * 64; q.n0 = nb * 32; q.d0 = nb * 32; return q; }
    r -= I_OUT;
    if (r < I_INC) { const int kb = r / 160, nb = r % 160;
        q.W = a->in[26] + (size_t)j * 2048 * 5120; q.WT = (bf16_t*)(ws + WS_WINC) + (size_t)j * 5120 * 2048; q.K = 2048; q.N = 5120; q.k0 = kb * 64; q.n0 = nb * 32; q.d0 = nb * 32; return q; }
    r -= I_INC;
    { const int kb = r / 64, nb = r % 64;
        q.W = a->in[30] + (size_t)j * 2048 * 2048; q.WT = (bf16_t*)(ws + WS_WOUTC) + (size_t)j * 2048 * 2048; q.K = 2048; q.N = 2048; q.k0 = kb * 64; q.n0 = nb * 32; q.d0 = nb * 32; return q; }
}

__device__ __forceinline__ void p0_transposes(KArgs a, LAS unsigned char* lds, int lo, int hi, int w, int NW) {
    const int lane = otid() & 63, wave = (otid() >> 6);
    LAS float* scr = (LAS float*)(lds + wave * 8448);
    for (int it = lo + w; it < hi; it += 2 * NW) {
        const bool two = it + NW < hi;
        const P0Item qa = p0_decode(a, it); const P0Item qb = p0_decode(a, two ? it + NW : it);
        float va[32], vb[32];
        p0_load(qa, va, lane); if (two) p0_load(qb, vb, lane);
        p0_emit(qa, va, scr, lane); if (two) p0_emit(qb, vb, scr, lane);
    }
}
constexpr int P0_EARLY = 32 * 218 + 8 * 48 + 4 * 64 + 32 * 64;
constexpr int P0_TOTAL = 2 * (32 * 218 + 8 * 48 + 4 * 64 + 32 * 64 + 32 * 160 + 32 * 64);
__device__ __forceinline__ void phase_p0(KArgs a, LAS unsigned char* lds) {
    const int tid = otid(), lane = tid & 63, wave = tid >> 6;
    const int G = gridDim.x, bid = obid();
    const int gw = bid * NWAVES + wave, NGW = G * NWAVES;
    unsigned char* ws = a->ws;
    p0_transposes(a, lds, 0, P0_EARLY, gw, NGW);
    p0_transposes(a, lds, P0_EARLY + 16000, P0_TOTAL, gw, NGW);
    const int gt = bid * NTHR + tid, NGT = G * NTHR;
    const unsigned zz = ozero();
    for (int i = gt; i < 2 * 192 * 256; i += NGT) { const int j = i / (192 * 256), r = i % (192 * 256);
        *(u32x4*)((bf16_t*)(ws + WS_WINAB) + (size_t)j * 7168 * 2048 + (size_t)6976 * 2048 + (size_t)r * 8) = (u32x4){zz, zz, zz, zz}; }
    for (int i = gt; i < 2 * 131072; i += NGT) { const int which = i / 131072, e = (i % 131072) * 8;
        const float* src = a->in[6 + which] + e; const f32x4 x0 = *(const f32x4*)src, x1 = *(const f32x4*)(src + 4);
        u32x4 w; w.x = pk2(x0[0], x0[1]); w.y = pk2(x0[2], x0[3]); w.z = pk2(x1[0], x1[1]); w.w = pk2(x1[2], x1[3]);
        *(u32x4*)((bf16_t*)(ws + WS_KCC) + (size_t)(e >> 9) * LDP_C + (which ? 512 : 0) + (e & 511)) = w; }
    for (int i = gt; i < 2 * 2048; i += NGT) { const int j = i / 2048, r = i % 2048; const float l0 = a->in[20][r], l1 = a->in[20][2048 + r];
        ((float*)(ws + WS_LB))[i] = j == 0 ? 0.f : 1.f / (1.f + __expf(l0 - l1)); }
    for (int i = gt; i < 2048 * 32; i += NGT) { const int t = i >> 5, f = i & 31; const float pos = f < 16 ? (float)(t >> 6) : (float)(t & 63);
        const float inv = exp2f(-(float)(f & 15) * (13.287712379549449f / 16.f)); const float ang = pos * inv;
        ((float*)(ws + WS_ROPEA))[2 * i] = __cosf(ang); ((float*)(ws + WS_ROPEA))[2 * i + 1] = __sinf(ang); }
    for (int i = gt; i < 2048 * 64; i += NGT) { const int t = i >> 6, f = i & 63; const float pos = f < 32 ? (float)(t >> 6) : (float)(t & 63);
        const float inv = exp2f(-(float)(f & 31) * (13.287712379549449f / 32.f)); const float ang = pos * inv;
        ((float*)(ws + WS_ROPEC))[2 * i] = __cosf(ang); ((float*)(ws + WS_ROPEC))[2 * i + 1] = __sinf(ang); }
    __syncthreads();
    {
        LAS float* SC = (LAS float*)lds;
        LAS float* RED = (LAS float*)(lds + 40960);
        for (int i = tid; i < 5 * 2048; i += NTHR) { const int b = i >> 11, k = i & 2047; const float x = b < 4 ? a->in[8][b * 2048 + k] : a->in[9][k]; SC[i] = silu_f(x); }
        __syncthreads();
        const int cq = tid & 7, ks = tid >> 3;
        for (int u = bid; u < 768; u += G) {
            const int L = u / 192, col0 = (u % 192) * 32;
            const float* W = ((L & 1) ? a->in[23] : a->in[10]) + (size_t)(L >> 1) * 2048 * 6144;
            const float* bias = ((L & 1) ? a->in[24] : a->in[11]) + (size_t)(L >> 1) * 6144;
            f32x4 acc[5];
#pragma unroll
            for (int b = 0; b < 5; ++b) acc[b] = (f32x4){0.f, 0.f, 0.f, 0.f};
#pragma unroll 16
            for (int kk = 0; kk < 32; ++kk) { const int k = 32 * ks + kk; const f32x4 w = *(const f32x4*)(W + (size_t)k * 6144 + col0 + 4 * cq);
#pragma unroll
                for (int b = 0; b < 5; ++b) acc[b] += SC[b * 2048 + k] * w; }
#pragma unroll
            for (int b = 0; b < 5; ++b) *(LAS f32x4*)(RED + (ks * 5 + b) * 32 + 4 * cq) = acc[b];
            __syncthreads();
            if (tid < 160) { const int b = tid >> 5, c = tid & 31; float s = 0.f;
                for (int q = 0; q < 64; ++q) s += RED[(q * 5 + b) * 32 + c];
                ((float*)(ws + WS_MOD))[(L * 5 + b) * 6144 + col0 + c] = s + bias[col0 + c]; }
            __syncthreads();
        }
    }
}

__device__ __forceinline__ void phase_modnorm(KArgs a, int L) {
    const int tid = otid(), lane = tid & 63, wave = tid >> 6;
    const int gw = obid() * NWAVES + wave, NGW = gridDim.x * NWAVES;
    const float* g = ((L & 1) ? a->in[25] : a->in[12]) + (L >> 1) * 2048;
    bf16_t* H = (bf16_t*)(a->ws + WS_H);
    for (int r0 = gw * 2; r0 < MROWS; r0 += NGW * 2) {
        f32x4 v[2][8]; float ss[2] = {0.f, 0.f};
#pragma unroll
        for (int u = 0; u < 2; ++u) { const int r = r0 + u;
            const float* x = L <= 1 ? (r < MC ? a->in[0] + (size_t)r * DM : a->in[1] + (size_t)(r - MC) * DM) : a->out + (size_t)r * DM;
#pragma unroll
            for (int j = 0; j < 8; ++j) v[u][j] = *(const f32x4*)(x + 256 * j + 4 * lane);
            if (L > 0) { const bf16_t* dp = (const bf16_t*)(a->ws + WS_PROJ) + (size_t)r * DM;
#pragma unroll
                for (int j = 0; j < 8; ++j) { const u32x2 dv = *(const u32x2*)(dp + 256 * j + 4 * lane);
                    v[u][j][0] += __uint_as_float(dv.x << 16); v[u][j][1] += __uint_as_float(dv.x & 0xffff0000u); v[u][j][2] += __uint_as_float(dv.y << 16); v[u][j][3] += __uint_as_float(dv.y & 0xffff0000u);
                    *(f32x4*)(a->out + (size_t)r * DM + 256 * j + 4 * lane) = v[u][j]; } } }
#pragma unroll
        for (int u = 0; u < 2; ++u) {
#pragma unroll
            for (int j = 0; j < 8; ++j) ss[u] += (v[u][j][0] * v[u][j][0] + v[u][j][1] * v[u][j][1]) + (v[u][j][2] * v[u][j][2] + v[u][j][3] * v[u][j][3]); }
#pragma unroll
        for (int u = 0; u < 2; ++u) { const int r = r0 + u;
            const int ci = r < MC ? 4 : ((r - MC) >> 11);
            const float* md = (const float*)(a->ws + WS_MOD) + (L * 5 + ci) * 6144;
            const float rstd = rsqrtf(wave_sum(ss[u]) * (1.f / 2048.f) + EPSN);
#pragma unroll
            for (int j = 0; j < 8; ++j) { const int c = 256 * j + 4 * lane;
                const f32x4 gg = *(const f32x4*)(g + c), sh = *(const f32x4*)(md + c), sc = *(const f32x4*)(md + 2048 + c);
                const f32x4 y = (v[u][j] * rstd * gg) * (sc + 1.f) + sh;
                u32x2 w; w.x = pk2(y[0], y[1]); w.y = pk2(y[2], y[3]);
                *(u32x2*)(H + (size_t)r * DM + c) = w; } }
    }
}

__device__ __forceinline__ void phase_final(KArgs a) {
    const int tid = otid();
    const int gt = obid() * NTHR + tid, NGT = gridDim.x * NTHR;
    const bf16_t* D = (const bf16_t*)(a->ws + WS_PROJ); float* out = a->out;
    for (int i = gt; i < MROWS * DM / 8; i += NGT) { const size_t e = (size_t)i * 8;
        const bf16x8 dv = *(const bf16x8*)(D + e); f32x4 x0 = *(const f32x4*)(out + e), x1 = *(const f32x4*)(out + e + 4);
        x0[0] += bf2f((unsigned short)dv[0]); x0[1] += bf2f((unsigned short)dv[1]); x0[2] += bf2f((unsigned short)dv[2]); x0[3] += bf2f((unsigned short)dv[3]);
        x1[0] += bf2f((unsigned short)dv[4]); x1[1] += bf2f((unsigned short)dv[5]); x1[2] += bf2f((unsigned short)dv[6]); x1[3] += bf2f((unsigned short)dv[7]);
        *(f32x4*)(out + e) = x0; *(f32x4*)(out + e + 4) = x1; }
}

__device__ __forceinline__ void phase_prep_ab(KArgs a, int j, int wg, int nwg) {
    const int tid = otid(), lane = tid & 63, wave = tid >> 6;
    const int gw = wg * NWAVES + wave, NGW = nwg * NWAVES;
    const bf16_t* P = (const bf16_t*)(a->ws + WS_PROJ);
    bf16_t* QN = (bf16_t*)(a->ws + WS_QN); bf16_t* CKV = (bf16_t*)(a->ws + WS_CKV);
    const float* gq = a->in[14] + j * 512; const float* gkv = a->in[15] + j * 256;
    for (int r = gw; r < MKROWS; r += NGW) {
        if (r < MROWS) {
            const bf16_t* p = P + (size_t)r * LDP_AB;
            const bf16x8 q = *(const bf16x8*)(p + COL_QL + 8 * lane);
            float qv[8]; float ss = 0.f;
#pragma unroll
            for (int e = 0; e < 8; ++e) { qv[e] = bf2f((unsigned short)q[e]); ss += qv[e] * qv[e]; }
            const float rq = rsqrtf(wave_sum(ss) * (1.f / 512.f) + EPSN);
#pragma unroll
            for (int e = 0; e < 8; ++e) qv[e] = qv[e] * rq * gq[8 * lane + e];
            *(bf16x8*)(QN + (size_t)r * 512 + 8 * lane) = pack8(qv);
            const s16x4 kv = *(const s16x4*)(p + COL_KVL + 4 * lane);
            float kf[4]; float s2 = 0.f;
#pragma unroll
            for (int e = 0; e < 4; ++e) { kf[e] = bf2f((unsigned short)kv[e]); s2 += kf[e] * kf[e]; }
            const float rk = rsqrtf(wave_sum(s2) * (1.f / 256.f) + EPSN);
#pragma unroll
            for (int e = 0; e < 4; ++e) kf[e] = kf[e] * rk * gkv[4 * lane + e];
            u32x2 w; w.x = pk2(kf[0], kf[1]); w.y = pk2(kf[2], kf[3]);
            *(u32x2*)(CKV + (size_t)r * 256 + 4 * lane) = w;
            if (r < MC) { const int b = r >> 8, t = r & 255; const size_t rowo = (size_t)((b * 2 + j) * 256 + t);
                *(f32x4*)(a->out + O_CKV + rowo * 256 + 4 * lane) = (f32x4){kf[0], kf[1], kf[2], kf[3]};
                a->out[O_KPE + rowo * 64 + lane] = bf2f(p[COL_KPE + lane]); }
        } else {
            const int rr = r - MROWS, b = rr >> 8, t = rr & 255;
            const f32x4 x = *(const f32x4*)(a->in[2] + (size_t)((b * 2 + j) * 256 + t) * 256 + 4 * lane);
            u32x2 w; w.x = pk2(x[0], x[1]); w.y = pk2(x[2], x[3]);
            *(u32x2*)(CKV + (size_t)r * 256 + 4 * lane) = w;
        }
    }
}

__device__ __forceinline__ void phase_hn_ab(KArgs a, int j, int wg, int nwg) {
    const int tid = otid(), lane = tid & 63, wave = tid >> 6, sub = lane & 15, hq = lane >> 4;
    const int gw = wg * NWAVES + wave, NGW = nwg * NWAVES;
    bf16_t* Q = (bf16_t*)(a->ws + WS_QRAW); const bf16_t* KV = (const bf16_t*)(a->ws + WS_KVRAW); bf16_t* KF = (bf16_t*)(a->ws + WS_KF);
    const bf16_t* P = (const bf16_t*)(a->ws + WS_PROJ);
    const float* RA = (const float*)(a->ws + WS_ROPEA);
    const float* gq = a->in[18] + j * 192; const float* gk = a->in[19] + j * 192;
    const float* ckpe = a->in[3];
    constexpr int U = 4;
    const int NQ = 0, NIT = MKROWS * 2;
    for (int base = gw * U; base < NIT; base += NGW * U) {
        bf16x8 vn[U]; float x1[U][2], x2[U][2]; f32x4 cs[U];
#pragma unroll
        for (int u = 0; u < U; ++u) { const int it = base + u; if (it < NIT) {
            const bool isq = it < NQ; const int w = isq ? it : it - NQ; const int r = w >> 1, h = (w & 1) * 4 + hq;
            if (isq) { const bf16_t* p = Q + (size_t)r * 1536 + h * 192;
                vn[u] = *(const bf16x8*)(p + 8 * sub); const unsigned a1 = *(const unsigned*)(p + 128 + 2 * sub), a2 = *(const unsigned*)(p + 160 + 2 * sub);
                x1[u][0] = bf2f(a1 & 0xffff); x1[u][1] = bf2f(a1 >> 16); x2[u][0] = bf2f(a2 & 0xffff); x2[u][1] = bf2f(a2 >> 16);
            } else { vn[u] = *(const bf16x8*)(KV + (size_t)r * 2048 + h * 256 + 8 * sub);
                if (r < MROWS) { const bf16_t* pe = P + (size_t)r * LDP_AB + COL_KPE; const unsigned a1 = *(const unsigned*)(pe + 2 * sub), a2 = *(const unsigned*)(pe + 32 + 2 * sub);
                    x1[u][0] = bf2f(a1 & 0xffff); x1[u][1] = bf2f(a1 >> 16); x2[u][0] = bf2f(a2 & 0xffff); x2[u][1] = bf2f(a2 >> 16); }
                else { const int rr = r - MROWS, b = rr >> 8, t = rr & 255; const float* pe = ckpe + (size_t)((b * 2 + j) * 256 + t) * 64;
                    x1[u][0] = pe[2 * sub]; x1[u][1] = pe[2 * sub + 1]; x2[u][0] = pe[32 + 2 * sub]; x2[u][1] = pe[32 + 2 * sub + 1]; } }
            if (r >= MC && r < MROWS) cs[u] = *(const f32x4*)(RA + (((r - MC) & 2047) * 32 + 2 * sub) * 2);
        } }
#pragma unroll
        for (int u = 0; u < U; ++u) { const int it = base + u; if (it < NIT) {
            const bool isq = it < NQ; const int w = isq ? it : it - NQ; const int r = w >> 1, h = (w & 1) * 4 + hq;
            float xn[8];
#pragma unroll
            for (int e = 0; e < 8; ++e) xn[e] = bf2f((unsigned short)vn[u][e]);
            float ss = x1[u][0] * x1[u][0] + x1[u][1] * x1[u][1] + x2[u][0] * x2[u][0] + x2[u][1] * x2[u][1];
#pragma unroll
            for (int e = 0; e < 8; ++e) ss += xn[e] * xn[e];
            const float rstd = rsqrtf(sum16(ss) * (1.f / 192.f) + EPSN);
            const float* g = isq ? gq : gk;
#pragma unroll
            for (int e = 0; e < 8; ++e) xn[e] = xn[e] * rstd * g[8 * sub + e];
            float y1[2], y2[2];
            y1[0] = x1[u][0] * rstd * g[128 + 2 * sub]; y1[1] = x1[u][1] * rstd * g[128 + 2 * sub + 1]; y2[0] = x2[u][0] * rstd * g[160 + 2 * sub]; y2[1] = x2[u][1] * rstd * g[160 + 2 * sub + 1];
            if (r >= MC && r < MROWS) {
#pragma unroll
                for (int q = 0; q < 2; ++q) { const float c = cs[u][2 * q], sn = cs[u][2 * q + 1];
                    const float z1 = y1[q] * c - y2[q] * sn, z2 = y1[q] * sn + y2[q] * c; y1[q] = z1; y2[q] = z2; } }
            bf16_t* p;
            if (isq) {
#pragma unroll
                for (int e = 0; e < 8; ++e) xn[e] *= QSC_A;
                y1[0] *= QSC_A; y1[1] *= QSC_A; y2[0] *= QSC_A; y2[1] *= QSC_A;
                p = Q + (size_t)r * 1536 + h * 192;
            } else p = KF + (size_t)r * 1536 + h * 192;
            *(bf16x8*)(p + 8 * sub) = pack8(xn); *(unsigned*)(p + 128 + 2 * sub) = pk2(y1[0], y1[1]); *(unsigned*)(p + 160 + 2 * sub) = pk2(y2[0], y2[1]);
        } }
    }
}

__device__ __forceinline__ void phase_fin_ab(KArgs a, int j) {
    const int tid = otid(), lane = tid & 63, wave = tid >> 6, sub = lane & 15, hq = lane >> 4;
    const int gw = obid() * NWAVES + wave, NGW = gridDim.x * NWAVES;
    const bf16_t* OF = (const bf16_t*)(a->ws + WS_OF); const bf16_t* OB = (const bf16_t*)(a->ws + WS_OB);
    const bf16_t* P = (const bf16_t*)(a->ws + WS_PROJ); bf16_t* MIX = (bf16_t*)(a->ws + WS_H);
    const float* g = a->in[21] + j * 128;
    constexpr int U = 4;
    for (int base = gw * U; base < MROWS * 2; base += NGW * U) {
        bf16x8 va[U], vb[U], vg[U];
#pragma unroll
        for (int u = 0; u < U; ++u) { const int it = base + u; const int r = it >> 1, h = (it & 1) * 4 + hq; const size_t o = (size_t)r * 1024 + h * 128 + 8 * sub;
            va[u] = *(const bf16x8*)(OF + o); vb[u] = *(const bf16x8*)(OB + o); vg[u] = *(const bf16x8*)(P + (size_t)r * LDP_AB + COL_BG + h * 128 + 8 * sub); }
#pragma unroll
        for (int u = 0; u < U; ++u) { const int it = base + u; const int r = it >> 1, h = (it & 1) * 4 + hq;
            float s[8]; float ss = 0.f;
#pragma unroll
            for (int e = 0; e < 8; ++e) { s[e] = bf2f((unsigned short)va[u][e]) + bf2f((unsigned short)vb[u][e]); ss += s[e] * s[e]; }
            const float rstd = rsqrtf(sum16(ss) * (1.f / 128.f) + EPSN);
#pragma unroll
            for (int e = 0; e < 8; ++e) s[e] = s[e] * rstd * g[8 * sub + e] * silu_f(bf2f((unsigned short)vg[u][e]));
            *(bf16x8*)(MIX + (size_t)r * DM + 1024 + h * 128 + 8 * sub) = pack8(s); }
    }
}

__device__ __forceinline__ void phase_hn_c(KArgs a, int j) {
    const int tid = otid(), lane = tid & 63, wave = tid >> 6, sub = lane & 15, hq = lane >> 4;
    const int gw = obid() * NWAVES + wave, NGW = gridDim.x * NWAVES;
    bf16_t* P = (bf16_t*)(a->ws + WS_PROJ);
    const float* RC = (const float*)(a->ws + WS_ROPEC);
    const float* gq = a->in[27] + j * 128; const float* gk = a->in[28] + j * 128;
    float* outp = a->out;
    for (int r = gw; r < MC; r += NGW) { const int b = r >> 8, t = r & 255; const bf16x8 v = *(const bf16x8*)(P + (size_t)r * LDP_C + 2560 + 8 * lane);
        float* o = outp + O_VC + (size_t)((b * 2 + j) * 256 + t) * 512 + 8 * lane;
        *(f32x4*)o = (f32x4){bf2f((unsigned short)v[0]), bf2f((unsigned short)v[1]), bf2f((unsigned short)v[2]), bf2f((unsigned short)v[3])};
        *(f32x4*)(o + 4) = (f32x4){bf2f((unsigned short)v[4]), bf2f((unsigned short)v[5]), bf2f((unsigned short)v[6]), bf2f((unsigned short)v[7])}; }
    constexpr int U = 4;
    const int NIT = MROWS;
    for (int base = gw * U; base < NIT; base += NGW * U) {
        s16x4 v1[U], v2[U]; f32x4 ca[U], cb[U];
#pragma unroll
        for (int u = 0; u < U; ++u) { const int it = base + u; if (it < NIT) {
            const int r = it, h = 16 + hq; const bool isq = false;
            const bf16_t* p = P + (size_t)r * LDP_C + (isq ? h * 128 : 2048 + (h - 16) * 128);
            v1[u] = *(const s16x4*)(p + 4 * sub); v2[u] = *(const s16x4*)(p + 64 + 4 * sub);
            if (r >= MC) { const float* rc = RC + (((r - MC) & 2047) * 64 + 4 * sub) * 2; ca[u] = *(const f32x4*)rc; cb[u] = *(const f32x4*)(rc + 4); }
        } }
#pragma unroll
        for (int u = 0; u < U; ++u) { const int it = base + u; if (it < NIT) {
            const int r = it, h = 16 + hq; const bool isq = false;
            bf16_t* p = P + (size_t)r * LDP_C + (isq ? h * 128 : 2048 + (h - 16) * 128);
            float x1[4], x2[4]; float ss = 0.f;
#pragma unroll
            for (int e = 0; e < 4; ++e) { x1[e] = bf2f((unsigned short)v1[u][e]); x2[e] = bf2f((unsigned short)v2[u][e]); ss += x1[e] * x1[e] + x2[e] * x2[e]; }
            const float rstd = rsqrtf(sum16(ss) * (1.f / 128.f) + EPSN);
            const float* g = isq ? gq : gk;
#pragma unroll
            for (int e = 0; e < 4; ++e) { x1[e] *= rstd * g[4 * sub + e]; x2[e] *= rstd * g[64 + 4 * sub + e]; }
            if (r >= MC) {
#pragma unroll
                for (int e = 0; e < 4; ++e) { const float c = e < 2 ? ca[u][2 * e] : cb[u][2 * (e - 2)], sn = e < 2 ? ca[u][2 * e + 1] : cb[u][2 * (e - 2) + 1];
                    const float y1 = x1[e] * c - x2[e] * sn, y2 = x1[e] * sn + x2[e] * c; x1[e] = y1; x2[e] = y2; } }
            else if (!isq) { const int b = r >> 8, t = r & 255; float* o = outp + O_KC + (size_t)((b * 2 + j) * 256 + t) * 512 + (h - 16) * 128;
                *(f32x4*)(o + 4 * sub) = (f32x4){x1[0], x1[1], x1[2], x1[3]}; *(f32x4*)(o + 64 + 4 * sub) = (f32x4){x2[0], x2[1], x2[2], x2[3]}; }
            if (isq) {
#pragma unroll
                for (int e = 0; e < 4; ++e) { x1[e] *= QSC_C; x2[e] *= QSC_C; } }
            u32x2 w1, w2; w1.x = pk2(x1[0], x1[1]); w1.y = pk2(x1[2], x1[3]); w2.x = pk2(x2[0], x2[1]); w2.y = pk2(x2[2], x2[3]);
            *(u32x2*)(p + 4 * sub) = w1; *(u32x2*)(p + 64 + 4 * sub) = w2;
        } }
    }
}

namespace att {
__device__ __forceinline__ int crow(int r, int hi) { return (r & 3) + 8 * (r >> 2) + 4 * hi; }
__device__ __forceinline__ unsigned cvtpk(float lo, float hi) { return pk2(lo, hi); }
__device__ __forceinline__ int v_st(int k, int c) { const int kk = (k & ~0xC) | ((k & 4) << 1) | ((k & 8) >> 1); return ((kk >> 3) * 4 + (c >> 5)) * 512 + ((kk & 7) * 32 + (c & 31)) * 2; }
__device__ __forceinline__ int v_rd_base(int lane) { return ((lane & 3) << 3) | (((lane >> 2) & 3) << 6) | (((lane >> 4) & 1) << 5) | (((lane >> 5) & 1) << 8); }
constexpr int v_rd_off(int d0, int ks, int half) { return d0 * 512 + ks * 4096 + half * 2048; }
template <int OFF> __device__ __forceinline__ s16x4 tr_read(int vb) {
    s16x4 r; asm volatile("ds_read_b64_tr_b16 %0, %1 offset:%2" : "=&v"(r) : "v"(vb), "i"(OFF) : "memory"); return r;
}
template <int D0> __device__ __forceinline__ void pv_read8(s16x4 (&r)[8], int vb) {
    r[0] = tr_read<v_rd_off(D0, 0, 0)>(vb); r[1] = tr_read<v_rd_off(D0, 0, 1)>(vb); r[2] = tr_read<v_rd_off(D0, 1, 0)>(vb); r[3] = tr_read<v_rd_off(D0, 1, 1)>(vb);
    r[4] = tr_read<v_rd_off(D0, 2, 0)>(vb); r[5] = tr_read<v_rd_off(D0, 2, 1)>(vb); r[6] = tr_read<v_rd_off(D0, 3, 0)>(vb); r[7] = tr_read<v_rd_off(D0, 3, 1)>(vb);
}
__device__ __forceinline__ void pv_mma4(f32x16& od, const s16x4 (&r)[8], bf16x8 pa0, bf16x8 pa1, bf16x8 pa2, bf16x8 pa3) {
#define ATT_PK(L, H) (bf16x8){L[0], L[1], L[2], L[3], H[0], H[1], H[2], H[3]}
    od = __builtin_amdgcn_mfma_f32_32x32x16_bf16(pa0, ATT_PK(r[0], r[1]), od, 0, 0, 0);
    od = __builtin_amdgcn_mfma_f32_32x32x16_bf16(pa1, ATT_PK(r[2], r[3]), od, 0, 0, 0);
    od = __builtin_amdgcn_mfma_f32_32x32x16_bf16(pa2, ATT_PK(r[4], r[5]), od, 0, 0, 0);
    od = __builtin_amdgcn_mfma_f32_32x32x16_bf16(pa3, ATT_PK(r[6], r[7]), od, 0, 0, 0);
#undef ATT_PK
}
__device__ __forceinline__ void pv_all(f32x16 (&o)[4], int vb, bf16x8 pa0, bf16x8 pa1, bf16x8 pa2, bf16x8 pa3) {
    s16x4 ra[8], rb[8];
    pv_read8<0>(ra, vb);
    pv_read8<1>(rb, vb); asm volatile("s_waitcnt lgkmcnt(8)" ::: "memory"); __builtin_amdgcn_sched_barrier(0);
    pv_mma4(o[0], ra, pa0, pa1, pa2, pa3); __builtin_amdgcn_sched_barrier(0);
    pv_read8<2>(ra, vb); asm volatile("s_waitcnt lgkmcnt(8)" ::: "memory"); __builtin_amdgcn_sched_barrier(0);
    pv_mma4(o[1], rb, pa0, pa1, pa2, pa3); __builtin_amdgcn_sched_barrier(0);
    pv_read8<3>(rb, vb); asm volatile("s_waitcnt lgkmcnt(8)" ::: "memory"); __builtin_amdgcn_sched_barrier(0);
    pv_mma4(o[2], ra, pa0, pa1, pa2, pa3); __builtin_amdgcn_sched_barrier(0);
    asm volatile("s_waitcnt lgkmcnt(0)" ::: "memory"); __builtin_amdgcn_sched_barrier(0);
    pv_mma4(o[3], rb, pa0, pa1, pa2, pa3);
}
struct Item {
    const bf16_t* Q; int ldq;
    const bf16_t* K0; const bf16_t* V0; int n0;
    const bf16_t* K1; const bf16_t* V1; int ldk, ldv, t_lo, t_hi;
    int q0, band; float m0, l0;
    const float* qg; const float* rope; float qscale;
    const bf16_t* G; int ldg; bf16_t* O; int ldo;
};
template <int DQK>
__device__ __forceinline__ void attn_item(LAS unsigned char* lds, const Item& it) {
    constexpr int KROW = DQK * 2, SHM_K = 64 * KROW, SHM_V = 64 * 128 * 2, ND = DQK / 16;
    const int tid = otid(), wid = tid >> 6, lane = tid & 63, r32 = lane & 31, hi = lane >> 5;
    LAS unsigned char* V_lds = lds; LAS unsigned char* K_lds = lds + 3 * SHM_V;
    LAS float* wsx = (LAS float*)(lds + 3 * SHM_V + 3 * SHM_K) + wid * 64; LAS float* li_l = wsx; LAS float* al_l = wsx + 32;
    float m_reg = it.m0, l_reg = it.l0;
    f32x16 o[4];
#pragma unroll
    for (int d = 0; d < 4; ++d)
#pragma unroll
        for (int r = 0; r < 16; ++r) o[d][r] = 0.f;
    bf16x8 qr[ND];
    {
      const bf16_t* Qw = it.Q + (size_t)(wid * 32 + r32) * it.ldq + hi * 8;
      float xf[ND][8]; float ss = 0.f;
#pragma unroll
      for (int d0 = 0; d0 < ND; ++d0) { const bf16x8 v = *(const bf16x8*)(Qw + d0 * 16);
#pragma unroll
          for (int e = 0; e < 8; ++e) { xf[d0][e] = bf2f((unsigned short)v[e]); ss += xf[d0][e] * xf[d0][e]; } }
      ss += __shfl_xor(ss, 32);
      const float rstd = rsqrtf(ss * (1.f / (float)DQK) + EPSN);
#pragma unroll
      for (int d0 = 0; d0 < ND; ++d0) { const f32x4 g0 = *(const f32x4*)(it.qg + d0 * 16 + hi * 8), g1 = *(const f32x4*)(it.qg + d0 * 16 + hi * 8 + 4);
#pragma unroll
          for (int e = 0; e < 8; ++e) xf[d0][e] *= rstd * (e < 4 ? g0[e & 3] : g1[e & 3]); }
      if (it.rope) { constexpr int NR = DQK == 128 ? 4 : 2, RB = DQK == 128 ? 0 : 8, RS = DQK == 128 ? 64 : 32;
          const float* rp = it.rope + (size_t)((it.q0 + wid * 32 + r32) * RS + hi * 8) * 2;
#pragma unroll
          for (int p = 0; p < NR; ++p) { f32x4 cs4[4];
#pragma unroll
              for (int q = 0; q < 4; ++q) cs4[q] = *(const f32x4*)(rp + p * 32 + 4 * q);
#pragma unroll
              for (int e = 0; e < 8; ++e) { const float c = cs4[e >> 1][(e & 1) * 2], sn = cs4[e >> 1][(e & 1) * 2 + 1];
                  const float x1 = xf[RB + p][e], x2 = xf[RB + NR + p][e]; xf[RB + p][e] = x1 * c - x2 * sn; xf[RB + NR + p][e] = x1 * sn + x2 * c; } } }
#pragma unroll
      for (int d0 = 0; d0 < ND; ++d0) { float t8[8];
#pragma unroll
          for (int e = 0; e < 8; ++e) t8[e] = xf[d0][e] * it.qscale;
          qr[d0] = pack8(t8); } }
    const int NT = it.n0 + (it.t_hi - it.t_lo);
    const int wvu = __builtin_amdgcn_readfirstlane(wid);
    const int vb0 = (int)(uintptr_t)V_lds + v_rd_base(lane);
    constexpr int NKI = SHM_K / 8192;
    unsigned kog[NKI], vog[2];
#pragma unroll
    for (int i = 0; i < NKI; ++i) { const int off = i * 8192 + wid * 1024 + lane * 16, row = off / KROW, pos = off % KROW; kog[i] = (unsigned)(row * it.ldk + ((pos ^ ((row & 7) << 4)) >> 1)); }
#pragma unroll
    for (int i = 0; i < 2; ++i) { const int q = (i * 8192 + wid * 1024 + lane * 16) >> 4, sub = q >> 5, rem = q & 31, rowin = rem >> 2, cch = rem & 3;
        const int kk = (sub >> 2) * 8 + rowin; vog[i] = (unsigned)(((kk & ~0xC) | ((kk & 4) << 1) | ((kk & 8) >> 1)) * it.ldv + (sub & 3) * 32 + cch * 8); }
    int koff[4];
#pragma unroll
    for (int dl = 0; dl < 4; ++dl) koff[dl] = r32 * KROW + ((dl * 32 + hi * 16) ^ ((r32 & 7) << 4));
#define ATT_STAGE(jj, b) do { const int _j = (jj); const bool _s0 = _j < it.n0; const int _t = _s0 ? _j : it.t_lo + (_j - it.n0); \
        const bf16_t* _Kp = (_s0 ? it.K0 : it.K1) + (size_t)(64 * _t) * it.ldk; const bf16_t* _Vp = (_s0 ? it.V0 : it.V1) + (size_t)(64 * _t) * it.ldv; \
        _Pragma("unroll") for (int _i = 0; _i < NKI; ++_i) __builtin_amdgcn_global_load_lds((const unsigned*)(_Kp + kog[_i]), (LAS unsigned*)(K_lds + (b) * SHM_K + _i * 8192 + wvu * 1024), 16, 0, 0); \
        _Pragma("unroll") for (int _i = 0; _i < 2; ++_i) __builtin_amdgcn_global_load_lds((const unsigned*)(_Vp + vog[_i]), (LAS unsigned*)(V_lds + (b) * SHM_V + _i * 8192 + wvu * 1024), 16, 0, 0); } while (0)
#define ATT_WAIT_TILE(more) do { if (more) { if constexpr (NKI == 3) asm volatile("s_waitcnt vmcnt(5)" ::: "memory"); else asm volatile("s_waitcnt vmcnt(4)" ::: "memory"); } \
        else asm volatile("s_waitcnt vmcnt(0)" ::: "memory"); \
        asm volatile("s_waitcnt lgkmcnt(0)" ::: "memory"); __builtin_amdgcn_s_barrier(); asm volatile("" ::: "memory"); } while (0)
    ATT_STAGE(0, 0); if (NT > 1) ATT_STAGE(1, 1);
    ATT_WAIT_TILE(NT > 1);
    int cur = 0;
    for (int j = 0; j < NT; ++j) {
        if (j + 2 < NT) ATT_STAGE(j + 2, (cur == 0 ? 2 : cur - 1));
        bool act = true; const bool domask = it.band && j >= it.n0; int kpos0 = 0;
        if (domask) { kpos0 = 64 * (it.t_lo + j - it.n0); const int qlo = it.q0 + wid * 32; act = (kpos0 + 63 >= qlo - 128) && (kpos0 <= qlo + 31 + 128); }
        if (act) {
            f32x16 p0, p1;
#pragma unroll
            for (int r = 0; r < 16; ++r) { p0[r] = 0.f; p1[r] = 0.f; }
            const LAS unsigned char* Ks = K_lds + cur * SHM_K;
            {
                constexpr int NG = ND / 4;
                bf16x8 kf[2][8];
#define ATT_LOADG(g_, dst) do { _Pragma("unroll") for (int u_ = 0; u_ < 4; ++u_) { dst[2 * u_] = *(const LAS bf16x8*)(Ks + koff[u_] + (g_) * 128); dst[2 * u_ + 1] = *(const LAS bf16x8*)(Ks + koff[u_] + (g_) * 128 + 32 * KROW); } } while (0)
                ATT_LOADG(0, kf[0]);
#pragma unroll
                for (int g = 0; g < NG; ++g) {
                    if (g + 1 < NG) ATT_LOADG(g + 1, kf[(g + 1) & 1]);
                    __builtin_amdgcn_sched_barrier(0);
#pragma unroll
                    for (int u_ = 0; u_ < 4; ++u_) { p0 = __builtin_amdgcn_mfma_f32_32x32x16_bf16(kf[g & 1][2 * u_], qr[4 * g + u_], p0, 0, 0, 0);
                        p1 = __builtin_amdgcn_mfma_f32_32x32x16_bf16(kf[g & 1][2 * u_ + 1], qr[4 * g + u_], p1, 0, 0, 0); }
                    __builtin_amdgcn_sched_barrier(0); }
#undef ATT_LOADG
            }
            if (domask) { const int qp = it.q0 + wid * 32 + r32;
#pragma unroll
                for (int r = 0; r < 16; ++r) { const int d = kpos0 + crow(r, hi) - qp;
                    if (d > 128 || d < -128) p0[r] = -1e30f;
                    if (d + 32 > 128 || d + 32 < -128) p1[r] = -1e30f; } }
            float pmax = p0[0];
#pragma unroll
            for (int r = 1; r < 16; ++r) pmax = fmaxf(pmax, p0[r]);
#pragma unroll
            for (int r = 0; r < 16; ++r) pmax = fmaxf(pmax, p1[r]);
            { auto rr = __builtin_amdgcn_permlane32_swap(__float_as_uint(pmax), __float_as_uint(pmax), false, false);
              pmax = fmaxf(__uint_as_float(rr[0]), __uint_as_float(rr[1])); }
            float mn, alpha;
            if (__all(pmax - m_reg <= 11.5415603f)) { mn = m_reg; alpha = 1.f; }
            else { mn = fmaxf(m_reg, pmax); alpha = __builtin_amdgcn_exp2f(m_reg - mn); m_reg = mn; }
            float ps = 0.f;
#pragma unroll
            for (int r = 0; r < 16; ++r) { p0[r] = __builtin_amdgcn_exp2f(p0[r] - mn); p1[r] = __builtin_amdgcn_exp2f(p1[r] - mn); ps += p0[r] + p1[r]; }
            { auto rr = __builtin_amdgcn_permlane32_swap(__float_as_uint(ps), __float_as_uint(ps), false, false);
              ps = __uint_as_float(rr[0]) + __uint_as_float(rr[1]); }
            l_reg = l_reg * alpha + ps;
            bf16x8 pa0, pa1, pa2, pa3;
#define ATT_PK4(P, BASE, OUT) do { unsigned a0 = cvtpk(P[BASE + 0], P[BASE + 1]), a1 = cvtpk(P[BASE + 2], P[BASE + 3]);   \
    unsigned b0 = cvtpk(P[BASE + 4], P[BASE + 5]), b1 = cvtpk(P[BASE + 6], P[BASE + 7]);                              \
    auto r0 = __builtin_amdgcn_permlane32_swap(a0, b0, false, false); auto r1 = __builtin_amdgcn_permlane32_swap(a1, b1, false, false); \
    u32x4 w = {r0[0], r1[0], r0[1], r1[1]}; OUT = __builtin_bit_cast(bf16x8, w); } while (0)
            ATT_PK4(p0, 0, pa0); ATT_PK4(p0, 8, pa1); ATT_PK4(p1, 0, pa2); ATT_PK4(p1, 8, pa3);
#undef ATT_PK4
            if (__any(alpha < 1.f)) { if (hi == 0) al_l[r32] = alpha; asm volatile("s_waitcnt lgkmcnt(0)" ::: "memory");
#pragma unroll
                for (int r = 0; r < 16; ++r) { const float al = al_l[crow(r, hi)];
#pragma unroll
                    for (int d = 0; d < 4; ++d) o[d][r] *= al; } }
            const int vb = vb0 + cur * SHM_V;
            pv_all(o, vb, pa0, pa1, pa2, pa3);
        }
        ATT_WAIT_TILE(j + 2 < NT);
        cur = cur == 2 ? 0 : cur + 1;
    }
#undef ATT_STAGE
#undef ATT_WAIT_TILE
    const int er = lane >> 4, ec = (lane & 15) * 8;
    bf16x8 gv[8];
    { const bf16_t* Gw = it.G + (size_t)(wid * 32 + er) * it.ldg + ec;
#pragma unroll
      for (int c = 0; c < 8; ++c) gv[c] = *(const bf16x8*)(Gw + (size_t)(4 * c) * it.ldg); }
    if (hi == 0) li_l[r32] = l_reg; asm volatile("s_waitcnt lgkmcnt(0)" ::: "memory");
    LAS bf16_t* ost = (LAS bf16_t*)(lds + wid * 8192);
#pragma unroll
    for (int r = 0; r < 16; ++r) { const float rli = 1.f / li_l[crow(r, hi)];
#pragma unroll
        for (int d0 = 0; d0 < 4; ++d0) ost[crow(r, hi) * 128 + d0 * 32 + r32] = (bf16_t)f2bf(o[d0][r] * rli); }
    asm volatile("s_waitcnt lgkmcnt(0)" ::: "memory");
    { bf16_t* Ow = it.O + (size_t)(wid * 32 + er) * it.ldo + ec;
#pragma unroll
      for (int c = 0; c < 8; ++c) { const bf16x8 ov = *(const LAS bf16x8*)(ost + (4 * c + er) * 128 + ec); float t8[8];
#pragma unroll
          for (int e = 0; e < 8; ++e) t8[e] = bf2f((unsigned short)ov[e]) * silu_f(bf2f((unsigned short)gv[c][e]));
          *(bf16x8*)(Ow + (size_t)(4 * c) * it.ldo) = pack8(t8); } }
    __syncthreads();
}
}

__device__ __forceinline__ void hgrn_item(LAS unsigned char* lds, const bf16_t* PROJ, int rowbase, int T, int h, int dir,
                                          const float* lb, const float* s0, float* sout, bf16_t* OUT, int c0, int c1, float* sbuf) {
    const int tid = otid(), wid = tid >> 6, lane = tid & 63, fr = lane & 15, fq = lane >> 4;
    const int c2 = 16 * wid + (lane & 15), part = lane >> 4, n0 = wid * 16;
    f32x4 S[8];
    { const float* sin_ = c0 > 0 ? sbuf : (s0 ? s0 : sbuf);
      const float ssc = (c0 > 0 || s0) ? 1.f : 0.f;
#pragma unroll
      for (int kt = 0; kt < 8; ++kt)
#pragma unroll
          for (int r = 0; r < 4; ++r) S[kt][r] = sin_[(size_t)(16 * kt + 4 * fq + r) * 128 + n0 + fr] * ssc; }
    __builtin_amdgcn_s_waitcnt(0x0F70);
    const float oml = 1.f - lb[c2];
    const unsigned hz = ozero();
    const int nch = T / 32;
    LAS unsigned char* RAW = lds + 76800;
    const int wvu = __builtin_amdgcn_readfirstlane(wid);
    const int dtl = 4 * wid + (lane >> 4), dch = (lane & 15) * 8;
    const bf16_t* dsrc = PROJ + h * 128 + dch;
    const int colf = dir ? COL_FB : COL_FF;
#define HG_DMA(cc, slot) do { const int _p = 32 * (cc) + dtl; const int _tok = dir ? T - 1 - _p : _p; const bf16_t* _s = dsrc + (size_t)(rowbase + _tok) * LDP_AB; \
        __builtin_amdgcn_global_load_lds((const unsigned*)(_s + COL_BQ), (LAS unsigned*)(RAW + (slot) * 24576 + wvu * 1024), 16, 0, 0); \
        __builtin_amdgcn_global_load_lds((const unsigned*)(_s + colf), (LAS unsigned*)(RAW + (slot) * 24576 + 8192 + wvu * 1024), 16, 0, 0); \
        __builtin_amdgcn_global_load_lds((const unsigned*)(_s + COL_BI), (LAS unsigned*)(RAW + (slot) * 24576 + 16384 + wvu * 1024), 16, 0, 0); } while (0)
#define HG_BAR() do { asm volatile("s_waitcnt lgkmcnt(0)" ::: "memory"); __builtin_amdgcn_s_barrier(); asm volatile("" ::: "memory"); } while (0)
    HG_DMA(c0, 0);
    asm volatile("s_waitcnt vmcnt(0)" ::: "memory");
    HG_BAR();
    int cur = 0;
    for (int cc = c0; cc < c1; ++cc) {
        if (cc + 1 < c1) HG_DMA(cc + 1, cur ^ 1);
        LAS float* DEC = (LAS float*)lds + cur * 128;
        LAS bf16_t* QT = (LAS bf16_t*)(lds + 1024 + cur * 37888);
        LAS bf16_t* KT = QT + 32 * 136;
        LAS bf16_t* KTt = KT + 32 * 136;
        LAS bf16_t* Vt = KTt + 128 * 40;
        float b[8], kk[8], sq[8]; unsigned short vv[8]; float run = 0.f;
        { const LAS bf16_t* rw = (const LAS bf16_t*)(RAW + cur * 24576) + (8 * part) * 128 + c2;
            unsigned short rq[8], rf[8];
#pragma unroll
            for (int i = 0; i < 8; ++i) { rq[i] = rw[i * 128]; rf[i] = rw[4096 + i * 128]; vv[i] = rw[8192 + i * 128]; }
#pragma unroll
            for (int i = 0; i < 8; ++i) { const float x = bf2f(rf[i]); const float omf = oml * __builtin_amdgcn_rcpf(1.f + __expf(x));
                const float lf = fmaxf(__logf(1.f - omf), -30.f); run += lf; b[i] = run; kk[i] = omf; sq[i] = silu_f(bf2f(rq[i])); } }
        { const float r1 = __shfl_up(run, 16), r2 = __shfl_up(run, 32), r3 = __shfl_up(run, 48);
            const float off = (part >= 1 ? r1 : 0.f) + (part >= 2 ? r2 : 0.f) + (part >= 3 ? r3 : 0.f);
            float kt_[8];
#pragma unroll
            for (int i = 0; i < 8; ++i) { const float bb = b[i] + off; const int t = 8 * part + i;
                const float qv = sq[i] * __expf(bb); kt_[i] = kk[i] * __expf(fminf(-bb, 80.f));
                QT[t * 136 + c2] = (bf16_t)f2bf(qv); KT[t * 136 + c2] = (bf16_t)f2bf(kt_[i]);
                if (i == 7 && part == 3) DEC[c2] = __expf(bb); }
            *(LAS bf16x8*)(KTt + c2 * 40 + 8 * part) = pack8(kt_);
            u32x4 wv; wv.x = (unsigned)vv[0] | ((unsigned)vv[1] << 16); wv.y = (unsigned)vv[2] | ((unsigned)vv[3] << 16); wv.z = (unsigned)vv[4] | ((unsigned)vv[5] << 16); wv.w = (unsigned)vv[6] | ((unsigned)vv[7] << 16);
            *(LAS u32x4*)(Vt + c2 * 40 + 8 * part) = wv; }
        asm volatile("s_waitcnt vmcnt(0)" ::: "memory");
        HG_BAR();
        f32x4 pt00 = {0.f, 0.f, 0.f, 0.f}, pt01 = pt00, pt11 = pt00;
#pragma unroll
        for (int ks = 0; ks < 4; ++ks) {
            const bf16x8 a0 = *(const LAS bf16x8*)(KT + fr * 136 + 32 * ks + 8 * fq), a1 = *(const LAS bf16x8*)(KT + (16 + fr) * 136 + 32 * ks + 8 * fq);
            const bf16x8 b0 = *(const LAS bf16x8*)(QT + fr * 136 + 32 * ks + 8 * fq), b1 = *(const LAS bf16x8*)(QT + (16 + fr) * 136 + 32 * ks + 8 * fq);
            pt00 = __builtin_amdgcn_mfma_f32_16x16x32_bf16(a0, b0, pt00, 0, 0, 0);
            pt01 = __builtin_amdgcn_mfma_f32_16x16x32_bf16(a0, b1, pt01, 0, 0, 0);
            pt11 = __builtin_amdgcn_mfma_f32_16x16x32_bf16(a1, b1, pt11, 0, 0, 0); }
#pragma unroll
        for (int r = 0; r < 4; ++r) { if (4 * fq + r > fr) { pt00[r] = 0.f; pt11[r] = 0.f; } }
        u32x4 wA0, wA1;
        wA0.x = pk2(pt00[0], pt00[1]); wA0.y = pk2(pt00[2], pt00[3]); wA0.z = hz; wA0.w = hz;
        wA1.x = pk2(pt01[0], pt01[1]); wA1.y = pk2(pt01[2], pt01[3]); wA1.z = pk2(pt11[0], pt11[1]); wA1.w = pk2(pt11[2], pt11[3]);
        const u32x2 vlo = *(const LAS u32x2*)(Vt + (n0 + fr) * 40 + 4 * fq), vhi = *(const LAS u32x2*)(Vt + (n0 + fr) * 40 + 16 + 4 * fq);
        const u32x4 wV = {vlo.x, vlo.y, vhi.x, vhi.y};
        f32x4 o0 = {0.f, 0.f, 0.f, 0.f}, o1 = o0;
        o0 = __builtin_amdgcn_mfma_f32_16x16x32_bf16(__builtin_bit_cast(bf16x8, wA0), __builtin_bit_cast(bf16x8, wV), o0, 0, 0, 0);
        o1 = __builtin_amdgcn_mfma_f32_16x16x32_bf16(__builtin_bit_cast(bf16x8, wA1), __builtin_bit_cast(bf16x8, wV), o1, 0, 0, 0);
#pragma unroll
        for (int aa = 0; aa < 4; ++aa) {
            u32x4 wS; wS.x = pk2(S[2 * aa][0], S[2 * aa][1]); wS.y = pk2(S[2 * aa][2], S[2 * aa][3]); wS.z = pk2(S[2 * aa + 1][0], S[2 * aa + 1][1]); wS.w = pk2(S[2 * aa + 1][2], S[2 * aa + 1][3]);
            const u32x2 q0l = *(const LAS u32x2*)(QT + fr * 136 + 32 * aa + 4 * fq), q0h = *(const LAS u32x2*)(QT + fr * 136 + 32 * aa + 16 + 4 * fq);
            const u32x2 q1l = *(const LAS u32x2*)(QT + (16 + fr) * 136 + 32 * aa + 4 * fq), q1h = *(const LAS u32x2*)(QT + (16 + fr) * 136 + 32 * aa + 16 + 4 * fq);
            const u32x4 wQ0 = {q0l.x, q0l.y, q0h.x, q0h.y}, wQ1 = {q1l.x, q1l.y, q1h.x, q1h.y};
            o0 = __builtin_amdgcn_mfma_f32_16x16x32_bf16(__builtin_bit_cast(bf16x8, wQ0), __builtin_bit_cast(bf16x8, wS), o0, 0, 0, 0);
            o1 = __builtin_amdgcn_mfma_f32_16x16x32_bf16(__builtin_bit_cast(bf16x8, wQ1), __builtin_bit_cast(bf16x8, wS), o1, 0, 0, 0); }
        { const bf16x8 vn = *(const LAS bf16x8*)(Vt + (n0 + fr) * 40 + 8 * fq);
#pragma unroll
            for (int kt = 0; kt < 8; ++kt) { const bf16x8 ka = *(const LAS bf16x8*)(KTt + (16 * kt + fr) * 40 + 8 * fq);
                S[kt] = __builtin_amdgcn_mfma_f32_16x16x32_bf16(ka, vn, S[kt], 0, 0, 0);
                const f32x4 d = *(const LAS f32x4*)(DEC + 16 * kt + 4 * fq); S[kt] = S[kt] * d; } }
#pragma unroll
        for (int r = 0; r < 4; ++r) {
            const int i0 = 4 * fq + r, i1 = 16 + 4 * fq + r;
            const int tok0 = dir ? T - 1 - (32 * cc + i0) : 32 * cc + i0, tok1 = dir ? T - 1 - (32 * cc + i1) : 32 * cc + i1;
            OUT[(size_t)(rowbase + tok0) * 1024 + h * 128 + n0 + fr] = (bf16_t)f2bf(o0[r]);
            OUT[(size_t)(rowbase + tok1) * 1024 + h * 128 + n0 + fr] = (bf16_t)f2bf(o1[r]); }
        cur ^= 1;
    }
#undef HG_DMA
#undef HG_BAR
    { float* so_ = c1 < nch ? sbuf : sout;
      if (so_) {
#pragma unroll
        for (int kt = 0; kt < 8; ++kt)
#pragma unroll
            for (int r = 0; r < 4; ++r) so_[(size_t)(16 * kt + 4 * fq + r) * 128 + n0 + fr] = S[kt][r]; } }
    __syncthreads();
}

__device__ __forceinline__ int fetch_item(unsigned* ctr, LAS int* slot) {
    __syncthreads();
    if (otid() == 0) *slot = (int)atomicAdd(ctr, 1u);
    __syncthreads();
    return __builtin_amdgcn_readfirstlane(*slot);
}

#define XB_TMO      128
#define XB_XCNT(j)  (256  + 64 * (j))
#define XB_XSUB(j)  (1280 + 64 * (j))
#define XB_XGEN(j)  (2304 + 64 * (j))
#define XB_TOP      3328
#define XB_TOPGEN   3392
#define XCD_BAR_WORDS 3456
#define XB_SPIN_CAP (1u << 18)

__device__ __forceinline__ unsigned xb_ld(unsigned* p)              { return __hip_atomic_load(p, __ATOMIC_RELAXED, __HIP_MEMORY_SCOPE_AGENT); }
__device__ __forceinline__ unsigned xb_add(unsigned* p, unsigned v) { return __hip_atomic_fetch_add(p, v, __ATOMIC_RELAXED, __HIP_MEMORY_SCOPE_AGENT); }
__device__ __forceinline__ unsigned xb_xcc_id() { return (unsigned)__builtin_amdgcn_s_getreg((3 << 11) | 20) & 0xFu; }
#define XB_SPIN(cond, bar) do { unsigned _sp = 0; while (cond) { __builtin_amdgcn_s_sleep(1); \
    if ((++_sp & 255u) == 0u) { if (xb_ld(&(bar)[XB_TMO])) break; if (_sp > XB_SPIN_CAP) { atomicAdd(&(bar)[XB_TMO], 1u); break; } } } } while (0)

struct XcdBarrier {
    unsigned* bar; unsigned x;
    volatile LAS unsigned* st;
};

__device__ __forceinline__ XcdBarrier xcd_barrier_post(unsigned* bar, volatile LAS unsigned* st) {
    XcdBarrier b; b.bar = bar; b.x = xb_xcc_id(); b.st = st;
    if (threadIdx.x == 0) (void)xb_add(&bar[XB_XCNT(b.x)], 1u);
    return b;
}
__device__ __forceinline__ void xcd_barrier_complete(unsigned* bar, unsigned x, unsigned& nloc, unsigned& nx) {
    const unsigned G = gridDim.x * gridDim.y * gridDim.z;
    unsigned sum, cnt, mine, sp = 0u;
    for (;;) {
        sum = 0u; cnt = 0u; mine = 0u;
#pragma unroll
        for (unsigned j = 0; j < 16; ++j) { const unsigned c = xb_ld(&bar[XB_XCNT(j)]); sum += c; cnt += (c > 0u) ? 1u : 0u; mine = (j == x) ? c : mine; }
        if (sum == G) break;
        __builtin_amdgcn_s_sleep(1);
        if ((++sp & 255u) == 0u) { if (xb_ld(&bar[XB_TMO])) break; if (sp > XB_SPIN_CAP) { atomicAdd(&bar[XB_TMO], 1u); break; } }
    }
    nloc = mine > 0u ? mine : 1u; nx = cnt > 0u ? cnt : 1u;
}

__device__ __forceinline__ void xcd_barrier(const XcdBarrier& b) {
    asm volatile("s_waitcnt vmcnt(0)" ::: "memory");
    __syncthreads();
    if (threadIdx.x == 0) {
        unsigned* bar = b.bar;
        __builtin_amdgcn_s_waitcnt(0);
        unsigned nloc = b.st[0], nx = b.st[1];
        if (nloc == 0u) { xcd_barrier_complete(bar, b.x, nloc, nx); b.st[0] = nloc; b.st[1] = nx; }
        const unsigned old = xb_add(&bar[XB_XSUB(b.x)], 1u);
        const unsigned gen = old / nloc;
        if (old + 1u == (gen + 1u) * nloc) {
            __builtin_amdgcn_fence(__ATOMIC_RELEASE, "agent");
            asm volatile("s_waitcnt vmcnt(0)" ::: "memory");
            const unsigned og = xb_add(&bar[XB_TOP], 1u);
            const unsigned tg = og / nx;
            if (og + 1u == (tg + 1u) * nx) xb_add(&bar[XB_TOPGEN], 1u);
            else XB_SPIN(xb_ld(&bar[XB_TOPGEN]) == tg, bar);
            __builtin_amdgcn_fence(__ATOMIC_ACQUIRE, "agent");
            xb_add(&bar[XB_XGEN(b.x)], 1u);
            asm volatile("s_waitcnt vmcnt(0)" ::: "memory");
        } else {
            XB_SPIN(xb_ld(&bar[XB_XGEN(b.x)]) == gen, bar);
            __builtin_amdgcn_fence(__ATOMIC_ACQUIRE, "agent");
            asm volatile("s_waitcnt vmcnt(0)" ::: "memory");
        }
    }
    __syncthreads();
}

#ifndef BG_C1
#define BG_C1 4
#define BG_C2 12
#define BG_C3 16
#endif
enum { K_FINAL = 12, K_P0 = 0, K_MODNORM, K_GEMM_IN, K_PREP_AB, K_GEMM_QUP, K_GEMM_KVUP, K_HN_AB, K_MIX_AB, K_FIN_AB, K_GEMM_OUT, K_HN_C, K_ATTN_C };

__global__ void __launch_bounds__(NTHR, 2) mk_fwd(Args a_byval) {
    extern __shared__ __attribute__((aligned(16))) unsigned char lds_raw[];
    LAS unsigned char* lds = (LAS unsigned char*)lds_raw;
    LAS int* slot = (LAS int*)(lds + LDS_PHASE);
    cg::grid_group grid = cg::this_grid();
    const int G = gridDim.x;
    volatile LAS unsigned* bst = (volatile LAS unsigned*)(lds + LDS_PHASE + 64);
    if (threadIdx.x < 2) bst[threadIdx.x] = 0u;
    __syncthreads();
    (void)xcd_barrier_post((unsigned*)(a_byval.ws + WS_CTL) + 8192, bst);

    grid.sync();
#ifndef PROBE_TSEL
#define PROBE_TSEL 0
#endif
    unsigned long long t_acc = 0ull;
    for (int step = 0; step < 30; ++step) {
        unsigned long long t_begin = 0ull; if (PROBE_TSEL) t_begin = __builtin_amdgcn_s_memrealtime();
        asm volatile("" : "+s"(step));
        KArgs a = (KArgs)__builtin_amdgcn_kernarg_segment_ptr();
        asm volatile("" : "+s"(a));
        unsigned char* ws = a->ws;
        unsigned* ctl = (unsigned*)(ws + WS_CTL);
        XcdBarrier xbar; xbar.bar = ctl + 8192; xbar.x = xb_xcc_id(); xbar.st = (volatile LAS unsigned*)(lds + LDS_PHASE + 64);
        int kind, L = 0; bool sync_after = true;
        if (step == 0) kind = K_P0;
        else if (step == 29) { kind = K_FINAL; L = 4; }
        else { const int s = step - 1, pair = s / 14, r = s % 14;
            if (r < 9) { L = 2 * pair; kind = r == 0 ? K_MODNORM : r == 1 ? K_GEMM_IN : r == 2 ? K_PREP_AB : r == 3 ? K_GEMM_QUP : r == 4 ? K_GEMM_KVUP : r == 5 ? K_HN_AB : r == 6 ? K_MIX_AB : r == 7 ? K_FIN_AB : K_GEMM_OUT; }
            else { L = 2 * pair + 1; const int q = r - 9; kind = q == 0 ? K_MODNORM : q == 1 ? K_GEMM_IN : q == 2 ? K_HN_C : q == 3 ? K_ATTN_C : K_GEMM_OUT; } }
        const int j = L >> 1; const bool isC = (L & 1) != 0;
        if (kind == K_GEMM_QUP) sync_after = false;
        if (step == 29) sync_after = false;

#ifndef PROBE_MASK
#define PROBE_MASK 0
#endif
#ifndef PROBE_SEL
#define PROBE_SEL 0
#endif
#ifndef PROBE_REPS
#define PROBE_REPS 2
#endif
        const int nrep = (((PROBE_MASK >> kind) & 1) && (kind != K_GEMM_OUT || L == 0)) ? 1 + PROBE_REPS : 1;
        for (int rep = 0; rep < nrep; ++rep) {
        if (PROBE_MASK == 0x1000) { for (int q = 0; q < 2; ++q) xcd_barrier(xbar); }
        const int bid = obid();
        const bool bgphase = kind == K_PREP_AB || kind == K_GEMM_QUP || kind == K_GEMM_KVUP || kind == K_HN_AB;
        if (rep == 0 && bid < NBG && (kind == K_PREP_AB || kind == K_GEMM_QUP || kind == K_HN_AB || kind == K_MIX_AB)) {
            const int b = bid >> 4, h = (bid >> 1) & 7, dir = bid & 1;
            const int c0 = kind == K_PREP_AB ? 0 : kind == K_GEMM_QUP ? BG_C1 : kind == K_HN_AB ? BG_C2 : BG_C3;
            const int c1 = kind == K_PREP_AB ? BG_C1 : kind == K_GEMM_QUP ? BG_C2 : kind == K_HN_AB ? BG_C3 : 64;
            hgrn_item(lds, (const bf16_t*)(ws + WS_PROJ), MC + b * 2048, 2048, h, dir, (const float*)(ws + WS_LB) + (j * 2 + dir) * 1024 + h * 128,
                      a->in[4 + dir] + (size_t)((b * 2 + j) * 8 + h) * 16384, nullptr, (bf16_t*)(ws + (dir ? WS_OB : WS_OF)), c0, c1, (float*)(ws + WS_SBUF) + (size_t)bid * 16384);
        }
        const int ewg = bgphase ? bid - NBG : bid, enwg = bgphase ? G - NBG : G;
        if (bgphase && bid < NBG) {}
        else
        if (kind == K_P0) phase_p0(a, lds);
        else if (kind == K_MODNORM) phase_modnorm(a, L);
        else if (kind == K_GEMM_IN || kind == K_GEMM_QUP || kind == K_GEMM_KVUP) {
            pg8::Gemm g; pg8::EpiStore E;
            if (kind == K_GEMM_IN) {
                if (!isC) { g = pg8::Gemm{(const bf16_t*)(ws + WS_H), (const bf16_t*)(ws + WS_WINAB) + (size_t)j * 7168 * 2048, MROWS, 7168, 2048}; E = pg8::EpiStore{(bf16_t*)(ws + WS_PROJ), LDP_AB}; }
                else { g = pg8::Gemm{(const bf16_t*)(ws + WS_H), (const bf16_t*)(ws + WS_WINC) + (size_t)j * 5120 * 2048, MROWS, 5120, 2048}; E = pg8::EpiStore{(bf16_t*)(ws + WS_PROJ), LDP_C}; }
            } else if (kind == K_GEMM_QUP) { g = pg8::Gemm{(const bf16_t*)(ws + WS_QN), (const bf16_t*)(ws + WS_WQUP) + (size_t)j * 1536 * 512, MROWS, 1536, 512}; E = pg8::EpiStore{(bf16_t*)(ws + WS_QRAW), 1536}; }
            else { g = pg8::Gemm{(const bf16_t*)(ws + WS_CKV), (const bf16_t*)(ws + WS_WKVUP) + (size_t)j * 2048 * 256, MKROWS, 2048, 256}; E = pg8::EpiStore{(bf16_t*)(ws + WS_KVRAW), 2048}; }
            pg8::StaticOrder S; S.init(g.M, g.N, enwg, ewg);
            pg8::gemm_phase<pg8::EpiStore, pg8::StaticOrder, true, true>(lds, g, S, E);
            if (kind == K_GEMM_IN && L <= 1) { const int left = ((g.M / 256) * (g.N / 256)) % G;
                if (left > 0 && bid >= left) { const int lo = L == 0 ? P0_EARLY : P0_EARLY + 10000, hi = L == 0 ? P0_EARLY + 6000 : P0_EARLY + 12000;
                    p0_transposes(a, lds, lo, hi, (bid - left) * NWAVES + (otid() >> 6), (G - left) * NWAVES); } }
        }
        else if (kind == K_GEMM_OUT) {
            pg8::Gemm g{(const bf16_t*)(ws + WS_H), (const bf16_t*)(ws + (isC ? WS_WOUTC : WS_WOUTAB)) + (size_t)j * 2048 * 2048, MROWS, 2048, 2048};
            pg8::EpiResid E{(bf16_t*)(ws + WS_PROJ), (const float*)(ws + WS_MOD) + (size_t)L * 5 * 6144 + 4096,
                            (float*)(ws + WS_QRAW), ctl + 16384 + step * 256};
            pg8::StaticOrder S; S.init(g.M, g.N, G, obid());
            pg8::gemm_phase<pg8::EpiResid, pg8::StaticOrder, true, true>(lds, g, S, E);
            if (L <= 1) { const int left = ((g.M / 256) * (g.N / 256)) % G;
                if (left > 0 && bid >= left) { const int lo = L == 0 ? P0_EARLY + 6000 : P0_EARLY + 12000, hi = L == 0 ? P0_EARLY + 10000 : P0_EARLY + 16000;
                    p0_transposes(a, lds, lo, hi, (bid - left) * NWAVES + (otid() >> 6), (G - left) * NWAVES); } }
        }
        else if (kind == K_FINAL) phase_final(a);
        else if (kind == K_PREP_AB) phase_prep_ab(a, j, ewg, enwg);
        else if (kind == K_HN_AB) phase_hn_ab(a, j, ewg, enwg);
        else if (kind == K_FIN_AB) phase_fin_ab(a, j);
        else if (kind == K_HN_C) phase_hn_c(a, j);
        else if (kind == K_MIX_AB) {
            unsigned* ctr = ctl + 64 * step + 8 * rep;
            const bf16_t* P = (const bf16_t*)(ws + WS_PROJ); bf16_t* MIX = (bf16_t*)(ws + WS_H);
            const bf16_t* QF = (const bf16_t*)(ws + WS_QRAW); const bf16_t* KF = (const bf16_t*)(ws + WS_KF); const bf16_t* KV = (const bf16_t*)(ws + WS_KVRAW);
            for (;;) {
                const int idx = fetch_item(ctr, slot);
                if (idx >= 640) break;
                if (idx >= 256 && idx < 512) {
                    const int i = idx - 256; const int b = i >> 4, h = (i >> 1) & 7, dir = i & 1;
                    const float* lb = (const float*)(ws + WS_LB) + (j * 2 + dir) * 1024 + h * 128;
                    float* so = a->out + (dir ? O_SB : O_SF) + (size_t)((b * 2 + j) * 8 + h) * 16384;
                    if (PROBE_SEL != 1 || rep == 0) hgrn_item(lds, P, b * 256, 256, h, dir, lb, nullptr, so, (bf16_t*)(ws + (dir ? WS_OB : WS_OF)), 0, 8, (float*)(ws + WS_SBUF));
                } else {
                    att::Item it;
                    const bool lat = idx < 256; int b, h, r0;
                    if (lat) { const int i = idx; b = i >> 6; h = (i >> 3) & 7; const int qb = i & 7; r0 = MC + b * 2048 + qb * 256; it.q0 = qb * 256;
                        it.K0 = KF + (size_t)(MROWS + b * 256) * 1536 + h * 192; it.V0 = KV + (size_t)(MROWS + b * 256) * 2048 + h * 256 + 128; it.n0 = 4;
                        it.K1 = KF + (size_t)(MC + b * 2048) * 1536 + h * 192; it.V1 = KV + (size_t)(MC + b * 2048) * 2048 + h * 256 + 128; it.t_lo = 0; it.t_hi = 32; }
                    else { const int i = idx - 512; b = i >> 3; h = i & 7; r0 = b * 256; it.q0 = 0;
                        it.K0 = KF; it.V0 = KV; it.n0 = 0;
                        it.K1 = KF + (size_t)r0 * 1536 + h * 192; it.V1 = KV + (size_t)r0 * 2048 + h * 256 + 128; it.t_lo = 0; it.t_hi = 4; }
                    it.ldk = 1536; it.ldv = 2048;
                    it.Q = QF + (size_t)r0 * 1536 + h * 192; it.ldq = 1536; it.band = 0; it.m0 = -1e30f; it.l0 = 0.f;
                    it.qg = a->in[18] + j * 192; it.rope = lat ? (const float*)(ws + WS_ROPEA) : nullptr; it.qscale = QSC_A;
                    it.G = P + (size_t)r0 * LDP_AB + COL_AG + h * 128; it.ldg = LDP_AB; it.O = MIX + (size_t)r0 * DM + h * 128; it.ldo = DM;
                    if (PROBE_SEL != 2 || rep == 0) att::attn_item<192>(lds, it);
                }
            }
        }
        else if (kind == K_ATTN_C) {
            unsigned* ctr = ctl + 64 * step + 8 * rep;
            const bf16_t* P = (const bf16_t*)(ws + WS_PROJ); bf16_t* MIX = (bf16_t*)(ws + WS_H);
            const bf16_t* KCC = (const bf16_t*)(ws + WS_KCC);
            for (;;) {
                const int idx = fetch_item(ctr, slot);
                if (idx >= 768) break;
                att::Item it; int b, h, r0;
                if (idx < 512) { b = idx >> 7; h = (idx >> 3) & 15; const int qb = idx & 7; r0 = MC + b * 2048 + qb * 256; const int kvh = h >> 2;
                    it.K0 = KCC + (size_t)((b * 2 + j) * 256) * LDP_C + kvh * 128; it.V0 = KCC + (size_t)((b * 2 + j) * 256) * LDP_C + 512 + kvh * 128; it.n0 = 4;
                    it.K1 = P + (size_t)(MC + b * 2048) * LDP_C + 2048 + kvh * 128; it.V1 = P + (size_t)(MC + b * 2048) * LDP_C + 2560 + kvh * 128;
                    it.t_lo = 4 * qb - 2 < 0 ? 0 : 4 * qb - 2; it.t_hi = 4 * qb + 6 > 32 ? 32 : 4 * qb + 6; it.q0 = qb * 256; it.band = 1; }
                else { const int i = idx - 512; b = i >> 4; h = i & 15; r0 = b * 256; const int kvh = h >> 2;
                    it.K0 = KCC; it.V0 = KCC; it.n0 = 0;
                    it.K1 = P + (size_t)r0 * LDP_C + 2048 + kvh * 128; it.V1 = P + (size_t)r0 * LDP_C + 2560 + kvh * 128; it.t_lo = 0; it.t_hi = 4; it.q0 = 0; it.band = 0; }
                it.ldk = LDP_C; it.ldv = LDP_C;
                it.Q = P + (size_t)r0 * LDP_C + h * 128; it.ldq = LDP_C; it.m0 = a->in[29][j * 16 + h] * LOG2E; it.l0 = 1.f;
                it.qg = a->in[27] + j * 128; it.rope = idx < 512 ? (const float*)(ws + WS_ROPEC) : nullptr; it.qscale = QSC_C;
                it.G = P + (size_t)r0 * LDP_C + 3072 + h * 128; it.ldg = LDP_C; it.O = MIX + (size_t)r0 * DM + h * 128; it.ldo = DM;
                att::attn_item<128>(lds, it);
            }
        }
        if (rep + 1 < nrep) xcd_barrier(xbar);
        }
        if (sync_after) xcd_barrier(xbar);
        if (PROBE_TSEL) { if ((PROBE_TSEL >> kind) & 1) t_acc += __builtin_amdgcn_s_memrealtime() - t_begin; }
    }
    if (PROBE_TSEL) { if (blockIdx.x == 0) { const unsigned long long t_end = __builtin_amdgcn_s_memrealtime() + 2ull * t_acc;
        while (__builtin_amdgcn_s_memrealtime() < t_end) __builtin_amdgcn_s_sleep(32); } }
}

extern "C" void kernel_launch(void* const* d_in, const int* in_sizes, int n_in, void* d_out, int out_size, void* d_ws, size_t ws_size, hipStream_t stream) {
    static int grid = 0;
    if (grid == 0) {
        if (n_in != 31 || ws_size < WS_END) { fprintf(stderr, "kernel_launch: unexpected n_in %d or ws_size %zu (< %zu)\n", n_in, ws_size, (size_t)WS_END); grid = -1; return; }
        int dev = 0, cus = 0, per_cu = 0;
        hipGetDevice(&dev); hipDeviceGetAttribute(&cus, hipDeviceAttributeMultiprocessorCount, dev);
        if (hipFuncSetAttribute((const void*)mk_fwd, hipFuncAttributeMaxDynamicSharedMemorySize, LDS_BYTES) != hipSuccess) { fprintf(stderr, "kernel_launch: hipFuncSetAttribute failed\n"); grid = -1; return; }
        if (hipOccupancyMaxActiveBlocksPerMultiprocessor(&per_cu, (const void*)mk_fwd, NTHR, LDS_BYTES) != hipSuccess || per_cu < 1) per_cu = 1;
        (void)hipGetLastError();
        grid = cus > 0 ? cus : 256;
    }
    if (grid < 0) return;
    hipMemsetAsync((char*)d_ws + WS_CTL, 0, CTL_BYTES, stream);
    Args a{};
    for (int i = 0; i < 31; ++i) a.in[i] = (const float*)d_in[i];
    a.out = (float*)d_out; a.ws = (unsigned char*)d_ws;
    void* args[] = {&a};
    hipError_t e = hipLaunchCooperativeKernel((const void*)mk_fwd, dim3(grid), dim3(NTHR), args, LDS_BYTES, stream);
    if (e != hipSuccess) fprintf(stderr, "cooperative launch failed: %s (grid %d)\n", hipGetErrorString(e), grid);
}
```

```cpp
#include <hip/hip_runtime.h>
#include <hip/hip_cooperative_groups.h>
#include <cstdio>
#include <cstdint>
namespace cg = cooperative_groups;

namespace pg8 {
#define PG8_LAS __attribute__((address_space(3)))
typedef unsigned short bf16_t;
typedef short bf16x8 __attribute__((ext_vector_type(8)));
typedef float f32x4 __attribute__((ext_vector_type(4)));
typedef unsigned u32x4 __attribute__((ext_vector_type(4)));
constexpr int BM = 256, BK = 64, HALF = 128, HTB = HALF * BK * 2  , STAGE_BYTES = 8 * HTB, NXCD = 8, WGM = 8;
__device__ __forceinline__ int pg8_otid() { int t = threadIdx.x; asm volatile("" : "+v"(t)); return t; }

__host__ __device__ __forceinline__ int lds_byte(int r, int c) { const int st = (r >> 4) * 2 + (c >> 5), rr = r & 15, cc = c & 31, ob = rr * 64 + cc * 2; return st * 1024 + (ob ^ (((ob >> 9) & 1) << 5)); }
__host__ __device__ __forceinline__ void stage_rc(int b, int& R, int& C) { const int st = b / 1024, sb = b % 1024, swz = sb ^ (((sb >> 9) & 1) << 5); R = (st >> 1) * 16 + swz / 64; C = (st & 1) * 32 + (swz % 64) / 2; }
__host__ __device__ __forceinline__ int perm32(int rho) { const int n = rho >> 4, i = rho & 15; return 8 * (i >> 2) + 4 * n + (i & 3); }

struct Unit { int pm, pn, kp, np, tix; };
struct Gemm { const bf16_t* A; const bf16_t* Bt; int M, N, K; };

struct StaticOrder {
    int nM, nN, nwg, G, c;
    __host__ __device__ void init(int M, int N, int G_, int c_) { nM = M / BM; nN = N / BM; nwg = nM * nN; G = G_; c = c_; }
    __host__ __device__ bool next(int i, Unit& u) const {
        const long L = (long)i * G + c; if (L >= nwg) return false;
        int wgid = (int)L; { const int q = nwg / NXCD, r = nwg % NXCD, xcd = wgid % NXCD, off = wgid / NXCD; wgid = (xcd < r ? xcd * (q + 1) : r * (q + 1) + (xcd - r) * q) + off; }
        const int nig = WGM * nN, gid = wgid / nig, fm = gid * WGM, gsz = (nM - fm) < WGM ? (nM - fm) : WGM;
        u.pm = fm + ((wgid % nig) % gsz); u.pn = (wgid % nig) / gsz; u.kp = 0; u.np = 1; u.tix = 0; return true;
    }
    __device__ __forceinline__ void a_ready(const Unit&) const {}
    __device__ __forceinline__ void done(const Unit&) const {}
};
struct SplitOrder {
    StaticOrder so; int R, np;
    __host__ __device__ void init(int M, int N, int K, int G_, int c_) { so.init(M, N, G_, c_); R = so.nwg / G_; const int left = so.nwg - R * G_;
        np = 1; if (left > 0 && G_ % left == 0) { const int q = G_ / left; if (q == 2 && (K / q) % 128 == 0) np = q; } }
    __host__ __device__ bool next(int i, Unit& u) const {
        if (np == 1 || i < R) return so.next(i, u);
        if (i > R) return false;
        StaticOrder t = so; t.c = so.c / np; const bool ok = t.next(i, u); u.kp = so.c % np; u.np = np; u.tix = so.c / np; return ok;
    }
    __device__ __forceinline__ void a_ready(const Unit&) const {}
    __device__ __forceinline__ void done(const Unit&) const {}
};

typedef float f32x2c __attribute__((ext_vector_type(2)));
typedef __bf16 bf16x2c __attribute__((ext_vector_type(2)));
__device__ __forceinline__ unsigned cvt_pk_bf16(float lo, float hi) { const f32x2c v = {lo, hi}; const bf16x2c b = __builtin_convertvector(v, bf16x2c); return __builtin_bit_cast(unsigned, b); }

struct EpiStore {
    static constexpr bool PERM = true, AFTER_DRAIN = false;
    bf16_t* O; int ldc;
    __device__ __forceinline__ void operator()(const f32x4 (&acc)[2][2][4][2], const Unit& u, int wr, int wc, int fr, int fq) const {
        const int row0 = u.pm * BM + wr * 64 + fr; const int col0 = u.pn * BM + wc * 32 + 8 * fq;
#pragma unroll
        for (int ai = 0; ai < 2; ++ai)
#pragma unroll
            for (int m = 0; m < 4; ++m) { bf16_t* rowp = O + (size_t)(row0 + ai * HALF + m * 16) * ldc + col0;
#pragma unroll
                for (int bj = 0; bj < 2; ++bj) { const f32x4 v0 = acc[ai][bj][m][0], v1 = acc[ai][bj][m][1];
                    u32x4 w; w.x = cvt_pk_bf16(v0[0], v0[1]); w.y = cvt_pk_bf16(v0[2], v0[3]); w.z = cvt_pk_bf16(v1[0], v1[1]); w.w = cvt_pk_bf16(v1[2], v1[3]);
                    *(u32x4*)(rowp + bj * HALF) = w; } }
    }
};
struct EpiResid {
    static constexpr bool PERM = true, AFTER_DRAIN = false;
    bf16_t* dout; const float* gate_base;
    float* slab; unsigned* cnt;
    __device__ __forceinline__ void operator()(f32x4 (&acc)[2][2][4][2], const Unit& u, int wr, int wc, int fr, int fq) const {
        const int tid = (wr * 4 + wc) * 64 + fq * 16 + fr;
        const f32x4* sl = nullptr;
        if (u.np > 1) {
            float* sb = slab + (size_t)u.tix * (u.np - 1) * 65536;
            if (u.kp < u.np - 1) {
                f32x4* sp = (f32x4*)(sb + (size_t)u.kp * 65536) + tid;
#pragma unroll
                for (int ai = 0; ai < 2; ++ai)
#pragma unroll
                    for (int bj = 0; bj < 2; ++bj)
#pragma unroll
                        for (int m = 0; m < 4; ++m)
#pragma unroll
                            for (int n = 0; n < 2; ++n) sp[(((ai * 2 + bj) * 4 + m) * 2 + n) * 512] = acc[ai][bj][m][n];
                asm volatile("s_waitcnt vmcnt(0)" ::: "memory");
                __syncthreads();
                if (tid == 0) { __builtin_amdgcn_fence(__ATOMIC_RELEASE, "agent"); asm volatile("s_waitcnt vmcnt(0)" ::: "memory");
                    __hip_atomic_fetch_add(cnt + u.tix, 1u, __ATOMIC_RELAXED, __HIP_MEMORY_SCOPE_AGENT); }
                return;
            }
            if (tid == 0) { unsigned sp_ = 0;
                while (__hip_atomic_load(cnt + u.tix, __ATOMIC_RELAXED, __HIP_MEMORY_SCOPE_AGENT) < (unsigned)(u.np - 1)) { __builtin_amdgcn_s_sleep(2); if (++sp_ > (1u << 22)) break; }
                __builtin_amdgcn_fence(__ATOMIC_ACQUIRE, "agent"); asm volatile("s_waitcnt vmcnt(0)" ::: "memory"); }
            __syncthreads();
            sl = (const f32x4*)sb + tid;
        }
        const int pm = u.pm;
        const int ci = pm < 16 ? 4 : ((pm - 16) >> 3);
        const float* gt = gate_base + ci * 6144;
        const int row0 = pm * BM + wr * 64 + fr, col0 = u.pn * BM + wc * 32 + 8 * fq;
#pragma unroll
        for (int bj = 0; bj < 2; ++bj) { const f32x4 gq0 = *(const f32x4*)(gt + col0 + bj * HALF), gq1 = *(const f32x4*)(gt + col0 + bj * HALF + 4);
#pragma unroll
            for (int ai = 0; ai < 2; ++ai) {
#pragma unroll
                for (int m = 0; m < 4; ++m) { f32x4 a0 = acc[ai][bj][m][0], a1 = acc[ai][bj][m][1];
                    if (sl) { a0 += sl[(((ai * 2 + bj) * 4 + m) * 2 + 0) * 512]; a1 += sl[(((ai * 2 + bj) * 4 + m) * 2 + 1) * 512]; }
                    a0 = a0 * gq0; a1 = a1 * gq1;
                    u32x4 w; w.x = cvt_pk_bf16(a0[0], a0[1]); w.y = cvt_pk_bf16(a0[2], a0[3]); w.z = cvt_pk_bf16(a1[0], a1[1]); w.w = cvt_pk_bf16(a1[2], a1[3]);
                    *(u32x4*)(dout + (size_t)(row0 + ai * HALF + m * 16) * 2048 + col0 + bj * HALF) = w; }
                asm volatile("" ::: "memory"); } }
    }
};

template <class Epi, class Sched, bool ALIGN_EPI = false, bool SP2 = false>
__device__ __forceinline__ void gemm_phase(PG8_LAS unsigned char* lds, const Gemm g, const Sched& S, const Epi& E) {
    const int tid = pg8_otid(), wid = __builtin_amdgcn_readfirstlane(tid >> 6), lane = tid & 63, wr = wid >> 2, wc = wid & 3, fr = lane & 15, fq = lane >> 4;
    const int K = g.K, nt = K / BK;
    unsigned voffA[2], voffB[2];
#pragma unroll
    for (int i = 0; i < 2; ++i) { int R, C; stage_rc(tid * 16 + i * 8192, R, C); const int Rb = Epi::PERM ? ((R & ~31) + perm32(R & 31)) : R;
        voffA[i] = (unsigned)(R * K + C) * 2u; voffB[i] = (unsigned)(Rb * K + C) * 2u; }
    const size_t kstep = (size_t)(BK * 2);
    const size_t hstep = (size_t)HALF * K * 2;
    const size_t tstep = 2 * hstep;
    const unsigned ldsw = (unsigned)wid * 1024u;
    const int aoff = lds_byte(wr * 64 + fr, fq * 8), boff = lds_byte(wc * 32 + fr, fq * 8);
#define PG8_SA(b, h) (((b) * 2 + (h)) * HTB)
#define PG8_SB(b, h) ((4 + (b) * 2 + (h)) * HTB)
#define PG8_STAGE(bufoff, gbase, voff) do { _Pragma("unroll") for (int _i = 0; _i < 2; ++_i) \
        __builtin_amdgcn_global_load_lds((const unsigned*)((const char*)(gbase) + (voff)[_i]), (PG8_LAS unsigned*)(lds + (bufoff) + ldsw + _i * 8192), 16, 0, 0); } while (0)
#define PG8_LDA(dst, b, h) do { _Pragma("unroll") for (int m = 0; m < 4; ++m) _Pragma("unroll") for (int k = 0; k < 2; ++k) dst[m][k] = *(const PG8_LAS bf16x8*)(lds + PG8_SA(b, h) + aoff + m * 2048 + k * 1024); } while (0)
#define PG8_LDB(dst, b, h) do { _Pragma("unroll") for (int n = 0; n < 2; ++n) _Pragma("unroll") for (int k = 0; k < 2; ++k) dst[n][k] = *(const PG8_LAS bf16x8*)(lds + PG8_SB(b, h) + boff + n * 2048 + k * 1024); } while (0)
#define PG8_MMA(ai, bj, At, Bt) do { __builtin_amdgcn_s_setprio(1); _Pragma("unroll") for (int m = 0; m < 4; ++m) _Pragma("unroll") for (int n = 0; n < 2; ++n) _Pragma("unroll") for (int k = 0; k < 2; ++k) \
        acc[ai][bj][m][n] = __builtin_amdgcn_mfma_f32_16x16x32_bf16(Bt[n][k], At[m][k], acc[ai][bj][m][n], 0, 0, 0); __builtin_amdgcn_s_setprio(0); } while (0)
#define PG8_WAIT_V(n) asm volatile("s_waitcnt vmcnt(" #n ")" ::: "memory")
#define PG8_WAIT_L(n) asm volatile("s_waitcnt lgkmcnt(" #n ")" ::: "memory")
#define PG8_BAR __builtin_amdgcn_s_barrier()
#define PG8_SCHED __builtin_amdgcn_sched_barrier(0)
    Unit cur, nxt; int ui = 0;
    if (!S.next(0, cur)) return;
    f32x4 acc[2][2][4][2];
#pragma unroll
    for (int a = 0; a < 2; ++a)
#pragma unroll
        for (int b = 0; b < 2; ++b)
#pragma unroll
            for (int m = 0; m < 4; ++m)
#pragma unroll
                for (int n = 0; n < 2; ++n) acc[a][b][m][n] = (f32x4){0.f, 0.f, 0.f, 0.f};
    bf16x8 At[4][2], B0[2][2], B1[2][2];
    const char* cA = (const char*)g.A + (size_t)cur.pm * tstep + (size_t)cur.kp * (K / cur.np) * 2; const char* cB = (const char*)g.Bt + (size_t)cur.pn * tstep + (size_t)cur.kp * (K / cur.np) * 2;
    S.a_ready(cur);
    if constexpr (SP2) {
        PG8_STAGE(PG8_SB(0, 0), cB, voffB); PG8_STAGE(PG8_SB(0, 1), cB + hstep, voffB); PG8_STAGE(PG8_SA(0, 0), cA, voffA); PG8_STAGE(PG8_SA(0, 1), cA + hstep, voffA);
        if (wr == 1) PG8_BAR;
        PG8_WAIT_V(2); PG8_BAR;
        PG8_STAGE(PG8_SB(1, 0), cB + kstep, voffB); PG8_STAGE(PG8_SA(1, 0), cA + kstep, voffA); PG8_STAGE(PG8_SB(1, 1), cB + hstep + kstep, voffB);
        PG8_WAIT_V(6); PG8_BAR;
    } else {
        PG8_STAGE(PG8_SB(0, 0), cB, voffB); PG8_STAGE(PG8_SA(0, 0), cA, voffA); PG8_STAGE(PG8_SB(0, 1), cB + hstep, voffB); PG8_STAGE(PG8_SA(0, 1), cA + hstep, voffA);
        if (wr == 1) PG8_BAR;
        PG8_WAIT_V(4); PG8_BAR;
        PG8_STAGE(PG8_SB(1, 0), cB + kstep, voffB); PG8_STAGE(PG8_SA(1, 0), cA + kstep, voffA); PG8_STAGE(PG8_SB(1, 1), cB + hstep + kstep, voffB);
        PG8_WAIT_V(6); PG8_BAR;
    }
    for (;;) {
        const bool has_next = S.next(ui + 1, nxt);
        const size_t nko = has_next ? (size_t)nxt.kp * (K / nxt.np) * 2 : 0; const char* nA = has_next ? (const char*)g.A + (size_t)nxt.pm * tstep + nko : cA; const char* nB = has_next ? (const char*)g.Bt + (size_t)nxt.pn * tstep + nko : cB;
        const int ntc = nt / cur.np;
        for (int t = 0; t < ntc; t += 2) {
            const bool last = (t == ntc - 2);
            const char* a1 = cA + (size_t)(t + 1) * kstep;
            const char* a2 = last ? nA : cA + (size_t)(t + 2) * kstep; const char* b2 = last ? nB : cB + (size_t)(t + 2) * kstep;
            const char* a3 = a2 + kstep; const char* b3 = b2 + kstep;
            if (last && has_next) S.a_ready(nxt);
            if constexpr (SP2) {
            PG8_LDB(B0, 0, 0); PG8_LDB(B1, 0, 1); PG8_SCHED; PG8_LDA(At, 0, 0); PG8_STAGE(PG8_SA(1, 1), a1 + hstep, voffA);
            PG8_WAIT_V(8); PG8_WAIT_L(0); PG8_BAR; PG8_MMA(0, 0, At, B0); PG8_MMA(0, 1, At, B1); PG8_BAR; PG8_SCHED;
            PG8_LDA(At, 0, 1); PG8_STAGE(PG8_SB(0, 0), b2, voffB); PG8_STAGE(PG8_SB(0, 1), b2 + hstep, voffB); PG8_STAGE(PG8_SA(0, 0), a2, voffA);
            PG8_WAIT_V(8); PG8_WAIT_L(0); PG8_BAR; PG8_MMA(1, 0, At, B0); PG8_MMA(1, 1, At, B1); PG8_BAR; PG8_SCHED;
            PG8_LDB(B0, 1, 0); PG8_LDB(B1, 1, 1); PG8_SCHED; PG8_LDA(At, 1, 0); PG8_STAGE(PG8_SA(0, 1), a2 + hstep, voffA);
            PG8_WAIT_V(8); PG8_WAIT_L(0); PG8_BAR; PG8_MMA(0, 0, At, B0); PG8_MMA(0, 1, At, B1); PG8_BAR; PG8_SCHED;
            PG8_LDA(At, 1, 1); PG8_STAGE(PG8_SB(1, 0), b3, voffB); PG8_STAGE(PG8_SB(1, 1), b3 + hstep, voffB); PG8_STAGE(PG8_SA(1, 0), a3, voffA);
            PG8_WAIT_V(8); PG8_WAIT_L(0); PG8_BAR; PG8_MMA(1, 0, At, B0); PG8_MMA(1, 1, At, B1); PG8_BAR; PG8_SCHED;
            } else {
            PG8_LDB(B0, 0, 0); PG8_SCHED; PG8_LDA(At, 0, 0); PG8_STAGE(PG8_SA(1, 1), a1 + hstep, voffA);
            PG8_WAIT_L(8); PG8_BAR; PG8_WAIT_L(0); PG8_MMA(0, 0, At, B0); PG8_BAR; PG8_SCHED;
            PG8_LDB(B1, 0, 1); PG8_STAGE(PG8_SB(0, 0), b2, voffB);
            PG8_BAR; PG8_WAIT_L(0); PG8_MMA(0, 1, At, B1); PG8_BAR;
            PG8_LDA(At, 0, 1); PG8_STAGE(PG8_SA(0, 0), a2, voffA);
            PG8_BAR; PG8_WAIT_L(0); PG8_MMA(1, 0, At, B0); PG8_BAR; PG8_SCHED;
            PG8_STAGE(PG8_SB(0, 1), b2 + hstep, voffB);
            PG8_WAIT_V(6); PG8_BAR; PG8_MMA(1, 1, At, B1); PG8_BAR;
            PG8_LDB(B0, 1, 0); PG8_SCHED; PG8_LDA(At, 1, 0); PG8_STAGE(PG8_SA(0, 1), a2 + hstep, voffA);
            PG8_WAIT_L(8); PG8_BAR; PG8_WAIT_L(0); PG8_MMA(0, 0, At, B0); PG8_BAR; PG8_SCHED;
            PG8_LDB(B1, 1, 1); PG8_STAGE(PG8_SB(1, 0), b3, voffB);
            PG8_BAR; PG8_WAIT_L(0); PG8_MMA(0, 1, At, B1); PG8_BAR;
            PG8_LDA(At, 1, 1); PG8_STAGE(PG8_SA(1, 0), a3, voffA);
            PG8_BAR; PG8_WAIT_L(0); PG8_MMA(1, 0, At, B0); PG8_BAR; PG8_SCHED;
            PG8_STAGE(PG8_SB(1, 1), b3 + hstep, voffB);
            PG8_WAIT_V(6); PG8_BAR; PG8_MMA(1, 1, At, B1); PG8_BAR;
            }
        }
        if constexpr (ALIGN_EPI) { if (wr == 0) PG8_BAR; }
        if constexpr (!Epi::AFTER_DRAIN) { E(acc, cur, wr, wc, fr, fq); S.done(cur); }
        if (!has_next) break;
#pragma unroll
        for (int a = 0; a < 2; ++a)
#pragma unroll
            for (int b = 0; b < 2; ++b)
#pragma unroll
                for (int m = 0; m < 4; ++m)
#pragma unroll
                    for (int n = 0; n < 2; ++n) acc[a][b][m][n] = (f32x4){0.f, 0.f, 0.f, 0.f};
        cur = nxt; cA = nA; cB = nB; ++ui;
        if constexpr (ALIGN_EPI) { if (wr == 1) PG8_BAR; }
    }
    PG8_WAIT_V(0);
    if constexpr (!ALIGN_EPI) { if (wr == 0) PG8_BAR; }
    PG8_BAR;
    if constexpr (Epi::AFTER_DRAIN) { E.fused(acc, cur, wr, wc, fr, fq, lds, wid, lane); S.done(cur); }
#undef PG8_SA
#undef PG8_SB
#undef PG8_STAGE
#undef PG8_LDA
#undef PG8_LDB
#undef PG8_MMA
#undef PG8_WAIT_V
#undef PG8_WAIT_L
#undef PG8_BAR
#undef PG8_SCHED
}
}

#define LAS __attribute__((address_space(3)))
typedef unsigned short bf16_t;
typedef short bf16x8 __attribute__((ext_vector_type(8)));
typedef short s16x4 __attribute__((ext_vector_type(4)));
typedef float f32x4 __attribute__((ext_vector_type(4)));
typedef float f32x16 __attribute__((ext_vector_type(16)));
typedef unsigned u32x4 __attribute__((ext_vector_type(4)));
typedef unsigned u32x2 __attribute__((ext_vector_type(2)));


__device__ __forceinline__ int otid() { int t = threadIdx.x; asm volatile("" : "+v"(t)); return t; }
__device__ __forceinline__ unsigned ozero() { unsigned z = 0u; asm volatile("" : "+v"(z)); return z; }
__device__ __forceinline__ int obid() { int b = blockIdx.x; asm volatile("" : "+s"(b)); return b; }
constexpr int NWAVES = 8, NTHR = 512;
constexpr int DM = 2048, MC = 4096, ML = 8192, MROWS = 12288, MKROWS = 13312;
constexpr int LDP_AB = 7168, LDP_C = 5120;
constexpr int COL_QL = 0, COL_KVL = 512, COL_AG = 768, COL_BQ = 1792, COL_FF = 2816, COL_FB = 3840, COL_BI = 4864, COL_BG = 5888, COL_KPE = 6912;
constexpr float EPSN = 1e-6f;
constexpr float LOG2E = 1.4426950408889634f;
constexpr float QSC_A = 0.07216878364870322f * LOG2E;
constexpr float QSC_C = 0.08838834764831845f * LOG2E;

constexpr size_t O_YP = 0, O_YS = 8388608, O_CKV = 25165824, O_KPE = 27262976, O_SF = 27787264, O_SB = 31981568, O_KC = 36175872, O_VC = 40370176;

constexpr size_t MiB = 1u << 20;
constexpr size_t WS_CTL = 0, CTL_BYTES = 131072;
constexpr size_t WS_MOD = 1 * MiB, WS_LB = WS_MOD + 512 * 1024, WS_ROPEA = WS_LB + 64 * 1024, WS_ROPEC = WS_ROPEA + 512 * 1024;
constexpr size_t WS_KCC = 532 * MiB;
constexpr size_t WS_WINAB = 8 * MiB, WS_WQUP = 64 * MiB, WS_WKVUP = 67 * MiB, WS_WOUTAB = 69 * MiB, WS_WINC = 85 * MiB, WS_WOUTC = 125 * MiB;
constexpr size_t WS_H = 141 * MiB, WS_PROJ = 189 * MiB, WS_QRAW = 357 * MiB, WS_KVRAW = 393 * MiB, WS_KF = 445 * MiB, WS_OF = 484 * MiB, WS_OB = 508 * MiB;
constexpr size_t WS_QN = WS_H, WS_CKV = WS_H + 12 * MiB, WS_END = 552 * MiB;
constexpr size_t WS_SBUF = 4 * MiB;
constexpr int NBG = 64;

constexpr int LDS_PHASE = 131072, LDS_BYTES = LDS_PHASE + 1024;

__device__ __forceinline__ float bf2f(unsigned short b) { return __uint_as_float((unsigned)b << 16); }
typedef float f32x2_t __attribute__((ext_vector_type(2)));
typedef __bf16 bf16x2_t __attribute__((ext_vector_type(2)));
__device__ __forceinline__ unsigned pk2(float lo, float hi) { const f32x2_t v = {lo, hi}; const bf16x2_t b = __builtin_convertvector(v, bf16x2_t); return __builtin_bit_cast(unsigned, b); }
__device__ __forceinline__ unsigned f2bf(float f) { return pk2(f, 0.f) & 0xffffu; }
__device__ __forceinline__ float silu_f(float x) { return x * __builtin_amdgcn_rcpf(1.f + __expf(-x)); }
__device__ __forceinline__ float wave_sum(float v) {
#pragma unroll
    for (int o = 1; o < 64; o <<= 1) v += __shfl_xor(v, o);
    return v;
}
__device__ __forceinline__ float sum16(float v) {
    v += __shfl_xor(v, 1); v += __shfl_xor(v, 2); v += __shfl_xor(v, 4); v += __shfl_xor(v, 8); return v;
}
__device__ __forceinline__ bf16x8 pack8(const float* v) {
    u32x4 w; w.x = pk2(v[0], v[1]); w.y = pk2(v[2], v[3]); w.z = pk2(v[4], v[5]); w.w = pk2(v[6], v[7]); return __builtin_bit_cast(bf16x8, w);
}

struct Args { const float* in[31]; float* out; unsigned char* ws; };
typedef const Args __attribute__((address_space(4)))* KArgs;

struct P0Item { const float* W; bf16_t* WT; int K, N, k0, n0, d0; };
__device__ __forceinline__ void p0_load(const P0Item& q, float (&v)[32], int lane) {
#pragma unroll
    for (int i = 0; i < 32; ++i) { const int kk = 2 * i + (lane >> 5); v[i] = q.W[(size_t)(q.k0 + kk) * q.N + q.n0 + (lane & 31)]; }
}
__device__ __forceinline__ void p0_emit(const P0Item& q, const float (&v)[32], LAS float* scr, int lane) {
#pragma unroll
    for (int i = 0; i < 32; ++i) { const int kk = 2 * i + (lane >> 5); scr[kk * 33 + (lane & 31)] = v[i]; }
    asm volatile("s_waitcnt lgkmcnt(0)" ::: "memory");
    const int c = lane & 7;
#pragma unroll
    for (int j = 0; j < 4; ++j) { const int n = (lane >> 3) + 8 * j; const LAS float* s = scr + (8 * c) * 33 + n;
        u32x4 o; o.x = pk2(s[0 * 33], s[1 * 33]); o.y = pk2(s[2 * 33], s[3 * 33]); o.z = pk2(s[4 * 33], s[5 * 33]); o.w = pk2(s[6 * 33], s[7 * 33]);
        *(u32x4*)(q.WT + (size_t)(q.d0 + n) * q.K + q.k0 + 8 * c) = o; }
    asm volatile("s_waitcnt lgkmcnt(0)" ::: "memory");
}
__device__ __forceinline__ P0Item p0_decode(KArgs a, int it) {
    constexpr int I_INAB = 32 * 218, I_QUP = 8 * 48, I_KVUP = 4 * 64, I_OUT = 32 * 64, I_INC = 32 * 160;
    constexpr int PER_J = I_INAB + I_QUP + I_KVUP + I_OUT + I_INC + I_OUT;
    unsigned char* ws = a->ws; P0Item q;
    const int j = it / PER_J; int r = it % PER_J;
    if (r < I_INAB) { const int kb = r / 218, nb = r % 218, n0 = nb * 32;
        q.W = a->in[13] + (size_t)j * 2048 * 6976; q.WT = (bf16_t*)(ws + WS_WINAB) + (size_t)j * 7168 * 2048; q.K = 2048; q.N = 6976; q.k0 = kb * 64; q.n0 = n0; q.d0 = n0 < 768 ? n0 : (n0 < 832 ? n0 + 6144 : n0 - 64); return q; }
    r -= I_INAB;
    if (r < I_QUP) { const int kb = r / 48, nb = r % 48;
        q.W = a->in[16] + (size_t)j * 512 * 1536; q.WT = (bf16_t*)(ws + WS_WQUP) + (size_t)j * 1536 * 512; q.K = 512; q.N = 1536; q.k0 = kb * 64; q.n0 = nb * 32; q.d0 = nb * 32; return q; }
    r -= I_QUP;
    if (r < I_KVUP) { const int kb = r / 64, nb = r % 64;
        q.W = a->in[17] + (size_t)j * 256 * 2048; q.WT = (bf16_t*)(ws + WS_WKVUP) + (size_t)j * 2048 * 256; q.K = 256; q.N = 2048; q.k0 = kb * 64; q.n0 = nb * 32; q.d0 = nb * 32; return q; }
    r -= I_KVUP;
    if (r < I_OUT) { const int kb = r / 64, nb = r % 64;
        q.W = a->in[22] + (size_t)j * 2048 * 2048; q.WT = (bf16_t*)(ws + WS_WOUTAB) + (size_t)j * 2048 * 2048; q.K = 2048; q.N = 2048; q.k0 = kb * 64; q.n0 = nb * 32; q.d0 = nb * 32; return q; }
    r -= I_OUT;
    if (r < I_INC) { const int kb = r / 160, nb = r % 160;
        q.W = a->in[26] + (size_t)j * 2048 * 5120; q.WT = (bf16_t*)(ws + WS_WINC) + (size_t)j * 5120 * 2048; q.K = 2048; q.N = 5120; q.k0 = kb * 64; q.n0 = nb * 32; q.d0 = nb * 32; return q; }
    r -= I_INC;
    { const int kb = r / 64, nb = r % 64;
        q.W = a->in[30] + (size_t)j * 2048 * 2048; q.WT = (bf16_t*)(ws + WS_WOUTC) + (size_t)j * 2048 * 2048; q.K = 2048; q.N = 2048; q.k0 = kb * 64; q.n0 = nb * 32; q.d0 = nb * 32; return q; }
}

__device__ __forceinline__ void p0_transposes(KArgs a, LAS unsigned char* lds, int lo, int hi, int w, int NW) {
    const int lane = otid() & 63, wave = (otid() >> 6);
    LAS float* scr = (LAS float*)(lds + wave * 8448);
    for (int it = lo + w; it < hi; it += 2 * NW) {
        const bool two = it + NW < hi;
        const P0Item qa = p0_decode(a, it); const P0Item qb = p0_decode(a, two ? it + NW : it);
        float va[32], vb[32];
        p0_load(qa, va, lane); if (two) p0_load(qb, vb, lane);
        p0_emit(qa, va, scr, lane); if (two) p0_emit(qb, vb, scr, lane);
    }
}
constexpr int P0_EARLY = 32 * 218 + 8 * 48 + 4 * 64 + 32 * 64;
constexpr int P0_TOTAL = 2 * (32 * 218 + 8 * 48 + 4 * 64 + 32 * 64 + 32 * 160 + 32 * 64);
__device__ __forceinline__ void phase_p0(KArgs a, LAS unsigned char* lds) {
    const int tid = otid(), lane = tid & 63, wave = tid >> 6;
    const int G = gridDim.x, bid = obid();
    const int gw = bid * NWAVES + wave, NGW = G * NWAVES;
    unsigned char* ws = a->ws;
    p0_transposes(a, lds, 0, P0_EARLY, gw, NGW);
    p0_transposes(a, lds, P0_EARLY + 16000, P0_TOTAL, gw, NGW);
    const int gt = bid * NTHR + tid, NGT = G * NTHR;
    const unsigned zz = ozero();
    for (int i = gt; i < 2 * 192 * 256; i += NGT) { const int j = i / (192 * 256), r = i % (192 * 256);
        *(u32x4*)((bf16_t*)(ws + WS_WINAB) + (size_t)j * 7168 * 2048 + (size_t)6976 * 2048 + (size_t)r * 8) = (u32x4){zz, zz, zz, zz}; }
    for (int i = gt; i < 2 * 131072; i += NGT) { const int which = i / 131072, e = (i % 131072) * 8;
        const float* src = a->in[6 + which] + e; const f32x4 x0 = *(const f32x4*)src, x1 = *(const f32x4*)(src + 4);
        u32x4 w; w.x = pk2(x0[0], x0[1]); w.y = pk2(x0[2], x0[3]); w.z = pk2(x1[0], x1[1]); w.w = pk2(x1[2], x1[3]);
        *(u32x4*)((bf16_t*)(ws + WS_KCC) + (size_t)(e >> 9) * LDP_C + (which ? 512 : 0) + (e & 511)) = w; }
    for (int i = gt; i < 2 * 2048; i += NGT) { const int j = i / 2048, r = i % 2048; const float l0 = a->in[20][r], l1 = a->in[20][2048 + r];
        ((float*)(ws + WS_LB))[i] = j == 0 ? 0.f : 1.f / (1.f + __expf(l0 - l1)); }
    for (int i = gt; i < 2048 * 32; i += NGT) { const int t = i >> 5, f = i & 31; const float pos = f < 16 ? (float)(t >> 6) : (float)(t & 63);
        const float inv = exp2f(-(float)(f & 15) * (13.287712379549449f / 16.f)); const float ang = pos * inv;
        ((float*)(ws + WS_ROPEA))[2 * i] = __cosf(ang); ((float*)(ws + WS_ROPEA))[2 * i + 1] = __sinf(ang); }
    for (int i = gt; i < 2048 * 64; i += NGT) { const int t = i >> 6, f = i & 63; const float pos = f < 32 ? (float)(t >> 6) : (float)(t & 63);
        const float inv = exp2f(-(float)(f & 31) * (13.287712379549449f / 32.f)); const float ang = pos * inv;
        ((float*)(ws + WS_ROPEC))[2 * i] = __cosf(ang); ((float*)(ws + WS_ROPEC))[2 * i + 1] = __sinf(ang); }
    __syncthreads();
    {
        LAS float* SC = (LAS float*)lds;
        LAS float* RED = (LAS float*)(lds + 40960);
        for (int i = tid; i < 5 * 2048; i += NTHR) { const int b = i >> 11, k = i & 2047; const float x = b < 4 ? a->in[8][b * 2048 + k] : a->in[9][k]; SC[i] = silu_f(x); }
        __syncthreads();
        const int cq = tid & 7, ks = tid >> 3;
        for (int u = bid; u < 768; u += G) {
            const int L = u / 192, col0 = (u % 192) * 32;
            const float* W = ((L & 1) ? a->in[23] : a->in[10]) + (size_t)(L >> 1) * 2048 * 6144;
            const float* bias = ((L & 1) ? a->in[24] : a->in[11]) + (size_t)(L >> 1) * 6144;
            f32x4 acc[5];
#pragma unroll
            for (int b = 0; b < 5; ++b) acc[b] = (f32x4){0.f, 0.f, 0.f, 0.f};
#pragma unroll 16
            for (int kk = 0; kk < 32; ++kk) { const int k = 32 * ks + kk; const f32x4 w = *(const f32x4*)(W + (size_t)k * 6144 + col0 + 4 * cq);
#pragma unroll
                for (int b = 0; b < 5; ++b) acc[b] += SC[b * 2048 + k] * w; }
#pragma unroll
            for (int b = 0; b < 5; ++b) *(LAS f32x4*)(RED + (ks * 5 + b) * 32 + 4 * cq) = acc[b];
            __syncthreads();
            if (tid < 160) { const int b = tid >> 5, c = tid & 31; float s = 0.f;
                for (int q = 0; q < 64; ++q) s += RED[(q * 5 + b) * 32 + c];
                ((float*)(ws + WS_MOD))[(L * 5 + b) * 6144 + col0 + c] = s + bias[col0 + c]; }
            __syncthreads();
        }
    }
}

__device__ __forceinline__ void phase_modnorm(KArgs a, int L) {
    const int tid = otid(), lane = tid & 63, wave = tid >> 6;
    const int gw = obid() * NWAVES + wave, NGW = gridDim.x * NWAVES;
    const float* g = ((L & 1) ? a->in[25] : a->in[12]) + (L >> 1) * 2048;
    bf16_t* H = (bf16_t*)(a->ws + WS_H);
    for (int r0 = gw * 2; r0 < MROWS; r0 += NGW * 2) {
        f32x4 v[2][8]; float ss[2] = {0.f, 0.f};
#pragma unroll
        for (int u = 0; u < 2; ++u) { const int r = r0 + u;
            const float* x = L <= 1 ? (r < MC ? a->in[0] + (size_t)r * DM : a->in[1] + (size_t)(r - MC) * DM) : a->out + (size_t)r * DM;
#pragma unroll
            for (int j = 0; j < 8; ++j) v[u][j] = *(const f32x4*)(x + 256 * j + 4 * lane);
            if (L > 0) { const bf16_t* dp = (const bf16_t*)(a->ws + WS_PROJ) + (size_t)r * DM;
#pragma unroll
                for (int j = 0; j < 8; ++j) { const u32x2 dv = *(const u32x2*)(dp + 256 * j + 4 * lane);
                    v[u][j][0] += __uint_as_float(dv.x << 16); v[u][j][1] += __uint_as_float(dv.x & 0xffff0000u); v[u][j][2] += __uint_as_float(dv.y << 16); v[u][j][3] += __uint_as_float(dv.y & 0xffff0000u);
                    *(f32x4*)(a->out + (size_t)r * DM + 256 * j + 4 * lane) = v[u][j]; } } }
#pragma unroll
        for (int u = 0; u < 2; ++u) {
#pragma unroll
            for (int j = 0; j < 8; ++j) ss[u] += (v[u][j][0] * v[u][j][0] + v[u][j][1] * v[u][j][1]) + (v[u][j][2] * v[u][j][2] + v[u][j][3] * v[u][j][3]); }
#pragma unroll
        for (int u = 0; u < 2; ++u) { const int r = r0 + u;
            const int ci = r < MC ? 4 : ((r - MC) >> 11);
            const float* md = (const float*)(a->ws + WS_MOD) + (L * 5 + ci) * 6144;
            const float rstd = rsqrtf(wave_sum(ss[u]) * (1.f / 2048.f) + EPSN);
#pragma unroll
            for (int j = 0; j < 8; ++j) { const int c = 256 * j + 4 * lane;
                const f32x4 gg = *(const f32x4*)(g + c), sh = *(const f32x4*)(md + c), sc = *(const f32x4*)(md + 2048 + c);
                const f32x4 y = (v[u][j] * rstd * gg) * (sc + 1.f) + sh;
                u32x2 w; w.x = pk2(y[0], y[1]); w.y = pk2(y[2], y[3]);
                *(u32x2*)(H + (size_t)r * DM + c) = w; } }
    }
}

__device__ __forceinline__ void phase_final(KArgs a) {
    const int tid = otid();
    const int gt = obid() * NTHR + tid, NGT = gridDim.x * NTHR;
    const bf16_t* D = (const bf16_t*)(a->ws + WS_PROJ); float* out = a->out;
    for (int i = gt; i < MROWS * DM / 8; i += NGT) { const size_t e = (size_t)i * 8;
        const bf16x8 dv = *(const bf16x8*)(D + e); f32x4 x0 = *(const f32x4*)(out + e), x1 = *(const f32x4*)(out + e + 4);
        x0[0] += bf2f((unsigned short)dv[0]); x0[1] += bf2f((unsigned short)dv[1]); x0[2] += bf2f((unsigned short)dv[2]); x0[3] += bf2f((unsigned short)dv[3]);
        x1[0] += bf2f((unsigned short)dv[4]); x1[1] += bf2f((unsigned short)dv[5]); x1[2] += bf2f((unsigned short)dv[6]); x1[3] += bf2f((unsigned short)dv[7]);
        *(f32x4*)(out + e) = x0; *(f32x4*)(out + e + 4) = x1; }
}

__device__ __forceinline__ void phase_prep_ab(KArgs a, int j, int wg, int nwg) {
    const int tid = otid(), lane = tid & 63, wave = tid >> 6;
    const int gw = wg * NWAVES + wave, NGW = nwg * NWAVES;
    const bf16_t* P = (const bf16_t*)(a->ws + WS_PROJ);
    bf16_t* QN = (bf16_t*)(a->ws + WS_QN); bf16_t* CKV = (bf16_t*)(a->ws + WS_CKV);
    const float* gq = a->in[14] + j * 512; const float* gkv = a->in[15] + j * 256;
    for (int r = gw; r < MKROWS; r += NGW) {
        if (r < MROWS) {
            const bf16_t* p = P + (size_t)r * LDP_AB;
            const bf16x8 q = *(const bf16x8*)(p + COL_QL + 8 * lane);
            float qv[8]; float ss = 0.f;
#pragma unroll
            for (int e = 0; e < 8; ++e) { qv[e] = bf2f((unsigned short)q[e]); ss += qv[e] * qv[e]; }
            const float rq = rsqrtf(wave_sum(ss) * (1.f / 512.f) + EPSN);
#pragma unroll
            for (int e = 0; e < 8; ++e) qv[e] = qv[e] * rq * gq[8 * lane + e];
            *(bf16x8*)(QN + (size_t)r * 512 + 8 * lane) = pack8(qv);
            const s16x4 kv = *(const s16x4*)(p + COL_KVL + 4 * lane);
            float kf[4]; float s2 = 0.f;
#pragma unroll
            for (int e = 0; e < 4; ++e) { kf[e] = bf2f((unsigned short)kv[e]); s2 += kf[e] * kf[e]; }
            const float rk = rsqrtf(wave_sum(s2) * (1.f / 256.f) + EPSN);
#pragma unroll
            for (int e = 0; e < 4; ++e) kf[e] = kf[e] * rk * gkv[4 * lane + e];
            u32x2 w; w.x = pk2(kf[0], kf[1]); w.y = pk2(kf[2], kf[3]);
            *(u32x2*)(CKV + (size_t)r * 256 + 4 * lane) = w;
            if (r < MC) { const int b = r >> 8, t = r & 255; const size_t rowo = (size_t)((b * 2 + j) * 256 + t);
                *(f32x4*)(a->out + O_CKV + rowo * 256 + 4 * lane) = (f32x4){kf[0], kf[1], kf[2], kf[3]};
                a->out[O_KPE + rowo * 64 + lane] = bf2f(p[COL_KPE + lane]); }
        } else {
            const int rr = r - MROWS, b = rr >> 8, t = rr & 255;
            const f32x4 x = *(const f32x4*)(a->in[2] + (size_t)((b * 2 + j) * 256 + t) * 256 + 4 * lane);
            u32x2 w; w.x = pk2(x[0], x[1]); w.y = pk2(x[2], x[3]);
            *(u32x2*)(CKV + (size_t)r * 256 + 4 * lane) = w;
        }
    }
}

__device__ __forceinline__ void phase_hn_ab(KArgs a, int j, int wg, int nwg) {
    const int tid = otid(), lane = tid & 63, wave = tid >> 6, sub = lane & 15, hq = lane >> 4;
    const int gw = wg * NWAVES + wave, NGW = nwg * NWAVES;
    bf16_t* Q = (bf16_t*)(a->ws + WS_QRAW); const bf16_t* KV = (const bf16_t*)(a->ws + WS_KVRAW); bf16_t* KF = (bf16_t*)(a->ws + WS_KF);
    const bf16_t* P = (const bf16_t*)(a->ws + WS_PROJ);
    const float* RA = (const float*)(a->ws + WS_ROPEA);
    const float* gq = a->in[18] + j * 192; const float* gk = a->in[19] + j * 192;
    const float* ckpe = a->in[3];
    constexpr int U = 4;
    const int NQ = 0, NIT = MKROWS * 2;
    for (int base = gw * U; base < NIT; base += NGW * U) {
        bf16x8 vn[U]; float x1[U][2], x2[U][2]; f32x4 cs[U];
#pragma unroll
        for (int u = 0; u < U; ++u) { const int it = base + u; if (it < NIT) {
            const bool isq = it < NQ; const int w = isq ? it : it - NQ; const int r = w >> 1, h = (w & 1) * 4 + hq;
            if (isq) { const bf16_t* p = Q + (size_t)r * 1536 + h * 192;
                vn[u] = *(const bf16x8*)(p + 8 * sub); const unsigned a1 = *(const unsigned*)(p + 128 + 2 * sub), a2 = *(const unsigned*)(p + 160 + 2 * sub);
                x1[u][0] = bf2f(a1 & 0xffff); x1[u][1] = bf2f(a1 >> 16); x2[u][0] = bf2f(a2 & 0xffff); x2[u][1] = bf2f(a2 >> 16);
            } else { vn[u] = *(const bf16x8*)(KV + (size_t)r * 2048 + h * 256 + 8 * sub);
                if (r < MROWS) { const bf16_t* pe = P + (size_t)r * LDP_AB + COL_KPE; const unsigned a1 = *(const unsigned*)(pe + 2 * sub), a2 = *(const unsigned*)(pe + 32 + 2 * sub);
                    x1[u][0] = bf2f(a1 & 0xffff); x1[u][1] = bf2f(a1 >> 16); x2[u][0] = bf2f(a2 & 0xffff); x2[u][1] = bf2f(a2 >> 16); }
                else { const int rr = r - MROWS, b = rr >> 8, t = rr & 255; const float* pe = ckpe + (size_t)((b * 2 + j) * 256 + t) * 64;
                    x1[u][0] = pe[2 * sub]; x1[u][1] = pe[2 * sub + 1]; x2[u][0] = pe[32 + 2 * sub]; x2[u][1] = pe[32 + 2 * sub + 1]; } }
            if (r >= MC && r < MROWS) cs[u] = *(const f32x4*)(RA + (((r - MC) & 2047) * 32 + 2 * sub) * 2);
        } }
#pragma unroll
        for (int u = 0; u < U; ++u) { const int it = base + u; if (it < NIT) {
            const bool isq = it < NQ; const int w = isq ? it : it - NQ; const int r = w >> 1, h = (w & 1) * 4 + hq;
            float xn[8];
#pragma unroll
            for (int e = 0; e < 8; ++e) xn[e] = bf2f((unsigned short)vn[u][e]);
            float ss = x1[u][0] * x1[u][0] + x1[u][1] * x1[u][1] + x2[u][0] * x2[u][0] + x2[u][1] * x2[u][1];
#pragma unroll
            for (int e = 0; e < 8; ++e) ss += xn[e] * xn[e];
            const float rstd = rsqrtf(sum16(ss) * (1.f / 192.f) + EPSN);
            const float* g = isq ? gq : gk;
#pragma unroll
            for (int e = 0; e < 8; ++e) xn[e] = xn[e] * rstd * g[8 * sub + e];
            float y1[2], y2[2];
            y1[0] = x1[u][0] * rstd * g[128 + 2 * sub]; y1[1] = x1[u][1] * rstd * g[128 + 2 * sub + 1]; y2[0] = x2[u][0] * rstd * g[160 + 2 * sub]; y2[1] = x2[u][1] * rstd * g[160 + 2 * sub + 1];
            if (r >= MC && r < MROWS) {
#pragma unroll
                for (int q = 0; q < 2; ++q) { const float c = cs[u][2 * q], sn = cs[u][2 * q + 1];
                    const float z1 = y1[q] * c - y2[q] * sn, z2 = y1[q] * sn + y2[q] * c; y1[q] = z1; y2[q] = z2; } }
            bf16_t* p;
            if (isq) {
#pragma unroll
                for (int e = 0; e < 8; ++e) xn[e] *= QSC_A;
                y1[0] *= QSC_A; y1[1] *= QSC_A; y2[0] *= QSC_A; y2[1] *= QSC_A;
                p = Q + (size_t)r * 1536 + h * 192;
            } else p = KF + (size_t)r * 1536 + h * 192;
            *(bf16x8*)(p + 8 * sub) = pack8(xn); *(unsigned*)(p + 128 + 2 * sub) = pk2(y1[0], y1[1]); *(unsigned*)(p + 160 + 2 * sub) = pk2(y2[0], y2[1]);
        } }
    }
}

__device__ __forceinline__ void phase_fin_ab(KArgs a, int j) {
    const int tid = otid(), lane = tid & 63, wave = tid >> 6, sub = lane & 15, hq = lane >> 4;
    const int gw = obid() * NWAVES + wave, NGW = gridDim.x * NWAVES;
    const bf16_t* OF = (const bf16_t*)(a->ws + WS_OF); const bf16_t* OB = (const bf16_t*)(a->ws + WS_OB);
    const bf16_t* P = (const bf16_t*)(a->ws + WS_PROJ); bf16_t* MIX = (bf16_t*)(a->ws + WS_H);
    const float* g = a->in[21] + j * 128;
    constexpr int U = 4;
    for (int base = gw * U; base < MROWS * 2; base += NGW * U) {
        bf16x8 va[U], vb[U], vg[U];
#pragma unroll
        for (int u = 0; u < U; ++u) { const int it = base + u; const int r = it >> 1, h = (it & 1) * 4 + hq; const size_t o = (size_t)r * 1024 + h * 128 + 8 * sub;
            va[u] = *(const bf16x8*)(OF + o); vb[u] = *(const bf16x8*)(OB + o); vg[u] = *(const bf16x8*)(P + (size_t)r * LDP_AB + COL_BG + h * 128 + 8 * sub); }
#pragma unroll
        for (int u = 0; u < U; ++u) { const int it = base + u; const int r = it >> 1, h = (it & 1) * 4 + hq;
            float s[8]; float ss = 0.f;
#pragma unroll
            for (int e = 0; e < 8; ++e) { s[e] = bf2f((unsigned short)va[u][e]) + bf2f((unsigned short)vb[u][e]); ss += s[e] * s[e]; }
            const float rstd = rsqrtf(sum16(ss) * (1.f / 128.f) + EPSN);
#pragma unroll
            for (int e = 0; e < 8; ++e) s[e] = s[e] * rstd * g[8 * sub + e] * silu_f(bf2f((unsigned short)vg[u][e]));
            *(bf16x8*)(MIX + (size_t)r * DM + 1024 + h * 128 + 8 * sub) = pack8(s); }
    }
}

__device__ __forceinline__ void phase_hn_c(KArgs a, int j) {
    const int tid = otid(), lane = tid & 63, wave = tid >> 6, sub = lane & 15, hq = lane >> 4;
    const int gw = obid() * NWAVES + wave, NGW = gridDim.x * NWAVES;
    bf16_t* P = (bf16_t*)(a->ws + WS_PROJ);
    const float* RC = (const float*)(a->ws + WS_ROPEC);
    const float* gq = a->in[27] + j * 128; const float* gk = a->in[28] + j * 128;
    float* outp = a->out;
    for (int r = gw; r < MC; r += NGW) { const int b = r >> 8, t = r & 255; const bf16x8 v = *(const bf16x8*)(P + (size_t)r * LDP_C + 2560 + 8 * lane);
        float* o = outp + O_VC + (size_t)((b * 2 + j) * 256 + t) * 512 + 8 * lane;
        *(f32x4*)o = (f32x4){bf2f((unsigned short)v[0]), bf2f((unsigned short)v[1]), bf2f((unsigned short)v[2]), bf2f((unsigned short)v[3])};
        *(f32x4*)(o + 4) = (f32x4){bf2f((unsigned short)v[4]), bf2f((unsigned short)v[5]), bf2f((unsigned short)v[6]), bf2f((unsigned short)v[7])}; }
    constexpr int U = 4;
    const int NIT = MROWS;
    for (int base = gw * U; base < NIT; base += NGW * U) {
        s16x4 v1[U], v2[U]; f32x4 ca[U], cb[U];
#pragma unroll
        for (int u = 0; u < U; ++u) { const int it = base + u; if (it < NIT) {
            const int r = it, h = 16 + hq; const bool isq = false;
            const bf16_t* p = P + (size_t)r * LDP_C + (isq ? h * 128 : 2048 + (h - 16) * 128);
            v1[u] = *(const s16x4*)(p + 4 * sub); v2[u] = *(const s16x4*)(p + 64 + 4 * sub);
            if (r >= MC) { const float* rc = RC + (((r - MC) & 2047) * 64 + 4 * sub) * 2; ca[u] = *(const f32x4*)rc; cb[u] = *(const f32x4*)(rc + 4); }
        } }
#pragma unroll
        for (int u = 0; u < U; ++u) { const int it = base + u; if (it < NIT) {
            const int r = it, h = 16 + hq; const bool isq = false;
            bf16_t* p = P + (size_t)r * LDP_C + (isq ? h * 128 : 2048 + (h - 16) * 128);
            float x1[4], x2[4]; float ss = 0.f;
#pragma unroll
            for (int e = 0; e < 4; ++e) { x1[e] = bf2f((unsigned short)v1[u][e]); x2[e] = bf2f((unsigned short)v2[u][e]); ss += x1[e] * x1[e] + x2[e] * x2[e]; }
            const float rstd = rsqrtf(sum16(ss) * (1.f / 128.f) + EPSN);
            const float* g = isq ? gq : gk;
#pragma unroll
            for (int e = 0; e < 4; ++e) { x1[e] *= rstd * g[4 * sub + e]; x2[e] *= rstd * g[64 + 4 * sub + e]; }
            if (r >= MC) {
#pragma unroll
                for (int e = 0; e < 4; ++e) { const float c = e < 2 ? ca[u][2 * e] : cb[u][2 * (e - 2)], sn = e < 2 ? ca[u][2 * e + 1] : cb[u][2 * (e - 2) + 1];
                    const float y1 = x1[e] * c - x2[e] * sn, y2 = x1[e] * sn + x2[e] * c; x1[e] = y1; x2[e] = y2; } }
            else if (!isq) { const int b = r >> 8, t = r & 255; float* o = outp + O_KC + (size_t)((b * 2 + j) * 256 + t) * 512 + (h - 16) * 128;
                *(f32x4*)(o + 4 * sub) = (f32x4){x1[0], x1[1], x1[2], x1[3]}; *(f32x4*)(o + 64 + 4 * sub) = (f32x4){x2[0], x2[1], x2[2], x2[3]}; }
            if (isq) {
#pragma unroll
                for (int e = 0; e < 4; ++e) { x1[e] *= QSC_C; x2[e] *= QSC_C; } }
            u32x2 w1, w2; w1.x = pk2(x1[0], x1[1]); w1.y = pk2(x1[2], x1[3]); w2.x = pk2(x2[0], x2[1]); w2.y = pk2(x2[2], x2[3]);
            *(u32x2*)(p + 4 * sub) = w1; *(u32x2*)(p + 64 + 4 * sub) = w2;
        } }
    }
}

namespace att {
__device__ __forceinline__ int crow(int r, int hi) { return (r & 3) + 8 * (r >> 2) + 4 * hi; }
__device__ __forceinline__ unsigned cvtpk(float lo, float hi) { return pk2(lo, hi); }
__device__ __forceinline__ int v_st(int k, int c) { const int kk = (k & ~0xC) | ((k & 4) << 1) | ((k & 8) >> 1); return ((kk >> 3) * 4 + (c >> 5)) * 512 + ((kk & 7) * 32 + (c & 31)) * 2; }
__device__ __forceinline__ int v_rd_base(int lane) { return ((lane & 3) << 3) | (((lane >> 2) & 3) << 6) | (((lane >> 4) & 1) << 5) | (((lane >> 5) & 1) << 8); }
constexpr int v_rd_off(int d0, int ks, int half) { return d0 * 512 + ks * 4096 + half * 2048; }
template <int OFF> __device__ __forceinline__ s16x4 tr_read(int vb) {
    s16x4 r; asm volatile("ds_read_b64_tr_b16 %0, %1 offset:%2" : "=&v"(r) : "v"(vb), "i"(OFF) : "memory"); return r;
}
template <int D0> __device__ __forceinline__ void pv_read8(s16x4 (&r)[8], int vb) {
    r[0] = tr_read<v_rd_off(D0, 0, 0)>(vb); r[1] = tr_read<v_rd_off(D0, 0, 1)>(vb); r[2] = tr_read<v_rd_off(D0, 1, 0)>(vb); r[3] = tr_read<v_rd_off(D0, 1, 1)>(vb);
    r[4] = tr_read<v_rd_off(D0, 2, 0)>(vb); r[5] = tr_read<v_rd_off(D0, 2, 1)>(vb); r[6] = tr_read<v_rd_off(D0, 3, 0)>(vb); r[7] = tr_read<v_rd_off(D0, 3, 1)>(vb);
}
__device__ __forceinline__ void pv_mma4(f32x16& od, const s16x4 (&r)[8], bf16x8 pa0, bf16x8 pa1, bf16x8 pa2, bf16x8 pa3) {
#define ATT_PK(L, H) (bf16x8){L[0], L[1], L[2], L[3], H[0], H[1], H[2], H[3]}
    od = __builtin_amdgcn_mfma_f32_32x32x16_bf16(pa0, ATT_PK(r[0], r[1]), od, 0, 0, 0);
    od = __builtin_amdgcn_mfma_f32_32x32x16_bf16(pa1, ATT_PK(r[2], r[3]), od, 0, 0, 0);
    od = __builtin_amdgcn_mfma_f32_32x32x16_bf16(pa2, ATT_PK(r[4], r[5]), od, 0, 0, 0);
    od = __builtin_amdgcn_mfma_f32_32x32x16_bf16(pa3, ATT_PK(r[6], r[7]), od, 0, 0, 0);
#undef ATT_PK
}
__device__ __forceinline__ void pv_all(f32x16 (&o)[4], int vb, bf16x8 pa0, bf16x8 pa1, bf16x8 pa2, bf16x8 pa3) {
    s16x4 ra[8], rb[8];
    pv_read8<0>(ra, vb);
    pv_read8<1>(rb, vb); asm volatile("s_waitcnt lgkmcnt(8)" ::: "memory"); __builtin_amdgcn_sched_barrier(0);
    pv_mma4(o[0], ra, pa0, pa1, pa2, pa3); __builtin_amdgcn_sched_barrier(0);
    pv_read8<2>(ra, vb); asm volatile("s_waitcnt lgkmcnt(8)" ::: "memory"); __builtin_amdgcn_sched_barrier(0);
    pv_mma4(o[1], rb, pa0, pa1, pa2, pa3); __builtin_amdgcn_sched_barrier(0);
    pv_read8<3>(rb, vb); asm volatile("s_waitcnt lgkmcnt(8)" ::: "memory"); __builtin_amdgcn_sched_barrier(0);
    pv_mma4(o[2], ra, pa0, pa1, pa2, pa3); __builtin_amdgcn_sched_barrier(0);
    asm volatile("s_waitcnt lgkmcnt(0)" ::: "memory"); __builtin_amdgcn_sched_barrier(0);
    pv_mma4(o[3], rb, pa0, pa1, pa2, pa3);
}
struct Item {
    const bf16_t* Q; int ldq;
    const bf16_t* K0; const bf16_t* V0; int n0;
    const bf16_t* K1; const bf16_t* V1; int ldk, ldv, t_lo, t_hi;
    int q0, band; float m0, l0;
    const float* qg; const float* rope; float qscale;
    const bf16_t* G; int ldg; bf16_t* O; int ldo;
};
template <int DQK>
__device__ __forceinline__ void attn_item(LAS unsigned char* lds, const Item& it) {
    constexpr int KROW = DQK * 2, SHM_K = 64 * KROW, SHM_V = 64 * 128 * 2, ND = DQK / 16;
    const int tid = otid(), wid = tid >> 6, lane = tid & 63, r32 = lane & 31, hi = lane >> 5;
    LAS unsigned char* V_lds = lds; LAS unsigned char* K_lds = lds + 3 * SHM_V;
    LAS float* wsx = (LAS float*)(lds + 3 * SHM_V + 3 * SHM_K) + wid * 64; LAS float* li_l = wsx; LAS float* al_l = wsx + 32;
    float m_reg = it.m0, l_reg = it.l0;
    f32x16 o[4];
#pragma unroll
    for (int d = 0; d < 4; ++d)
#pragma unroll
        for (int r = 0; r < 16; ++r) o[d][r] = 0.f;
    bf16x8 qr[ND];
    {
      const bf16_t* Qw = it.Q + (size_t)(wid * 32 + r32) * it.ldq + hi * 8;
      float xf[ND][8]; float ss = 0.f;
#pragma unroll
      for (int d0 = 0; d0 < ND; ++d0) { const bf16x8 v = *(const bf16x8*)(Qw + d0 * 16);
#pragma unroll
          for (int e = 0; e < 8; ++e) { xf[d0][e] = bf2f((unsigned short)v[e]); ss += xf[d0][e] * xf[d0][e]; } }
      ss += __shfl_xor(ss, 32);
      const float rstd = rsqrtf(ss * (1.f / (float)DQK) + EPSN);
#pragma unroll
      for (int d0 = 0; d0 < ND; ++d0) { const f32x4 g0 = *(const f32x4*)(it.qg + d0 * 16 + hi * 8), g1 = *(const f32x4*)(it.qg + d0 * 16 + hi * 8 + 4);
#pragma unroll
          for (int e = 0; e < 8; ++e) xf[d0][e] *= rstd * (e < 4 ? g0[e & 3] : g1[e & 3]); }
      if (it.rope) { constexpr int NR = DQK == 128 ? 4 : 2, RB = DQK == 128 ? 0 : 8, RS = DQK == 128 ? 64 : 32;
          const float* rp = it.rope + (size_t)((it.q0 + wid * 32 + r32) * RS + hi * 8) * 2;
#pragma unroll
          for (int p = 0; p < NR; ++p) { f32x4 cs4[4];
#pragma unroll
              for (int q = 0; q < 4; ++q) cs4[q] = *(const f32x4*)(rp + p * 32 + 4 * q);
#pragma unroll
              for (int e = 0; e < 8; ++e) { const float c = cs4[e >> 1][(e & 1) * 2], sn = cs4[e >> 1][(e & 1) * 2 + 1];
                  const float x1 = xf[RB + p][e], x2 = xf[RB + NR + p][e]; xf[RB + p][e] = x1 * c - x2 * sn; xf[RB + NR + p][e] = x1 * sn + x2 * c; } } }
#pragma unroll
      for (int d0 = 0; d0 < ND; ++d0) { float t8[8];
#pragma unroll
          for (int e = 0; e < 8; ++e) t8[e] = xf[d0][e] * it.qscale;
          qr[d0] = pack8(t8); } }
    const int NT = it.n0 + (it.t_hi - it.t_lo);
    const int wvu = __builtin_amdgcn_readfirstlane(wid);
    const int vb0 = (int)(uintptr_t)V_lds + v_rd_base(lane);
    constexpr int NKI = SHM_K / 8192;
    unsigned kog[NKI], vog[2];
#pragma unroll
    for (int i = 0; i < NKI; ++i) { const int off = i * 8192 + wid * 1024 + lane * 16, row = off / KROW, pos = off % KROW; kog[i] = (unsigned)(row * it.ldk + ((pos ^ ((row & 7) << 4)) >> 1)); }
#pragma unroll
    for (int i = 0; i < 2; ++i) { const int q = (i * 8192 + wid * 1024 + lane * 16) >> 4, sub = q >> 5, rem = q & 31, rowin = rem >> 2, cch = rem & 3;
        const int kk = (sub >> 2) * 8 + rowin; vog[i] = (unsigned)(((kk & ~0xC) | ((kk & 4) << 1) | ((kk & 8) >> 1)) * it.ldv + (sub & 3) * 32 + cch * 8); }
    int koff[4];
#pragma unroll
    for (int dl = 0; dl < 4; ++dl) koff[dl] = r32 * KROW + ((dl * 32 + hi * 16) ^ ((r32 & 7) << 4));
#define ATT_STAGE(jj, b) do { const int _j = (jj); const bool _s0 = _j < it.n0; const int _t = _s0 ? _j : it.t_lo + (_j - it.n0); \
        const bf16_t* _Kp = (_s0 ? it.K0 : it.K1) + (size_t)(64 * _t) * it.ldk; const bf16_t* _Vp = (_s0 ? it.V0 : it.V1) + (size_t)(64 * _t) * it.ldv; \
        _Pragma("unroll") for (int _i = 0; _i < NKI; ++_i) __builtin_amdgcn_global_load_lds((const unsigned*)(_Kp + kog[_i]), (LAS unsigned*)(K_lds + (b) * SHM_K + _i * 8192 + wvu * 1024), 16, 0, 0); \
        _Pragma("unroll") for (int _i = 0; _i < 2; ++_i) __builtin_amdgcn_global_load_lds((const unsigned*)(_Vp + vog[_i]), (LAS unsigned*)(V_lds + (b) * SHM_V + _i * 8192 + wvu * 1024), 16, 0, 0); } while (0)
#define ATT_WAIT_TILE(more) do { if (more) { if constexpr (NKI == 3) asm volatile("s_waitcnt vmcnt(5)" ::: "memory"); else asm volatile("s_waitcnt vmcnt(4)" ::: "memory"); } \
        else asm volatile("s_waitcnt vmcnt(0)" ::: "memory"); \
        asm volatile("s_waitcnt lgkmcnt(0)" ::: "memory"); __builtin_amdgcn_s_barrier(); asm volatile("" ::: "memory"); } while (0)
    ATT_STAGE(0, 0); if (NT > 1) ATT_STAGE(1, 1);
    ATT_WAIT_TILE(NT > 1);
    int cur = 0;
    for (int j = 0; j < NT; ++j) {
        if (j + 2 < NT) ATT_STAGE(j + 2, (cur == 0 ? 2 : cur - 1));
        bool act = true; const bool domask = it.band && j >= it.n0; int kpos0 = 0;
        if (domask) { kpos0 = 64 * (it.t_lo + j - it.n0); const int qlo = it.q0 + wid * 32; act = (kpos0 + 63 >= qlo - 128) && (kpos0 <= qlo + 31 + 128); }
        if (act) {
            f32x16 p0, p1;
#pragma unroll
            for (int r = 0; r < 16; ++r) { p0[r] = 0.f; p1[r] = 0.f; }
            const LAS unsigned char* Ks = K_lds + cur * SHM_K;
            {
                constexpr int NG = ND / 4;
                bf16x8 kf[2][8];
#define ATT_LOADG(g_, dst) do { _Pragma("unroll") for (int u_ = 0; u_ < 4; ++u_) { dst[2 * u_] = *(const LAS bf16x8*)(Ks + koff[u_] + (g_) * 128); dst[2 * u_ + 1] = *(const LAS bf16x8*)(Ks + koff[u_] + (g_) * 128 + 32 * KROW); } } while (0)
                ATT_LOADG(0, kf[0]);
#pragma unroll
                for (int g = 0; g < NG; ++g) {
                    if (g + 1 < NG) ATT_LOADG(g + 1, kf[(g + 1) & 1]);
                    __builtin_amdgcn_sched_barrier(0);
#pragma unroll
                    for (int u_ = 0; u_ < 4; ++u_) { p0 = __builtin_amdgcn_mfma_f32_32x32x16_bf16(kf[g & 1][2 * u_], qr[4 * g + u_], p0, 0, 0, 0);
                        p1 = __builtin_amdgcn_mfma_f32_32x32x16_bf16(kf[g & 1][2 * u_ + 1], qr[4 * g + u_], p1, 0, 0, 0); }
                    __builtin_amdgcn_sched_barrier(0); }
#undef ATT_LOADG
            }
            if (domask) { const int qp = it.q0 + wid * 32 + r32;
#pragma unroll
                for (int r = 0; r < 16; ++r) { const int d = kpos0 + crow(r, hi) - qp;
                    if (d > 128 || d < -128) p0[r] = -1e30f;
                    if (d + 32 > 128 || d + 32 < -128) p1[r] = -1e30f; } }
            float pmax = p0[0];
#pragma unroll
            for (int r = 1; r < 16; ++r) pmax = fmaxf(pmax, p0[r]);
#pragma unroll
            for (int r = 0; r < 16; ++r) pmax = fmaxf(pmax, p1[r]);
            { auto rr = __builtin_amdgcn_permlane32_swap(__float_as_uint(pmax), __float_as_uint(pmax), false, false);
              pmax = fmaxf(__uint_as_float(rr[0]), __uint_as_float(rr[1])); }
            float mn, alpha;
            if (__all(pmax - m_reg <= 11.5415603f)) { mn = m_reg; alpha = 1.f; }
            else { mn = fmaxf(m_reg, pmax); alpha = __builtin_amdgcn_exp2f(m_reg - mn); m_reg = mn; }
            float ps = 0.f;
#pragma unroll
            for (int r = 0; r < 16; ++r) { p0[r] = __builtin_amdgcn_exp2f(p0[r] - mn); p1[r] = __builtin_amdgcn_exp2f(p1[r] - mn); ps += p0[r] + p1[r]; }
            { auto rr = __builtin_amdgcn_permlane32_swap(__float_as_uint(ps), __float_as_uint(ps), false, false);
              ps = __uint_as_float(rr[0]) + __uint_as_float(rr[1]); }
            l_reg = l_reg * alpha + ps;
            bf16x8 pa0, pa1, pa2, pa3;
#define ATT_PK4(P, BASE, OUT) do { unsigned a0 = cvtpk(P[BASE + 0], P[BASE + 1]), a1 = cvtpk(P[BASE + 2], P[BASE + 3]);   \
    unsigned b0 = cvtpk(P[BASE + 4], P[BASE + 5]), b1 = cvtpk(P[BASE + 6], P[BASE + 7]);                              \
    auto r0 = __builtin_amdgcn_permlane32_swap(a0, b0, false, false); auto r1 = __builtin_amdgcn_permlane32_swap(a1, b1, false, false); \
    u32x4 w = {r0[0], r1[0], r0[1], r1[1]}; OUT = __builtin_bit_cast(bf16x8, w); } while (0)
            ATT_PK4(p0, 0, pa0); ATT_PK4(p0, 8, pa1); ATT_PK4(p1, 0, pa2); ATT_PK4(p1, 8, pa3);
#undef ATT_PK4
            if (__any(alpha < 1.f)) { if (hi == 0) al_l[r32] = alpha; asm volatile("s_waitcnt lgkmcnt(0)" ::: "memory");
#pragma unroll
                for (int r = 0; r < 16; ++r) { const float al = al_l[crow(r, hi)];
#pragma unroll
                    for (int d = 0; d < 4; ++d) o[d][r] *= al; } }
            const int vb = vb0 + cur * SHM_V;
            pv_all(o, vb, pa0, pa1, pa2, pa3);
        }
        ATT_WAIT_TILE(j + 2 < NT);
        cur = cur == 2 ? 0 : cur + 1;
    }
#undef ATT_STAGE
#undef ATT_WAIT_TILE
    const int er = lane >> 4, ec = (lane & 15) * 8;
    bf16x8 gv[8];
    { const bf16_t* Gw = it.G + (size_t)(wid * 32 + er) * it.ldg + ec;
#pragma unroll
      for (int c = 0; c < 8; ++c) gv[c] = *(const bf16x8*)(Gw + (size_t)(4 * c) * it.ldg); }
    if (hi == 0) li_l[r32] = l_reg; asm volatile("s_waitcnt lgkmcnt(0)" ::: "memory");
    LAS bf16_t* ost = (LAS bf16_t*)(lds + wid * 8192);
#pragma unroll
    for (int r = 0; r < 16; ++r) { const float rli = 1.f / li_l[crow(r, hi)];
#pragma unroll
        for (int d0 = 0; d0 < 4; ++d0) ost[crow(r, hi) * 128 + d0 * 32 + r32] = (bf16_t)f2bf(o[d0][r] * rli); }
    asm volatile("s_waitcnt lgkmcnt(0)" ::: "memory");
    { bf16_t* Ow = it.O + (size_t)(wid * 32 + er) * it.ldo + ec;
#pragma unroll
      for (int c = 0; c < 8; ++c) { const bf16x8 ov = *(const LAS bf16x8*)(ost + (4 * c + er) * 128 + ec); float t8[8];
#pragma unroll
          for (int e = 0; e < 8; ++e) t8[e] = bf2f((unsigned short)ov[e]) * silu_f(bf2f((unsigned short)gv[c][e]));
          *(bf16x8*)(Ow + (size_t)(4 * c) * it.ldo) = pack8(t8); } }
    __syncthreads();
}
}

__device__ __forceinline__ void hgrn_item(LAS unsigned char* lds, const bf16_t* PROJ, int rowbase, int T, int h, int dir,
                                          const float* lb, const float* s0, float* sout, bf16_t* OUT, int c0, int c1, float* sbuf) {
    const int tid = otid(), wid = tid >> 6, lane = tid & 63, fr = lane & 15, fq = lane >> 4;
    const int c2 = 16 * wid + (lane & 15), part = lane >> 4, n0 = wid * 16;
    f32x4 S[8];
    { const float* sin_ = c0 > 0 ? sbuf : (s0 ? s0 : sbuf);
      const float ssc = (c0 > 0 || s0) ? 1.f : 0.f;
#pragma unroll
      for (int kt = 0; kt < 8; ++kt)
#pragma unroll
          for (int r = 0; r < 4; ++r) S[kt][r] = sin_[(size_t)(16 * kt + 4 * fq + r) * 128 + n0 + fr] * ssc; }
    __builtin_amdgcn_s_waitcnt(0x0F70);
    const float oml = 1.f - lb[c2];
    const unsigned hz = ozero();
    const int nch = T / 32;
    LAS unsigned char* RAW = lds + 76800;
    const int wvu = __builtin_amdgcn_readfirstlane(wid);
    const int dtl = 4 * wid + (lane >> 4), dch = (lane & 15) * 8;
    const bf16_t* dsrc = PROJ + h * 128 + dch;
    const int colf = dir ? COL_FB : COL_FF;
#define HG_DMA(cc, slot) do { const int _p = 32 * (cc) + dtl; const int _tok = dir ? T - 1 - _p : _p; const bf16_t* _s = dsrc + (size_t)(rowbase + _tok) * LDP_AB; \
        __builtin_amdgcn_global_load_lds((const unsigned*)(_s + COL_BQ), (LAS unsigned*)(RAW + (slot) * 24576 + wvu * 1024), 16, 0, 0); \
        __builtin_amdgcn_global_load_lds((const unsigned*)(_s + colf), (LAS unsigned*)(RAW + (slot) * 24576 + 8192 + wvu * 1024), 16, 0, 0); \
        __builtin_amdgcn_global_load_lds((const unsigned*)(_s + COL_BI), (LAS unsigned*)(RAW + (slot) * 24576 + 16384 + wvu * 1024), 16, 0, 0); } while (0)
#define HG_BAR() do { asm volatile("s_waitcnt lgkmcnt(0)" ::: "memory"); __builtin_amdgcn_s_barrier(); asm volatile("" ::: "memory"); } while (0)
    HG_DMA(c0, 0);
    asm volatile("s_waitcnt vmcnt(0)" ::: "memory");
    HG_BAR();
    int cur = 0;
    for (int cc = c0; cc < c1; ++cc) {
        if (cc + 1 < c1) HG_DMA(cc + 1, cur ^ 1);
        LAS float* DEC = (LAS float*)lds + cur * 128;
        LAS bf16_t* QT = (LAS bf16_t*)(lds + 1024 + cur * 37888);
        LAS bf16_t* KT = QT + 32 * 136;
        LAS bf16_t* KTt = KT + 32 * 136;
        LAS bf16_t* Vt = KTt + 128 * 40;
        float b[8], kk[8], sq[8]; unsigned short vv[8]; float run = 0.f;
        { const LAS bf16_t* rw = (const LAS bf16_t*)(RAW + cur * 24576) + (8 * part) * 128 + c2;
            unsigned short rq[8], rf[8];
#pragma unroll
            for (int i = 0; i < 8; ++i) { rq[i] = rw[i * 128]; rf[i] = rw[4096 + i * 128]; vv[i] = rw[8192 + i * 128]; }
#pragma unroll
            for (int i = 0; i < 8; ++i) { const float x = bf2f(rf[i]); const float omf = oml * __builtin_amdgcn_rcpf(1.f + __expf(x));
                const float lf = fmaxf(__logf(1.f - omf), -30.f); run += lf; b[i] = run; kk[i] = omf; sq[i] = silu_f(bf2f(rq[i])); } }
        { const float r1 = __shfl_up(run, 16), r2 = __shfl_up(run, 32), r3 = __shfl_up(run, 48);
            const float off = (part >= 1 ? r1 : 0.f) + (part >= 2 ? r2 : 0.f) + (part >= 3 ? r3 : 0.f);
            float kt_[8];
#pragma unroll
            for (int i = 0; i < 8; ++i) { const float bb = b[i] + off; const int t = 8 * part + i;
                const float qv = sq[i] * __expf(bb); kt_[i] = kk[i] * __expf(fminf(-bb, 80.f));
                QT[t * 136 + c2] = (bf16_t)f2bf(qv); KT[t * 136 + c2] = (bf16_t)f2bf(kt_[i]);
                if (i == 7 && part == 3) DEC[c2] = __expf(bb); }
            *(LAS bf16x8*)(KTt + c2 * 40 + 8 * part) = pack8(kt_);
            u32x4 wv; wv.x = (unsigned)vv[0] | ((unsigned)vv[1] << 16); wv.y = (unsigned)vv[2] | ((unsigned)vv[3] << 16); wv.z = (unsigned)vv[4] | ((unsigned)vv[5] << 16); wv.w = (unsigned)vv[6] | ((unsigned)vv[7] << 16);
            *(LAS u32x4*)(Vt + c2 * 40 + 8 * part) = wv; }
        asm volatile("s_waitcnt vmcnt(0)" ::: "memory");
        HG_BAR();
        f32x4 pt00 = {0.f, 0.f, 0.f, 0.f}, pt01 = pt00, pt11 = pt00;
#pragma unroll
        for (int ks = 0; ks < 4; ++ks) {
            const bf16x8 a0 = *(const LAS bf16x8*)(KT + fr * 136 + 32 * ks + 8 * fq), a1 = *(const LAS bf16x8*)(KT + (16 + fr) * 136 + 32 * ks + 8 * fq);
            const bf16x8 b0 = *(const LAS bf16x8*)(QT + fr * 136 + 32 * ks + 8 * fq), b1 = *(const LAS bf16x8*)(QT + (16 + fr) * 136 + 32 * ks + 8 * fq);
            pt00 = __builtin_amdgcn_mfma_f32_16x16x32_bf16(a0, b0, pt00, 0, 0, 0);
            pt01 = __builtin_amdgcn_mfma_f32_16x16x32_bf16(a0, b1, pt01, 0, 0, 0);
            pt11 = __builtin_amdgcn_mfma_f32_16x16x32_bf16(a1, b1, pt11, 0, 0, 0); }
#pragma unroll
        for (int r = 0; r < 4; ++r) { if (4 * fq + r > fr) { pt00[r] = 0.f; pt11[r] = 0.f; } }
        u32x4 wA0, wA1;
        wA0.x = pk2(pt00[0], pt00[1]); wA0.y = pk2(pt00[2], pt00[3]); wA0.z = hz; wA0.w = hz;
        wA1.x = pk2(pt01[0], pt01[1]); wA1.y = pk2(pt01[2], pt01[3]); wA1.z = pk2(pt11[0], pt11[1]); wA1.w = pk2(pt11[2], pt11[3]);
        const u32x2 vlo = *(const LAS u32x2*)(Vt + (n0 + fr) * 40 + 4 * fq), vhi = *(const LAS u32x2*)(Vt + (n0 + fr) * 40 + 16 + 4 * fq);
        const u32x4 wV = {vlo.x, vlo.y, vhi.x, vhi.y};
        f32x4 o0 = {0.f, 0.f, 0.f, 0.f}, o1 = o0;
        o0 = __builtin_amdgcn_mfma_f32_16x16x32_bf16(__builtin_bit_cast(bf16x8, wA0), __builtin_bit_cast(bf16x8, wV), o0, 0, 0, 0);
        o1 = __builtin_amdgcn_mfma_f32_16x16x32_bf16(__builtin_bit_cast(bf16x8, wA1), __builtin_bit_cast(bf16x8, wV), o1, 0, 0, 0);
#pragma unroll
        for (int aa = 0; aa < 4; ++aa) {
            u32x4 wS; wS.x = pk2(S[2 * aa][0], S[2 * aa][1]); wS.y = pk2(S[2 * aa][2], S[2 * aa][3]); wS.z = pk2(S[2 * aa + 1][0], S[2 * aa + 1][1]); wS.w = pk2(S[2 * aa + 1][2], S[2 * aa + 1][3]);
            const u32x2 q0l = *(const LAS u32x2*)(QT + fr * 136 + 32 * aa + 4 * fq), q0h = *(const LAS u32x2*)(QT + fr * 136 + 32 * aa + 16 + 4 * fq);
            const u32x2 q1l = *(const LAS u32x2*)(QT + (16 + fr) * 136 + 32 * aa + 4 * fq), q1h = *(const LAS u32x2*)(QT + (16 + fr) * 136 + 32 * aa + 16 + 4 * fq);
            const u32x4 wQ0 = {q0l.x, q0l.y, q0h.x, q0h.y}, wQ1 = {q1l.x, q1l.y, q1h.x, q1h.y};
            o0 = __builtin_amdgcn_mfma_f32_16x16x32_bf16(__builtin_bit_cast(bf16x8, wQ0), __builtin_bit_cast(bf16x8, wS), o0, 0, 0, 0);
            o1 = __builtin_amdgcn_mfma_f32_16x16x32_bf16(__builtin_bit_cast(bf16x8, wQ1), __builtin_bit_cast(bf16x8, wS), o1, 0, 0, 0); }
        { const bf16x8 vn = *(const LAS bf16x8*)(Vt + (n0 + fr) * 40 + 8 * fq);
#pragma unroll
            for (int kt = 0; kt < 8; ++kt) { const bf16x8 ka = *(const LAS bf16x8*)(KTt + (16 * kt + fr) * 40 + 8 * fq);
                S[kt] = __builtin_amdgcn_mfma_f32_16x16x32_bf16(ka, vn, S[kt], 0, 0, 0);
                const f32x4 d = *(const LAS f32x4*)(DEC + 16 * kt + 4 * fq); S[kt] = S[kt] * d; } }
#pragma unroll
        for (int r = 0; r < 4; ++r) {
            const int i0 = 4 * fq + r, i1 = 16 + 4 * fq + r;
            const int tok0 = dir ? T - 1 - (32 * cc + i0) : 32 * cc + i0, tok1 = dir ? T - 1 - (32 * cc + i1) : 32 * cc + i1;
            OUT[(size_t)(rowbase + tok0) * 1024 + h * 128 + n0 + fr] = (bf16_t)f2bf(o0[r]);
            OUT[(size_t)(rowbase + tok1) * 1024 + h * 128 + n0 + fr] = (bf16_t)f2bf(o1[r]); }
        cur ^= 1;
    }
#undef HG_DMA
#undef HG_BAR
    { float* so_ = c1 < nch ? sbuf : sout;
      if (so_) {
#pragma unroll
        for (int kt = 0; kt < 8; ++kt)
#pragma unroll
            for (int r = 0; r < 4; ++r) so_[(size_t)(16 * kt + 4 * fq + r) * 128 + n0 + fr] = S[kt][r]; } }
    __syncthreads();
}

__device__ __forceinline__ int fetch_item(unsigned* ctr, LAS int* slot) {
    __syncthreads();
    if (otid() == 0) *slot = (int)atomicAdd(ctr, 1u);
    __syncthreads();
    return __builtin_amdgcn_readfirstlane(*slot);
}

#define XB_TMO      128
#define XB_XCNT(j)  (256  + 64 * (j))
#define XB_XSUB(j)  (1280 + 64 * (j))
#define XB_XGEN(j)  (2304 + 64 * (j))
#define XB_TOP      3328
#define XB_TOPGEN   3392
#define XCD_BAR_WORDS 3456
#define XB_SPIN_CAP (1u << 18)

__device__ __forceinline__ unsigned xb_ld(unsigned* p)              { return __hip_atomic_load(p, __ATOMIC_RELAXED, __HIP_MEMORY_SCOPE_AGENT); }
__device__ __forceinline__ unsigned xb_add(unsigned* p, unsigned v) { return __hip_atomic_fetch_add(p, v, __ATOMIC_RELAXED, __HIP_MEMORY_SCOPE_AGENT); }
__device__ __forceinline__ unsigned xb_xcc_id() { return (unsigned)__builtin_amdgcn_s_getreg((3 << 11) | 20) & 0xFu; }
#define XB_SPIN(cond, bar) do { unsigned _sp = 0; while (cond) { __builtin_amdgcn_s_sleep(1); \
    if ((++_sp & 255u) == 0u) { if (xb_ld(&(bar)[XB_TMO])) break; if (_sp > XB_SPIN_CAP) { atomicAdd(&(bar)[XB_TMO], 1u); break; } } } } while (0)

struct XcdBarrier {
    unsigned* bar; unsigned x;
    volatile LAS unsigned* st;
};

__device__ __forceinline__ XcdBarrier xcd_barrier_post(unsigned* bar, volatile LAS unsigned* st) {
    XcdBarrier b; b.bar = bar; b.x = xb_xcc_id(); b.st = st;
    if (threadIdx.x == 0) (void)xb_add(&bar[XB_XCNT(b.x)], 1u);
    return b;
}
__device__ __forceinline__ void xcd_barrier_complete(unsigned* bar, unsigned x, unsigned& nloc, unsigned& nx) {
    const unsigned G = gridDim.x * gridDim.y * gridDim.z;
    unsigned sum, cnt, mine, sp = 0u;
    for (;;) {
        sum = 0u; cnt = 0u; mine = 0u;
#pragma unroll
        for (unsigned j = 0; j < 16; ++j) { const unsigned c = xb_ld(&bar[XB_XCNT(j)]); sum += c; cnt += (c > 0u) ? 1u : 0u; mine = (j == x) ? c : mine; }
        if (sum == G) break;
        __builtin_amdgcn_s_sleep(1);
        if ((++sp & 255u) == 0u) { if (xb_ld(&bar[XB_TMO])) break; if (sp > XB_SPIN_CAP) { atomicAdd(&bar[XB_TMO], 1u); break; } }
    }
    nloc = mine > 0u ? mine : 1u; nx = cnt > 0u ? cnt : 1u;
}

__device__ __forceinline__ void xcd_barrier(const XcdBarrier& b) {
    asm volatile("s_waitcnt vmcnt(0)" ::: "memory");
    __syncthreads();
    if (threadIdx.x == 0) {
        unsigned* bar = b.bar;
        __builtin_amdgcn_s_waitcnt(0);
        unsigned nloc = b.st[0], nx = b.st[1];
        if (nloc == 0u) { xcd_barrier_complete(bar, b.x, nloc, nx); b.st[0] = nloc; b.st[1] = nx; }
        const unsigned old = xb_add(&bar[XB_XSUB(b.x)], 1u);
        const unsigned gen = old / nloc;
        if (old + 1u == (gen + 1u) * nloc) {
            __builtin_amdgcn_fence(__ATOMIC_RELEASE, "agent");
            asm volatile("s_waitcnt vmcnt(0)" ::: "memory");
            const unsigned og = xb_add(&bar[XB_TOP], 1u);
            const unsigned tg = og / nx;
            if (og + 1u == (tg + 1u) * nx) xb_add(&bar[XB_TOPGEN], 1u);
            else XB_SPIN(xb_ld(&bar[XB_TOPGEN]) == tg, bar);
            __builtin_amdgcn_fence(__ATOMIC_ACQUIRE, "agent");
            xb_add(&bar[XB_XGEN(b.x)], 1u);
            asm volatile("s_waitcnt vmcnt(0)" ::: "memory");
        } else {
            XB_SPIN(xb_ld(&bar[XB_XGEN(b.x)]) == gen, bar);
            __builtin_amdgcn_fence(__ATOMIC_ACQUIRE, "agent");
            asm volatile("s_waitcnt vmcnt(0)" ::: "memory");
        }
    }
    __syncthreads();
}

#ifndef BG_C1
#define BG_C1 4
#define BG_C2 12
#define BG_C3 16
#endif
enum { K_FINAL = 12, K_P0 = 0, K_MODNORM, K_GEMM_IN, K_PREP_AB, K_GEMM_QUP, K_GEMM_KVUP, K_HN_AB, K_MIX_AB, K_FIN_AB, K_GEMM_OUT, K_HN_C, K_ATTN_C };

__global__ void __launch_bounds__(NTHR, 2) mk_fwd(Args a_byval) {
    extern __shared__ __attribute__((aligned(16))) unsigned char lds_raw[];
    LAS unsigned char* lds = (LAS unsigned char*)lds_raw;
    LAS int* slot = (LAS int*)(lds + LDS_PHASE);
    cg::grid_group grid = cg::this_grid();
    const int G = gridDim.x;
    volatile LAS unsigned* bst = (volatile LAS unsigned*)(lds + LDS_PHASE + 64);
    if (threadIdx.x < 2) bst[threadIdx.x] = 0u;
    __syncthreads();
    (void)xcd_barrier_post((unsigned*)(a_byval.ws + WS_CTL) + 8192, bst);

    grid.sync();
#ifndef PROBE_TSEL
#define PROBE_TSEL 0
#endif
    unsigned long long t_acc = 0ull;
    for (int step = 0; step < 30; ++step) {
        unsigned long long t_begin = 0ull; if (PROBE_TSEL) t_begin = __builtin_amdgcn_s_memrealtime();
        asm volatile("" : "+s"(step));
        KArgs a = (KArgs)__builtin_amdgcn_kernarg_segment_ptr();
        asm volatile("" : "+s"(a));
        unsigned char* ws = a->ws;
        unsigned* ctl = (unsigned*)(ws + WS_CTL);
        XcdBarrier xbar; xbar.bar = ctl + 8192; xbar.x = xb_xcc_id(); xbar.st = (volatile LAS unsigned*)(lds + LDS_PHASE + 64);
        int kind, L = 0; bool sync_after = true;
        if (step == 0) kind = K_P0;
        else if (step == 29) { kind = K_FINAL; L = 4; }
        else { const int s = step - 1, pair = s / 14, r = s % 14;
            if (r < 9) { L = 2 * pair; kind = r == 0 ? K_MODNORM : r == 1 ? K_GEMM_IN : r == 2 ? K_PREP_AB : r == 3 ? K_GEMM_QUP : r == 4 ? K_GEMM_KVUP : r == 5 ? K_HN_AB : r == 6 ? K_MIX_AB : r == 7 ? K_FIN_AB : K_GEMM_OUT; }
            else { L = 2 * pair + 1; const int q = r - 9; kind = q == 0 ? K_MODNORM : q == 1 ? K_GEMM_IN : q == 2 ? K_HN_C : q == 3 ? K_ATTN_C : K_GEMM_OUT; } }
        const int j = L >> 1; const bool isC = (L & 1) != 0;
        if (kind == K_GEMM_QUP) sync_after = false;
        if (step == 29) sync_after = false;

#ifndef PROBE_MASK
#define PROBE_MASK 0
#endif
#ifndef PROBE_SEL
#define PROBE_SEL 0
#endif
#ifndef PROBE_REPS
#define PROBE_REPS 2
#endif
        const int nrep = (((PROBE_MASK >> kind) & 1) && (kind != K_GEMM_OUT || L == 0)) ? 1 + PROBE_REPS : 1;
        for (int rep = 0; rep < nrep; ++rep) {
        if (PROBE_MASK == 0x1000) { for (int q = 0; q < 2; ++q) xcd_barrier(xbar); }
        const int bid = obid();
        const bool bgphase = kind == K_PREP_AB || kind == K_GEMM_QUP || kind == K_GEMM_KVUP || kind == K_HN_AB;
        if (rep == 0 && bid < NBG && (kind == K_PREP_AB || kind == K_GEMM_QUP || kind == K_HN_AB || kind == K_MIX_AB)) {
            const int b = bid >> 4, h = (bid >> 1) & 7, dir = bid & 1;
            const int c0 = kind == K_PREP_AB ? 0 : kind == K_GEMM_QUP ? BG_C1 : kind == K_HN_AB ? BG_C2 : BG_C3;
            const int c1 = kind == K_PREP_AB ? BG_C1 : kind == K_GEMM_QUP ? BG_C2 : kind == K_HN_AB ? BG_C3 : 64;
            hgrn_item(lds, (const bf16_t*)(ws + WS_PROJ), MC + b * 2048, 2048, h, dir, (const float*)(ws + WS_LB) + (j * 2 + dir) * 1024 + h * 128,
                      a->in[4 + dir] + (size_t)((b * 2 + j) * 8 + h) * 16384, nullptr, (bf16_t*)(ws + (dir ? WS_OB : WS_OF)), c0, c1, (float*)(ws + WS_SBUF) + (size_t)bid * 16384);
        }
        const int ewg = bgphase ? bid - NBG : bid, enwg = bgphase ? G - NBG : G;
        if (bgphase && bid < NBG) {}
        else
        if (kind == K_P0) phase_p0(a, lds);
        else if (kind == K_MODNORM) phase_modnorm(a, L);
        else if (kind == K_GEMM_IN || kind == K_GEMM_QUP || kind == K_GEMM_KVUP) {
            pg8::Gemm g; pg8::EpiStore E;
            if (kind == K_GEMM_IN) {
                if (!isC) { g = pg8::Gemm{(const bf16_t*)(ws + WS_H), (const bf16_t*)(ws + WS_WINAB) + (size_t)j * 7168 * 2048, MROWS, 7168, 2048}; E = pg8::EpiStore{(bf16_t*)(ws + WS_PROJ), LDP_AB}; }
                else { g = pg8::Gemm{(const bf16_t*)(ws + WS_H), (const bf16_t*)(ws + WS_WINC) + (size_t)j * 5120 * 2048, MROWS, 5120, 2048}; E = pg8::EpiStore{(bf16_t*)(ws + WS_PROJ), LDP_C}; }
            } else if (kind == K_GEMM_QUP) { g = pg8::Gemm{(const bf16_t*)(ws + WS_QN), (const bf16_t*)(ws + WS_WQUP) + (size_t)j * 1536 * 512, MROWS, 1536, 512}; E = pg8::EpiStore{(bf16_t*)(ws + WS_QRAW), 1536}; }
            else { g = pg8::Gemm{(const bf16_t*)(ws + WS_CKV), (const bf16_t*)(ws + WS_WKVUP) + (size_t)j * 2048 * 256, MKROWS, 2048, 256}; E = pg8::EpiStore{(bf16_t*)(ws + WS_KVRAW), 2048}; }
            pg8::StaticOrder S; S.init(g.M, g.N, enwg, ewg);
            pg8::gemm_phase<pg8::EpiStore, pg8::StaticOrder, true, true>(lds, g, S, E);
            if (kind == K_GEMM_IN && L <= 1) { const int left = ((g.M / 256) * (g.N / 256)) % G;
                if (left > 0 && bid >= left) { const int lo = L == 0 ? P0_EARLY : P0_EARLY + 10000, hi = L == 0 ? P0_EARLY + 6000 : P0_EARLY + 12000;
                    p0_transposes(a, lds, lo, hi, (bid - left) * NWAVES + (otid() >> 6), (G - left) * NWAVES); } }
        }
        else if (kind == K_GEMM_OUT) {
            pg8::Gemm g{(const bf16_t*)(ws + WS_H), (const bf16_t*)(ws + (isC ? WS_WOUTC : WS_WOUTAB)) + (size_t)j * 2048 * 2048, MROWS, 2048, 2048};
            pg8::EpiResid E{(bf16_t*)(ws + WS_PROJ), (const float*)(ws + WS_MOD) + (size_t)L * 5 * 6144 + 4096,
                            (float*)(ws + WS_QRAW), ctl + 16384 + step * 256};
            pg8::StaticOrder S; S.init(g.M, g.N, G, obid());
            pg8::gemm_phase<pg8::EpiResid, pg8::StaticOrder, true, true>(lds, g, S, E);
            if (L <= 1) { const int left = ((g.M / 256) * (g.N / 256)) % G;
                if (left > 0 && bid >= left) { const int lo = L == 0 ? P0_EARLY + 6000 : P0_EARLY + 12000, hi = L == 0 ? P0_EARLY + 10000 : P0_EARLY + 16000;
                    p0_transposes(a, lds, lo, hi, (bid - left) * NWAVES + (otid() >> 6), (G - left) * NWAVES); } }
        }
        else if (kind == K_FINAL) phase_final(a);
        else if (kind == K_PREP_AB) phase_prep_ab(a, j, ewg, enwg);
        else if (kind == K_HN_AB) phase_hn_ab(a, j, ewg, enwg);
        else if (kind == K_FIN_AB) phase_fin_ab(a, j);
        else if (kind == K_HN_C) phase_hn_c(a, j);
        else if (kind == K_MIX_AB) {
            unsigned* ctr = ctl + 64 * step + 8 * rep;
            const bf16_t* P = (const bf16_t*)(ws + WS_PROJ); bf16_t* MIX = (bf16_t*)(ws + WS_H);
            const bf16_t* QF = (const bf16_t*)(ws + WS_QRAW); const bf16_t* KF = (const bf16_t*)(ws + WS_KF); const bf16_t* KV = (const bf16_t*)(ws + WS_KVRAW);
            for (;;) {
                const int idx = fetch_item(ctr, slot);
                if (idx >= 640) break;
                if (idx >= 256 && idx < 512) {
                    const int i = idx - 256; const int b = i >> 4, h = (i >> 1) & 7, dir = i & 1;
                    const float* lb = (const float*)(ws + WS_LB) + (j * 2 + dir) * 1024 + h * 128;
                    float* so = a->out + (dir ? O_SB : O_SF) + (size_t)((b * 2 + j) * 8 + h) * 16384;
                    if (PROBE_SEL != 1 || rep == 0) hgrn_item(lds, P, b * 256, 256, h, dir, lb, nullptr, so, (bf16_t*)(ws + (dir ? WS_OB : WS_OF)), 0, 8, (float*)(ws + WS_SBUF));
                } else {
                    att::Item it;
                    const bool lat = idx < 256; int b, h, r0;
                    if (lat) { const int i = idx; b = i >> 6; h = (i >> 3) & 7; const int qb = i & 7; r0 = MC + b * 2048 + qb * 256; it.q0 = qb * 256;
                        it.K0 = KF + (size_t)(MROWS + b * 256) * 1536 + h * 192; it.V0 = KV + (size_t)(MROWS + b * 256) * 2048 + h * 256 + 128; it.n0 = 4;
                        it.K1 = KF + (size_t)(MC + b * 2048) * 1536 + h * 192; it.V1 = KV + (size_t)(MC + b * 2048) * 2048 + h * 256 + 128; it.t_lo = 0; it.t_hi = 32; }
                    else { const int i = idx - 512; b = i >> 3; h = i & 7; r0 = b * 256; it.q0 = 0;
                        it.K0 = KF; it.V0 = KV; it.n0 = 0;
                        it.K1 = KF + (size_t)r0 * 1536 + h * 192; it.V1 = KV + (size_t)r0 * 2048 + h * 256 + 128; it.t_lo = 0; it.t_hi = 4; }
                    it.ldk = 1536; it.ldv = 2048;
                    it.Q = QF + (size_t)r0 * 1536 + h * 192; it.ldq = 1536; it.band = 0; it.m0 = -1e30f; it.l0 = 0.f;
                    it.qg = a->in[18] + j * 192; it.rope = lat ? (const float*)(ws + WS_ROPEA) : nullptr; it.qscale = QSC_A;
                    it.G = P + (size_t)r0 * LDP_AB + COL_AG + h * 128; it.ldg = LDP_AB; it.O = MIX + (size_t)r0 * DM + h * 128; it.ldo = DM;
                    if (PROBE_SEL != 2 || rep == 0) att::attn_item<192>(lds, it);
                }
            }
        }
        else if (kind == K_ATTN_C) {
            unsigned* ctr = ctl + 64 * step + 8 * rep;
            const bf16_t* P = (const bf16_t*)(ws + WS_PROJ); bf16_t* MIX = (bf16_t*)(ws + WS_H);
            const bf16_t* KCC = (const bf16_t*)(ws + WS_KCC);
            const bool sdeal = G == 256; const int xg = bid & 7, xw = bid >> 3;
            for (int kq = 0;; ++kq) {
                int idx;
                if (sdeal) { if (kq >= 3) break;
                    if (kq < 2) { const int grp = 2 * xg + kq; idx = ((grp >> 2) << 7) | ((((grp & 3) << 2) | (xw >> 3)) << 3) | (xw & 7); }
                    else { const int grp = 8 * xg + (xw >> 2); idx = 512 + (((grp >> 2) << 4) | ((grp & 3) << 2) | (xw & 3)); } }
                else { idx = fetch_item(ctr, slot); if (idx >= 768) break; }
                att::Item it; int b, h, r0;
                if (idx < 512) { b = idx >> 7; h = (idx >> 3) & 15; const int qb = idx & 7; r0 = MC + b * 2048 + qb * 256; const int kvh = h >> 2;
                    it.K0 = KCC + (size_t)((b * 2 + j) * 256) * LDP_C + kvh * 128; it.V0 = KCC + (size_t)((b * 2 + j) * 256) * LDP_C + 512 + kvh * 128; it.n0 = 4;
                    it.K1 = P + (size_t)(MC + b * 2048) * LDP_C + 2048 + kvh * 128; it.V1 = P + (size_t)(MC + b * 2048) * LDP_C + 2560 + kvh * 128;
                    it.t_lo = 4 * qb - 2 < 0 ? 0 : 4 * qb - 2; it.t_hi = 4 * qb + 6 > 32 ? 32 : 4 * qb + 6; it.q0 = qb * 256; it.band = 1; }
                else { const int i = idx - 512; b = i >> 4; h = i & 15; r0 = b * 256; const int kvh = h >> 2;
                    it.K0 = KCC; it.V0 = KCC; it.n0 = 0;
                    it.K1 = P + (size_t)r0 * LDP_C + 2048 + kvh * 128; it.V1 = P + (size_t)r0 * LDP_C + 2560 + kvh * 128; it.t_lo = 0; it.t_hi = 4; it.q0 = 0; it.band = 0; }
                it.ldk = LDP_C; it.ldv = LDP_C;
                it.Q = P + (size_t)r0 * LDP_C + h * 128; it.ldq = LDP_C; it.m0 = a->in[29][j * 16 + h] * LOG2E; it.l0 = 1.f;
                it.qg = a->in[27] + j * 128; it.rope = idx < 512 ? (const float*)(ws + WS_ROPEC) : nullptr; it.qscale = QSC_C;
                it.G = P + (size_t)r0 * LDP_C + 3072 + h * 128; it.ldg = LDP_C; it.O = MIX + (size_t)r0 * DM + h * 128; it.ldo = DM;
                att::attn_item<128>(lds, it);
            }
        }
        if (rep + 1 < nrep) xcd_barrier(xbar);
        }
        if (sync_after) xcd_barrier(xbar);
        if (PROBE_TSEL) { if ((PROBE_TSEL >> kind) & 1) t_acc += __builtin_amdgcn_s_memrealtime() - t_begin; }
    }
    if (PROBE_TSEL) { if (blockIdx.x == 0) { const unsigned long long t_end = __builtin_amdgcn_s_memrealtime() + 2ull * t_acc;
        while (__builtin_amdgcn_s_memrealtime() < t_end) __builtin_amdgcn_s_sleep(32); } }
}

extern "C" void kernel_launch(void* const* d_in, const int* in_sizes, int n_in, void* d_out, int out_size, void* d_ws, size_t ws_size, hipStream_t stream) {
    static int grid = 0;
    if (grid == 0) {
        if (n_in != 31 || ws_size < WS_END) { fprintf(stderr, "kernel_launch: unexpected n_in %d or ws_size %zu (< %zu)\n", n_in, ws_size, (size_t)WS_END); grid = -1; return; }
        int dev = 0, cus = 0, per_cu = 0;
        hipGetDevice(&dev); hipDeviceGetAttribute(&cus, hipDeviceAttributeMultiprocessorCount, dev);
        if (hipFuncSetAttribute((const void*)mk_fwd, hipFuncAttributeMaxDynamicSharedMemorySize, LDS_BYTES) != hipSuccess) { fprintf(stderr, "kernel_launch: hipFuncSetAttribute failed\n"); grid = -1; return; }
        if (hipOccupancyMaxActiveBlocksPerMultiprocessor(&per_cu, (const void*)mk_fwd, NTHR, LDS_BYTES) != hipSuccess || per_cu < 1) per_cu = 1;
        (void)hipGetLastError();
        grid = cus > 0 ? cus : 256;
    }
    if (grid < 0) return;
    hipMemsetAsync((char*)d_ws + WS_CTL, 0, CTL_BYTES, stream);
    Args a{};
    for (int i = 0; i < 31; ++i) a.in[i] = (const float*)d_in[i];
    a.out = (float*)d_out; a.ws = (unsigned char*)d_ws;
    void* args[] = {&a};
    hipError_t e = hipLaunchCooperativeKernel((const void*)mk_fwd, dim3(grid), dim3(NTHR), args, LDS_BYTES, stream);
    if (e != hipSuccess) fprintf(stderr, "cooperative launch failed: %s (grid %d)\n", hipGetErrorString(e), grid);
}
```

```cpp
#include <hip/hip_runtime.h>
#include <hip/hip_cooperative_groups.h>
#include <cstdio>
#include <cstdint>
namespace cg = cooperative_groups;

namespace pg8 {
#define PG8_LAS __attribute__((address_space(3)))
typedef unsigned short bf16_t;
typedef short bf16x8 __attribute__((ext_vector_type(8)));
typedef float f32x4 __attribute__((ext_vector_type(4)));
typedef unsigned u32x4 __attribute__((ext_vector_type(4)));
constexpr int BM = 256, BK = 64, HALF = 128, HTB = HALF * BK * 2  , STAGE_BYTES = 8 * HTB, NXCD = 8, WGM = 8;
__device__ __forceinline__ int pg8_otid() { int t = threadIdx.x; asm volatile("" : "+v"(t)); return t; }

__host__ __device__ __forceinline__ int lds_byte(int r, int c) { const int st = (r >> 4) * 2 + (c >> 5), rr = r & 15, cc = c & 31, ob = rr * 64 + cc * 2; return st * 1024 + (ob ^ (((ob >> 9) & 1) << 5)); }
__host__ __device__ __forceinline__ void stage_rc(int b, int& R, int& C) { const int st = b / 1024, sb = b % 1024, swz = sb ^ (((sb >> 9) & 1) << 5); R = (st >> 1) * 16 + swz / 64; C = (st & 1) * 32 + (swz % 64) / 2; }
__host__ __device__ __forceinline__ int perm32(int rho) { const int n = rho >> 4, i = rho & 15; return 8 * (i >> 2) + 4 * n + (i & 3); }

struct Unit { int pm, pn, kp, np, tix; };
struct Gemm { const bf16_t* A; const bf16_t* Bt; int M, N, K; };

struct StaticOrder {
    int nM, nN, nwg, G, c;
    __host__ __device__ void init(int M, int N, int G_, int c_) { nM = M / BM; nN = N / BM; nwg = nM * nN; G = G_; c = c_; }
    __host__ __device__ bool next(int i, Unit& u) const {
        const long L = (long)i * G + c; if (L >= nwg) return false;
        int wgid = (int)L; { const int q = nwg / NXCD, r = nwg % NXCD, xcd = wgid % NXCD, off = wgid / NXCD; wgid = (xcd < r ? xcd * (q + 1) : r * (q + 1) + (xcd - r) * q) + off; }
        const int nig = WGM * nN, gid = wgid / nig, fm = gid * WGM, gsz = (nM - fm) < WGM ? (nM - fm) : WGM;
        u.pm = fm + ((wgid % nig) % gsz); u.pn = (wgid % nig) / gsz; u.kp = 0; u.np = 1; u.tix = 0; return true;
    }
    __device__ __forceinline__ void a_ready(const Unit&) const {}
    __device__ __forceinline__ void done(const Unit&) const {}
};
struct SplitOrder {
    StaticOrder so; int R, np;
    __host__ __device__ void init(int M, int N, int K, int G_, int c_) { so.init(M, N, G_, c_); R = so.nwg / G_; const int left = so.nwg - R * G_;
        np = 1; if (left > 0 && G_ % left == 0) { const int q = G_ / left; if (q == 2 && (K / q) % 128 == 0) np = q; } }
    __host__ __device__ bool next(int i, Unit& u) const {
        if (np == 1 || i < R) return so.next(i, u);
        if (i > R) return false;
        StaticOrder t = so; t.c = so.c / np; const bool ok = t.next(i, u); u.kp = so.c % np; u.np = np; u.tix = so.c / np; return ok;
    }
    __device__ __forceinline__ void a_ready(const Unit&) const {}
    __device__ __forceinline__ void done(const Unit&) const {}
};

typedef float f32x2c __attribute__((ext_vector_type(2)));
typedef __bf16 bf16x2c __attribute__((ext_vector_type(2)));
__device__ __forceinline__ unsigned cvt_pk_bf16(float lo, float hi) { const f32x2c v = {lo, hi}; const bf16x2c b = __builtin_convertvector(v, bf16x2c); return __builtin_bit_cast(unsigned, b); }

struct EpiStore {
    static constexpr bool PERM = true, AFTER_DRAIN = false;
    bf16_t* O; int ldc;
    __device__ __forceinline__ void operator()(const f32x4 (&acc)[2][2][4][2], const Unit& u, int wr, int wc, int fr, int fq) const {
        const int row0 = u.pm * BM + wr * 64 + fr; const int col0 = u.pn * BM + wc * 32 + 8 * fq;
#pragma unroll
        for (int ai = 0; ai < 2; ++ai)
#pragma unroll
            for (int m = 0; m < 4; ++m) { bf16_t* rowp = O + (size_t)(row0 + ai * HALF + m * 16) * ldc + col0;
#pragma unroll
                for (int bj = 0; bj < 2; ++bj) { const f32x4 v0 = acc[ai][bj][m][0], v1 = acc[ai][bj][m][1];
                    u32x4 w; w.x = cvt_pk_bf16(v0[0], v0[1]); w.y = cvt_pk_bf16(v0[2], v0[3]); w.z = cvt_pk_bf16(v1[0], v1[1]); w.w = cvt_pk_bf16(v1[2], v1[3]);
                    *(u32x4*)(rowp + bj * HALF) = w; } }
    }
};
struct EpiResid {
    static constexpr bool PERM = true, AFTER_DRAIN = false;
    bf16_t* dout; const float* gate_base;
    float* slab; unsigned* cnt;
    __device__ __forceinline__ void operator()(f32x4 (&acc)[2][2][4][2], const Unit& u, int wr, int wc, int fr, int fq) const {
        const int tid = (wr * 4 + wc) * 64 + fq * 16 + fr;
        const f32x4* sl = nullptr;
        if (u.np > 1) {
            float* sb = slab + (size_t)u.tix * (u.np - 1) * 65536;
            if (u.kp < u.np - 1) {
                f32x4* sp = (f32x4*)(sb + (size_t)u.kp * 65536) + tid;
#pragma unroll
                for (int ai = 0; ai < 2; ++ai)
#pragma unroll
                    for (int bj = 0; bj < 2; ++bj)
#pragma unroll
                        for (int m = 0; m < 4; ++m)
#pragma unroll
                            for (int n = 0; n < 2; ++n) sp[(((ai * 2 + bj) * 4 + m) * 2 + n) * 512] = acc[ai][bj][m][n];
                asm volatile("s_waitcnt vmcnt(0)" ::: "memory");
                __syncthreads();
                if (tid == 0) { __builtin_amdgcn_fence(__ATOMIC_RELEASE, "agent"); asm volatile("s_waitcnt vmcnt(0)" ::: "memory");
                    __hip_atomic_fetch_add(cnt + u.tix, 1u, __ATOMIC_RELAXED, __HIP_MEMORY_SCOPE_AGENT); }
                return;
            }
            if (tid == 0) { unsigned sp_ = 0;
                while (__hip_atomic_load(cnt + u.tix, __ATOMIC_RELAXED, __HIP_MEMORY_SCOPE_AGENT) < (unsigned)(u.np - 1)) { __builtin_amdgcn_s_sleep(2); if (++sp_ > (1u << 22)) break; }
                __builtin_amdgcn_fence(__ATOMIC_ACQUIRE, "agent"); asm volatile("s_waitcnt vmcnt(0)" ::: "memory"); }
            __syncthreads();
            sl = (const f32x4*)sb + tid;
        }
        const int pm = u.pm;
        const int ci = pm < 16 ? 4 : ((pm - 16) >> 3);
        const float* gt = gate_base + ci * 6144;
        const int row0 = pm * BM + wr * 64 + fr, col0 = u.pn * BM + wc * 32 + 8 * fq;
#pragma unroll
        for (int bj = 0; bj < 2; ++bj) { const f32x4 gq0 = *(const f32x4*)(gt + col0 + bj * HALF), gq1 = *(const f32x4*)(gt + col0 + bj * HALF + 4);
#pragma unroll
            for (int ai = 0; ai < 2; ++ai) {
#pragma unroll
                for (int m = 0; m < 4; ++m) { f32x4 a0 = acc[ai][bj][m][0], a1 = acc[ai][bj][m][1];
                    if (sl) { a0 += sl[(((ai * 2 + bj) * 4 + m) * 2 + 0) * 512]; a1 += sl[(((ai * 2 + bj) * 4 + m) * 2 + 1) * 512]; }
                    a0 = a0 * gq0; a1 = a1 * gq1;
                    u32x4 w; w.x = cvt_pk_bf16(a0[0], a0[1]); w.y = cvt_pk_bf16(a0[2], a0[3]); w.z = cvt_pk_bf16(a1[0], a1[1]); w.w = cvt_pk_bf16(a1[2], a1[3]);
                    *(u32x4*)(dout + (size_t)(row0 + ai * HALF + m * 16) * 2048 + col0 + bj * HALF) = w; }
                asm volatile("" ::: "memory"); } }
    }
};

template <class Epi, class Sched, bool ALIGN_EPI = false, bool SP2 = false>
__device__ __forceinline__ void gemm_phase(PG8_LAS unsigned char* lds, const Gemm g, const Sched& S, const Epi& E) {
    const int tid = pg8_otid(), wid = __builtin_amdgcn_readfirstlane(tid >> 6), lane = tid & 63, wr = wid >> 2, wc = wid & 3, fr = lane & 15, fq = lane >> 4;
    const int K = g.K, nt = K / BK;
    unsigned voffA[2], voffB[2];
#pragma unroll
    for (int i = 0; i < 2; ++i) { int R, C; stage_rc(tid * 16 + i * 8192, R, C); const int Rb = Epi::PERM ? ((R & ~31) + perm32(R & 31)) : R;
        voffA[i] = (unsigned)(R * K + C) * 2u; voffB[i] = (unsigned)(Rb * K + C) * 2u; }
    const size_t kstep = (size_t)(BK * 2);
    const size_t hstep = (size_t)HALF * K * 2;
    const size_t tstep = 2 * hstep;
    const unsigned ldsw = (unsigned)wid * 1024u;
    const int aoff = lds_byte(wr * 64 + fr, fq * 8), boff = lds_byte(wc * 32 + fr, fq * 8);
#define PG8_SA(b, h) (((b) * 2 + (h)) * HTB)
#define PG8_SB(b, h) ((4 + (b) * 2 + (h)) * HTB)
#define PG8_STAGE(bufoff, gbase, voff) do { _Pragma("unroll") for (int _i = 0; _i < 2; ++_i) \
        __builtin_amdgcn_global_load_lds((const unsigned*)((const char*)(gbase) + (voff)[_i]), (PG8_LAS unsigned*)(lds + (bufoff) + ldsw + _i * 8192), 16, 0, 0); } while (0)
#define PG8_LDA(dst, b, h) do { _Pragma("unroll") for (int m = 0; m < 4; ++m) _Pragma("unroll") for (int k = 0; k < 2; ++k) dst[m][k] = *(const PG8_LAS bf16x8*)(lds + PG8_SA(b, h) + aoff + m * 2048 + k * 1024); } while (0)
#define PG8_LDB(dst, b, h) do { _Pragma("unroll") for (int n = 0; n < 2; ++n) _Pragma("unroll") for (int k = 0; k < 2; ++k) dst[n][k] = *(const PG8_LAS bf16x8*)(lds + PG8_SB(b, h) + boff + n * 2048 + k * 1024); } while (0)
#define PG8_MMA(ai, bj, At, Bt) do { __builtin_amdgcn_s_setprio(1); _Pragma("unroll") for (int m = 0; m < 4; ++m) _Pragma("unroll") for (int n = 0; n < 2; ++n) _Pragma("unroll") for (int k = 0; k < 2; ++k) \
        acc[ai][bj][m][n] = __builtin_amdgcn_mfma_f32_16x16x32_bf16(Bt[n][k], At[m][k], acc[ai][bj][m][n], 0, 0, 0); __builtin_amdgcn_s_setprio(0); } while (0)
#define PG8_WAIT_V(n) asm volatile("s_waitcnt vmcnt(" #n ")" ::: "memory")
#define PG8_WAIT_L(n) asm volatile("s_waitcnt lgkmcnt(" #n ")" ::: "memory")
#define PG8_BAR __builtin_amdgcn_s_barrier()
#define PG8_SCHED __builtin_amdgcn_sched_barrier(0)
    Unit cur, nxt; int ui = 0;
    if (!S.next(0, cur)) return;
    f32x4 acc[2][2][4][2];
#pragma unroll
    for (int a = 0; a < 2; ++a)
#pragma unroll
        for (int b = 0; b < 2; ++b)
#pragma unroll
            for (int m = 0; m < 4; ++m)
#pragma unroll
                for (int n = 0; n < 2; ++n) acc[a][b][m][n] = (f32x4){0.f, 0.f, 0.f, 0.f};
    bf16x8 At[4][2], B0[2][2], B1[2][2];
    const char* cA = (const char*)g.A + (size_t)cur.pm * tstep + (size_t)cur.kp * (K / cur.np) * 2; const char* cB = (const char*)g.Bt + (size_t)cur.pn * tstep + (size_t)cur.kp * (K / cur.np) * 2;
    S.a_ready(cur);
    if constexpr (SP2) {
        PG8_STAGE(PG8_SB(0, 0), cB, voffB); PG8_STAGE(PG8_SB(0, 1), cB + hstep, voffB); PG8_STAGE(PG8_SA(0, 0), cA, voffA); PG8_STAGE(PG8_SA(0, 1), cA + hstep, voffA);
        if (wr == 1) PG8_BAR;
        PG8_WAIT_V(2); PG8_BAR;
        PG8_STAGE(PG8_SB(1, 0), cB + kstep, voffB); PG8_STAGE(PG8_SA(1, 0), cA + kstep, voffA); PG8_STAGE(PG8_SB(1, 1), cB + hstep + kstep, voffB);
        PG8_WAIT_V(6); PG8_BAR;
    } else {
        PG8_STAGE(PG8_SB(0, 0), cB, voffB); PG8_STAGE(PG8_SA(0, 0), cA, voffA); PG8_STAGE(PG8_SB(0, 1), cB + hstep, voffB); PG8_STAGE(PG8_SA(0, 1), cA + hstep, voffA);
        if (wr == 1) PG8_BAR;
        PG8_WAIT_V(4); PG8_BAR;
        PG8_STAGE(PG8_SB(1, 0), cB + kstep, voffB); PG8_STAGE(PG8_SA(1, 0), cA + kstep, voffA); PG8_STAGE(PG8_SB(1, 1), cB + hstep + kstep, voffB);
        PG8_WAIT_V(6); PG8_BAR;
    }
    for (;;) {
        const bool has_next = S.next(ui + 1, nxt);
        const size_t nko = has_next ? (size_t)nxt.kp * (K / nxt.np) * 2 : 0; const char* nA = has_next ? (const char*)g.A + (size_t)nxt.pm * tstep + nko : cA; const char* nB = has_next ? (const char*)g.Bt + (size_t)nxt.pn * tstep + nko : cB;
        const int ntc = nt / cur.np;
        for (int t = 0; t < ntc; t += 2) {
            const bool last = (t == ntc - 2);
            const char* a1 = cA + (size_t)(t + 1) * kstep;
            const char* a2 = last ? nA : cA + (size_t)(t + 2) * kstep; const char* b2 = last ? nB : cB + (size_t)(t + 2) * kstep;
            const char* a3 = a2 + kstep; const char* b3 = b2 + kstep;
            if (last && has_next) S.a_ready(nxt);
            if constexpr (SP2) {
            PG8_LDB(B0, 0, 0); PG8_LDB(B1, 0, 1); PG8_SCHED; PG8_LDA(At, 0, 0); PG8_STAGE(PG8_SA(1, 1), a1 + hstep, voffA);
            PG8_WAIT_V(8); PG8_WAIT_L(0); PG8_BAR; PG8_MMA(0, 0, At, B0); PG8_MMA(0, 1, At, B1); PG8_BAR; PG8_SCHED;
            PG8_LDA(At, 0, 1); PG8_STAGE(PG8_SB(0, 0), b2, voffB); PG8_STAGE(PG8_SB(0, 1), b2 + hstep, voffB); PG8_STAGE(PG8_SA(0, 0), a2, voffA);
            PG8_WAIT_V(8); PG8_WAIT_L(0); PG8_BAR; PG8_MMA(1, 0, At, B0); PG8_MMA(1, 1, At, B1); PG8_BAR; PG8_SCHED;
            PG8_LDB(B0, 1, 0); PG8_LDB(B1, 1, 1); PG8_SCHED; PG8_LDA(At, 1, 0); PG8_STAGE(PG8_SA(0, 1), a2 + hstep, voffA);
            PG8_WAIT_V(8); PG8_WAIT_L(0); PG8_BAR; PG8_MMA(0, 0, At, B0); PG8_MMA(0, 1, At, B1); PG8_BAR; PG8_SCHED;
            PG8_LDA(At, 1, 1); PG8_STAGE(PG8_SB(1, 0), b3, voffB); PG8_STAGE(PG8_SB(1, 1), b3 + hstep, voffB); PG8_STAGE(PG8_SA(1, 0), a3, voffA);
            PG8_WAIT_V(8); PG8_WAIT_L(0); PG8_BAR; PG8_MMA(1, 0, At, B0); PG8_MMA(1, 1, At, B1); PG8_BAR; PG8_SCHED;
            } else {
            PG8_LDB(B0, 0, 0); PG8_SCHED; PG8_LDA(At, 0, 0); PG8_STAGE(PG8_SA(1, 1), a1 + hstep, voffA);
            PG8_WAIT_L(8); PG8_BAR; PG8_WAIT_L(0); PG8_MMA(0, 0, At, B0); PG8_BAR; PG8_SCHED;
            PG8_LDB(B1, 0, 1); PG8_STAGE(PG8_SB(0, 0), b2, voffB);
            PG8_BAR; PG8_WAIT_L(0); PG8_MMA(0, 1, At, B1); PG8_BAR;
            PG8_LDA(At, 0, 1); PG8_STAGE(PG8_SA(0, 0), a2, voffA);
            PG8_BAR; PG8_WAIT_L(0); PG8_MMA(1, 0, At, B0); PG8_BAR; PG8_SCHED;
            PG8_STAGE(PG8_SB(0, 1), b2 + hstep, voffB);
            PG8_WAIT_V(6); PG8_BAR; PG8_MMA(1, 1, At, B1); PG8_BAR;
            PG8_LDB(B0, 1, 0); PG8_SCHED; PG8_LDA(At, 1, 0); PG8_STAGE(PG8_SA(0, 1), a2 + hstep, voffA);
            PG8_WAIT_L(8); PG8_BAR; PG8_WAIT_L(0); PG8_MMA(0, 0, At, B0); PG8_BAR; PG8_SCHED;
            PG8_LDB(B1, 1, 1); PG8_STAGE(PG8_SB(1, 0), b3, voffB);
            PG8_BAR; PG8_WAIT_L(0); PG8_MMA(0, 1, At, B1); PG8_BAR;
            PG8_LDA(At, 1, 1); PG8_STAGE(PG8_SA(1, 0), a3, voffA);
            PG8_BAR; PG8_WAIT_L(0); PG8_MMA(1, 0, At, B0); PG8_BAR; PG8_SCHED;
            PG8_STAGE(PG8_SB(1, 1), b3 + hstep, voffB);
            PG8_WAIT_V(6); PG8_BAR; PG8_MMA(1, 1, At, B1); PG8_BAR;
            }
        }
        if constexpr (ALIGN_EPI) { if (wr == 0) PG8_BAR; }
        if constexpr (!Epi::AFTER_DRAIN) { E(acc, cur, wr, wc, fr, fq); S.done(cur); }
        if (!has_next) break;
#pragma unroll
        for (int a = 0; a < 2; ++a)
#pragma unroll
            for (int b = 0; b < 2; ++b)
#pragma unroll
                for (int m = 0; m < 4; ++m)
#pragma unroll
                    for (int n = 0; n < 2; ++n) acc[a][b][m][n] = (f32x4){0.f, 0.f, 0.f, 0.f};
        cur = nxt; cA = nA; cB = nB; ++ui;
        if constexpr (ALIGN_EPI) { if (wr == 1) PG8_BAR; }
    }
    PG8_WAIT_V(0);
    if constexpr (!ALIGN_EPI) { if (wr == 0) PG8_BAR; }
    PG8_BAR;
    if constexpr (Epi::AFTER_DRAIN) { E.fused(acc, cur, wr, wc, fr, fq, lds, wid, lane); S.done(cur); }
#undef PG8_SA
#undef PG8_SB
#undef PG8_STAGE
#undef PG8_LDA
#undef PG8_LDB
#undef PG8_MMA
#undef PG8_WAIT_V
#undef PG8_WAIT_L
#undef PG8_BAR
#undef PG8_SCHED
}
}

#define LAS __attribute__((address_space(3)))
typedef unsigned short bf16_t;
typedef short bf16x8 __attribute__((ext_vector_type(8)));
typedef short s16x4 __attribute__((ext_vector_type(4)));
typedef float f32x4 __attribute__((ext_vector_type(4)));
typedef float f32x16 __attribute__((ext_vector_type(16)));
typedef unsigned u32x4 __attribute__((ext_vector_type(4)));
typedef unsigned u32x2 __attribute__((ext_vector_type(2)));


__device__ __forceinline__ int otid() { int t = threadIdx.x; asm volatile("" : "+v"(t)); return t; }
__device__ __forceinline__ unsigned ozero() { unsigned z = 0u; asm volatile("" : "+v"(z)); return z; }
__device__ __forceinline__ int obid() { int b = blockIdx.x; asm volatile("" : "+s"(b)); return b; }
constexpr int NWAVES = 8, NTHR = 512;
constexpr int DM = 2048, MC = 4096, ML = 8192, MROWS = 12288, MKROWS = 13312;
constexpr int LDP_AB = 7168, LDP_C = 5120;
constexpr int COL_QL = 0, COL_KVL = 512, COL_AG = 768, COL_BQ = 1792, COL_FF = 2816, COL_FB = 3840, COL_BI = 4864, COL_BG = 5888, COL_KPE = 6912;
constexpr float EPSN = 1e-6f;
constexpr float LOG2E = 1.4426950408889634f;
constexpr float QSC_A = 0.07216878364870322f * LOG2E;
constexpr float QSC_C = 0.08838834764831845f * LOG2E;

constexpr size_t O_YP = 0, O_YS = 8388608, O_CKV = 25165824, O_KPE = 27262976, O_SF = 27787264, O_SB = 31981568, O_KC = 36175872, O_VC = 40370176;

constexpr size_t MiB = 1u << 20;
constexpr size_t WS_CTL = 0, CTL_BYTES = 131072;
constexpr size_t WS_MOD = 1 * MiB, WS_LB = WS_MOD + 512 * 1024, WS_ROPEA = WS_LB + 64 * 1024, WS_ROPEC = WS_ROPEA + 512 * 1024;
constexpr size_t WS_KCC = 532 * MiB;
constexpr size_t WS_WINAB = 8 * MiB, WS_WQUP = 64 * MiB, WS_WKVUP = 67 * MiB, WS_WOUTAB = 69 * MiB, WS_WINC = 85 * MiB, WS_WOUTC = 125 * MiB;
constexpr size_t WS_H = 141 * MiB, WS_PROJ = 189 * MiB, WS_QRAW = 357 * MiB, WS_KVRAW = 393 * MiB, WS_KF = 445 * MiB, WS_OF = 484 * MiB, WS_OB = 508 * MiB;
constexpr size_t WS_QN = WS_H, WS_CKV = WS_H + 12 * MiB, WS_END = 552 * MiB;
constexpr size_t WS_SBUF = 4 * MiB;
constexpr int NBG = 64;

constexpr int LDS_PHASE = 131072, LDS_BYTES = LDS_PHASE + 1024;

__device__ __forceinline__ float bf2f(unsigned short b) { return __uint_as_float((unsigned)b << 16); }
typedef float f32x2_t __attribute__((ext_vector_type(2)));
typedef __bf16 bf16x2_t __attribute__((ext_vector_type(2)));
__device__ __forceinline__ unsigned pk2(float lo, float hi) { const f32x2_t v = {lo, hi}; const bf16x2_t b = __builtin_convertvector(v, bf16x2_t); return __builtin_bit_cast(unsigned, b); }
__device__ __forceinline__ unsigned f2bf(float f) { return pk2(f, 0.f) & 0xffffu; }
__device__ __forceinline__ float silu_f(float x) { return x * __builtin_amdgcn_rcpf(1.f + __expf(-x)); }
__device__ __forceinline__ float wave_sum(float v) {
#pragma unroll
    for (int o = 1; o < 64; o <<= 1) v += __shfl_xor(v, o);
    return v;
}
__device__ __forceinline__ float sum16(float v) {
    v += __shfl_xor(v, 1); v += __shfl_xor(v, 2); v += __shfl_xor(v, 4); v += __shfl_xor(v, 8); return v;
}
__device__ __forceinline__ bf16x8 pack8(const float* v) {
    u32x4 w; w.x = pk2(v[0], v[1]); w.y = pk2(v[2], v[3]); w.z = pk2(v[4], v[5]); w.w = pk2(v[6], v[7]); return __builtin_bit_cast(bf16x8, w);
}

struct Args { const float* in[31]; float* out; unsigned char* ws; };
typedef const Args __attribute__((address_space(4)))* KArgs;

struct P0Item { const float* W; bf16_t* WT; int K, N, k0, n0, d0; };
__device__ __forceinline__ void p0_load(const P0Item& q, float (&v)[32], int lane) {
#pragma unroll
    for (int i = 0; i < 32; ++i) { const int kk = 2 * i + (lane >> 5); v[i] = q.W[(size_t)(q.k0 + kk) * q.N + q.n0 + (lane & 31)]; }
}
__device__ __forceinline__ void p0_emit(const P0Item& q, const float (&v)[32], LAS float* scr, int lane) {
#pragma unroll
    for (int i = 0; i < 32; ++i) { const int kk = 2 * i + (lane >> 5); scr[kk * 33 + (lane & 31)] = v[i]; }
    asm volatile("s_waitcnt lgkmcnt(0)" ::: "memory");
    const int c = lane & 7;
#pragma unroll
    for (int j = 0; j < 4; ++j) { const int n = (lane >> 3) + 8 * j; const LAS float* s = scr + (8 * c) * 33 + n;
        u32x4 o; o.x = pk2(s[0 * 33], s[1 * 33]); o.y = pk2(s[2 * 33], s[3 * 33]); o.z = pk2(s[4 * 33], s[5 * 33]); o.w = pk2(s[6 * 33], s[7 * 33]);
        *(u32x4*)(q.WT + (size_t)(q.d0 + n) * q.K + q.k0 + 8 * c) = o; }
    asm volatile("s_waitcnt lgkmcnt(0)" ::: "memory");
}
__device__ __forceinline__ P0Item p0_decode(KArgs a, int it) {
    constexpr int I_INAB = 32 * 218, I_QUP = 8 * 48, I_KVUP = 4 * 64, I_OUT = 32 * 64, I_INC = 32 * 160;
    constexpr int PER_J = I_INAB + I_QUP + I_KVUP + I_OUT + I_INC + I_OUT;
    unsigned char* ws = a->ws; P0Item q;
    const int j = it / PER_J; int r = it % PER_J;
    if (r < I_INAB) { const int kb = r / 218, nb = r % 218, n0 = nb * 32;
        q.W = a->in[13] + (size_t)j * 2048 * 6976; q.WT = (bf16_t*)(ws + WS_WINAB) + (size_t)j * 7168 * 2048; q.K = 2048; q.N = 6976; q.k0 = kb * 64; q.n0 = n0; q.d0 = n0 < 768 ? n0 : (n0 < 832 ? n0 + 6144 : n0 - 64); return q; }
    r -= I_INAB;
    if (r < I_QUP) { const int kb = r / 48, nb = r % 48;
        q.W = a->in[16] + (size_t)j * 512 * 1536; q.WT = (bf16_t*)(ws + WS_WQUP) + (size_t)j * 1536 * 512; q.K = 512; q.N = 1536; q.k0 = kb * 64; q.n0 = nb * 32; q.d0 = nb * 32; return q; }
    r -= I_QUP;
    if (r < I_KVUP) { const int kb = r / 64, nb = r % 64;
        q.W = a->in[17] + (size_t)j * 256 * 2048; q.WT = (bf16_t*)(ws + WS_WKVUP) + (size_t)j * 2048 * 256; q.K = 256; q.N = 2048; q.k0 = kb * 64; q.n0 = nb * 32; q.d0 = nb * 32; return q; }
    r -= I_KVUP;
    if (r < I_OUT) { const int kb = r / 64, nb = r % 64;
        q.W = a->in[22] + (size_t)j * 2048 * 2048; q.WT = (bf16_t*)(ws + WS_WOUTAB) + (size_t)j * 2048 * 2048; q.K = 2048; q.N = 2048; q.k0 = kb * 64; q.n0 = nb * 32; q.d0 = nb * 32; return q; }
    r -= I_OUT;
    if (r < I_INC) { const int kb = r / 160, nb = r % 160;
        q.W = a->in[26] + (size_t)j * 2048 * 5120; q.WT = (bf16_t*)(ws + WS_WINC) + (size_t)j * 5120 * 2048; q.K = 2048; q.N = 5120; q.k0 = kb * 64; q.n0 = nb * 32; q.d0 = nb * 32; return q; }
    r -= I_INC;
    { const int kb = r / 64, nb = r % 64;
        q.W = a->in[30] + (size_t)j * 2048 * 2048; q.WT = (bf16_t*)(ws + WS_WOUTC) + (size_t)j * 2048 * 2048; q.K = 2048; q.N = 2048; q.k0 = kb * 64; q.n0 = nb * 32; q.d0 = nb * 32; return q; }
}

__device__ __forceinline__ void p0_transposes(KArgs a, LAS unsigned char* lds, int lo, int hi, int w, int NW) {
    const int lane = otid() & 63, wave = (otid() >> 6);
    LAS float* scr = (LAS float*)(lds + wave * 8448);
    for (int it = lo + w; it < hi; it += 2 * NW) {
        const bool two = it + NW < hi;
        const P0Item qa = p0_decode(a, it); const P0Item qb = p0_decode(a, two ? it + NW : it);
        float va[32], vb[32];
        p0_load(qa, va, lane); if (two) p0_load(qb, vb, lane);
        p0_emit(qa, va, scr, lane); if (two) p0_emit(qb, vb, scr, lane);
    }
}
constexpr int P0_EARLY = 32 * 218 + 8 * 48 + 4 * 64 + 32 * 64;
constexpr int P0_TOTAL = 2 * (32 * 218 + 8 * 48 + 4 * 64 + 32 * 64 + 32 * 160 + 32 * 64);
__device__ __forceinline__ void phase_p0(KArgs a, LAS unsigned char* lds) {
    const int tid = otid(), lane = tid & 63, wave = tid >> 6;
    const int G = gridDim.x, bid = obid();
    const int gw = bid * NWAVES + wave, NGW = G * NWAVES;
    unsigned char* ws = a->ws;
    p0_transposes(a, lds, 0, P0_EARLY, gw, NGW);
    p0_transposes(a, lds, P0_EARLY + 16000, P0_TOTAL, gw, NGW);
    const int gt = bid * NTHR + tid, NGT = G * NTHR;
    const unsigned zz = ozero();
    for (int i = gt; i < 2 * 192 * 256; i += NGT) { const int j = i / (192 * 256), r = i % (192 * 256);
        *(u32x4*)((bf16_t*)(ws + WS_WINAB) + (size_t)j * 7168 * 2048 + (size_t)6976 * 2048 + (size_t)r * 8) = (u32x4){zz, zz, zz, zz}; }
    for (int i = gt; i < 2 * 131072; i += NGT) { const int which = i / 131072, e = (i % 131072) * 8;
        const float* src = a->in[6 + which] + e; const f32x4 x0 = *(const f32x4*)src, x1 = *(const f32x4*)(src + 4);
        u32x4 w; w.x = pk2(x0[0], x0[1]); w.y = pk2(x0[2], x0[3]); w.z = pk2(x1[0], x1[1]); w.w = pk2(x1[2], x1[3]);
        *(u32x4*)((bf16_t*)(ws + WS_KCC) + (size_t)(e >> 9) * LDP_C + (which ? 512 : 0) + (e & 511)) = w; }
    for (int i = gt; i < 2 * 2048; i += NGT) { const int j = i / 2048, r = i % 2048; const float l0 = a->in[20][r], l1 = a->in[20][2048 + r];
        ((float*)(ws + WS_LB))[i] = j == 0 ? 0.f : 1.f / (1.f + __expf(l0 - l1)); }
    for (int i = gt; i < 2048 * 32; i += NGT) { const int t = i >> 5, f = i & 31; const float pos = f < 16 ? (float)(t >> 6) : (float)(t & 63);
        const float inv = exp2f(-(float)(f & 15) * (13.287712379549449f / 16.f)); const float ang = pos * inv;
        ((float*)(ws + WS_ROPEA))[2 * i] = __cosf(ang); ((float*)(ws + WS_ROPEA))[2 * i + 1] = __sinf(ang); }
    for (int i = gt; i < 2048 * 64; i += NGT) { const int t = i >> 6, f = i & 63; const float pos = f < 32 ? (float)(t >> 6) : (float)(t & 63);
        const float inv = exp2f(-(float)(f & 31) * (13.287712379549449f / 32.f)); const float ang = pos * inv;
        ((float*)(ws + WS_ROPEC))[2 * i] = __cosf(ang); ((float*)(ws + WS_ROPEC))[2 * i + 1] = __sinf(ang); }
    __syncthreads();
    {
        LAS float* SC = (LAS float*)lds;
        LAS float* RED = (LAS float*)(lds + 40960);
        for (int i = tid; i < 5 * 2048; i += NTHR) { const int b = i >> 11, k = i & 2047; const float x = b < 4 ? a->in[8][b * 2048 + k] : a->in[9][k]; SC[i] = silu_f(x); }
        __syncthreads();
        const int cq = tid & 7, ks = tid >> 3;
        for (int u = bid; u < 768; u += G) {
            const int L = u / 192, col0 = (u % 192) * 32;
            const float* W = ((L & 1) ? a->in[23] : a->in[10]) + (size_t)(L >> 1) * 2048 * 6144;
            const float* bias = ((L & 1) ? a->in[24] : a->in[11]) + (size_t)(L >> 1) * 6144;
            f32x4 acc[5];
#pragma unroll
            for (int b = 0; b < 5; ++b) acc[b] = (f32x4){0.f, 0.f, 0.f, 0.f};
#pragma unroll 16
            for (int kk = 0; kk < 32; ++kk) { const int k = 32 * ks + kk; const f32x4 w = *(const f32x4*)(W + (size_t)k * 6144 + col0 + 4 * cq);
#pragma unroll
                for (int b = 0; b < 5; ++b) acc[b] += SC[b * 2048 + k] * w; }
#pragma unroll
            for (int b = 0; b < 5; ++b) *(LAS f32x4*)(RED + (ks * 5 + b) * 32 + 4 * cq) = acc[b];
            __syncthreads();
            if (tid < 160) { const int b = tid >> 5, c = tid & 31; float s = 0.f;
                for (int q = 0; q < 64; ++q) s += RED[(q * 5 + b) * 32 + c];
                ((float*)(ws + WS_MOD))[(L * 5 + b) * 6144 + col0 + c] = s + bias[col0 + c]; }
            __syncthreads();
        }
    }
}

__device__ __forceinline__ void phase_modnorm(KArgs a, int L) {
    const int tid = otid(), lane = tid & 63, wave = tid >> 6;
    const int gw = obid() * NWAVES + wave, NGW = gridDim.x * NWAVES;
    const float* g = ((L & 1) ? a->in[25] : a->in[12]) + (L >> 1) * 2048;
    bf16_t* H = (bf16_t*)(a->ws + WS_H);
    for (int r0 = gw * 2; r0 < MROWS; r0 += NGW * 2) {
        f32x4 v[2][8]; float ss[2] = {0.f, 0.f};
#pragma unroll
        for (int u = 0; u < 2; ++u) { const int r = r0 + u;
            const float* x = L <= 1 ? (r < MC ? a->in[0] + (size_t)r * DM : a->in[1] + (size_t)(r - MC) * DM) : a->out + (size_t)r * DM;
#pragma unroll
            for (int j = 0; j < 8; ++j) v[u][j] = *(const f32x4*)(x + 256 * j + 4 * lane);
            if (L > 0) { const bf16_t* dp = (const bf16_t*)(a->ws + WS_PROJ) + (size_t)r * DM;
#pragma unroll
                for (int j = 0; j < 8; ++j) { const u32x2 dv = *(const u32x2*)(dp + 256 * j + 4 * lane);
                    v[u][j][0] += __uint_as_float(dv.x << 16); v[u][j][1] += __uint_as_float(dv.x & 0xffff0000u); v[u][j][2] += __uint_as_float(dv.y << 16); v[u][j][3] += __uint_as_float(dv.y & 0xffff0000u);
                    *(f32x4*)(a->out + (size_t)r * DM + 256 * j + 4 * lane) = v[u][j]; } } }
#pragma unroll
        for (int u = 0; u < 2; ++u) {
#pragma unroll
            for (int j = 0; j < 8; ++j) ss[u] += (v[u][j][0] * v[u][j][0] + v[u][j][1] * v[u][j][1]) + (v[u][j][2] * v[u][j][2] + v[u][j][3] * v[u][j][3]); }
#pragma unroll
        for (int u = 0; u < 2; ++u) { const int r = r0 + u;
            const int ci = r < MC ? 4 : ((r - MC) >> 11);
            const float* md = (const float*)(a->ws + WS_MOD) + (L * 5 + ci) * 6144;
            const float rstd = rsqrtf(wave_sum(ss[u]) * (1.f / 2048.f) + EPSN);
#pragma unroll
            for (int j = 0; j < 8; ++j) { const int c = 256 * j + 4 * lane;
                const f32x4 gg = *(const f32x4*)(g + c), sh = *(const f32x4*)(md + c), sc = *(const f32x4*)(md + 2048 + c);
                const f32x4 y = (v[u][j] * rstd * gg) * (sc + 1.f) + sh;
                u32x2 w; w.x = pk2(y[0], y[1]); w.y = pk2(y[2], y[3]);
                *(u32x2*)(H + (size_t)r * DM + c) = w; } }
    }
}

__device__ __forceinline__ void phase_final(KArgs a) {
    const int tid = otid();
    const int gt = obid() * NTHR + tid, NGT = gridDim.x * NTHR;
    const bf16_t* D = (const bf16_t*)(a->ws + WS_PROJ); float* out = a->out;
    for (int i = gt; i < MROWS * DM / 8; i += NGT) { const size_t e = (size_t)i * 8;
        const bf16x8 dv = *(const bf16x8*)(D + e); f32x4 x0 = *(const f32x4*)(out + e), x1 = *(const f32x4*)(out + e + 4);
        x0[0] += bf2f((unsigned short)dv[0]); x0[1] += bf2f((unsigned short)dv[1]); x0[2] += bf2f((unsigned short)dv[2]); x0[3] += bf2f((unsigned short)dv[3]);
        x1[0] += bf2f((unsigned short)dv[4]); x1[1] += bf2f((unsigned short)dv[5]); x1[2] += bf2f((unsigned short)dv[6]); x1[3] += bf2f((unsigned short)dv[7]);
        *(f32x4*)(out + e) = x0; *(f32x4*)(out + e + 4) = x1; }
}

__device__ __forceinline__ void phase_prep_ab(KArgs a, int j, int wg, int nwg) {
    const int tid = otid(), lane = tid & 63, wave = tid >> 6;
    const int gw = wg * NWAVES + wave, NGW = nwg * NWAVES;
    const bf16_t* P = (const bf16_t*)(a->ws + WS_PROJ);
    bf16_t* QN = (bf16_t*)(a->ws + WS_QN); bf16_t* CKV = (bf16_t*)(a->ws + WS_CKV);
    const float* gq = a->in[14] + j * 512; const float* gkv = a->in[15] + j * 256;
    for (int r = gw; r < MKROWS; r += NGW) {
        if (r < MROWS) {
            const bf16_t* p = P + (size_t)r * LDP_AB;
            const bf16x8 q = *(const bf16x8*)(p + COL_QL + 8 * lane);
            float qv[8]; float ss = 0.f;
#pragma unroll
            for (int e = 0; e < 8; ++e) { qv[e] = bf2f((unsigned short)q[e]); ss += qv[e] * qv[e]; }
            const float rq = rsqrtf(wave_sum(ss) * (1.f / 512.f) + EPSN);
#pragma unroll
            for (int e = 0; e < 8; ++e) qv[e] = qv[e] * rq * gq[8 * lane + e];
            *(bf16x8*)(QN + (size_t)r * 512 + 8 * lane) = pack8(qv);
            const s16x4 kv = *(const s16x4*)(p + COL_KVL + 4 * lane);
            float kf[4]; float s2 = 0.f;
#pragma unroll
            for (int e = 0; e < 4; ++e) { kf[e] = bf2f((unsigned short)kv[e]); s2 += kf[e] * kf[e]; }
            const float rk = rsqrtf(wave_sum(s2) * (1.f / 256.f) + EPSN);
#pragma unroll
            for (int e = 0; e < 4; ++e) kf[e] = kf[e] * rk * gkv[4 * lane + e];
            u32x2 w; w.x = pk2(kf[0], kf[1]); w.y = pk2(kf[2], kf[3]);
            *(u32x2*)(CKV + (size_t)r * 256 + 4 * lane) = w;
            if (r < MC) { const int b = r >> 8, t = r & 255; const size_t rowo = (size_t)((b * 2 + j) * 256 + t);
                *(f32x4*)(a->out + O_CKV + rowo * 256 + 4 * lane) = (f32x4){kf[0], kf[1], kf[2], kf[3]};
                a->out[O_KPE + rowo * 64 + lane] = bf2f(p[COL_KPE + lane]); }
        } else {
            const int rr = r - MROWS, b = rr >> 8, t = rr & 255;
            const f32x4 x = *(const f32x4*)(a->in[2] + (size_t)((b * 2 + j) * 256 + t) * 256 + 4 * lane);
            u32x2 w; w.x = pk2(x[0], x[1]); w.y = pk2(x[2], x[3]);
            *(u32x2*)(CKV + (size_t)r * 256 + 4 * lane) = w;
        }
    }
}

__device__ __forceinline__ void phase_hn_ab(KArgs a, int j, int wg, int nwg) {
    const int tid = otid(), lane = tid & 63, wave = tid >> 6, sub = lane & 15, hq = lane >> 4;
    const int gw = wg * NWAVES + wave, NGW = nwg * NWAVES;
    bf16_t* Q = (bf16_t*)(a->ws + WS_QRAW); const bf16_t* KV = (const bf16_t*)(a->ws + WS_KVRAW); bf16_t* KF = (bf16_t*)(a->ws + WS_KF);
    const bf16_t* P = (const bf16_t*)(a->ws + WS_PROJ);
    const float* RA = (const float*)(a->ws + WS_ROPEA);
    const float* gq = a->in[18] + j * 192; const float* gk = a->in[19] + j * 192;
    const float* ckpe = a->in[3];
    constexpr int U = 4;
    const int NQ = 0, NIT = MKROWS * 2;
    for (int base = gw * U; base < NIT; base += NGW * U) {
        bf16x8 vn[U]; float x1[U][2], x2[U][2]; f32x4 cs[U];
#pragma unroll
        for (int u = 0; u < U; ++u) { const int it = base + u; if (it < NIT) {
            const bool isq = it < NQ; const int w = isq ? it : it - NQ; const int r = w >> 1, h = (w & 1) * 4 + hq;
            if (isq) { const bf16_t* p = Q + (size_t)r * 1536 + h * 192;
                vn[u] = *(const bf16x8*)(p + 8 * sub); const unsigned a1 = *(const unsigned*)(p + 128 + 2 * sub), a2 = *(const unsigned*)(p + 160 + 2 * sub);
                x1[u][0] = bf2f(a1 & 0xffff); x1[u][1] = bf2f(a1 >> 16); x2[u][0] = bf2f(a2 & 0xffff); x2[u][1] = bf2f(a2 >> 16);
            } else { vn[u] = *(const bf16x8*)(KV + (size_t)r * 2048 + h * 256 + 8 * sub);
                if (r < MROWS) { const bf16_t* pe = P + (size_t)r * LDP_AB + COL_KPE; const unsigned a1 = *(const unsigned*)(pe + 2 * sub), a2 = *(const unsigned*)(pe + 32 + 2 * sub);
                    x1[u][0] = bf2f(a1 & 0xffff); x1[u][1] = bf2f(a1 >> 16); x2[u][0] = bf2f(a2 & 0xffff); x2[u][1] = bf2f(a2 >> 16); }
                else { const int rr = r - MROWS, b = rr >> 8, t = rr & 255; const float* pe = ckpe + (size_t)((b * 2 + j) * 256 + t) * 64;
                    x1[u][0] = pe[2 * sub]; x1[u][1] = pe[2 * sub + 1]; x2[u][0] = pe[32 + 2 * sub]; x2[u][1] = pe[32 + 2 * sub + 1]; } }
            if (r >= MC && r < MROWS) cs[u] = *(const f32x4*)(RA + (((r - MC) & 2047) * 32 + 2 * sub) * 2);
        } }
#pragma unroll
        for (int u = 0; u < U; ++u) { const int it = base + u; if (it < NIT) {
            const bool isq = it < NQ; const int w = isq ? it : it - NQ; const int r = w >> 1, h = (w & 1) * 4 + hq;
            float xn[8];
#pragma unroll
            for (int e = 0; e < 8; ++e) xn[e] = bf2f((unsigned short)vn[u][e]);
            float ss = x1[u][0] * x1[u][0] + x1[u][1] * x1[u][1] + x2[u][0] * x2[u][0] + x2[u][1] * x2[u][1];
#pragma unroll
            for (int e = 0; e < 8; ++e) ss += xn[e] * xn[e];
            const float rstd = rsqrtf(sum16(ss) * (1.f / 192.f) + EPSN);
            const float* g = isq ? gq : gk;
#pragma unroll
            for (int e = 0; e < 8; ++e) xn[e] = xn[e] * rstd * g[8 * sub + e];
            float y1[2], y2[2];
            y1[0] = x1[u][0] * rstd * g[128 + 2 * sub]; y1[1] = x1[u][1] * rstd * g[128 + 2 * sub + 1]; y2[0] = x2[u][0] * rstd * g[160 + 2 * sub]; y2[1] = x2[u][1] * rstd * g[160 + 2 * sub + 1];
            if (r >= MC && r < MROWS) {
#pragma unroll
                for (int q = 0; q < 2; ++q) { const float c = cs[u][2 * q], sn = cs[u][2 * q + 1];
                    const float z1 = y1[q] * c - y2[q] * sn, z2 = y1[q] * sn + y2[q] * c; y1[q] = z1; y2[q] = z2; } }
            bf16_t* p;
            if (isq) {
#pragma unroll
                for (int e = 0; e < 8; ++e) xn[e] *= QSC_A;
                y1[0] *= QSC_A; y1[1] *= QSC_A; y2[0] *= QSC_A; y2[1] *= QSC_A;
                p = Q + (size_t)r * 1536 + h * 192;
            } else p = KF + (size_t)r * 1536 + h * 192;
            *(bf16x8*)(p + 8 * sub) = pack8(xn); *(unsigned*)(p + 128 + 2 * sub) = pk2(y1[0], y1[1]); *(unsigned*)(p + 160 + 2 * sub) = pk2(y2[0], y2[1]);
        } }
    }
}

__device__ __forceinline__ void phase_fin_ab(KArgs a, int j) {
    const int tid = otid(), lane = tid & 63, wave = tid >> 6, sub = lane & 15, hq = lane >> 4;
    const int gw = obid() * NWAVES + wave, NGW = gridDim.x * NWAVES;
    const bf16_t* OF = (const bf16_t*)(a->ws + WS_OF); const bf16_t* OB = (const bf16_t*)(a->ws + WS_OB);
    const bf16_t* P = (const bf16_t*)(a->ws + WS_PROJ); bf16_t* MIX = (bf16_t*)(a->ws + WS_H);
    const float* g = a->in[21] + j * 128;
    constexpr int U = 4;
    for (int base = gw * U; base < MROWS * 2; base += NGW * U) {
        bf16x8 va[U], vb[U], vg[U];
#pragma unroll
        for (int u = 0; u < U; ++u) { const int it = base + u; const int r = it >> 1, h = (it & 1) * 4 + hq; const size_t o = (size_t)r * 1024 + h * 128 + 8 * sub;
            va[u] = *(const bf16x8*)(OF + o); vb[u] = *(const bf16x8*)(OB + o); vg[u] = *(const bf16x8*)(P + (size_t)r * LDP_AB + COL_BG + h * 128 + 8 * sub); }
#pragma unroll
        for (int u = 0; u < U; ++u) { const int it = base + u; const int r = it >> 1, h = (it & 1) * 4 + hq;
            float s[8]; float ss = 0.f;
#pragma unroll
            for (int e = 0; e < 8; ++e) { s[e] = bf2f((unsigned short)va[u][e]) + bf2f((unsigned short)vb[u][e]); ss += s[e] * s[e]; }
            const float rstd = rsqrtf(sum16(ss) * (1.f / 128.f) + EPSN);
#pragma unroll
            for (int e = 0; e < 8; ++e) s[e] = s[e] * rstd * g[8 * sub + e] * silu_f(bf2f((unsigned short)vg[u][e]));
            *(bf16x8*)(MIX + (size_t)r * DM + 1024 + h * 128 + 8 * sub) = pack8(s); }
    }
}

__device__ __forceinline__ void phase_hn_c(KArgs a, int j) {
    const int tid = otid(), lane = tid & 63, wave = tid >> 6, sub = lane & 15, hq = lane >> 4;
    const int gw = obid() * NWAVES + wave, NGW = gridDim.x * NWAVES;
    bf16_t* P = (bf16_t*)(a->ws + WS_PROJ);
    const float* RC = (const float*)(a->ws + WS_ROPEC);
    const float* gq = a->in[27] + j * 128; const float* gk = a->in[28] + j * 128;
    float* outp = a->out;
    for (int r = gw; r < MC; r += NGW) { const int b = r >> 8, t = r & 255; const bf16x8 v = *(const bf16x8*)(P + (size_t)r * LDP_C + 2560 + 8 * lane);
        float* o = outp + O_VC + (size_t)((b * 2 + j) * 256 + t) * 512 + 8 * lane;
        *(f32x4*)o = (f32x4){bf2f((unsigned short)v[0]), bf2f((unsigned short)v[1]), bf2f((unsigned short)v[2]), bf2f((unsigned short)v[3])};
        *(f32x4*)(o + 4) = (f32x4){bf2f((unsigned short)v[4]), bf2f((unsigned short)v[5]), bf2f((unsigned short)v[6]), bf2f((unsigned short)v[7])}; }
    constexpr int U = 4;
    const int NIT = MROWS;
    for (int base = gw * U; base < NIT; base += NGW * U) {
        s16x4 v1[U], v2[U]; f32x4 ca[U], cb[U];
#pragma unroll
        for (int u = 0; u < U; ++u) { const int it = base + u; if (it < NIT) {
            const int r = it, h = 16 + hq; const bool isq = false;
            const bf16_t* p = P + (size_t)r * LDP_C + (isq ? h * 128 : 2048 + (h - 16) * 128);
            v1[u] = *(const s16x4*)(p + 4 * sub); v2[u] = *(const s16x4*)(p + 64 + 4 * sub);
            if (r >= MC) { const float* rc = RC + (((r - MC) & 2047) * 64 + 4 * sub) * 2; ca[u] = *(const f32x4*)rc; cb[u] = *(const f32x4*)(rc + 4); }
        } }
#pragma unroll
        for (int u = 0; u < U; ++u) { const int it = base + u; if (it < NIT) {
            const int r = it, h = 16 + hq; const bool isq = false;
            bf16_t* p = P + (size_t)r * LDP_C + (isq ? h * 128 : 2048 + (h - 16) * 128);
            float x1[4], x2[4]; float ss = 0.f;
#pragma unroll
            for (int e = 0; e < 4; ++e) { x1[e] = bf2f((unsigned short)v1[u][e]); x2[e] = bf2f((unsigned short)v2[u][e]); ss += x1[e] * x1[e] + x2[e] * x2[e]; }
            const float rstd = rsqrtf(sum16(ss) * (1.f / 128.f) + EPSN);
            const float* g = isq ? gq : gk;
#pragma unroll
            for (int e = 0; e < 4; ++e) { x1[e] *= rstd * g[4 * sub + e]; x2[e] *= rstd * g[64 + 4 * sub + e]; }
            if (r >= MC) {
#pragma unroll
                for (int e = 0; e < 4; ++e) { const float c = e < 2 ? ca[u][2 * e] : cb[u][2 * (e - 2)], sn = e < 2 ? ca[u][2 * e + 1] : cb[u][2 * (e - 2) + 1];
                    const float y1 = x1[e] * c - x2[e] * sn, y2 = x1[e] * sn + x2[e] * c; x1[e] = y1; x2[e] = y2; } }
            else if (!isq) { const int b = r >> 8, t = r & 255; float* o = outp + O_KC + (size_t)((b * 2 + j) * 256 + t) * 512 + (h - 16) * 128;
                *(f32x4*)(o + 4 * sub) = (f32x4){x1[0], x1[1], x1[2], x1[3]}; *(f32x4*)(o + 64 + 4 * sub) = (f32x4){x2[0], x2[1], x2[2], x2[3]}; }
            if (isq) {
#pragma unroll
                for (int e = 0; e < 4; ++e) { x1[e] *= QSC_C; x2[e] *= QSC_C; } }
            u32x2 w1, w2; w1.x = pk2(x1[0], x1[1]); w1.y = pk2(x1[2], x1[3]); w2.x = pk2(x2[0], x2[1]); w2.y = pk2(x2[2], x2[3]);
            *(u32x2*)(p + 4 * sub) = w1; *(u32x2*)(p + 64 + 4 * sub) = w2;
        } }
    }
}

namespace att {
__device__ __forceinline__ int crow(int r, int hi) { return (r & 3) + 8 * (r >> 2) + 4 * hi; }
__device__ __forceinline__ unsigned cvtpk(float lo, float hi) { return pk2(lo, hi); }
__device__ __forceinline__ int v_st(int k, int c) { const int kk = (k & ~0xC) | ((k & 4) << 1) | ((k & 8) >> 1); return ((kk >> 3) * 4 + (c >> 5)) * 512 + ((kk & 7) * 32 + (c & 31)) * 2; }
__device__ __forceinline__ int v_rd_base(int lane) { return ((lane & 3) << 3) | (((lane >> 2) & 3) << 6) | (((lane >> 4) & 1) << 5) | (((lane >> 5) & 1) << 8); }
constexpr int v_rd_off(int d0, int ks, int half) { return d0 * 512 + ks * 4096 + half * 2048; }
template <int OFF> __device__ __forceinline__ s16x4 tr_read(int vb) {
    s16x4 r; asm volatile("ds_read_b64_tr_b16 %0, %1 offset:%2" : "=&v"(r) : "v"(vb), "i"(OFF) : "memory"); return r;
}
template <int D0> __device__ __forceinline__ void pv_read8(s16x4 (&r)[8], int vb) {
    r[0] = tr_read<v_rd_off(D0, 0, 0)>(vb); r[1] = tr_read<v_rd_off(D0, 0, 1)>(vb); r[2] = tr_read<v_rd_off(D0, 1, 0)>(vb); r[3] = tr_read<v_rd_off(D0, 1, 1)>(vb);
    r[4] = tr_read<v_rd_off(D0, 2, 0)>(vb); r[5] = tr_read<v_rd_off(D0, 2, 1)>(vb); r[6] = tr_read<v_rd_off(D0, 3, 0)>(vb); r[7] = tr_read<v_rd_off(D0, 3, 1)>(vb);
}
__device__ __forceinline__ void pv_mma4(f32x16& od, const s16x4 (&r)[8], bf16x8 pa0, bf16x8 pa1, bf16x8 pa2, bf16x8 pa3) {
#define ATT_PK(L, H) (bf16x8){L[0], L[1], L[2], L[3], H[0], H[1], H[2], H[3]}
    od = __builtin_amdgcn_mfma_f32_32x32x16_bf16(pa0, ATT_PK(r[0], r[1]), od, 0, 0, 0);
    od = __builtin_amdgcn_mfma_f32_32x32x16_bf16(pa1, ATT_PK(r[2], r[3]), od, 0, 0, 0);
    od = __builtin_amdgcn_mfma_f32_32x32x16_bf16(pa2, ATT_PK(r[4], r[5]), od, 0, 0, 0);
    od = __builtin_amdgcn_mfma_f32_32x32x16_bf16(pa3, ATT_PK(r[6], r[7]), od, 0, 0, 0);
#undef ATT_PK
}
__device__ __forceinline__ void pv_all(f32x16 (&o)[4], int vb, bf16x8 pa0, bf16x8 pa1, bf16x8 pa2, bf16x8 pa3) {
    s16x4 ra[8], rb[8];
    pv_read8<0>(ra, vb);
    pv_read8<1>(rb, vb); asm volatile("s_waitcnt lgkmcnt(8)" ::: "memory"); __builtin_amdgcn_sched_barrier(0);
    pv_mma4(o[0], ra, pa0, pa1, pa2, pa3); __builtin_amdgcn_sched_barrier(0);
    pv_read8<2>(ra, vb); asm volatile("s_waitcnt lgkmcnt(8)" ::: "memory"); __builtin_amdgcn_sched_barrier(0);
    pv_mma4(o[1], rb, pa0, pa1, pa2, pa3); __builtin_amdgcn_sched_barrier(0);
    pv_read8<3>(rb, vb); asm volatile("s_waitcnt lgkmcnt(8)" ::: "memory"); __builtin_amdgcn_sched_barrier(0);
    pv_mma4(o[2], ra, pa0, pa1, pa2, pa3); __builtin_amdgcn_sched_barrier(0);
    asm volatile("s_waitcnt lgkmcnt(0)" ::: "memory"); __builtin_amdgcn_sched_barrier(0);
    pv_mma4(o[3], rb, pa0, pa1, pa2, pa3);
}
struct Item {
    const bf16_t* Q; int ldq;
    const bf16_t* K0; const bf16_t* V0; int n0;
    const bf16_t* K1; const bf16_t* V1; int ldk, ldv, t_lo, t_hi;
    int q0, band; float m0, l0;
    const float* qg; const float* rope; float qscale;
    const bf16_t* G; int ldg; bf16_t* O; int ldo;
};
template <int DQK>
__device__ __forceinline__ void attn_item(LAS unsigned char* lds, const Item& it) {
    constexpr int KROW = DQK * 2, SHM_K = 64 * KROW, SHM_V = 64 * 128 * 2, ND = DQK / 16;
    const int tid = otid(), wid = tid >> 6, lane = tid & 63, r32 = lane & 31, hi = lane >> 5;
    LAS unsigned char* V_lds = lds; LAS unsigned char* K_lds = lds + 3 * SHM_V;
    LAS float* wsx = (LAS float*)(lds + 3 * SHM_V + 3 * SHM_K) + wid * 64; LAS float* li_l = wsx; LAS float* al_l = wsx + 32;
    float m_reg = it.m0, l_reg = it.l0;
    f32x16 o[4];
#pragma unroll
    for (int d = 0; d < 4; ++d)
#pragma unroll
        for (int r = 0; r < 16; ++r) o[d][r] = 0.f;
    bf16x8 qr[ND];
    {
      const bf16_t* Qw = it.Q + (size_t)(wid * 32 + r32) * it.ldq + hi * 8;
      float xf[ND][8]; float ss = 0.f;
#pragma unroll
      for (int d0 = 0; d0 < ND; ++d0) { const bf16x8 v = *(const bf16x8*)(Qw + d0 * 16);
#pragma unroll
          for (int e = 0; e < 8; ++e) { xf[d0][e] = bf2f((unsigned short)v[e]); ss += xf[d0][e] * xf[d0][e]; } }
      ss += __shfl_xor(ss, 32);
      const float rstd = rsqrtf(ss * (1.f / (float)DQK) + EPSN);
#pragma unroll
      for (int d0 = 0; d0 < ND; ++d0) { const f32x4 g0 = *(const f32x4*)(it.qg + d0 * 16 + hi * 8), g1 = *(const f32x4*)(it.qg + d0 * 16 + hi * 8 + 4);
#pragma unroll
          for (int e = 0; e < 8; ++e) xf[d0][e] *= rstd * (e < 4 ? g0[e & 3] : g1[e & 3]); }
      if (it.rope) { constexpr int NR = DQK == 128 ? 4 : 2, RB = DQK == 128 ? 0 : 8, RS = DQK == 128 ? 64 : 32;
          const float* rp = it.rope + (size_t)((it.q0 + wid * 32 + r32) * RS + hi * 8) * 2;
#pragma unroll
          for (int p = 0; p < NR; ++p) { f32x4 cs4[4];
#pragma unroll
              for (int q = 0; q < 4; ++q) cs4[q] = *(const f32x4*)(rp + p * 32 + 4 * q);
#pragma unroll
              for (int e = 0; e < 8; ++e) { const float c = cs4[e >> 1][(e & 1) * 2], sn = cs4[e >> 1][(e & 1) * 2 + 1];
                  const float x1 = xf[RB + p][e], x2 = xf[RB + NR + p][e]; xf[RB + p][e] = x1 * c - x2 * sn; xf[RB + NR + p][e] = x1 * sn + x2 * c; } } }
#pragma unroll
      for (int d0 = 0; d0 < ND; ++d0) { float t8[8];
#pragma unroll
          for (int e = 0; e < 8; ++e) t8[e] = xf[d0][e] * it.qscale;
          qr[d0] = pack8(t8); } }
    const int NT = it.n0 + (it.t_hi - it.t_lo);
    const int wvu = __builtin_amdgcn_readfirstlane(wid);
    const int vb0 = (int)(uintptr_t)V_lds + v_rd_base(lane);
    constexpr int NKI = SHM_K / 8192;
    unsigned kog[NKI], vog[2];
#pragma unroll
    for (int i = 0; i < NKI; ++i) { const int off = i * 8192 + wid * 1024 + lane * 16, row = off / KROW, pos = off % KROW; kog[i] = (unsigned)(row * it.ldk + ((pos ^ ((row & 7) << 4)) >> 1)); }
#pragma unroll
    for (int i = 0; i < 2; ++i) { const int q = (i * 8192 + wid * 1024 + lane * 16) >> 4, sub = q >> 5, rem = q & 31, rowin = rem >> 2, cch = rem & 3;
        const int kk = (sub >> 2) * 8 + rowin; vog[i] = (unsigned)(((kk & ~0xC) | ((kk & 4) << 1) | ((kk & 8) >> 1)) * it.ldv + (sub & 3) * 32 + cch * 8); }
    int koff[4];
#pragma unroll
    for (int dl = 0; dl < 4; ++dl) koff[dl] = r32 * KROW + ((dl * 32 + hi * 16) ^ ((r32 & 7) << 4));
#define ATT_STAGE(jj, b) do { const int _j = (jj); const bool _s0 = _j < it.n0; const int _t = _s0 ? _j : it.t_lo + (_j - it.n0); \
        const bf16_t* _Kp = (_s0 ? it.K0 : it.K1) + (size_t)(64 * _t) * it.ldk; const bf16_t* _Vp = (_s0 ? it.V0 : it.V1) + (size_t)(64 * _t) * it.ldv; \
        _Pragma("unroll") for (int _i = 0; _i < NKI; ++_i) __builtin_amdgcn_global_load_lds((const unsigned*)(_Kp + kog[_i]), (LAS unsigned*)(K_lds + (b) * SHM_K + _i * 8192 + wvu * 1024), 16, 0, 0); \
        _Pragma("unroll") for (int _i = 0; _i < 2; ++_i) __builtin_amdgcn_global_load_lds((const unsigned*)(_Vp + vog[_i]), (LAS unsigned*)(V_lds + (b) * SHM_V + _i * 8192 + wvu * 1024), 16, 0, 0); } while (0)
#define ATT_WAIT_TILE(more) do { if (more) { if constexpr (NKI == 3) asm volatile("s_waitcnt vmcnt(5)" ::: "memory"); else asm volatile("s_waitcnt vmcnt(4)" ::: "memory"); } \
        else asm volatile("s_waitcnt vmcnt(0)" ::: "memory"); \
        asm volatile("s_waitcnt lgkmcnt(0)" ::: "memory"); __builtin_amdgcn_s_barrier(); asm volatile("" ::: "memory"); } while (0)
    ATT_STAGE(0, 0); if (NT > 1) ATT_STAGE(1, 1);
    ATT_WAIT_TILE(NT > 1);
    int cur = 0;
    for (int j = 0; j < NT; ++j) {
        if (j + 2 < NT) ATT_STAGE(j + 2, (cur == 0 ? 2 : cur - 1));
        bool act = true; const bool domask = it.band && j >= it.n0; int kpos0 = 0;
        if (domask) { kpos0 = 64 * (it.t_lo + j - it.n0); const int qlo = it.q0 + wid * 32; act = (kpos0 + 63 >= qlo - 128) && (kpos0 <= qlo + 31 + 128); }
        if (act) {
            f32x16 p0, p1;
#pragma unroll
            for (int r = 0; r < 16; ++r) { p0[r] = 0.f; p1[r] = 0.f; }
            const LAS unsigned char* Ks = K_lds + cur * SHM_K;
            {
                constexpr int NG = ND / 4;
                bf16x8 kf[2][8];
#define ATT_LOADG(g_, dst) do { _Pragma("unroll") for (int u_ = 0; u_ < 4; ++u_) { dst[2 * u_] = *(const LAS bf16x8*)(Ks + koff[u_] + (g_) * 128); dst[2 * u_ + 1] = *(const LAS bf16x8*)(Ks + koff[u_] + (g_) * 128 + 32 * KROW); } } while (0)
                ATT_LOADG(0, kf[0]);
#pragma unroll
                for (int g = 0; g < NG; ++g) {
                    if (g + 1 < NG) ATT_LOADG(g + 1, kf[(g + 1) & 1]);
                    __builtin_amdgcn_sched_barrier(0);
#pragma unroll
                    for (int u_ = 0; u_ < 4; ++u_) { p0 = __builtin_amdgcn_mfma_f32_32x32x16_bf16(kf[g & 1][2 * u_], qr[4 * g + u_], p0, 0, 0, 0);
                        p1 = __builtin_amdgcn_mfma_f32_32x32x16_bf16(kf[g & 1][2 * u_ + 1], qr[4 * g + u_], p1, 0, 0, 0); }
                    __builtin_amdgcn_sched_barrier(0); }
#undef ATT_LOADG
            }
            if (domask) { const int qp = it.q0 + wid * 32 + r32;
#pragma unroll
                for (int r = 0; r < 16; ++r) { const int d = kpos0 + crow(r, hi) - qp;
                    if (d > 128 || d < -128) p0[r] = -1e30f;
                    if (d + 32 > 128 || d + 32 < -128) p1[r] = -1e30f; } }
            float pmax = p0[0];
#pragma unroll
            for (int r = 1; r < 16; ++r) pmax = fmaxf(pmax, p0[r]);
#pragma unroll
            for (int r = 0; r < 16; ++r) pmax = fmaxf(pmax, p1[r]);
            { auto rr = __builtin_amdgcn_permlane32_swap(__float_as_uint(pmax), __float_as_uint(pmax), false, false);
              pmax = fmaxf(__uint_as_float(rr[0]), __uint_as_float(rr[1])); }
            float mn, alpha;
            if (__all(pmax - m_reg <= 11.5415603f)) { mn = m_reg; alpha = 1.f; }
            else { mn = fmaxf(m_reg, pmax); alpha = __builtin_amdgcn_exp2f(m_reg - mn); m_reg = mn; }
            float ps = 0.f;
#pragma unroll
            for (int r = 0; r < 16; ++r) { p0[r] = __builtin_amdgcn_exp2f(p0[r] - mn); p1[r] = __builtin_amdgcn_exp2f(p1[r] - mn); ps += p0[r] + p1[r]; }
            { auto rr = __builtin_amdgcn_permlane32_swap(__float_as_uint(ps), __float_as_uint(ps), false, false);
              ps = __uint_as_float(rr[0]) + __uint_as_float(rr[1]); }
            l_reg = l_reg * alpha + ps;
            bf16x8 pa0, pa1, pa2, pa3;
#define ATT_PK4(P, BASE, OUT) do { unsigned a0 = cvtpk(P[BASE + 0], P[BASE + 1]), a1 = cvtpk(P[BASE + 2], P[BASE + 3]);   \
    unsigned b0 = cvtpk(P[BASE + 4], P[BASE + 5]), b1 = cvtpk(P[BASE + 6], P[BASE + 7]);                              \
    auto r0 = __builtin_amdgcn_permlane32_swap(a0, b0, false, false); auto r1 = __builtin_amdgcn_permlane32_swap(a1, b1, false, false); \
    u32x4 w = {r0[0], r1[0], r0[1], r1[1]}; OUT = __builtin_bit_cast(bf16x8, w); } while (0)
            ATT_PK4(p0, 0, pa0); ATT_PK4(p0, 8, pa1); ATT_PK4(p1, 0, pa2); ATT_PK4(p1, 8, pa3);
#undef ATT_PK4
            if (__any(alpha < 1.f)) { if (hi == 0) al_l[r32] = alpha; asm volatile("s_waitcnt lgkmcnt(0)" ::: "memory");
#pragma unroll
                for (int r = 0; r < 16; ++r) { const float al = al_l[crow(r, hi)];
#pragma unroll
                    for (int d = 0; d < 4; ++d) o[d][r] *= al; } }
            const int vb = vb0 + cur * SHM_V;
            pv_all(o, vb, pa0, pa1, pa2, pa3);
        }
        ATT_WAIT_TILE(j + 2 < NT);
        cur = cur == 2 ? 0 : cur + 1;
    }
#undef ATT_STAGE
#undef ATT_WAIT_TILE
    const int er = lane >> 4, ec = (lane & 15) * 8;
    bf16x8 gv[8];
    { const bf16_t* Gw = it.G + (size_t)(wid * 32 + er) * it.ldg + ec;
#pragma unroll
      for (int c = 0; c < 8; ++c) gv[c] = *(const bf16x8*)(Gw + (size_t)(4 * c) * it.ldg); }
    if (hi == 0) li_l[r32] = l_reg; asm volatile("s_waitcnt lgkmcnt(0)" ::: "memory");
    LAS bf16_t* ost = (LAS bf16_t*)(lds + wid * 8192);
#pragma unroll
    for (int r = 0; r < 16; ++r) { const float rli = 1.f / li_l[crow(r, hi)];
#pragma unroll
        for (int d0 = 0; d0 < 4; ++d0) ost[crow(r, hi) * 128 + d0 * 32 + r32] = (bf16_t)f2bf(o[d0][r] * rli); }
    asm volatile("s_waitcnt lgkmcnt(0)" ::: "memory");
    { bf16_t* Ow = it.O + (size_t)(wid * 32 + er) * it.ldo + ec;
#pragma unroll
      for (int c = 0; c < 8; ++c) { const bf16x8 ov = *(const LAS bf16x8*)(ost + (4 * c + er) * 128 + ec); float t8[8];
#pragma unroll
          for (int e = 0; e < 8; ++e) t8[e] = bf2f((unsigned short)ov[e]) * silu_f(bf2f((unsigned short)gv[c][e]));
          *(bf16x8*)(Ow + (size_t)(4 * c) * it.ldo) = pack8(t8); } }
    __syncthreads();
}
}

__device__ __forceinline__ void hgrn_item(LAS unsigned char* lds, const bf16_t* PROJ, int rowbase, int T, int h, int dir,
                                          const float* lb, const float* s0, float* sout, bf16_t* OUT, int c0, int c1, float* sbuf) {
    const int tid = otid(), wid = tid >> 6, lane = tid & 63, fr = lane & 15, fq = lane >> 4;
    const int c2 = 16 * wid + (lane & 15), part = lane >> 4, n0 = wid * 16;
    f32x4 S[8];
    { const float* sin_ = c0 > 0 ? sbuf : (s0 ? s0 : sbuf);
      const float ssc = (c0 > 0 || s0) ? 1.f : 0.f;
#pragma unroll
      for (int kt = 0; kt < 8; ++kt)
#pragma unroll
          for (int r = 0; r < 4; ++r) S[kt][r] = sin_[(size_t)(16 * kt + 4 * fq + r) * 128 + n0 + fr] * ssc; }
    __builtin_amdgcn_s_waitcnt(0x0F70);
    const float oml = 1.f - lb[c2];
    const unsigned hz = ozero();
    const int nch = T / 32;
    LAS unsigned char* RAW = lds + 76800;
    const int wvu = __builtin_amdgcn_readfirstlane(wid);
    const int dtl = 4 * wid + (lane >> 4), dch = (lane & 15) * 8;
    const bf16_t* dsrc = PROJ + h * 128 + dch;
    const int colf = dir ? COL_FB : COL_FF;
#define HG_DMA(cc, slot) do { const int _p = 32 * (cc) + dtl; const int _tok = dir ? T - 1 - _p : _p; const bf16_t* _s = dsrc + (size_t)(rowbase + _tok) * LDP_AB; \
        __builtin_amdgcn_global_load_lds((const unsigned*)(_s + COL_BQ), (LAS unsigned*)(RAW + (slot) * 24576 + wvu * 1024), 16, 0, 0); \
        __builtin_amdgcn_global_load_lds((const unsigned*)(_s + colf), (LAS unsigned*)(RAW + (slot) * 24576 + 8192 + wvu * 1024), 16, 0, 0); \
        __builtin_amdgcn_global_load_lds((const unsigned*)(_s + COL_BI), (LAS unsigned*)(RAW + (slot) * 24576 + 16384 + wvu * 1024), 16, 0, 0); } while (0)
#define HG_BAR() do { asm volatile("s_waitcnt lgkmcnt(0)" ::: "memory"); __builtin_amdgcn_s_barrier(); asm volatile("" ::: "memory"); } while (0)
    HG_DMA(c0, 0);
    asm volatile("s_waitcnt vmcnt(0)" ::: "memory");
    HG_BAR();
    int cur = 0;
    for (int cc = c0; cc < c1; ++cc) {
        if (cc + 1 < c1) HG_DMA(cc + 1, cur ^ 1);
        LAS float* DEC = (LAS float*)lds + cur * 128;
        LAS bf16_t* QT = (LAS bf16_t*)(lds + 1024 + cur * 37888);
        LAS bf16_t* KT = QT + 32 * 136;
        LAS bf16_t* KTt = KT + 32 * 136;
        LAS bf16_t* Vt = KTt + 128 * 40;
        float b[8], kk[8], sq[8]; unsigned short vv[8]; float run = 0.f;
        { const LAS bf16_t* rw = (const LAS bf16_t*)(RAW + cur * 24576) + (8 * part) * 128 + c2;
            unsigned short rq[8], rf[8];
#pragma unroll
            for (int i = 0; i < 8; ++i) { rq[i] = rw[i * 128]; rf[i] = rw[4096 + i * 128]; vv[i] = rw[8192 + i * 128]; }
#pragma unroll
            for (int i = 0; i < 8; ++i) { const float x = bf2f(rf[i]); const float omf = oml * __builtin_amdgcn_rcpf(1.f + __expf(x));
                const float lf = fmaxf(__logf(1.f - omf), -30.f); run += lf; b[i] = run; kk[i] = omf; sq[i] = silu_f(bf2f(rq[i])); } }
        { const float r1 = __shfl_up(run, 16), r2 = __shfl_up(run, 32), r3 = __shfl_up(run, 48);
            const float off = (part >= 1 ? r1 : 0.f) + (part >= 2 ? r2 : 0.f) + (part >= 3 ? r3 : 0.f);
            float kt_[8];
#pragma unroll
            for (int i = 0; i < 8; ++i) { const float bb = b[i] + off; const int t = 8 * part + i;
                const float qv = sq[i] * __expf(bb); kt_[i] = kk[i] * __expf(fminf(-bb, 80.f));
                QT[t * 136 + c2] = (bf16_t)f2bf(qv); KT[t * 136 + c2] = (bf16_t)f2bf(kt_[i]);
                if (i == 7 && part == 3) DEC[c2] = __expf(bb); }
            *(LAS bf16x8*)(KTt + c2 * 40 + 8 * part) = pack8(kt_);
            u32x4 wv; wv.x = (unsigned)vv[0] | ((unsigned)vv[1] << 16); wv.y = (unsigned)vv[2] | ((unsigned)vv[3] << 16); wv.z = (unsigned)vv[4] | ((unsigned)vv[5] << 16); wv.w = (unsigned)vv[6] | ((unsigned)vv[7] << 16);
            *(LAS u32x4*)(Vt + c2 * 40 + 8 * part) = wv; }
        asm volatile("s_waitcnt vmcnt(0)" ::: "memory");
        HG_BAR();
        f32x4 pt00 = {0.f, 0.f, 0.f, 0.f}, pt01 = pt00, pt11 = pt00;
#pragma unroll
        for (int ks = 0; ks < 4; ++ks) {
            const bf16x8 a0 = *(const LAS bf16x8*)(KT + fr * 136 + 32 * ks + 8 * fq), a1 = *(const LAS bf16x8*)(KT + (16 + fr) * 136 + 32 * ks + 8 * fq);
            const bf16x8 b0 = *(const LAS bf16x8*)(QT + fr * 136 + 32 * ks + 8 * fq), b1 = *(const LAS bf16x8*)(QT + (16 + fr) * 136 + 32 * ks + 8 * fq);
            pt00 = __builtin_amdgcn_mfma_f32_16x16x32_bf16(a0, b0, pt00, 0, 0, 0);
            pt01 = __builtin_amdgcn_mfma_f32_16x16x32_bf16(a0, b1, pt01, 0, 0, 0);
            pt11 = __builtin_amdgcn_mfma_f32_16x16x32_bf16(a1, b1, pt11, 0, 0, 0); }
#pragma unroll
        for (int r = 0; r < 4; ++r) { if (4 * fq + r > fr) { pt00[r] = 0.f; pt11[r] = 0.f; } }
        u32x4 wA0, wA1;
        wA0.x = pk2(pt00[0], pt00[1]); wA0.y = pk2(pt00[2], pt00[3]); wA0.z = hz; wA0.w = hz;
        wA1.x = pk2(pt01[0], pt01[1]); wA1.y = pk2(pt01[2], pt01[3]); wA1.z = pk2(pt11[0], pt11[1]); wA1.w = pk2(pt11[2], pt11[3]);
        const u32x2 vlo = *(const LAS u32x2*)(Vt + (n0 + fr) * 40 + 4 * fq), vhi = *(const LAS u32x2*)(Vt + (n0 + fr) * 40 + 16 + 4 * fq);
        const u32x4 wV = {vlo.x, vlo.y, vhi.x, vhi.y};
        f32x4 o0 = {0.f, 0.f, 0.f, 0.f}, o1 = o0;
        o0 = __builtin_amdgcn_mfma_f32_16x16x32_bf16(__builtin_bit_cast(bf16x8, wA0), __builtin_bit_cast(bf16x8, wV), o0, 0, 0, 0);
        o1 = __builtin_amdgcn_mfma_f32_16x16x32_bf16(__builtin_bit_cast(bf16x8, wA1), __builtin_bit_cast(bf16x8, wV), o1, 0, 0, 0);
#pragma unroll
        for (int aa = 0; aa < 4; ++aa) {
            u32x4 wS; wS.x = pk2(S[2 * aa][0], S[2 * aa][1]); wS.y = pk2(S[2 * aa][2], S[2 * aa][3]); wS.z = pk2(S[2 * aa + 1][0], S[2 * aa + 1][1]); wS.w = pk2(S[2 * aa + 1][2], S[2 * aa + 1][3]);
            const u32x2 q0l = *(const LAS u32x2*)(QT + fr * 136 + 32 * aa + 4 * fq), q0h = *(const LAS u32x2*)(QT + fr * 136 + 32 * aa + 16 + 4 * fq);
            const u32x2 q1l = *(const LAS u32x2*)(QT + (16 + fr) * 136 + 32 * aa + 4 * fq), q1h = *(const LAS u32x2*)(QT + (16 + fr) * 136 + 32 * aa + 16 + 4 * fq);
            const u32x4 wQ0 = {q0l.x, q0l.y, q0h.x, q0h.y}, wQ1 = {q1l.x, q1l.y, q1h.x, q1h.y};
            o0 = __builtin_amdgcn_mfma_f32_16x16x32_bf16(__builtin_bit_cast(bf16x8, wQ0), __builtin_bit_cast(bf16x8, wS), o0, 0, 0, 0);
            o1 = __builtin_amdgcn_mfma_f32_16x16x32_bf16(__builtin_bit_cast(bf16x8, wQ1), __builtin_bit_cast(bf16x8, wS), o1, 0, 0, 0); }
        { const bf16x8 vn = *(const LAS bf16x8*)(Vt + (n0 + fr) * 40 + 8 * fq);
#pragma unroll
            for (int kt = 0; kt < 8; ++kt) { const bf16x8 ka = *(const LAS bf16x8*)(KTt + (16 * kt + fr) * 40 + 8 * fq);
                S[kt] = __builtin_amdgcn_mfma_f32_16x16x32_bf16(ka, vn, S[kt], 0, 0, 0);
                const f32x4 d = *(const LAS f32x4*)(DEC + 16 * kt + 4 * fq); S[kt] = S[kt] * d; } }
#pragma unroll
        for (int r = 0; r < 4; ++r) {
            const int i0 = 4 * fq + r, i1 = 16 + 4 * fq + r;
            const int tok0 = dir ? T - 1 - (32 * cc + i0) : 32 * cc + i0, tok1 = dir ? T - 1 - (32 * cc + i1) : 32 * cc + i1;
            OUT[(size_t)(rowbase + tok0) * 1024 + h * 128 + n0 + fr] = (bf16_t)f2bf(o0[r]);
            OUT[(size_t)(rowbase + tok1) * 1024 + h * 128 + n0 + fr] = (bf16_t)f2bf(o1[r]); }
        cur ^= 1;
    }
#undef HG_DMA
#undef HG_BAR
    { float* so_ = c1 < nch ? sbuf : sout;
      if (so_) {
#pragma unroll
        for (int kt = 0; kt < 8; ++kt)
#pragma unroll
            for (int r = 0; r < 4; ++r) so_[(size_t)(16 * kt + 4 * fq + r) * 128 + n0 + fr] = S[kt][r]; } }
    __syncthreads();
}

__device__ __forceinline__ int fetch_item(unsigned* ctr, LAS int* slot) {
    __syncthreads();
    if (otid() == 0) *slot = (int)atomicAdd(ctr, 1u);
    __syncthreads();
    return __builtin_amdgcn_readfirstlane(*slot);
}

#define XB_TMO      128
#define XB_XCNT(j)  (256  + 64 * (j))
#define XB_XSUB(j)  (1280 + 64 * (j))
#define XB_XGEN(j)  (2304 + 64 * (j))
#define XB_TOP      3328
#define XB_TOPGEN   3392
#define XCD_BAR_WORDS 3456
#define XB_SPIN_CAP (1u << 18)

__device__ __forceinline__ unsigned xb_ld(unsigned* p)              { return __hip_atomic_load(p, __ATOMIC_RELAXED, __HIP_MEMORY_SCOPE_AGENT); }
__device__ __forceinline__ unsigned xb_add(unsigned* p, unsigned v) { return __hip_atomic_fetch_add(p, v, __ATOMIC_RELAXED, __HIP_MEMORY_SCOPE_AGENT); }
__device__ __forceinline__ unsigned xb_xcc_id() { return (unsigned)__builtin_amdgcn_s_getreg((3 << 11) | 20) & 0xFu; }
#define XB_SPIN(cond, bar) do { unsigned _sp = 0; while (cond) { __builtin_amdgcn_s_sleep(1); \
    if ((++_sp & 255u) == 0u) { if (xb_ld(&(bar)[XB_TMO])) break; if (_sp > XB_SPIN_CAP) { atomicAdd(&(bar)[XB_TMO], 1u); break; } } } } while (0)

struct XcdBarrier {
    unsigned* bar; unsigned x;
    volatile LAS unsigned* st;
};

__device__ __forceinline__ XcdBarrier xcd_barrier_post(unsigned* bar, volatile LAS unsigned* st) {
    XcdBarrier b; b.bar = bar; b.x = xb_xcc_id(); b.st = st;
    if (threadIdx.x == 0) (void)xb_add(&bar[XB_XCNT(b.x)], 1u);
    return b;
}
__device__ __forceinline__ void xcd_barrier_complete(unsigned* bar, unsigned x, unsigned& nloc, unsigned& nx) {
    const unsigned G = gridDim.x * gridDim.y * gridDim.z;
    unsigned sum, cnt, mine, sp = 0u;
    for (;;) {
        sum = 0u; cnt = 0u; mine = 0u;
#pragma unroll
        for (unsigned j = 0; j < 16; ++j) { const unsigned c = xb_ld(&bar[XB_XCNT(j)]); sum += c; cnt += (c > 0u) ? 1u : 0u; mine = (j == x) ? c : mine; }
        if (sum == G) break;
        __builtin_amdgcn_s_sleep(1);
        if ((++sp & 255u) == 0u) { if (xb_ld(&bar[XB_TMO])) break; if (sp > XB_SPIN_CAP) { atomicAdd(&bar[XB_TMO], 1u); break; } }
    }
    nloc = mine > 0u ? mine : 1u; nx = cnt > 0u ? cnt : 1u;
}

__device__ __forceinline__ void xcd_barrier(const XcdBarrier& b) {
    asm volatile("s_waitcnt vmcnt(0)" ::: "memory");
    __syncthreads();
    if (threadIdx.x == 0) {
        unsigned* bar = b.bar;
        __builtin_amdgcn_s_waitcnt(0);
        unsigned nloc = b.st[0], nx = b.st[1];
        if (nloc == 0u) { xcd_barrier_complete(bar, b.x, nloc, nx); b.st[0] = nloc; b.st[1] = nx; }
        const unsigned old = xb_add(&bar[XB_XSUB(b.x)], 1u);
        const unsigned gen = old / nloc;
        if (old + 1u == (gen + 1u) * nloc) {
            __builtin_amdgcn_fence(__ATOMIC_RELEASE, "agent");
            asm volatile("s_waitcnt vmcnt(0)" ::: "memory");
            const unsigned og = xb_add(&bar[XB_TOP], 1u);
            const unsigned tg = og / nx;
            if (og + 1u == (tg + 1u) * nx) xb_add(&bar[XB_TOPGEN], 1u);
            else XB_SPIN(xb_ld(&bar[XB_TOPGEN]) == tg, bar);
            __builtin_amdgcn_fence(__ATOMIC_ACQUIRE, "agent");
            xb_add(&bar[XB_XGEN(b.x)], 1u);
            asm volatile("s_waitcnt vmcnt(0)" ::: "memory");
        } else {
            XB_SPIN(xb_ld(&bar[XB_XGEN(b.x)]) == gen, bar);
            __builtin_amdgcn_fence(__ATOMIC_ACQUIRE, "agent");
            asm volatile("s_waitcnt vmcnt(0)" ::: "memory");
        }
    }
    __syncthreads();
}

#ifndef BG_C1
#define BG_C1 5
#define BG_C2 15
#define BG_C3 20
#endif
enum { K_FINAL = 12, K_P0 = 0, K_MODNORM, K_GEMM_IN, K_PREP_AB, K_GEMM_QUP, K_GEMM_KVUP, K_HN_AB, K_MIX_AB, K_FIN_AB, K_GEMM_OUT, K_HN_C, K_ATTN_C };

__global__ void __launch_bounds__(NTHR, 2) mk_fwd(Args a_byval) {
    extern __shared__ __attribute__((aligned(16))) unsigned char lds_raw[];
    LAS unsigned char* lds = (LAS unsigned char*)lds_raw;
    LAS int* slot = (LAS int*)(lds + LDS_PHASE);
    cg::grid_group grid = cg::this_grid();
    const int G = gridDim.x;
    volatile LAS unsigned* bst = (volatile LAS unsigned*)(lds + LDS_PHASE + 64);
    if (threadIdx.x < 2) bst[threadIdx.x] = 0u;
    __syncthreads();
    (void)xcd_barrier_post((unsigned*)(a_byval.ws + WS_CTL) + 8192, bst);

    grid.sync();
#ifndef PROBE_TSEL
#define PROBE_TSEL 0
#endif
    unsigned long long t_acc = 0ull;
    for (int step = 0; step < 30; ++step) {
        unsigned long long t_begin = 0ull; if (PROBE_TSEL) t_begin = __builtin_amdgcn_s_memrealtime();
        asm volatile("" : "+s"(step));
        KArgs a = (KArgs)__builtin_amdgcn_kernarg_segment_ptr();
        asm volatile("" : "+s"(a));
        unsigned char* ws = a->ws;
        unsigned* ctl = (unsigned*)(ws + WS_CTL);
        XcdBarrier xbar; xbar.bar = ctl + 8192; xbar.x = xb_xcc_id(); xbar.st = (volatile LAS unsigned*)(lds + LDS_PHASE + 64);
        int kind, L = 0; bool sync_after = true;
        if (step == 0) kind = K_P0;
        else if (step == 29) { kind = K_FINAL; L = 4; }
        else { const int s = step - 1, pair = s / 14, r = s % 14;
            if (r < 9) { L = 2 * pair; kind = r == 0 ? K_MODNORM : r == 1 ? K_GEMM_IN : r == 2 ? K_PREP_AB : r == 3 ? K_GEMM_QUP : r == 4 ? K_GEMM_KVUP : r == 5 ? K_HN_AB : r == 6 ? K_MIX_AB : r == 7 ? K_FIN_AB : K_GEMM_OUT; }
            else { L = 2 * pair + 1; const int q = r - 9; kind = q == 0 ? K_MODNORM : q == 1 ? K_GEMM_IN : q == 2 ? K_HN_C : q == 3 ? K_ATTN_C : K_GEMM_OUT; } }
        const int j = L >> 1; const bool isC = (L & 1) != 0;
        if (kind == K_GEMM_QUP) sync_after = false;
        if (step == 29) sync_after = false;

#ifndef PROBE_MASK
#define PROBE_MASK 0
#endif
#ifndef PROBE_SEL
#define PROBE_SEL 0
#endif
#ifndef PROBE_REPS
#define PROBE_REPS 2
#endif
        const int nrep = (((PROBE_MASK >> kind) & 1) && (kind != K_GEMM_OUT || L == 0)) ? 1 + PROBE_REPS : 1;
        for (int rep = 0; rep < nrep; ++rep) {
        if (PROBE_MASK == 0x1000) { for (int q = 0; q < 2; ++q) xcd_barrier(xbar); }
        const int bid = obid();
        const bool bgphase = kind == K_PREP_AB || kind == K_GEMM_QUP || kind == K_GEMM_KVUP || kind == K_HN_AB;
        if (rep == 0 && bid < NBG && (kind == K_PREP_AB || kind == K_GEMM_QUP || kind == K_HN_AB || kind == K_MIX_AB)) {
            const int b = bid >> 4, h = (bid >> 1) & 7, dir = bid & 1;
            const int c0 = kind == K_PREP_AB ? 0 : kind == K_GEMM_QUP ? BG_C1 : kind == K_HN_AB ? BG_C2 : BG_C3;
            const int c1 = kind == K_PREP_AB ? BG_C1 : kind == K_GEMM_QUP ? BG_C2 : kind == K_HN_AB ? BG_C3 : 64;
            hgrn_item(lds, (const bf16_t*)(ws + WS_PROJ), MC + b * 2048, 2048, h, dir, (const float*)(ws + WS_LB) + (j * 2 + dir) * 1024 + h * 128,
                      a->in[4 + dir] + (size_t)((b * 2 + j) * 8 + h) * 16384, nullptr, (bf16_t*)(ws + (dir ? WS_OB : WS_OF)), c0, c1, (float*)(ws + WS_SBUF) + (size_t)bid * 16384);
        }
        const int ewg = bgphase ? bid - NBG : bid, enwg = bgphase ? G - NBG : G;
        if (bgphase && bid < NBG) {}
        else
        if (kind == K_P0) phase_p0(a, lds);
        else if (kind == K_MODNORM) phase_modnorm(a, L);
        else if (kind == K_GEMM_IN || kind == K_GEMM_QUP || kind == K_GEMM_KVUP) {
            pg8::Gemm g; pg8::EpiStore E;
            if (kind == K_GEMM_IN) {
                if (!isC) { g = pg8::Gemm{(const bf16_t*)(ws + WS_H), (const bf16_t*)(ws + WS_WINAB) + (size_t)j * 7168 * 2048, MROWS, 7168, 2048}; E = pg8::EpiStore{(bf16_t*)(ws + WS_PROJ), LDP_AB}; }
                else { g = pg8::Gemm{(const bf16_t*)(ws + WS_H), (const bf16_t*)(ws + WS_WINC) + (size_t)j * 5120 * 2048, MROWS, 5120, 2048}; E = pg8::EpiStore{(bf16_t*)(ws + WS_PROJ), LDP_C}; }
            } else if (kind == K_GEMM_QUP) { g = pg8::Gemm{(const bf16_t*)(ws + WS_QN), (const bf16_t*)(ws + WS_WQUP) + (size_t)j * 1536 * 512, MROWS, 1536, 512}; E = pg8::EpiStore{(bf16_t*)(ws + WS_QRAW), 1536}; }
            else { g = pg8::Gemm{(const bf16_t*)(ws + WS_CKV), (const bf16_t*)(ws + WS_WKVUP) + (size_t)j * 2048 * 256, MKROWS, 2048, 256}; E = pg8::EpiStore{(bf16_t*)(ws + WS_KVRAW), 2048}; }
            pg8::StaticOrder S; S.init(g.M, g.N, enwg, ewg);
            pg8::gemm_phase<pg8::EpiStore, pg8::StaticOrder, true, true>(lds, g, S, E);
            if (kind == K_GEMM_IN && L <= 1) { const int left = ((g.M / 256) * (g.N / 256)) % G;
                if (left > 0 && bid >= left) { const int lo = L == 0 ? P0_EARLY : P0_EARLY + 10000, hi = L == 0 ? P0_EARLY + 6000 : P0_EARLY + 12000;
                    p0_transposes(a, lds, lo, hi, (bid - left) * NWAVES + (otid() >> 6), (G - left) * NWAVES); } }
        }
        else if (kind == K_GEMM_OUT) {
            pg8::Gemm g{(const bf16_t*)(ws + WS_H), (const bf16_t*)(ws + (isC ? WS_WOUTC : WS_WOUTAB)) + (size_t)j * 2048 * 2048, MROWS, 2048, 2048};
            pg8::EpiResid E{(bf16_t*)(ws + WS_PROJ), (const float*)(ws + WS_MOD) + (size_t)L * 5 * 6144 + 4096,
                            (float*)(ws + WS_QRAW), ctl + 16384 + step * 256};
            pg8::StaticOrder S; S.init(g.M, g.N, G, obid());
            pg8::gemm_phase<pg8::EpiResid, pg8::StaticOrder, true, true>(lds, g, S, E);
            if (L <= 1) { const int left = ((g.M / 256) * (g.N / 256)) % G;
                if (left > 0 && bid >= left) { const int lo = L == 0 ? P0_EARLY + 6000 : P0_EARLY + 12000, hi = L == 0 ? P0_EARLY + 10000 : P0_EARLY + 16000;
                    p0_transposes(a, lds, lo, hi, (bid - left) * NWAVES + (otid() >> 6), (G - left) * NWAVES); } }
        }
        else if (kind == K_FINAL) phase_final(a);
        else if (kind == K_PREP_AB) phase_prep_ab(a, j, ewg, enwg);
        else if (kind == K_HN_AB) phase_hn_ab(a, j, ewg, enwg);
        else if (kind == K_FIN_AB) phase_fin_ab(a, j);
        else if (kind == K_HN_C) phase_hn_c(a, j);
        else if (kind == K_MIX_AB) {
            unsigned* ctr = ctl + 64 * step + 8 * rep;
            const bf16_t* P = (const bf16_t*)(ws + WS_PROJ); bf16_t* MIX = (bf16_t*)(ws + WS_H);
            const bf16_t* QF = (const bf16_t*)(ws + WS_QRAW); const bf16_t* KF = (const bf16_t*)(ws + WS_KF); const bf16_t* KV = (const bf16_t*)(ws + WS_KVRAW);
            for (;;) {
                const int idx = fetch_item(ctr, slot);
                if (idx >= 640) break;
                if (idx >= 256 && idx < 512) {
                    const int i = idx - 256; const int b = i >> 4, h = (i >> 1) & 7, dir = i & 1;
                    const float* lb = (const float*)(ws + WS_LB) + (j * 2 + dir) * 1024 + h * 128;
                    float* so = a->out + (dir ? O_SB : O_SF) + (size_t)((b * 2 + j) * 8 + h) * 16384;
                    if (PROBE_SEL != 1 || rep == 0) hgrn_item(lds, P, b * 256, 256, h, dir, lb, nullptr, so, (bf16_t*)(ws + (dir ? WS_OB : WS_OF)), 0, 8, (float*)(ws + WS_SBUF));
                } else {
                    att::Item it;
                    const bool lat = idx < 256; int b, h, r0;
                    if (lat) { const int i = idx; b = i >> 6; h = (i >> 3) & 7; const int qb = i & 7; r0 = MC + b * 2048 + qb * 256; it.q0 = qb * 256;
                        it.K0 = KF + (size_t)(MROWS + b * 256) * 1536 + h * 192; it.V0 = KV + (size_t)(MROWS + b * 256) * 2048 + h * 256 + 128; it.n0 = 4;
                        it.K1 = KF + (size_t)(MC + b * 2048) * 1536 + h * 192; it.V1 = KV + (size_t)(MC + b * 2048) * 2048 + h * 256 + 128; it.t_lo = 0; it.t_hi = 32; }
                    else { const int i = idx - 512; b = i >> 3; h = i & 7; r0 = b * 256; it.q0 = 0;
                        it.K0 = KF; it.V0 = KV; it.n0 = 0;
                        it.K1 = KF + (size_t)r0 * 1536 + h * 192; it.V1 = KV + (size_t)r0 * 2048 + h * 256 + 128; it.t_lo = 0; it.t_hi = 4; }
                    it.ldk = 1536; it.ldv = 2048;
                    it.Q = QF + (size_t)r0 * 1536 + h * 192; it.ldq = 1536; it.band = 0; it.m0 = -1e30f; it.l0 = 0.f;
                    it.qg = a->in[18] + j * 192; it.rope = lat ? (const float*)(ws + WS_ROPEA) : nullptr; it.qscale = QSC_A;
                    it.G = P + (size_t)r0 * LDP_AB + COL_AG + h * 128; it.ldg = LDP_AB; it.O = MIX + (size_t)r0 * DM + h * 128; it.ldo = DM;
                    if (PROBE_SEL != 2 || rep == 0) att::attn_item<192>(lds, it);
                }
            }
        }
        else if (kind == K_ATTN_C) {
            unsigned* ctr = ctl + 64 * step + 8 * rep;
            const bf16_t* P = (const bf16_t*)(ws + WS_PROJ); bf16_t* MIX = (bf16_t*)(ws + WS_H);
            const bf16_t* KCC = (const bf16_t*)(ws + WS_KCC);
            const bool sdeal = G == 256; const int xg = bid & 7, xw = bid >> 3;
            for (int kq = 0;; ++kq) {
                int idx;
                if (sdeal) { if (kq >= 3) break;
                    if (kq < 2) { const int grp = 2 * xg + kq; idx = ((grp >> 2) << 7) | ((((grp & 3) << 2) | (xw >> 3)) << 3) | (xw & 7); }
                    else { const int grp = 8 * xg + (xw >> 2); idx = 512 + (((grp >> 2) << 4) | ((grp & 3) << 2) | (xw & 3)); } }
                else { idx = fetch_item(ctr, slot); if (idx >= 768) break; }
                att::Item it; int b, h, r0;
                if (idx < 512) { b = idx >> 7; h = (idx >> 3) & 15; const int qb = idx & 7; r0 = MC + b * 2048 + qb * 256; const int kvh = h >> 2;
                    it.K0 = KCC + (size_t)((b * 2 + j) * 256) * LDP_C + kvh * 128; it.V0 = KCC + (size_t)((b * 2 + j) * 256) * LDP_C + 512 + kvh * 128; it.n0 = 4;
                    it.K1 = P + (size_t)(MC + b * 2048) * LDP_C + 2048 + kvh * 128; it.V1 = P + (size_t)(MC + b * 2048) * LDP_C + 2560 + kvh * 128;
                    it.t_lo = 4 * qb - 2 < 0 ? 0 : 4 * qb - 2; it.t_hi = 4 * qb + 6 > 32 ? 32 : 4 * qb + 6; it.q0 = qb * 256; it.band = 1; }
                else { const int i = idx - 512; b = i >> 4; h = i & 15; r0 = b * 256; const int kvh = h >> 2;
                    it.K0 = KCC; it.V0 = KCC; it.n0 = 0;
                    it.K1 = P + (size_t)r0 * LDP_C + 2048 + kvh * 128; it.V1 = P + (size_t)r0 * LDP_C + 2560 + kvh * 128; it.t_lo = 0; it.t_hi = 4; it.q0 = 0; it.band = 0; }
                it.ldk = LDP_C; it.ldv = LDP_C;
                it.Q = P + (size_t)r0 * LDP_C + h * 128; it.ldq = LDP_C; it.m0 = a->in[29][j * 16 + h] * LOG2E; it.l0 = 1.f;
                it.qg = a->in[27] + j * 128; it.rope = idx < 512 ? (const float*)(ws + WS_ROPEC) : nullptr; it.qscale = QSC_C;
                it.G = P + (size_t)r0 * LDP_C + 3072 + h * 128; it.ldg = LDP_C; it.O = MIX + (size_t)r0 * DM + h * 128; it.ldo = DM;
                att::attn_item<128>(lds, it);
            }
        }
        if (rep + 1 < nrep) xcd_barrier(xbar);
        }
        if (sync_after) xcd_barrier(xbar);
        if (PROBE_TSEL) { if ((PROBE_TSEL >> kind) & 1) t_acc += __builtin_amdgcn_s_memrealtime() - t_begin; }
    }
    if (PROBE_TSEL) { if (blockIdx.x == 0) { const unsigned long long t_end = __builtin_amdgcn_s_memrealtime() + 2ull * t_acc;
        while (__builtin_amdgcn_s_memrealtime() < t_end) __builtin_amdgcn_s_sleep(32); } }
}

extern "C" void kernel_launch(void* const* d_in, const int* in_sizes, int n_in, void* d_out, int out_size, void* d_ws, size_t ws_size, hipStream_t stream) {
    static int grid = 0;
    if (grid == 0) {
        if (n_in != 31 || ws_size < WS_END) { fprintf(stderr, "kernel_launch: unexpected n_in %d or ws_size %zu (< %zu)\n", n_in, ws_size, (size_t)WS_END); grid = -1; return; }
        int dev = 0, cus = 0, per_cu = 0;
        hipGetDevice(&dev); hipDeviceGetAttribute(&cus, hipDeviceAttributeMultiprocessorCount, dev);
        if (hipFuncSetAttribute((const void*)mk_fwd, hipFuncAttributeMaxDynamicSharedMemorySize, LDS_BYTES) != hipSuccess) { fprintf(stderr, "kernel_launch: hipFuncSetAttribute failed\n"); grid = -1; return; }
        if (hipOccupancyMaxActiveBlocksPerMultiprocessor(&per_cu, (const void*)mk_fwd, NTHR, LDS_BYTES) != hipSuccess || per_cu < 1) per_cu = 1;
        (void)hipGetLastError();
        grid = cus > 0 ? cus : 256;
    }
    if (grid < 0) return;
    hipMemsetAsync((char*)d_ws + WS_CTL, 0, CTL_BYTES, stream);
    Args a{};
    for (int i = 0; i < 31; ++i) a.in[i] = (const float*)d_in[i];
    a.out = (float*)d_out; a.ws = (unsigned char*)d_ws;
    void* args[] = {&a};
    hipError_t e = hipLaunchCooperativeKernel((const void*)mk_fwd, dim3(grid), dim3(NTHR), args, LDS_BYTES, stream);
    if (e != hipSuccess) fprintf(stderr, "cooperative launch failed: %s (grid %d)\n", hipGetErrorString(e), grid);
}
```
